# Optimizing an MI355X kernel written in HIP

```python
import jax
import jax.numpy as jnp
from jax import lax
import numpy as np

D_MODEL = 1024
BATCH = 2
SEQ = 16384
DEPTH = 2

GRID_W = 64
CTX_LEN = 256

FNET_GROUPS = 4
FNET_GROUP_DIM = 128
FNET_WIDTH = FNET_GROUPS * FNET_GROUP_DIM

NA_HEADS = 8
NA_HEAD_DIM = 64
NA_WIDTH = NA_HEADS * NA_HEAD_DIM
NA_KH = 8
NA_KW = 16
NA_SCALE = NA_HEAD_DIM ** -0.5

MLA_HEADS = 8
MLA_Q_LORA = 256
MLA_KV_LORA = 128
MLA_NOPE_DIM = 64
MLA_ROPE_DIM = 32
MLA_V_DIM = 64
MLA_WIDTH = MLA_HEADS * MLA_V_DIM
MLA_SCALE = (MLA_NOPE_DIM + MLA_ROPE_DIM) ** -0.5
ATTN_BLOCK = 128
ROPE_BASE = 10000.0

N_BRANCH = 3
BRANCH_DIM = 512

FFN_HIDDEN = -(-8 * D_MODEL // (3 * 256)) * 256

NORM_EPS = 1e-5
DEEPNORM_ALPHA = (2 * DEPTH) ** 0.25
DEEPNORM_BETA = (8 * DEPTH) ** -0.25

IN_SIZES = (FNET_WIDTH, NA_WIDTH, NA_WIDTH, NA_WIDTH, MLA_Q_LORA, MLA_KV_LORA, MLA_ROPE_DIM, N_BRANCH * D_MODEL)
IN_DIM = int(sum(IN_SIZES))
IN_OFFSETS = [int(v) for v in np.cumsum(IN_SIZES)[:-1]]

kernel_name = 'hybrid_fnet_natten_mla_deepnorm_prefix'


def layer_norm(x, g, b):
    xf = x.astype(jnp.float32)
    mu = jnp.mean(xf, axis=-1, keepdims=True)
    var = jnp.mean(jnp.square(xf - mu), axis=-1, keepdims=True)
    y = (xf - mu) * lax.rsqrt(var + NORM_EPS) * g.astype(jnp.float32) + b.astype(jnp.float32)
    return y.astype(x.dtype)


def rms_norm(x, g):
    xf = x.astype(jnp.float32)
    y = xf * lax.rsqrt(jnp.mean(jnp.square(xf), axis=-1, keepdims=True) + NORM_EPS) * g.astype(jnp.float32)
    return y.astype(x.dtype)


def rope_tables(n):
    t = jnp.arange(n, dtype=jnp.int32)
    rows = (t // GRID_W).astype(jnp.float32)
    cols = (t % GRID_W).astype(jnp.float32)
    n_freq = MLA_ROPE_DIM // 4
    inv_freq = ROPE_BASE ** (-jnp.arange(n_freq, dtype=jnp.float32) / n_freq)
    ang = jnp.concatenate([rows[:, None] * inv_freq, cols[:, None] * inv_freq], axis=-1)
    return jnp.cos(ang), jnp.sin(ang)


def axial_rope(x, cos, sin):
    xf = x.astype(jnp.float32)
    half = x.shape[-1] // 2
    x1, x2 = xf[..., :half], xf[..., half:]
    return jnp.concatenate([x1 * cos - x2 * sin, x2 * cos + x1 * sin], axis=-1).astype(x.dtype)


def split_heads(z, n_heads):
    b, n, w = z.shape
    return z.reshape(b, n, n_heads, w // n_heads)


def fourier_mix(z):
    b, n, _ = z.shape
    zg = z.reshape(b, n, FNET_GROUPS, FNET_GROUP_DIM).astype(jnp.float32)
    y = jnp.fft.fft2(zg, axes=(1, 3), norm='ortho').real
    return y.reshape(b, n, FNET_WIDTH).astype(z.dtype)


def softmax_attend(q, k, v, scale):
    s = jnp.einsum('bqhd,bkhd->bhqk', q, k, preferred_element_type=jnp.float32) * scale
    p = jax.nn.softmax(s, axis=-1).astype(v.dtype)
    return jnp.einsum('bhqk,bkhd->bqhd', p, v)


def blocked_attend(q, k, v, scale):
    b, n, h, dq = q.shape
    qb = q.reshape(b, n // ATTN_BLOCK, ATTN_BLOCK, h, dq).transpose(1, 0, 2, 3, 4)
    out = lax.map(lambda qi: softmax_attend(qi, k, v, scale), qb)
    return out.transpose(1, 0, 2, 3, 4).reshape(b, n, h, v.shape[-1])


def neighbourhood_attention(q, k, v, k_ctx, v_ctx, rpb, n_rows):
    b, n, h, dh = q.shape
    kh = min(NA_KH, n_rows)
    kw = NA_KW
    qg = q.reshape(b, n_rows, GRID_W, h, dh).transpose(1, 0, 2, 3, 4)
    kg = k.reshape(b, n_rows, GRID_W, h, dh)
    vg = v.reshape(b, n_rows, GRID_W, h, dh)
    cols = jnp.arange(GRID_W, dtype=jnp.int32)
    col_start = jnp.clip(cols - kw // 2, 0, GRID_W - kw)
    col_idx = col_start[:, None] + jnp.arange(kw, dtype=jnp.int32)
    dc = col_idx - cols[:, None] + (NA_KW - 1)
    rpb_c = rpb.astype(jnp.float32)[:, :, dc]
    n_loc = kh * kw

    def row_fn(args):
        r, q_r = args
        rs = jnp.clip(r - kh // 2, 0, n_rows - kh)
        k_rows = lax.dynamic_slice_in_dim(kg, rs, kh, axis=1)
        v_rows = lax.dynamic_slice_in_dim(vg, rs, kh, axis=1)
        k_win = k_rows[:, :, col_idx]
        v_win = v_rows[:, :, col_idx]
        dr = rs + jnp.arange(kh, dtype=jnp.int32) - r + (NA_KH - 1)
        bias = jnp.take(rpb_c, dr, axis=1).transpose(0, 2, 1, 3)
        s_loc = jnp.einsum('bwhd,bkwjhd->bhwkj', q_r, k_win, preferred_element_type=jnp.float32) * NA_SCALE + bias[None]
        s_ctx = jnp.einsum('bwhd,bchd->bhwc', q_r, k_ctx, preferred_element_type=jnp.float32) * NA_SCALE
        s = jnp.concatenate([s_loc.reshape(b, h, GRID_W, n_loc), s_ctx], axis=-1)
        p = jax.nn.softmax(s, axis=-1).astype(v.dtype)
        p_loc = p[..., :n_loc].reshape(b, h, GRID_W, kh, kw)
        p_ctx = p[..., n_loc:]
        return (jnp.einsum('bhwkj,bkwjhd->bwhd', p_loc, v_win)
                + jnp.einsum('bhwc,bchd->bwhd', p_ctx, v_ctx))

    out = lax.map(row_fn, (jnp.arange(n_rows, dtype=jnp.int32), qg))
    return out.transpose(1, 0, 2, 3, 4).reshape(b, n, h * dh)


def mla_queries(cq, g_q, w_uq, w_qr, rope):
    b, n, _ = cq.shape
    cq = rms_norm(cq, g_q)
    q_nope = (cq @ w_uq).reshape(b, n, MLA_HEADS, MLA_NOPE_DIM)
    q_rope = (cq @ w_qr).reshape(b, n, MLA_HEADS, MLA_ROPE_DIM)
    if rope is not None:
        q_rope = axial_rope(q_rope, rope[0][:, None, :], rope[1][:, None, :])
    return jnp.concatenate([q_nope, q_rope], axis=-1)


def mla_keys_values(ckv, kr, g_kv, w_uk, w_uv, rope):
    b, n, _ = ckv.shape
    ckv = rms_norm(ckv, g_kv)
    k_nope = (ckv @ w_uk).reshape(b, n, MLA_HEADS, MLA_NOPE_DIM)
    v = (ckv @ w_uv).reshape(b, n, MLA_HEADS, MLA_V_DIM)
    if rope is not None:
        kr = axial_rope(kr, rope[0], rope[1])
    k_rope = jnp.broadcast_to(kr[:, :, None, :], (b, n, MLA_HEADS, MLA_ROPE_DIM))
    return jnp.concatenate([k_nope, k_rope], axis=-1), v


def merge_branches(ys, g, w_branch, w_out):
    b, n, _ = g.shape
    y = jnp.stack(ys, axis=2)
    proj = jnp.einsum('bngi,gio->bngo', y, w_branch)
    gate = jax.nn.sigmoid(g.reshape(b, n, N_BRANCH, D_MODEL).astype(jnp.float32)).astype(proj.dtype)
    return jnp.sum(gate * proj, axis=2) @ w_out


def mixer(h, hc, lp, rope, n_rows, need_ctx):
    b, n, _ = h.shape
    f, nq, nk, nv, cq, ckv, kr, g = jnp.split(h @ lp['w_in'], IN_OFFSETS, axis=-1)
    fc, nqc, nkc, nvc, cqc, ckvc, krc, gc = jnp.split(hc @ lp['w_in'], IN_OFFSETS, axis=-1)
    na_kc, na_vc = split_heads(nkc, NA_HEADS), split_heads(nvc, NA_HEADS)
    mla_kc, mla_vc = mla_keys_values(ckvc, krc, lp['g_kv'], lp['w_uk'], lp['w_uv'], None)
    y_f = fourier_mix(f)
    y_na = neighbourhood_attention(split_heads(nq, NA_HEADS), split_heads(nk, NA_HEADS), split_heads(nv, NA_HEADS),
                                   na_kc, na_vc, lp['rpb'], n_rows)
    mla_k, mla_v = mla_keys_values(ckv, kr, lp['g_kv'], lp['w_uk'], lp['w_uv'], rope)
    mla_q = mla_queries(cq, lp['g_q'], lp['w_uq'], lp['w_qr'], rope)
    y_mla = blocked_attend(mla_q, jnp.concatenate([mla_kc, mla_k], axis=1),
                           jnp.concatenate([mla_vc, mla_v], axis=1), MLA_SCALE).reshape(b, n, MLA_WIDTH)
    out = merge_branches([y_f, y_na, y_mla], g, lp['w_branch'], lp['w_out'])
    if not need_ctx:
        return out, None
    n_ctx = hc.shape[1]
    yc_f = fourier_mix(fc)
    yc_na = softmax_attend(split_heads(nqc, NA_HEADS), na_kc, na_vc, NA_SCALE).reshape(b, n_ctx, NA_WIDTH)
    mla_qc = mla_queries(cqc, lp['g_q'], lp['w_uq'], lp['w_qr'], None)
    yc_mla = softmax_attend(mla_qc, mla_kc, mla_vc, MLA_SCALE).reshape(b, n_ctx, MLA_WIDTH)
    out_c = merge_branches([yc_f, yc_na, yc_mla], gc, lp['w_branch'], lp['w_out'])
    return out, out_c


def swiglu(h, w_gate, w_up, w_down):
    return (jax.nn.silu(h @ w_gate) * (h @ w_up)) @ w_down


def setup_inputs(seed: int = 0) -> dict:
    key = jax.random.key(seed)
    ks = jax.random.split(key, 32)

    def nrm(k, shape, scale):
        return jax.random.normal(k, shape, dtype=jnp.float32) * scale

    L, D, F = DEPTH, D_MODEL, FFN_HIDDEN
    return {
        'x': nrm(ks[0], (BATCH, SEQ, D), 1.0),
        'c': nrm(ks[1], (BATCH, D), 1.0),
        'ctx': nrm(ks[2], (BATCH, CTX_LEN, D), 1.0),
        'c_ctx': nrm(ks[3], (D,), 1.0),
        'ln_in_g': 1.0 + nrm(ks[4], (D,), 0.02),
        'ln_in_b': nrm(ks[5], (D,), 0.02),
        'w_mod': nrm(ks[6], (L, D, 6 * D), 0.1 * D ** -0.5),
        'b_mod': nrm(ks[7], (L, 6 * D), 0.02),
        'w_in': nrm(ks[8], (L, D, IN_DIM), D ** -0.5),
        'mla_q_norm_g': 1.0 + nrm(ks[9], (L, MLA_Q_LORA), 0.02),
        'mla_kv_norm_g': 1.0 + nrm(ks[10], (L, MLA_KV_LORA), 0.02),
        'w_uq': nrm(ks[11], (L, MLA_Q_LORA, MLA_HEADS * MLA_NOPE_DIM), MLA_Q_LORA ** -0.5),
        'w_qr': nrm(ks[12], (L, MLA_Q_LORA, MLA_HEADS * MLA_ROPE_DIM), MLA_Q_LORA ** -0.5),
        'w_uk': nrm(ks[13], (L, MLA_KV_LORA, MLA_HEADS * MLA_NOPE_DIM), MLA_KV_LORA ** -0.5),
        'w_uv': nrm(ks[14], (L, MLA_KV_LORA, MLA_HEADS * MLA_V_DIM), MLA_KV_LORA ** -0.5),
        'na_rpb': nrm(ks[15], (L, NA_HEADS, 2 * NA_KH - 1, 2 * NA_KW - 1), 0.1),
        'w_branch': nrm(ks[16], (L, N_BRANCH, BRANCH_DIM, D), BRANCH_DIM ** -0.5),
        'w_out': nrm(ks[17], (L, D, D), DEEPNORM_BETA * D ** -0.5),
        'ln1_g': 1.0 + nrm(ks[18], (L, D), 0.02),
        'ln1_b': nrm(ks[19], (L, D), 0.02),
        'ln2_g': 1.0 + nrm(ks[20], (L, D), 0.02),
        'ln2_b': nrm(ks[21], (L, D), 0.02),
        'w_ffn_gate': nrm(ks[22], (L, D, F), D ** -0.5),
        'w_ffn_up': nrm(ks[23], (L, D, F), D ** -0.5),
        'w_ffn_down': nrm(ks[24], (L, F, D), DEEPNORM_BETA * F ** -0.5),
    }


def reference(x, c, ctx, c_ctx, ln_in_g, ln_in_b, w_mod, b_mod, w_in, mla_q_norm_g, mla_kv_norm_g,
              w_uq, w_qr, w_uk, w_uv, na_rpb, w_branch, w_out, ln1_g, ln1_b, ln2_g, ln2_b,
              w_ffn_gate, w_ffn_up, w_ffn_down):
    n = x.shape[1]
    n_rows = n // GRID_W
    rope = rope_tables(n)
    x_lat = layer_norm(x, ln_in_g, ln_in_b)
    x_ctx = layer_norm(ctx, ln_in_g, ln_in_b)
    silu_c = jax.nn.silu(c)
    silu_cc = jax.nn.silu(c_ctx)
    for l in range(DEPTH):
        last = l == DEPTH - 1
        lp = {'w_in': w_in[l], 'g_q': mla_q_norm_g[l], 'g_kv': mla_kv_norm_g[l], 'w_uq': w_uq[l],
              'w_qr': w_qr[l], 'w_uk': w_uk[l], 'w_uv': w_uv[l], 'rpb': na_rpb[l],
              'w_branch': w_branch[l], 'w_out': w_out[l]}
        sh1, sc1, g1, sh2, sc2, g2 = [m[:, None, :] for m in jnp.split(silu_c @ w_mod[l] + b_mod[l], 6, axis=-1)]
        csh1, csc1, cg1, csh2, csc2, cg2 = jnp.split(silu_cc @ w_mod[l] + b_mod[l], 6, axis=-1)
        a_lat = x_lat * (1 + sc1) + sh1
        a_ctx = x_ctx * (1 + csc1) + csh1
        m_lat, m_ctx = mixer(a_lat, a_ctx, lp, rope, n_rows, not last)
        x_lat = layer_norm(DEEPNORM_ALPHA * x_lat + (1 + g1) * m_lat, ln1_g[l], ln1_b[l])
        f_lat = swiglu(x_lat * (1 + sc2) + sh2, w_ffn_gate[l], w_ffn_up[l], w_ffn_down[l])
        x_lat = layer_norm(DEEPNORM_ALPHA * x_lat + (1 + g2) * f_lat, ln2_g[l], ln2_b[l])
        if not last:
            x_ctx = layer_norm(DEEPNORM_ALPHA * x_ctx + (1 + cg1) * m_ctx, ln1_g[l], ln1_b[l])
            f_ctx = swiglu(x_ctx * (1 + csc2) + csh2, w_ffn_gate[l], w_ffn_up[l], w_ffn_down[l])
            x_ctx = layer_norm(DEEPNORM_ALPHA * x_ctx + (1 + cg2) * f_ctx, ln2_g[l], ln2_b[l])
    return x_lat
```

```cpp
#include <hip/hip_runtime.h>
#include <hip/hip_cooperative_groups.h>
#include <stdint.h>
#include <cstdio>
namespace cg = cooperative_groups;

#ifndef COOP
#define COOP 1
#endif

typedef __attribute__((ext_vector_type(8))) short bf16x8;
typedef __attribute__((ext_vector_type(4))) short bf16x4;
typedef __attribute__((ext_vector_type(16))) float f32x16;
typedef unsigned short u16;
typedef __attribute__((ext_vector_type(4))) unsigned int u32x4;

constexpr int D = 1024;
constexpr int NBATCH = 2;
constexpr int SEQ = 16384;
constexpr int CTXL = 256;
constexpr int KPB = SEQ + CTXL;
constexpr int T = NBATCH * KPB;
constexpr int NRT = T / 128;
constexpr int FH = 2816;
constexpr int IN_DIM = 5536;
constexpr float LOG2E = 1.4426950408889634f;
constexpr float NA_SCALE_L2 = 0.125f * LOG2E;
constexpr float MLA_SCALE_L2 = 0.10206207261596575f * LOG2E;
constexpr float ALPHA = 1.4142135623730951f;
constexpr float EPS = 1e-5f;
constexpr float RS128 = 0.08838834764831845f;

constexpr size_t al256(size_t x) { return (x + 255) & ~(size_t)255; }
constexpr size_t O_WF = 0;
constexpr size_t O_WP = O_WF + (size_t)1024 * 1024 * 2;
constexpr size_t O_WG = O_WP + (size_t)2048 * 1024 * 2;
constexpr size_t O_WUQ = O_WG + (size_t)3072 * 1024 * 2;
constexpr size_t O_WUKV = O_WUQ + (size_t)768 * 256 * 2;
constexpr size_t O_WB = O_WUKV + (size_t)1024 * 128 * 2;
constexpr size_t O_WO = O_WB + (size_t)3 * 1024 * 512 * 2;
constexpr size_t O_WGU = O_WO + (size_t)1024 * 1024 * 2;
constexpr size_t O_WD = O_WGU + (size_t)5632 * 1024 * 2;
constexpr size_t O_MA = O_WD + (size_t)1024 * 2816 * 2;
constexpr size_t O_MB = O_MA + (size_t)256 * 256 * 2;
constexpr size_t O_MC = O_MB + (size_t)128 * 256 * 2;
constexpr size_t O_TW = O_MC + (size_t)256 * 512 * 2;
constexpr size_t O_MODP = O_TW + (size_t)128 * 128 * 2 * 4;
constexpr size_t O_MOD = O_MODP + (size_t)16 * 2 * 3 * 6144 * 4;
constexpr size_t O_XCTX = O_MOD + (size_t)2 * 3 * 6144 * 4;
constexpr size_t O_D1C = O_XCTX + (size_t)512 * 1024 * 4;
constexpr size_t O_A = O_D1C + (size_t)2 * 512 * 2 * 256 * 2;
constexpr size_t O_RQ = O_A + (size_t)T * 1024 * 2;
constexpr size_t O_QNA = O_RQ;
constexpr size_t O_KNA = O_QNA + (size_t)T * 512 * 2;
constexpr size_t O_VNAT = O_KNA + (size_t)T * 512 * 2;
constexpr size_t O_RY = O_VNAT + (size_t)T * 512 * 2;
constexpr size_t O_Y = O_RY;
constexpr size_t O_D1 = O_RY;
constexpr size_t O_LAT = O_RY + (size_t)67108864;
constexpr size_t O_D2 = O_RY + (size_t)T * 1536 * 2;
constexpr size_t O_QM = O_D2 + (size_t)67108864;
constexpr size_t O_KN = O_QM + (size_t)T * 768 * 2;
constexpr size_t O_KRR = O_KN + (size_t)T * 512 * 2;
constexpr size_t O_VMT = O_KRR + (size_t)T * 32 * 2;
constexpr size_t O_END = O_VMT + (size_t)T * 512 * 2;
constexpr size_t O_M = O_RQ;
constexpr size_t O_HH = O_RQ;

struct Params {
  const float *x, *c, *ctx, *c_ctx, *ln_in_g, *ln_in_b, *w_mod, *b_mod, *w_in, *gq, *gkv, *w_uq, *w_qr, *w_uk,
      *w_uv, *rpb, *w_branch, *w_out, *ln1_g, *ln1_b, *ln2_g, *ln2_b, *w_gate, *w_up, *w_down;
  float* out;
  unsigned char* ws;
};

__device__ __forceinline__ u16 f2bf(float f) {
  uint32_t u = __float_as_uint(f);
  u += 0x7fffu + ((u >> 16) & 1u);
  return (u16)(u >> 16);
}
__device__ __forceinline__ uint32_t pack2(float a, float b) { return (uint32_t)f2bf(a) | ((uint32_t)f2bf(b) << 16); }
__device__ __forceinline__ float bf2f(u16 v) { return __uint_as_float(((uint32_t)v) << 16); }
__device__ __forceinline__ float wsum(float v) {
#pragma unroll
  for (int o = 32; o > 0; o >>= 1) v += __shfl_xor(v, o);
  return v;
}
__device__ __forceinline__ float fsigmoid(float v) { return 1.f / (1.f + __expf(-v)); }

__device__ __forceinline__ int ltid() {
  int t = threadIdx.x;
  asm volatile("" : "+v"(t));
  return t;
}

template <typename Tp>
__device__ __forceinline__ Tp* wsp(const Params& p, size_t off) { return (Tp*)(p.ws + off); }

__device__ __forceinline__ float* xrow(const Params& p, int row) {
  int b = row / KPB, kk = row - b * KPB;
  if (kk < CTXL) return wsp<float>(p, O_XCTX) + (size_t)(b * CTXL + kk) * D;
  return p.out + (size_t)(b * SEQ + kk - CTXL) * D;
}

constexpr int LSTR = 72;
constexpr int SM_A = 128 * LSTR;

__device__ __forceinline__ void gemm_core(f32x16 (&acc)[2][2], const u16* __restrict__ A, size_t lda,
                                          const u16* __restrict__ B, size_t ldb, int K, u16* smem) {
  const int tid = ltid(), lane = tid & 63, wave = tid >> 6;
  const int wm = wave >> 1, wn = wave & 1, r = lane & 31, hh = lane >> 5;
  u16* sA = smem;
  u16* sB = smem + 2 * SM_A;
  const int lrow = tid >> 3, lkc = (tid & 7) * 8;
  const u16* ga = A + (size_t)lrow * lda + lkc;
  const u16* gb = B + (size_t)lrow * ldb + lkc;
  uint4 ra[4], rb[4];
#pragma unroll
  for (int i = 0; i < 4; i++) {
    ra[i] = *(const uint4*)(ga + (size_t)(32 * i) * lda);
    rb[i] = *(const uint4*)(gb + (size_t)(32 * i) * ldb);
  }
#pragma unroll
  for (int i = 0; i < 4; i++) {
    *(uint4*)(sA + (lrow + 32 * i) * LSTR + lkc) = ra[i];
    *(uint4*)(sB + (lrow + 32 * i) * LSTR + lkc) = rb[i];
  }
  __syncthreads();
  const int nk = K >> 6;
  for (int kt = 0; kt < nk; kt++) {
    const int cur = kt & 1;
    const bool more = (kt + 1 < nk);
    if (more) {
      const int ko = (kt + 1) * 64;
#pragma unroll
      for (int i = 0; i < 4; i++) {
        ra[i] = *(const uint4*)(ga + (size_t)(32 * i) * lda + ko);
        rb[i] = *(const uint4*)(gb + (size_t)(32 * i) * ldb + ko);
      }
    }
    const u16* pa = sA + cur * SM_A + (wm * 64 + r) * LSTR + hh * 8;
    const u16* pb = sB + cur * SM_A + (wn * 64 + r) * LSTR + hh * 8;
#pragma unroll
    for (int ks = 0; ks < 4; ks++) {
      bf16x8 a0 = *(const bf16x8*)(pa + ks * 16);
      bf16x8 a1 = *(const bf16x8*)(pa + 32 * LSTR + ks * 16);
      bf16x8 b0 = *(const bf16x8*)(pb + ks * 16);
      bf16x8 b1 = *(const bf16x8*)(pb + 32 * LSTR + ks * 16);
      acc[0][0] = __builtin_amdgcn_mfma_f32_32x32x16_bf16(a0, b0, acc[0][0], 0, 0, 0);
      acc[0][1] = __builtin_amdgcn_mfma_f32_32x32x16_bf16(a0, b1, acc[0][1], 0, 0, 0);
      acc[1][0] = __builtin_amdgcn_mfma_f32_32x32x16_bf16(a1, b0, acc[1][0], 0, 0, 0);
      acc[1][1] = __builtin_amdgcn_mfma_f32_32x32x16_bf16(a1, b1, acc[1][1], 0, 0, 0);
    }
    if (more) {
      u16* wa = sA + (cur ^ 1) * SM_A;
      u16* wb = sB + (cur ^ 1) * SM_A;
#pragma unroll
      for (int i = 0; i < 4; i++) {
        *(uint4*)(wa + (lrow + 32 * i) * LSTR + lkc) = ra[i];
        *(uint4*)(wb + (lrow + 32 * i) * LSTR + lkc) = rb[i];
      }
    }
    __syncthreads();
  }
}

__device__ __forceinline__ void zero_acc(f32x16 (&acc)[2][2]) {
#pragma unroll
  for (int i = 0; i < 2; i++)
#pragma unroll
    for (int j = 0; j < 2; j++)
#pragma unroll
      for (int e = 0; e < 16; e++) acc[i][j][e] = 0.f;
}

#define EPI_DECL                                                     \
  const int lane_ = ltid() & 63, wave_ = ltid() >> 6;      \
  const int wm_ = wave_ >> 1, wn_ = wave_ & 1, r_ = lane_ & 31, hh_ = lane_ >> 5; \
  (void)wm_; (void)wn_; (void)r_; (void)hh_;

__device__ __forceinline__ const float* src_col(const Params& p, int l, int kind, int n, int& ld) {
  switch (kind) {
    case 0:
      ld = IN_DIM;
      return n < 1952 ? p.w_in + (size_t)l * D * IN_DIM + 512 + n : nullptr;
    case 1:
      ld = IN_DIM;
      return p.w_in + (size_t)l * D * IN_DIM + 2464 + n;
    case 2:
      if (n < 512) {
        ld = 512;
        return p.w_uq + (size_t)l * 256 * 512 + n;
      } else {
        int m = n - 512, wt = m >> 6, jb = (m >> 5) & 1, idx = wt * 32 + (m & 31);
        int h = idx >> 4, e = idx & 15;
        ld = 256;
        return p.w_qr + (size_t)l * 256 * 256 + h * 32 + jb * 16 + e;
      }
    case 3:
      ld = 512;
      return n < 512 ? p.w_uk + (size_t)l * 128 * 512 + n : p.w_uv + (size_t)l * 128 * 512 + (n - 512);
    case 4: {
      int g = n >> 10, nn = n & 1023;
      ld = 1024;
      return p.w_branch + ((size_t)(l * 3 + g) * 512) * 1024 + nn;
    }
    case 5:
      ld = 1024;
      return p.w_out + (size_t)l * D * D + n;
    case 6: {
      int jb = (n >> 5) & 1, q = (n >> 6) * 32 + (n & 31);
      ld = FH;
      return (jb ? p.w_up : p.w_gate) + (size_t)l * D * FH + q;
    }
    default:
      ld = 1024;
      return p.w_down + (size_t)l * FH * D + n;
  }
}

__device__ __forceinline__ int job_nd(int k) {
  switch (k) { case 0: return 2048; case 1: return 3072; case 2: return 768; case 3: return 1024; case 4: return 3072;
    case 5: return 1024; case 6: return 5632; default: return 1024; }
}
__device__ __forceinline__ int job_kd(int k) {
  switch (k) { case 0: return 1024; case 1: return 1024; case 2: return 256; case 3: return 128; case 4: return 512;
    case 5: return 1024; case 6: return 1024; default: return 2816; }
}
__device__ __forceinline__ size_t job_od(int k) {
  switch (k) { case 0: return O_WP; case 1: return O_WG; case 2: return O_WUQ; case 3: return O_WUKV; case 4: return O_WB;
    case 5: return O_WO; case 6: return O_WGU; default: return O_WD; }
}
__device__ void prep_weights(const Params& p, int l, int bid, int nb, u16* smem) {
  float* tile = (float*)smem;
  const int tid = ltid();
  int start = 0;
#pragma unroll 1
  for (int kind = 0; kind < 8; kind++) {
    const int Kk = job_kd(kind);
    const int nkt = Kk >> 6, ntile = (job_nd(kind) >> 6) * nkt;
    u16* dst = wsp<u16>(p, job_od(kind));
    const float* ksc = kind == 2 ? p.gq + l * 256 : (kind == 3 ? p.gkv + l * 128 : nullptr);
    for (int t = (bid + nb - (start % nb)) % nb; t < ntile; t += nb) {
      const int nt = t / nkt, kt = t - nt * nkt;
      const int n0 = nt * 64, k0 = kt * 64;
      {
        const int nn = tid & 63;
        int ld;
        const float* sp = src_col(p, l, kind, n0 + nn, ld);
#pragma unroll 4
        for (int i = 0; i < 16; i++) {
          const int kk = i * 4 + (tid >> 6);
          float v = sp ? sp[(size_t)(k0 + kk) * ld] : 0.f;
          if (ksc) v *= ksc[k0 + kk];
          tile[kk * 65 + nn] = v;
        }
      }
      __syncthreads();
      {
        const int kk = tid & 63;
#pragma unroll 4
        for (int i = 0; i < 16; i++) {
          const int nn = i * 4 + (tid >> 6);
          dst[(size_t)(n0 + nn) * Kk + k0 + kk] = f2bf(tile[kk * 65 + nn]);
        }
      }
      __syncthreads();
    }
    start += ntile;
  }
  {
    float* ctab = (float*)smem;
    __syncthreads();
    if (tid < 128) ctab[tid] = cospif((float)tid * (1.f / 64.f));
    __syncthreads();
    u16* dst = wsp<u16>(p, O_WF);
    for (int it = bid; it < 4096; it += nb) {
      const int o = it * 256 + tid;
      const int np = o & 1023, k = o >> 10;
      const int reim = np >> 9, g = (np >> 7) & 3, m = np & 127;
      const float* w = p.w_in + (size_t)l * D * IN_DIM + (size_t)k * IN_DIM + g * 128;
      const int sh = reim ? 96 : 0;
      float acc = 0.f;
#pragma unroll 8
      for (int c = 0; c < 128; c++) acc += w[c] * ctab[(m * c + sh) & 127];
      dst[(size_t)np * 1024 + k] = f2bf(acc * RS128);
    }
    __syncthreads();
  }
}

__device__ void prep_tables(const Params& p, int bid, int nb) {
  u16* MA = wsp<u16>(p, O_MA);
  u16* MB = wsp<u16>(p, O_MB);
  u16* MC = wsp<u16>(p, O_MC);
  float* TW = wsp<float>(p, O_TW);
  const int total = 65536 + 32768 + 131072 + 16384;
  for (int idx = bid * 256 + ltid(); idx < total; idx += nb * 256) {
    if (idx < 65536) {
      const int n = idx >> 8, k = idx & 255;
      const int nt = n >> 7, wn = (n >> 6) & 1, jb = (n >> 5) & 1, klo = nt * 64 + wn * 32 + (n & 31);
      const int ri = k >> 7, nhi = k & 127;
      const int xx = (klo * nhi) & 127;
      const float c = cospif((float)xx * (1.f / 64.f)), s = sinpif((float)xx * (1.f / 64.f));
      float v = jb == 0 ? (ri == 0 ? c : -s) : (ri == 0 ? -s : -c);
      MA[idx] = f2bf(v * RS128);
    } else if (idx < 65536 + 32768) {
      const int i2 = idx - 65536;
      const int khi = i2 >> 8, k = i2 & 255;
      const int ri = k >> 7, nlo = k & 127;
      const int xx = (khi * nlo) & 127;
      const float c = cospif((float)xx * (1.f / 64.f)), s = sinpif((float)xx * (1.f / 64.f));
      MB[i2] = f2bf((ri == 0 ? c : s) * RS128);
    } else if (idx < 65536 + 32768 + 131072) {
      const int i2 = idx - 65536 - 32768;
      const int kk = i2 >> 9, k = i2 & 511;
      const int ri = k >> 8, nn = k & 255;
      const int xx = (kk * nn) & 255;
      const float c = cospif((float)xx * (1.f / 128.f)), s = sinpif((float)xx * (1.f / 128.f));
      MC[i2] = f2bf((ri == 0 ? c : -s) * 0.0625f);
    } else {
      const int i2 = idx - 65536 - 32768 - 131072;
      const int klo = i2 >> 7, nlo = i2 & 127;
      const int xx = klo * nlo;
      TW[i2 * 2] = cospif((float)xx * (1.f / 8192.f));
      TW[i2 * 2 + 1] = sinpif((float)xx * (1.f / 8192.f));
    }
  }
}

__device__ void prep_modp(const Params& p, int bid, int nb) {
  float* modp = wsp<float>(p, O_MODP);
  for (int it = bid; it < 2 * 16 * 24; it += nb) {
    const int l = it / (16 * 24), rem = it - l * 16 * 24, kc = rem / 24, nblk = rem - kc * 24;
    const int n = nblk * 256 + ltid();
    const float* w = p.w_mod + (size_t)l * D * 6144 + n;
    float a0 = 0.f, a1 = 0.f, a2 = 0.f;
#pragma unroll 8
    for (int kk = 0; kk < 64; kk++) {
      const int k = kc * 64 + kk;
      const float wv = w[(size_t)k * 6144];
      float c0 = p.c[k], c1 = p.c[1024 + k], c2 = p.c_ctx[k];
      c0 = c0 / (1.f + __expf(-c0));
      c1 = c1 / (1.f + __expf(-c1));
      c2 = c2 / (1.f + __expf(-c2));
      a0 += c0 * wv;
      a1 += c1 * wv;
      a2 += c2 * wv;
    }
    float* o = modp + ((size_t)(kc * 2 + l) * 3) * 6144 + n;
    o[0] = a0;
    o[6144] = a1;
    o[2 * 6144] = a2;
  }
}
__device__ void prep_modr(const Params& p, int bid, int nb) {
  const float* modp = wsp<float>(p, O_MODP);
  float* mod = wsp<float>(p, O_MOD);
  for (int idx = bid * 256 + ltid(); idx < 2 * 3 * 6144; idx += nb * 256) {
    const int l = idx / (3 * 6144), n = idx % 6144;
    float v = p.b_mod[l * 6144 + n];
    for (int kc = 0; kc < 16; kc++) v += modp[(size_t)kc * 2 * 3 * 6144 + idx];
    mod[idx] = v;
  }
}

__device__ void ln_phase(const Params& p, int mode, const float* g, const float* bta, int lmod, int shoff, int scoff,
                         bool skip_ctx, int bid, int nb) {
  const int lane = ltid() & 63, wave = ltid() >> 6;
  u16* A = wsp<u16>(p, O_A);
  const float* mod = wsp<float>(p, O_MOD);
  for (int row = bid * 4 + wave; row < T; row += nb * 4) {
    const int b = row / KPB, kk = row - b * KPB;
    if (skip_ctx && kk < CTXL) continue;
    float* xr = xrow(p, row);
    const float* src;
    if (mode == 0)
      src = kk < CTXL ? p.ctx + (size_t)(b * CTXL + kk) * D : p.x + (size_t)(b * SEQ + kk - CTXL) * D;
    else
      src = xr;
    float4 v[4];
    float s = 0.f;
#pragma unroll
    for (int i = 0; i < 4; i++) {
      v[i] = *(const float4*)(src + i * 256 + lane * 4);
      s += v[i].x + v[i].y + v[i].z + v[i].w;
    }
    const float mu = wsum(s) * (1.f / 1024.f);
    float q = 0.f;
#pragma unroll
    for (int i = 0; i < 4; i++) {
      v[i].x -= mu; v[i].y -= mu; v[i].z -= mu; v[i].w -= mu;
      q += v[i].x * v[i].x + v[i].y * v[i].y + v[i].z * v[i].z + v[i].w * v[i].w;
    }
    const float rstd = rsqrtf(wsum(q) * (1.f / 1024.f) + EPS);
    const int m = kk < CTXL ? 2 : b;
    const float* md = mod + ((size_t)(lmod < 0 ? 0 : lmod) * 3 + m) * 6144;
#pragma unroll
    for (int i = 0; i < 4; i++) {
      const int c0 = i * 256 + lane * 4;
      const float4 gg = *(const float4*)(g + c0), bb = *(const float4*)(bta + c0);
      float4 y;
      y.x = v[i].x * rstd * gg.x + bb.x;
      y.y = v[i].y * rstd * gg.y + bb.y;
      y.z = v[i].z * rstd * gg.z + bb.z;
      y.w = v[i].w * rstd * gg.w + bb.w;
      *(float4*)(xr + c0) = y;
      if (lmod >= 0) {
        const float4 sh = *(const float4*)(md + shoff + c0), sc = *(const float4*)(md + scoff + c0);
        uint2 o;
        o.x = pack2(y.x * (1.f + sc.x) + sh.x, y.y * (1.f + sc.y) + sh.y);
        o.y = pack2(y.z * (1.f + sc.z) + sh.z, y.w * (1.f + sc.w) + sh.w);
        *(uint2*)(A + (size_t)row * D + c0) = o;
      }
    }
  }
}

__device__ void phase_p1(const Params& p, int l, bool last, int bid, int nb, u16* smem) {
  EPI_DECL
  const u16* A = wsp<u16>(p, O_A);
  const int nP = NRT * 16;
  const int nFl = 256 * 8, nFc = last ? 0 : 4 * 8;
  const int total = nP + nFl + nFc;
  for (int t = bid; t < total; t += nb) {
    f32x16 acc[2][2];
    zero_acc(acc);
    if (t < nP) {
      const int rt = t >> 4, ct = t & 15;
      gemm_core(acc, A + (size_t)rt * 128 * D, D, wsp<u16>(p, O_WP) + (size_t)ct * 128 * D, D, D, smem);
      const int row0 = rt * 128, b = row0 / KPB, kk0 = row0 - b * KPB;
      if (ct < 8 || ct >= 12) {
        u16* dst;
        float sc = 1.f;
        int cb;
        if (ct < 4) { dst = wsp<u16>(p, O_QNA); sc = NA_SCALE_L2; cb = ct * 128; }
        else if (ct < 8) { dst = wsp<u16>(p, O_KNA); cb = (ct - 4) * 128; }
        else { dst = wsp<u16>(p, O_LAT); cb = (ct - 12) * 128; }
#pragma unroll
        for (int i = 0; i < 2; i++)
#pragma unroll
          for (int j = 0; j < 2; j++)
#pragma unroll
            for (int e = 0; e < 16; e++) {
              const int row = row0 + wm_ * 64 + i * 32 + 8 * (e >> 2) + 4 * hh_ + (e & 3);
              const int col = cb + wn_ * 64 + j * 32 + r_;
              dst[(size_t)row * 512 + col] = f2bf(acc[i][j][e] * sc);
            }
      } else {
        u16* dst = wsp<u16>(p, O_VNAT);
        const int cb = (ct - 8) * 128;
#pragma unroll
        for (int i = 0; i < 2; i++)
#pragma unroll
          for (int j = 0; j < 2; j++)
#pragma unroll
            for (int g = 0; g < 4; g++) {
              const int kk = kk0 + wm_ * 64 + i * 32 + 8 * g + 4 * hh_;
              const int col = cb + wn_ * 64 + j * 32 + r_;
              uint2 o;
              o.x = pack2(acc[i][j][4 * g], acc[i][j][4 * g + 1]);
              o.y = pack2(acc[i][j][4 * g + 2], acc[i][j][4 * g + 3]);
              *(uint2*)(dst + ((size_t)(b * 512 + col)) * KPB + kk) = o;
            }
      }
    } else if (t < nP + nFl) {
      const int t2 = t - nP;
      const int rt = t2 >> 3, ct = t2 & 7;
      const int b = rt >> 7, nlo = rt & 127;
      gemm_core(acc, A + (size_t)(b * KPB + CTXL + nlo) * D, (size_t)128 * D,
                wsp<u16>(p, O_WF) + (size_t)ct * 128 * D, D, D, smem);
      u16* dst = wsp<u16>(p, O_D1);
#pragma unroll
      for (int i = 0; i < 2; i++)
#pragma unroll
        for (int j = 0; j < 2; j++)
#pragma unroll
          for (int g = 0; g < 4; g++) {
            const int nhi = wm_ * 64 + i * 32 + 8 * g + 4 * hh_;
            const int n = ct * 128 + wn_ * 64 + j * 32 + r_;
            const int reim = n >> 9, jj = n & 511;
            uint2 o;
            o.x = pack2(acc[i][j][4 * g], acc[i][j][4 * g + 1]);
            o.y = pack2(acc[i][j][4 * g + 2], acc[i][j][4 * g + 3]);
            *(uint2*)(dst + ((((size_t)(b * 512 + jj)) * 128 + nlo) * 2 + reim) * 128 + nhi) = o;
          }
    } else {
      const int t2 = t - nP - nFl;
      const int rt = t2 >> 3, ct = t2 & 7;
      const int b = rt >> 1, rb = rt & 1;
      gemm_core(acc, A + (size_t)(b * KPB + rb * 128) * D, D, wsp<u16>(p, O_WF) + (size_t)ct * 128 * D, D, D, smem);
      u16* dst = wsp<u16>(p, O_D1C);
#pragma unroll
      for (int i = 0; i < 2; i++)
#pragma unroll
        for (int j = 0; j < 2; j++)
#pragma unroll
          for (int g = 0; g < 4; g++) {
            const int nc = rb * 128 + wm_ * 64 + i * 32 + 8 * g + 4 * hh_;
            const int n = ct * 128 + wn_ * 64 + j * 32 + r_;
            const int reim = n >> 9, jj = n & 511;
            uint2 o;
            o.x = pack2(acc[i][j][4 * g], acc[i][j][4 * g + 1]);
            o.y = pack2(acc[i][j][4 * g + 2], acc[i][j][4 * g + 3]);
            *(uint2*)(dst + (((size_t)(b * 512 + jj)) * 2 + reim) * 256 + nc) = o;
          }
    }
  }
}

__device__ __forceinline__ float inv_freq(int i) {
  switch (i) {
    case 0: return 1.0f;
    case 1: return 0.31622776601683794f;
    case 2: return 0.1f;
    case 3: return 0.03162277660168379f;
    case 4: return 0.01f;
    case 5: return 0.0031622776601683794f;
    case 6: return 0.001f;
    default: return 0.00031622776601683794f;
  }
}
__device__ __forceinline__ void rope_cs(int kk, int e, float& cs, float& sn) {
  if (kk < CTXL) { cs = 1.f; sn = 0.f; return; }
  const int tkn = kk - CTXL;
  const float pos = (e < 8) ? (float)(tkn >> 6) : (float)(tkn & 63);
  const float ang = pos * inv_freq(e & 7);
  double xr = (double)ang * 0.31830988618379067;
  xr -= 2.0 * floor(xr * 0.5);
  const float yr = (float)xr;
  cs = cospif(yr);
  sn = sinpif(yr);
}

__device__ __forceinline__ void row_rms(const u16* A, size_t lda, int K, float* rs) {
  const int tid = ltid();
  const int row = tid >> 1, half = tid & 1;
  const u16* pr = A + (size_t)row * lda + half * (K >> 1);
  float s = 0.f;
  for (int c = 0; c < (K >> 1); c += 8) {
    uint4 v = *(const uint4*)(pr + c);
    const uint32_t w[4] = {v.x, v.y, v.z, v.w};
#pragma unroll
    for (int q = 0; q < 4; q++) {
      const float a = __uint_as_float(w[q] << 16), bq = __uint_as_float(w[q] & 0xffff0000u);
      s += a * a + bq * bq;
    }
  }
  s += __shfl_xor(s, 1);
  if (half == 0) rs[row] = rsqrtf(s / (float)K + EPS);
  __syncthreads();
}

__device__ void phase_p2(const Params& p, int l, int bid, int nb, u16* smem) {
  EPI_DECL
  const u16* LAT = wsp<u16>(p, O_LAT);
  float* rs = (float*)(smem + 4 * SM_A);
  const int nQ = NRT * 6, nKV = NRT * 8, nFA = 1024 * 2, nKR = NRT;
  const int total = nQ + nKV + nFA + nKR;
  for (int t = bid; t < total; t += nb) {
    if (t < nQ) {
      const int rt = t / 6, ct = t - rt * 6;
      const int row0 = rt * 128, b = row0 / KPB, kk0 = row0 - b * KPB;
      row_rms(LAT + (size_t)row0 * 512, 512, 256, rs);
      f32x16 acc[2][2];
      zero_acc(acc);
      gemm_core(acc, LAT + (size_t)row0 * 512, 512, wsp<u16>(p, O_WUQ) + (size_t)ct * 128 * 256, 256, 256, smem);
      u16* QM = wsp<u16>(p, O_QM);
      if (ct < 4) {
#pragma unroll
        for (int i = 0; i < 2; i++)
#pragma unroll
          for (int j = 0; j < 2; j++)
#pragma unroll
            for (int e = 0; e < 16; e++) {
              const int rl = wm_ * 64 + i * 32 + 8 * (e >> 2) + 4 * hh_ + (e & 3);
              const int col = ct * 128 + wn_ * 64 + j * 32 + r_;
              const int h = col >> 6, d = col & 63;
              QM[(size_t)(row0 + rl) * 768 + h * 96 + d] = f2bf(acc[i][j][e] * rs[rl] * MLA_SCALE_L2);
            }
      } else {
        const int idx = ((ct - 4) * 2 + wn_) * 32 + r_;
        const int h = idx >> 4, e16 = idx & 15;
#pragma unroll
        for (int i = 0; i < 2; i++)
#pragma unroll
          for (int e = 0; e < 16; e++) {
            const int rl = wm_ * 64 + i * 32 + 8 * (e >> 2) + 4 * hh_ + (e & 3);
            float cs, sn;
            rope_cs(kk0 + rl, e16, cs, sn);
            const float sc = rs[rl] * MLA_SCALE_L2;
            const float x1 = acc[i][0][e] * sc, x2 = acc[i][1][e] * sc;
            u16* q = QM + (size_t)(row0 + rl) * 768 + h * 96 + 64 + e16;
            q[0] = f2bf(x1 * cs - x2 * sn);
            q[16] = f2bf(x2 * cs + x1 * sn);
          }
      }
      __syncthreads();
    } else if (t < nQ + nKV) {
      const int t2 = t - nQ;
      const int rt = t2 >> 3, ct = t2 & 7;
      const int row0 = rt * 128, b = row0 / KPB, kk0 = row0 - b * KPB;
      row_rms(LAT + (size_t)row0 * 512 + 256, 512, 128, rs);
      f32x16 acc[2][2];
      zero_acc(acc);
      gemm_core(acc, LAT + (size_t)row0 * 512 + 256, 512, wsp<u16>(p, O_WUKV) + (size_t)ct * 128 * 128, 128, 128,
                smem);
      if (ct < 4) {
        u16* KN = wsp<u16>(p, O_KN);
#pragma unroll
        for (int i = 0; i < 2; i++)
#pragma unroll
          for (int j = 0; j < 2; j++)
#pragma unroll
            for (int e = 0; e < 16; e++) {
              const int rl = wm_ * 64 + i * 32 + 8 * (e >> 2) + 4 * hh_ + (e & 3);
              const int col = ct * 128 + wn_ * 64 + j * 32 + r_;
              KN[(size_t)(row0 + rl) * 512 + col] = f2bf(acc[i][j][e] * rs[rl]);
            }
      } else {
        u16* VMT = wsp<u16>(p, O_VMT);
#pragma unroll
        for (int i = 0; i < 2; i++)
#pragma unroll
          for (int j = 0; j < 2; j++)
#pragma unroll
            for (int g = 0; g < 4; g++) {
              const int rl = wm_ * 64 + i * 32 + 8 * g + 4 * hh_;
              const int col = (ct - 4) * 128 + wn_ * 64 + j * 32 + r_;
              uint2 o;
              o.x = pack2(acc[i][j][4 * g] * rs[rl], acc[i][j][4 * g + 1] * rs[rl + 1]);
              o.y = pack2(acc[i][j][4 * g + 2] * rs[rl + 2], acc[i][j][4 * g + 3] * rs[rl + 3]);
              *(uint2*)(VMT + ((size_t)(b * 512 + col)) * KPB + kk0 + rl) = o;
            }
      }
      __syncthreads();
    } else if (t < nQ + nKV + nFA) {
      const int t2 = t - nQ - nKV;
      const int rt = t2 >> 1, ct = t2 & 1;
      const int b = rt >> 9, jj = rt & 511;
      f32x16 acc[2][2];
      zero_acc(acc);
      gemm_core(acc, wsp<u16>(p, O_D1) + (size_t)rt * 128 * 256, 256, wsp<u16>(p, O_MA) + (size_t)ct * 128 * 256, 256,
                256, smem);
      const float* TW = wsp<float>(p, O_TW);
      u16* D2 = wsp<u16>(p, O_D2);
      const int klo = ct * 64 + wn_ * 32 + r_;
#pragma unroll
      for (int i = 0; i < 2; i++)
#pragma unroll
        for (int g = 0; g < 4; g++) {
          const int nlo = wm_ * 64 + i * 32 + 8 * g + 4 * hh_;
          float re[4], im[4];
#pragma unroll
          for (int q = 0; q < 4; q++) {
            const float2 tw = *(const float2*)(TW + ((size_t)klo * 128 + nlo + q) * 2);
            const float ar = acc[i][0][4 * g + q], ai = acc[i][1][4 * g + q];
            re[q] = ar * tw.x + ai * tw.y;
            im[q] = ai * tw.x - ar * tw.y;
          }
          u16* d = D2 + ((((size_t)(b * 128 + klo)) * 512 + jj) * 2) * 128 + nlo;
          uint2 o;
          o.x = pack2(re[0], re[1]);
          o.y = pack2(re[2], re[3]);
          *(uint2*)d = o;
          o.x = pack2(im[0], im[1]);
          o.y = pack2(im[2], im[3]);
          *(uint2*)(d + 128) = o;
        }
    } else {
      const int rt = t - nQ - nKV - nFA;
      u16* KRR = wsp<u16>(p, O_KRR);
      for (int idx = ltid(); idx < 128 * 16; idx += 256) {
        const int rl = idx >> 4, e16 = idx & 15;
        const int row = rt * 128 + rl, b = row / KPB, kk = row - b * KPB;
        const float x1 = bf2f(LAT[(size_t)row * 512 + 384 + e16]), x2 = bf2f(LAT[(size_t)row * 512 + 400 + e16]);
        float cs, sn;
        rope_cs(kk, e16, cs, sn);
        KRR[(size_t)row * 32 + e16] = f2bf(x1 * cs - x2 * sn);
        KRR[(size_t)row * 32 + 16 + e16] = f2bf(x2 * cs + x1 * sn);
      }
    }
  }
}

template <int MODE>
__device__ void attn_item(const Params& p, int l, int b, int h, int q0  ,
                          int ntiles, int rs0, int ycol, u16* smem) {
  constexpr int DQK = MODE == 0 ? 96 : 64;
  constexpr int KSTR = DQK + 8;
  constexpr int NKS = DQK / 16;
  constexpr int CPR = DQK / 8;
  constexpr int NKC = 64 * CPR / 256;
  const int tid = ltid(), lane = tid & 63, wave = tid >> 6, r = lane & 31, hh = lane >> 5;
  u16* Ks = smem;
  u16* Vs = smem + 2 * 64 * KSTR;
  const u16* Kg = MODE == 0 ? wsp<u16>(p, O_KN) : wsp<u16>(p, O_KNA);
  const u16* Kr = wsp<u16>(p, O_KRR);
  const u16* Vg = (MODE == 0 ? wsp<u16>(p, O_VMT) : wsp<u16>(p, O_VNAT)) + (size_t)(b * 512 + h * 64) * KPB;
  const int qk = q0 + wave * 32 + r;
  const size_t qrow = (size_t)b * KPB + qk;
  bf16x8 qf[NKS];
  {
    const u16* qp = MODE == 0 ? wsp<u16>(p, O_QM) + qrow * 768 + h * 96 : wsp<u16>(p, O_QNA) + qrow * 512 + h * 64;
#pragma unroll
    for (int ks = 0; ks < NKS; ks++) qf[ks] = *(const bf16x8*)(qp + ks * 16 + hh * 8);
  }
  int qr = 0, qc = 0, rsq = 0, cs = 0;
  const float* rpb = nullptr;
  if (MODE == 1 && rs0 >= 0) {
    const int tkn = qk - CTXL;
    qr = tkn >> 6;
    qc = tkn & 63;
    rsq = min(max(qr - 4, 0), 248);
    cs = min(max(qc - 8, 0), 48);
    rpb = p.rpb + ((size_t)(l * 8 + h)) * 15 * 31;
  }
  f32x16 o[2];
#pragma unroll
  for (int e = 0; e < 16; e++) { o[0][e] = 0.f; o[1][e] = 0.f; }
  float m = -1e30f, lsum = 0.f;

  u32x4 kr0, kr1, kr2, vr0, vr1;
  kr2 = kr1 = kr0 = vr0 = vr1 = (u32x4){0u, 0u, 0u, 0u};
#define TILE_KK0(t) ((MODE == 1 && (t) >= 4) ? (CTXL + 64 * (rs0 + (t)-4)) : 64 * (t))
#define LOAD_K1(i, dstv)                                                             \
  {                                                                                  \
    const int c = tid + 256 * (i);                                                   \
    const int row = c / CPR, cc = c - row * CPR;                                     \
    const size_t grow = (size_t)b * KPB + kk0_ + row;                                \
    const u16* src_ = (MODE == 0 && cc >= 8) ? (Kr + grow * 32 + (cc - 8) * 8) : (Kg + grow * 512 + h * 64 + cc * 8); \
    dstv = *(const u32x4*)src_;                                                      \
  }
#define LOAD_V1(i, dstv)                                                             \
  {                                                                                  \
    const int c = tid + 256 * (i);                                                   \
    const int d = c >> 3, cc = c & 7;                                                \
    dstv = *(const u32x4*)(Vg + (size_t)d * KPB + kk0_ + cc * 8);                    \
  }
#define LOAD_TILE(t)                                                                 \
  {                                                                                  \
    const int kk0_ = TILE_KK0(t);                                                    \
    LOAD_K1(0, kr0) LOAD_K1(1, kr1) if (NKC == 3) LOAD_K1(2, kr2)                     \
    LOAD_V1(0, vr0) LOAD_V1(1, vr1)                                                  \
  }
#define STORE_K1(buf, i, srcv)                                                       \
  {                                                                                  \
    const int c = tid + 256 * (i);                                                   \
    const int row = c / CPR, cc = c - row * CPR;                                     \
    *(u32x4*)(Ks + (buf)*64 * KSTR + row * KSTR + cc * 8) = srcv;                    \
  }
#define STORE_V1(buf, i, srcv)                                                       \
  {                                                                                  \
    const int c = tid + 256 * (i);                                                   \
    const int d = c >> 3, cc = c & 7;                                                \
    *(u32x4*)(Vs + (buf)*64 * 72 + d * 72 + cc * 8) = srcv;                          \
  }
#define STORE_TILE(buf)                                                              \
  {                                                                                  \
    STORE_K1(buf, 0, kr0) STORE_K1(buf, 1, kr1) if (NKC == 3) STORE_K1(buf, 2, kr2)   \
    STORE_V1(buf, 0, vr0) STORE_V1(buf, 1, vr1)                                      \
  }
  LOAD_TILE(0);
  STORE_TILE(0);
  __syncthreads();
  for (int t = 0; t < ntiles; t++) {
    const int cur = t & 1;
    const bool more = t + 1 < ntiles;
    if (more) LOAD_TILE(t + 1);
    bool active = true;
    int kr = 0;
    if (MODE == 1 && t >= 4) {
      kr = rs0 + t - 4;
      active = (kr >= rsq) && (kr < rsq + 8);
    }
    if (active) {
      f32x16 s[2];
#pragma unroll
      for (int e = 0; e < 16; e++) { s[0][e] = 0.f; s[1][e] = 0.f; }
      const u16* kb_ = Ks + cur * 64 * KSTR + r * KSTR + hh * 8;
#pragma unroll
      for (int kb = 0; kb < 2; kb++)
#pragma unroll
        for (int ks = 0; ks < NKS; ks++) {
          bf16x8 kf = *(const bf16x8*)(kb_ + kb * 32 * KSTR + ks * 16);
          s[kb] = __builtin_amdgcn_mfma_f32_32x32x16_bf16(kf, qf[ks], s[kb], 0, 0, 0);
        }
      if (MODE == 1 && t >= 4) {
        const float* rp = rpb + (kr - qr + 7) * 31 + (15 - qc);
#pragma unroll
        for (int kb = 0; kb < 2; kb++)
#pragma unroll
          for (int e = 0; e < 16; e++) {
            const int kc = kb * 32 + (e & 3) + 8 * (e >> 2) + 4 * hh;
            const bool valid = (kc >= cs) && (kc < cs + 16);
            float bias = 0.f;
            if (valid) bias = rp[kc];
            s[kb][e] = valid ? s[kb][e] + bias * LOG2E : -1e30f;
          }
      }
      float mloc = s[0][0];
#pragma unroll
      for (int e = 1; e < 16; e++) mloc = fmaxf(mloc, s[0][e]);
#pragma unroll
      for (int e = 0; e < 16; e++) mloc = fmaxf(mloc, s[1][e]);
      mloc = fmaxf(mloc, __shfl_xor(mloc, 32));
      const float mnew = fmaxf(m, mloc);
      const float alpha = __builtin_amdgcn_exp2f(m - mnew);
      m = mnew;
      float rsum = 0.f;
#pragma unroll
      for (int kb = 0; kb < 2; kb++)
#pragma unroll
        for (int e = 0; e < 16; e++) {
          const float pv = __builtin_amdgcn_exp2f(s[kb][e] - mnew);
          s[kb][e] = pv;
          rsum += pv;
        }
      lsum = lsum * alpha + rsum;
#pragma unroll
      for (int e = 0; e < 16; e++) { o[0][e] *= alpha; o[1][e] *= alpha; }
      const u16* vb_ = Vs + cur * 64 * 72 + r * 72 + 4 * hh;
#pragma unroll
      for (int kb = 0; kb < 2; kb++)
#pragma unroll
        for (int st = 0; st < 2; st++) {
          u32x4 pu;
          pu[0] = pack2(s[kb][8 * st + 0], s[kb][8 * st + 1]);
          pu[1] = pack2(s[kb][8 * st + 2], s[kb][8 * st + 3]);
          pu[2] = pack2(s[kb][8 * st + 4], s[kb][8 * st + 5]);
          pu[3] = pack2(s[kb][8 * st + 6], s[kb][8 * st + 7]);
          const bf16x8 pbv = __builtin_bit_cast(bf16x8, pu);
#pragma unroll
          for (int db = 0; db < 2; db++) {
            const u16* vp = vb_ + db * 32 * 72 + kb * 32 + 16 * st;
            const bf16x4 vlo = *(const bf16x4*)(vp);
            const bf16x4 vhi = *(const bf16x4*)(vp + 8);
            const bf16x8 vfv = __builtin_shufflevector(vlo, vhi, 0, 1, 2, 3, 4, 5, 6, 7);
            o[db] = __builtin_amdgcn_mfma_f32_32x32x16_bf16(vfv, pbv, o[db], 0, 0, 0);
          }
        }
    }
    if (more) STORE_TILE(cur ^ 1);
    __syncthreads();
  }
  const float ltot = lsum + __shfl_xor(lsum, 32);
  const float inv = 1.f / ltot;
  u16* yp = wsp<u16>(p, O_Y) + qrow * 1536 + ycol + h * 64;
#pragma unroll
  for (int db = 0; db < 2; db++)
#pragma unroll
    for (int g = 0; g < 4; g++) {
      uint2 ov;
      ov.x = pack2(o[db][4 * g] * inv, o[db][4 * g + 1] * inv);
      ov.y = pack2(o[db][4 * g + 2] * inv, o[db][4 * g + 3] * inv);
      *(uint2*)(yp + db * 32 + 8 * g + 4 * hh) = ov;
    }
}

__device__ void phase_p3(const Params& p, int l, bool last, int bid, int nb, u16* smem) {
  EPI_DECL
  const int nMLA = 2048, nNA = 2048, nFB = 1024;
  const int nC = last ? 0 : (32 + 32 + 16);
  const int total = nMLA + nNA + nFB + nC;
  for (int t = bid; t < total; t += nb) {
    int kind, b = 0, h = 0, q0 = 0, ntl = 0, rs0 = -1;
    size_t aoff = 0, boff = 0;
    int Kf = 256, j0 = 0, tok0 = 0, tokmul = 1, colbase = 0;
    if (t < nMLA) {
      kind = 0;
      h = t & 7;
      const int rest = t >> 3;
      b = rest >> 7;
      q0 = CTXL + (rest & 127) * 128;
      ntl = 260;
    } else if (t < nMLA + nNA) {
      kind = 1;
      const int t2 = t - nMLA;
      h = t2 & 7;
      const int rest = t2 >> 3, rp = rest & 127;
      b = rest >> 7;
      rs0 = min(max(2 * rp - 4, 0), 248);
      const int rs1 = min(max(2 * rp + 1 - 4, 0), 248);
      q0 = CTXL + rp * 128;
      ntl = 4 + (rs1 + 8 - rs0);
    } else if (t < nMLA + nNA + nFB) {
      kind = 2;
      const int rt = t - nMLA - nNA;
      const int bk = rt >> 2;
      j0 = (rt & 3) * 128;
      b = bk >> 7;
      tok0 = CTXL + (bk & 127);
      tokmul = 128;
      aoff = O_D2 + (size_t)rt * 128 * 256 * 2;
      boff = O_MB;
      Kf = 256;
    } else {
      const int t2 = t - nMLA - nNA - nFB;
      if (t2 < 64) {
        kind = t2 >> 5;
        const int t3 = t2 & 31;
        h = t3 & 7;
        b = (t3 >> 3) & 1;
        q0 = (t3 >> 4) * 128;
        ntl = 4;
      } else {
        kind = 2;
        const int t3 = t2 - 64;
        const int rt = t3 >> 1, ct = t3 & 1;
        b = rt >> 2;
        j0 = (rt & 3) * 128;
        colbase = ct * 128;
        aoff = O_D1C + (size_t)rt * 128 * 512 * 2;
        boff = O_MC + (size_t)ct * 128 * 512 * 2;
        Kf = 512;
      }
    }
    if (kind == 0) {
      attn_item<0>(p, l, b, h, q0, ntl, -1, 1024, smem);
    } else if (kind == 1) {
      attn_item<1>(p, l, b, h, q0, ntl, rs0, 512, smem);
    } else {
      f32x16 acc[2][2];
      zero_acc(acc);
      gemm_core(acc, wsp<u16>(p, aoff), Kf, wsp<u16>(p, boff), Kf, Kf, smem);
      u16* Y = wsp<u16>(p, O_Y);
#pragma unroll
      for (int i = 0; i < 2; i++)
#pragma unroll
        for (int j = 0; j < 2; j++)
#pragma unroll
          for (int g = 0; g < 4; g++) {
            const int jj = j0 + wm_ * 64 + i * 32 + 8 * g + 4 * hh_;
            const int tok = tok0 + (colbase + wn_ * 64 + j * 32 + r_) * tokmul;
            uint2 ov;
            ov.x = pack2(acc[i][j][4 * g], acc[i][j][4 * g + 1]);
            ov.y = pack2(acc[i][j][4 * g + 2], acc[i][j][4 * g + 3]);
            *(uint2*)(Y + ((size_t)b * KPB + tok) * 1536 + jj) = ov;
          }
    }
  }
}

__device__ __forceinline__ int n_row_tiles(bool last) { return last ? NRT - 4 : NRT; }
__device__ __forceinline__ int row_tile(bool last, int i) {
  if (!last) return i;
  return i < 128 ? i + 2 : i + 4;
}

__device__ void phase_p4(const Params& p, int l, bool last, int bid, int nb, u16* smem) {
  EPI_DECL
  const u16* A = wsp<u16>(p, O_A);
  const u16* Y = wsp<u16>(p, O_Y);
  u16* M = wsp<u16>(p, O_M);
  uint4* stash = wsp<uint4>(p, O_QM) + (size_t)bid * 8 * 256 + ltid();
  const int total = n_row_tiles(last) * 8;
  for (int t = bid; t < total; t += nb) {
    const int rt = row_tile(last, t >> 3), ct = t & 7;
    f32x16 mg[2][2];
    zero_acc(mg);
#pragma unroll 1
    for (int g = 0; g < 3; g++) {
      {
        f32x16 acc[2][2];
        zero_acc(acc);
        gemm_core(acc, A + (size_t)rt * 128 * D, D, wsp<u16>(p, O_WG) + (size_t)(g * 1024 + ct * 128) * D, D, D, smem);
#pragma unroll
        for (int i = 0; i < 2; i++)
#pragma unroll
          for (int j = 0; j < 2; j++)
#pragma unroll
            for (int e = 0; e < 2; e++) {
              uint4 gq4;
              gq4.x = pack2(fsigmoid(acc[i][j][8 * e]), fsigmoid(acc[i][j][8 * e + 1]));
              gq4.y = pack2(fsigmoid(acc[i][j][8 * e + 2]), fsigmoid(acc[i][j][8 * e + 3]));
              gq4.z = pack2(fsigmoid(acc[i][j][8 * e + 4]), fsigmoid(acc[i][j][8 * e + 5]));
              gq4.w = pack2(fsigmoid(acc[i][j][8 * e + 6]), fsigmoid(acc[i][j][8 * e + 7]));
              stash[((i * 2 + j) * 2 + e) * 256] = gq4;
            }
      }
      {
        f32x16 acc[2][2];
        zero_acc(acc);
        gemm_core(acc, Y + (size_t)rt * 128 * 1536 + g * 512, 1536,
                  wsp<u16>(p, O_WB) + (size_t)(g * 1024 + ct * 128) * 512, 512, 512, smem);
#pragma unroll
        for (int i = 0; i < 2; i++)
#pragma unroll
          for (int j = 0; j < 2; j++)
#pragma unroll
            for (int e = 0; e < 2; e++) {
              const uint4 gq4 = stash[((i * 2 + j) * 2 + e) * 256];
              const uint32_t gw[4] = {gq4.x, gq4.y, gq4.z, gq4.w};
#pragma unroll
              for (int q = 0; q < 4; q++) {
                mg[i][j][8 * e + 2 * q] += __uint_as_float(gw[q] << 16) * acc[i][j][8 * e + 2 * q];
                mg[i][j][8 * e + 2 * q + 1] += __uint_as_float(gw[q] & 0xffff0000u) * acc[i][j][8 * e + 2 * q + 1];
              }
            }
      }
    }
#pragma unroll
    for (int i = 0; i < 2; i++)
#pragma unroll
      for (int j = 0; j < 2; j++)
#pragma unroll
        for (int e = 0; e < 16; e++) {
          const int row = rt * 128 + wm_ * 64 + i * 32 + 8 * (e >> 2) + 4 * hh_ + (e & 3);
          const int col = ct * 128 + wn_ * 64 + j * 32 + r_;
          M[(size_t)row * D + col] = f2bf(mg[i][j][e]);
        }
  }
}

__device__ void phase_resid(const Params& p, int l, bool last, const u16* Ain, size_t lda, const u16* W, int K, int goff,
                            int bid, int nb, u16* smem) {
  EPI_DECL
  const float* mod = wsp<float>(p, O_MOD);
  const int total = n_row_tiles(last) * 8;
  for (int t = bid; t < total; t += nb) {
    const int rt = row_tile(last, t >> 3), ct = t & 7;
    f32x16 acc[2][2];
    zero_acc(acc);
    gemm_core(acc, Ain + (size_t)rt * 128 * lda, lda, W + (size_t)ct * 128 * K, K, K, smem);
    const int row0 = rt * 128, b = row0 / KPB, kk0 = row0 - b * KPB;
    const int m = kk0 < CTXL ? 2 : b;
    float* xb = xrow(p, row0);
    const float* gv = mod + ((size_t)l * 3 + m) * 6144 + goff;
#pragma unroll
    for (int j = 0; j < 2; j++) {
      const int col = ct * 128 + wn_ * 64 + j * 32 + r_;
      const float g1 = 1.f + gv[col];
#pragma unroll
      for (int i = 0; i < 2; i++)
#pragma unroll
        for (int e = 0; e < 16; e++) {
          const int rl = wm_ * 64 + i * 32 + 8 * (e >> 2) + 4 * hh_ + (e & 3);
          float* xp = xb + (size_t)rl * D + col;
          *xp = ALPHA * (*xp) + g1 * acc[i][j][e];
        }
    }
  }
}

__device__ void phase_p7(const Params& p, int l, bool last, int bid, int nb, u16* smem) {
  EPI_DECL
  const u16* A = wsp<u16>(p, O_A);
  u16* HH = wsp<u16>(p, O_HH);
  const int nrt = n_row_tiles(last);
  const int total = nrt * 44;
  for (int t = bid; t < total; t += nb) {
    const int rt = row_tile(last, t / 44), ct = t % 44;
    f32x16 acc[2][2];
    zero_acc(acc);
    gemm_core(acc, A + (size_t)rt * 128 * D, D, wsp<u16>(p, O_WGU) + (size_t)ct * 128 * D, D, D, smem);
    const int q = (ct * 2 + wn_) * 32 + r_;
#pragma unroll
    for (int i = 0; i < 2; i++)
#pragma unroll
      for (int e = 0; e < 16; e++) {
        const int row = rt * 128 + wm_ * 64 + i * 32 + 8 * (e >> 2) + 4 * hh_ + (e & 3);
        const float gt = acc[i][0][e], up = acc[i][1][e];
        HH[(size_t)row * FH + q] = f2bf(gt * fsigmoid(gt) * up);
      }
  }
}

constexpr int NPHASE = 3 + 9 * 2;

__device__ void run_phase(const Params& p, int ph, int bid, int nb, u16* smem) {
  if (ph == 0) {
    prep_tables(p, bid, nb);
    prep_modp(p, bid, nb);
    prep_weights(p, 0, bid, nb, smem);
    return;
  }
  if (ph == 1) { prep_modr(p, bid, nb); return; }
  if (ph == 2) { ln_phase(p, 0, p.ln_in_g, p.ln_in_b, 0, 0, 1024, false, bid, nb); return; }
  const int l = (ph - 3) / 9, s = (ph - 3) % 9;
  const bool last = (l == 1);
  switch (s) {
    case 0: phase_p1(p, l, last, bid, nb, smem); break;
    case 1: phase_p2(p, l, bid, nb, smem); break;
    case 2: phase_p3(p, l, last, bid, nb, smem); break;
    case 3: phase_p4(p, l, last, bid, nb, smem); break;
    case 4: phase_resid(p, l, last, wsp<u16>(p, O_M), D, wsp<u16>(p, O_WO), D, 2048, bid, nb, smem); break;
    case 5: ln_phase(p, 1, p.ln1_g + l * D, p.ln1_b + l * D, l, 3072, 4096, last, bid, nb); break;
    case 6: phase_p7(p, l, last, bid, nb, smem); break;
    case 7: phase_resid(p, l, last, wsp<u16>(p, O_HH), FH, wsp<u16>(p, O_WD), FH, 5120, bid, nb, smem); break;
    default:
      ln_phase(p, 1, p.ln2_g + l * D, p.ln2_b + l * D, last ? -1 : l + 1, 0, 1024, last, bid, nb);
      if (!last) prep_weights(p, l + 1, bid, nb, smem);
      break;
  }
}

constexpr int SMEM_ELEMS = 4 * SM_A + 256;

#if COOP
__global__ void __launch_bounds__(256, 2) mega_kernel(Params p) {
  __shared__ __attribute__((aligned(16))) u16 smem[SMEM_ELEMS];
  cg::grid_group grid = cg::this_grid();
  for (int ph = 0; ph < NPHASE; ph++) {
    run_phase(p, ph, blockIdx.x, gridDim.x, smem);
    if (ph + 1 < NPHASE) grid.sync();
  }
}
#else
__global__ void __launch_bounds__(256, 2) phase_kernel(Params p, int ph) {
  __shared__ __attribute__((aligned(16))) u16 smem[SMEM_ELEMS];
  run_phase(p, ph, blockIdx.x, gridDim.x, smem);
}
#endif

extern "C" void kernel_launch(void* const* d_in, const int* in_sizes, int n_in, void* d_out, int out_size, void* d_ws,
                              size_t ws_size, hipStream_t stream) {
  Params p{};
  const float** f = (const float**)&p;
  for (int i = 0; i < 25; i++) f[i] = (const float*)d_in[i];
  p.out = (float*)d_out;
  p.ws = (unsigned char*)d_ws;
  if (ws_size < O_END) fprintf(stderr, "workspace too small: %zu < %zu\n", ws_size, (size_t)O_END);
#if COOP
  static int grid_blocks = 0;
  if (!grid_blocks) {
    int dev = 0, cus = 0, per_cu = 0;
    hipGetDevice(&dev);
    hipDeviceGetAttribute(&cus, hipDeviceAttributeMultiprocessorCount, dev);
    hipOccupancyMaxActiveBlocksPerMultiprocessor(&per_cu, mega_kernel, 256, 0);
    if (per_cu > 2) per_cu = 2;
    grid_blocks = cus * per_cu;
  }
  void* args[] = {&p};
  hipError_t e = hipLaunchCooperativeKernel((void*)mega_kernel, dim3(grid_blocks), dim3(256), args, 0, stream);
  if (e != hipSuccess) fprintf(stderr, "cooperative launch failed: %s (grid %d)\n", hipGetErrorString(e), grid_blocks);
#else
  for (int ph = 0; ph < NPHASE; ph++) phase_kernel<<<512, 256, 0, stream>>>(p, ph);
#endif
}
```

```cpp
#include <hip/hip_runtime.h>
#include <hip/hip_cooperative_groups.h>
#include <stdint.h>
#include <cstdio>
namespace cg = cooperative_groups;

#ifndef COOP
#define COOP 1
#endif

typedef __attribute__((ext_vector_type(8))) short bf16x8;
typedef __attribute__((ext_vector_type(4))) short bf16x4;
typedef __attribute__((ext_vector_type(16))) float f32x16;
typedef unsigned short u16;
typedef __attribute__((ext_vector_type(4))) unsigned int u32x4;

constexpr int D = 1024;
constexpr int NBATCH = 2;
constexpr int SEQ = 16384;
constexpr int CTXL = 256;
constexpr int KPB = SEQ + CTXL;
constexpr int T = NBATCH * KPB;
constexpr int NRT = T / 128;
constexpr int FH = 2816;
constexpr int IN_DIM = 5536;
constexpr float LOG2E = 1.4426950408889634f;
constexpr float NA_SCALE_L2 = 0.125f * LOG2E;
constexpr float MLA_SCALE_L2 = 0.10206207261596575f * LOG2E;
constexpr float ALPHA = 1.4142135623730951f;
constexpr float EPS = 1e-5f;
constexpr float RS128 = 0.08838834764831845f;

constexpr size_t al256(size_t x) { return (x + 255) & ~(size_t)255; }
constexpr size_t O_WF = 0;
constexpr size_t O_WP = O_WF + (size_t)1024 * 1024 * 2;
constexpr size_t O_WG = O_WP + (size_t)2048 * 1024 * 2;
constexpr size_t O_WUQ = O_WG + (size_t)3072 * 1024 * 2;
constexpr size_t O_WUKV = O_WUQ + (size_t)768 * 256 * 2;
constexpr size_t O_WB = O_WUKV + (size_t)1024 * 128 * 2;
constexpr size_t O_WO = O_WB + (size_t)3 * 1024 * 512 * 2;
constexpr size_t O_WGU = O_WO + (size_t)1024 * 1024 * 2;
constexpr size_t O_WD = O_WGU + (size_t)5632 * 1024 * 2;
constexpr size_t O_MA = O_WD + (size_t)1024 * 2816 * 2;
constexpr size_t O_MB = O_MA + (size_t)256 * 256 * 2;
constexpr size_t O_MC = O_MB + (size_t)128 * 256 * 2;
constexpr size_t O_TW = O_MC + (size_t)256 * 512 * 2;
constexpr size_t O_MODP = O_TW + (size_t)128 * 128 * 2 * 4;
constexpr size_t O_MOD = O_MODP + (size_t)16 * 2 * 3 * 6144 * 4;
constexpr size_t O_XCTX = O_MOD + (size_t)2 * 3 * 6144 * 4;
constexpr size_t O_D1C = O_XCTX + (size_t)512 * 1024 * 4;
constexpr size_t O_A = O_D1C + (size_t)2 * 512 * 2 * 256 * 2;
constexpr size_t O_RQ = O_A + (size_t)T * 1024 * 2;
constexpr size_t O_QNA = O_RQ;
constexpr size_t O_KNA = O_QNA + (size_t)T * 512 * 2;
constexpr size_t O_VNAT = O_KNA + (size_t)T * 512 * 2;
constexpr size_t O_RY = O_VNAT + (size_t)T * 512 * 2;
constexpr size_t O_Y = O_RY;
constexpr size_t O_D1 = O_RY;
constexpr size_t O_LAT = O_RY + (size_t)67108864;
constexpr size_t O_D2 = O_RY + (size_t)T * 1536 * 2;
constexpr size_t O_QM = O_D2 + (size_t)67108864;
constexpr size_t O_KN = O_QM + (size_t)T * 768 * 2;
constexpr size_t O_KRR = O_KN + (size_t)T * 512 * 2;
constexpr size_t O_VMT = O_KRR + (size_t)T * 32 * 2;
constexpr size_t O_END = O_VMT + (size_t)T * 512 * 2;
constexpr size_t O_M = O_RQ;
constexpr size_t O_HH = O_RQ;

struct Params {
  const float *x, *c, *ctx, *c_ctx, *ln_in_g, *ln_in_b, *w_mod, *b_mod, *w_in, *gq, *gkv, *w_uq, *w_qr, *w_uk,
      *w_uv, *rpb, *w_branch, *w_out, *ln1_g, *ln1_b, *ln2_g, *ln2_b, *w_gate, *w_up, *w_down;
  float* out;
  unsigned char* ws;
};

__device__ __forceinline__ u16 f2bf(float f) {
  uint32_t u = __float_as_uint(f);
  u += 0x7fffu + ((u >> 16) & 1u);
  return (u16)(u >> 16);
}
__device__ __forceinline__ uint32_t pack2(float a, float b) { return (uint32_t)f2bf(a) | ((uint32_t)f2bf(b) << 16); }
__device__ __forceinline__ float bf2f(u16 v) { return __uint_as_float(((uint32_t)v) << 16); }
__device__ __forceinline__ float wsum(float v) {
#pragma unroll
  for (int o = 32; o > 0; o >>= 1) v += __shfl_xor(v, o);
  return v;
}
__device__ __forceinline__ float fsigmoid(float v) { return 1.f / (1.f + __expf(-v)); }

__device__ __forceinline__ int ltid() {
  int t = threadIdx.x;
  asm volatile("" : "+v"(t));
  return t;
}

template <typename Tp>
__device__ __forceinline__ Tp* wsp(const Params& p, size_t off) { return (Tp*)(p.ws + off); }

__device__ __forceinline__ float* xrow(const Params& p, int row) {
  int b = row / KPB, kk = row - b * KPB;
  if (kk < CTXL) return wsp<float>(p, O_XCTX) + (size_t)(b * CTXL + kk) * D;
  return p.out + (size_t)(b * SEQ + kk - CTXL) * D;
}

constexpr int LSTR = 72;
constexpr int SM_A = 128 * LSTR;

template <bool DEEP = true>
__device__ __forceinline__ void gemm_core(f32x16 (&acc)[2][2], const u16* __restrict__ A, size_t lda,
                                          const u16* __restrict__ B, size_t ldb, int K, u16* smem) {
  const int tid = ltid(), lane = tid & 63, wave = tid >> 6;
  const int wm = wave >> 1, wn = wave & 1, r = lane & 31, hh = lane >> 5;
  u16* sA = smem;
  u16* sB = smem + 2 * SM_A;
  const int lrow = tid >> 3, lkc = (tid & 7) * 8;
  const u16* ga = A + (size_t)lrow * lda + lkc;
  const u16* gb = B + (size_t)lrow * ldb + lkc;
  u16* wa = sA + lrow * LSTR + lkc;
  u16* wb = sB + lrow * LSTR + lkc;
  const u16* pa = sA + (wm * 64 + r) * LSTR + hh * 8;
  const u16* pb = sB + (wn * 64 + r) * LSTR + hh * 8;
  u32x4 a0r[4], b0r[4], a1r[4], b1r[4];
#define G_LOAD(ar, br, ko)                                               \
  _Pragma("unroll") for (int i = 0; i < 4; i++) {                        \
    ar[i] = *(const u32x4*)(ga + (size_t)(32 * i) * lda + (ko));         \
    br[i] = *(const u32x4*)(gb + (size_t)(32 * i) * ldb + (ko));         \
  }
#define G_STORE(ar, br, buf)                                             \
  _Pragma("unroll") for (int i = 0; i < 4; i++) {                        \
    *(u32x4*)(wa + (buf)*SM_A + 32 * i * LSTR) = ar[i];                  \
    *(u32x4*)(wb + (buf)*SM_A + 32 * i * LSTR) = br[i];                  \
  }
#define G_COMPUTE(buf)                                                                   \
  _Pragma("unroll") for (int ks = 0; ks < 4; ks++) {                                     \
    const bf16x8 fa0 = *(const bf16x8*)(pa + (buf)*SM_A + ks * 16);                      \
    const bf16x8 fa1 = *(const bf16x8*)(pa + (buf)*SM_A + 32 * LSTR + ks * 16);          \
    const bf16x8 fb0 = *(const bf16x8*)(pb + (buf)*SM_A + ks * 16);                      \
    const bf16x8 fb1 = *(const bf16x8*)(pb + (buf)*SM_A + 32 * LSTR + ks * 16);          \
    acc[0][0] = __builtin_amdgcn_mfma_f32_32x32x16_bf16(fa0, fb0, acc[0][0], 0, 0, 0);   \
    acc[0][1] = __builtin_amdgcn_mfma_f32_32x32x16_bf16(fa0, fb1, acc[0][1], 0, 0, 0);   \
    acc[1][0] = __builtin_amdgcn_mfma_f32_32x32x16_bf16(fa1, fb0, acc[1][0], 0, 0, 0);   \
    acc[1][1] = __builtin_amdgcn_mfma_f32_32x32x16_bf16(fa1, fb1, acc[1][1], 0, 0, 0);   \
  }
  const int nk = K >> 6;
  if (DEEP) {
    G_LOAD(a0r, b0r, 0)
    G_LOAD(a1r, b1r, 64)
    G_STORE(a0r, b0r, 0)
    __syncthreads();
    if (nk > 2) G_LOAD(a0r, b0r, 128)
    for (int kt = 0; kt < nk; kt += 2) {
      G_COMPUTE(0)
      G_STORE(a1r, b1r, 1)
      __syncthreads();
      if (kt + 3 < nk) G_LOAD(a1r, b1r, (kt + 3) * 64)
      G_COMPUTE(1)
      if (kt + 2 < nk) G_STORE(a0r, b0r, 0)
      __syncthreads();
      if (kt + 4 < nk) G_LOAD(a0r, b0r, (kt + 4) * 64)
    }
  } else {
    G_LOAD(a0r, b0r, 0)
    G_STORE(a0r, b0r, 0)
    __syncthreads();
    for (int kt = 0; kt < nk; kt += 2) {
      G_LOAD(a0r, b0r, (kt + 1) * 64)
      G_COMPUTE(0)
      G_STORE(a0r, b0r, 1)
      __syncthreads();
      if (kt + 2 < nk) G_LOAD(a0r, b0r, (kt + 2) * 64)
      G_COMPUTE(1)
      if (kt + 2 < nk) G_STORE(a0r, b0r, 0)
      __syncthreads();
    }
  }
#undef G_LOAD
#undef G_STORE
#undef G_COMPUTE
}

__device__ __forceinline__ void zero_acc(f32x16 (&acc)[2][2]) {
#pragma unroll
  for (int i = 0; i < 2; i++)
#pragma unroll
    for (int j = 0; j < 2; j++)
#pragma unroll
      for (int e = 0; e < 16; e++) acc[i][j][e] = 0.f;
}

#define EPI_DECL                                                     \
  const int lane_ = ltid() & 63, wave_ = ltid() >> 6;      \
  const int wm_ = wave_ >> 1, wn_ = wave_ & 1, r_ = lane_ & 31, hh_ = lane_ >> 5; \
  (void)wm_; (void)wn_; (void)r_; (void)hh_;

__device__ __forceinline__ const float* src_col(const Params& p, int l, int kind, int n, int& ld) {
  switch (kind) {
    case 0:
      ld = IN_DIM;
      return n < 1952 ? p.w_in + (size_t)l * D * IN_DIM + 512 + n : nullptr;
    case 1:
      ld = IN_DIM;
      return p.w_in + (size_t)l * D * IN_DIM + 2464 + n;
    case 2:
      if (n < 512) {
        ld = 512;
        return p.w_uq + (size_t)l * 256 * 512 + n;
      } else {
        int m = n - 512, wt = m >> 6, jb = (m >> 5) & 1, idx = wt * 32 + (m & 31);
        int h = idx >> 4, e = idx & 15;
        ld = 256;
        return p.w_qr + (size_t)l * 256 * 256 + h * 32 + jb * 16 + e;
      }
    case 3:
      ld = 512;
      return n < 512 ? p.w_uk + (size_t)l * 128 * 512 + n : p.w_uv + (size_t)l * 128 * 512 + (n - 512);
    case 4: {
      int g = n >> 10, nn = n & 1023;
      ld = 1024;
      return p.w_branch + ((size_t)(l * 3 + g) * 512) * 1024 + nn;
    }
    case 5:
      ld = 1024;
      return p.w_out + (size_t)l * D * D + n;
    case 6: {
      int jb = (n >> 5) & 1, q = (n >> 6) * 32 + (n & 31);
      ld = FH;
      return (jb ? p.w_up : p.w_gate) + (size_t)l * D * FH + q;
    }
    default:
      ld = 1024;
      return p.w_down + (size_t)l * FH * D + n;
  }
}

__device__ __forceinline__ int job_nd(int k) {
  switch (k) { case 0: return 2048; case 1: return 3072; case 2: return 768; case 3: return 1024; case 4: return 3072;
    case 5: return 1024; case 6: return 5632; default: return 1024; }
}
__device__ __forceinline__ int job_kd(int k) {
  switch (k) { case 0: return 1024; case 1: return 1024; case 2: return 256; case 3: return 128; case 4: return 512;
    case 5: return 1024; case 6: return 1024; default: return 2816; }
}
__device__ __forceinline__ size_t job_od(int k) {
  switch (k) { case 0: return O_WP; case 1: return O_WG; case 2: return O_WUQ; case 3: return O_WUKV; case 4: return O_WB;
    case 5: return O_WO; case 6: return O_WGU; default: return O_WD; }
}
__device__ void prep_weights(const Params& p, int l, int bid, int nb, u16* smem) {
  float* tile = (float*)smem;
  const int tid = ltid();
  int start = 0;
#pragma unroll 1
  for (int kind = 0; kind < 8; kind++) {
    const int Kk = job_kd(kind);
    const int nkt = Kk >> 6, ntile = (job_nd(kind) >> 6) * nkt;
    u16* dst = wsp<u16>(p, job_od(kind));
    const float* ksc = kind == 2 ? p.gq + l * 256 : (kind == 3 ? p.gkv + l * 128 : nullptr);
    for (int t = (bid + nb - (start % nb)) % nb; t < ntile; t += nb) {
      const int nt = t / nkt, kt = t - nt * nkt;
      const int n0 = nt * 64, k0 = kt * 64;
      {
        const int nn = tid & 63;
        int ld;
        const float* sp = src_col(p, l, kind, n0 + nn, ld);
#pragma unroll 4
        for (int i = 0; i < 16; i++) {
          const int kk = i * 4 + (tid >> 6);
          float v = sp ? sp[(size_t)(k0 + kk) * ld] : 0.f;
          if (ksc) v *= ksc[k0 + kk];
          tile[kk * 65 + nn] = v;
        }
      }
      __syncthreads();
      {
        const int kk = tid & 63;
#pragma unroll 4
        for (int i = 0; i < 16; i++) {
          const int nn = i * 4 + (tid >> 6);
          dst[(size_t)(n0 + nn) * Kk + k0 + kk] = f2bf(tile[kk * 65 + nn]);
        }
      }
      __syncthreads();
    }
    start += ntile;
  }
  {
    float* ctab = (float*)smem;
    __syncthreads();
    if (tid < 128) ctab[tid] = cospif((float)tid * (1.f / 64.f));
    __syncthreads();
    u16* dst = wsp<u16>(p, O_WF);
    for (int it = bid; it < 4096; it += nb) {
      const int o = it * 256 + tid;
      const int np = o & 1023, k = o >> 10;
      const int reim = np >> 9, g = (np >> 7) & 3, m = np & 127;
      const float* w = p.w_in + (size_t)l * D * IN_DIM + (size_t)k * IN_DIM + g * 128;
      const int sh = reim ? 96 : 0;
      float acc = 0.f;
#pragma unroll 8
      for (int c = 0; c < 128; c++) acc += w[c] * ctab[(m * c + sh) & 127];
      dst[(size_t)np * 1024 + k] = f2bf(acc * RS128);
    }
    __syncthreads();
  }
}

__device__ void prep_tables(const Params& p, int bid, int nb) {
  u16* MA = wsp<u16>(p, O_MA);
  u16* MB = wsp<u16>(p, O_MB);
  u16* MC = wsp<u16>(p, O_MC);
  float* TW = wsp<float>(p, O_TW);
  const int total = 65536 + 32768 + 131072 + 16384;
  for (int idx = bid * 256 + ltid(); idx < total; idx += nb * 256) {
    if (idx < 65536) {
      const int n = idx >> 8, k = idx & 255;
      const int nt = n >> 7, wn = (n >> 6) & 1, jb = (n >> 5) & 1, klo = nt * 64 + wn * 32 + (n & 31);
      const int ri = k >> 7, nhi = k & 127;
      const int xx = (klo * nhi) & 127;
      const float c = cospif((float)xx * (1.f / 64.f)), s = sinpif((float)xx * (1.f / 64.f));
      float v = jb == 0 ? (ri == 0 ? c : -s) : (ri == 0 ? -s : -c);
      MA[idx] = f2bf(v * RS128);
    } else if (idx < 65536 + 32768) {
      const int i2 = idx - 65536;
      const int khi = i2 >> 8, k = i2 & 255;
      const int ri = k >> 7, nlo = k & 127;
      const int xx = (khi * nlo) & 127;
      const float c = cospif((float)xx * (1.f / 64.f)), s = sinpif((float)xx * (1.f / 64.f));
      MB[i2] = f2bf((ri == 0 ? c : s) * RS128);
    } else if (idx < 65536 + 32768 + 131072) {
      const int i2 = idx - 65536 - 32768;
      const int kk = i2 >> 9, k = i2 & 511;
      const int ri = k >> 8, nn = k & 255;
      const int xx = (kk * nn) & 255;
      const float c = cospif((float)xx * (1.f / 128.f)), s = sinpif((float)xx * (1.f / 128.f));
      MC[i2] = f2bf((ri == 0 ? c : -s) * 0.0625f);
    } else {
      const int i2 = idx - 65536 - 32768 - 131072;
      const int klo = i2 >> 7, nlo = i2 & 127;
      const int xx = klo * nlo;
      TW[i2 * 2] = cospif((float)xx * (1.f / 8192.f));
      TW[i2 * 2 + 1] = sinpif((float)xx * (1.f / 8192.f));
    }
  }
}

__device__ void prep_modp(const Params& p, int bid, int nb) {
  float* modp = wsp<float>(p, O_MODP);
  for (int it = bid; it < 2 * 16 * 24; it += nb) {
    const int l = it / (16 * 24), rem = it - l * 16 * 24, kc = rem / 24, nblk = rem - kc * 24;
    const int n = nblk * 256 + ltid();
    const float* w = p.w_mod + (size_t)l * D * 6144 + n;
    float a0 = 0.f, a1 = 0.f, a2 = 0.f;
#pragma unroll 8
    for (int kk = 0; kk < 64; kk++) {
      const int k = kc * 64 + kk;
      const float wv = w[(size_t)k * 6144];
      float c0 = p.c[k], c1 = p.c[1024 + k], c2 = p.c_ctx[k];
      c0 = c0 / (1.f + __expf(-c0));
      c1 = c1 / (1.f + __expf(-c1));
      c2 = c2 / (1.f + __expf(-c2));
      a0 += c0 * wv;
      a1 += c1 * wv;
      a2 += c2 * wv;
    }
    float* o = modp + ((size_t)(kc * 2 + l) * 3) * 6144 + n;
    o[0] = a0;
    o[6144] = a1;
    o[2 * 6144] = a2;
  }
}
__device__ void prep_modr(const Params& p, int bid, int nb) {
  const float* modp = wsp<float>(p, O_MODP);
  float* mod = wsp<float>(p, O_MOD);
  for (int idx = bid * 256 + ltid(); idx < 2 * 3 * 6144; idx += nb * 256) {
    const int l = idx / (3 * 6144), n = idx % 6144;
    float v = p.b_mod[l * 6144 + n];
    for (int kc = 0; kc < 16; kc++) v += modp[(size_t)kc * 2 * 3 * 6144 + idx];
    mod[idx] = v;
  }
}

__device__ void ln_phase(const Params& p, int mode, const float* g, const float* bta, int lmod, int shoff, int scoff,
                         bool skip_ctx, int bid, int nb) {
  const int lane = ltid() & 63, wave = ltid() >> 6;
  u16* A = wsp<u16>(p, O_A);
  const float* mod = wsp<float>(p, O_MOD);
  for (int row = bid * 4 + wave; row < T; row += nb * 4) {
    const int b = row / KPB, kk = row - b * KPB;
    if (skip_ctx && kk < CTXL) continue;
    float* xr = xrow(p, row);
    const float* src;
    if (mode == 0)
      src = kk < CTXL ? p.ctx + (size_t)(b * CTXL + kk) * D : p.x + (size_t)(b * SEQ + kk - CTXL) * D;
    else
      src = xr;
    float4 v[4];
    float s = 0.f;
#pragma unroll
    for (int i = 0; i < 4; i++) {
      v[i] = *(const float4*)(src + i * 256 + lane * 4);
      s += v[i].x + v[i].y + v[i].z + v[i].w;
    }
    const float mu = wsum(s) * (1.f / 1024.f);
    float q = 0.f;
#pragma unroll
    for (int i = 0; i < 4; i++) {
      v[i].x -= mu; v[i].y -= mu; v[i].z -= mu; v[i].w -= mu;
      q += v[i].x * v[i].x + v[i].y * v[i].y + v[i].z * v[i].z + v[i].w * v[i].w;
    }
    const float rstd = rsqrtf(wsum(q) * (1.f / 1024.f) + EPS);
    const int m = kk < CTXL ? 2 : b;
    const float* md = mod + ((size_t)(lmod < 0 ? 0 : lmod) * 3 + m) * 6144;
#pragma unroll
    for (int i = 0; i < 4; i++) {
      const int c0 = i * 256 + lane * 4;
      const float4 gg = *(const float4*)(g + c0), bb = *(const float4*)(bta + c0);
      float4 y;
      y.x = v[i].x * rstd * gg.x + bb.x;
      y.y = v[i].y * rstd * gg.y + bb.y;
      y.z = v[i].z * rstd * gg.z + bb.z;
      y.w = v[i].w * rstd * gg.w + bb.w;
      *(float4*)(xr + c0) = y;
      if (lmod >= 0) {
        const float4 sh = *(const float4*)(md + shoff + c0), sc = *(const float4*)(md + scoff + c0);
        uint2 o;
        o.x = pack2(y.x * (1.f + sc.x) + sh.x, y.y * (1.f + sc.y) + sh.y);
        o.y = pack2(y.z * (1.f + sc.z) + sh.z, y.w * (1.f + sc.w) + sh.w);
        *(uint2*)(A + (size_t)row * D + c0) = o;
      }
    }
  }
}

#define PATCH_LOOP_BEGIN(NR_, NC_, PR_, PC_)                                   \
  {                                                                            \
    const int x_ = bid & 7, w_ = bid >> 3, nbx_ = nb >> 3;                     \
    const int CG_ = ((NC_) + (PC_)-1) / (PC_);                                 \
    const int npatch_ = (((NR_) + (PR_)-1) / (PR_)) * CG_;                     \
    for (int u_ = w_;; u_ += nbx_) {                                           \
      const int g_ = (u_ >> 6) * 8 + x_;                                       \
      if (g_ >= npatch_) break;                                                \
      const int s_ = u_ & 63;                                                  \
      const int rg_ = g_ / CG_;                                                \
      const int prt = rg_ * (PR_) + s_ / (PC_);                                \
      const int pct = (g_ - rg_ * CG_) * (PC_) + s_ % (PC_);                   \
      if (prt >= (NR_) || pct >= (NC_)) continue;
#define PATCH_LOOP_END \
    }                  \
  }

__device__ void phase_p1(const Params& p, int l, bool last, int bid, int nb, u16* smem) {
  EPI_DECL
  const u16* A = wsp<u16>(p, O_A);
  PATCH_LOOP_BEGIN(NRT, 16, 8, 8)
    f32x16 acc[2][2];
    zero_acc(acc);
    {
      const int rt = prt, ct = pct;
      const int row0 = rt * 128, b = row0 / KPB, kk0 = row0 - b * KPB;
      if (ct < 8 || ct >= 12) {
        gemm_core(acc, wsp<u16>(p, O_WP) + (size_t)ct * 128 * D, D, A + (size_t)rt * 128 * D, D, D, smem);
        u16* dst;
        float sc = 1.f;
        int cb;
        if (ct < 4) { dst = wsp<u16>(p, O_QNA); sc = NA_SCALE_L2; cb = ct * 128; }
        else if (ct < 8) { dst = wsp<u16>(p, O_KNA); cb = (ct - 4) * 128; }
        else { dst = wsp<u16>(p, O_LAT); cb = (ct - 12) * 128; }
#pragma unroll
        for (int i = 0; i < 2; i++)
#pragma unroll
          for (int j = 0; j < 2; j++)
#pragma unroll
            for (int g = 0; g < 4; g++) {
              const int row = row0 + wn_ * 64 + j * 32 + r_;
              const int col = cb + wm_ * 64 + i * 32 + 8 * g + 4 * hh_;
              uint2 o;
              o.x = pack2(acc[i][j][4 * g] * sc, acc[i][j][4 * g + 1] * sc);
              o.y = pack2(acc[i][j][4 * g + 2] * sc, acc[i][j][4 * g + 3] * sc);
              *(uint2*)(dst + (size_t)row * 512 + col) = o;
            }
      } else {
        gemm_core(acc, A + (size_t)rt * 128 * D, D, wsp<u16>(p, O_WP) + (size_t)ct * 128 * D, D, D, smem);
        u16* dst = wsp<u16>(p, O_VNAT);
        const int cb = (ct - 8) * 128;
#pragma unroll
        for (int i = 0; i < 2; i++)
#pragma unroll
          for (int j = 0; j < 2; j++)
#pragma unroll
            for (int g = 0; g < 4; g++) {
              const int kk = kk0 + wm_ * 64 + i * 32 + 8 * g + 4 * hh_;
              const int col = cb + wn_ * 64 + j * 32 + r_;
              uint2 o;
              o.x = pack2(acc[i][j][4 * g], acc[i][j][4 * g + 1]);
              o.y = pack2(acc[i][j][4 * g + 2], acc[i][j][4 * g + 3]);
              *(uint2*)(dst + ((size_t)(b * 512 + col)) * KPB + kk) = o;
            }
      }
    }
  PATCH_LOOP_END
  PATCH_LOOP_BEGIN(256, 8, 8, 8)
    f32x16 acc[2][2];
    zero_acc(acc);
    {
      const int rt = prt, ct = pct;
      const int b = rt >> 7, nlo = rt & 127;
      gemm_core(acc, A + (size_t)(b * KPB + CTXL + nlo) * D, (size_t)128 * D,
                wsp<u16>(p, O_WF) + (size_t)ct * 128 * D, D, D, smem);
      u16* dst = wsp<u16>(p, O_D1);
#pragma unroll
      for (int i = 0; i < 2; i++)
#pragma unroll
        for (int j = 0; j < 2; j++)
#pragma unroll
          for (int g = 0; g < 4; g++) {
            const int nhi = wm_ * 64 + i * 32 + 8 * g + 4 * hh_;
            const int n = ct * 128 + wn_ * 64 + j * 32 + r_;
            const int reim = n >> 9, jj = n & 511;
            uint2 o;
            o.x = pack2(acc[i][j][4 * g], acc[i][j][4 * g + 1]);
            o.y = pack2(acc[i][j][4 * g + 2], acc[i][j][4 * g + 3]);
            *(uint2*)(dst + ((((size_t)(b * 512 + jj)) * 128 + nlo) * 2 + reim) * 128 + nhi) = o;
          }
    }
  PATCH_LOOP_END
  if (!last) {
    for (int t2 = bid; t2 < 32; t2 += nb) {
      f32x16 acc[2][2];
      zero_acc(acc);
      const int rt = t2 >> 3, ct = t2 & 7;
      const int b = rt >> 1, rb = rt & 1;
      gemm_core(acc, A + (size_t)(b * KPB + rb * 128) * D, D, wsp<u16>(p, O_WF) + (size_t)ct * 128 * D, D, D, smem);
      u16* dst = wsp<u16>(p, O_D1C);
#pragma unroll
      for (int i = 0; i < 2; i++)
#pragma unroll
        for (int j = 0; j < 2; j++)
#pragma unroll
          for (int g = 0; g < 4; g++) {
            const int nc = rb * 128 + wm_ * 64 + i * 32 + 8 * g + 4 * hh_;
            const int n = ct * 128 + wn_ * 64 + j * 32 + r_;
            const int reim = n >> 9, jj = n & 511;
            uint2 o;
            o.x = pack2(acc[i][j][4 * g], acc[i][j][4 * g + 1]);
            o.y = pack2(acc[i][j][4 * g + 2], acc[i][j][4 * g + 3]);
            *(uint2*)(dst + (((size_t)(b * 512 + jj)) * 2 + reim) * 256 + nc) = o;
          }
    }
  }
}

__device__ __forceinline__ float inv_freq(int i) {
  switch (i) {
    case 0: return 1.0f;
    case 1: return 0.31622776601683794f;
    case 2: return 0.1f;
    case 3: return 0.03162277660168379f;
    case 4: return 0.01f;
    case 5: return 0.0031622776601683794f;
    case 6: return 0.001f;
    default: return 0.00031622776601683794f;
  }
}
__device__ __forceinline__ void rope_cs(int kk, int e, float& cs, float& sn) {
  if (kk < CTXL) { cs = 1.f; sn = 0.f; return; }
  const int tkn = kk - CTXL;
  const float pos = (e < 8) ? (float)(tkn >> 6) : (float)(tkn & 63);
  const float ang = pos * inv_freq(e & 7);
  double xr = (double)ang * 0.31830988618379067;
  xr -= 2.0 * floor(xr * 0.5);
  const float yr = (float)xr;
  cs = cospif(yr);
  sn = sinpif(yr);
}

__device__ __forceinline__ void row_rms(const u16* A, size_t lda, int K, float* rs) {
  const int tid = ltid();
  const int row = tid >> 1, half = tid & 1;
  const u16* pr = A + (size_t)row * lda + half * (K >> 1);
  float s = 0.f;
  for (int c = 0; c < (K >> 1); c += 8) {
    uint4 v = *(const uint4*)(pr + c);
    const uint32_t w[4] = {v.x, v.y, v.z, v.w};
#pragma unroll
    for (int q = 0; q < 4; q++) {
      const float a = __uint_as_float(w[q] << 16), bq = __uint_as_float(w[q] & 0xffff0000u);
      s += a * a + bq * bq;
    }
  }
  s += __shfl_xor(s, 1);
  if (half == 0) rs[row] = rsqrtf(s / (float)K + EPS);
  __syncthreads();
}

__device__ void phase_p2(const Params& p, int l, int bid, int nb, u16* smem) {
  EPI_DECL
  const u16* LAT = wsp<u16>(p, O_LAT);
  float* rs = (float*)(smem + 4 * SM_A);
  const int nQ = NRT * 6, nKV = NRT * 8, nFA = 1024 * 2, nKR = NRT;
  const int total = nQ + nKV + nFA + nKR;
  for (int t = bid; t < total; t += nb) {
    if (t < nQ) {
      const int rt = t / 6, ct = t - rt * 6;
      const int row0 = rt * 128, b = row0 / KPB, kk0 = row0 - b * KPB;
      row_rms(LAT + (size_t)row0 * 512, 512, 256, rs);
      f32x16 acc[2][2];
      zero_acc(acc);
      gemm_core(acc, wsp<u16>(p, O_WUQ) + (size_t)ct * 128 * 256, 256, LAT + (size_t)row0 * 512, 512, 256, smem);
      u16* QM = wsp<u16>(p, O_QM);
      if (ct < 4) {
#pragma unroll
        for (int i = 0; i < 2; i++)
#pragma unroll
          for (int j = 0; j < 2; j++)
#pragma unroll
            for (int g = 0; g < 4; g++) {
              const int rl = wn_ * 64 + j * 32 + r_;
              const int col = ct * 128 + wm_ * 64 + i * 32 + 8 * g + 4 * hh_;
              const int h = col >> 6, d = col & 63;
              const float sc = rs[rl] * MLA_SCALE_L2;
              uint2 o;
              o.x = pack2(acc[i][j][4 * g] * sc, acc[i][j][4 * g + 1] * sc);
              o.y = pack2(acc[i][j][4 * g + 2] * sc, acc[i][j][4 * g + 3] * sc);
              *(uint2*)(QM + (size_t)(row0 + rl) * 768 + h * 96 + d) = o;
            }
      } else {
        const int wt = (ct - 4) * 2 + wm_;
#pragma unroll
        for (int j = 0; j < 2; j++) {
          const int rl = wn_ * 64 + j * 32 + r_;
          const float sc = rs[rl] * MLA_SCALE_L2;
#pragma unroll
          for (int g = 0; g < 4; g++) {
            const int idx = wt * 32 + 8 * g + 4 * hh_;
            const int h = idx >> 4, e16 = idx & 15;
            float o1[4], o2[4];
#pragma unroll
            for (int q = 0; q < 4; q++) {
              float cs, sn;
              rope_cs(kk0 + rl, e16 + q, cs, sn);
              const float x1 = acc[0][j][4 * g + q] * sc, x2 = acc[1][j][4 * g + q] * sc;
              o1[q] = x1 * cs - x2 * sn;
              o2[q] = x2 * cs + x1 * sn;
            }
            u16* qd = QM + (size_t)(row0 + rl) * 768 + h * 96 + 64 + e16;
            uint2 o;
            o.x = pack2(o1[0], o1[1]);
            o.y = pack2(o1[2], o1[3]);
            *(uint2*)qd = o;
            o.x = pack2(o2[0], o2[1]);
            o.y = pack2(o2[2], o2[3]);
            *(uint2*)(qd + 16) = o;
          }
        }
      }
      __syncthreads();
    } else if (t < nQ + nKV) {
      const int t2 = t - nQ;
      const int rt = t2 >> 3, ct = t2 & 7;
      const int row0 = rt * 128, b = row0 / KPB, kk0 = row0 - b * KPB;
      row_rms(LAT + (size_t)row0 * 512 + 256, 512, 128, rs);
      f32x16 acc[2][2];
      zero_acc(acc);
      if (ct < 4) {
        gemm_core(acc, wsp<u16>(p, O_WUKV) + (size_t)ct * 128 * 128, 128, LAT + (size_t)row0 * 512 + 256, 512, 128,
                  smem);
        u16* KN = wsp<u16>(p, O_KN);
#pragma unroll
        for (int i = 0; i < 2; i++)
#pragma unroll
          for (int j = 0; j < 2; j++)
#pragma unroll
            for (int g = 0; g < 4; g++) {
              const int rl = wn_ * 64 + j * 32 + r_;
              const int col = ct * 128 + wm_ * 64 + i * 32 + 8 * g + 4 * hh_;
              const float sc = rs[rl];
              uint2 o;
              o.x = pack2(acc[i][j][4 * g] * sc, acc[i][j][4 * g + 1] * sc);
              o.y = pack2(acc[i][j][4 * g + 2] * sc, acc[i][j][4 * g + 3] * sc);
              *(uint2*)(KN + (size_t)(row0 + rl) * 512 + col) = o;
            }
      } else {
        gemm_core(acc, LAT + (size_t)row0 * 512 + 256, 512, wsp<u16>(p, O_WUKV) + (size_t)ct * 128 * 128, 128, 128,
                  smem);
        u16* VMT = wsp<u16>(p, O_VMT);
#pragma unroll
        for (int i = 0; i < 2; i++)
#pragma unroll
          for (int j = 0; j < 2; j++)
#pragma unroll
            for (int g = 0; g < 4; g++) {
              const int rl = wm_ * 64 + i * 32 + 8 * g + 4 * hh_;
              const int col = (ct - 4) * 128 + wn_ * 64 + j * 32 + r_;
              uint2 o;
              o.x = pack2(acc[i][j][4 * g] * rs[rl], acc[i][j][4 * g + 1] * rs[rl + 1]);
              o.y = pack2(acc[i][j][4 * g + 2] * rs[rl + 2], acc[i][j][4 * g + 3] * rs[rl + 3]);
              *(uint2*)(VMT + ((size_t)(b * 512 + col)) * KPB + kk0 + rl) = o;
            }
      }
      __syncthreads();
    } else if (t < nQ + nKV + nFA) {
      const int t2 = t - nQ - nKV;
      const int rt = t2 >> 1, ct = t2 & 1;
      const int b = rt >> 9, jj = rt & 511;
      f32x16 acc[2][2];
      zero_acc(acc);
      gemm_core(acc, wsp<u16>(p, O_D1) + (size_t)rt * 128 * 256, 256, wsp<u16>(p, O_MA) + (size_t)ct * 128 * 256, 256,
                256, smem);
      const float* TW = wsp<float>(p, O_TW);
      u16* D2 = wsp<u16>(p, O_D2);
      const int klo = ct * 64 + wn_ * 32 + r_;
#pragma unroll
      for (int i = 0; i < 2; i++)
#pragma unroll
        for (int g = 0; g < 4; g++) {
          const int nlo = wm_ * 64 + i * 32 + 8 * g + 4 * hh_;
          float re[4], im[4];
#pragma unroll
          for (int q = 0; q < 4; q++) {
            const float2 tw = *(const float2*)(TW + ((size_t)klo * 128 + nlo + q) * 2);
            const float ar = acc[i][0][4 * g + q], ai = acc[i][1][4 * g + q];
            re[q] = ar * tw.x + ai * tw.y;
            im[q] = ai * tw.x - ar * tw.y;
          }
          u16* d = D2 + ((((size_t)(b * 128 + klo)) * 512 + jj) * 2) * 128 + nlo;
          uint2 o;
          o.x = pack2(re[0], re[1]);
          o.y = pack2(re[2], re[3]);
          *(uint2*)d = o;
          o.x = pack2(im[0], im[1]);
          o.y = pack2(im[2], im[3]);
          *(uint2*)(d + 128) = o;
        }
    } else {
      const int rt = t - nQ - nKV - nFA;
      u16* KRR = wsp<u16>(p, O_KRR);
      for (int idx = ltid(); idx < 128 * 16; idx += 256) {
        const int rl = idx >> 4, e16 = idx & 15;
        const int row = rt * 128 + rl, b = row / KPB, kk = row - b * KPB;
        const float x1 = bf2f(LAT[(size_t)row * 512 + 384 + e16]), x2 = bf2f(LAT[(size_t)row * 512 + 400 + e16]);
        float cs, sn;
        rope_cs(kk, e16, cs, sn);
        KRR[(size_t)row * 32 + e16] = f2bf(x1 * cs - x2 * sn);
        KRR[(size_t)row * 32 + 16 + e16] = f2bf(x2 * cs + x1 * sn);
      }
    }
  }
}

template <int MODE>
__device__ void attn_item(const Params& p, int l, int b, int h, int q0  ,
                          int ntiles, int rs0, int ycol, u16* smem) {
  constexpr int DQK = MODE == 0 ? 96 : 64;
  constexpr int KSTR = DQK + 8;
  constexpr int NKS = DQK / 16;
  constexpr int CPR = DQK / 8;
  constexpr int NKC = 64 * CPR / 256;
  const int tid = ltid(), lane = tid & 63, wave = tid >> 6, r = lane & 31, hh = lane >> 5;
  u16* Ks = smem;
  u16* Vs = smem + 2 * 64 * KSTR;
  const u16* Kg = MODE == 0 ? wsp<u16>(p, O_KN) : wsp<u16>(p, O_KNA);
  const u16* Kr = wsp<u16>(p, O_KRR);
  const u16* Vg = (MODE == 0 ? wsp<u16>(p, O_VMT) : wsp<u16>(p, O_VNAT)) + (size_t)(b * 512 + h * 64) * KPB;
  const int qk = q0 + wave * 32 + r;
  const size_t qrow = (size_t)b * KPB + qk;
  bf16x8 qf[NKS];
  {
    const u16* qp = MODE == 0 ? wsp<u16>(p, O_QM) + qrow * 768 + h * 96 : wsp<u16>(p, O_QNA) + qrow * 512 + h * 64;
#pragma unroll
    for (int ks = 0; ks < NKS; ks++) qf[ks] = *(const bf16x8*)(qp + ks * 16 + hh * 8);
  }
  int qr = 0, qc = 0, rsq = 0, cs = 0;
  const float* rpb = nullptr;
  if (MODE == 1 && rs0 >= 0) {
    const int tkn = qk - CTXL;
    qr = tkn >> 6;
    qc = tkn & 63;
    rsq = min(max(qr - 4, 0), 248);
    cs = min(max(qc - 8, 0), 48);
    rpb = p.rpb + ((size_t)(l * 8 + h)) * 15 * 31;
  }
  f32x16 o[2];
#pragma unroll
  for (int e = 0; e < 16; e++) { o[0][e] = 0.f; o[1][e] = 0.f; }
  float m = -1e30f, lsum = 0.f;

  u32x4 kr0, kr1, kr2, vr0, vr1;
  kr2 = kr1 = kr0 = vr0 = vr1 = (u32x4){0u, 0u, 0u, 0u};
#define TILE_KK0(t) ((MODE == 1 && (t) >= 4) ? (CTXL + 64 * (rs0 + (t)-4)) : 64 * (t))
#define LOAD_K1(i, dstv)                                                             \
  {                                                                                  \
    const int c = tid + 256 * (i);                                                   \
    const int row = c / CPR, cc = c - row * CPR;                                     \
    const size_t grow = (size_t)b * KPB + kk0_ + row;                                \
    const u16* src_ = (MODE == 0 && cc >= 8) ? (Kr + grow * 32 + (cc - 8) * 8) : (Kg + grow * 512 + h * 64 + cc * 8); \
    dstv = *(const u32x4*)src_;                                                      \
  }
#define LOAD_V1(i, dstv)                                                             \
  {                                                                                  \
    const int c = tid + 256 * (i);                                                   \
    const int d = c >> 3, cc = c & 7;                                                \
    dstv = *(const u32x4*)(Vg + (size_t)d * KPB + kk0_ + cc * 8);                    \
  }
#define LOAD_TILE(t)                                                                 \
  {                                                                                  \
    const int kk0_ = TILE_KK0(t);                                                    \
    LOAD_K1(0, kr0) LOAD_K1(1, kr1) if (NKC == 3) LOAD_K1(2, kr2)                     \
    LOAD_V1(0, vr0) LOAD_V1(1, vr1)                                                  \
  }
#define STORE_K1(buf, i, srcv)                                                       \
  {                                                                                  \
    const int c = tid + 256 * (i);                                                   \
    const int row = c / CPR, cc = c - row * CPR;                                     \
    *(u32x4*)(Ks + (buf)*64 * KSTR + row * KSTR + cc * 8) = srcv;                    \
  }
#define STORE_V1(buf, i, srcv)                                                       \
  {                                                                                  \
    const int c = tid + 256 * (i);                                                   \
    const int d = c >> 3, cc = c & 7;                                                \
    *(u32x4*)(Vs + (buf)*64 * 72 + d * 72 + cc * 8) = srcv;                          \
  }
#define STORE_TILE(buf)                                                              \
  {                                                                                  \
    STORE_K1(buf, 0, kr0) STORE_K1(buf, 1, kr1) if (NKC == 3) STORE_K1(buf, 2, kr2)   \
    STORE_V1(buf, 0, vr0) STORE_V1(buf, 1, vr1)                                      \
  }
  LOAD_TILE(0);
  STORE_TILE(0);
  __syncthreads();
  for (int t = 0; t < ntiles; t++) {
    const int cur = t & 1;
    const bool more = t + 1 < ntiles;
    if (more) LOAD_TILE(t + 1);
    bool active = true;
    int kr = 0;
    if (MODE == 1 && t >= 4) {
      kr = rs0 + t - 4;
      active = (kr >= rsq) && (kr < rsq + 8);
    }
    if (active) {
      f32x16 s[2];
#pragma unroll
      for (int e = 0; e < 16; e++) { s[0][e] = 0.f; s[1][e] = 0.f; }
      const u16* kb_ = Ks + cur * 64 * KSTR + r * KSTR + hh * 8;
#pragma unroll
      for (int kb = 0; kb < 2; kb++)
#pragma unroll
        for (int ks = 0; ks < NKS; ks++) {
          bf16x8 kf = *(const bf16x8*)(kb_ + kb * 32 * KSTR + ks * 16);
          s[kb] = __builtin_amdgcn_mfma_f32_32x32x16_bf16(kf, qf[ks], s[kb], 0, 0, 0);
        }
      if (MODE == 1 && t >= 4) {
        const float* rp = rpb + (kr - qr + 7) * 31 + (15 - qc);
#pragma unroll
        for (int kb = 0; kb < 2; kb++)
#pragma unroll
          for (int e = 0; e < 16; e++) {
            const int kc = kb * 32 + (e & 3) + 8 * (e >> 2) + 4 * hh;
            const bool valid = (kc >= cs) && (kc < cs + 16);
            float bias = 0.f;
            if (valid) bias = rp[kc];
            s[kb][e] = valid ? s[kb][e] + bias * LOG2E : -1e30f;
          }
      }
      float mloc = s[0][0];
#pragma unroll
      for (int e = 1; e < 16; e++) mloc = fmaxf(mloc, s[0][e]);
#pragma unroll
      for (int e = 0; e < 16; e++) mloc = fmaxf(mloc, s[1][e]);
      mloc = fmaxf(mloc, __shfl_xor(mloc, 32));
      const float mnew = fmaxf(m, mloc);
      const float alpha = __builtin_amdgcn_exp2f(m - mnew);
      m = mnew;
      float rsum = 0.f;
#pragma unroll
      for (int kb = 0; kb < 2; kb++)
#pragma unroll
        for (int e = 0; e < 16; e++) {
          const float pv = __builtin_amdgcn_exp2f(s[kb][e] - mnew);
          s[kb][e] = pv;
          rsum += pv;
        }
      lsum = lsum * alpha + rsum;
#pragma unroll
      for (int e = 0; e < 16; e++) { o[0][e] *= alpha; o[1][e] *= alpha; }
      const u16* vb_ = Vs + cur * 64 * 72 + r * 72 + 4 * hh;
#pragma unroll
      for (int kb = 0; kb < 2; kb++)
#pragma unroll
        for (int st = 0; st < 2; st++) {
          u32x4 pu;
          pu[0] = pack2(s[kb][8 * st + 0], s[kb][8 * st + 1]);
          pu[1] = pack2(s[kb][8 * st + 2], s[kb][8 * st + 3]);
          pu[2] = pack2(s[kb][8 * st + 4], s[kb][8 * st + 5]);
          pu[3] = pack2(s[kb][8 * st + 6], s[kb][8 * st + 7]);
          const bf16x8 pbv = __builtin_bit_cast(bf16x8, pu);
#pragma unroll
          for (int db = 0; db < 2; db++) {
            const u16* vp = vb_ + db * 32 * 72 + kb * 32 + 16 * st;
            const bf16x4 vlo = *(const bf16x4*)(vp);
            const bf16x4 vhi = *(const bf16x4*)(vp + 8);
            const bf16x8 vfv = __builtin_shufflevector(vlo, vhi, 0, 1, 2, 3, 4, 5, 6, 7);
            o[db] = __builtin_amdgcn_mfma_f32_32x32x16_bf16(vfv, pbv, o[db], 0, 0, 0);
          }
        }
    }
    if (more) STORE_TILE(cur ^ 1);
    __syncthreads();
  }
  const float ltot = lsum + __shfl_xor(lsum, 32);
  const float inv = 1.f / ltot;
  u16* yp = wsp<u16>(p, O_Y) + qrow * 1536 + ycol + h * 64;
#pragma unroll
  for (int db = 0; db < 2; db++)
#pragma unroll
    for (int g = 0; g < 4; g++) {
      uint2 ov;
      ov.x = pack2(o[db][4 * g] * inv, o[db][4 * g + 1] * inv);
      ov.y = pack2(o[db][4 * g + 2] * inv, o[db][4 * g + 3] * inv);
      *(uint2*)(yp + db * 32 + 8 * g + 4 * hh) = ov;
    }
}

__device__ void phase_p3(const Params& p, int l, bool last, int bid, int nb, u16* smem) {
  EPI_DECL
  const int nMLA = 2048, nNA = 2048, nFB = 1024;
  const int nC = last ? 0 : (32 + 32 + 16);
  const int total = nMLA + nNA + nFB + nC;
  for (int t = bid; t < total; t += nb) {
    int kind, b = 0, h = 0, q0 = 0, ntl = 0, rs0 = -1;
    size_t aoff = 0, boff = 0;
    int Kf = 256, j0 = 0, tok0 = 0, tokmul = 1, colbase = 0;
    if (t < nMLA) {
      kind = 0;
      h = t & 7;
      const int rest = t >> 3;
      b = rest >> 7;
      q0 = CTXL + (rest & 127) * 128;
      ntl = 260;
    } else if (t < nMLA + nNA) {
      kind = 1;
      const int t2 = t - nMLA;
      h = t2 & 7;
      const int rest = t2 >> 3, rp = rest & 127;
      b = rest >> 7;
      rs0 = min(max(2 * rp - 4, 0), 248);
      const int rs1 = min(max(2 * rp + 1 - 4, 0), 248);
      q0 = CTXL + rp * 128;
      ntl = 4 + (rs1 + 8 - rs0);
    } else if (t < nMLA + nNA + nFB) {
      kind = 2;
      const int rt = t - nMLA - nNA;
      const int bk = rt >> 2;
      j0 = (rt & 3) * 128;
      b = bk >> 7;
      tok0 = CTXL + (bk & 127);
      tokmul = 128;
      aoff = O_D2 + (size_t)rt * 128 * 256 * 2;
      boff = O_MB;
      Kf = 256;
    } else {
      const int t2 = t - nMLA - nNA - nFB;
      if (t2 < 64) {
        kind = t2 >> 5;
        const int t3 = t2 & 31;
        h = t3 & 7;
        b = (t3 >> 3) & 1;
        q0 = (t3 >> 4) * 128;
        ntl = 4;
      } else {
        kind = 2;
        const int t3 = t2 - 64;
        const int rt = t3 >> 1, ct = t3 & 1;
        b = rt >> 2;
        j0 = (rt & 3) * 128;
        colbase = ct * 128;
        aoff = O_D1C + (size_t)rt * 128 * 512 * 2;
        boff = O_MC + (size_t)ct * 128 * 512 * 2;
        Kf = 512;
      }
    }
    if (kind == 0) {
      attn_item<0>(p, l, b, h, q0, ntl, -1, 1024, smem);
    } else if (kind == 1) {
      attn_item<1>(p, l, b, h, q0, ntl, rs0, 512, smem);
    } else {
      f32x16 acc[2][2];
      zero_acc(acc);
      gemm_core(acc, wsp<u16>(p, aoff), Kf, wsp<u16>(p, boff), Kf, Kf, smem);
      u16* Y = wsp<u16>(p, O_Y);
#pragma unroll
      for (int i = 0; i < 2; i++)
#pragma unroll
        for (int j = 0; j < 2; j++)
#pragma unroll
          for (int g = 0; g < 4; g++) {
            const int jj = j0 + wm_ * 64 + i * 32 + 8 * g + 4 * hh_;
            const int tok = tok0 + (colbase + wn_ * 64 + j * 32 + r_) * tokmul;
            uint2 ov;
            ov.x = pack2(acc[i][j][4 * g], acc[i][j][4 * g + 1]);
            ov.y = pack2(acc[i][j][4 * g + 2], acc[i][j][4 * g + 3]);
            *(uint2*)(Y + ((size_t)b * KPB + tok) * 1536 + jj) = ov;
          }
    }
  }
}

__device__ __forceinline__ int n_row_tiles(bool last) { return last ? NRT - 4 : NRT; }
__device__ __forceinline__ int row_tile(bool last, int i) {
  if (!last) return i;
  return i < 128 ? i + 2 : i + 4;
}

__device__ void phase_p4(const Params& p, int l, bool last, int bid, int nb, u16* smem) {
  EPI_DECL
  const u16* A = wsp<u16>(p, O_A);
  const u16* Y = wsp<u16>(p, O_Y);
  u16* M = wsp<u16>(p, O_M);
  uint4* stash = wsp<uint4>(p, O_QM) + (size_t)bid * 24 * 256 + ltid();
  const int nrt_ = n_row_tiles(last);
  PATCH_LOOP_BEGIN(nrt_, 8, 8, 8)
    const int rt = row_tile(last, prt), ct = pct;
#pragma unroll 1
    for (int g = 0; g < 3; g++) {
      f32x16 acc[2][2];
      zero_acc(acc);
      gemm_core<true>(acc, wsp<u16>(p, O_WG) + (size_t)(g * 1024 + ct * 128) * D, D, A + (size_t)rt * 128 * D, D, D,
                      smem);
#pragma unroll
      for (int i = 0; i < 2; i++)
#pragma unroll
        for (int j = 0; j < 2; j++)
#pragma unroll
          for (int e = 0; e < 2; e++) {
            uint4 gq4;
            gq4.x = pack2(fsigmoid(acc[i][j][8 * e]), fsigmoid(acc[i][j][8 * e + 1]));
            gq4.y = pack2(fsigmoid(acc[i][j][8 * e + 2]), fsigmoid(acc[i][j][8 * e + 3]));
            gq4.z = pack2(fsigmoid(acc[i][j][8 * e + 4]), fsigmoid(acc[i][j][8 * e + 5]));
            gq4.w = pack2(fsigmoid(acc[i][j][8 * e + 6]), fsigmoid(acc[i][j][8 * e + 7]));
            stash[(g * 8 + (i * 2 + j) * 2 + e) * 256] = gq4;
          }
    }
    f32x16 mg[2][2];
    zero_acc(mg);
#pragma unroll 1
    for (int g = 0; g < 3; g++) {
      f32x16 acc[2][2];
      zero_acc(acc);
      gemm_core<false>(acc, wsp<u16>(p, O_WB) + (size_t)(g * 1024 + ct * 128) * 512, 512,
                       Y + (size_t)rt * 128 * 1536 + g * 512, 1536, 512, smem);
#pragma unroll
      for (int i = 0; i < 2; i++)
#pragma unroll
        for (int j = 0; j < 2; j++)
#pragma unroll
          for (int e = 0; e < 2; e++) {
            const uint4 gq4 = stash[(g * 8 + (i * 2 + j) * 2 + e) * 256];
            const uint32_t gw[4] = {gq4.x, gq4.y, gq4.z, gq4.w};
#pragma unroll
            for (int q = 0; q < 4; q++) {
              mg[i][j][8 * e + 2 * q] += __uint_as_float(gw[q] << 16) * acc[i][j][8 * e + 2 * q];
              mg[i][j][8 * e + 2 * q + 1] += __uint_as_float(gw[q] & 0xffff0000u) * acc[i][j][8 * e + 2 * q + 1];
            }
          }
    }
#pragma unroll
    for (int i = 0; i < 2; i++)
#pragma unroll
      for (int j = 0; j < 2; j++)
#pragma unroll
        for (int g = 0; g < 4; g++) {
          const int row = rt * 128 + wn_ * 64 + j * 32 + r_;
          const int col = ct * 128 + wm_ * 64 + i * 32 + 8 * g + 4 * hh_;
          uint2 o;
          o.x = pack2(mg[i][j][4 * g], mg[i][j][4 * g + 1]);
          o.y = pack2(mg[i][j][4 * g + 2], mg[i][j][4 * g + 3]);
          *(uint2*)(M + (size_t)row * D + col) = o;
        }
  PATCH_LOOP_END
}

__device__ void phase_resid(const Params& p, int l, bool last, const u16* Ain, size_t lda, const u16* W, int K, int goff,
                            int bid, int nb, u16* smem) {
  EPI_DECL
  const float* mod = wsp<float>(p, O_MOD);
  const int nrt_ = n_row_tiles(last);
  PATCH_LOOP_BEGIN(nrt_, 8, 8, 8)
    const int rt = row_tile(last, prt), ct = pct;
    f32x16 acc[2][2];
    zero_acc(acc);
    gemm_core(acc, W + (size_t)ct * 128 * K, K, Ain + (size_t)rt * 128 * lda, lda, K, smem);
    const int row0 = rt * 128, b = row0 / KPB, kk0 = row0 - b * KPB;
    const int m = kk0 < CTXL ? 2 : b;
    float* xb = xrow(p, row0);
    const float* gv = mod + ((size_t)l * 3 + m) * 6144 + goff;
#pragma unroll
    for (int i = 0; i < 2; i++)
#pragma unroll
      for (int g = 0; g < 4; g++) {
        const int col = ct * 128 + wm_ * 64 + i * 32 + 8 * g + 4 * hh_;
        const float4 g4 = *(const float4*)(gv + col);
#pragma unroll
        for (int j = 0; j < 2; j++) {
          const int rl = wn_ * 64 + j * 32 + r_;
          float4* xp = (float4*)(xb + (size_t)rl * D + col);
          float4 xv = *xp;
          xv.x = ALPHA * xv.x + (1.f + g4.x) * acc[i][j][4 * g];
          xv.y = ALPHA * xv.y + (1.f + g4.y) * acc[i][j][4 * g + 1];
          xv.z = ALPHA * xv.z + (1.f + g4.z) * acc[i][j][4 * g + 2];
          xv.w = ALPHA * xv.w + (1.f + g4.w) * acc[i][j][4 * g + 3];
          *xp = xv;
        }
      }
  PATCH_LOOP_END
}

__device__ void phase_p7(const Params& p, int l, bool last, int bid, int nb, u16* smem) {
  EPI_DECL
  const u16* A = wsp<u16>(p, O_A);
  u16* HH = wsp<u16>(p, O_HH);
  const int nrt_ = n_row_tiles(last);
  PATCH_LOOP_BEGIN(nrt_, 44, 16, 4)
    const int rt = row_tile(last, prt), ct = pct;
    f32x16 acc[2][2];
    zero_acc(acc);
    gemm_core(acc, wsp<u16>(p, O_WGU) + (size_t)ct * 128 * D, D, A + (size_t)rt * 128 * D, D, D, smem);
#pragma unroll
    for (int j = 0; j < 2; j++)
#pragma unroll
      for (int g = 0; g < 4; g++) {
        const int row = rt * 128 + wn_ * 64 + j * 32 + r_;
        const int q = (ct * 2 + wm_) * 32 + 8 * g + 4 * hh_;
        float hv[4];
#pragma unroll
        for (int t = 0; t < 4; t++) {
          const float gt = acc[0][j][4 * g + t], up = acc[1][j][4 * g + t];
          hv[t] = gt * fsigmoid(gt) * up;
        }
        uint2 o;
        o.x = pack2(hv[0], hv[1]);
        o.y = pack2(hv[2], hv[3]);
        *(uint2*)(HH + (size_t)row * FH + q) = o;
      }
  PATCH_LOOP_END
}

constexpr int NPHASE = 3 + 9 * 2;

__device__ void run_phase(const Params& p, int ph, int bid, int nb, u16* smem) {
  if (ph == 0) {
    prep_tables(p, bid, nb);
    prep_modp(p, bid, nb);
    prep_weights(p, 0, bid, nb, smem);
    return;
  }
  if (ph == 1) { prep_modr(p, bid, nb); return; }
  if (ph == 2) { ln_phase(p, 0, p.ln_in_g, p.ln_in_b, 0, 0, 1024, false, bid, nb); return; }
  const int l = (ph - 3) / 9, s = (ph - 3) % 9;
  const bool last = (l == 1);
  switch (s) {
    case 0: phase_p1(p, l, last, bid, nb, smem); break;
    case 1: phase_p2(p, l, bid, nb, smem); break;
    case 2: phase_p3(p, l, last, bid, nb, smem); break;
    case 3: phase_p4(p, l, last, bid, nb, smem); break;
    case 4: phase_resid(p, l, last, wsp<u16>(p, O_M), D, wsp<u16>(p, O_WO), D, 2048, bid, nb, smem); break;
    case 5: ln_phase(p, 1, p.ln1_g + l * D, p.ln1_b + l * D, l, 3072, 4096, last, bid, nb); break;
    case 6: phase_p7(p, l, last, bid, nb, smem); break;
    case 7: phase_resid(p, l, last, wsp<u16>(p, O_HH), FH, wsp<u16>(p, O_WD), FH, 5120, bid, nb, smem); break;
    default:
      ln_phase(p, 1, p.ln2_g + l * D, p.ln2_b + l * D, last ? -1 : l + 1, 0, 1024, last, bid, nb);
      if (!last) prep_weights(p, l + 1, bid, nb, smem);
      break;
  }
}

constexpr int SMEM_ELEMS = 4 * SM_A + 256;

#if COOP
__global__ void __launch_bounds__(256, 2) mega_kernel(Params p) {
  __shared__ __attribute__((aligned(16))) u16 smem[SMEM_ELEMS];
  cg::grid_group grid = cg::this_grid();
  for (int ph = 0; ph < NPHASE; ph++) {
#ifdef PROBE_MASK
    const int s9 = ph >= 3 ? (ph - 3) % 9 : -1;
    const int nrep = (s9 >= 0 && ((PROBE_MASK >> s9) & 1)) ? 2 : 1;
    for (int rep = 0; rep < nrep; rep++) {
      run_phase(p, ph, blockIdx.x, gridDim.x, smem);
      if (ph + 1 < NPHASE || rep + 1 < nrep) grid.sync();
    }
#else
    run_phase(p, ph, blockIdx.x, gridDim.x, smem);
    if (ph + 1 < NPHASE) grid.sync();
#endif
  }
}
#else
__global__ void __launch_bounds__(256, 2) phase_kernel(Params p, int ph) {
  __shared__ __attribute__((aligned(16))) u16 smem[SMEM_ELEMS];
  run_phase(p, ph, blockIdx.x, gridDim.x, smem);
}
#endif

extern "C" void kernel_launch(void* const* d_in, const int* in_sizes, int n_in, void* d_out, int out_size, void* d_ws,
                              size_t ws_size, hipStream_t stream) {
  Params p{};
  const float** f = (const float**)&p;
  for (int i = 0; i < 25; i++) f[i] = (const float*)d_in[i];
  p.out = (float*)d_out;
  p.ws = (unsigned char*)d_ws;
  if (ws_size < O_END) fprintf(stderr, "workspace too small: %zu < %zu\n", ws_size, (size_t)O_END);
#if COOP
  static int grid_blocks = 0;
  if (!grid_blocks) {
    int dev = 0, cus = 0, per_cu = 0;
    hipGetDevice(&dev);
    hipDeviceGetAttribute(&cus, hipDeviceAttributeMultiprocessorCount, dev);
    hipOccupancyMaxActiveBlocksPerMultiprocessor(&per_cu, mega_kernel, 256, 0);
    if (per_cu > 2) per_cu = 2;
    grid_blocks = cus * per_cu;
  }
  void* args[] = {&p};
  hipError_t e = hipLaunchCooperativeKernel((void*)mega_kernel, dim3(grid_blocks), dim3(256), args, 0, stream);
  if (e != hipSuccess) fprintf(stderr, "cooperative launch failed: %s (grid %d)\n", hipGetErrorString(e), grid_blocks);
#else
  for (int ph = 0; ph < NPHASE; ph++) phase_kernel<<<512, 256, 0, stream>>>(p, ph);
#endif
}
```

```cpp
#include <hip/hip_runtime.h>
#include <hip/hip_cooperative_groups.h>
#include <stdint.h>
#include <cstdio>
namespace cg = cooperative_groups;

#ifndef COOP
#define COOP 1
#endif

typedef __attribute__((ext_vector_type(8))) short bf16x8;
typedef __attribute__((ext_vector_type(4))) short bf16x4;
typedef __attribute__((ext_vector_type(16))) float f32x16;
typedef unsigned short u16;
typedef __attribute__((ext_vector_type(4))) unsigned int u32x4;

constexpr int D = 1024;
constexpr int NBATCH = 2;
constexpr int SEQ = 16384;
constexpr int CTXL = 256;
constexpr int KPB = SEQ + CTXL;
constexpr int T = NBATCH * KPB;
constexpr int NRT = T / 128;
constexpr int FH = 2816;
constexpr int IN_DIM = 5536;
constexpr float LOG2E = 1.4426950408889634f;
constexpr float NA_SCALE_L2 = 0.125f * LOG2E;
constexpr float MLA_SCALE_L2 = 0.10206207261596575f * LOG2E;
constexpr float ALPHA = 1.4142135623730951f;
constexpr float EPS = 1e-5f;
constexpr float RS128 = 0.08838834764831845f;

constexpr size_t al256(size_t x) { return (x + 255) & ~(size_t)255; }
constexpr size_t O_WF = 0;
constexpr size_t O_WP = O_WF + (size_t)1024 * 1024 * 2;
constexpr size_t O_WG = O_WP + (size_t)2048 * 1024 * 2;
constexpr size_t O_WUQ = O_WG + (size_t)3072 * 1024 * 2;
constexpr size_t O_WUKV = O_WUQ + (size_t)768 * 256 * 2;
constexpr size_t O_WB = O_WUKV + (size_t)1024 * 128 * 2;
constexpr size_t O_WO = O_WB + (size_t)3 * 1024 * 512 * 2;
constexpr size_t O_WGU = O_WO + (size_t)1024 * 1024 * 2;
constexpr size_t O_WD = O_WGU + (size_t)5632 * 1024 * 2;
constexpr size_t O_MA = O_WD + (size_t)1024 * 2816 * 2;
constexpr size_t O_MB = O_MA + (size_t)256 * 256 * 2;
constexpr size_t O_MC = O_MB + (size_t)128 * 256 * 2;
constexpr size_t O_TW = O_MC + (size_t)256 * 512 * 2;
constexpr size_t O_MODP = O_TW + (size_t)128 * 128 * 2 * 4;
constexpr size_t O_MOD = O_MODP + (size_t)16 * 2 * 3 * 6144 * 4;
constexpr size_t O_XCTX = O_MOD + (size_t)2 * 3 * 6144 * 4;
constexpr size_t O_D1C = O_XCTX + (size_t)512 * 1024 * 4;
constexpr size_t O_A = O_D1C + (size_t)2 * 512 * 2 * 256 * 2;
constexpr size_t O_RQ = O_A + (size_t)T * 1024 * 2;
constexpr size_t O_QNA = O_RQ;
constexpr size_t O_KNA = O_QNA + (size_t)T * 512 * 2;
constexpr size_t O_VNAT = O_KNA + (size_t)T * 512 * 2;
constexpr size_t O_RY = O_VNAT + (size_t)T * 512 * 2;
constexpr size_t O_Y = O_RY;
constexpr size_t O_D1 = O_RY;
constexpr size_t O_LAT = O_RY + (size_t)67108864;
constexpr size_t O_D2 = O_RY + (size_t)T * 1536 * 2;
constexpr size_t O_QM = O_D2 + (size_t)67108864;
constexpr size_t O_KN = O_QM + (size_t)T * 768 * 2;
constexpr size_t O_KRR = O_KN + (size_t)T * 512 * 2;
constexpr size_t O_VMT = O_KRR + (size_t)T * 32 * 2;
constexpr size_t O_END = O_VMT + (size_t)T * 512 * 2;
constexpr size_t O_BAR = (O_END + 255) & ~(size_t)255;
constexpr size_t O_WSEND = O_BAR + 3456 * 4;
constexpr size_t O_M = O_RQ;
constexpr size_t O_HH = O_RQ;

struct Params {
  const float *x, *c, *ctx, *c_ctx, *ln_in_g, *ln_in_b, *w_mod, *b_mod, *w_in, *gq, *gkv, *w_uq, *w_qr, *w_uk,
      *w_uv, *rpb, *w_branch, *w_out, *ln1_g, *ln1_b, *ln2_g, *ln2_b, *w_gate, *w_up, *w_down;
  float* out;
  unsigned char* ws;
};

__device__ __forceinline__ u16 f2bf(float f) {
  uint32_t u = __float_as_uint(f);
  u += 0x7fffu + ((u >> 16) & 1u);
  return (u16)(u >> 16);
}
typedef __attribute__((ext_vector_type(2))) __bf16 bf16v2;
typedef __attribute__((ext_vector_type(2))) float f32v2;
__device__ __forceinline__ uint32_t pack2(float a, float b) {
  const f32v2 v = {a, b};
  return __builtin_bit_cast(uint32_t, __builtin_convertvector(v, bf16v2));
}
__device__ __forceinline__ float bf2f(u16 v) { return __uint_as_float(((uint32_t)v) << 16); }
__device__ __forceinline__ float wsum(float v) {
#pragma unroll
  for (int o = 32; o > 0; o >>= 1) v += __shfl_xor(v, o);
  return v;
}
__device__ __forceinline__ float fsigmoid(float v) { return 1.f / (1.f + __expf(-v)); }

__device__ __forceinline__ int ltid() {
  int t = threadIdx.x;
  asm volatile("" : "+v"(t));
  return t;
}

template <typename Tp>
__device__ __forceinline__ Tp* wsp(const Params& p, size_t off) { return (Tp*)(p.ws + off); }

__device__ __forceinline__ float* xrow(const Params& p, int row) {
  int b = row / KPB, kk = row - b * KPB;
  if (kk < CTXL) return wsp<float>(p, O_XCTX) + (size_t)(b * CTXL + kk) * D;
  return p.out + (size_t)(b * SEQ + kk - CTXL) * D;
}

constexpr int LSTR = 72;
constexpr int SM_A = 128 * LSTR;

template <bool DEEP = true>
__device__ __forceinline__ void gemm_core(f32x16 (&acc)[2][2], const u16* __restrict__ A, size_t lda,
                                          const u16* __restrict__ B, size_t ldb, int K, u16* smem) {
  const int tid = ltid(), lane = tid & 63, wave = tid >> 6;
  const int wm = wave >> 1, wn = wave & 1, r = lane & 31, hh = lane >> 5;
  u16* sA = smem;
  u16* sB = smem + 2 * SM_A;
  const int lrow = tid >> 3, lkc = (tid & 7) * 8;
  const u16* ga = A + (size_t)lrow * lda + lkc;
  const u16* gb = B + (size_t)lrow * ldb + lkc;
  u16* wa = sA + lrow * LSTR + lkc;
  u16* wb = sB + lrow * LSTR + lkc;
  const u16* pa = sA + (wm * 64 + r) * LSTR + hh * 8;
  const u16* pb = sB + (wn * 64 + r) * LSTR + hh * 8;
  u32x4 a0r[4], b0r[4], a1r[4], b1r[4];
#define G_LOAD(ar, br, ko)                                               \
  _Pragma("unroll") for (int i = 0; i < 4; i++) {                        \
    ar[i] = *(const u32x4*)(ga + (size_t)(32 * i) * lda + (ko));         \
    br[i] = *(const u32x4*)(gb + (size_t)(32 * i) * ldb + (ko));         \
  }
#define G_STORE(ar, br, buf)                                             \
  _Pragma("unroll") for (int i = 0; i < 4; i++) {                        \
    *(u32x4*)(wa + (buf)*SM_A + 32 * i * LSTR) = ar[i];                  \
    *(u32x4*)(wb + (buf)*SM_A + 32 * i * LSTR) = br[i];                  \
  }
#define G_COMPUTE(buf)                                                                   \
  _Pragma("unroll") for (int ks = 0; ks < 4; ks++) {                                     \
    const bf16x8 fa0 = *(const bf16x8*)(pa + (buf)*SM_A + ks * 16);                      \
    const bf16x8 fa1 = *(const bf16x8*)(pa + (buf)*SM_A + 32 * LSTR + ks * 16);          \
    const bf16x8 fb0 = *(const bf16x8*)(pb + (buf)*SM_A + ks * 16);                      \
    const bf16x8 fb1 = *(const bf16x8*)(pb + (buf)*SM_A + 32 * LSTR + ks * 16);          \
    acc[0][0] = __builtin_amdgcn_mfma_f32_32x32x16_bf16(fa0, fb0, acc[0][0], 0, 0, 0);   \
    acc[0][1] = __builtin_amdgcn_mfma_f32_32x32x16_bf16(fa0, fb1, acc[0][1], 0, 0, 0);   \
    acc[1][0] = __builtin_amdgcn_mfma_f32_32x32x16_bf16(fa1, fb0, acc[1][0], 0, 0, 0);   \
    acc[1][1] = __builtin_amdgcn_mfma_f32_32x32x16_bf16(fa1, fb1, acc[1][1], 0, 0, 0);   \
  }
  const int nk = K >> 6;
  if (DEEP) {
    G_LOAD(a0r, b0r, 0)
    G_LOAD(a1r, b1r, 64)
    G_STORE(a0r, b0r, 0)
    __syncthreads();
    const int klast = (nk - 1) * 64;
    G_LOAD(a0r, b0r, min(128, klast))
    for (int kt = 0; kt < nk; kt += 2) {
      G_COMPUTE(0)
      G_STORE(a1r, b1r, 1)
      __syncthreads();
      G_LOAD(a1r, b1r, min((kt + 3) * 64, klast))
      __builtin_amdgcn_sched_barrier(0);
      G_COMPUTE(1)
      G_STORE(a0r, b0r, 0)
      __syncthreads();
      G_LOAD(a0r, b0r, min((kt + 4) * 64, klast))
      __builtin_amdgcn_sched_barrier(0);
    }
  } else {
    G_LOAD(a0r, b0r, 0)
    G_STORE(a0r, b0r, 0)
    __syncthreads();
    for (int kt = 0; kt < nk; kt += 2) {
      G_LOAD(a0r, b0r, (kt + 1) * 64)
      G_COMPUTE(0)
      G_STORE(a0r, b0r, 1)
      __syncthreads();
      if (kt + 2 < nk) G_LOAD(a0r, b0r, (kt + 2) * 64)
      G_COMPUTE(1)
      if (kt + 2 < nk) G_STORE(a0r, b0r, 0)
      __syncthreads();
    }
  }
#undef G_LOAD
#undef G_STORE
#undef G_COMPUTE
}

__device__ __forceinline__ void zero_acc(f32x16 (&acc)[2][2]) {
#pragma unroll
  for (int i = 0; i < 2; i++)
#pragma unroll
    for (int j = 0; j < 2; j++)
#pragma unroll
      for (int e = 0; e < 16; e++) acc[i][j][e] = 0.f;
}

#define EPI_DECL                                                     \
  const int lane_ = ltid() & 63, wave_ = ltid() >> 6;      \
  const int wm_ = wave_ >> 1, wn_ = wave_ & 1, r_ = lane_ & 31, hh_ = lane_ >> 5; \
  (void)wm_; (void)wn_; (void)r_; (void)hh_;

__device__ __forceinline__ const float* src_col(const Params& p, int l, int kind, int n, int& ld) {
  switch (kind) {
    case 0:
      ld = IN_DIM;
      return n < 1952 ? p.w_in + (size_t)l * D * IN_DIM + 512 + n : nullptr;
    case 1:
      ld = IN_DIM;
      return p.w_in + (size_t)l * D * IN_DIM + 2464 + n;
    case 2:
      if (n < 512) {
        ld = 512;
        return p.w_uq + (size_t)l * 256 * 512 + n;
      } else {
        int m = n - 512, wt = m >> 6, jb = (m >> 5) & 1, idx = wt * 32 + (m & 31);
        int h = idx >> 4, e = idx & 15;
        ld = 256;
        return p.w_qr + (size_t)l * 256 * 256 + h * 32 + jb * 16 + e;
      }
    case 3:
      ld = 512;
      return n < 512 ? p.w_uk + (size_t)l * 128 * 512 + n : p.w_uv + (size_t)l * 128 * 512 + (n - 512);
    case 4: {
      int g = n >> 10, nn = n & 1023;
      ld = 1024;
      return p.w_branch + ((size_t)(l * 3 + g) * 512) * 1024 + nn;
    }
    case 5:
      ld = 1024;
      return p.w_out + (size_t)l * D * D + n;
    case 6: {
      int jb = (n >> 5) & 1, q = (n >> 6) * 32 + (n & 31);
      ld = FH;
      return (jb ? p.w_up : p.w_gate) + (size_t)l * D * FH + q;
    }
    default:
      ld = 1024;
      return p.w_down + (size_t)l * FH * D + n;
  }
}

__device__ __forceinline__ int job_nd(int k) {
  switch (k) { case 0: return 2048; case 1: return 3072; case 2: return 768; case 3: return 1024; case 4: return 3072;
    case 5: return 1024; case 6: return 5632; default: return 1024; }
}
__device__ __forceinline__ int job_kd(int k) {
  switch (k) { case 0: return 1024; case 1: return 1024; case 2: return 256; case 3: return 128; case 4: return 512;
    case 5: return 1024; case 6: return 1024; default: return 2816; }
}
__device__ __forceinline__ size_t job_od(int k) {
  switch (k) { case 0: return O_WP; case 1: return O_WG; case 2: return O_WUQ; case 3: return O_WUKV; case 4: return O_WB;
    case 5: return O_WO; case 6: return O_WGU; default: return O_WD; }
}
__device__ void prep_weights(const Params& p, int l, int bid, int nb, u16* smem) {
  float* tile = (float*)smem;
  const int tid = ltid();
  int start = 0;
#pragma unroll 1
  for (int kind = 0; kind < 8; kind++) {
    const int Kk = job_kd(kind);
    const int nkt = Kk >> 6, ntile = (job_nd(kind) >> 6) * nkt;
    u16* dst = wsp<u16>(p, job_od(kind));
    const float* ksc = kind == 2 ? p.gq + l * 256 : (kind == 3 ? p.gkv + l * 128 : nullptr);
    for (int t = (bid + nb - (start % nb)) % nb; t < ntile; t += nb) {
      const int nt = t / nkt, kt = t - nt * nkt;
      const int n0 = nt * 64, k0 = kt * 64;
      {
        const int nn = tid & 63;
        int ld;
        const float* sp = src_col(p, l, kind, n0 + nn, ld);
#pragma unroll 4
        for (int i = 0; i < 16; i++) {
          const int kk = i * 4 + (tid >> 6);
          float v = sp ? sp[(size_t)(k0 + kk) * ld] : 0.f;
          if (ksc) v *= ksc[k0 + kk];
          tile[kk * 65 + nn] = v;
        }
      }
      __syncthreads();
      {
        const int kk = tid & 63;
#pragma unroll 4
        for (int i = 0; i < 16; i++) {
          const int nn = i * 4 + (tid >> 6);
          dst[(size_t)(n0 + nn) * Kk + k0 + kk] = f2bf(tile[kk * 65 + nn]);
        }
      }
      __syncthreads();
    }
    start += ntile;
  }
  {
    float* ctab = (float*)smem;
    __syncthreads();
    if (tid < 128) ctab[tid] = cospif((float)tid * (1.f / 64.f));
    __syncthreads();
    u16* dst = wsp<u16>(p, O_WF);
    for (int it = bid; it < 4096; it += nb) {
      const int o = it * 256 + tid;
      const int np = o & 1023, k = o >> 10;
      const int reim = np >> 9, g = (np >> 7) & 3, m = np & 127;
      const float* w = p.w_in + (size_t)l * D * IN_DIM + (size_t)k * IN_DIM + g * 128;
      const int sh = reim ? 96 : 0;
      float acc = 0.f;
#pragma unroll 8
      for (int c = 0; c < 128; c++) acc += w[c] * ctab[(m * c + sh) & 127];
      dst[(size_t)np * 1024 + k] = f2bf(acc * RS128);
    }
    __syncthreads();
  }
}

__device__ void prep_tables(const Params& p, int bid, int nb) {
  u16* MA = wsp<u16>(p, O_MA);
  u16* MB = wsp<u16>(p, O_MB);
  u16* MC = wsp<u16>(p, O_MC);
  float* TW = wsp<float>(p, O_TW);
  const int total = 65536 + 32768 + 131072 + 16384;
  for (int idx = bid * 256 + ltid(); idx < total; idx += nb * 256) {
    if (idx < 65536) {
      const int n = idx >> 8, k = idx & 255;
      const int nt = n >> 7, wn = (n >> 6) & 1, jb = (n >> 5) & 1, klo = nt * 64 + wn * 32 + (n & 31);
      const int ri = k >> 7, nhi = k & 127;
      const int xx = (klo * nhi) & 127;
      const float c = cospif((float)xx * (1.f / 64.f)), s = sinpif((float)xx * (1.f / 64.f));
      float v = jb == 0 ? (ri == 0 ? c : -s) : (ri == 0 ? -s : -c);
      MA[idx] = f2bf(v * RS128);
    } else if (idx < 65536 + 32768) {
      const int i2 = idx - 65536;
      const int khi = i2 >> 8, k = i2 & 255;
      const int ri = k >> 7, nlo = k & 127;
      const int xx = (khi * nlo) & 127;
      const float c = cospif((float)xx * (1.f / 64.f)), s = sinpif((float)xx * (1.f / 64.f));
      MB[i2] = f2bf((ri == 0 ? c : s) * RS128);
    } else if (idx < 65536 + 32768 + 131072) {
      const int i2 = idx - 65536 - 32768;
      const int kk = i2 >> 9, k = i2 & 511;
      const int ri = k >> 8, nn = k & 255;
      const int xx = (kk * nn) & 255;
      const float c = cospif((float)xx * (1.f / 128.f)), s = sinpif((float)xx * (1.f / 128.f));
      MC[i2] = f2bf((ri == 0 ? c : -s) * 0.0625f);
    } else {
      const int i2 = idx - 65536 - 32768 - 131072;
      const int klo = i2 >> 7, nlo = i2 & 127;
      const int xx = klo * nlo;
      TW[i2 * 2] = cospif((float)xx * (1.f / 8192.f));
      TW[i2 * 2 + 1] = sinpif((float)xx * (1.f / 8192.f));
    }
  }
}

__device__ void prep_modp(const Params& p, int bid, int nb) {
  float* modp = wsp<float>(p, O_MODP);
  for (int it = bid; it < 2 * 16 * 24; it += nb) {
    const int l = it / (16 * 24), rem = it - l * 16 * 24, kc = rem / 24, nblk = rem - kc * 24;
    const int n = nblk * 256 + ltid();
    const float* w = p.w_mod + (size_t)l * D * 6144 + n;
    float a0 = 0.f, a1 = 0.f, a2 = 0.f;
#pragma unroll 8
    for (int kk = 0; kk < 64; kk++) {
      const int k = kc * 64 + kk;
      const float wv = w[(size_t)k * 6144];
      float c0 = p.c[k], c1 = p.c[1024 + k], c2 = p.c_ctx[k];
      c0 = c0 / (1.f + __expf(-c0));
      c1 = c1 / (1.f + __expf(-c1));
      c2 = c2 / (1.f + __expf(-c2));
      a0 += c0 * wv;
      a1 += c1 * wv;
      a2 += c2 * wv;
    }
    float* o = modp + ((size_t)(kc * 2 + l) * 3) * 6144 + n;
    o[0] = a0;
    o[6144] = a1;
    o[2 * 6144] = a2;
  }
}
__device__ void prep_modr(const Params& p, int bid, int nb) {
  const float* modp = wsp<float>(p, O_MODP);
  float* mod = wsp<float>(p, O_MOD);
  for (int idx = bid * 256 + ltid(); idx < 2 * 3 * 6144; idx += nb * 256) {
    const int l = idx / (3 * 6144), n = idx % 6144;
    float v = p.b_mod[l * 6144 + n];
    for (int kc = 0; kc < 16; kc++) v += modp[(size_t)kc * 2 * 3 * 6144 + idx];
    mod[idx] = v;
  }
}

__device__ void ln_phase(const Params& p, int mode, const float* g, const float* bta, int lmod, int shoff, int scoff,
                         bool skip_ctx, int bid, int nb) {
  const int lane = ltid() & 63, wave = ltid() >> 6;
  u16* A = wsp<u16>(p, O_A);
  const float* mod = wsp<float>(p, O_MOD);
  for (int row = bid * 4 + wave; row < T; row += nb * 4) {
    const int b = row / KPB, kk = row - b * KPB;
    if (skip_ctx && kk < CTXL) continue;
    float* xr = xrow(p, row);
    const float* src;
    if (mode == 0)
      src = kk < CTXL ? p.ctx + (size_t)(b * CTXL + kk) * D : p.x + (size_t)(b * SEQ + kk - CTXL) * D;
    else
      src = xr;
    float4 v[4];
    float s = 0.f;
#pragma unroll
    for (int i = 0; i < 4; i++) {
      v[i] = *(const float4*)(src + i * 256 + lane * 4);
      s += v[i].x + v[i].y + v[i].z + v[i].w;
    }
    const float mu = wsum(s) * (1.f / 1024.f);
    float q = 0.f;
#pragma unroll
    for (int i = 0; i < 4; i++) {
      v[i].x -= mu; v[i].y -= mu; v[i].z -= mu; v[i].w -= mu;
      q += v[i].x * v[i].x + v[i].y * v[i].y + v[i].z * v[i].z + v[i].w * v[i].w;
    }
    const float rstd = rsqrtf(wsum(q) * (1.f / 1024.f) + EPS);
    const int m = kk < CTXL ? 2 : b;
    const float* md = mod + ((size_t)(lmod < 0 ? 0 : lmod) * 3 + m) * 6144;
#pragma unroll
    for (int i = 0; i < 4; i++) {
      const int c0 = i * 256 + lane * 4;
      const float4 gg = *(const float4*)(g + c0), bb = *(const float4*)(bta + c0);
      float4 y;
      y.x = v[i].x * rstd * gg.x + bb.x;
      y.y = v[i].y * rstd * gg.y + bb.y;
      y.z = v[i].z * rstd * gg.z + bb.z;
      y.w = v[i].w * rstd * gg.w + bb.w;
      *(float4*)(xr + c0) = y;
      if (lmod >= 0) {
        const float4 sh = *(const float4*)(md + shoff + c0), sc = *(const float4*)(md + scoff + c0);
        uint2 o;
        o.x = pack2(y.x * (1.f + sc.x) + sh.x, y.y * (1.f + sc.y) + sh.y);
        o.y = pack2(y.z * (1.f + sc.z) + sh.z, y.w * (1.f + sc.w) + sh.w);
        *(uint2*)(A + (size_t)row * D + c0) = o;
      }
    }
  }
}

#define PATCH_LOOP_BEGIN(NR_, NC_, PR_, PC_)                                   \
  {                                                                            \
    const int x_ = bid & 7, w_ = bid >> 3, nbx_ = nb >> 3;                     \
    const int CG_ = ((NC_) + (PC_)-1) / (PC_);                                 \
    const int npatch_ = (((NR_) + (PR_)-1) / (PR_)) * CG_;                     \
    for (int u_ = w_;; u_ += nbx_) {                                           \
      const int g_ = (u_ >> 6) * 8 + x_;                                       \
      if (g_ >= npatch_) break;                                                \
      const int s_ = u_ & 63;                                                  \
      const int rg_ = g_ / CG_;                                                \
      const int prt = rg_ * (PR_) + s_ / (PC_);                                \
      const int pct = (g_ - rg_ * CG_) * (PC_) + s_ % (PC_);                   \
      if (prt >= (NR_) || pct >= (NC_)) continue;
#define PATCH_LOOP_END \
    }                  \
  }

__device__ void phase_p1(const Params& p, int l, bool last, int bid, int nb, u16* smem) {
  EPI_DECL
  const u16* A = wsp<u16>(p, O_A);
  PATCH_LOOP_BEGIN(NRT, 16, 8, 8)
    f32x16 acc[2][2];
    zero_acc(acc);
    {
      const int rt = prt, ct = pct;
      const int row0 = rt * 128, b = row0 / KPB, kk0 = row0 - b * KPB;
      if (ct < 8 || ct >= 12) {
        gemm_core(acc, wsp<u16>(p, O_WP) + (size_t)ct * 128 * D, D, A + (size_t)rt * 128 * D, D, D, smem);
        u16* dst;
        float sc = 1.f;
        int cb;
        if (ct < 4) { dst = wsp<u16>(p, O_QNA); sc = NA_SCALE_L2; cb = ct * 128; }
        else if (ct < 8) { dst = wsp<u16>(p, O_KNA); cb = (ct - 4) * 128; }
        else { dst = wsp<u16>(p, O_LAT); cb = (ct - 12) * 128; }
#pragma unroll
        for (int i = 0; i < 2; i++)
#pragma unroll
          for (int j = 0; j < 2; j++)
#pragma unroll
            for (int g = 0; g < 4; g++) {
              const int row = row0 + wn_ * 64 + j * 32 + r_;
              const int col = cb + wm_ * 64 + i * 32 + 8 * g + 4 * hh_;
              uint2 o;
              o.x = pack2(acc[i][j][4 * g] * sc, acc[i][j][4 * g + 1] * sc);
              o.y = pack2(acc[i][j][4 * g + 2] * sc, acc[i][j][4 * g + 3] * sc);
              *(uint2*)(dst + (size_t)row * 512 + col) = o;
            }
      } else {
        gemm_core(acc, A + (size_t)rt * 128 * D, D, wsp<u16>(p, O_WP) + (size_t)ct * 128 * D, D, D, smem);
        u16* dst = wsp<u16>(p, O_VNAT);
        const int cb = (ct - 8) * 128;
#pragma unroll
        for (int i = 0; i < 2; i++)
#pragma unroll
          for (int j = 0; j < 2; j++)
#pragma unroll
            for (int g = 0; g < 4; g++) {
              const int kk = kk0 + wm_ * 64 + i * 32 + 8 * g + 4 * hh_;
              const int col = cb + wn_ * 64 + j * 32 + r_;
              uint2 o;
              o.x = pack2(acc[i][j][4 * g], acc[i][j][4 * g + 1]);
              o.y = pack2(acc[i][j][4 * g + 2], acc[i][j][4 * g + 3]);
              *(uint2*)(dst + ((size_t)(b * 512 + col)) * KPB + kk) = o;
            }
      }
    }
  PATCH_LOOP_END
  PATCH_LOOP_BEGIN(256, 8, 8, 8)
    f32x16 acc[2][2];
    zero_acc(acc);
    {
      const int rt = prt, ct = pct;
      const int b = rt >> 7, nlo = rt & 127;
      gemm_core(acc, A + (size_t)(b * KPB + CTXL + nlo) * D, (size_t)128 * D,
                wsp<u16>(p, O_WF) + (size_t)ct * 128 * D, D, D, smem);
      u16* dst = wsp<u16>(p, O_D1);
#pragma unroll
      for (int i = 0; i < 2; i++)
#pragma unroll
        for (int j = 0; j < 2; j++)
#pragma unroll
          for (int g = 0; g < 4; g++) {
            const int nhi = wm_ * 64 + i * 32 + 8 * g + 4 * hh_;
            const int n = ct * 128 + wn_ * 64 + j * 32 + r_;
            const int reim = n >> 9, jj = n & 511;
            uint2 o;
            o.x = pack2(acc[i][j][4 * g], acc[i][j][4 * g + 1]);
            o.y = pack2(acc[i][j][4 * g + 2], acc[i][j][4 * g + 3]);
            *(uint2*)(dst + ((((size_t)(b * 512 + jj)) * 128 + nlo) * 2 + reim) * 128 + nhi) = o;
          }
    }
  PATCH_LOOP_END
  if (!last) {
    for (int t2 = bid; t2 < 32; t2 += nb) {
      f32x16 acc[2][2];
      zero_acc(acc);
      const int rt = t2 >> 3, ct = t2 & 7;
      const int b = rt >> 1, rb = rt & 1;
      gemm_core(acc, A + (size_t)(b * KPB + rb * 128) * D, D, wsp<u16>(p, O_WF) + (size_t)ct * 128 * D, D, D, smem);
      u16* dst = wsp<u16>(p, O_D1C);
#pragma unroll
      for (int i = 0; i < 2; i++)
#pragma unroll
        for (int j = 0; j < 2; j++)
#pragma unroll
          for (int g = 0; g < 4; g++) {
            const int nc = rb * 128 + wm_ * 64 + i * 32 + 8 * g + 4 * hh_;
            const int n = ct * 128 + wn_ * 64 + j * 32 + r_;
            const int reim = n >> 9, jj = n & 511;
            uint2 o;
            o.x = pack2(acc[i][j][4 * g], acc[i][j][4 * g + 1]);
            o.y = pack2(acc[i][j][4 * g + 2], acc[i][j][4 * g + 3]);
            *(uint2*)(dst + (((size_t)(b * 512 + jj)) * 2 + reim) * 256 + nc) = o;
          }
    }
  }
}

__device__ __forceinline__ float inv_freq(int i) {
  switch (i) {
    case 0: return 1.0f;
    case 1: return 0.31622776601683794f;
    case 2: return 0.1f;
    case 3: return 0.03162277660168379f;
    case 4: return 0.01f;
    case 5: return 0.0031622776601683794f;
    case 6: return 0.001f;
    default: return 0.00031622776601683794f;
  }
}
__device__ __forceinline__ void rope_cs(int kk, int e, float& cs, float& sn) {
  if (kk < CTXL) { cs = 1.f; sn = 0.f; return; }
  const int tkn = kk - CTXL;
  const float pos = (e < 8) ? (float)(tkn >> 6) : (float)(tkn & 63);
  const float ang = pos * inv_freq(e & 7);
  double xr = (double)ang * 0.31830988618379067;
  xr -= 2.0 * floor(xr * 0.5);
  const float yr = (float)xr;
  cs = cospif(yr);
  sn = sinpif(yr);
}

__device__ __forceinline__ void row_rms(const u16* A, size_t lda, int K, float* rs) {
  const int tid = ltid();
  const int row = tid >> 1, half = tid & 1;
  const u16* pr = A + (size_t)row * lda + half * (K >> 1);
  float s = 0.f;
  for (int c = 0; c < (K >> 1); c += 8) {
    uint4 v = *(const uint4*)(pr + c);
    const uint32_t w[4] = {v.x, v.y, v.z, v.w};
#pragma unroll
    for (int q = 0; q < 4; q++) {
      const float a = __uint_as_float(w[q] << 16), bq = __uint_as_float(w[q] & 0xffff0000u);
      s += a * a + bq * bq;
    }
  }
  s += __shfl_xor(s, 1);
  if (half == 0) rs[row] = rsqrtf(s / (float)K + EPS);
  __syncthreads();
}

__device__ void phase_p2(const Params& p, int l, int bid, int nb, u16* smem) {
  EPI_DECL
  const u16* LAT = wsp<u16>(p, O_LAT);
  float* rs = (float*)(smem + 4 * SM_A);
  const int nQ = NRT * 6, nKV = NRT * 8, nFA = 1024 * 2, nKR = NRT;
  const int total = nQ + nKV + nFA + nKR;
  for (int t = bid; t < total; t += nb) {
    if (t < nQ) {
      const int rt = t / 6, ct = t - rt * 6;
      const int row0 = rt * 128, b = row0 / KPB, kk0 = row0 - b * KPB;
      row_rms(LAT + (size_t)row0 * 512, 512, 256, rs);
      f32x16 acc[2][2];
      zero_acc(acc);
      gemm_core(acc, wsp<u16>(p, O_WUQ) + (size_t)ct * 128 * 256, 256, LAT + (size_t)row0 * 512, 512, 256, smem);
      u16* QM = wsp<u16>(p, O_QM);
      if (ct < 4) {
#pragma unroll
        for (int i = 0; i < 2; i++)
#pragma unroll
          for (int j = 0; j < 2; j++)
#pragma unroll
            for (int g = 0; g < 4; g++) {
              const int rl = wn_ * 64 + j * 32 + r_;
              const int col = ct * 128 + wm_ * 64 + i * 32 + 8 * g + 4 * hh_;
              const int h = col >> 6, d = col & 63;
              const float sc = rs[rl] * MLA_SCALE_L2;
              uint2 o;
              o.x = pack2(acc[i][j][4 * g] * sc, acc[i][j][4 * g + 1] * sc);
              o.y = pack2(acc[i][j][4 * g + 2] * sc, acc[i][j][4 * g + 3] * sc);
              *(uint2*)(QM + (size_t)(row0 + rl) * 768 + h * 96 + d) = o;
            }
      } else {
        const int wt = (ct - 4) * 2 + wm_;
#pragma unroll
        for (int j = 0; j < 2; j++) {
          const int rl = wn_ * 64 + j * 32 + r_;
          const float sc = rs[rl] * MLA_SCALE_L2;
#pragma unroll
          for (int g = 0; g < 4; g++) {
            const int idx = wt * 32 + 8 * g + 4 * hh_;
            const int h = idx >> 4, e16 = idx & 15;
            float o1[4], o2[4];
#pragma unroll
            for (int q = 0; q < 4; q++) {
              float cs, sn;
              rope_cs(kk0 + rl, e16 + q, cs, sn);
              const float x1 = acc[0][j][4 * g + q] * sc, x2 = acc[1][j][4 * g + q] * sc;
              o1[q] = x1 * cs - x2 * sn;
              o2[q] = x2 * cs + x1 * sn;
            }
            u16* qd = QM + (size_t)(row0 + rl) * 768 + h * 96 + 64 + e16;
            uint2 o;
            o.x = pack2(o1[0], o1[1]);
            o.y = pack2(o1[2], o1[3]);
            *(uint2*)qd = o;
            o.x = pack2(o2[0], o2[1]);
            o.y = pack2(o2[2], o2[3]);
            *(uint2*)(qd + 16) = o;
          }
        }
      }
      __syncthreads();
    } else if (t < nQ + nKV) {
      const int t2 = t - nQ;
      const int rt = t2 >> 3, ct = t2 & 7;
      const int row0 = rt * 128, b = row0 / KPB, kk0 = row0 - b * KPB;
      row_rms(LAT + (size_t)row0 * 512 + 256, 512, 128, rs);
      f32x16 acc[2][2];
      zero_acc(acc);
      if (ct < 4) {
        gemm_core(acc, wsp<u16>(p, O_WUKV) + (size_t)ct * 128 * 128, 128, LAT + (size_t)row0 * 512 + 256, 512, 128,
                  smem);
        u16* KN = wsp<u16>(p, O_KN);
#pragma unroll
        for (int i = 0; i < 2; i++)
#pragma unroll
          for (int j = 0; j < 2; j++)
#pragma unroll
            for (int g = 0; g < 4; g++) {
              const int rl = wn_ * 64 + j * 32 + r_;
              const int col = ct * 128 + wm_ * 64 + i * 32 + 8 * g + 4 * hh_;
              const float sc = rs[rl];
              uint2 o;
              o.x = pack2(acc[i][j][4 * g] * sc, acc[i][j][4 * g + 1] * sc);
              o.y = pack2(acc[i][j][4 * g + 2] * sc, acc[i][j][4 * g + 3] * sc);
              *(uint2*)(KN + (size_t)(row0 + rl) * 512 + col) = o;
            }
      } else {
        gemm_core(acc, LAT + (size_t)row0 * 512 + 256, 512, wsp<u16>(p, O_WUKV) + (size_t)ct * 128 * 128, 128, 128,
                  smem);
        u16* VMT = wsp<u16>(p, O_VMT);
#pragma unroll
        for (int i = 0; i < 2; i++)
#pragma unroll
          for (int j = 0; j < 2; j++)
#pragma unroll
            for (int g = 0; g < 4; g++) {
              const int rl = wm_ * 64 + i * 32 + 8 * g + 4 * hh_;
              const int col = (ct - 4) * 128 + wn_ * 64 + j * 32 + r_;
              uint2 o;
              o.x = pack2(acc[i][j][4 * g] * rs[rl], acc[i][j][4 * g + 1] * rs[rl + 1]);
              o.y = pack2(acc[i][j][4 * g + 2] * rs[rl + 2], acc[i][j][4 * g + 3] * rs[rl + 3]);
              *(uint2*)(VMT + ((size_t)(b * 512 + col)) * KPB + kk0 + rl) = o;
            }
      }
      __syncthreads();
    } else if (t < nQ + nKV + nFA) {
      const int t2 = t - nQ - nKV;
      const int rt = t2 >> 1, ct = t2 & 1;
      const int b = rt >> 9, jj = rt & 511;
      f32x16 acc[2][2];
      zero_acc(acc);
      gemm_core(acc, wsp<u16>(p, O_D1) + (size_t)rt * 128 * 256, 256, wsp<u16>(p, O_MA) + (size_t)ct * 128 * 256, 256,
                256, smem);
      const float* TW = wsp<float>(p, O_TW);
      u16* D2 = wsp<u16>(p, O_D2);
      const int klo = ct * 64 + wn_ * 32 + r_;
#pragma unroll
      for (int i = 0; i < 2; i++)
#pragma unroll
        for (int g = 0; g < 4; g++) {
          const int nlo = wm_ * 64 + i * 32 + 8 * g + 4 * hh_;
          float re[4], im[4];
#pragma unroll
          for (int q = 0; q < 4; q++) {
            const float2 tw = *(const float2*)(TW + ((size_t)klo * 128 + nlo + q) * 2);
            const float ar = acc[i][0][4 * g + q], ai = acc[i][1][4 * g + q];
            re[q] = ar * tw.x + ai * tw.y;
            im[q] = ai * tw.x - ar * tw.y;
          }
          u16* d = D2 + ((((size_t)(b * 128 + klo)) * 512 + jj) * 2) * 128 + nlo;
          uint2 o;
          o.x = pack2(re[0], re[1]);
          o.y = pack2(re[2], re[3]);
          *(uint2*)d = o;
          o.x = pack2(im[0], im[1]);
          o.y = pack2(im[2], im[3]);
          *(uint2*)(d + 128) = o;
        }
    } else {
      const int rt = t - nQ - nKV - nFA;
      u16* KRR = wsp<u16>(p, O_KRR);
      for (int idx = ltid(); idx < 128 * 16; idx += 256) {
        const int rl = idx >> 4, e16 = idx & 15;
        const int row = rt * 128 + rl, b = row / KPB, kk = row - b * KPB;
        const float x1 = bf2f(LAT[(size_t)row * 512 + 384 + e16]), x2 = bf2f(LAT[(size_t)row * 512 + 400 + e16]);
        float cs, sn;
        rope_cs(kk, e16, cs, sn);
        KRR[(size_t)row * 32 + e16] = f2bf(x1 * cs - x2 * sn);
        KRR[(size_t)row * 32 + 16 + e16] = f2bf(x2 * cs + x1 * sn);
      }
    }
  }
}

template <int MODE>
__device__ void attn_item(const Params& p, int l, int b, int h, int q0  ,
                          int ntiles, int rs0, int ycol, u16* smem) {
  constexpr int DQK = MODE == 0 ? 96 : 64;
  constexpr int KSTR = DQK + 8;
  constexpr int NKS = DQK / 16;
  constexpr int CPR = DQK / 8;
  constexpr int NKC = 64 * CPR / 256;
  const int tid = ltid(), lane = tid & 63, wave = tid >> 6, r = lane & 31, hh = lane >> 5;
  u16* Ks = smem;
  u16* Vs = smem + 2 * 64 * KSTR;
  const u16* Kg = MODE == 0 ? wsp<u16>(p, O_KN) : wsp<u16>(p, O_KNA);
  const u16* Kr = wsp<u16>(p, O_KRR);
  const u16* Vg = (MODE == 0 ? wsp<u16>(p, O_VMT) : wsp<u16>(p, O_VNAT)) + (size_t)(b * 512 + h * 64) * KPB;
  const int qk = q0 + wave * 32 + r;
  const size_t qrow = (size_t)b * KPB + qk;
  bf16x8 qf[NKS];
  {
    const u16* qp = MODE == 0 ? wsp<u16>(p, O_QM) + qrow * 768 + h * 96 : wsp<u16>(p, O_QNA) + qrow * 512 + h * 64;
#pragma unroll
    for (int ks = 0; ks < NKS; ks++) qf[ks] = *(const bf16x8*)(qp + ks * 16 + hh * 8);
  }
  int qr = 0, qc = 0, rsq = 0, cs = 0;
  const float* rpb = nullptr;
  if (MODE == 1 && rs0 >= 0) {
    const int tkn = qk - CTXL;
    qr = tkn >> 6;
    qc = tkn & 63;
    rsq = min(max(qr - 4, 0), 248);
    cs = min(max(qc - 8, 0), 48);
    rpb = p.rpb + ((size_t)(l * 8 + h)) * 15 * 31;
  }
  f32x16 o[2], ol;
#pragma unroll
  for (int e = 0; e < 16; e++) { o[0][e] = 0.f; o[1][e] = 0.f; ol[e] = 0.f; }
  float m = -1e30f;
  const bf16x8 ones = {(short)0x3F80, (short)0x3F80, (short)0x3F80, (short)0x3F80,
                       (short)0x3F80, (short)0x3F80, (short)0x3F80, (short)0x3F80};

  u32x4 kr0, kr1, kr2, vr0, vr1;
  kr2 = kr1 = kr0 = vr0 = vr1 = (u32x4){0u, 0u, 0u, 0u};
#define TILE_KK0(t) ((MODE == 1 && (t) >= 4) ? (CTXL + 64 * (rs0 + (t)-4)) : 64 * (t))
#define LOAD_K1(i, dstv)                                                             \
  {                                                                                  \
    const int c = tid + 256 * (i);                                                   \
    const int row = c / CPR, cc = c - row * CPR;                                     \
    const size_t grow = (size_t)b * KPB + kk0_ + row;                                \
    const u16* src_ = (MODE == 0 && cc >= 8) ? (Kr + grow * 32 + (cc - 8) * 8) : (Kg + grow * 512 + h * 64 + cc * 8); \
    dstv = *(const u32x4*)src_;                                                      \
  }
#define LOAD_V1(i, dstv)                                                             \
  {                                                                                  \
    const int c = tid + 256 * (i);                                                   \
    const int d = c >> 3, cc = c & 7;                                                \
    dstv = *(const u32x4*)(Vg + (size_t)d * KPB + kk0_ + cc * 8);                    \
  }
#define LOAD_K(t)                                                                    \
  {                                                                                  \
    const int kk0_ = TILE_KK0(t);                                                    \
    LOAD_K1(0, kr0) LOAD_K1(1, kr1) if (NKC == 3) LOAD_K1(2, kr2)                     \
  }
#define LOAD_V(t)                                                                    \
  {                                                                                  \
    const int kk0_ = TILE_KK0(t);                                                    \
    LOAD_V1(0, vr0) LOAD_V1(1, vr1)                                                  \
  }
#define STORE_K1(buf, i, srcv)                                                       \
  {                                                                                  \
    const int c = tid + 256 * (i);                                                   \
    const int row = c / CPR, cc = c - row * CPR;                                     \
    *(u32x4*)(Ks + (buf)*64 * KSTR + row * KSTR + cc * 8) = srcv;                    \
  }
#define STORE_V1(buf, i, srcv)                                                       \
  {                                                                                  \
    const int c = tid + 256 * (i);                                                   \
    const int d = c >> 3, cc = c & 7;                                                \
    u32x4 sv_ = srcv;                                                                \
    if (d & 8) sv_ = (u32x4){sv_[2], sv_[3], sv_[0], sv_[1]};                        \
    *(u32x4*)(Vs + (buf)*64 * 72 + d * 72 + cc * 8) = sv_;                           \
  }
#define STORE_K(buf) { STORE_K1(buf, 0, kr0) STORE_K1(buf, 1, kr1) if (NKC == 3) STORE_K1(buf, 2, kr2) }
#define STORE_V(buf) { STORE_V1(buf, 0, vr0) STORE_V1(buf, 1, vr1) }
#define QK_TILE(sdst, kbuf, t)                                                                     \
  {                                                                                                \
    _Pragma("unroll") for (int e = 0; e < 16; e++) { sdst[0][e] = 0.f; sdst[1][e] = 0.f; }         \
    const u16* kb_ = Ks + (kbuf)*64 * KSTR + r * KSTR + hh * 8;                                    \
    _Pragma("unroll") for (int ks = 0; ks < NKS; ks++) {                                           \
      const bf16x8 kf0 = *(const bf16x8*)(kb_ + ks * 16);                                          \
      const bf16x8 kf1 = *(const bf16x8*)(kb_ + 32 * KSTR + ks * 16);                              \
      sdst[0] = __builtin_amdgcn_mfma_f32_32x32x16_bf16(kf0, qf[ks], sdst[0], 0, 0, 0);            \
      sdst[1] = __builtin_amdgcn_mfma_f32_32x32x16_bf16(kf1, qf[ks], sdst[1], 0, 0, 0);            \
    }                                                                                              \
    if (MODE == 1 && (t) >= 4) {                                                                   \
      const int kr_ = rs0 + (t)-4;                                                                 \
      const bool rowok = (kr_ >= rsq) && (kr_ < rsq + 8);                                          \
      const float* rp = rpb + (kr_ - qr + 7) * 31 + (15 - qc);                                     \
      _Pragma("unroll") for (int kb = 0; kb < 2; kb++) _Pragma("unroll") for (int e = 0; e < 16; e++) { \
        const int kc = kb * 32 + (e & 3) + 8 * (e >> 2) + 4 * hh;                                  \
        const bool valid = rowok && (kc >= cs) && (kc < cs + 16);                                  \
        float bias = 0.f;                                                                          \
        if (valid) bias = rp[kc];                                                                  \
        sdst[kb][e] = valid ? sdst[kb][e] + bias * LOG2E : -1e30f;                                 \
      }                                                                                            \
    }                                                                                              \
  }

  const int tl = ntiles - 1;
  LOAD_K(0)
  LOAD_V(0)
  STORE_K(0)
  STORE_V(0)
  LOAD_K(min(1, tl))
  STORE_K(1)
  __syncthreads();
  f32x16 sc[2], sn[2];
  QK_TILE(sc, 0, 0)
#pragma unroll
  for (int e = 0; e < 16; e++) { sn[0][e] = 0.f; sn[1][e] = 0.f; }
  const int vsw = 4 * (hh ^ ((r >> 3) & 1));
  for (int t = 0; t < ntiles; t++) {
    const int cur = t & 1;
    LOAD_K(min(t + 2, tl))
    LOAD_V(min(t + 1, tl))
    __builtin_amdgcn_sched_barrier(0);
    if (t + 1 < ntiles) QK_TILE(sn, cur ^ 1, t + 1)
    {
      float tmax = sc[0][0];
#pragma unroll
      for (int e = 1; e < 16; e++) tmax = fmaxf(tmax, sc[0][e]);
#pragma unroll
      for (int e = 0; e < 16; e++) tmax = fmaxf(tmax, sc[1][e]);
      {
        const uint32_t tu = __float_as_uint(tmax);
        const auto sw = __builtin_amdgcn_permlane32_swap(tu, tu, false, false);
        tmax = fmaxf(__uint_as_float(sw[0]), __uint_as_float(sw[1]));
      }
      if (__any(tmax > m + 8.f)) {
        const float mnew = fmaxf(m, tmax);
        const float alpha = __builtin_amdgcn_exp2f(m - mnew);
        m = mnew;
#pragma unroll
        for (int e = 0; e < 16; e++) { o[0][e] *= alpha; o[1][e] *= alpha; ol[e] *= alpha; }
      }
      const u16* vb_ = Vs + cur * 64 * 72 + r * 72 + vsw;
#pragma unroll
      for (int kb = 0; kb < 2; kb++)
#pragma unroll
        for (int st = 0; st < 2; st++) {
          u32x4 pu;
#pragma unroll
          for (int q = 0; q < 4; q++)
            pu[q] = pack2(__builtin_amdgcn_exp2f(sc[kb][8 * st + 2 * q] - m),
                          __builtin_amdgcn_exp2f(sc[kb][8 * st + 2 * q + 1] - m));
          const bf16x8 pbv = __builtin_bit_cast(bf16x8, pu);
#pragma unroll
          for (int db = 0; db < 2; db++) {
            const u16* vp = vb_ + db * 32 * 72 + kb * 32 + 16 * st;
            const bf16x4 vlo = *(const bf16x4*)(vp);
            const bf16x4 vhi = *(const bf16x4*)(vp + 8);
            const bf16x8 vfv = __builtin_shufflevector(vlo, vhi, 0, 1, 2, 3, 4, 5, 6, 7);
            o[db] = __builtin_amdgcn_mfma_f32_32x32x16_bf16(vfv, pbv, o[db], 0, 0, 0);
          }
          ol = __builtin_amdgcn_mfma_f32_32x32x16_bf16(ones, pbv, ol, 0, 0, 0);
        }
    }
    STORE_K(cur)
    STORE_V(cur ^ 1)
    __syncthreads();
    sc[0] = sn[0];
    sc[1] = sn[1];
  }
  const float inv = 1.f / ol[0];
  u16* yp = wsp<u16>(p, O_Y) + qrow * 1536 + ycol + h * 64;
#pragma unroll
  for (int db = 0; db < 2; db++)
#pragma unroll
    for (int g = 0; g < 4; g++) {
      uint2 ov;
      ov.x = pack2(o[db][4 * g] * inv, o[db][4 * g + 1] * inv);
      ov.y = pack2(o[db][4 * g + 2] * inv, o[db][4 * g + 3] * inv);
      *(uint2*)(yp + db * 32 + 8 * g + 4 * hh) = ov;
    }
#undef TILE_KK0
#undef LOAD_K1
#undef LOAD_V1
#undef LOAD_K
#undef LOAD_V
#undef STORE_K1
#undef STORE_V1
#undef STORE_K
#undef STORE_V
#undef QK_TILE
}

__device__ void phase_p3(const Params& p, int l, bool last, int bid, int nb, u16* smem) {
  EPI_DECL
  const int nMLA = 2048, nNA = 2048, nFB = 1024;
  const int nC = last ? 0 : (32 + 32 + 16);
  const int total = nMLA + nNA + nFB + nC;
  for (int t = bid; t < total; t += nb) {
    int kind, b = 0, h = 0, q0 = 0, ntl = 0, rs0 = -1;
    size_t aoff = 0, boff = 0;
    int Kf = 256, j0 = 0, tok0 = 0, tokmul = 1, colbase = 0;
    if (t < nMLA) {
      kind = 0;
      h = t & 7;
      const int rest = t >> 3;
      b = rest >> 7;
      q0 = CTXL + (rest & 127) * 128;
      ntl = 260;
    } else if (t < nMLA + nNA) {
      kind = 1;
      const int t2 = t - nMLA;
      h = t2 & 7;
      const int rest = t2 >> 3, rp = rest & 127;
      b = rest >> 7;
      rs0 = min(max(2 * rp - 4, 0), 248);
      const int rs1 = min(max(2 * rp + 1 - 4, 0), 248);
      q0 = CTXL + rp * 128;
      ntl = 4 + (rs1 + 8 - rs0);
    } else if (t < nMLA + nNA + nFB) {
      kind = 2;
      const int rt = t - nMLA - nNA;
      const int bk = rt >> 2;
      j0 = (rt & 3) * 128;
      b = bk >> 7;
      tok0 = CTXL + (bk & 127);
      tokmul = 128;
      aoff = O_D2 + (size_t)rt * 128 * 256 * 2;
      boff = O_MB;
      Kf = 256;
    } else {
      const int t2 = t - nMLA - nNA - nFB;
      if (t2 < 64) {
        kind = t2 >> 5;
        const int t3 = t2 & 31;
        h = t3 & 7;
        b = (t3 >> 3) & 1;
        q0 = (t3 >> 4) * 128;
        ntl = 4;
      } else {
        kind = 2;
        const int t3 = t2 - 64;
        const int rt = t3 >> 1, ct = t3 & 1;
        b = rt >> 2;
        j0 = (rt & 3) * 128;
        colbase = ct * 128;
        aoff = O_D1C + (size_t)rt * 128 * 512 * 2;
        boff = O_MC + (size_t)ct * 128 * 512 * 2;
        Kf = 512;
      }
    }
    if (kind == 0) {
      attn_item<0>(p, l, b, h, q0, ntl, -1, 1024, smem);
    } else if (kind == 1) {
      attn_item<1>(p, l, b, h, q0, ntl, rs0, 512, smem);
    } else {
      f32x16 acc[2][2];
      zero_acc(acc);
      gemm_core(acc, wsp<u16>(p, aoff), Kf, wsp<u16>(p, boff), Kf, Kf, smem);
      u16* Y = wsp<u16>(p, O_Y);
#pragma unroll
      for (int i = 0; i < 2; i++)
#pragma unroll
        for (int j = 0; j < 2; j++)
#pragma unroll
          for (int g = 0; g < 4; g++) {
            const int jj = j0 + wm_ * 64 + i * 32 + 8 * g + 4 * hh_;
            const int tok = tok0 + (colbase + wn_ * 64 + j * 32 + r_) * tokmul;
            uint2 ov;
            ov.x = pack2(acc[i][j][4 * g], acc[i][j][4 * g + 1]);
            ov.y = pack2(acc[i][j][4 * g + 2], acc[i][j][4 * g + 3]);
            *(uint2*)(Y + ((size_t)b * KPB + tok) * 1536 + jj) = ov;
          }
    }
  }
}

__device__ __forceinline__ int n_row_tiles(bool last) { return last ? NRT - 4 : NRT; }
__device__ __forceinline__ int row_tile(bool last, int i) {
  if (!last) return i;
  return i < 128 ? i + 2 : i + 4;
}

__device__ void phase_p4(const Params& p, int l, bool last, int bid, int nb, u16* smem) {
  EPI_DECL
  const u16* A = wsp<u16>(p, O_A);
  const u16* Y = wsp<u16>(p, O_Y);
  u16* M = wsp<u16>(p, O_M);
  uint4* stash = wsp<uint4>(p, O_QM) + (size_t)bid * 24 * 256 + ltid();
  const int nrt_ = n_row_tiles(last);
  PATCH_LOOP_BEGIN(nrt_, 8, 8, 8)
    const int rt = row_tile(last, prt), ct = pct;
#pragma unroll 1
    for (int g = 0; g < 3; g++) {
      f32x16 acc[2][2];
      zero_acc(acc);
      gemm_core<true>(acc, wsp<u16>(p, O_WG) + (size_t)(g * 1024 + ct * 128) * D, D, A + (size_t)rt * 128 * D, D, D,
                      smem);
#pragma unroll
      for (int i = 0; i < 2; i++)
#pragma unroll
        for (int j = 0; j < 2; j++)
#pragma unroll
          for (int e = 0; e < 2; e++) {
            uint4 gq4;
            gq4.x = pack2(fsigmoid(acc[i][j][8 * e]), fsigmoid(acc[i][j][8 * e + 1]));
            gq4.y = pack2(fsigmoid(acc[i][j][8 * e + 2]), fsigmoid(acc[i][j][8 * e + 3]));
            gq4.z = pack2(fsigmoid(acc[i][j][8 * e + 4]), fsigmoid(acc[i][j][8 * e + 5]));
            gq4.w = pack2(fsigmoid(acc[i][j][8 * e + 6]), fsigmoid(acc[i][j][8 * e + 7]));
            stash[(g * 8 + (i * 2 + j) * 2 + e) * 256] = gq4;
          }
    }
    f32x16 mg[2][2];
    zero_acc(mg);
#pragma unroll 1
    for (int g = 0; g < 3; g++) {
      f32x16 acc[2][2];
      zero_acc(acc);
      gemm_core<false>(acc, wsp<u16>(p, O_WB) + (size_t)(g * 1024 + ct * 128) * 512, 512,
                       Y + (size_t)rt * 128 * 1536 + g * 512, 1536, 512, smem);
#pragma unroll
      for (int i = 0; i < 2; i++)
#pragma unroll
        for (int j = 0; j < 2; j++)
#pragma unroll
          for (int e = 0; e < 2; e++) {
            const uint4 gq4 = stash[(g * 8 + (i * 2 + j) * 2 + e) * 256];
            const uint32_t gw[4] = {gq4.x, gq4.y, gq4.z, gq4.w};
#pragma unroll
            for (int q = 0; q < 4; q++) {
              mg[i][j][8 * e + 2 * q] += __uint_as_float(gw[q] << 16) * acc[i][j][8 * e + 2 * q];
              mg[i][j][8 * e + 2 * q + 1] += __uint_as_float(gw[q] & 0xffff0000u) * acc[i][j][8 * e + 2 * q + 1];
            }
          }
    }
#pragma unroll
    for (int i = 0; i < 2; i++)
#pragma unroll
      for (int j = 0; j < 2; j++)
#pragma unroll
        for (int g = 0; g < 4; g++) {
          const int row = rt * 128 + wn_ * 64 + j * 32 + r_;
          const int col = ct * 128 + wm_ * 64 + i * 32 + 8 * g + 4 * hh_;
          uint2 o;
          o.x = pack2(mg[i][j][4 * g], mg[i][j][4 * g + 1]);
          o.y = pack2(mg[i][j][4 * g + 2], mg[i][j][4 * g + 3]);
          *(uint2*)(M + (size_t)row * D + col) = o;
        }
  PATCH_LOOP_END
}

__device__ void phase_resid(const Params& p, int l, bool last, const u16* Ain, size_t lda, const u16* W, int K, int goff,
                            int bid, int nb, u16* smem) {
  EPI_DECL
  const float* mod = wsp<float>(p, O_MOD);
  const int nrt_ = n_row_tiles(last);
  PATCH_LOOP_BEGIN(nrt_, 8, 8, 8)
    const int rt = row_tile(last, prt), ct = pct;
    f32x16 acc[2][2];
    zero_acc(acc);
    gemm_core(acc, W + (size_t)ct * 128 * K, K, Ain + (size_t)rt * 128 * lda, lda, K, smem);
    const int row0 = rt * 128, b = row0 / KPB, kk0 = row0 - b * KPB;
    const int m = kk0 < CTXL ? 2 : b;
    float* xb = xrow(p, row0);
    const float* gv = mod + ((size_t)l * 3 + m) * 6144 + goff;
#pragma unroll
    for (int i = 0; i < 2; i++)
#pragma unroll
      for (int g = 0; g < 4; g++) {
        const int col = ct * 128 + wm_ * 64 + i * 32 + 8 * g + 4 * hh_;
        const float4 g4 = *(const float4*)(gv + col);
#pragma unroll
        for (int j = 0; j < 2; j++) {
          const int rl = wn_ * 64 + j * 32 + r_;
          float4* xp = (float4*)(xb + (size_t)rl * D + col);
          float4 xv = *xp;
          xv.x = ALPHA * xv.x + (1.f + g4.x) * acc[i][j][4 * g];
          xv.y = ALPHA * xv.y + (1.f + g4.y) * acc[i][j][4 * g + 1];
          xv.z = ALPHA * xv.z + (1.f + g4.z) * acc[i][j][4 * g + 2];
          xv.w = ALPHA * xv.w + (1.f + g4.w) * acc[i][j][4 * g + 3];
          *xp = xv;
        }
      }
  PATCH_LOOP_END
}

__device__ void phase_p7(const Params& p, int l, bool last, int bid, int nb, u16* smem) {
  EPI_DECL
  const u16* A = wsp<u16>(p, O_A);
  u16* HH = wsp<u16>(p, O_HH);
  const int nrt_ = n_row_tiles(last);
  PATCH_LOOP_BEGIN(nrt_, 44, 16, 4)
    const int rt = row_tile(last, prt), ct = pct;
    f32x16 acc[2][2];
    zero_acc(acc);
    gemm_core(acc, wsp<u16>(p, O_WGU) + (size_t)ct * 128 * D, D, A + (size_t)rt * 128 * D, D, D, smem);
#pragma unroll
    for (int j = 0; j < 2; j++)
#pragma unroll
      for (int g = 0; g < 4; g++) {
        const int row = rt * 128 + wn_ * 64 + j * 32 + r_;
        const int q = (ct * 2 + wm_) * 32 + 8 * g + 4 * hh_;
        float hv[4];
#pragma unroll
        for (int t = 0; t < 4; t++) {
          const float gt = acc[0][j][4 * g + t], up = acc[1][j][4 * g + t];
          hv[t] = gt * fsigmoid(gt) * up;
        }
        uint2 o;
        o.x = pack2(hv[0], hv[1]);
        o.y = pack2(hv[2], hv[3]);
        *(uint2*)(HH + (size_t)row * FH + q) = o;
      }
  PATCH_LOOP_END
}

constexpr int NPHASE = 3 + 9 * 2;

__device__ void run_phase(const Params& p, int ph, int bid, int nb, u16* smem) {
  if (ph == 0) {
    prep_tables(p, bid, nb);
    prep_modp(p, bid, nb);
    prep_weights(p, 0, bid, nb, smem);
    return;
  }
  if (ph == 1) { prep_modr(p, bid, nb); return; }
  if (ph == 2) { ln_phase(p, 0, p.ln_in_g, p.ln_in_b, 0, 0, 1024, false, bid, nb); return; }
  const int l = (ph - 3) / 9, s = (ph - 3) % 9;
  const bool last = (l == 1);
  switch (s) {
    case 0: phase_p1(p, l, last, bid, nb, smem); break;
    case 1: phase_p2(p, l, bid, nb, smem); break;
    case 2: phase_p3(p, l, last, bid, nb, smem); break;
    case 3: phase_p4(p, l, last, bid, nb, smem); break;
    case 4: phase_resid(p, l, last, wsp<u16>(p, O_M), D, wsp<u16>(p, O_WO), D, 2048, bid, nb, smem); break;
    case 5: ln_phase(p, 1, p.ln1_g + l * D, p.ln1_b + l * D, l, 3072, 4096, last, bid, nb); break;
    case 6: phase_p7(p, l, last, bid, nb, smem); break;
    case 7: phase_resid(p, l, last, wsp<u16>(p, O_HH), FH, wsp<u16>(p, O_WD), FH, 5120, bid, nb, smem); break;
    default:
      ln_phase(p, 1, p.ln2_g + l * D, p.ln2_b + l * D, last ? -1 : l + 1, 0, 1024, last, bid, nb);
      if (!last) prep_weights(p, l + 1, bid, nb, smem);
      break;
  }
}


#define XB_TMO      128
#define XB_XCNT(j)  (256  + 64 * (j))
#define XB_XSUB(j)  (1280 + 64 * (j))
#define XB_XGEN(j)  (2304 + 64 * (j))
#define XB_TOP      3328
#define XB_TOPGEN   3392
#define XCD_BAR_WORDS 3456
#define XB_SPIN_CAP (1u << 20)
#define LAS __attribute__((address_space(3)))
__device__ __forceinline__ unsigned xb_ld(unsigned* p) { return __hip_atomic_load(p, __ATOMIC_RELAXED, __HIP_MEMORY_SCOPE_AGENT); }
__device__ __forceinline__ unsigned xb_add(unsigned* p, unsigned v) { return __hip_atomic_fetch_add(p, v, __ATOMIC_RELAXED, __HIP_MEMORY_SCOPE_AGENT); }
__device__ __forceinline__ unsigned xb_xcc_id() { return (unsigned)__builtin_amdgcn_s_getreg((3 << 11) | 20) & 0xFu; }
#define XB_SPIN(cond, bar) do { unsigned _sp = 0; while (cond) { __builtin_amdgcn_s_sleep(1); \
    if ((++_sp & 255u) == 0u) { if (xb_ld(&(bar)[XB_TMO])) break; if (_sp > XB_SPIN_CAP) { atomicAdd(&(bar)[XB_TMO], 1u); break; } } } } while (0)
struct XcdBarrier {
  unsigned* bar; unsigned x;
  volatile LAS unsigned* st;
};
__device__ __forceinline__ XcdBarrier xcd_barrier_post(unsigned* bar, volatile LAS unsigned* st) {
  XcdBarrier b; b.bar = bar; b.x = xb_xcc_id(); b.st = st;
  if (threadIdx.x == 0) (void)xb_add(&bar[XB_XCNT(b.x)], 1u);
  return b;
}
__device__ __forceinline__ void xcd_barrier_complete(unsigned* bar, unsigned x, unsigned& nloc, unsigned& nx) {
  const unsigned G = gridDim.x * gridDim.y * gridDim.z;
  unsigned sum, cnt, mine, sp = 0u;
  for (;;) {
    sum = 0u; cnt = 0u; mine = 0u;
#pragma unroll
    for (unsigned j = 0; j < 16; ++j) { const unsigned c = xb_ld(&bar[XB_XCNT(j)]); sum += c; cnt += (c > 0u) ? 1u : 0u; mine = (j == x) ? c : mine; }
    if (sum == G) break;
    __builtin_amdgcn_s_sleep(1);
    if ((++sp & 255u) == 0u) { if (xb_ld(&bar[XB_TMO])) break; if (sp > XB_SPIN_CAP) { atomicAdd(&bar[XB_TMO], 1u); break; } }
  }
  nloc = mine > 0u ? mine : 1u; nx = cnt > 0u ? cnt : 1u;
}
__device__ __forceinline__ void xcd_barrier(const XcdBarrier& b) {
  asm volatile("s_waitcnt vmcnt(0)" ::: "memory");
  __syncthreads();
  if (threadIdx.x == 0) {
    unsigned* bar = b.bar;
    __builtin_amdgcn_s_waitcnt(0);
    unsigned nloc = b.st[0], nx = b.st[1];
    if (nloc == 0u) { xcd_barrier_complete(bar, b.x, nloc, nx); b.st[0] = nloc; b.st[1] = nx; }
    const unsigned old = xb_add(&bar[XB_XSUB(b.x)], 1u);
    const unsigned gen = old / nloc;
    if (old + 1u == (gen + 1u) * nloc) {
      __builtin_amdgcn_fence(__ATOMIC_RELEASE, "agent");
      asm volatile("s_waitcnt vmcnt(0)" ::: "memory");
      const unsigned og = xb_add(&bar[XB_TOP], 1u);
      const unsigned tg = og / nx;
      if (og + 1u == (tg + 1u) * nx) xb_add(&bar[XB_TOPGEN], 1u);
      else XB_SPIN(xb_ld(&bar[XB_TOPGEN]) == tg, bar);
      __builtin_amdgcn_fence(__ATOMIC_ACQUIRE, "agent");
      xb_add(&bar[XB_XGEN(b.x)], 1u);
      asm volatile("s_waitcnt vmcnt(0)" ::: "memory");
    } else {
      XB_SPIN(xb_ld(&bar[XB_XGEN(b.x)]) == gen, bar);
      __builtin_amdgcn_fence(__ATOMIC_ACQUIRE, "agent");
      asm volatile("s_waitcnt vmcnt(0)" ::: "memory");
    }
  }
  __syncthreads();
}

constexpr int SMEM_ELEMS = 4 * SM_A + 256 + 8;

#if COOP
__global__ void __launch_bounds__(256, 2) mega_kernel(Params p) {
  __shared__ __attribute__((aligned(16))) u16 smem[SMEM_ELEMS];
  cg::grid_group grid = cg::this_grid();
  volatile LAS unsigned* st = (volatile LAS unsigned*)(smem + 4 * SM_A + 256);
  if (threadIdx.x == 0) { st[0] = 0u; st[1] = 0u; }
  __syncthreads();
  XcdBarrier xb = xcd_barrier_post((unsigned*)(p.ws + O_BAR), st);
  for (int ph = 0; ph < NPHASE; ph++) {
#ifdef PROBE_MASK
    const int s9 = ph >= 3 ? (ph - 3) % 9 : -1;
    const int nrep = (s9 >= 0 && ((PROBE_MASK >> s9) & 1)) ? 2 : 1;
    for (int rep = 0; rep < nrep; rep++) {
      run_phase(p, ph, blockIdx.x, gridDim.x, smem);
      if (ph == 0) grid.sync();
      else if (ph + 1 < NPHASE || rep + 1 < nrep) xcd_barrier(xb);
    }
#else
    run_phase(p, ph, blockIdx.x, gridDim.x, smem);
    if (ph == 0) grid.sync();
    else if (ph + 1 < NPHASE) xcd_barrier(xb);
#endif
  }
}
#else
__global__ void __launch_bounds__(256, 2) phase_kernel(Params p, int ph) {
  __shared__ __attribute__((aligned(16))) u16 smem[SMEM_ELEMS];
  run_phase(p, ph, blockIdx.x, gridDim.x, smem);
}
#endif

extern "C" void kernel_launch(void* const* d_in, const int* in_sizes, int n_in, void* d_out, int out_size, void* d_ws,
                              size_t ws_size, hipStream_t stream) {
  Params p{};
  const float** f = (const float**)&p;
  for (int i = 0; i < 25; i++) f[i] = (const float*)d_in[i];
  p.out = (float*)d_out;
  p.ws = (unsigned char*)d_ws;
  if (ws_size < O_WSEND) fprintf(stderr, "workspace too small: %zu < %zu\n", ws_size, (size_t)O_WSEND);
#if COOP
  static int grid_blocks = 0;
  if (!grid_blocks) {
    int dev = 0, cus = 0, per_cu = 0;
    hipGetDevice(&dev);
    hipDeviceGetAttribute(&cus, hipDeviceAttributeMultiprocessorCount, dev);
    hipOccupancyMaxActiveBlocksPerMultiprocessor(&per_cu, mega_kernel, 256, 0);
    if (per_cu > 2) per_cu = 2;
    grid_blocks = cus * per_cu;
  }
  (void)hipMemsetAsync(p.ws + O_BAR, 0, 3456 * 4, stream);
  void* args[] = {&p};
  hipError_t e = hipLaunchCooperativeKernel((void*)mega_kernel, dim3(grid_blocks), dim3(256), args, 0, stream);
  if (e != hipSuccess) fprintf(stderr, "cooperative launch failed: %s (grid %d)\n", hipGetErrorString(e), grid_blocks);
#else
  for (int ph = 0; ph < NPHASE; ph++) phase_kernel<<<512, 256, 0, stream>>>(p, ph);
#endif
}
```

```cpp
#include <hip/hip_runtime.h>
#include <hip/hip_cooperative_groups.h>
#include <stdint.h>
#include <cstdio>
namespace cg = cooperative_groups;

#ifndef COOP
#define COOP 1
#endif

typedef __attribute__((ext_vector_type(8))) short bf16x8;
typedef __attribute__((ext_vector_type(4))) short bf16x4;
typedef __attribute__((ext_vector_type(16))) float f32x16;
typedef unsigned short u16;
typedef __attribute__((ext_vector_type(4))) unsigned int u32x4;

constexpr int D = 1024;
constexpr int NBATCH = 2;
constexpr int SEQ = 16384;
constexpr int CTXL = 256;
constexpr int KPB = SEQ + CTXL;
constexpr int T = NBATCH * KPB;
constexpr int NRT = T / 128;
constexpr int FH = 2816;
constexpr int IN_DIM = 5536;
constexpr float LOG2E = 1.4426950408889634f;
constexpr float NA_SCALE_L2 = 0.125f * LOG2E;
constexpr float MLA_SCALE_L2 = 0.10206207261596575f * LOG2E;
constexpr float ALPHA = 1.4142135623730951f;
constexpr float EPS = 1e-5f;
constexpr float RS128 = 0.08838834764831845f;

constexpr size_t al256(size_t x) { return (x + 255) & ~(size_t)255; }
constexpr size_t O_WF = 0;
constexpr size_t O_WP = O_WF + (size_t)1024 * 1024 * 2;
constexpr size_t O_WG = O_WP + (size_t)2048 * 1024 * 2;
constexpr size_t O_WUQ = O_WG + (size_t)3072 * 1024 * 2;
constexpr size_t O_WUKV = O_WUQ + (size_t)768 * 256 * 2;
constexpr size_t O_WB = O_WUKV + (size_t)1024 * 128 * 2;
constexpr size_t O_WO = O_WB + (size_t)3 * 1024 * 512 * 2;
constexpr size_t O_WGU = O_WO + (size_t)1024 * 1024 * 2;
constexpr size_t O_WD = O_WGU + (size_t)5632 * 1024 * 2;
constexpr size_t O_MA = O_WD + (size_t)1024 * 2816 * 2;
constexpr size_t O_MB = O_MA + (size_t)256 * 256 * 2;
constexpr size_t O_MC = O_MB + (size_t)128 * 256 * 2;
constexpr size_t O_TW = O_MC + (size_t)256 * 512 * 2;
constexpr size_t O_MODP = O_TW + (size_t)128 * 128 * 2 * 4;
constexpr size_t O_MOD = O_MODP + (size_t)16 * 2 * 3 * 6144 * 4;
constexpr size_t O_XCTX = O_MOD + (size_t)2 * 3 * 6144 * 4;
constexpr size_t O_D1C = O_XCTX + (size_t)512 * 1024 * 4;
constexpr size_t O_A = O_D1C + (size_t)2 * 512 * 2 * 256 * 2;
constexpr size_t O_RQ = O_A + (size_t)T * 1024 * 2;
constexpr size_t O_QNA = O_RQ;
constexpr size_t O_KNA = O_QNA + (size_t)T * 512 * 2;
constexpr size_t O_VNAT = O_KNA + (size_t)T * 512 * 2;
constexpr size_t O_RY = O_VNAT + (size_t)T * 512 * 2;
constexpr size_t O_Y = O_RY;
constexpr size_t O_D1 = O_RY;
constexpr size_t O_LAT = O_RY + (size_t)67108864;
constexpr size_t O_D2 = O_RY + (size_t)T * 1536 * 2;
constexpr size_t O_QM = O_D2 + (size_t)67108864;
constexpr size_t O_KN = O_QM + (size_t)T * 768 * 2;
constexpr size_t O_KRR = O_KN + (size_t)T * 512 * 2;
constexpr size_t O_VMT = O_KRR + (size_t)T * 32 * 2;
constexpr size_t O_END = O_VMT + (size_t)T * 512 * 2;
constexpr size_t O_BAR = (O_END + 255) & ~(size_t)255;
constexpr size_t O_WSEND = O_BAR + 3456 * 4;
constexpr size_t O_M = O_RQ;
constexpr size_t O_HH = O_RQ;

struct Params {
  const float *x, *c, *ctx, *c_ctx, *ln_in_g, *ln_in_b, *w_mod, *b_mod, *w_in, *gq, *gkv, *w_uq, *w_qr, *w_uk,
      *w_uv, *rpb, *w_branch, *w_out, *ln1_g, *ln1_b, *ln2_g, *ln2_b, *w_gate, *w_up, *w_down;
  float* out;
  unsigned char* ws;
};

__device__ __forceinline__ u16 f2bf(float f) {
  uint32_t u = __float_as_uint(f);
  u += 0x7fffu + ((u >> 16) & 1u);
  return (u16)(u >> 16);
}
typedef __attribute__((ext_vector_type(2))) __bf16 bf16v2;
typedef __attribute__((ext_vector_type(2))) float f32v2;
__device__ __forceinline__ uint32_t pack2(float a, float b) {
  const f32v2 v = {a, b};
  return __builtin_bit_cast(uint32_t, __builtin_convertvector(v, bf16v2));
}
__device__ __forceinline__ float bf2f(u16 v) { return __uint_as_float(((uint32_t)v) << 16); }
__device__ __forceinline__ float wsum(float v) {
#pragma unroll
  for (int o = 32; o > 0; o >>= 1) v += __shfl_xor(v, o);
  return v;
}
__device__ __forceinline__ float fsigmoid(float v) { return 1.f / (1.f + __expf(-v)); }

__device__ __forceinline__ int ltid() {
  int t = threadIdx.x;
  asm volatile("" : "+v"(t));
  return t;
}

template <typename Tp>
__device__ __forceinline__ Tp* wsp(const Params& p, size_t off) { return (Tp*)(p.ws + off); }

__device__ __forceinline__ float* xrow(const Params& p, int row) {
  int b = row / KPB, kk = row - b * KPB;
  if (kk < CTXL) return wsp<float>(p, O_XCTX) + (size_t)(b * CTXL + kk) * D;
  return p.out + (size_t)(b * SEQ + kk - CTXL) * D;
}

constexpr int LSTR = 72;
constexpr int SM_A = 128 * LSTR;

template <bool DEEP = true>
__device__ __forceinline__ void gemm_core(f32x16 (&acc)[2][2], const u16* __restrict__ A, size_t lda,
                                          const u16* __restrict__ B, size_t ldb, int K, u16* smem) {
  const int tid = ltid(), lane = tid & 63, wave = tid >> 6;
  const int wm = wave >> 1, wn = wave & 1, r = lane & 31, hh = lane >> 5;
  u16* sA = smem;
  u16* sB = smem + 2 * SM_A;
  const int lrow = tid >> 3, lkc = (tid & 7) * 8;
  const u16* ga = A + (size_t)lrow * lda + lkc;
  const u16* gb = B + (size_t)lrow * ldb + lkc;
  u16* wa = sA + lrow * LSTR + lkc;
  u16* wb = sB + lrow * LSTR + lkc;
  const u16* pa = sA + (wm * 64 + r) * LSTR + hh * 8;
  const u16* pb = sB + (wn * 64 + r) * LSTR + hh * 8;
  u32x4 a0r[4], b0r[4], a1r[4], b1r[4];
#define G_LOAD(ar, br, ko)                                               \
  _Pragma("unroll") for (int i = 0; i < 4; i++) {                        \
    ar[i] = *(const u32x4*)(ga + (size_t)(32 * i) * lda + (ko));         \
    br[i] = *(const u32x4*)(gb + (size_t)(32 * i) * ldb + (ko));         \
  }
#define G_STORE(ar, br, buf)                                             \
  _Pragma("unroll") for (int i = 0; i < 4; i++) {                        \
    *(u32x4*)(wa + (buf)*SM_A + 32 * i * LSTR) = ar[i];                  \
    *(u32x4*)(wb + (buf)*SM_A + 32 * i * LSTR) = br[i];                  \
  }
#define G_COMPUTE(buf)                                                                   \
  _Pragma("unroll") for (int ks = 0; ks < 4; ks++) {                                     \
    const bf16x8 fa0 = *(const bf16x8*)(pa + (buf)*SM_A + ks * 16);                      \
    const bf16x8 fa1 = *(const bf16x8*)(pa + (buf)*SM_A + 32 * LSTR + ks * 16);          \
    const bf16x8 fb0 = *(const bf16x8*)(pb + (buf)*SM_A + ks * 16);                      \
    const bf16x8 fb1 = *(const bf16x8*)(pb + (buf)*SM_A + 32 * LSTR + ks * 16);          \
    acc[0][0] = __builtin_amdgcn_mfma_f32_32x32x16_bf16(fa0, fb0, acc[0][0], 0, 0, 0);   \
    acc[0][1] = __builtin_amdgcn_mfma_f32_32x32x16_bf16(fa0, fb1, acc[0][1], 0, 0, 0);   \
    acc[1][0] = __builtin_amdgcn_mfma_f32_32x32x16_bf16(fa1, fb0, acc[1][0], 0, 0, 0);   \
    acc[1][1] = __builtin_amdgcn_mfma_f32_32x32x16_bf16(fa1, fb1, acc[1][1], 0, 0, 0);   \
  }
  const int nk = K >> 6;
  if (DEEP) {
    G_LOAD(a0r, b0r, 0)
    G_LOAD(a1r, b1r, 64)
    G_STORE(a0r, b0r, 0)
    __syncthreads();
    const int klast = (nk - 1) * 64;
    G_LOAD(a0r, b0r, min(128, klast))
    for (int kt = 0; kt < nk; kt += 2) {
      G_COMPUTE(0)
      G_STORE(a1r, b1r, 1)
      __syncthreads();
      G_LOAD(a1r, b1r, min((kt + 3) * 64, klast))
      __builtin_amdgcn_sched_barrier(0);
      G_COMPUTE(1)
      G_STORE(a0r, b0r, 0)
      __syncthreads();
      G_LOAD(a0r, b0r, min((kt + 4) * 64, klast))
      __builtin_amdgcn_sched_barrier(0);
    }
  } else {
    G_LOAD(a0r, b0r, 0)
    G_STORE(a0r, b0r, 0)
    __syncthreads();
    for (int kt = 0; kt < nk; kt += 2) {
      G_LOAD(a0r, b0r, (kt + 1) * 64)
      G_COMPUTE(0)
      G_STORE(a0r, b0r, 1)
      __syncthreads();
      if (kt + 2 < nk) G_LOAD(a0r, b0r, (kt + 2) * 64)
      G_COMPUTE(1)
      if (kt + 2 < nk) G_STORE(a0r, b0r, 0)
      __syncthreads();
    }
  }
#undef G_LOAD
#undef G_STORE
#undef G_COMPUTE
}

__device__ __forceinline__ void zero_acc(f32x16 (&acc)[2][2]) {
#pragma unroll
  for (int i = 0; i < 2; i++)
#pragma unroll
    for (int j = 0; j < 2; j++)
#pragma unroll
      for (int e = 0; e < 16; e++) acc[i][j][e] = 0.f;
}

#define EPI_DECL                                                     \
  const int lane_ = ltid() & 63, wave_ = ltid() >> 6;      \
  const int wm_ = wave_ >> 1, wn_ = wave_ & 1, r_ = lane_ & 31, hh_ = lane_ >> 5; \
  (void)wm_; (void)wn_; (void)r_; (void)hh_;

__device__ __forceinline__ const float* src_col(const Params& p, int l, int kind, int n, int& ld) {
  switch (kind) {
    case 0:
      ld = IN_DIM;
      return n < 1952 ? p.w_in + (size_t)l * D * IN_DIM + 512 + n : nullptr;
    case 1:
      ld = IN_DIM;
      return p.w_in + (size_t)l * D * IN_DIM + 2464 + n;
    case 2:
      if (n < 512) {
        ld = 512;
        return p.w_uq + (size_t)l * 256 * 512 + n;
      } else {
        int m = n - 512, wt = m >> 6, jb = (m >> 5) & 1, idx = wt * 32 + (m & 31);
        int h = idx >> 4, e = idx & 15;
        ld = 256;
        return p.w_qr + (size_t)l * 256 * 256 + h * 32 + jb * 16 + e;
      }
    case 3:
      ld = 512;
      return n < 512 ? p.w_uk + (size_t)l * 128 * 512 + n : p.w_uv + (size_t)l * 128 * 512 + (n - 512);
    case 4: {
      int g = n >> 10, nn = n & 1023;
      ld = 1024;
      return p.w_branch + ((size_t)(l * 3 + g) * 512) * 1024 + nn;
    }
    case 5:
      ld = 1024;
      return p.w_out + (size_t)l * D * D + n;
    case 6: {
      int jb = (n >> 5) & 1, q = (n >> 6) * 32 + (n & 31);
      ld = FH;
      return (jb ? p.w_up : p.w_gate) + (size_t)l * D * FH + q;
    }
    default:
      ld = 1024;
      return p.w_down + (size_t)l * FH * D + n;
  }
}

__device__ __forceinline__ int job_nd(int k) {
  switch (k) { case 0: return 2048; case 1: return 3072; case 2: return 768; case 3: return 1024; case 4: return 3072;
    case 5: return 1024; case 6: return 5632; default: return 1024; }
}
__device__ __forceinline__ int job_kd(int k) {
  switch (k) { case 0: return 1024; case 1: return 1024; case 2: return 256; case 3: return 128; case 4: return 512;
    case 5: return 1024; case 6: return 1024; default: return 2816; }
}
__device__ __forceinline__ size_t job_od(int k) {
  switch (k) { case 0: return O_WP; case 1: return O_WG; case 2: return O_WUQ; case 3: return O_WUKV; case 4: return O_WB;
    case 5: return O_WO; case 6: return O_WGU; default: return O_WD; }
}
__device__ void prep_weights(const Params& p, int l, int bid, int nb, u16* smem) {
  float* tile = (float*)smem;
  const int tid = ltid();
  int start = 0;
#pragma unroll 1
  for (int kind = 0; kind < 8; kind++) {
    const int Kk = job_kd(kind);
    const int nkt = Kk >> 6, ntile = (job_nd(kind) >> 6) * nkt;
    u16* dst = wsp<u16>(p, job_od(kind));
    const float* ksc = kind == 2 ? p.gq + l * 256 : (kind == 3 ? p.gkv + l * 128 : nullptr);
    for (int t = (bid + nb - (start % nb)) % nb; t < ntile; t += nb) {
      const int nt = t / nkt, kt = t - nt * nkt;
      const int n0 = nt * 64, k0 = kt * 64;
      {
        const int nn = tid & 63;
        int ld;
        const float* sp = src_col(p, l, kind, n0 + nn, ld);
#pragma unroll 4
        for (int i = 0; i < 16; i++) {
          const int kk = i * 4 + (tid >> 6);
          float v = sp ? sp[(size_t)(k0 + kk) * ld] : 0.f;
          if (ksc) v *= ksc[k0 + kk];
          tile[kk * 65 + nn] = v;
        }
      }
      __syncthreads();
      {
        const int kk = tid & 63;
#pragma unroll 4
        for (int i = 0; i < 16; i++) {
          const int nn = i * 4 + (tid >> 6);
          dst[(size_t)(n0 + nn) * Kk + k0 + kk] = f2bf(tile[kk * 65 + nn]);
        }
      }
      __syncthreads();
    }
    start += ntile;
  }
  {
    float* ctab = (float*)smem;
    __syncthreads();
    if (tid < 128) ctab[tid] = cospif((float)tid * (1.f / 64.f));
    __syncthreads();
    u16* dst = wsp<u16>(p, O_WF);
    for (int it = bid; it < 4096; it += nb) {
      const int o = it * 256 + tid;
      const int np = o & 1023, k = o >> 10;
      const int reim = np >> 9, g = (np >> 7) & 3, m = np & 127;
      const float* w = p.w_in + (size_t)l * D * IN_DIM + (size_t)k * IN_DIM + g * 128;
      const int sh = reim ? 96 : 0;
      float acc = 0.f;
#pragma unroll 8
      for (int c = 0; c < 128; c++) acc += w[c] * ctab[(m * c + sh) & 127];
      dst[(size_t)np * 1024 + k] = f2bf(acc * RS128);
    }
    __syncthreads();
  }
}

__device__ void prep_tables(const Params& p, int bid, int nb) {
  u16* MA = wsp<u16>(p, O_MA);
  u16* MB = wsp<u16>(p, O_MB);
  u16* MC = wsp<u16>(p, O_MC);
  float* TW = wsp<float>(p, O_TW);
  const int total = 65536 + 32768 + 131072 + 16384;
  for (int idx = bid * 256 + ltid(); idx < total; idx += nb * 256) {
    if (idx < 65536) {
      const int n = idx >> 8, k = idx & 255;
      const int nt = n >> 7, wn = (n >> 6) & 1, jb = (n >> 5) & 1, klo = nt * 64 + wn * 32 + (n & 31);
      const int ri = k >> 7, nhi = k & 127;
      const int xx = (klo * nhi) & 127;
      const float c = cospif((float)xx * (1.f / 64.f)), s = sinpif((float)xx * (1.f / 64.f));
      float v = jb == 0 ? (ri == 0 ? c : -s) : (ri == 0 ? -s : -c);
      MA[idx] = f2bf(v * RS128);
    } else if (idx < 65536 + 32768) {
      const int i2 = idx - 65536;
      const int khi = i2 >> 8, k = i2 & 255;
      const int ri = k >> 7, nlo = k & 127;
      const int xx = (khi * nlo) & 127;
      const float c = cospif((float)xx * (1.f / 64.f)), s = sinpif((float)xx * (1.f / 64.f));
      MB[i2] = f2bf((ri == 0 ? c : s) * RS128);
    } else if (idx < 65536 + 32768 + 131072) {
      const int i2 = idx - 65536 - 32768;
      const int kk = i2 >> 9, k = i2 & 511;
      const int ri = k >> 8, nn = k & 255;
      const int xx = (kk * nn) & 255;
      const float c = cospif((float)xx * (1.f / 128.f)), s = sinpif((float)xx * (1.f / 128.f));
      MC[i2] = f2bf((ri == 0 ? c : -s) * 0.0625f);
    } else {
      const int i2 = idx - 65536 - 32768 - 131072;
      const int klo = i2 >> 7, nlo = i2 & 127;
      const int xx = klo * nlo;
      TW[i2 * 2] = cospif((float)xx * (1.f / 8192.f));
      TW[i2 * 2 + 1] = sinpif((float)xx * (1.f / 8192.f));
    }
  }
}

__device__ void prep_modp(const Params& p, int bid, int nb) {
  float* modp = wsp<float>(p, O_MODP);
  for (int it = bid; it < 2 * 16 * 24; it += nb) {
    const int l = it / (16 * 24), rem = it - l * 16 * 24, kc = rem / 24, nblk = rem - kc * 24;
    const int n = nblk * 256 + ltid();
    const float* w = p.w_mod + (size_t)l * D * 6144 + n;
    float a0 = 0.f, a1 = 0.f, a2 = 0.f;
#pragma unroll 8
    for (int kk = 0; kk < 64; kk++) {
      const int k = kc * 64 + kk;
      const float wv = w[(size_t)k * 6144];
      float c0 = p.c[k], c1 = p.c[1024 + k], c2 = p.c_ctx[k];
      c0 = c0 / (1.f + __expf(-c0));
      c1 = c1 / (1.f + __expf(-c1));
      c2 = c2 / (1.f + __expf(-c2));
      a0 += c0 * wv;
      a1 += c1 * wv;
      a2 += c2 * wv;
    }
    float* o = modp + ((size_t)(kc * 2 + l) * 3) * 6144 + n;
    o[0] = a0;
    o[6144] = a1;
    o[2 * 6144] = a2;
  }
}
__device__ void prep_modr(const Params& p, int bid, int nb) {
  const float* modp = wsp<float>(p, O_MODP);
  float* mod = wsp<float>(p, O_MOD);
  for (int idx = bid * 256 + ltid(); idx < 2 * 3 * 6144; idx += nb * 256) {
    const int l = idx / (3 * 6144), n = idx % 6144;
    float v = p.b_mod[l * 6144 + n];
    for (int kc = 0; kc < 16; kc++) v += modp[(size_t)kc * 2 * 3 * 6144 + idx];
    mod[idx] = v;
  }
}

__device__ void ln_phase(const Params& p, int mode, const float* g, const float* bta, int lmod, int shoff, int scoff,
                         bool skip_ctx, int bid, int nb) {
  const int lane = ltid() & 63, wave = ltid() >> 6;
  u16* A = wsp<u16>(p, O_A);
  const float* mod = wsp<float>(p, O_MOD);
  for (int row = bid * 4 + wave; row < T; row += nb * 4) {
    const int b = row / KPB, kk = row - b * KPB;
    if (skip_ctx && kk < CTXL) continue;
    float* xr = xrow(p, row);
    const float* src;
    if (mode == 0)
      src = kk < CTXL ? p.ctx + (size_t)(b * CTXL + kk) * D : p.x + (size_t)(b * SEQ + kk - CTXL) * D;
    else
      src = xr;
    float4 v[4];
    float s = 0.f;
#pragma unroll
    for (int i = 0; i < 4; i++) {
      v[i] = *(const float4*)(src + i * 256 + lane * 4);
      s += v[i].x + v[i].y + v[i].z + v[i].w;
    }
    const float mu = wsum(s) * (1.f / 1024.f);
    float q = 0.f;
#pragma unroll
    for (int i = 0; i < 4; i++) {
      v[i].x -= mu; v[i].y -= mu; v[i].z -= mu; v[i].w -= mu;
      q += v[i].x * v[i].x + v[i].y * v[i].y + v[i].z * v[i].z + v[i].w * v[i].w;
    }
    const float rstd = rsqrtf(wsum(q) * (1.f / 1024.f) + EPS);
    const int m = kk < CTXL ? 2 : b;
    const float* md = mod + ((size_t)(lmod < 0 ? 0 : lmod) * 3 + m) * 6144;
#pragma unroll
    for (int i = 0; i < 4; i++) {
      const int c0 = i * 256 + lane * 4;
      const float4 gg = *(const float4*)(g + c0), bb = *(const float4*)(bta + c0);
      float4 y;
      y.x = v[i].x * rstd * gg.x + bb.x;
      y.y = v[i].y * rstd * gg.y + bb.y;
      y.z = v[i].z * rstd * gg.z + bb.z;
      y.w = v[i].w * rstd * gg.w + bb.w;
      *(float4*)(xr + c0) = y;
      if (lmod >= 0) {
        const float4 sh = *(const float4*)(md + shoff + c0), sc = *(const float4*)(md + scoff + c0);
        uint2 o;
        o.x = pack2(y.x * (1.f + sc.x) + sh.x, y.y * (1.f + sc.y) + sh.y);
        o.y = pack2(y.z * (1.f + sc.z) + sh.z, y.w * (1.f + sc.w) + sh.w);
        *(uint2*)(A + (size_t)row * D + c0) = o;
      }
    }
  }
}

#define PATCH_LOOP_BEGIN(NR_, NC_, PR_, PC_)                                   \
  {                                                                            \
    const int x_ = bid & 7, w_ = bid >> 3, nbx_ = nb >> 3;                     \
    const int CG_ = ((NC_) + (PC_)-1) / (PC_);                                 \
    const int npatch_ = (((NR_) + (PR_)-1) / (PR_)) * CG_;                     \
    for (int u_ = w_;; u_ += nbx_) {                                           \
      const int g_ = (u_ >> 6) * 8 + x_;                                       \
      if (g_ >= npatch_) break;                                                \
      const int s_ = u_ & 63;                                                  \
      const int rg_ = g_ / CG_;                                                \
      const int prt = rg_ * (PR_) + s_ / (PC_);                                \
      const int pct = (g_ - rg_ * CG_) * (PC_) + s_ % (PC_);                   \
      if (prt >= (NR_) || pct >= (NC_)) continue;
#define PATCH_LOOP_END \
    }                  \
  }

__device__ void phase_p1(const Params& p, int l, bool last, int bid, int nb, u16* smem) {
  EPI_DECL
  const u16* A = wsp<u16>(p, O_A);
  PATCH_LOOP_BEGIN(NRT, 16, 8, 8)
    f32x16 acc[2][2];
    zero_acc(acc);
    {
      const int rt = prt, ct = pct;
      const int row0 = rt * 128, b = row0 / KPB, kk0 = row0 - b * KPB;
      if (ct < 8 || ct >= 12) {
        gemm_core(acc, wsp<u16>(p, O_WP) + (size_t)ct * 128 * D, D, A + (size_t)rt * 128 * D, D, D, smem);
        u16* dst;
        float sc = 1.f;
        int cb;
        if (ct < 4) { dst = wsp<u16>(p, O_QNA); sc = NA_SCALE_L2; cb = ct * 128; }
        else if (ct < 8) { dst = wsp<u16>(p, O_KNA); cb = (ct - 4) * 128; }
        else { dst = wsp<u16>(p, O_LAT); cb = (ct - 12) * 128; }
#pragma unroll
        for (int i = 0; i < 2; i++)
#pragma unroll
          for (int j = 0; j < 2; j++)
#pragma unroll
            for (int g = 0; g < 4; g++) {
              const int row = row0 + wn_ * 64 + j * 32 + r_;
              const int col = cb + wm_ * 64 + i * 32 + 8 * g + 4 * hh_;
              uint2 o;
              o.x = pack2(acc[i][j][4 * g] * sc, acc[i][j][4 * g + 1] * sc);
              o.y = pack2(acc[i][j][4 * g + 2] * sc, acc[i][j][4 * g + 3] * sc);
              *(uint2*)(dst + (size_t)row * 512 + col) = o;
            }
      } else {
        gemm_core(acc, A + (size_t)rt * 128 * D, D, wsp<u16>(p, O_WP) + (size_t)ct * 128 * D, D, D, smem);
        u16* dst = wsp<u16>(p, O_VNAT);
        const int cb = (ct - 8) * 128;
#pragma unroll
        for (int i = 0; i < 2; i++)
#pragma unroll
          for (int j = 0; j < 2; j++)
#pragma unroll
            for (int g = 0; g < 4; g++) {
              const int kk = kk0 + wm_ * 64 + i * 32 + 8 * g + 4 * hh_;
              const int col = cb + wn_ * 64 + j * 32 + r_;
              uint2 o;
              o.x = pack2(acc[i][j][4 * g], acc[i][j][4 * g + 1]);
              o.y = pack2(acc[i][j][4 * g + 2], acc[i][j][4 * g + 3]);
              *(uint2*)(dst + ((size_t)(b * 512 + col)) * KPB + kk) = o;
            }
      }
    }
  PATCH_LOOP_END
  PATCH_LOOP_BEGIN(256, 8, 8, 8)
    f32x16 acc[2][2];
    zero_acc(acc);
    {
      const int rt = prt, ct = pct;
      const int b = rt >> 7, nlo = rt & 127;
      gemm_core(acc, A + (size_t)(b * KPB + CTXL + nlo) * D, (size_t)128 * D,
                wsp<u16>(p, O_WF) + (size_t)ct * 128 * D, D, D, smem);
      u16* dst = wsp<u16>(p, O_D1);
#pragma unroll
      for (int i = 0; i < 2; i++)
#pragma unroll
        for (int j = 0; j < 2; j++)
#pragma unroll
          for (int g = 0; g < 4; g++) {
            const int nhi = wm_ * 64 + i * 32 + 8 * g + 4 * hh_;
            const int n = ct * 128 + wn_ * 64 + j * 32 + r_;
            const int reim = n >> 9, jj = n & 511;
            uint2 o;
            o.x = pack2(acc[i][j][4 * g], acc[i][j][4 * g + 1]);
            o.y = pack2(acc[i][j][4 * g + 2], acc[i][j][4 * g + 3]);
            *(uint2*)(dst + ((((size_t)(b * 512 + jj)) * 128 + nlo) * 2 + reim) * 128 + nhi) = o;
          }
    }
  PATCH_LOOP_END
  if (!last) {
    for (int t2 = bid; t2 < 32; t2 += nb) {
      f32x16 acc[2][2];
      zero_acc(acc);
      const int rt = t2 >> 3, ct = t2 & 7;
      const int b = rt >> 1, rb = rt & 1;
      gemm_core(acc, A + (size_t)(b * KPB + rb * 128) * D, D, wsp<u16>(p, O_WF) + (size_t)ct * 128 * D, D, D, smem);
      u16* dst = wsp<u16>(p, O_D1C);
#pragma unroll
      for (int i = 0; i < 2; i++)
#pragma unroll
        for (int j = 0; j < 2; j++)
#pragma unroll
          for (int g = 0; g < 4; g++) {
            const int nc = rb * 128 + wm_ * 64 + i * 32 + 8 * g + 4 * hh_;
            const int n = ct * 128 + wn_ * 64 + j * 32 + r_;
            const int reim = n >> 9, jj = n & 511;
            uint2 o;
            o.x = pack2(acc[i][j][4 * g], acc[i][j][4 * g + 1]);
            o.y = pack2(acc[i][j][4 * g + 2], acc[i][j][4 * g + 3]);
            *(uint2*)(dst + (((size_t)(b * 512 + jj)) * 2 + reim) * 256 + nc) = o;
          }
    }
  }
}

__device__ __forceinline__ float inv_freq(int i) {
  switch (i) {
    case 0: return 1.0f;
    case 1: return 0.31622776601683794f;
    case 2: return 0.1f;
    case 3: return 0.03162277660168379f;
    case 4: return 0.01f;
    case 5: return 0.0031622776601683794f;
    case 6: return 0.001f;
    default: return 0.00031622776601683794f;
  }
}
__device__ __forceinline__ void rope_cs(int kk, int e, float& cs, float& sn) {
  if (kk < CTXL) { cs = 1.f; sn = 0.f; return; }
  const int tkn = kk - CTXL;
  const float pos = (e < 8) ? (float)(tkn >> 6) : (float)(tkn & 63);
  const float ang = pos * inv_freq(e & 7);
  double xr = (double)ang * 0.31830988618379067;
  xr -= 2.0 * floor(xr * 0.5);
  const float yr = (float)xr;
  cs = cospif(yr);
  sn = sinpif(yr);
}

__device__ __forceinline__ void row_rms(const u16* A, size_t lda, int K, float* rs) {
  const int tid = ltid();
  const int row = tid >> 1, half = tid & 1;
  const u16* pr = A + (size_t)row * lda + half * (K >> 1);
  float s = 0.f;
  for (int c = 0; c < (K >> 1); c += 8) {
    uint4 v = *(const uint4*)(pr + c);
    const uint32_t w[4] = {v.x, v.y, v.z, v.w};
#pragma unroll
    for (int q = 0; q < 4; q++) {
      const float a = __uint_as_float(w[q] << 16), bq = __uint_as_float(w[q] & 0xffff0000u);
      s += a * a + bq * bq;
    }
  }
  s += __shfl_xor(s, 1);
  if (half == 0) rs[row] = rsqrtf(s / (float)K + EPS);
  __syncthreads();
}

__device__ void phase_p2(const Params& p, int l, int bid, int nb, u16* smem) {
  EPI_DECL
  const u16* LAT = wsp<u16>(p, O_LAT);
  float* rs = (float*)(smem + 4 * SM_A);
  const int nQ = NRT * 6, nKV = NRT * 8, nFA = 1024 * 2, nKR = NRT;
  const int total = nQ + nKV + nFA + nKR;
  for (int t = bid; t < total; t += nb) {
    if (t < nQ) {
      const int rt = t / 6, ct = t - rt * 6;
      const int row0 = rt * 128, b = row0 / KPB, kk0 = row0 - b * KPB;
      row_rms(LAT + (size_t)row0 * 512, 512, 256, rs);
      f32x16 acc[2][2];
      zero_acc(acc);
      gemm_core(acc, wsp<u16>(p, O_WUQ) + (size_t)ct * 128 * 256, 256, LAT + (size_t)row0 * 512, 512, 256, smem);
      u16* QM = wsp<u16>(p, O_QM);
      if (ct < 4) {
#pragma unroll
        for (int i = 0; i < 2; i++)
#pragma unroll
          for (int j = 0; j < 2; j++)
#pragma unroll
            for (int g = 0; g < 4; g++) {
              const int rl = wn_ * 64 + j * 32 + r_;
              const int col = ct * 128 + wm_ * 64 + i * 32 + 8 * g + 4 * hh_;
              const int h = col >> 6, d = col & 63;
              const float sc = rs[rl] * MLA_SCALE_L2;
              uint2 o;
              o.x = pack2(acc[i][j][4 * g] * sc, acc[i][j][4 * g + 1] * sc);
              o.y = pack2(acc[i][j][4 * g + 2] * sc, acc[i][j][4 * g + 3] * sc);
              *(uint2*)(QM + (size_t)(row0 + rl) * 768 + h * 96 + d) = o;
            }
      } else {
        const int wt = (ct - 4) * 2 + wm_;
#pragma unroll
        for (int j = 0; j < 2; j++) {
          const int rl = wn_ * 64 + j * 32 + r_;
          const float sc = rs[rl] * MLA_SCALE_L2;
#pragma unroll
          for (int g = 0; g < 4; g++) {
            const int idx = wt * 32 + 8 * g + 4 * hh_;
            const int h = idx >> 4, e16 = idx & 15;
            float o1[4], o2[4];
#pragma unroll
            for (int q = 0; q < 4; q++) {
              float cs, sn;
              rope_cs(kk0 + rl, e16 + q, cs, sn);
              const float x1 = acc[0][j][4 * g + q] * sc, x2 = acc[1][j][4 * g + q] * sc;
              o1[q] = x1 * cs - x2 * sn;
              o2[q] = x2 * cs + x1 * sn;
            }
            u16* qd = QM + (size_t)(row0 + rl) * 768 + h * 96 + 64 + e16;
            uint2 o;
            o.x = pack2(o1[0], o1[1]);
            o.y = pack2(o1[2], o1[3]);
            *(uint2*)qd = o;
            o.x = pack2(o2[0], o2[1]);
            o.y = pack2(o2[2], o2[3]);
            *(uint2*)(qd + 16) = o;
          }
        }
      }
      __syncthreads();
    } else if (t < nQ + nKV) {
      const int t2 = t - nQ;
      const int rt = t2 >> 3, ct = t2 & 7;
      const int row0 = rt * 128, b = row0 / KPB, kk0 = row0 - b * KPB;
      row_rms(LAT + (size_t)row0 * 512 + 256, 512, 128, rs);
      f32x16 acc[2][2];
      zero_acc(acc);
      if (ct < 4) {
        gemm_core(acc, wsp<u16>(p, O_WUKV) + (size_t)ct * 128 * 128, 128, LAT + (size_t)row0 * 512 + 256, 512, 128,
                  smem);
        u16* KN = wsp<u16>(p, O_KN);
#pragma unroll
        for (int i = 0; i < 2; i++)
#pragma unroll
          for (int j = 0; j < 2; j++)
#pragma unroll
            for (int g = 0; g < 4; g++) {
              const int rl = wn_ * 64 + j * 32 + r_;
              const int col = ct * 128 + wm_ * 64 + i * 32 + 8 * g + 4 * hh_;
              const float sc = rs[rl];
              uint2 o;
              o.x = pack2(acc[i][j][4 * g] * sc, acc[i][j][4 * g + 1] * sc);
              o.y = pack2(acc[i][j][4 * g + 2] * sc, acc[i][j][4 * g + 3] * sc);
              *(uint2*)(KN + (size_t)(row0 + rl) * 512 + col) = o;
            }
      } else {
        gemm_core(acc, LAT + (size_t)row0 * 512 + 256, 512, wsp<u16>(p, O_WUKV) + (size_t)ct * 128 * 128, 128, 128,
                  smem);
        u16* VMT = wsp<u16>(p, O_VMT);
#pragma unroll
        for (int i = 0; i < 2; i++)
#pragma unroll
          for (int j = 0; j < 2; j++)
#pragma unroll
            for (int g = 0; g < 4; g++) {
              const int rl = wm_ * 64 + i * 32 + 8 * g + 4 * hh_;
              const int col = (ct - 4) * 128 + wn_ * 64 + j * 32 + r_;
              uint2 o;
              o.x = pack2(acc[i][j][4 * g] * rs[rl], acc[i][j][4 * g + 1] * rs[rl + 1]);
              o.y = pack2(acc[i][j][4 * g + 2] * rs[rl + 2], acc[i][j][4 * g + 3] * rs[rl + 3]);
              *(uint2*)(VMT + ((size_t)(b * 512 + col)) * KPB + kk0 + rl) = o;
            }
      }
      __syncthreads();
    } else if (t < nQ + nKV + nFA) {
      const int t2 = t - nQ - nKV;
      const int rt = t2 >> 1, ct = t2 & 1;
      const int b = rt >> 9, jj = rt & 511;
      f32x16 acc[2][2];
      zero_acc(acc);
      gemm_core(acc, wsp<u16>(p, O_D1) + (size_t)rt * 128 * 256, 256, wsp<u16>(p, O_MA) + (size_t)ct * 128 * 256, 256,
                256, smem);
      const float* TW = wsp<float>(p, O_TW);
      u16* D2 = wsp<u16>(p, O_D2);
      const int klo = ct * 64 + wn_ * 32 + r_;
#pragma unroll
      for (int i = 0; i < 2; i++)
#pragma unroll
        for (int g = 0; g < 4; g++) {
          const int nlo = wm_ * 64 + i * 32 + 8 * g + 4 * hh_;
          float re[4], im[4];
#pragma unroll
          for (int q = 0; q < 4; q++) {
            const float2 tw = *(const float2*)(TW + ((size_t)klo * 128 + nlo + q) * 2);
            const float ar = acc[i][0][4 * g + q], ai = acc[i][1][4 * g + q];
            re[q] = ar * tw.x + ai * tw.y;
            im[q] = ai * tw.x - ar * tw.y;
          }
          u16* d = D2 + ((((size_t)(b * 128 + klo)) * 512 + jj) * 2) * 128 + nlo;
          uint2 o;
          o.x = pack2(re[0], re[1]);
          o.y = pack2(re[2], re[3]);
          *(uint2*)d = o;
          o.x = pack2(im[0], im[1]);
          o.y = pack2(im[2], im[3]);
          *(uint2*)(d + 128) = o;
        }
    } else {
      const int rt = t - nQ - nKV - nFA;
      u16* KRR = wsp<u16>(p, O_KRR);
      for (int idx = ltid(); idx < 128 * 16; idx += 256) {
        const int rl = idx >> 4, e16 = idx & 15;
        const int row = rt * 128 + rl, b = row / KPB, kk = row - b * KPB;
        const float x1 = bf2f(LAT[(size_t)row * 512 + 384 + e16]), x2 = bf2f(LAT[(size_t)row * 512 + 400 + e16]);
        float cs, sn;
        rope_cs(kk, e16, cs, sn);
        KRR[(size_t)row * 32 + e16] = f2bf(x1 * cs - x2 * sn);
        KRR[(size_t)row * 32 + 16 + e16] = f2bf(x2 * cs + x1 * sn);
      }
    }
  }
}

template <int MODE>
__device__ void attn_item(const Params& p, int l, int b, int h, int q0  ,
                          int ntiles, int rs0, int ycol, u16* smem) {
  constexpr int DQK = MODE == 0 ? 96 : 64;
  constexpr int KSTR = DQK + 8;
  constexpr int NKS = DQK / 16;
  constexpr int CPR = DQK / 8;
  constexpr int NKC = 64 * CPR / 256;
  const int tid = ltid(), lane = tid & 63, wave = tid >> 6, r = lane & 31, hh = lane >> 5;
  u16* Ks = smem;
  u16* Vs = smem + 2 * 64 * KSTR;
  const u16* Kg = MODE == 0 ? wsp<u16>(p, O_KN) : wsp<u16>(p, O_KNA);
  const u16* Kr = wsp<u16>(p, O_KRR);
  const u16* Vg = (MODE == 0 ? wsp<u16>(p, O_VMT) : wsp<u16>(p, O_VNAT)) + (size_t)(b * 512 + h * 64) * KPB;
  const int qk = q0 + wave * 32 + r;
  const size_t qrow = (size_t)b * KPB + qk;
  bf16x8 qf[NKS];
  {
    const u16* qp = MODE == 0 ? wsp<u16>(p, O_QM) + qrow * 768 + h * 96 : wsp<u16>(p, O_QNA) + qrow * 512 + h * 64;
#pragma unroll
    for (int ks = 0; ks < NKS; ks++) qf[ks] = *(const bf16x8*)(qp + ks * 16 + hh * 8);
  }
  int qr = 0, qc = 0, rsq = 0, cs = 0;
  const float* rpb = nullptr;
  if (MODE == 1 && rs0 >= 0) {
    const int tkn = qk - CTXL;
    qr = tkn >> 6;
    qc = tkn & 63;
    rsq = min(max(qr - 4, 0), 248);
    cs = min(max(qc - 8, 0), 48);
    rpb = p.rpb + ((size_t)(l * 8 + h)) * 15 * 31;
  }
  f32x16 o[2], ol;
#pragma unroll
  for (int e = 0; e < 16; e++) { o[0][e] = 0.f; o[1][e] = 0.f; ol[e] = 0.f; }
  float m = -1e30f;
  const bf16x8 ones = {(short)0x3F80, (short)0x3F80, (short)0x3F80, (short)0x3F80,
                       (short)0x3F80, (short)0x3F80, (short)0x3F80, (short)0x3F80};

  u32x4 kr0A, kr1A, kr2A, vr0A, vr1A, kr0B, kr1B, kr2B, vr0B, vr1B;
  kr2A = kr1A = kr0A = vr0A = vr1A = kr2B = kr1B = kr0B = vr0B = vr1B = (u32x4){0u, 0u, 0u, 0u};
#define TILE_KK0(t) ((MODE == 1 && (t) >= 4) ? (CTXL + 64 * min(rs0 + (t)-4, 255)) : 64 * (t))
#define LOAD_K1(i, dstv)                                                             \
  {                                                                                  \
    const int c = tid + 256 * (i);                                                   \
    const int row = c / CPR, cc = c - row * CPR;                                     \
    const size_t grow = (size_t)b * KPB + kk0_ + row;                                \
    const u16* src_ = (MODE == 0 && cc >= 8) ? (Kr + grow * 32 + (cc - 8) * 8) : (Kg + grow * 512 + h * 64 + cc * 8); \
    dstv = *(const u32x4*)src_;                                                      \
  }
#define LOAD_V1(i, dstv)                                                             \
  {                                                                                  \
    const int c = tid + 256 * (i);                                                   \
    const int d = c >> 3, cc = c & 7;                                                \
    dstv = *(const u32x4*)(Vg + (size_t)d * KPB + kk0_ + cc * 8);                    \
  }
#define LOAD_K(t, S)                                                                 \
  {                                                                                  \
    const int kk0_ = TILE_KK0(t);                                                    \
    LOAD_K1(0, kr0##S) LOAD_K1(1, kr1##S) if (NKC == 3) LOAD_K1(2, kr2##S)            \
  }
#define LOAD_V(t, S)                                                                 \
  {                                                                                  \
    const int kk0_ = TILE_KK0(t);                                                    \
    LOAD_V1(0, vr0##S) LOAD_V1(1, vr1##S)                                            \
  }
#define STORE_K1(buf, i, srcv)                                                       \
  {                                                                                  \
    const int c = tid + 256 * (i);                                                   \
    const int row = c / CPR, cc = c - row * CPR;                                     \
    *(u32x4*)(Ks + (buf)*64 * KSTR + row * KSTR + cc * 8) = srcv;                    \
  }
#define STORE_V1(buf, i, srcv)                                                       \
  {                                                                                  \
    const int c = tid + 256 * (i);                                                   \
    const int d = c >> 3, cc = c & 7;                                                \
    u32x4 sv_ = srcv;                                                                \
    if (d & 8) sv_ = (u32x4){sv_[2], sv_[3], sv_[0], sv_[1]};                        \
    *(u32x4*)(Vs + (buf)*64 * 72 + d * 72 + cc * 8) = sv_;                           \
  }
#define STORE_K(buf, S) { STORE_K1(buf, 0, kr0##S) STORE_K1(buf, 1, kr1##S) if (NKC == 3) STORE_K1(buf, 2, kr2##S) }
#define STORE_V(buf, S) { STORE_V1(buf, 0, vr0##S) STORE_V1(buf, 1, vr1##S) }
#define QK_TILE(sdst, kbuf, t)                                                                     \
  {                                                                                                \
    _Pragma("unroll") for (int e = 0; e < 16; e++) { sdst[0][e] = 0.f; sdst[1][e] = 0.f; }         \
    const u16* kb_ = Ks + (kbuf)*64 * KSTR + r * KSTR + hh * 8;                                    \
    _Pragma("unroll") for (int ks = 0; ks < NKS; ks++) {                                           \
      const bf16x8 kf0 = *(const bf16x8*)(kb_ + ks * 16);                                          \
      const bf16x8 kf1 = *(const bf16x8*)(kb_ + 32 * KSTR + ks * 16);                              \
      sdst[0] = __builtin_amdgcn_mfma_f32_32x32x16_bf16(kf0, qf[ks], sdst[0], 0, 0, 0);            \
      sdst[1] = __builtin_amdgcn_mfma_f32_32x32x16_bf16(kf1, qf[ks], sdst[1], 0, 0, 0);            \
    }                                                                                              \
    if (MODE == 1 && (t) >= 4) {                                                                   \
      const int kr_ = rs0 + (t)-4;                                                                 \
      const bool rowok = (kr_ >= rsq) && (kr_ < rsq + 8);                                          \
      const float* rp = rpb + (kr_ - qr + 7) * 31 + (15 - qc);                                     \
      _Pragma("unroll") for (int kb = 0; kb < 2; kb++) _Pragma("unroll") for (int e = 0; e < 16; e++) { \
        const int kc = kb * 32 + (e & 3) + 8 * (e >> 2) + 4 * hh;                                  \
        const bool valid = rowok && (kc >= cs) && (kc < cs + 16);                                  \
        float bias = 0.f;                                                                          \
        if (valid) bias = rp[kc];                                                                  \
        sdst[kb][e] = valid ? sdst[kb][e] + bias * LOG2E : -1e30f;                                 \
      }                                                                                            \
    }                                                                                              \
  }
#define SOFTMAX_PV(vbuf)                                                                           \
  {                                                                                                \
    float tmax = sc[0][0];                                                                         \
    _Pragma("unroll") for (int e = 1; e < 16; e++) tmax = fmaxf(tmax, sc[0][e]);                   \
    _Pragma("unroll") for (int e = 0; e < 16; e++) tmax = fmaxf(tmax, sc[1][e]);                   \
    {                                                                                              \
      const uint32_t tu = __float_as_uint(tmax);                                                   \
      const auto sw = __builtin_amdgcn_permlane32_swap(tu, tu, false, false);                      \
      tmax = fmaxf(__uint_as_float(sw[0]), __uint_as_float(sw[1]));                                \
    }                                                                                              \
             \
    if (__any(tmax > m + 8.f)) {                                                                   \
      const float mnew = fmaxf(m, tmax);                                                           \
      const float alpha = __builtin_amdgcn_exp2f(m - mnew);                                        \
      m = mnew;                                                                                    \
      _Pragma("unroll") for (int e = 0; e < 16; e++) { o[0][e] *= alpha; o[1][e] *= alpha; ol[e] *= alpha; } \
    }                                                                                              \
    const u16* vb_ = Vs + (vbuf)*64 * 72 + r * 72 + vsw;                                           \
    _Pragma("unroll") for (int kb = 0; kb < 2; kb++) _Pragma("unroll") for (int st = 0; st < 2; st++) { \
      u32x4 pu;                                                                                    \
      _Pragma("unroll") for (int q = 0; q < 4; q++)                                                \
        pu[q] = pack2(__builtin_amdgcn_exp2f(sc[kb][8 * st + 2 * q] - m),                          \
                      __builtin_amdgcn_exp2f(sc[kb][8 * st + 2 * q + 1] - m));                     \
      const bf16x8 pbv = __builtin_bit_cast(bf16x8, pu);                                           \
      _Pragma("unroll") for (int db = 0; db < 2; db++) {                                           \
        const u16* vp = vb_ + db * 32 * 72 + kb * 32 + 16 * st;                                    \
        const bf16x4 vlo = *(const bf16x4*)(vp);                                                   \
        const bf16x4 vhi = *(const bf16x4*)(vp + 8);                                               \
        const bf16x8 vfv = __builtin_shufflevector(vlo, vhi, 0, 1, 2, 3, 4, 5, 6, 7);              \
        o[db] = __builtin_amdgcn_mfma_f32_32x32x16_bf16(vfv, pbv, o[db], 0, 0, 0);                 \
      }                                                                                            \
      ol = __builtin_amdgcn_mfma_f32_32x32x16_bf16(ones, pbv, ol, 0, 0, 0);                        \
    }                                                                                              \
  }
#define ATT_STEP(t, LD, ST)                                        \
  {                                                                \
    const int cur = (t)&1;                                         \
    LOAD_K(min((t) + 3, tl), LD)                                   \
    LOAD_V(min((t) + 2, tl), LD)                                   \
    __builtin_amdgcn_sched_barrier(0);                             \
    if ((t) + 1 < ntiles) QK_TILE(sn, cur ^ 1, (t) + 1)            \
    SOFTMAX_PV(cur)                                                \
    STORE_K(cur, ST)                                               \
    STORE_V(cur ^ 1, ST)                                           \
    __syncthreads();                                               \
    sc[0] = sn[0];                                                 \
    sc[1] = sn[1];                                                 \
  }

  const int tl = ntiles - 1;
  LOAD_K(0, A)
  LOAD_V(0, A)
  STORE_K(0, A)
  STORE_V(0, A)
  LOAD_K(min(1, tl), A)
  STORE_K(1, A)
  LOAD_K(min(2, tl), A)
  LOAD_V(min(1, tl), A)
  __syncthreads();
  f32x16 sc[2], sn[2];
  QK_TILE(sc, 0, 0)
#pragma unroll
  for (int e = 0; e < 16; e++) { sn[0][e] = 0.f; sn[1][e] = 0.f; }
  const int vsw = 4 * (hh ^ ((r >> 3) & 1));
  __syncthreads();
  for (int t = 0; t < ntiles; t += 2) {
    ATT_STEP(t, B, A)
    ATT_STEP(t + 1, A, B)
  }
  const float inv = 1.f / ol[0];
  u16* yp = wsp<u16>(p, O_Y) + qrow * 1536 + ycol + h * 64;
#pragma unroll
  for (int db = 0; db < 2; db++)
#pragma unroll
    for (int g = 0; g < 4; g++) {
      uint2 ov;
      ov.x = pack2(o[db][4 * g] * inv, o[db][4 * g + 1] * inv);
      ov.y = pack2(o[db][4 * g + 2] * inv, o[db][4 * g + 3] * inv);
      *(uint2*)(yp + db * 32 + 8 * g + 4 * hh) = ov;
    }
#undef TILE_KK0
#undef LOAD_K1
#undef LOAD_V1
#undef LOAD_K
#undef LOAD_V
#undef STORE_K1
#undef STORE_V1
#undef STORE_K
#undef STORE_V
#undef QK_TILE
#undef SOFTMAX_PV
#undef ATT_STEP
}

__device__ void phase_p3(const Params& p, int l, bool last, int bid, int nb, u16* smem) {
  EPI_DECL
  const int nMLA = 2048, nNA = 2048, nFB = 1024;
  const int nC = last ? 0 : (32 + 32 + 16);
  const int total = nMLA + nNA + nFB + nC;
  for (int t = bid; t < total; t += nb) {
    int kind, b = 0, h = 0, q0 = 0, ntl = 0, rs0 = -1;
    size_t aoff = 0, boff = 0;
    int Kf = 256, j0 = 0, tok0 = 0, tokmul = 1, colbase = 0;
    if (t < nMLA) {
      kind = 0;
      h = t & 7;
      const int rest = t >> 3;
      b = rest >> 7;
      q0 = CTXL + (rest & 127) * 128;
      ntl = 260;
    } else if (t < nMLA + nNA) {
      kind = 1;
      const int t2 = t - nMLA;
      h = t2 & 7;
      const int rest = t2 >> 3, rp = rest & 127;
      b = rest >> 7;
      rs0 = min(max(2 * rp - 4, 0), 248);
      const int rs1 = min(max(2 * rp + 1 - 4, 0), 248);
      q0 = CTXL + rp * 128;
      ntl = (4 + (rs1 + 8 - rs0) + 1) & ~1;
    } else if (t < nMLA + nNA + nFB) {
      kind = 2;
      const int rt = t - nMLA - nNA;
      const int bk = rt >> 2;
      j0 = (rt & 3) * 128;
      b = bk >> 7;
      tok0 = CTXL + (bk & 127);
      tokmul = 128;
      aoff = O_D2 + (size_t)rt * 128 * 256 * 2;
      boff = O_MB;
      Kf = 256;
    } else {
      const int t2 = t - nMLA - nNA - nFB;
      if (t2 < 64) {
        kind = t2 >> 5;
        const int t3 = t2 & 31;
        h = t3 & 7;
        b = (t3 >> 3) & 1;
        q0 = (t3 >> 4) * 128;
        ntl = 4;
      } else {
        kind = 2;
        const int t3 = t2 - 64;
        const int rt = t3 >> 1, ct = t3 & 1;
        b = rt >> 2;
        j0 = (rt & 3) * 128;
        colbase = ct * 128;
        aoff = O_D1C + (size_t)rt * 128 * 512 * 2;
        boff = O_MC + (size_t)ct * 128 * 512 * 2;
        Kf = 512;
      }
    }
    if (kind == 0) {
      attn_item<0>(p, l, b, h, q0, ntl, -1, 1024, smem);
    } else if (kind == 1) {
      attn_item<1>(p, l, b, h, q0, ntl, rs0, 512, smem);
    } else {
      f32x16 acc[2][2];
      zero_acc(acc);
      gemm_core(acc, wsp<u16>(p, aoff), Kf, wsp<u16>(p, boff), Kf, Kf, smem);
      u16* Y = wsp<u16>(p, O_Y);
#pragma unroll
      for (int i = 0; i < 2; i++)
#pragma unroll
        for (int j = 0; j < 2; j++)
#pragma unroll
          for (int g = 0; g < 4; g++) {
            const int jj = j0 + wm_ * 64 + i * 32 + 8 * g + 4 * hh_;
            const int tok = tok0 + (colbase + wn_ * 64 + j * 32 + r_) * tokmul;
            uint2 ov;
            ov.x = pack2(acc[i][j][4 * g], acc[i][j][4 * g + 1]);
            ov.y = pack2(acc[i][j][4 * g + 2], acc[i][j][4 * g + 3]);
            *(uint2*)(Y + ((size_t)b * KPB + tok) * 1536 + jj) = ov;
          }
    }
  }
}

__device__ __forceinline__ int n_row_tiles(bool last) { return last ? NRT - 4 : NRT; }
__device__ __forceinline__ int row_tile(bool last, int i) {
  if (!last) return i;
  return i < 128 ? i + 2 : i + 4;
}

__device__ void phase_p4(const Params& p, int l, bool last, int bid, int nb, u16* smem) {
  EPI_DECL
  const u16* A = wsp<u16>(p, O_A);
  const u16* Y = wsp<u16>(p, O_Y);
  u16* M = wsp<u16>(p, O_M);
  uint4* stash = wsp<uint4>(p, O_QM) + (size_t)bid * 24 * 256 + ltid();
  const int nrt_ = n_row_tiles(last);
  PATCH_LOOP_BEGIN(nrt_, 8, 8, 8)
    const int rt = row_tile(last, prt), ct = pct;
#pragma unroll 1
    for (int g = 0; g < 3; g++) {
      f32x16 acc[2][2];
      zero_acc(acc);
      gemm_core<true>(acc, wsp<u16>(p, O_WG) + (size_t)(g * 1024 + ct * 128) * D, D, A + (size_t)rt * 128 * D, D, D,
                      smem);
#pragma unroll
      for (int i = 0; i < 2; i++)
#pragma unroll
        for (int j = 0; j < 2; j++)
#pragma unroll
          for (int e = 0; e < 2; e++) {
            uint4 gq4;
            gq4.x = pack2(fsigmoid(acc[i][j][8 * e]), fsigmoid(acc[i][j][8 * e + 1]));
            gq4.y = pack2(fsigmoid(acc[i][j][8 * e + 2]), fsigmoid(acc[i][j][8 * e + 3]));
            gq4.z = pack2(fsigmoid(acc[i][j][8 * e + 4]), fsigmoid(acc[i][j][8 * e + 5]));
            gq4.w = pack2(fsigmoid(acc[i][j][8 * e + 6]), fsigmoid(acc[i][j][8 * e + 7]));
            stash[(g * 8 + (i * 2 + j) * 2 + e) * 256] = gq4;
          }
    }
    f32x16 mg[2][2];
    zero_acc(mg);
#pragma unroll 1
    for (int g = 0; g < 3; g++) {
      f32x16 acc[2][2];
      zero_acc(acc);
      gemm_core<false>(acc, wsp<u16>(p, O_WB) + (size_t)(g * 1024 + ct * 128) * 512, 512,
                       Y + (size_t)rt * 128 * 1536 + g * 512, 1536, 512, smem);
#pragma unroll
      for (int i = 0; i < 2; i++)
#pragma unroll
        for (int j = 0; j < 2; j++)
#pragma unroll
          for (int e = 0; e < 2; e++) {
            const uint4 gq4 = stash[(g * 8 + (i * 2 + j) * 2 + e) * 256];
            const uint32_t gw[4] = {gq4.x, gq4.y, gq4.z, gq4.w};
#pragma unroll
            for (int q = 0; q < 4; q++) {
              mg[i][j][8 * e + 2 * q] += __uint_as_float(gw[q] << 16) * acc[i][j][8 * e + 2 * q];
              mg[i][j][8 * e + 2 * q + 1] += __uint_as_float(gw[q] & 0xffff0000u) * acc[i][j][8 * e + 2 * q + 1];
            }
          }
    }
#pragma unroll
    for (int i = 0; i < 2; i++)
#pragma unroll
      for (int j = 0; j < 2; j++)
#pragma unroll
        for (int g = 0; g < 4; g++) {
          const int row = rt * 128 + wn_ * 64 + j * 32 + r_;
          const int col = ct * 128 + wm_ * 64 + i * 32 + 8 * g + 4 * hh_;
          uint2 o;
          o.x = pack2(mg[i][j][4 * g], mg[i][j][4 * g + 1]);
          o.y = pack2(mg[i][j][4 * g + 2], mg[i][j][4 * g + 3]);
          *(uint2*)(M + (size_t)row * D + col) = o;
        }
  PATCH_LOOP_END
}

__device__ void phase_resid(const Params& p, int l, bool last, const u16* Ain, size_t lda, const u16* W, int K, int goff,
                            int bid, int nb, u16* smem) {
  EPI_DECL
  const float* mod = wsp<float>(p, O_MOD);
  const int nrt_ = n_row_tiles(last);
  PATCH_LOOP_BEGIN(nrt_, 8, 8, 8)
    const int rt = row_tile(last, prt), ct = pct;
    f32x16 acc[2][2];
    zero_acc(acc);
    gemm_core(acc, W + (size_t)ct * 128 * K, K, Ain + (size_t)rt * 128 * lda, lda, K, smem);
    const int row0 = rt * 128, b = row0 / KPB, kk0 = row0 - b * KPB;
    const int m = kk0 < CTXL ? 2 : b;
    float* xb = xrow(p, row0);
    const float* gv = mod + ((size_t)l * 3 + m) * 6144 + goff;
#pragma unroll
    for (int i = 0; i < 2; i++)
#pragma unroll
      for (int g = 0; g < 4; g++) {
        const int col = ct * 128 + wm_ * 64 + i * 32 + 8 * g + 4 * hh_;
        const float4 g4 = *(const float4*)(gv + col);
#pragma unroll
        for (int j = 0; j < 2; j++) {
          const int rl = wn_ * 64 + j * 32 + r_;
          float4* xp = (float4*)(xb + (size_t)rl * D + col);
          float4 xv = *xp;
          xv.x = ALPHA * xv.x + (1.f + g4.x) * acc[i][j][4 * g];
          xv.y = ALPHA * xv.y + (1.f + g4.y) * acc[i][j][4 * g + 1];
          xv.z = ALPHA * xv.z + (1.f + g4.z) * acc[i][j][4 * g + 2];
          xv.w = ALPHA * xv.w + (1.f + g4.w) * acc[i][j][4 * g + 3];
          *xp = xv;
        }
      }
  PATCH_LOOP_END
}

__device__ void phase_p7(const Params& p, int l, bool last, int bid, int nb, u16* smem) {
  EPI_DECL
  const u16* A = wsp<u16>(p, O_A);
  u16* HH = wsp<u16>(p, O_HH);
  const int nrt_ = n_row_tiles(last);
  PATCH_LOOP_BEGIN(nrt_, 44, 16, 4)
    const int rt = row_tile(last, prt), ct = pct;
    f32x16 acc[2][2];
    zero_acc(acc);
    gemm_core(acc, wsp<u16>(p, O_WGU) + (size_t)ct * 128 * D, D, A + (size_t)rt * 128 * D, D, D, smem);
#pragma unroll
    for (int j = 0; j < 2; j++)
#pragma unroll
      for (int g = 0; g < 4; g++) {
        const int row = rt * 128 + wn_ * 64 + j * 32 + r_;
        const int q = (ct * 2 + wm_) * 32 + 8 * g + 4 * hh_;
        float hv[4];
#pragma unroll
        for (int t = 0; t < 4; t++) {
          const float gt = acc[0][j][4 * g + t], up = acc[1][j][4 * g + t];
          hv[t] = gt * fsigmoid(gt) * up;
        }
        uint2 o;
        o.x = pack2(hv[0], hv[1]);
        o.y = pack2(hv[2], hv[3]);
        *(uint2*)(HH + (size_t)row * FH + q) = o;
      }
  PATCH_LOOP_END
}

constexpr int NPHASE = 3 + 9 * 2;

__device__ void run_phase(const Params& p, int ph, int bid, int nb, u16* smem) {
  if (ph == 0) {
    prep_tables(p, bid, nb);
    prep_modp(p, bid, nb);
    prep_weights(p, 0, bid, nb, smem);
    return;
  }
  if (ph == 1) { prep_modr(p, bid, nb); return; }
  if (ph == 2) { ln_phase(p, 0, p.ln_in_g, p.ln_in_b, 0, 0, 1024, false, bid, nb); return; }
  const int l = (ph - 3) / 9, s = (ph - 3) % 9;
  const bool last = (l == 1);
  switch (s) {
    case 0: phase_p1(p, l, last, bid, nb, smem); break;
    case 1: phase_p2(p, l, bid, nb, smem); break;
    case 2: phase_p3(p, l, last, bid, nb, smem); break;
    case 3: phase_p4(p, l, last, bid, nb, smem); break;
    case 4: phase_resid(p, l, last, wsp<u16>(p, O_M), D, wsp<u16>(p, O_WO), D, 2048, bid, nb, smem); break;
    case 5: ln_phase(p, 1, p.ln1_g + l * D, p.ln1_b + l * D, l, 3072, 4096, last, bid, nb); break;
    case 6: phase_p7(p, l, last, bid, nb, smem); break;
    case 7: phase_resid(p, l, last, wsp<u16>(p, O_HH), FH, wsp<u16>(p, O_WD), FH, 5120, bid, nb, smem); break;
    default:
      ln_phase(p, 1, p.ln2_g + l * D, p.ln2_b + l * D, last ? -1 : l + 1, 0, 1024, last, bid, nb);
      if (!last) prep_weights(p, l + 1, bid, nb, smem);
      break;
  }
}


#define XB_TMO      128
#define XB_XCNT(j)  (256  + 64 * (j))
#define XB_XSUB(j)  (1280 + 64 * (j))
#define XB_XGEN(j)  (2304 + 64 * (j))
#define XB_TOP      3328
#define XB_TOPGEN   3392
#define XCD_BAR_WORDS 3456
#define XB_SPIN_CAP (1u << 20)
#define LAS __attribute__((address_space(3)))
__device__ __forceinline__ unsigned xb_ld(unsigned* p) { return __hip_atomic_load(p, __ATOMIC_RELAXED, __HIP_MEMORY_SCOPE_AGENT); }
__device__ __forceinline__ unsigned xb_add(unsigned* p, unsigned v) { return __hip_atomic_fetch_add(p, v, __ATOMIC_RELAXED, __HIP_MEMORY_SCOPE_AGENT); }
__device__ __forceinline__ unsigned xb_xcc_id() { return (unsigned)__builtin_amdgcn_s_getreg((3 << 11) | 20) & 0xFu; }
#define XB_SPIN(cond, bar) do { unsigned _sp = 0; while (cond) { __builtin_amdgcn_s_sleep(1); \
    if ((++_sp & 255u) == 0u) { if (xb_ld(&(bar)[XB_TMO])) break; if (_sp > XB_SPIN_CAP) { atomicAdd(&(bar)[XB_TMO], 1u); break; } } } } while (0)
struct XcdBarrier {
  unsigned* bar; unsigned x;
  volatile LAS unsigned* st;
};
__device__ __forceinline__ XcdBarrier xcd_barrier_post(unsigned* bar, volatile LAS unsigned* st) {
  XcdBarrier b; b.bar = bar; b.x = xb_xcc_id(); b.st = st;
  if (threadIdx.x == 0) (void)xb_add(&bar[XB_XCNT(b.x)], 1u);
  return b;
}
__device__ __forceinline__ void xcd_barrier_complete(unsigned* bar, unsigned x, unsigned& nloc, unsigned& nx) {
  const unsigned G = gridDim.x * gridDim.y * gridDim.z;
  unsigned sum, cnt, mine, sp = 0u;
  for (;;) {
    sum = 0u; cnt = 0u; mine = 0u;
#pragma unroll
    for (unsigned j = 0; j < 16; ++j) { const unsigned c = xb_ld(&bar[XB_XCNT(j)]); sum += c; cnt += (c > 0u) ? 1u : 0u; mine = (j == x) ? c : mine; }
    if (sum == G) break;
    __builtin_amdgcn_s_sleep(1);
    if ((++sp & 255u) == 0u) { if (xb_ld(&bar[XB_TMO])) break; if (sp > XB_SPIN_CAP) { atomicAdd(&bar[XB_TMO], 1u); break; } }
  }
  nloc = mine > 0u ? mine : 1u; nx = cnt > 0u ? cnt : 1u;
}
__device__ __forceinline__ void xcd_barrier(const XcdBarrier& b) {
  asm volatile("s_waitcnt vmcnt(0)" ::: "memory");
  __syncthreads();
  if (threadIdx.x == 0) {
    unsigned* bar = b.bar;
    __builtin_amdgcn_s_waitcnt(0);
    unsigned nloc = b.st[0], nx = b.st[1];
    if (nloc == 0u) { xcd_barrier_complete(bar, b.x, nloc, nx); b.st[0] = nloc; b.st[1] = nx; }
    const unsigned old = xb_add(&bar[XB_XSUB(b.x)], 1u);
    const unsigned gen = old / nloc;
    if (old + 1u == (gen + 1u) * nloc) {
      __builtin_amdgcn_fence(__ATOMIC_RELEASE, "agent");
      asm volatile("s_waitcnt vmcnt(0)" ::: "memory");
      const unsigned og = xb_add(&bar[XB_TOP], 1u);
      const unsigned tg = og / nx;
      if (og + 1u == (tg + 1u) * nx) xb_add(&bar[XB_TOPGEN], 1u);
      else XB_SPIN(xb_ld(&bar[XB_TOPGEN]) == tg, bar);
      __builtin_amdgcn_fence(__ATOMIC_ACQUIRE, "agent");
      xb_add(&bar[XB_XGEN(b.x)], 1u);
      asm volatile("s_waitcnt vmcnt(0)" ::: "memory");
    } else {
      XB_SPIN(xb_ld(&bar[XB_XGEN(b.x)]) == gen, bar);
      __builtin_amdgcn_fence(__ATOMIC_ACQUIRE, "agent");
      asm volatile("s_waitcnt vmcnt(0)" ::: "memory");
    }
  }
  __syncthreads();
}

constexpr int SMEM_ELEMS = 4 * SM_A + 256 + 8;

#if COOP
__global__ void __launch_bounds__(256, 2) mega_kernel(Params p) {
  __shared__ __attribute__((aligned(16))) u16 smem[SMEM_ELEMS];
  cg::grid_group grid = cg::this_grid();
  volatile LAS unsigned* st = (volatile LAS unsigned*)(smem + 4 * SM_A + 256);
  if (threadIdx.x == 0) { st[0] = 0u; st[1] = 0u; }
  __syncthreads();
  XcdBarrier xb = xcd_barrier_post((unsigned*)(p.ws + O_BAR), st);
  for (int ph = 0; ph < NPHASE; ph++) {
#ifdef PROBE_MASK
    const int s9 = ph >= 3 ? (ph - 3) % 9 : -1;
    const int nrep = (s9 >= 0 && ((PROBE_MASK >> s9) & 1)) ? 2 : 1;
    for (int rep = 0; rep < nrep; rep++) {
      run_phase(p, ph, blockIdx.x, gridDim.x, smem);
      if (ph == 0) grid.sync();
      else if (ph + 1 < NPHASE || rep + 1 < nrep) xcd_barrier(xb);
    }
#else
    run_phase(p, ph, blockIdx.x, gridDim.x, smem);
    if (ph == 0) grid.sync();
    else if (ph + 1 < NPHASE) xcd_barrier(xb);
#endif
  }
}
#else
__global__ void __launch_bounds__(256, 2) phase_kernel(Params p, int ph) {
  __shared__ __attribute__((aligned(16))) u16 smem[SMEM_ELEMS];
  run_phase(p, ph, blockIdx.x, gridDim.x, smem);
}
#endif

extern "C" void kernel_launch(void* const* d_in, const int* in_sizes, int n_in, void* d_out, int out_size, void* d_ws,
                              size_t ws_size, hipStream_t stream) {
  Params p{};
  const float** f = (const float**)&p;
  for (int i = 0; i < 25; i++) f[i] = (const float*)d_in[i];
  p.out = (float*)d_out;
  p.ws = (unsigned char*)d_ws;
  if (ws_size < O_WSEND) fprintf(stderr, "workspace too small: %zu < %zu\n", ws_size, (size_t)O_WSEND);
#if COOP
  static int grid_blocks = 0;
  if (!grid_blocks) {
    int dev = 0, cus = 0, per_cu = 0;
    hipGetDevice(&dev);
    hipDeviceGetAttribute(&cus, hipDeviceAttributeMultiprocessorCount, dev);
    hipOccupancyMaxActiveBlocksPerMultiprocessor(&per_cu, mega_kernel, 256, 0);
    if (per_cu > 2) per_cu = 2;
    grid_blocks = cus * per_cu;
  }
  (void)hipMemsetAsync(p.ws + O_BAR, 0, 3456 * 4, stream);
  void* args[] = {&p};
  hipError_t e = hipLaunchCooperativeKernel((void*)mega_kernel, dim3(grid_blocks), dim3(256), args, 0, stream);
  if (e != hipSuccess) fprintf(stderr, "cooperative launch failed: %s (grid %d)\n", hipGetErrorString(e), grid_blocks);
#else
  for (int ph = 0; ph < NPHASE; ph++) phase_kernel<<<512, 256, 0, stream>>>(p, ph);
#endif
}
```

```cpp
#include <hip/hip_runtime.h>
#include <hip/hip_cooperative_groups.h>
#include <stdint.h>
#include <cstdio>
namespace cg = cooperative_groups;

#ifndef COOP
#define COOP 1
#endif

typedef __attribute__((ext_vector_type(8))) short bf16x8;
typedef __attribute__((ext_vector_type(4))) short bf16x4;
typedef __attribute__((ext_vector_type(16))) float f32x16;
typedef unsigned short u16;
typedef __attribute__((ext_vector_type(4))) unsigned int u32x4;

constexpr int D = 1024;
constexpr int NBATCH = 2;
constexpr int SEQ = 16384;
constexpr int CTXL = 256;
constexpr int KPB = SEQ + CTXL;
constexpr int T = NBATCH * KPB;
constexpr int NRT = T / 128;
constexpr int FH = 2816;
constexpr int IN_DIM = 5536;
constexpr float LOG2E = 1.4426950408889634f;
constexpr float NA_SCALE_L2 = 0.125f * LOG2E;
constexpr float MLA_SCALE_L2 = 0.10206207261596575f * LOG2E;
constexpr float ALPHA = 1.4142135623730951f;
constexpr float EPS = 1e-5f;
constexpr float RS128 = 0.08838834764831845f;

constexpr size_t al256(size_t x) { return (x + 255) & ~(size_t)255; }
constexpr size_t O_WF = 0;
constexpr size_t O_WP = O_WF + (size_t)1024 * 1024 * 2;
constexpr size_t O_WG = O_WP + (size_t)2048 * 1024 * 2;
constexpr size_t O_WUQ = O_WG + (size_t)3072 * 1024 * 2;
constexpr size_t O_WUKV = O_WUQ + (size_t)768 * 256 * 2;
constexpr size_t O_WB = O_WUKV + (size_t)1024 * 128 * 2;
constexpr size_t O_WO = O_WB + (size_t)3 * 1024 * 512 * 2;
constexpr size_t O_WGU = O_WO + (size_t)1024 * 1024 * 2;
constexpr size_t O_WD = O_WGU + (size_t)5632 * 1024 * 2;
constexpr size_t O_MA = O_WD + (size_t)1024 * 2816 * 2;
constexpr size_t O_MB = O_MA + (size_t)256 * 256 * 2;
constexpr size_t O_MC = O_MB + (size_t)128 * 256 * 2;
constexpr size_t O_TW = O_MC + (size_t)256 * 512 * 2;
constexpr size_t O_MODP = O_TW + (size_t)128 * 128 * 2 * 4;
constexpr size_t O_MOD = O_MODP + (size_t)16 * 2 * 3 * 6144 * 4;
constexpr size_t O_XCTX = O_MOD + (size_t)2 * 3 * 6144 * 4;
constexpr size_t O_D1C = O_XCTX + (size_t)512 * 1024 * 4;
constexpr size_t O_A = O_D1C + (size_t)2 * 512 * 2 * 256 * 2;
constexpr size_t O_RQ = O_A + (size_t)T * 1024 * 2;
constexpr size_t O_QNA = O_RQ;
constexpr size_t O_KNA = O_QNA + (size_t)T * 512 * 2;
constexpr size_t O_VNAT = O_KNA + (size_t)T * 512 * 2;
constexpr size_t O_RY = O_VNAT + (size_t)T * 512 * 2;
constexpr size_t O_Y = O_RY;
constexpr size_t O_D1 = O_RY;
constexpr size_t O_LAT = O_RY + (size_t)67108864;
constexpr size_t O_D2 = O_RY + (size_t)T * 1536 * 2;
constexpr size_t O_QM = O_D2 + (size_t)67108864;
constexpr size_t O_KN = O_QM + (size_t)T * 768 * 2;
constexpr size_t O_KRR = O_KN + (size_t)T * 512 * 2;
constexpr size_t O_VMT = O_KRR + (size_t)T * 32 * 2;
constexpr size_t O_END = O_VMT + (size_t)T * 512 * 2;
constexpr size_t O_BAR = (O_END + 255) & ~(size_t)255;
constexpr size_t O_WSEND = O_BAR + 3456 * 4;
constexpr size_t O_M = O_RQ;
constexpr size_t O_HH = O_RQ;

struct Params {
  const float *x, *c, *ctx, *c_ctx, *ln_in_g, *ln_in_b, *w_mod, *b_mod, *w_in, *gq, *gkv, *w_uq, *w_qr, *w_uk,
      *w_uv, *rpb, *w_branch, *w_out, *ln1_g, *ln1_b, *ln2_g, *ln2_b, *w_gate, *w_up, *w_down;
  float* out;
  unsigned char* ws;
};

__device__ __forceinline__ u16 f2bf(float f) {
  uint32_t u = __float_as_uint(f);
  u += 0x7fffu + ((u >> 16) & 1u);
  return (u16)(u >> 16);
}
typedef __attribute__((ext_vector_type(2))) __bf16 bf16v2;
typedef __attribute__((ext_vector_type(2))) float f32v2;
__device__ __forceinline__ uint32_t pack2(float a, float b) {
  const f32v2 v = {a, b};
  return __builtin_bit_cast(uint32_t, __builtin_convertvector(v, bf16v2));
}
__device__ __forceinline__ float bf2f(u16 v) { return __uint_as_float(((uint32_t)v) << 16); }
__device__ __forceinline__ float wsum(float v) {
#pragma unroll
  for (int o = 32; o > 0; o >>= 1) v += __shfl_xor(v, o);
  return v;
}
__device__ __forceinline__ float fsigmoid(float v) { return 1.f / (1.f + __expf(-v)); }

__device__ __forceinline__ int ltid() {
  int t = threadIdx.x;
  asm volatile("" : "+v"(t));
  return t;
}

template <typename Tp>
__device__ __forceinline__ Tp* wsp(const Params& p, size_t off) { return (Tp*)(p.ws + off); }

__device__ __forceinline__ float* xrow(const Params& p, int row) {
  int b = row / KPB, kk = row - b * KPB;
  if (kk < CTXL) return wsp<float>(p, O_XCTX) + (size_t)(b * CTXL + kk) * D;
  return p.out + (size_t)(b * SEQ + kk - CTXL) * D;
}

constexpr int LSTR = 72;
constexpr int SM_A = 128 * LSTR;

template <bool DEEP = true>
__device__ __forceinline__ void gemm_core(f32x16 (&acc)[2][2], const u16* __restrict__ A, size_t lda,
                                          const u16* __restrict__ B, size_t ldb, int K, u16* smem) {
  const int tid = ltid(), lane = tid & 63, wave = tid >> 6;
  const int wm = wave >> 1, wn = wave & 1, r = lane & 31, hh = lane >> 5;
  u16* sA = smem;
  u16* sB = smem + 2 * SM_A;
  const int lrow = tid >> 3, lkc = (tid & 7) * 8;
  const u16* ga = A + (size_t)lrow * lda + lkc;
  const u16* gb = B + (size_t)lrow * ldb + lkc;
  u16* wa = sA + lrow * LSTR + lkc;
  u16* wb = sB + lrow * LSTR + lkc;
  const u16* pa = sA + (wm * 64 + r) * LSTR + hh * 8;
  const u16* pb = sB + (wn * 64 + r) * LSTR + hh * 8;
  u32x4 a0r[4], b0r[4], a1r[4], b1r[4];
#define G_LOAD(ar, br, ko)                                               \
  _Pragma("unroll") for (int i = 0; i < 4; i++) {                        \
    ar[i] = *(const u32x4*)(ga + (size_t)(32 * i) * lda + (ko));         \
    br[i] = *(const u32x4*)(gb + (size_t)(32 * i) * ldb + (ko));         \
  }
#define G_STORE(ar, br, buf)                                             \
  _Pragma("unroll") for (int i = 0; i < 4; i++) {                        \
    *(u32x4*)(wa + (buf)*SM_A + 32 * i * LSTR) = ar[i];                  \
    *(u32x4*)(wb + (buf)*SM_A + 32 * i * LSTR) = br[i];                  \
  }
#define G_COMPUTE(buf)                                                                   \
  _Pragma("unroll") for (int ks = 0; ks < 4; ks++) {                                     \
    const bf16x8 fa0 = *(const bf16x8*)(pa + (buf)*SM_A + ks * 16);                      \
    const bf16x8 fa1 = *(const bf16x8*)(pa + (buf)*SM_A + 32 * LSTR + ks * 16);          \
    const bf16x8 fb0 = *(const bf16x8*)(pb + (buf)*SM_A + ks * 16);                      \
    const bf16x8 fb1 = *(const bf16x8*)(pb + (buf)*SM_A + 32 * LSTR + ks * 16);          \
    acc[0][0] = __builtin_amdgcn_mfma_f32_32x32x16_bf16(fa0, fb0, acc[0][0], 0, 0, 0);   \
    acc[0][1] = __builtin_amdgcn_mfma_f32_32x32x16_bf16(fa0, fb1, acc[0][1], 0, 0, 0);   \
    acc[1][0] = __builtin_amdgcn_mfma_f32_32x32x16_bf16(fa1, fb0, acc[1][0], 0, 0, 0);   \
    acc[1][1] = __builtin_amdgcn_mfma_f32_32x32x16_bf16(fa1, fb1, acc[1][1], 0, 0, 0);   \
  }
  const int nk = K >> 6;
  if (DEEP) {
    G_LOAD(a0r, b0r, 0)
    G_LOAD(a1r, b1r, 64)
    G_STORE(a0r, b0r, 0)
    __syncthreads();
    const int klast = (nk - 1) * 64;
    G_LOAD(a0r, b0r, min(128, klast))
    for (int kt = 0; kt < nk; kt += 2) {
      G_COMPUTE(0)
      G_STORE(a1r, b1r, 1)
      __syncthreads();
      G_LOAD(a1r, b1r, min((kt + 3) * 64, klast))
      __builtin_amdgcn_sched_barrier(0);
      G_COMPUTE(1)
      G_STORE(a0r, b0r, 0)
      __syncthreads();
      G_LOAD(a0r, b0r, min((kt + 4) * 64, klast))
      __builtin_amdgcn_sched_barrier(0);
    }
  } else {
    G_LOAD(a0r, b0r, 0)
    G_STORE(a0r, b0r, 0)
    __syncthreads();
    for (int kt = 0; kt < nk; kt += 2) {
      G_LOAD(a0r, b0r, (kt + 1) * 64)
      G_COMPUTE(0)
      G_STORE(a0r, b0r, 1)
      __syncthreads();
      if (kt + 2 < nk) G_LOAD(a0r, b0r, (kt + 2) * 64)
      G_COMPUTE(1)
      if (kt + 2 < nk) G_STORE(a0r, b0r, 0)
      __syncthreads();
    }
  }
#undef G_LOAD
#undef G_STORE
#undef G_COMPUTE
}

__device__ __forceinline__ void zero_acc(f32x16 (&acc)[2][2]) {
#pragma unroll
  for (int i = 0; i < 2; i++)
#pragma unroll
    for (int j = 0; j < 2; j++)
#pragma unroll
      for (int e = 0; e < 16; e++) acc[i][j][e] = 0.f;
}

#define EPI_DECL                                                     \
  const int lane_ = ltid() & 63, wave_ = ltid() >> 6;      \
  const int wm_ = wave_ >> 1, wn_ = wave_ & 1, r_ = lane_ & 31, hh_ = lane_ >> 5; \
  (void)wm_; (void)wn_; (void)r_; (void)hh_;

__device__ __forceinline__ const float* src_col(const Params& p, int l, int kind, int n, int& ld) {
  switch (kind) {
    case 0:
      ld = IN_DIM;
      return n < 1952 ? p.w_in + (size_t)l * D * IN_DIM + 512 + n : nullptr;
    case 1:
      ld = IN_DIM;
      return p.w_in + (size_t)l * D * IN_DIM + 2464 + n;
    case 2:
      if (n < 512) {
        ld = 512;
        return p.w_uq + (size_t)l * 256 * 512 + n;
      } else {
        int m = n - 512, wt = m >> 6, jb = (m >> 5) & 1, idx = wt * 32 + (m & 31);
        int h = idx >> 4, e = idx & 15;
        ld = 256;
        return p.w_qr + (size_t)l * 256 * 256 + h * 32 + jb * 16 + e;
      }
    case 3:
      ld = 512;
      return n < 512 ? p.w_uk + (size_t)l * 128 * 512 + n : p.w_uv + (size_t)l * 128 * 512 + (n - 512);
    case 4: {
      int g = n >> 10, nn = n & 1023;
      ld = 1024;
      return p.w_branch + ((size_t)(l * 3 + g) * 512) * 1024 + nn;
    }
    case 5:
      ld = 1024;
      return p.w_out + (size_t)l * D * D + n;
    case 6: {
      int jb = (n >> 5) & 1, q = (n >> 6) * 32 + (n & 31);
      ld = FH;
      return (jb ? p.w_up : p.w_gate) + (size_t)l * D * FH + q;
    }
    default:
      ld = 1024;
      return p.w_down + (size_t)l * FH * D + n;
  }
}

__device__ __forceinline__ int job_nd(int k) {
  switch (k) { case 0: return 2048; case 1: return 3072; case 2: return 768; case 3: return 1024; case 4: return 3072;
    case 5: return 1024; case 6: return 5632; default: return 1024; }
}
__device__ __forceinline__ int job_kd(int k) {
  switch (k) { case 0: return 1024; case 1: return 1024; case 2: return 256; case 3: return 128; case 4: return 512;
    case 5: return 1024; case 6: return 1024; default: return 2816; }
}
__device__ __forceinline__ size_t job_od(int k) {
  switch (k) { case 0: return O_WP; case 1: return O_WG; case 2: return O_WUQ; case 3: return O_WUKV; case 4: return O_WB;
    case 5: return O_WO; case 6: return O_WGU; default: return O_WD; }
}
__device__ void prep_weights(const Params& p, int l, int bid, int nb, u16* smem) {
  float* tile = (float*)smem;
  const int tid = ltid();
  int start = 0;
#pragma unroll 1
  for (int kind = 0; kind < 8; kind++) {
    const int Kk = job_kd(kind);
    const int nkt = Kk >> 6, ntile = (job_nd(kind) >> 6) * nkt;
    u16* dst = wsp<u16>(p, job_od(kind));
    const float* ksc = kind == 2 ? p.gq + l * 256 : (kind == 3 ? p.gkv + l * 128 : nullptr);
    for (int t = (bid + nb - (start % nb)) % nb; t < ntile; t += nb) {
      const int nt = t / nkt, kt = t - nt * nkt;
      const int n0 = nt * 64, k0 = kt * 64;
      {
        const int nn = tid & 63;
        int ld;
        const float* sp = src_col(p, l, kind, n0 + nn, ld);
#pragma unroll 4
        for (int i = 0; i < 16; i++) {
          const int kk = i * 4 + (tid >> 6);
          float v = sp ? sp[(size_t)(k0 + kk) * ld] : 0.f;
          if (ksc) v *= ksc[k0 + kk];
          tile[kk * 65 + nn] = v;
        }
      }
      __syncthreads();
      {
        const int kk = tid & 63;
#pragma unroll 4
        for (int i = 0; i < 16; i++) {
          const int nn = i * 4 + (tid >> 6);
          dst[(size_t)(n0 + nn) * Kk + k0 + kk] = f2bf(tile[kk * 65 + nn]);
        }
      }
      __syncthreads();
    }
    start += ntile;
  }
  {
    float* ctab = (float*)smem;
    __syncthreads();
    if (tid < 128) ctab[tid] = cospif((float)tid * (1.f / 64.f));
    __syncthreads();
    u16* dst = wsp<u16>(p, O_WF);
    for (int it = bid; it < 4096; it += nb) {
      const int o = it * 256 + tid;
      const int np = o & 1023, k = o >> 10;
      const int reim = np >> 9, g = (np >> 7) & 3, m = np & 127;
      const float* w = p.w_in + (size_t)l * D * IN_DIM + (size_t)k * IN_DIM + g * 128;
      const int sh = reim ? 96 : 0;
      float acc = 0.f;
#pragma unroll 8
      for (int c = 0; c < 128; c++) acc += w[c] * ctab[(m * c + sh) & 127];
      dst[(size_t)np * 1024 + k] = f2bf(acc * RS128);
    }
    __syncthreads();
  }
}

__device__ void prep_tables(const Params& p, int bid, int nb) {
  u16* MA = wsp<u16>(p, O_MA);
  u16* MB = wsp<u16>(p, O_MB);
  u16* MC = wsp<u16>(p, O_MC);
  float* TW = wsp<float>(p, O_TW);
  const int total = 65536 + 32768 + 131072 + 16384;
  for (int idx = bid * 256 + ltid(); idx < total; idx += nb * 256) {
    if (idx < 65536) {
      const int n = idx >> 8, k = idx & 255;
      const int nt = n >> 7, wn = (n >> 6) & 1, jb = (n >> 5) & 1, klo = nt * 64 + wn * 32 + (n & 31);
      const int ri = k >> 7, nhi = k & 127;
      const int xx = (klo * nhi) & 127;
      const float c = cospif((float)xx * (1.f / 64.f)), s = sinpif((float)xx * (1.f / 64.f));
      float v = jb == 0 ? (ri == 0 ? c : -s) : (ri == 0 ? -s : -c);
      MA[idx] = f2bf(v * RS128);
    } else if (idx < 65536 + 32768) {
      const int i2 = idx - 65536;
      const int khi = i2 >> 8, k = i2 & 255;
      const int ri = k >> 7, nlo = k & 127;
      const int xx = (khi * nlo) & 127;
      const float c = cospif((float)xx * (1.f / 64.f)), s = sinpif((float)xx * (1.f / 64.f));
      MB[i2] = f2bf((ri == 0 ? c : s) * RS128);
    } else if (idx < 65536 + 32768 + 131072) {
      const int i2 = idx - 65536 - 32768;
      const int kk = i2 >> 9, k = i2 & 511;
      const int ri = k >> 8, nn = k & 255;
      const int xx = (kk * nn) & 255;
      const float c = cospif((float)xx * (1.f / 128.f)), s = sinpif((float)xx * (1.f / 128.f));
      MC[i2] = f2bf((ri == 0 ? c : -s) * 0.0625f);
    } else {
      const int i2 = idx - 65536 - 32768 - 131072;
      const int klo = i2 >> 7, nlo = i2 & 127;
      const int xx = klo * nlo;
      TW[i2 * 2] = cospif((float)xx * (1.f / 8192.f));
      TW[i2 * 2 + 1] = sinpif((float)xx * (1.f / 8192.f));
    }
  }
}

__device__ void prep_modp(const Params& p, int bid, int nb) {
  float* modp = wsp<float>(p, O_MODP);
  for (int it = bid; it < 2 * 16 * 24; it += nb) {
    const int l = it / (16 * 24), rem = it - l * 16 * 24, kc = rem / 24, nblk = rem - kc * 24;
    const int n = nblk * 256 + ltid();
    const float* w = p.w_mod + (size_t)l * D * 6144 + n;
    float a0 = 0.f, a1 = 0.f, a2 = 0.f;
#pragma unroll 8
    for (int kk = 0; kk < 64; kk++) {
      const int k = kc * 64 + kk;
      const float wv = w[(size_t)k * 6144];
      float c0 = p.c[k], c1 = p.c[1024 + k], c2 = p.c_ctx[k];
      c0 = c0 / (1.f + __expf(-c0));
      c1 = c1 / (1.f + __expf(-c1));
      c2 = c2 / (1.f + __expf(-c2));
      a0 += c0 * wv;
      a1 += c1 * wv;
      a2 += c2 * wv;
    }
    float* o = modp + ((size_t)(kc * 2 + l) * 3) * 6144 + n;
    o[0] = a0;
    o[6144] = a1;
    o[2 * 6144] = a2;
  }
}
__device__ void prep_modr(const Params& p, int bid, int nb) {
  const float* modp = wsp<float>(p, O_MODP);
  float* mod = wsp<float>(p, O_MOD);
  for (int idx = bid * 256 + ltid(); idx < 2 * 3 * 6144; idx += nb * 256) {
    const int l = idx / (3 * 6144), n = idx % 6144;
    float v = p.b_mod[l * 6144 + n];
    for (int kc = 0; kc < 16; kc++) v += modp[(size_t)kc * 2 * 3 * 6144 + idx];
    mod[idx] = v;
  }
}

__device__ void ln_phase(const Params& p, int mode, const float* g, const float* bta, int lmod, int shoff, int scoff,
                         bool skip_ctx, int bid, int nb) {
  const int lane = ltid() & 63, wave = ltid() >> 6;
  u16* A = wsp<u16>(p, O_A);
  const float* mod = wsp<float>(p, O_MOD);
  for (int row = bid * 4 + wave; row < T; row += nb * 4) {
    const int b = row / KPB, kk = row - b * KPB;
    if (skip_ctx && kk < CTXL) continue;
    float* xr = xrow(p, row);
    const float* src;
    if (mode == 0)
      src = kk < CTXL ? p.ctx + (size_t)(b * CTXL + kk) * D : p.x + (size_t)(b * SEQ + kk - CTXL) * D;
    else
      src = xr;
    float4 v[4];
    float s = 0.f;
#pragma unroll
    for (int i = 0; i < 4; i++) {
      v[i] = *(const float4*)(src + i * 256 + lane * 4);
      s += v[i].x + v[i].y + v[i].z + v[i].w;
    }
    const float mu = wsum(s) * (1.f / 1024.f);
    float q = 0.f;
#pragma unroll
    for (int i = 0; i < 4; i++) {
      v[i].x -= mu; v[i].y -= mu; v[i].z -= mu; v[i].w -= mu;
      q += v[i].x * v[i].x + v[i].y * v[i].y + v[i].z * v[i].z + v[i].w * v[i].w;
    }
    const float rstd = rsqrtf(wsum(q) * (1.f / 1024.f) + EPS);
    const int m = kk < CTXL ? 2 : b;
    const float* md = mod + ((size_t)(lmod < 0 ? 0 : lmod) * 3 + m) * 6144;
#pragma unroll
    for (int i = 0; i < 4; i++) {
      const int c0 = i * 256 + lane * 4;
      const float4 gg = *(const float4*)(g + c0), bb = *(const float4*)(bta + c0);
      float4 y;
      y.x = v[i].x * rstd * gg.x + bb.x;
      y.y = v[i].y * rstd * gg.y + bb.y;
      y.z = v[i].z * rstd * gg.z + bb.z;
      y.w = v[i].w * rstd * gg.w + bb.w;
      *(float4*)(xr + c0) = y;
      if (lmod >= 0) {
        const float4 sh = *(const float4*)(md + shoff + c0), sc = *(const float4*)(md + scoff + c0);
        uint2 o;
        o.x = pack2(y.x * (1.f + sc.x) + sh.x, y.y * (1.f + sc.y) + sh.y);
        o.y = pack2(y.z * (1.f + sc.z) + sh.z, y.w * (1.f + sc.w) + sh.w);
        *(uint2*)(A + (size_t)row * D + c0) = o;
      }
    }
  }
}

#define PATCH_LOOP_BEGIN(NR_, NC_, PR_, PC_)                                   \
  {                                                                            \
    const int x_ = bid & 7, w_ = bid >> 3, nbx_ = nb >> 3;                     \
    const int CG_ = ((NC_) + (PC_)-1) / (PC_);                                 \
    const int npatch_ = (((NR_) + (PR_)-1) / (PR_)) * CG_;                     \
    for (int u_ = w_;; u_ += nbx_) {                                           \
      const int g_ = (u_ >> 6) * 8 + x_;                                       \
      if (g_ >= npatch_) break;                                                \
      const int s_ = u_ & 63;                                                  \
      const int rg_ = g_ / CG_;                                                \
      const int prt = rg_ * (PR_) + s_ / (PC_);                                \
      const int pct = (g_ - rg_ * CG_) * (PC_) + s_ % (PC_);                   \
      if (prt >= (NR_) || pct >= (NC_)) continue;
#define PATCH_LOOP_END \
    }                  \
  }

__device__ void phase_p1(const Params& p, int l, bool last, int bid, int nb, u16* smem) {
  EPI_DECL
  const u16* A = wsp<u16>(p, O_A);
  PATCH_LOOP_BEGIN(NRT, 16, 8, 8)
    f32x16 acc[2][2];
    zero_acc(acc);
    {
      const int rt = prt, ct = pct;
      const int row0 = rt * 128, b = row0 / KPB, kk0 = row0 - b * KPB;
      if (ct < 8 || ct >= 12) {
        gemm_core(acc, wsp<u16>(p, O_WP) + (size_t)ct * 128 * D, D, A + (size_t)rt * 128 * D, D, D, smem);
        u16* dst;
        float sc = 1.f;
        int cb;
        if (ct < 4) { dst = wsp<u16>(p, O_QNA); sc = NA_SCALE_L2; cb = ct * 128; }
        else if (ct < 8) { dst = wsp<u16>(p, O_KNA); cb = (ct - 4) * 128; }
        else { dst = wsp<u16>(p, O_LAT); cb = (ct - 12) * 128; }
#pragma unroll
        for (int i = 0; i < 2; i++)
#pragma unroll
          for (int j = 0; j < 2; j++)
#pragma unroll
            for (int g = 0; g < 4; g++) {
              const int row = row0 + wn_ * 64 + j * 32 + r_;
              const int col = cb + wm_ * 64 + i * 32 + 8 * g + 4 * hh_;
              uint2 o;
              o.x = pack2(acc[i][j][4 * g] * sc, acc[i][j][4 * g + 1] * sc);
              o.y = pack2(acc[i][j][4 * g + 2] * sc, acc[i][j][4 * g + 3] * sc);
              *(uint2*)(dst + (size_t)row * 512 + col) = o;
            }
      } else {
        gemm_core(acc, A + (size_t)rt * 128 * D, D, wsp<u16>(p, O_WP) + (size_t)ct * 128 * D, D, D, smem);
        u16* dst = wsp<u16>(p, O_VNAT);
        const int cb = (ct - 8) * 128;
#pragma unroll
        for (int i = 0; i < 2; i++)
#pragma unroll
          for (int j = 0; j < 2; j++)
#pragma unroll
            for (int g = 0; g < 4; g++) {
              const int kk = kk0 + wm_ * 64 + i * 32 + 8 * g + 4 * hh_;
              const int col = cb + wn_ * 64 + j * 32 + r_;
              uint2 o;
              o.x = pack2(acc[i][j][4 * g], acc[i][j][4 * g + 1]);
              o.y = pack2(acc[i][j][4 * g + 2], acc[i][j][4 * g + 3]);
              *(uint2*)(dst + ((size_t)(b * 512 + col)) * KPB + kk) = o;
            }
      }
    }
  PATCH_LOOP_END
  PATCH_LOOP_BEGIN(256, 8, 8, 8)
    f32x16 acc[2][2];
    zero_acc(acc);
    {
      const int rt = prt, ct = pct;
      const int b = rt >> 7, nlo = rt & 127;
      gemm_core(acc, A + (size_t)(b * KPB + CTXL + nlo) * D, (size_t)128 * D,
                wsp<u16>(p, O_WF) + (size_t)ct * 128 * D, D, D, smem);
      u16* dst = wsp<u16>(p, O_D1);
#pragma unroll
      for (int i = 0; i < 2; i++)
#pragma unroll
        for (int j = 0; j < 2; j++)
#pragma unroll
          for (int g = 0; g < 4; g++) {
            const int nhi = wm_ * 64 + i * 32 + 8 * g + 4 * hh_;
            const int n = ct * 128 + wn_ * 64 + j * 32 + r_;
            const int reim = n >> 9, jj = n & 511;
            uint2 o;
            o.x = pack2(acc[i][j][4 * g], acc[i][j][4 * g + 1]);
            o.y = pack2(acc[i][j][4 * g + 2], acc[i][j][4 * g + 3]);
            *(uint2*)(dst + ((((size_t)(b * 512 + jj)) * 128 + nlo) * 2 + reim) * 128 + nhi) = o;
          }
    }
  PATCH_LOOP_END
  if (!last) {
    for (int t2 = bid; t2 < 32; t2 += nb) {
      f32x16 acc[2][2];
      zero_acc(acc);
      const int rt = t2 >> 3, ct = t2 & 7;
      const int b = rt >> 1, rb = rt & 1;
      gemm_core(acc, A + (size_t)(b * KPB + rb * 128) * D, D, wsp<u16>(p, O_WF) + (size_t)ct * 128 * D, D, D, smem);
      u16* dst = wsp<u16>(p, O_D1C);
#pragma unroll
      for (int i = 0; i < 2; i++)
#pragma unroll
        for (int j = 0; j < 2; j++)
#pragma unroll
          for (int g = 0; g < 4; g++) {
            const int nc = rb * 128 + wm_ * 64 + i * 32 + 8 * g + 4 * hh_;
            const int n = ct * 128 + wn_ * 64 + j * 32 + r_;
            const int reim = n >> 9, jj = n & 511;
            uint2 o;
            o.x = pack2(acc[i][j][4 * g], acc[i][j][4 * g + 1]);
            o.y = pack2(acc[i][j][4 * g + 2], acc[i][j][4 * g + 3]);
            *(uint2*)(dst + (((size_t)(b * 512 + jj)) * 2 + reim) * 256 + nc) = o;
          }
    }
  }
}

__device__ __forceinline__ float inv_freq(int i) {
  switch (i) {
    case 0: return 1.0f;
    case 1: return 0.31622776601683794f;
    case 2: return 0.1f;
    case 3: return 0.03162277660168379f;
    case 4: return 0.01f;
    case 5: return 0.0031622776601683794f;
    case 6: return 0.001f;
    default: return 0.00031622776601683794f;
  }
}
__device__ __forceinline__ void rope_cs(int kk, int e, float& cs, float& sn) {
  if (kk < CTXL) { cs = 1.f; sn = 0.f; return; }
  const int tkn = kk - CTXL;
  const float pos = (e < 8) ? (float)(tkn >> 6) : (float)(tkn & 63);
  const float ang = pos * inv_freq(e & 7);
  double xr = (double)ang * 0.31830988618379067;
  xr -= 2.0 * floor(xr * 0.5);
  const float yr = (float)xr;
  cs = cospif(yr);
  sn = sinpif(yr);
}

__device__ __forceinline__ void row_rms(const u16* A, size_t lda, int K, float* rs) {
  const int tid = ltid();
  const int row = tid >> 1, half = tid & 1;
  const u16* pr = A + (size_t)row * lda + half * (K >> 1);
  float s = 0.f;
  for (int c = 0; c < (K >> 1); c += 8) {
    uint4 v = *(const uint4*)(pr + c);
    const uint32_t w[4] = {v.x, v.y, v.z, v.w};
#pragma unroll
    for (int q = 0; q < 4; q++) {
      const float a = __uint_as_float(w[q] << 16), bq = __uint_as_float(w[q] & 0xffff0000u);
      s += a * a + bq * bq;
    }
  }
  s += __shfl_xor(s, 1);
  if (half == 0) rs[row] = rsqrtf(s / (float)K + EPS);
  __syncthreads();
}

__device__ void phase_p2(const Params& p, int l, int bid, int nb, u16* smem) {
  EPI_DECL
  const u16* LAT = wsp<u16>(p, O_LAT);
  float* rs = (float*)(smem + 4 * SM_A);
  const int nQ = NRT * 6, nKV = NRT * 8, nFA = 1024 * 2, nKR = NRT;
  const int total = nQ + nKV + nFA + nKR;
  for (int t = bid; t < total; t += nb) {
    if (t < nQ) {
      const int rt = t / 6, ct = t - rt * 6;
      const int row0 = rt * 128, b = row0 / KPB, kk0 = row0 - b * KPB;
      row_rms(LAT + (size_t)row0 * 512, 512, 256, rs);
      f32x16 acc[2][2];
      zero_acc(acc);
      gemm_core(acc, wsp<u16>(p, O_WUQ) + (size_t)ct * 128 * 256, 256, LAT + (size_t)row0 * 512, 512, 256, smem);
      u16* QM = wsp<u16>(p, O_QM);
      if (ct < 4) {
#pragma unroll
        for (int i = 0; i < 2; i++)
#pragma unroll
          for (int j = 0; j < 2; j++)
#pragma unroll
            for (int g = 0; g < 4; g++) {
              const int rl = wn_ * 64 + j * 32 + r_;
              const int col = ct * 128 + wm_ * 64 + i * 32 + 8 * g + 4 * hh_;
              const int h = col >> 6, d = col & 63;
              const float sc = rs[rl] * MLA_SCALE_L2;
              uint2 o;
              o.x = pack2(acc[i][j][4 * g] * sc, acc[i][j][4 * g + 1] * sc);
              o.y = pack2(acc[i][j][4 * g + 2] * sc, acc[i][j][4 * g + 3] * sc);
              *(uint2*)(QM + (size_t)(row0 + rl) * 768 + h * 96 + d) = o;
            }
      } else {
        const int wt = (ct - 4) * 2 + wm_;
#pragma unroll
        for (int j = 0; j < 2; j++) {
          const int rl = wn_ * 64 + j * 32 + r_;
          const float sc = rs[rl] * MLA_SCALE_L2;
#pragma unroll
          for (int g = 0; g < 4; g++) {
            const int idx = wt * 32 + 8 * g + 4 * hh_;
            const int h = idx >> 4, e16 = idx & 15;
            float o1[4], o2[4];
#pragma unroll
            for (int q = 0; q < 4; q++) {
              float cs, sn;
              rope_cs(kk0 + rl, e16 + q, cs, sn);
              const float x1 = acc[0][j][4 * g + q] * sc, x2 = acc[1][j][4 * g + q] * sc;
              o1[q] = x1 * cs - x2 * sn;
              o2[q] = x2 * cs + x1 * sn;
            }
            u16* qd = QM + (size_t)(row0 + rl) * 768 + h * 96 + 64 + e16;
            uint2 o;
            o.x = pack2(o1[0], o1[1]);
            o.y = pack2(o1[2], o1[3]);
            *(uint2*)qd = o;
            o.x = pack2(o2[0], o2[1]);
            o.y = pack2(o2[2], o2[3]);
            *(uint2*)(qd + 16) = o;
          }
        }
      }
      __syncthreads();
    } else if (t < nQ + nKV) {
      const int t2 = t - nQ;
      const int rt = t2 >> 3, ct = t2 & 7;
      const int row0 = rt * 128, b = row0 / KPB, kk0 = row0 - b * KPB;
      row_rms(LAT + (size_t)row0 * 512 + 256, 512, 128, rs);
      f32x16 acc[2][2];
      zero_acc(acc);
      if (ct < 4) {
        gemm_core(acc, wsp<u16>(p, O_WUKV) + (size_t)ct * 128 * 128, 128, LAT + (size_t)row0 * 512 + 256, 512, 128,
                  smem);
        u16* KN = wsp<u16>(p, O_KN);
#pragma unroll
        for (int i = 0; i < 2; i++)
#pragma unroll
          for (int j = 0; j < 2; j++)
#pragma unroll
            for (int g = 0; g < 4; g++) {
              const int rl = wn_ * 64 + j * 32 + r_;
              const int col = ct * 128 + wm_ * 64 + i * 32 + 8 * g + 4 * hh_;
              const float sc = rs[rl];
              uint2 o;
              o.x = pack2(acc[i][j][4 * g] * sc, acc[i][j][4 * g + 1] * sc);
              o.y = pack2(acc[i][j][4 * g + 2] * sc, acc[i][j][4 * g + 3] * sc);
              *(uint2*)(KN + (size_t)(row0 + rl) * 512 + col) = o;
            }
      } else {
        gemm_core(acc, LAT + (size_t)row0 * 512 + 256, 512, wsp<u16>(p, O_WUKV) + (size_t)ct * 128 * 128, 128, 128,
                  smem);
        u16* VMT = wsp<u16>(p, O_VMT);
#pragma unroll
        for (int i = 0; i < 2; i++)
#pragma unroll
          for (int j = 0; j < 2; j++)
#pragma unroll
            for (int g = 0; g < 4; g++) {
              const int rl = wm_ * 64 + i * 32 + 8 * g + 4 * hh_;
              const int col = (ct - 4) * 128 + wn_ * 64 + j * 32 + r_;
              uint2 o;
              o.x = pack2(acc[i][j][4 * g] * rs[rl], acc[i][j][4 * g + 1] * rs[rl + 1]);
              o.y = pack2(acc[i][j][4 * g + 2] * rs[rl + 2], acc[i][j][4 * g + 3] * rs[rl + 3]);
              *(uint2*)(VMT + ((size_t)(b * 512 + col)) * KPB + kk0 + rl) = o;
            }
      }
      __syncthreads();
    } else if (t < nQ + nKV + nFA) {
      const int t2 = t - nQ - nKV;
      const int rt = t2 >> 1, ct = t2 & 1;
      const int b = rt >> 9, jj = rt & 511;
      f32x16 acc[2][2];
      zero_acc(acc);
      gemm_core(acc, wsp<u16>(p, O_D1) + (size_t)rt * 128 * 256, 256, wsp<u16>(p, O_MA) + (size_t)ct * 128 * 256, 256,
                256, smem);
      const float* TW = wsp<float>(p, O_TW);
      u16* D2 = wsp<u16>(p, O_D2);
      const int klo = ct * 64 + wn_ * 32 + r_;
#pragma unroll
      for (int i = 0; i < 2; i++)
#pragma unroll
        for (int g = 0; g < 4; g++) {
          const int nlo = wm_ * 64 + i * 32 + 8 * g + 4 * hh_;
          float re[4], im[4];
#pragma unroll
          for (int q = 0; q < 4; q++) {
            const float2 tw = *(const float2*)(TW + ((size_t)klo * 128 + nlo + q) * 2);
            const float ar = acc[i][0][4 * g + q], ai = acc[i][1][4 * g + q];
            re[q] = ar * tw.x + ai * tw.y;
            im[q] = ai * tw.x - ar * tw.y;
          }
          u16* d = D2 + ((((size_t)(b * 128 + klo)) * 512 + jj) * 2) * 128 + nlo;
          uint2 o;
          o.x = pack2(re[0], re[1]);
          o.y = pack2(re[2], re[3]);
          *(uint2*)d = o;
          o.x = pack2(im[0], im[1]);
          o.y = pack2(im[2], im[3]);
          *(uint2*)(d + 128) = o;
        }
    } else {
      const int rt = t - nQ - nKV - nFA;
      u16* KRR = wsp<u16>(p, O_KRR);
      for (int idx = ltid(); idx < 128 * 16; idx += 256) {
        const int rl = idx >> 4, e16 = idx & 15;
        const int row = rt * 128 + rl, b = row / KPB, kk = row - b * KPB;
        const float x1 = bf2f(LAT[(size_t)row * 512 + 384 + e16]), x2 = bf2f(LAT[(size_t)row * 512 + 400 + e16]);
        float cs, sn;
        rope_cs(kk, e16, cs, sn);
        KRR[(size_t)row * 32 + e16] = f2bf(x1 * cs - x2 * sn);
        KRR[(size_t)row * 32 + 16 + e16] = f2bf(x2 * cs + x1 * sn);
      }
    }
  }
}

template <int MODE>
__device__ void attn_item(const Params& p, int l, int b, int h, int q0  ,
                          int ntiles  , int rs0, int ycol, u16* smem) {
  constexpr int DQK = MODE == 0 ? 96 : 64;
  constexpr int KSTR = DQK + 8;
  constexpr int NKS = DQK / 16;
  constexpr int CPR = DQK / 8;
  constexpr int NKC = 64 * CPR / 256;
  const int tid = ltid(), lane = tid & 63, wave = tid >> 6, r = lane & 31, hh = lane >> 5;
  u16* Ks = smem;
  u16* Vs = smem + 2 * 64 * KSTR;
  const unsigned char* wsb = p.ws;
  const int qk = q0 + wave * 32 + r;
  const size_t qrow = (size_t)b * KPB + qk;
  bf16x8 qf[NKS];
  {
    const u16* qp = MODE == 0 ? wsp<u16>(p, O_QM) + qrow * 768 + h * 96 : wsp<u16>(p, O_QNA) + qrow * 512 + h * 64;
#pragma unroll
    for (int ks = 0; ks < NKS; ks++) qf[ks] = *(const bf16x8*)(qp + ks * 16 + hh * 8);
  }
  const short one_or_zero = hh == 0 ? (short)0x3F80 : (short)0;
  const bf16x8 kone = {one_or_zero, 0, 0, 0, 0, 0, 0, 0};
  bf16x8 qm = {0, 0, 0, 0, 0, 0, 0, 0};
  int qr = 0, qc = 0, rsq = 0, cs = 0;
  const float* rpb = nullptr;
  if (MODE == 1 && rs0 >= 0) {
    const int tkn = qk - CTXL;
    qr = tkn >> 6;
    qc = tkn & 63;
    rsq = min(max(qr - 4, 0), 248);
    cs = min(max(qc - 8, 0), 48);
    rpb = p.rpb + ((size_t)(l * 8 + h)) * 15 * 31;
  }
  f32x16 o[2], ol;
#pragma unroll
  for (int e = 0; e < 16; e++) { o[0][e] = 0.f; o[1][e] = 0.f; ol[e] = 0.f; }
  float m = 0.f;
  const bf16x8 ones = {(short)0x3F80, (short)0x3F80, (short)0x3F80, (short)0x3F80,
                       (short)0x3F80, (short)0x3F80, (short)0x3F80, (short)0x3F80};

#define KGEO(i)                                                                                          \
  uint32_t kof##i, kmu##i;                                                                               \
  int kls##i;                                                                                            \
  {                                                                                                      \
    const int c = tid + 256 * (i);                                                                       \
    const int row = c / CPR, cc = c - row * CPR;                                                         \
    if (MODE == 0 && cc >= 8) {                                                                          \
      kof##i = (uint32_t)(O_KRR + ((size_t)(b * KPB + row) * 32 + (cc - 8) * 8) * 2);                    \
      kmu##i = 64u;                                                                                      \
    } else {                                                                                             \
      kof##i = (uint32_t)((MODE == 0 ? O_KN : O_KNA) + ((size_t)(b * KPB + row) * 512 + h * 64 + cc * 8) * 2); \
      kmu##i = 1024u;                                                                                    \
    }                                                                                                    \
    kls##i = row * KSTR + cc * 8;                                                                        \
  }
#define VGEO(i)                                                                                          \
  uint32_t vof##i;                                                                                       \
  int vls##i;                                                                                            \
  bool vsx##i;                                                                                           \
  {                                                                                                      \
    const int c = tid + 256 * (i);                                                                       \
    const int d = c >> 3, cc = c & 7;                                                                    \
    vof##i = (uint32_t)((MODE == 0 ? O_VMT : O_VNAT) + ((size_t)(b * 512 + h * 64 + d) * KPB + cc * 8) * 2); \
    vls##i = d * 72 + cc * 8;                                                                            \
    vsx##i = (d & 8) != 0;                                                                               \
  }
  KGEO(0) KGEO(1) KGEO(2) VGEO(0) VGEO(1)
  (void)kof2; (void)kmu2; (void)kls2;
  u32x4 kr0A, kr1A, kr2A, vr0A, vr1A, kr0B, kr1B, kr2B, vr0B, vr1B;
  kr2A = kr1A = kr0A = vr0A = vr1A = kr2B = kr1B = kr0B = vr0B = vr1B = (u32x4){0u, 0u, 0u, 0u};
#define TILE_KK0(t) ((MODE == 1 && (t) >= 4) ? (uint32_t)(CTXL + 64 * min(rs0 + (t)-4, 255)) : (uint32_t)(64 * (t)))
#define LOAD_KV(t, S)                                                                   \
  {                                                                                     \
    const uint32_t kk0_ = TILE_KK0(t);                                                  \
    kr0##S = *(const u32x4*)(wsb + (size_t)(kof0 + kk0_ * kmu0));                       \
    kr1##S = *(const u32x4*)(wsb + (size_t)(kof1 + kk0_ * kmu1));                       \
    if (NKC == 3) kr2##S = *(const u32x4*)(wsb + (size_t)(kof2 + kk0_ * kmu2));         \
    vr0##S = *(const u32x4*)(wsb + (size_t)(vof0 + kk0_ * 2u));                         \
    vr1##S = *(const u32x4*)(wsb + (size_t)(vof1 + kk0_ * 2u));                         \
  }
#define STORE_V1(buf, i, srcv)                                                          \
  {                                                                                     \
    u32x4 sv_ = srcv;                                                                   \
    if (vsx##i) sv_ = (u32x4){sv_[2], sv_[3], sv_[0], sv_[1]};                          \
    *(u32x4*)(Vs + (buf)*64 * 72 + vls##i) = sv_;                                       \
  }
#define STORE_KV(buf, S)                                                                \
  {                                                                                     \
    *(u32x4*)(Ks + (buf)*64 * KSTR + kls0) = kr0##S;                                    \
    *(u32x4*)(Ks + (buf)*64 * KSTR + kls1) = kr1##S;                                    \
    if (NKC == 3) *(u32x4*)(Ks + (buf)*64 * KSTR + kls2) = kr2##S;                      \
    STORE_V1(buf, 0, vr0##S) STORE_V1(buf, 1, vr1##S)                                   \
  }
#define QK_TILE(kbuf, t)                                                                           \
  {                                                                                                \
    const u16* kb_ = Ks + (kbuf)*64 * KSTR + r * KSTR + hh * 8;                                    \
    {                                                                                              \
      f32x16 z_;                                                                                   \
      _Pragma("unroll") for (int e = 0; e < 16; e++) z_[e] = 0.f;                                  \
      sc[0] = __builtin_amdgcn_mfma_f32_32x32x16_bf16(kone, qm, z_, 0, 0, 0);                      \
      sc[1] = sc[0];                                                                               \
    }                                                                                              \
    _Pragma("unroll") for (int ks = 0; ks < NKS; ks++) {                                           \
      const bf16x8 kf0 = *(const bf16x8*)(kb_ + ks * 16);                                          \
      const bf16x8 kf1 = *(const bf16x8*)(kb_ + 32 * KSTR + ks * 16);                              \
      sc[0] = __builtin_amdgcn_mfma_f32_32x32x16_bf16(kf0, qf[ks], sc[0], 0, 0, 0);                \
      sc[1] = __builtin_amdgcn_mfma_f32_32x32x16_bf16(kf1, qf[ks], sc[1], 0, 0, 0);                \
    }                                                                                              \
    if (MODE == 1 && (t) >= 4) {                                                                   \
      const int kr_ = rs0 + (t)-4;                                                                 \
      const bool rowok = (kr_ >= rsq) && (kr_ < rsq + 8);                                          \
      const float* rp = rpb + (kr_ - qr + 7) * 31 + (15 - qc);                                     \
      _Pragma("unroll") for (int kb = 0; kb < 2; kb++) _Pragma("unroll") for (int e = 0; e < 16; e++) { \
        const int kc = kb * 32 + (e & 3) + 8 * (e >> 2) + 4 * hh;                                  \
        const bool valid = rowok && (kc >= cs) && (kc < cs + 16);                                  \
        float bias = 0.f;                                                                          \
        if (valid) bias = rp[kc];                                                                  \
        sc[kb][e] = valid ? sc[kb][e] + bias * LOG2E : -1e30f;                                     \
      }                                                                                            \
    }                                                                                              \
  }
#define TILE_MAX(tmax)                                                                             \
  {                                                                                                \
    tmax = sc[0][0];                                                                               \
    _Pragma("unroll") for (int e = 1; e < 16; e++) tmax = fmaxf(tmax, sc[0][e]);                   \
    _Pragma("unroll") for (int e = 0; e < 16; e++) tmax = fmaxf(tmax, sc[1][e]);                   \
    const uint32_t tu = __float_as_uint(tmax);                                                     \
    const auto sw = __builtin_amdgcn_permlane32_swap(tu, tu, false, false);                        \
    tmax = fmaxf(__uint_as_float(sw[0]), __uint_as_float(sw[1]));                                  \
  }
#define MOVE_REF(mnew_)                                                                            \
  {                                                                                                \
    const float mq_ = bf2f(f2bf(mnew_));                                                           \
    const float delta_ = mq_ - m;                                                                  \
    const float alpha = __builtin_amdgcn_exp2f(-delta_);                                           \
    m = mq_;                                                                                       \
    _Pragma("unroll") for (int e = 0; e < 16; e++) {                                               \
      o[0][e] *= alpha; o[1][e] *= alpha; ol[e] *= alpha;                                          \
      sc[0][e] -= delta_; sc[1][e] -= delta_;                                                      \
    }                                                                                              \
    qm[0] = (hh == 0) ? (short)f2bf(-m) : (short)0;                                                \
  }
#define SOFTMAX_PV(vbuf)                                                                           \
  {                                                                                                \
    const u16* vb_ = Vs + (vbuf)*64 * 72 + r * 72 + vsw;                                           \
    _Pragma("unroll") for (int kb = 0; kb < 2; kb++) _Pragma("unroll") for (int st = 0; st < 2; st++) { \
      u32x4 pu;                                                                                    \
      _Pragma("unroll") for (int q = 0; q < 4; q++)                                                \
        pu[q] = pack2(__builtin_amdgcn_exp2f(sc[kb][8 * st + 2 * q]),                              \
                      __builtin_amdgcn_exp2f(sc[kb][8 * st + 2 * q + 1]));                         \
      const bf16x8 pbv = __builtin_bit_cast(bf16x8, pu);                                           \
      _Pragma("unroll") for (int db = 0; db < 2; db++) {                                           \
        const u16* vp = vb_ + db * 32 * 72 + kb * 32 + 16 * st;                                    \
        const bf16x4 vlo = *(const bf16x4*)(vp);                                                   \
        const bf16x4 vhi = *(const bf16x4*)(vp + 8);                                               \
        const bf16x8 vfv = __builtin_shufflevector(vlo, vhi, 0, 1, 2, 3, 4, 5, 6, 7);              \
        o[db] = __builtin_amdgcn_mfma_f32_32x32x16_bf16(vfv, pbv, o[db], 0, 0, 0);                 \
      }                                                                                            \
      ol = __builtin_amdgcn_mfma_f32_32x32x16_bf16(ones, pbv, ol, 0, 0, 0);                        \
    }                                                                                              \
  }
#define DEFER_REF(tmax)                                                                            \
  if (__any(tmax > 8.f)) {                                                                         \
    const float mq_ = bf2f(f2bf(m + fmaxf(tmax, 0.f)));                                            \
    const float alpha = __builtin_amdgcn_exp2f(m - mq_);                                           \
    m = mq_;                                                                                       \
    _Pragma("unroll") for (int e = 0; e < 16; e++) { o[0][e] *= alpha; o[1][e] *= alpha; ol[e] *= alpha; } \
    qm[0] = (hh == 0) ? (short)f2bf(-m) : (short)0;                                                \
  }
#define ATT_STEP(t, LD, ST)                                        \
  {                                                                \
    const int cur = (t)&1;                                         \
    LOAD_KV(min((t) + 2, tl), LD)                                  \
    __builtin_amdgcn_sched_barrier(0);                             \
    QK_TILE(cur, t)                                                \
    SOFTMAX_PV(cur)                                                \
    float tmax;                                                    \
    TILE_MAX(tmax)                                                 \
    DEFER_REF(tmax)                                                \
    STORE_KV(cur ^ 1, ST)                                          \
    __syncthreads();                                               \
  }

  const int tl = ntiles - 1;
  const int vsw = 4 * (hh ^ ((r >> 3) & 1));
  f32x16 sc[2];
  LOAD_KV(0, A)
  STORE_KV(0, A)
  LOAD_KV(min(1, tl), A)
  __syncthreads();
  {
    LOAD_KV(min(2, tl), B)
    __builtin_amdgcn_sched_barrier(0);
    QK_TILE(0, 0)
    float tmax;
    TILE_MAX(tmax)
    MOVE_REF(tmax)
    SOFTMAX_PV(0)
    STORE_KV(1, A)
    __syncthreads();
  }
  for (int t = 1; t + 1 < ntiles; t += 2) {
    ATT_STEP(t, A, B)
    ATT_STEP(t + 1, B, A)
  }
  ATT_STEP(tl, A, B)
  const float inv = 1.f / ol[0];
  u16* yp = wsp<u16>(p, O_Y) + qrow * 1536 + ycol + h * 64;
#pragma unroll
  for (int db = 0; db < 2; db++)
#pragma unroll
    for (int g = 0; g < 4; g++) {
      uint2 ov;
      ov.x = pack2(o[db][4 * g] * inv, o[db][4 * g + 1] * inv);
      ov.y = pack2(o[db][4 * g + 2] * inv, o[db][4 * g + 3] * inv);
      *(uint2*)(yp + db * 32 + 8 * g + 4 * hh) = ov;
    }
#undef KGEO
#undef VGEO
#undef TILE_KK0
#undef LOAD_KV
#undef STORE_V1
#undef STORE_KV
#undef QK_TILE
#undef TILE_MAX
#undef MOVE_REF
#undef SOFTMAX_PV
#undef ATT_STEP
#undef DEFER_REF
}

__device__ void phase_p3(const Params& p, int l, bool last, int bid, int nb, u16* smem) {
  EPI_DECL
  const int nMLA = 2048, nNA = 2048, nFB = 1024;
  const int nC = last ? 0 : (32 + 32 + 16);
  const int total = nMLA + nNA + nFB + nC;
  for (int t = bid; t < total; t += nb) {
    int kind, b = 0, h = 0, q0 = 0, ntl = 0, rs0 = -1;
    size_t aoff = 0, boff = 0;
    int Kf = 256, j0 = 0, tok0 = 0, tokmul = 1, colbase = 0;
    if (t < nMLA) {
      kind = 0;
      h = t & 7;
      const int rest = t >> 3;
      b = rest >> 7;
      q0 = CTXL + (rest & 127) * 128;
      ntl = 260;
    } else if (t < nMLA + nNA) {
      kind = 1;
      const int t2 = t - nMLA;
      h = t2 & 7;
      const int rest = t2 >> 3, rp = rest & 127;
      b = rest >> 7;
      rs0 = min(max(2 * rp - 4, 0), 248);
      const int rs1 = min(max(2 * rp + 1 - 4, 0), 248);
      q0 = CTXL + rp * 128;
      ntl = (4 + (rs1 + 8 - rs0) + 1) & ~1;
    } else if (t < nMLA + nNA + nFB) {
      kind = 2;
      const int rt = t - nMLA - nNA;
      const int bk = rt >> 2;
      j0 = (rt & 3) * 128;
      b = bk >> 7;
      tok0 = CTXL + (bk & 127);
      tokmul = 128;
      aoff = O_D2 + (size_t)rt * 128 * 256 * 2;
      boff = O_MB;
      Kf = 256;
    } else {
      const int t2 = t - nMLA - nNA - nFB;
      if (t2 < 64) {
        kind = t2 >> 5;
        const int t3 = t2 & 31;
        h = t3 & 7;
        b = (t3 >> 3) & 1;
        q0 = (t3 >> 4) * 128;
        ntl = 4;
      } else {
        kind = 2;
        const int t3 = t2 - 64;
        const int rt = t3 >> 1, ct = t3 & 1;
        b = rt >> 2;
        j0 = (rt & 3) * 128;
        colbase = ct * 128;
        aoff = O_D1C + (size_t)rt * 128 * 512 * 2;
        boff = O_MC + (size_t)ct * 128 * 512 * 2;
        Kf = 512;
      }
    }
    if (kind == 0) {
      attn_item<0>(p, l, b, h, q0, ntl, -1, 1024, smem);
    } else if (kind == 1) {
      attn_item<1>(p, l, b, h, q0, ntl, rs0, 512, smem);
    } else {
      f32x16 acc[2][2];
      zero_acc(acc);
      gemm_core(acc, wsp<u16>(p, aoff), Kf, wsp<u16>(p, boff), Kf, Kf, smem);
      u16* Y = wsp<u16>(p, O_Y);
#pragma unroll
      for (int i = 0; i < 2; i++)
#pragma unroll
        for (int j = 0; j < 2; j++)
#pragma unroll
          for (int g = 0; g < 4; g++) {
            const int jj = j0 + wm_ * 64 + i * 32 + 8 * g + 4 * hh_;
            const int tok = tok0 + (colbase + wn_ * 64 + j * 32 + r_) * tokmul;
            uint2 ov;
            ov.x = pack2(acc[i][j][4 * g], acc[i][j][4 * g + 1]);
            ov.y = pack2(acc[i][j][4 * g + 2], acc[i][j][4 * g + 3]);
            *(uint2*)(Y + ((size_t)b * KPB + tok) * 1536 + jj) = ov;
          }
    }
  }
}

__device__ __forceinline__ int n_row_tiles(bool last) { return last ? NRT - 4 : NRT; }
__device__ __forceinline__ int row_tile(bool last, int i) {
  if (!last) return i;
  return i < 128 ? i + 2 : i + 4;
}

__device__ void phase_p4(const Params& p, int l, bool last, int bid, int nb, u16* smem) {
  EPI_DECL
  const u16* A = wsp<u16>(p, O_A);
  const u16* Y = wsp<u16>(p, O_Y);
  u16* M = wsp<u16>(p, O_M);
  uint4* stash = wsp<uint4>(p, O_QM) + (size_t)bid * 24 * 256 + ltid();
  const int nrt_ = n_row_tiles(last);
  PATCH_LOOP_BEGIN(nrt_, 8, 8, 8)
    const int rt = row_tile(last, prt), ct = pct;
#pragma unroll 1
    for (int g = 0; g < 3; g++) {
      f32x16 acc[2][2];
      zero_acc(acc);
      gemm_core<true>(acc, wsp<u16>(p, O_WG) + (size_t)(g * 1024 + ct * 128) * D, D, A + (size_t)rt * 128 * D, D, D,
                      smem);
#pragma unroll
      for (int i = 0; i < 2; i++)
#pragma unroll
        for (int j = 0; j < 2; j++)
#pragma unroll
          for (int e = 0; e < 2; e++) {
            uint4 gq4;
            gq4.x = pack2(fsigmoid(acc[i][j][8 * e]), fsigmoid(acc[i][j][8 * e + 1]));
            gq4.y = pack2(fsigmoid(acc[i][j][8 * e + 2]), fsigmoid(acc[i][j][8 * e + 3]));
            gq4.z = pack2(fsigmoid(acc[i][j][8 * e + 4]), fsigmoid(acc[i][j][8 * e + 5]));
            gq4.w = pack2(fsigmoid(acc[i][j][8 * e + 6]), fsigmoid(acc[i][j][8 * e + 7]));
            stash[(g * 8 + (i * 2 + j) * 2 + e) * 256] = gq4;
          }
    }
    f32x16 mg[2][2];
    zero_acc(mg);
#pragma unroll 1
    for (int g = 0; g < 3; g++) {
      f32x16 acc[2][2];
      zero_acc(acc);
      gemm_core<false>(acc, wsp<u16>(p, O_WB) + (size_t)(g * 1024 + ct * 128) * 512, 512,
                       Y + (size_t)rt * 128 * 1536 + g * 512, 1536, 512, smem);
#pragma unroll
      for (int i = 0; i < 2; i++)
#pragma unroll
        for (int j = 0; j < 2; j++)
#pragma unroll
          for (int e = 0; e < 2; e++) {
            const uint4 gq4 = stash[(g * 8 + (i * 2 + j) * 2 + e) * 256];
            const uint32_t gw[4] = {gq4.x, gq4.y, gq4.z, gq4.w};
#pragma unroll
            for (int q = 0; q < 4; q++) {
              mg[i][j][8 * e + 2 * q] += __uint_as_float(gw[q] << 16) * acc[i][j][8 * e + 2 * q];
              mg[i][j][8 * e + 2 * q + 1] += __uint_as_float(gw[q] & 0xffff0000u) * acc[i][j][8 * e + 2 * q + 1];
            }
          }
    }
#pragma unroll
    for (int i = 0; i < 2; i++)
#pragma unroll
      for (int j = 0; j < 2; j++)
#pragma unroll
        for (int g = 0; g < 4; g++) {
          const int row = rt * 128 + wn_ * 64 + j * 32 + r_;
          const int col = ct * 128 + wm_ * 64 + i * 32 + 8 * g + 4 * hh_;
          uint2 o;
          o.x = pack2(mg[i][j][4 * g], mg[i][j][4 * g + 1]);
          o.y = pack2(mg[i][j][4 * g + 2], mg[i][j][4 * g + 3]);
          *(uint2*)(M + (size_t)row * D + col) = o;
        }
  PATCH_LOOP_END
}

__device__ void phase_resid(const Params& p, int l, bool last, const u16* Ain, size_t lda, const u16* W, int K, int goff,
                            int bid, int nb, u16* smem) {
  EPI_DECL
  const float* mod = wsp<float>(p, O_MOD);
  const int nrt_ = n_row_tiles(last);
  PATCH_LOOP_BEGIN(nrt_, 8, 8, 8)
    const int rt = row_tile(last, prt), ct = pct;
    f32x16 acc[2][2];
    zero_acc(acc);
    gemm_core(acc, W + (size_t)ct * 128 * K, K, Ain + (size_t)rt * 128 * lda, lda, K, smem);
    const int row0 = rt * 128, b = row0 / KPB, kk0 = row0 - b * KPB;
    const int m = kk0 < CTXL ? 2 : b;
    float* xb = xrow(p, row0);
    const float* gv = mod + ((size_t)l * 3 + m) * 6144 + goff;
#pragma unroll
    for (int i = 0; i < 2; i++)
#pragma unroll
      for (int g = 0; g < 4; g++) {
        const int col = ct * 128 + wm_ * 64 + i * 32 + 8 * g + 4 * hh_;
        const float4 g4 = *(const float4*)(gv + col);
#pragma unroll
        for (int j = 0; j < 2; j++) {
          const int rl = wn_ * 64 + j * 32 + r_;
          float4* xp = (float4*)(xb + (size_t)rl * D + col);
          float4 xv = *xp;
          xv.x = ALPHA * xv.x + (1.f + g4.x) * acc[i][j][4 * g];
          xv.y = ALPHA * xv.y + (1.f + g4.y) * acc[i][j][4 * g + 1];
          xv.z = ALPHA * xv.z + (1.f + g4.z) * acc[i][j][4 * g + 2];
          xv.w = ALPHA * xv.w + (1.f + g4.w) * acc[i][j][4 * g + 3];
          *xp = xv;
        }
      }
  PATCH_LOOP_END
}

__device__ void phase_p7(const Params& p, int l, bool last, int bid, int nb, u16* smem) {
  EPI_DECL
  const u16* A = wsp<u16>(p, O_A);
  u16* HH = wsp<u16>(p, O_HH);
  const int nrt_ = n_row_tiles(last);
  PATCH_LOOP_BEGIN(nrt_, 44, 16, 4)
    const int rt = row_tile(last, prt), ct = pct;
    f32x16 acc[2][2];
    zero_acc(acc);
    gemm_core(acc, wsp<u16>(p, O_WGU) + (size_t)ct * 128 * D, D, A + (size_t)rt * 128 * D, D, D, smem);
#pragma unroll
    for (int j = 0; j < 2; j++)
#pragma unroll
      for (int g = 0; g < 4; g++) {
        const int row = rt * 128 + wn_ * 64 + j * 32 + r_;
        const int q = (ct * 2 + wm_) * 32 + 8 * g + 4 * hh_;
        float hv[4];
#pragma unroll
        for (int t = 0; t < 4; t++) {
          const float gt = acc[0][j][4 * g + t], up = acc[1][j][4 * g + t];
          hv[t] = gt * fsigmoid(gt) * up;
        }
        uint2 o;
        o.x = pack2(hv[0], hv[1]);
        o.y = pack2(hv[2], hv[3]);
        *(uint2*)(HH + (size_t)row * FH + q) = o;
      }
  PATCH_LOOP_END
}

constexpr int NPHASE = 3 + 9 * 2;

__device__ void run_phase(const Params& p, int ph, int bid, int nb, u16* smem) {
  if (ph == 0) {
    prep_tables(p, bid, nb);
    prep_modp(p, bid, nb);
    prep_weights(p, 0, bid, nb, smem);
    return;
  }
  if (ph == 1) { prep_modr(p, bid, nb); return; }
  if (ph == 2) { ln_phase(p, 0, p.ln_in_g, p.ln_in_b, 0, 0, 1024, false, bid, nb); return; }
  const int l = (ph - 3) / 9, s = (ph - 3) % 9;
  const bool last = (l == 1);
  switch (s) {
    case 0: phase_p1(p, l, last, bid, nb, smem); break;
    case 1: phase_p2(p, l, bid, nb, smem); break;
    case 2: phase_p3(p, l, last, bid, nb, smem); break;
    case 3: phase_p4(p, l, last, bid, nb, smem); break;
    case 4: phase_resid(p, l, last, wsp<u16>(p, O_M), D, wsp<u16>(p, O_WO), D, 2048, bid, nb, smem); break;
    case 5: ln_phase(p, 1, p.ln1_g + l * D, p.ln1_b + l * D, l, 3072, 4096, last, bid, nb); break;
    case 6: phase_p7(p, l, last, bid, nb, smem); break;
    case 7: phase_resid(p, l, last, wsp<u16>(p, O_HH), FH, wsp<u16>(p, O_WD), FH, 5120, bid, nb, smem); break;
    default:
      ln_phase(p, 1, p.ln2_g + l * D, p.ln2_b + l * D, last ? -1 : l + 1, 0, 1024, last, bid, nb);
      if (!last) prep_weights(p, l + 1, bid, nb, smem);
      break;
  }
}


#define XB_TMO      128
#define XB_XCNT(j)  (256  + 64 * (j))
#define XB_XSUB(j)  (1280 + 64 * (j))
#define XB_XGEN(j)  (2304 + 64 * (j))
#define XB_TOP      3328
#define XB_TOPGEN   3392
#define XCD_BAR_WORDS 3456
#define XB_SPIN_CAP (1u << 20)
#define LAS __attribute__((address_space(3)))
__device__ __forceinline__ unsigned xb_ld(unsigned* p) { return __hip_atomic_load(p, __ATOMIC_RELAXED, __HIP_MEMORY_SCOPE_AGENT); }
__device__ __forceinline__ unsigned xb_add(unsigned* p, unsigned v) { return __hip_atomic_fetch_add(p, v, __ATOMIC_RELAXED, __HIP_MEMORY_SCOPE_AGENT); }
__device__ __forceinline__ unsigned xb_xcc_id() { return (unsigned)__builtin_amdgcn_s_getreg((3 << 11) | 20) & 0xFu; }
#define XB_SPIN(cond, bar) do { unsigned _sp = 0; while (cond) { __builtin_amdgcn_s_sleep(1); \
    if ((++_sp & 255u) == 0u) { if (xb_ld(&(bar)[XB_TMO])) break; if (_sp > XB_SPIN_CAP) { atomicAdd(&(bar)[XB_TMO], 1u); break; } } } } while (0)
struct XcdBarrier {
  unsigned* bar; unsigned x;
  volatile LAS unsigned* st;
};
__device__ __forceinline__ XcdBarrier xcd_barrier_post(unsigned* bar, volatile LAS unsigned* st) {
  XcdBarrier b; b.bar = bar; b.x = xb_xcc_id(); b.st = st;
  if (threadIdx.x == 0) (void)xb_add(&bar[XB_XCNT(b.x)], 1u);
  return b;
}
__device__ __forceinline__ void xcd_barrier_complete(unsigned* bar, unsigned x, unsigned& nloc, unsigned& nx) {
  const unsigned G = gridDim.x * gridDim.y * gridDim.z;
  unsigned sum, cnt, mine, sp = 0u;
  for (;;) {
    sum = 0u; cnt = 0u; mine = 0u;
#pragma unroll
    for (unsigned j = 0; j < 16; ++j) { const unsigned c = xb_ld(&bar[XB_XCNT(j)]); sum += c; cnt += (c > 0u) ? 1u : 0u; mine = (j == x) ? c : mine; }
    if (sum == G) break;
    __builtin_amdgcn_s_sleep(1);
    if ((++sp & 255u) == 0u) { if (xb_ld(&bar[XB_TMO])) break; if (sp > XB_SPIN_CAP) { atomicAdd(&bar[XB_TMO], 1u); break; } }
  }
  nloc = mine > 0u ? mine : 1u; nx = cnt > 0u ? cnt : 1u;
}
__device__ __forceinline__ void xcd_barrier(const XcdBarrier& b) {
  asm volatile("s_waitcnt vmcnt(0)" ::: "memory");
  __syncthreads();
  if (threadIdx.x == 0) {
    unsigned* bar = b.bar;
    __builtin_amdgcn_s_waitcnt(0);
    unsigned nloc = b.st[0], nx = b.st[1];
    if (nloc == 0u) { xcd_barrier_complete(bar, b.x, nloc, nx); b.st[0] = nloc; b.st[1] = nx; }
    const unsigned old = xb_add(&bar[XB_XSUB(b.x)], 1u);
    const unsigned gen = old / nloc;
    if (old + 1u == (gen + 1u) * nloc) {
      __builtin_amdgcn_fence(__ATOMIC_RELEASE, "agent");
      asm volatile("s_waitcnt vmcnt(0)" ::: "memory");
      const unsigned og = xb_add(&bar[XB_TOP], 1u);
      const unsigned tg = og / nx;
      if (og + 1u == (tg + 1u) * nx) xb_add(&bar[XB_TOPGEN], 1u);
      else XB_SPIN(xb_ld(&bar[XB_TOPGEN]) == tg, bar);
      __builtin_amdgcn_fence(__ATOMIC_ACQUIRE, "agent");
      xb_add(&bar[XB_XGEN(b.x)], 1u);
      asm volatile("s_waitcnt vmcnt(0)" ::: "memory");
    } else {
      XB_SPIN(xb_ld(&bar[XB_XGEN(b.x)]) == gen, bar);
      __builtin_amdgcn_fence(__ATOMIC_ACQUIRE, "agent");
      asm volatile("s_waitcnt vmcnt(0)" ::: "memory");
    }
  }
  __syncthreads();
}

constexpr int SMEM_ELEMS = 4 * SM_A + 256 + 8;

#if COOP
__global__ void __launch_bounds__(256, 2) mega_kernel(Params p) {
  __shared__ __attribute__((aligned(16))) u16 smem[SMEM_ELEMS];
  cg::grid_group grid = cg::this_grid();
  volatile LAS unsigned* st = (volatile LAS unsigned*)(smem + 4 * SM_A + 256);
  if (threadIdx.x == 0) { st[0] = 0u; st[1] = 0u; }
  __syncthreads();
  XcdBarrier xb = xcd_barrier_post((unsigned*)(p.ws + O_BAR), st);
  for (int ph = 0; ph < NPHASE; ph++) {
#ifdef PROBE_MASK
    const int s9 = ph >= 3 ? (ph - 3) % 9 : -1;
    const int nrep = (s9 >= 0 && ((PROBE_MASK >> s9) & 1)) ? 2 : 1;
    for (int rep = 0; rep < nrep; rep++) {
      run_phase(p, ph, blockIdx.x, gridDim.x, smem);
      if (ph == 0) grid.sync();
      else if (ph + 1 < NPHASE || rep + 1 < nrep) xcd_barrier(xb);
    }
#else
    run_phase(p, ph, blockIdx.x, gridDim.x, smem);
    if (ph == 0) grid.sync();
    else if (ph + 1 < NPHASE) xcd_barrier(xb);
#endif
  }
}
#else
__global__ void __launch_bounds__(256, 2) phase_kernel(Params p, int ph) {
  __shared__ __attribute__((aligned(16))) u16 smem[SMEM_ELEMS];
  run_phase(p, ph, blockIdx.x, gridDim.x, smem);
}
#endif

extern "C" void kernel_launch(void* const* d_in, const int* in_sizes, int n_in, void* d_out, int out_size, void* d_ws,
                              size_t ws_size, hipStream_t stream) {
  Params p{};
  const float** f = (const float**)&p;
  for (int i = 0; i < 25; i++) f[i] = (const float*)d_in[i];
  p.out = (float*)d_out;
  p.ws = (unsigned char*)d_ws;
  if (ws_size < O_WSEND) fprintf(stderr, "workspace too small: %zu < %zu\n", ws_size, (size_t)O_WSEND);
#if COOP
  static int grid_blocks = 0;
  if (!grid_blocks) {
    int dev = 0, cus = 0, per_cu = 0;
    hipGetDevice(&dev);
    hipDeviceGetAttribute(&cus, hipDeviceAttributeMultiprocessorCount, dev);
    hipOccupancyMaxActiveBlocksPerMultiprocessor(&per_cu, mega_kernel, 256, 0);
    if (per_cu > 2) per_cu = 2;
    grid_blocks = cus * per_cu;
  }
  (void)hipMemsetAsync(p.ws + O_BAR, 0, 3456 * 4, stream);
  void* args[] = {&p};
  hipError_t e = hipLaunchCooperativeKernel((void*)mega_kernel, dim3(grid_blocks), dim3(256), args, 0, stream);
  if (e != hipSuccess) fprintf(stderr, "cooperative launch failed: %s (grid %d)\n", hipGetErrorString(e), grid_blocks);
#else
  for (int ph = 0; ph < NPHASE; ph++) phase_kernel<<<512, 256, 0, stream>>>(p, ph);
#endif
}
```

```cpp
#include <hip/hip_runtime.h>
#include <hip/hip_cooperative_groups.h>
#include <stdint.h>
#include <cstdio>
namespace cg = cooperative_groups;

#ifndef COOP
#define COOP 1
#endif

typedef __attribute__((ext_vector_type(8))) short bf16x8;
typedef __attribute__((ext_vector_type(4))) short bf16x4;
typedef __attribute__((ext_vector_type(16))) float f32x16;
typedef unsigned short u16;
typedef __attribute__((ext_vector_type(4))) unsigned int u32x4;

constexpr int D = 1024;
constexpr int NBATCH = 2;
constexpr int SEQ = 16384;
constexpr int CTXL = 256;
constexpr int KPB = SEQ + CTXL;
constexpr int T = NBATCH * KPB;
constexpr int NRT = T / 128;
constexpr int FH = 2816;
constexpr int IN_DIM = 5536;
constexpr float LOG2E = 1.4426950408889634f;
constexpr float NA_SCALE_L2 = 0.125f * LOG2E;
constexpr float MLA_SCALE_L2 = 0.10206207261596575f * LOG2E;
constexpr float ALPHA = 1.4142135623730951f;
constexpr float EPS = 1e-5f;
constexpr float RS128 = 0.08838834764831845f;

constexpr size_t al256(size_t x) { return (x + 255) & ~(size_t)255; }
constexpr size_t O_WF = 0;
constexpr size_t O_WP = O_WF + (size_t)1024 * 1024 * 2;
constexpr size_t O_WG = O_WP + (size_t)2048 * 1024 * 2;
constexpr size_t O_WUQ = O_WG + (size_t)3072 * 1024 * 2;
constexpr size_t O_WUKV = O_WUQ + (size_t)768 * 256 * 2;
constexpr size_t O_WB = O_WUKV + (size_t)1024 * 128 * 2;
constexpr size_t O_WO = O_WB + (size_t)3 * 1024 * 512 * 2;
constexpr size_t O_WGU = O_WO + (size_t)1024 * 1024 * 2;
constexpr size_t O_WD = O_WGU + (size_t)5632 * 1024 * 2;
constexpr size_t O_MA = O_WD + (size_t)1024 * 2816 * 2;
constexpr size_t O_MB = O_MA + (size_t)256 * 256 * 2;
constexpr size_t O_MC = O_MB + (size_t)128 * 256 * 2;
constexpr size_t O_TW = O_MC + (size_t)256 * 512 * 2;
constexpr size_t O_MODP = O_TW + (size_t)128 * 128 * 2 * 4;
constexpr size_t O_MOD = O_MODP + (size_t)16 * 2 * 3 * 6144 * 4;
constexpr size_t O_XCTX = O_MOD + (size_t)2 * 3 * 6144 * 4;
constexpr size_t O_D1C = O_XCTX + (size_t)512 * 1024 * 4;
constexpr size_t O_A = O_D1C + (size_t)2 * 512 * 2 * 256 * 2;
constexpr size_t O_RQ = O_A + (size_t)T * 1024 * 2;
constexpr size_t O_QNA = O_RQ;
constexpr size_t O_KNA = O_QNA + (size_t)T * 512 * 2;
constexpr size_t O_VNAT = O_KNA + (size_t)T * 512 * 2;
constexpr size_t O_RY = O_VNAT + (size_t)T * 512 * 2;
constexpr size_t O_Y = O_RY;
constexpr size_t O_D1 = O_RY;
constexpr size_t O_LAT = O_RY + (size_t)67108864;
constexpr size_t O_D2 = O_RY + (size_t)T * 1536 * 2;
constexpr size_t O_QM = O_D2 + (size_t)67108864;
constexpr size_t O_KN = O_QM + (size_t)T * 768 * 2;
constexpr size_t O_KRR = O_KN + (size_t)T * 512 * 2;
constexpr size_t O_VMT = O_KRR + (size_t)T * 32 * 2;
constexpr size_t O_END = O_VMT + (size_t)T * 512 * 2;
constexpr size_t O_BAR = (O_END + 255) & ~(size_t)255;
constexpr size_t O_WSEND = O_BAR + 3456 * 4;
constexpr size_t O_M = O_RQ;
constexpr size_t O_HH = O_RQ;

struct Params {
  const float *x, *c, *ctx, *c_ctx, *ln_in_g, *ln_in_b, *w_mod, *b_mod, *w_in, *gq, *gkv, *w_uq, *w_qr, *w_uk,
      *w_uv, *rpb, *w_branch, *w_out, *ln1_g, *ln1_b, *ln2_g, *ln2_b, *w_gate, *w_up, *w_down;
  float* out;
  unsigned char* ws;
};

__device__ __forceinline__ u16 f2bf(float f) {
  uint32_t u = __float_as_uint(f);
  u += 0x7fffu + ((u >> 16) & 1u);
  return (u16)(u >> 16);
}
typedef __attribute__((ext_vector_type(2))) __bf16 bf16v2;
typedef __attribute__((ext_vector_type(2))) float f32v2;
__device__ __forceinline__ uint32_t pack2(float a, float b) {
  const f32v2 v = {a, b};
  return __builtin_bit_cast(uint32_t, __builtin_convertvector(v, bf16v2));
}
__device__ __forceinline__ float bf2f(u16 v) { return __uint_as_float(((uint32_t)v) << 16); }
__device__ __forceinline__ float wsum(float v) {
#pragma unroll
  for (int o = 32; o > 0; o >>= 1) v += __shfl_xor(v, o);
  return v;
}
__device__ __forceinline__ float fsigmoid(float v) { return 1.f / (1.f + __expf(-v)); }

__device__ __forceinline__ int ltid() {
  int t = threadIdx.x;
  asm volatile("" : "+v"(t));
  return t;
}

template <typename Tp>
__device__ __forceinline__ Tp* wsp(const Params& p, size_t off) { return (Tp*)(p.ws + off); }

__device__ __forceinline__ float* xrow(const Params& p, int row) {
  int b = row / KPB, kk = row - b * KPB;
  if (kk < CTXL) return wsp<float>(p, O_XCTX) + (size_t)(b * CTXL + kk) * D;
  return p.out + (size_t)(b * SEQ + kk - CTXL) * D;
}

constexpr int LSTR = 72;
constexpr int SM_A = 128 * LSTR;

template <bool DEEP = true>
__device__ __forceinline__ void gemm_core(f32x16 (&acc)[2][2], const u16* __restrict__ A, size_t lda,
                                          const u16* __restrict__ B, size_t ldb, int K, u16* smem) {
  const int tid = ltid(), lane = tid & 63, wave = tid >> 6;
  const int wm = wave >> 1, wn = wave & 1, r = lane & 31, hh = lane >> 5;
  u16* sA = smem;
  u16* sB = smem + 2 * SM_A;
  const int lrow = tid >> 3, lkc = (tid & 7) * 8;
  const u16* ga = A + (size_t)lrow * lda + lkc;
  const u16* gb = B + (size_t)lrow * ldb + lkc;
  u16* wa = sA + lrow * LSTR + lkc;
  u16* wb = sB + lrow * LSTR + lkc;
  const u16* pa = sA + (wm * 64 + r) * LSTR + hh * 8;
  const u16* pb = sB + (wn * 64 + r) * LSTR + hh * 8;
  u32x4 a0r[4], b0r[4], a1r[4], b1r[4];
#define G_LOAD(ar, br, ko)                                               \
  _Pragma("unroll") for (int i = 0; i < 4; i++) {                        \
    ar[i] = *(const u32x4*)(ga + (size_t)(32 * i) * lda + (ko));         \
    br[i] = *(const u32x4*)(gb + (size_t)(32 * i) * ldb + (ko));         \
  }
#define G_STORE(ar, br, buf)                                             \
  _Pragma("unroll") for (int i = 0; i < 4; i++) {                        \
    *(u32x4*)(wa + (buf)*SM_A + 32 * i * LSTR) = ar[i];                  \
    *(u32x4*)(wb + (buf)*SM_A + 32 * i * LSTR) = br[i];                  \
  }
#define G_COMPUTE(buf)                                                                   \
  _Pragma("unroll") for (int ks = 0; ks < 4; ks++) {                                     \
    const bf16x8 fa0 = *(const bf16x8*)(pa + (buf)*SM_A + ks * 16);                      \
    const bf16x8 fa1 = *(const bf16x8*)(pa + (buf)*SM_A + 32 * LSTR + ks * 16);          \
    const bf16x8 fb0 = *(const bf16x8*)(pb + (buf)*SM_A + ks * 16);                      \
    const bf16x8 fb1 = *(const bf16x8*)(pb + (buf)*SM_A + 32 * LSTR + ks * 16);          \
    acc[0][0] = __builtin_amdgcn_mfma_f32_32x32x16_bf16(fa0, fb0, acc[0][0], 0, 0, 0);   \
    acc[0][1] = __builtin_amdgcn_mfma_f32_32x32x16_bf16(fa0, fb1, acc[0][1], 0, 0, 0);   \
    acc[1][0] = __builtin_amdgcn_mfma_f32_32x32x16_bf16(fa1, fb0, acc[1][0], 0, 0, 0);   \
    acc[1][1] = __builtin_amdgcn_mfma_f32_32x32x16_bf16(fa1, fb1, acc[1][1], 0, 0, 0);   \
  }
  const int nk = K >> 6;
  if (DEEP) {
    G_LOAD(a0r, b0r, 0)
    G_LOAD(a1r, b1r, 64)
    G_STORE(a0r, b0r, 0)
    __syncthreads();
    const int klast = (nk - 1) * 64;
    G_LOAD(a0r, b0r, min(128, klast))
    for (int kt = 0; kt < nk; kt += 2) {
      G_COMPUTE(0)
      G_STORE(a1r, b1r, 1)
      __syncthreads();
      G_LOAD(a1r, b1r, min((kt + 3) * 64, klast))
      __builtin_amdgcn_sched_barrier(0);
      G_COMPUTE(1)
      G_STORE(a0r, b0r, 0)
      __syncthreads();
      G_LOAD(a0r, b0r, min((kt + 4) * 64, klast))
      __builtin_amdgcn_sched_barrier(0);
    }
  } else {
    G_LOAD(a0r, b0r, 0)
    G_STORE(a0r, b0r, 0)
    __syncthreads();
    for (int kt = 0; kt < nk; kt += 2) {
      G_LOAD(a0r, b0r, (kt + 1) * 64)
      G_COMPUTE(0)
      G_STORE(a0r, b0r, 1)
      __syncthreads();
      if (kt + 2 < nk) G_LOAD(a0r, b0r, (kt + 2) * 64)
      G_COMPUTE(1)
      if (kt + 2 < nk) G_STORE(a0r, b0r, 0)
      __syncthreads();
    }
  }
#undef G_LOAD
#undef G_STORE
#undef G_COMPUTE
}

__device__ __forceinline__ void zero_acc(f32x16 (&acc)[2][2]) {
#pragma unroll
  for (int i = 0; i < 2; i++)
#pragma unroll
    for (int j = 0; j < 2; j++)
#pragma unroll
      for (int e = 0; e < 16; e++) acc[i][j][e] = 0.f;
}

#define EPI_DECL                                                     \
  const int lane_ = ltid() & 63, wave_ = ltid() >> 6;      \
  const int wm_ = wave_ >> 1, wn_ = wave_ & 1, r_ = lane_ & 31, hh_ = lane_ >> 5; \
  (void)wm_; (void)wn_; (void)r_; (void)hh_;

__device__ __forceinline__ const float* src_col(const Params& p, int l, int kind, int n, int& ld) {
  switch (kind) {
    case 0:
      ld = IN_DIM;
      return n < 1952 ? p.w_in + (size_t)l * D * IN_DIM + 512 + n : nullptr;
    case 1:
      ld = IN_DIM;
      return p.w_in + (size_t)l * D * IN_DIM + 2464 + n;
    case 2:
      if (n < 512) {
        ld = 512;
        return p.w_uq + (size_t)l * 256 * 512 + n;
      } else {
        int m = n - 512, wt = m >> 6, jb = (m >> 5) & 1, idx = wt * 32 + (m & 31);
        int h = idx >> 4, e = idx & 15;
        ld = 256;
        return p.w_qr + (size_t)l * 256 * 256 + h * 32 + jb * 16 + e;
      }
    case 3:
      ld = 512;
      return n < 512 ? p.w_uk + (size_t)l * 128 * 512 + n : p.w_uv + (size_t)l * 128 * 512 + (n - 512);
    case 4: {
      int g = n >> 10, nn = n & 1023;
      ld = 1024;
      return p.w_branch + ((size_t)(l * 3 + g) * 512) * 1024 + nn;
    }
    case 5:
      ld = 1024;
      return p.w_out + (size_t)l * D * D + n;
    case 6: {
      int jb = (n >> 5) & 1, q = (n >> 6) * 32 + (n & 31);
      ld = FH;
      return (jb ? p.w_up : p.w_gate) + (size_t)l * D * FH + q;
    }
    default:
      ld = 1024;
      return p.w_down + (size_t)l * FH * D + n;
  }
}

__device__ __forceinline__ int job_nd(int k) {
  switch (k) { case 0: return 2048; case 1: return 3072; case 2: return 768; case 3: return 1024; case 4: return 3072;
    case 5: return 1024; case 6: return 5632; default: return 1024; }
}
__device__ __forceinline__ int job_kd(int k) {
  switch (k) { case 0: return 1024; case 1: return 1024; case 2: return 256; case 3: return 128; case 4: return 512;
    case 5: return 1024; case 6: return 1024; default: return 2816; }
}
__device__ __forceinline__ size_t job_od(int k) {
  switch (k) { case 0: return O_WP; case 1: return O_WG; case 2: return O_WUQ; case 3: return O_WUKV; case 4: return O_WB;
    case 5: return O_WO; case 6: return O_WGU; default: return O_WD; }
}
__device__ void prep_weights(const Params& p, int l, int bid, int nb, u16* smem) {
  float* tile = (float*)smem;
  const int tid = ltid();
  int start = 0;
#pragma unroll 1
  for (int kind = 0; kind < 8; kind++) {
    const int Kk = job_kd(kind);
    const int nkt = Kk >> 6, ntile = (job_nd(kind) >> 6) * nkt;
    u16* dst = wsp<u16>(p, job_od(kind));
    const float* ksc = kind == 2 ? p.gq + l * 256 : (kind == 3 ? p.gkv + l * 128 : nullptr);
    for (int t = (bid + nb - (start % nb)) % nb; t < ntile; t += nb) {
      const int nt = t / nkt, kt = t - nt * nkt;
      const int n0 = nt * 64, k0 = kt * 64;
      {
        const int kq = tid >> 4, nn4 = (tid & 15) * 4;
        int ld;
        const float* sp = src_col(p, l, kind, n0 + nn4, ld);
#pragma unroll
        for (int i = 0; i < 4; i++) {
          const int kk = i * 16 + kq;
          float4 v = make_float4(0.f, 0.f, 0.f, 0.f);
          if (sp) v = *(const float4*)(sp + (size_t)(k0 + kk) * ld);
          if (ksc) {
            const float sc = ksc[k0 + kk];
            v.x *= sc; v.y *= sc; v.z *= sc; v.w *= sc;
          }
          float* tp = tile + kk * 65 + nn4;
          tp[0] = v.x; tp[1] = v.y; tp[2] = v.z; tp[3] = v.w;
        }
      }
      __syncthreads();
#pragma unroll
      for (int i = 0; i < 2; i++) {
        const int c = tid + 256 * i;
        const int nn = c >> 3, kc = (c & 7) * 8;
        const float* tp = tile + kc * 65 + nn;
        uint4 o;
        o.x = pack2(tp[0], tp[65]);
        o.y = pack2(tp[2 * 65], tp[3 * 65]);
        o.z = pack2(tp[4 * 65], tp[5 * 65]);
        o.w = pack2(tp[6 * 65], tp[7 * 65]);
        *(uint4*)(dst + (size_t)(n0 + nn) * Kk + k0 + kc) = o;
      }
      __syncthreads();
    }
    start += ntile;
  }
  {
    float* ctab = (float*)smem;
    __syncthreads();
    if (tid < 128) ctab[tid] = cospif((float)tid * (1.f / 64.f));
    __syncthreads();
    u16* dst = wsp<u16>(p, O_WF);
    for (int it = bid; it < 512; it += nb) {
      const int o = it * 256 + tid;
      const int np = o & 1023, k8 = (o >> 10) * 8;
      const int reim = np >> 9, g = (np >> 7) & 3, m = np & 127;
      const float* w = p.w_in + (size_t)l * D * IN_DIM + (size_t)k8 * IN_DIM + g * 128;
      const int sh = reim ? 96 : 0;
      float a8[8];
#pragma unroll
      for (int j = 0; j < 8; j++) a8[j] = 0.f;
#pragma unroll 4
      for (int c = 0; c < 128; c++) {
        const float tw = ctab[(m * c + sh) & 127];
#pragma unroll
        for (int j = 0; j < 8; j++) a8[j] += w[(size_t)j * IN_DIM + c] * tw;
      }
      uint4 ov;
      ov.x = pack2(a8[0] * RS128, a8[1] * RS128);
      ov.y = pack2(a8[2] * RS128, a8[3] * RS128);
      ov.z = pack2(a8[4] * RS128, a8[5] * RS128);
      ov.w = pack2(a8[6] * RS128, a8[7] * RS128);
      *(uint4*)(dst + (size_t)np * 1024 + k8) = ov;
    }
    __syncthreads();
  }
}

__device__ void prep_tables(const Params& p, int bid, int nb) {
  u16* MA = wsp<u16>(p, O_MA);
  u16* MB = wsp<u16>(p, O_MB);
  u16* MC = wsp<u16>(p, O_MC);
  float* TW = wsp<float>(p, O_TW);
  const int total = 65536 + 32768 + 131072 + 16384;
  for (int idx = bid * 256 + ltid(); idx < total; idx += nb * 256) {
    if (idx < 65536) {
      const int n = idx >> 8, k = idx & 255;
      const int nt = n >> 7, wn = (n >> 6) & 1, jb = (n >> 5) & 1, klo = nt * 64 + wn * 32 + (n & 31);
      const int ri = k >> 7, nhi = k & 127;
      const int xx = (klo * nhi) & 127;
      const float c = cospif((float)xx * (1.f / 64.f)), s = sinpif((float)xx * (1.f / 64.f));
      float v = jb == 0 ? (ri == 0 ? c : -s) : (ri == 0 ? -s : -c);
      MA[idx] = f2bf(v * RS128);
    } else if (idx < 65536 + 32768) {
      const int i2 = idx - 65536;
      const int khi = i2 >> 8, k = i2 & 255;
      const int ri = k >> 7, nlo = k & 127;
      const int xx = (khi * nlo) & 127;
      const float c = cospif((float)xx * (1.f / 64.f)), s = sinpif((float)xx * (1.f / 64.f));
      MB[i2] = f2bf((ri == 0 ? c : s) * RS128);
    } else if (idx < 65536 + 32768 + 131072) {
      const int i2 = idx - 65536 - 32768;
      const int kk = i2 >> 9, k = i2 & 511;
      const int ri = k >> 8, nn = k & 255;
      const int xx = (kk * nn) & 255;
      const float c = cospif((float)xx * (1.f / 128.f)), s = sinpif((float)xx * (1.f / 128.f));
      MC[i2] = f2bf((ri == 0 ? c : -s) * 0.0625f);
    } else {
      const int i2 = idx - 65536 - 32768 - 131072;
      const int klo = i2 >> 7, nlo = i2 & 127;
      const int xx = klo * nlo;
      TW[i2 * 2] = cospif((float)xx * (1.f / 8192.f));
      TW[i2 * 2 + 1] = sinpif((float)xx * (1.f / 8192.f));
    }
  }
}

__device__ void prep_modp(const Params& p, int bid, int nb) {
  float* modp = wsp<float>(p, O_MODP);
  for (int it = bid; it < 2 * 16 * 24; it += nb) {
    const int l = it / (16 * 24), rem = it - l * 16 * 24, kc = rem / 24, nblk = rem - kc * 24;
    const int n = nblk * 256 + ltid();
    const float* w = p.w_mod + (size_t)l * D * 6144 + n;
    float a0 = 0.f, a1 = 0.f, a2 = 0.f;
#pragma unroll 8
    for (int kk = 0; kk < 64; kk++) {
      const int k = kc * 64 + kk;
      const float wv = w[(size_t)k * 6144];
      float c0 = p.c[k], c1 = p.c[1024 + k], c2 = p.c_ctx[k];
      c0 = c0 / (1.f + __expf(-c0));
      c1 = c1 / (1.f + __expf(-c1));
      c2 = c2 / (1.f + __expf(-c2));
      a0 += c0 * wv;
      a1 += c1 * wv;
      a2 += c2 * wv;
    }
    float* o = modp + ((size_t)(kc * 2 + l) * 3) * 6144 + n;
    o[0] = a0;
    o[6144] = a1;
    o[2 * 6144] = a2;
  }
}
__device__ void prep_modr(const Params& p, int bid, int nb) {
  const float* modp = wsp<float>(p, O_MODP);
  float* mod = wsp<float>(p, O_MOD);
  for (int idx = bid * 256 + ltid(); idx < 2 * 3 * 6144; idx += nb * 256) {
    const int l = idx / (3 * 6144), n = idx % 6144;
    float v = p.b_mod[l * 6144 + n];
    for (int kc = 0; kc < 16; kc++) v += modp[(size_t)kc * 2 * 3 * 6144 + idx];
    mod[idx] = v;
  }
}

__device__ void ln_phase(const Params& p, int mode, const float* g, const float* bta, int lmod, int shoff, int scoff,
                         bool skip_ctx, int bid, int nb) {
  const int lane = ltid() & 63, wave = ltid() >> 6;
  u16* A = wsp<u16>(p, O_A);
  const float* mod = wsp<float>(p, O_MOD);
  for (int row = bid * 4 + wave; row < T; row += nb * 4) {
    const int b = row / KPB, kk = row - b * KPB;
    if (skip_ctx && kk < CTXL) continue;
    float* xr = xrow(p, row);
    const float* src;
    if (mode == 0)
      src = kk < CTXL ? p.ctx + (size_t)(b * CTXL + kk) * D : p.x + (size_t)(b * SEQ + kk - CTXL) * D;
    else
      src = xr;
    float4 v[4];
    float s = 0.f;
#pragma unroll
    for (int i = 0; i < 4; i++) {
      v[i] = *(const float4*)(src + i * 256 + lane * 4);
      s += v[i].x + v[i].y + v[i].z + v[i].w;
    }
    const float mu = wsum(s) * (1.f / 1024.f);
    float q = 0.f;
#pragma unroll
    for (int i = 0; i < 4; i++) {
      v[i].x -= mu; v[i].y -= mu; v[i].z -= mu; v[i].w -= mu;
      q += v[i].x * v[i].x + v[i].y * v[i].y + v[i].z * v[i].z + v[i].w * v[i].w;
    }
    const float rstd = rsqrtf(wsum(q) * (1.f / 1024.f) + EPS);
    const int m = kk < CTXL ? 2 : b;
    const float* md = mod + ((size_t)(lmod < 0 ? 0 : lmod) * 3 + m) * 6144;
#pragma unroll
    for (int i = 0; i < 4; i++) {
      const int c0 = i * 256 + lane * 4;
      const float4 gg = *(const float4*)(g + c0), bb = *(const float4*)(bta + c0);
      float4 y;
      y.x = v[i].x * rstd * gg.x + bb.x;
      y.y = v[i].y * rstd * gg.y + bb.y;
      y.z = v[i].z * rstd * gg.z + bb.z;
      y.w = v[i].w * rstd * gg.w + bb.w;
      *(float4*)(xr + c0) = y;
      if (lmod >= 0) {
        const float4 sh = *(const float4*)(md + shoff + c0), sc = *(const float4*)(md + scoff + c0);
        uint2 o;
        o.x = pack2(y.x * (1.f + sc.x) + sh.x, y.y * (1.f + sc.y) + sh.y);
        o.y = pack2(y.z * (1.f + sc.z) + sh.z, y.w * (1.f + sc.w) + sh.w);
        *(uint2*)(A + (size_t)row * D + c0) = o;
      }
    }
  }
}

#define PATCH_LOOP_BEGIN(NR_, NC_, PR_, PC_)                                   \
  {                                                                            \
    const int x_ = bid & 7, w_ = bid >> 3, nbx_ = nb >> 3;                     \
    const int CG_ = ((NC_) + (PC_)-1) / (PC_);                                 \
    const int npatch_ = (((NR_) + (PR_)-1) / (PR_)) * CG_;                     \
    for (int u_ = w_;; u_ += nbx_) {                                           \
      const int g_ = (u_ >> 6) * 8 + x_;                                       \
      if (g_ >= npatch_) break;                                                \
      const int s_ = u_ & 63;                                                  \
      const int rg_ = g_ / CG_;                                                \
      const int prt = rg_ * (PR_) + s_ / (PC_);                                \
      const int pct = (g_ - rg_ * CG_) * (PC_) + s_ % (PC_);                   \
      if (prt >= (NR_) || pct >= (NC_)) continue;
#define PATCH_LOOP_END \
    }                  \
  }

__device__ void phase_p1(const Params& p, int l, bool last, int bid, int nb, u16* smem) {
  EPI_DECL
  const u16* A = wsp<u16>(p, O_A);
  PATCH_LOOP_BEGIN(NRT, 16, 8, 8)
    f32x16 acc[2][2];
    zero_acc(acc);
    {
      const int rt = prt, ct = pct;
      const int row0 = rt * 128, b = row0 / KPB, kk0 = row0 - b * KPB;
      if (ct < 8 || ct >= 12) {
        gemm_core(acc, wsp<u16>(p, O_WP) + (size_t)ct * 128 * D, D, A + (size_t)rt * 128 * D, D, D, smem);
        u16* dst;
        float sc = 1.f;
        int cb;
        if (ct < 4) { dst = wsp<u16>(p, O_QNA); sc = NA_SCALE_L2; cb = ct * 128; }
        else if (ct < 8) { dst = wsp<u16>(p, O_KNA); cb = (ct - 4) * 128; }
        else { dst = wsp<u16>(p, O_LAT); cb = (ct - 12) * 128; }
#pragma unroll
        for (int i = 0; i < 2; i++)
#pragma unroll
          for (int j = 0; j < 2; j++)
#pragma unroll
            for (int g = 0; g < 4; g++) {
              const int row = row0 + wn_ * 64 + j * 32 + r_;
              const int col = cb + wm_ * 64 + i * 32 + 8 * g + 4 * hh_;
              uint2 o;
              o.x = pack2(acc[i][j][4 * g] * sc, acc[i][j][4 * g + 1] * sc);
              o.y = pack2(acc[i][j][4 * g + 2] * sc, acc[i][j][4 * g + 3] * sc);
              *(uint2*)(dst + (size_t)row * 512 + col) = o;
            }
      } else {
        gemm_core(acc, A + (size_t)rt * 128 * D, D, wsp<u16>(p, O_WP) + (size_t)ct * 128 * D, D, D, smem);
        u16* dst = wsp<u16>(p, O_VNAT);
        const int cb = (ct - 8) * 128;
#pragma unroll
        for (int i = 0; i < 2; i++)
#pragma unroll
          for (int j = 0; j < 2; j++)
#pragma unroll
            for (int g = 0; g < 4; g++) {
              const int kk = kk0 + wm_ * 64 + i * 32 + 8 * g + 4 * hh_;
              const int col = cb + wn_ * 64 + j * 32 + r_;
              uint2 o;
              o.x = pack2(acc[i][j][4 * g], acc[i][j][4 * g + 1]);
              o.y = pack2(acc[i][j][4 * g + 2], acc[i][j][4 * g + 3]);
              *(uint2*)(dst + ((size_t)(b * 512 + col)) * KPB + kk) = o;
            }
      }
    }
  PATCH_LOOP_END
  PATCH_LOOP_BEGIN(256, 8, 8, 8)
    f32x16 acc[2][2];
    zero_acc(acc);
    {
      const int rt = prt, ct = pct;
      const int b = rt >> 7, nlo = rt & 127;
      gemm_core(acc, A + (size_t)(b * KPB + CTXL + nlo) * D, (size_t)128 * D,
                wsp<u16>(p, O_WF) + (size_t)ct * 128 * D, D, D, smem);
      u16* dst = wsp<u16>(p, O_D1);
#pragma unroll
      for (int i = 0; i < 2; i++)
#pragma unroll
        for (int j = 0; j < 2; j++)
#pragma unroll
          for (int g = 0; g < 4; g++) {
            const int nhi = wm_ * 64 + i * 32 + 8 * g + 4 * hh_;
            const int n = ct * 128 + wn_ * 64 + j * 32 + r_;
            const int reim = n >> 9, jj = n & 511;
            uint2 o;
            o.x = pack2(acc[i][j][4 * g], acc[i][j][4 * g + 1]);
            o.y = pack2(acc[i][j][4 * g + 2], acc[i][j][4 * g + 3]);
            *(uint2*)(dst + ((((size_t)(b * 512 + jj)) * 128 + nlo) * 2 + reim) * 128 + nhi) = o;
          }
    }
  PATCH_LOOP_END
  if (!last) {
    for (int t2 = bid; t2 < 32; t2 += nb) {
      f32x16 acc[2][2];
      zero_acc(acc);
      const int rt = t2 >> 3, ct = t2 & 7;
      const int b = rt >> 1, rb = rt & 1;
      gemm_core(acc, A + (size_t)(b * KPB + rb * 128) * D, D, wsp<u16>(p, O_WF) + (size_t)ct * 128 * D, D, D, smem);
      u16* dst = wsp<u16>(p, O_D1C);
#pragma unroll
      for (int i = 0; i < 2; i++)
#pragma unroll
        for (int j = 0; j < 2; j++)
#pragma unroll
          for (int g = 0; g < 4; g++) {
            const int nc = rb * 128 + wm_ * 64 + i * 32 + 8 * g + 4 * hh_;
            const int n = ct * 128 + wn_ * 64 + j * 32 + r_;
            const int reim = n >> 9, jj = n & 511;
            uint2 o;
            o.x = pack2(acc[i][j][4 * g], acc[i][j][4 * g + 1]);
            o.y = pack2(acc[i][j][4 * g + 2], acc[i][j][4 * g + 3]);
            *(uint2*)(dst + (((size_t)(b * 512 + jj)) * 2 + reim) * 256 + nc) = o;
          }
    }
  }
}

__device__ __forceinline__ float inv_freq(int i) {
  switch (i) {
    case 0: return 1.0f;
    case 1: return 0.31622776601683794f;
    case 2: return 0.1f;
    case 3: return 0.03162277660168379f;
    case 4: return 0.01f;
    case 5: return 0.0031622776601683794f;
    case 6: return 0.001f;
    default: return 0.00031622776601683794f;
  }
}
__device__ __forceinline__ void rope_cs(int kk, int e, float& cs, float& sn) {
  if (kk < CTXL) { cs = 1.f; sn = 0.f; return; }
  const int tkn = kk - CTXL;
  const float pos = (e < 8) ? (float)(tkn >> 6) : (float)(tkn & 63);
  const float ang = pos * inv_freq(e & 7);
  double xr = (double)ang * 0.31830988618379067;
  xr -= 2.0 * floor(xr * 0.5);
  const float yr = (float)xr;
  cs = cospif(yr);
  sn = sinpif(yr);
}

__device__ __forceinline__ void row_rms(const u16* A, size_t lda, int K, float* rs) {
  const int tid = ltid();
  const int row = tid >> 1, half = tid & 1;
  const u16* pr = A + (size_t)row * lda + half * (K >> 1);
  float s = 0.f;
  for (int c = 0; c < (K >> 1); c += 8) {
    uint4 v = *(const uint4*)(pr + c);
    const uint32_t w[4] = {v.x, v.y, v.z, v.w};
#pragma unroll
    for (int q = 0; q < 4; q++) {
      const float a = __uint_as_float(w[q] << 16), bq = __uint_as_float(w[q] & 0xffff0000u);
      s += a * a + bq * bq;
    }
  }
  s += __shfl_xor(s, 1);
  if (half == 0) rs[row] = rsqrtf(s / (float)K + EPS);
  __syncthreads();
}

__device__ void phase_p2(const Params& p, int l, int bid, int nb, u16* smem) {
  EPI_DECL
  const u16* LAT = wsp<u16>(p, O_LAT);
  float* rs = (float*)(smem + 4 * SM_A);
  const int nQ = NRT * 6, nKV = NRT * 8, nFA = 1024 * 2, nKR = NRT;
  const int total = nQ + nKV + nFA + nKR;
  for (int t = bid; t < total; t += nb) {
    if (t < nQ) {
      const int rt = t / 6, ct = t - rt * 6;
      const int row0 = rt * 128, b = row0 / KPB, kk0 = row0 - b * KPB;
      row_rms(LAT + (size_t)row0 * 512, 512, 256, rs);
      f32x16 acc[2][2];
      zero_acc(acc);
      gemm_core(acc, wsp<u16>(p, O_WUQ) + (size_t)ct * 128 * 256, 256, LAT + (size_t)row0 * 512, 512, 256, smem);
      u16* QM = wsp<u16>(p, O_QM);
      if (ct < 4) {
#pragma unroll
        for (int i = 0; i < 2; i++)
#pragma unroll
          for (int j = 0; j < 2; j++)
#pragma unroll
            for (int g = 0; g < 4; g++) {
              const int rl = wn_ * 64 + j * 32 + r_;
              const int col = ct * 128 + wm_ * 64 + i * 32 + 8 * g + 4 * hh_;
              const int h = col >> 6, d = col & 63;
              const float sc = rs[rl] * MLA_SCALE_L2;
              uint2 o;
              o.x = pack2(acc[i][j][4 * g] * sc, acc[i][j][4 * g + 1] * sc);
              o.y = pack2(acc[i][j][4 * g + 2] * sc, acc[i][j][4 * g + 3] * sc);
              *(uint2*)(QM + (size_t)(row0 + rl) * 768 + h * 96 + d) = o;
            }
      } else {
        const int wt = (ct - 4) * 2 + wm_;
#pragma unroll
        for (int j = 0; j < 2; j++) {
          const int rl = wn_ * 64 + j * 32 + r_;
          const float sc = rs[rl] * MLA_SCALE_L2;
#pragma unroll
          for (int g = 0; g < 4; g++) {
            const int idx = wt * 32 + 8 * g + 4 * hh_;
            const int h = idx >> 4, e16 = idx & 15;
            float o1[4], o2[4];
#pragma unroll
            for (int q = 0; q < 4; q++) {
              float cs, sn;
              rope_cs(kk0 + rl, e16 + q, cs, sn);
              const float x1 = acc[0][j][4 * g + q] * sc, x2 = acc[1][j][4 * g + q] * sc;
              o1[q] = x1 * cs - x2 * sn;
              o2[q] = x2 * cs + x1 * sn;
            }
            u16* qd = QM + (size_t)(row0 + rl) * 768 + h * 96 + 64 + e16;
            uint2 o;
            o.x = pack2(o1[0], o1[1]);
            o.y = pack2(o1[2], o1[3]);
            *(uint2*)qd = o;
            o.x = pack2(o2[0], o2[1]);
            o.y = pack2(o2[2], o2[3]);
            *(uint2*)(qd + 16) = o;
          }
        }
      }
      __syncthreads();
    } else if (t < nQ + nKV) {
      const int t2 = t - nQ;
      const int rt = t2 >> 3, ct = t2 & 7;
      const int row0 = rt * 128, b = row0 / KPB, kk0 = row0 - b * KPB;
      row_rms(LAT + (size_t)row0 * 512 + 256, 512, 128, rs);
      f32x16 acc[2][2];
      zero_acc(acc);
      if (ct < 4) {
        gemm_core(acc, wsp<u16>(p, O_WUKV) + (size_t)ct * 128 * 128, 128, LAT + (size_t)row0 * 512 + 256, 512, 128,
                  smem);
        u16* KN = wsp<u16>(p, O_KN);
#pragma unroll
        for (int i = 0; i < 2; i++)
#pragma unroll
          for (int j = 0; j < 2; j++)
#pragma unroll
            for (int g = 0; g < 4; g++) {
              const int rl = wn_ * 64 + j * 32 + r_;
              const int col = ct * 128 + wm_ * 64 + i * 32 + 8 * g + 4 * hh_;
              const float sc = rs[rl];
              uint2 o;
              o.x = pack2(acc[i][j][4 * g] * sc, acc[i][j][4 * g + 1] * sc);
              o.y = pack2(acc[i][j][4 * g + 2] * sc, acc[i][j][4 * g + 3] * sc);
              *(uint2*)(KN + (size_t)(row0 + rl) * 512 + col) = o;
            }
      } else {
        gemm_core(acc, LAT + (size_t)row0 * 512 + 256, 512, wsp<u16>(p, O_WUKV) + (size_t)ct * 128 * 128, 128, 128,
                  smem);
        u16* VMT = wsp<u16>(p, O_VMT);
#pragma unroll
        for (int i = 0; i < 2; i++)
#pragma unroll
          for (int j = 0; j < 2; j++)
#pragma unroll
            for (int g = 0; g < 4; g++) {
              const int rl = wm_ * 64 + i * 32 + 8 * g + 4 * hh_;
              const int col = (ct - 4) * 128 + wn_ * 64 + j * 32 + r_;
              uint2 o;
              o.x = pack2(acc[i][j][4 * g] * rs[rl], acc[i][j][4 * g + 1] * rs[rl + 1]);
              o.y = pack2(acc[i][j][4 * g + 2] * rs[rl + 2], acc[i][j][4 * g + 3] * rs[rl + 3]);
              *(uint2*)(VMT + ((size_t)(b * 512 + col)) * KPB + kk0 + rl) = o;
            }
      }
      __syncthreads();
    } else if (t < nQ + nKV + nFA) {
      const int t2 = t - nQ - nKV;
      const int rt = t2 >> 1, ct = t2 & 1;
      const int b = rt >> 9, jj = rt & 511;
      f32x16 acc[2][2];
      zero_acc(acc);
      gemm_core(acc, wsp<u16>(p, O_D1) + (size_t)rt * 128 * 256, 256, wsp<u16>(p, O_MA) + (size_t)ct * 128 * 256, 256,
                256, smem);
      const float* TW = wsp<float>(p, O_TW);
      u16* D2 = wsp<u16>(p, O_D2);
      const int klo = ct * 64 + wn_ * 32 + r_;
#pragma unroll
      for (int i = 0; i < 2; i++)
#pragma unroll
        for (int g = 0; g < 4; g++) {
          const int nlo = wm_ * 64 + i * 32 + 8 * g + 4 * hh_;
          float re[4], im[4];
#pragma unroll
          for (int q = 0; q < 4; q++) {
            const float2 tw = *(const float2*)(TW + ((size_t)klo * 128 + nlo + q) * 2);
            const float ar = acc[i][0][4 * g + q], ai = acc[i][1][4 * g + q];
            re[q] = ar * tw.x + ai * tw.y;
            im[q] = ai * tw.x - ar * tw.y;
          }
          u16* d = D2 + ((((size_t)(b * 128 + klo)) * 512 + jj) * 2) * 128 + nlo;
          uint2 o;
          o.x = pack2(re[0], re[1]);
          o.y = pack2(re[2], re[3]);
          *(uint2*)d = o;
          o.x = pack2(im[0], im[1]);
          o.y = pack2(im[2], im[3]);
          *(uint2*)(d + 128) = o;
        }
    } else {
      const int rt = t - nQ - nKV - nFA;
      u16* KRR = wsp<u16>(p, O_KRR);
      for (int idx = ltid(); idx < 128 * 16; idx += 256) {
        const int rl = idx >> 4, e16 = idx & 15;
        const int row = rt * 128 + rl, b = row / KPB, kk = row - b * KPB;
        const float x1 = bf2f(LAT[(size_t)row * 512 + 384 + e16]), x2 = bf2f(LAT[(size_t)row * 512 + 400 + e16]);
        float cs, sn;
        rope_cs(kk, e16, cs, sn);
        KRR[(size_t)row * 32 + e16] = f2bf(x1 * cs - x2 * sn);
        KRR[(size_t)row * 32 + 16 + e16] = f2bf(x2 * cs + x1 * sn);
      }
    }
  }
}

template <int MODE>
__device__ void attn_item(const Params& p, int l, int b, int h, int q0  ,
                          int ntiles  , int rs0, int ycol, u16* smem) {
  constexpr int DQK = MODE == 0 ? 96 : 64;
  constexpr int KSTR = DQK + 8;
  constexpr int NKS = DQK / 16;
  constexpr int CPR = DQK / 8;
  constexpr int NKC = 64 * CPR / 256;
  const int tid = ltid(), lane = tid & 63, wave = tid >> 6, r = lane & 31, hh = lane >> 5;
  u16* Ks = smem;
  u16* Vs = smem + 2 * 64 * KSTR;
  const unsigned char* wsb = p.ws;
  const int qk = q0 + wave * 32 + r;
  const size_t qrow = (size_t)b * KPB + qk;
  bf16x8 qf[NKS];
  {
    const u16* qp = MODE == 0 ? wsp<u16>(p, O_QM) + qrow * 768 + h * 96 : wsp<u16>(p, O_QNA) + qrow * 512 + h * 64;
#pragma unroll
    for (int ks = 0; ks < NKS; ks++) qf[ks] = *(const bf16x8*)(qp + ks * 16 + hh * 8);
  }
  const short one_or_zero = hh == 0 ? (short)0x3F80 : (short)0;
  const bf16x8 kone = {one_or_zero, 0, 0, 0, 0, 0, 0, 0};
  bf16x8 qm = {0, 0, 0, 0, 0, 0, 0, 0};
  int qr = 0, qc = 0, rsq = 0, cs = 0;
  const float* rpb = nullptr;
  if (MODE == 1 && rs0 >= 0) {
    const int tkn = qk - CTXL;
    qr = tkn >> 6;
    qc = tkn & 63;
    rsq = min(max(qr - 4, 0), 248);
    cs = min(max(qc - 8, 0), 48);
    rpb = p.rpb + ((size_t)(l * 8 + h)) * 15 * 31;
  }
  f32x16 o[2], ol;
#pragma unroll
  for (int e = 0; e < 16; e++) { o[0][e] = 0.f; o[1][e] = 0.f; ol[e] = 0.f; }
  float m = 0.f;
  const bf16x8 ones = {(short)0x3F80, (short)0x3F80, (short)0x3F80, (short)0x3F80,
                       (short)0x3F80, (short)0x3F80, (short)0x3F80, (short)0x3F80};

#define KGEO(i)                                                                                          \
  uint32_t kof##i, kmu##i;                                                                               \
  int kls##i;                                                                                            \
  {                                                                                                      \
    const int c = tid + 256 * (i);                                                                       \
    const int row = c / CPR, cc = c - row * CPR;                                                         \
    if (MODE == 0 && cc >= 8) {                                                                          \
      kof##i = (uint32_t)(O_KRR + ((size_t)(b * KPB + row) * 32 + (cc - 8) * 8) * 2);                    \
      kmu##i = 64u;                                                                                      \
    } else {                                                                                             \
      kof##i = (uint32_t)((MODE == 0 ? O_KN : O_KNA) + ((size_t)(b * KPB + row) * 512 + h * 64 + cc * 8) * 2); \
      kmu##i = 1024u;                                                                                    \
    }                                                                                                    \
    kls##i = row * KSTR + cc * 8;                                                                        \
  }
#define VGEO(i)                                                                                          \
  uint32_t vof##i;                                                                                       \
  int vls##i;                                                                                            \
  bool vsx##i;                                                                                           \
  {                                                                                                      \
    const int c = tid + 256 * (i);                                                                       \
    const int d = c >> 3, cc = c & 7;                                                                    \
    vof##i = (uint32_t)((MODE == 0 ? O_VMT : O_VNAT) + ((size_t)(b * 512 + h * 64 + d) * KPB + cc * 8) * 2); \
    vls##i = d * 72 + cc * 8;                                                                            \
    vsx##i = (d & 8) != 0;                                                                               \
  }
  KGEO(0) KGEO(1) KGEO(2) VGEO(0) VGEO(1)
  (void)kof2; (void)kmu2; (void)kls2;
  u32x4 kr0A, kr1A, kr2A, vr0A, vr1A, kr0B, kr1B, kr2B, vr0B, vr1B;
  kr2A = kr1A = kr0A = vr0A = vr1A = kr2B = kr1B = kr0B = vr0B = vr1B = (u32x4){0u, 0u, 0u, 0u};
#define TILE_KK0(t) ((MODE == 1 && (t) >= 4) ? (uint32_t)(CTXL + 64 * min(rs0 + (t)-4, 255)) : (uint32_t)(64 * (t)))
#define LOAD_KV(t, S)                                                                   \
  {                                                                                     \
    const uint32_t kk0_ = TILE_KK0(t);                                                  \
    kr0##S = *(const u32x4*)(wsb + (size_t)(kof0 + kk0_ * kmu0));                       \
    kr1##S = *(const u32x4*)(wsb + (size_t)(kof1 + kk0_ * kmu1));                       \
    if (NKC == 3) kr2##S = *(const u32x4*)(wsb + (size_t)(kof2 + kk0_ * kmu2));         \
    vr0##S = *(const u32x4*)(wsb + (size_t)(vof0 + kk0_ * 2u));                         \
    vr1##S = *(const u32x4*)(wsb + (size_t)(vof1 + kk0_ * 2u));                         \
  }
#define STORE_V1(buf, i, srcv)                                                          \
  {                                                                                     \
    u32x4 sv_ = srcv;                                                                   \
    if (vsx##i) sv_ = (u32x4){sv_[2], sv_[3], sv_[0], sv_[1]};                          \
    *(u32x4*)(Vs + (buf)*64 * 72 + vls##i) = sv_;                                       \
  }
#define STORE_KV(buf, S)                                                                \
  {                                                                                     \
    *(u32x4*)(Ks + (buf)*64 * KSTR + kls0) = kr0##S;                                    \
    *(u32x4*)(Ks + (buf)*64 * KSTR + kls1) = kr1##S;                                    \
    if (NKC == 3) *(u32x4*)(Ks + (buf)*64 * KSTR + kls2) = kr2##S;                      \
    STORE_V1(buf, 0, vr0##S) STORE_V1(buf, 1, vr1##S)                                   \
  }
#define QK_TILE(kbuf, t)                                                                           \
  {                                                                                                \
    const u16* kb_ = Ks + (kbuf)*64 * KSTR + r * KSTR + hh * 8;                                    \
    {                                                                                              \
      f32x16 z_;                                                                                   \
      _Pragma("unroll") for (int e = 0; e < 16; e++) z_[e] = 0.f;                                  \
      sc[0] = __builtin_amdgcn_mfma_f32_32x32x16_bf16(kone, qm, z_, 0, 0, 0);                      \
      sc[1] = sc[0];                                                                               \
    }                                                                                              \
    _Pragma("unroll") for (int ks = 0; ks < NKS; ks++) {                                           \
      const bf16x8 kf0 = *(const bf16x8*)(kb_ + ks * 16);                                          \
      const bf16x8 kf1 = *(const bf16x8*)(kb_ + 32 * KSTR + ks * 16);                              \
      sc[0] = __builtin_amdgcn_mfma_f32_32x32x16_bf16(kf0, qf[ks], sc[0], 0, 0, 0);                \
      sc[1] = __builtin_amdgcn_mfma_f32_32x32x16_bf16(kf1, qf[ks], sc[1], 0, 0, 0);                \
    }                                                                                              \
    if (MODE == 1 && (t) >= 4) {                                                                   \
      const int kr_ = rs0 + (t)-4;                                                                 \
      const bool rowok = (kr_ >= rsq) && (kr_ < rsq + 8);                                          \
      const float* rp = rpb + (kr_ - qr + 7) * 31 + (15 - qc);                                     \
      _Pragma("unroll") for (int kb = 0; kb < 2; kb++) _Pragma("unroll") for (int e = 0; e < 16; e++) { \
        const int kc = kb * 32 + (e & 3) + 8 * (e >> 2) + 4 * hh;                                  \
        const bool valid = rowok && (kc >= cs) && (kc < cs + 16);                                  \
        float bias = 0.f;                                                                          \
        if (valid) bias = rp[kc];                                                                  \
        sc[kb][e] = valid ? sc[kb][e] + bias * LOG2E : -1e30f;                                     \
      }                                                                                            \
    }                                                                                              \
  }
#define TILE_MAX(tmax)                                                                             \
  {                                                                                                \
    tmax = sc[0][0];                                                                               \
    _Pragma("unroll") for (int e = 1; e < 16; e++) tmax = fmaxf(tmax, sc[0][e]);                   \
    _Pragma("unroll") for (int e = 0; e < 16; e++) tmax = fmaxf(tmax, sc[1][e]);                   \
    const uint32_t tu = __float_as_uint(tmax);                                                     \
    const auto sw = __builtin_amdgcn_permlane32_swap(tu, tu, false, false);                        \
    tmax = fmaxf(__uint_as_float(sw[0]), __uint_as_float(sw[1]));                                  \
  }
#define MOVE_REF(mnew_)                                                                            \
  {                                                                                                \
    const float mq_ = bf2f(f2bf(mnew_));                                                           \
    const float delta_ = mq_ - m;                                                                  \
    const float alpha = __builtin_amdgcn_exp2f(-delta_);                                           \
    m = mq_;                                                                                       \
    _Pragma("unroll") for (int e = 0; e < 16; e++) {                                               \
      o[0][e] *= alpha; o[1][e] *= alpha; ol[e] *= alpha;                                          \
      sc[0][e] -= delta_; sc[1][e] -= delta_;                                                      \
    }                                                                                              \
    qm[0] = (hh == 0) ? (short)f2bf(-m) : (short)0;                                                \
  }
#define SOFTMAX_PV(vbuf)                                                                           \
  {                                                                                                \
    const u16* vb_ = Vs + (vbuf)*64 * 72 + r * 72 + vsw;                                           \
    _Pragma("unroll") for (int kb = 0; kb < 2; kb++) _Pragma("unroll") for (int st = 0; st < 2; st++) { \
      u32x4 pu;                                                                                    \
      _Pragma("unroll") for (int q = 0; q < 4; q++)                                                \
        pu[q] = pack2(__builtin_amdgcn_exp2f(sc[kb][8 * st + 2 * q]),                              \
                      __builtin_amdgcn_exp2f(sc[kb][8 * st + 2 * q + 1]));                         \
      const bf16x8 pbv = __builtin_bit_cast(bf16x8, pu);                                           \
      _Pragma("unroll") for (int db = 0; db < 2; db++) {                                           \
        const u16* vp = vb_ + db * 32 * 72 + kb * 32 + 16 * st;                                    \
        const bf16x4 vlo = *(const bf16x4*)(vp);                                                   \
        const bf16x4 vhi = *(const bf16x4*)(vp + 8);                                               \
        const bf16x8 vfv = __builtin_shufflevector(vlo, vhi, 0, 1, 2, 3, 4, 5, 6, 7);              \
        o[db] = __builtin_amdgcn_mfma_f32_32x32x16_bf16(vfv, pbv, o[db], 0, 0, 0);                 \
      }                                                                                            \
      ol = __builtin_amdgcn_mfma_f32_32x32x16_bf16(ones, pbv, ol, 0, 0, 0);                        \
    }                                                                                              \
  }
#define DEFER_REF(tmax)                                                                            \
  if (__any(tmax > 8.f)) {                                                                         \
    const float mq_ = bf2f(f2bf(m + fmaxf(tmax, 0.f)));                                            \
    const float alpha = __builtin_amdgcn_exp2f(m - mq_);                                           \
    m = mq_;                                                                                       \
    _Pragma("unroll") for (int e = 0; e < 16; e++) { o[0][e] *= alpha; o[1][e] *= alpha; ol[e] *= alpha; } \
    qm[0] = (hh == 0) ? (short)f2bf(-m) : (short)0;                                                \
  }
#define ATT_STEP(t, LD, ST)                                        \
  {                                                                \
    const int cur = (t)&1;                                         \
    LOAD_KV(min((t) + 2, tl), LD)                                  \
    __builtin_amdgcn_sched_barrier(0);                             \
    QK_TILE(cur, t)                                                \
    SOFTMAX_PV(cur)                                                \
    float tmax;                                                    \
    TILE_MAX(tmax)                                                 \
    DEFER_REF(tmax)                                                \
    STORE_KV(cur ^ 1, ST)                                          \
    __syncthreads();                                               \
  }

  const int tl = ntiles - 1;
  const int vsw = 4 * (hh ^ ((r >> 3) & 1));
  f32x16 sc[2];
  LOAD_KV(0, A)
  STORE_KV(0, A)
  LOAD_KV(min(1, tl), A)
  __syncthreads();
  {
    LOAD_KV(min(2, tl), B)
    __builtin_amdgcn_sched_barrier(0);
    QK_TILE(0, 0)
    float tmax;
    TILE_MAX(tmax)
    MOVE_REF(tmax)
    SOFTMAX_PV(0)
    STORE_KV(1, A)
    __syncthreads();
  }
  for (int t = 1; t + 1 < ntiles; t += 2) {
    ATT_STEP(t, A, B)
    ATT_STEP(t + 1, B, A)
  }
  ATT_STEP(tl, A, B)
  const float inv = 1.f / ol[0];
  u16* yp = wsp<u16>(p, O_Y) + qrow * 1536 + ycol + h * 64;
#pragma unroll
  for (int db = 0; db < 2; db++)
#pragma unroll
    for (int g = 0; g < 4; g++) {
      uint2 ov;
      ov.x = pack2(o[db][4 * g] * inv, o[db][4 * g + 1] * inv);
      ov.y = pack2(o[db][4 * g + 2] * inv, o[db][4 * g + 3] * inv);
      *(uint2*)(yp + db * 32 + 8 * g + 4 * hh) = ov;
    }
#undef KGEO
#undef VGEO
#undef TILE_KK0
#undef LOAD_KV
#undef STORE_V1
#undef STORE_KV
#undef QK_TILE
#undef TILE_MAX
#undef MOVE_REF
#undef SOFTMAX_PV
#undef ATT_STEP
#undef DEFER_REF
}

__device__ void phase_p3(const Params& p, int l, bool last, int bid, int nb, u16* smem) {
  EPI_DECL
  const int nMLA = 2048, nNA = 2048, nFB = 1024;
  const int nC = last ? 0 : (32 + 32 + 16);
  const int total = nMLA + nNA + nFB + nC;
  for (int t = bid; t < total; t += nb) {
    int kind, b = 0, h = 0, q0 = 0, ntl = 0, rs0 = -1;
    size_t aoff = 0, boff = 0;
    int Kf = 256, j0 = 0, tok0 = 0, tokmul = 1, colbase = 0;
    if (t < nMLA) {
      kind = 0;
      h = t & 7;
      const int rest = t >> 3;
      b = rest >> 7;
      q0 = CTXL + (rest & 127) * 128;
      ntl = 260;
    } else if (t < nMLA + nNA) {
      kind = 1;
      const int t2 = t - nMLA;
      h = t2 & 7;
      const int rest = t2 >> 3, rp = rest & 127;
      b = rest >> 7;
      rs0 = min(max(2 * rp - 4, 0), 248);
      const int rs1 = min(max(2 * rp + 1 - 4, 0), 248);
      q0 = CTXL + rp * 128;
      ntl = (4 + (rs1 + 8 - rs0) + 1) & ~1;
    } else if (t < nMLA + nNA + nFB) {
      kind = 2;
      const int rt = t - nMLA - nNA;
      const int bk = rt >> 2;
      j0 = (rt & 3) * 128;
      b = bk >> 7;
      tok0 = CTXL + (bk & 127);
      tokmul = 128;
      aoff = O_D2 + (size_t)rt * 128 * 256 * 2;
      boff = O_MB;
      Kf = 256;
    } else {
      const int t2 = t - nMLA - nNA - nFB;
      if (t2 < 64) {
        kind = t2 >> 5;
        const int t3 = t2 & 31;
        h = t3 & 7;
        b = (t3 >> 3) & 1;
        q0 = (t3 >> 4) * 128;
        ntl = 4;
      } else {
        kind = 2;
        const int t3 = t2 - 64;
        const int rt = t3 >> 1, ct = t3 & 1;
        b = rt >> 2;
        j0 = (rt & 3) * 128;
        colbase = ct * 128;
        aoff = O_D1C + (size_t)rt * 128 * 512 * 2;
        boff = O_MC + (size_t)ct * 128 * 512 * 2;
        Kf = 512;
      }
    }
    if (kind == 0) {
      attn_item<0>(p, l, b, h, q0, ntl, -1, 1024, smem);
    } else if (kind == 1) {
      attn_item<1>(p, l, b, h, q0, ntl, rs0, 512, smem);
    } else {
      f32x16 acc[2][2];
      zero_acc(acc);
      gemm_core(acc, wsp<u16>(p, aoff), Kf, wsp<u16>(p, boff), Kf, Kf, smem);
      u16* Y = wsp<u16>(p, O_Y);
#pragma unroll
      for (int i = 0; i < 2; i++)
#pragma unroll
        for (int j = 0; j < 2; j++)
#pragma unroll
          for (int g = 0; g < 4; g++) {
            const int jj = j0 + wm_ * 64 + i * 32 + 8 * g + 4 * hh_;
            const int tok = tok0 + (colbase + wn_ * 64 + j * 32 + r_) * tokmul;
            uint2 ov;
            ov.x = pack2(acc[i][j][4 * g], acc[i][j][4 * g + 1]);
            ov.y = pack2(acc[i][j][4 * g + 2], acc[i][j][4 * g + 3]);
            *(uint2*)(Y + ((size_t)b * KPB + tok) * 1536 + jj) = ov;
          }
    }
  }
}

__device__ __forceinline__ int n_row_tiles(bool last) { return last ? NRT - 4 : NRT; }
__device__ __forceinline__ int row_tile(bool last, int i) {
  if (!last) return i;
  return i < 128 ? i + 2 : i + 4;
}

__device__ void phase_p4(const Params& p, int l, bool last, int bid, int nb, u16* smem) {
  EPI_DECL
  const u16* A = wsp<u16>(p, O_A);
  const u16* Y = wsp<u16>(p, O_Y);
  u16* M = wsp<u16>(p, O_M);
  uint4* stash = wsp<uint4>(p, O_QM) + (size_t)bid * 24 * 256 + ltid();
  const int nrt_ = n_row_tiles(last);
  PATCH_LOOP_BEGIN(nrt_, 8, 8, 8)
    const int rt = row_tile(last, prt), ct = pct;
#pragma unroll 1
    for (int g = 0; g < 3; g++) {
      f32x16 acc[2][2];
      zero_acc(acc);
      gemm_core<true>(acc, wsp<u16>(p, O_WG) + (size_t)(g * 1024 + ct * 128) * D, D, A + (size_t)rt * 128 * D, D, D,
                      smem);
#pragma unroll
      for (int i = 0; i < 2; i++)
#pragma unroll
        for (int j = 0; j < 2; j++)
#pragma unroll
          for (int e = 0; e < 2; e++) {
            uint4 gq4;
            gq4.x = pack2(fsigmoid(acc[i][j][8 * e]), fsigmoid(acc[i][j][8 * e + 1]));
            gq4.y = pack2(fsigmoid(acc[i][j][8 * e + 2]), fsigmoid(acc[i][j][8 * e + 3]));
            gq4.z = pack2(fsigmoid(acc[i][j][8 * e + 4]), fsigmoid(acc[i][j][8 * e + 5]));
            gq4.w = pack2(fsigmoid(acc[i][j][8 * e + 6]), fsigmoid(acc[i][j][8 * e + 7]));
            stash[(g * 8 + (i * 2 + j) * 2 + e) * 256] = gq4;
          }
    }
    f32x16 mg[2][2];
    zero_acc(mg);
#pragma unroll 1
    for (int g = 0; g < 3; g++) {
      f32x16 acc[2][2];
      zero_acc(acc);
      gemm_core<true>(acc, wsp<u16>(p, O_WB) + (size_t)(g * 1024 + ct * 128) * 512, 512,
                       Y + (size_t)rt * 128 * 1536 + g * 512, 1536, 512, smem);
#pragma unroll
      for (int i = 0; i < 2; i++)
#pragma unroll
        for (int j = 0; j < 2; j++)
#pragma unroll
          for (int e = 0; e < 2; e++) {
            const uint4 gq4 = stash[(g * 8 + (i * 2 + j) * 2 + e) * 256];
            const uint32_t gw[4] = {gq4.x, gq4.y, gq4.z, gq4.w};
#pragma unroll
            for (int q = 0; q < 4; q++) {
              mg[i][j][8 * e + 2 * q] += __uint_as_float(gw[q] << 16) * acc[i][j][8 * e + 2 * q];
              mg[i][j][8 * e + 2 * q + 1] += __uint_as_float(gw[q] & 0xffff0000u) * acc[i][j][8 * e + 2 * q + 1];
            }
          }
    }
#pragma unroll
    for (int i = 0; i < 2; i++)
#pragma unroll
      for (int j = 0; j < 2; j++)
#pragma unroll
        for (int g = 0; g < 4; g++) {
          const int row = rt * 128 + wn_ * 64 + j * 32 + r_;
          const int col = ct * 128 + wm_ * 64 + i * 32 + 8 * g + 4 * hh_;
          uint2 o;
          o.x = pack2(mg[i][j][4 * g], mg[i][j][4 * g + 1]);
          o.y = pack2(mg[i][j][4 * g + 2], mg[i][j][4 * g + 3]);
          *(uint2*)(M + (size_t)row * D + col) = o;
        }
  PATCH_LOOP_END
}

__device__ void phase_resid(const Params& p, int l, bool last, const u16* Ain, size_t lda, const u16* W, int K, int goff,
                            int bid, int nb, u16* smem) {
  EPI_DECL
  const float* mod = wsp<float>(p, O_MOD);
  const int nrt_ = n_row_tiles(last);
  PATCH_LOOP_BEGIN(nrt_, 8, 8, 8)
    const int rt = row_tile(last, prt), ct = pct;
    f32x16 acc[2][2];
    zero_acc(acc);
    gemm_core(acc, W + (size_t)ct * 128 * K, K, Ain + (size_t)rt * 128 * lda, lda, K, smem);
    const int row0 = rt * 128, b = row0 / KPB, kk0 = row0 - b * KPB;
    const int m = kk0 < CTXL ? 2 : b;
    float* xb = xrow(p, row0);
    const float* gv = mod + ((size_t)l * 3 + m) * 6144 + goff;
#pragma unroll
    for (int i = 0; i < 2; i++)
#pragma unroll
      for (int g = 0; g < 4; g++) {
        const int col = ct * 128 + wm_ * 64 + i * 32 + 8 * g + 4 * hh_;
        const float4 g4 = *(const float4*)(gv + col);
#pragma unroll
        for (int j = 0; j < 2; j++) {
          const int rl = wn_ * 64 + j * 32 + r_;
          float4* xp = (float4*)(xb + (size_t)rl * D + col);
          float4 xv = *xp;
          xv.x = ALPHA * xv.x + (1.f + g4.x) * acc[i][j][4 * g];
          xv.y = ALPHA * xv.y + (1.f + g4.y) * acc[i][j][4 * g + 1];
          xv.z = ALPHA * xv.z + (1.f + g4.z) * acc[i][j][4 * g + 2];
          xv.w = ALPHA * xv.w + (1.f + g4.w) * acc[i][j][4 * g + 3];
          *xp = xv;
        }
      }
  PATCH_LOOP_END
}

__device__ void phase_p7(const Params& p, int l, bool last, int bid, int nb, u16* smem) {
  EPI_DECL
  const u16* A = wsp<u16>(p, O_A);
  u16* HH = wsp<u16>(p, O_HH);
  const int nrt_ = n_row_tiles(last);
  PATCH_LOOP_BEGIN(nrt_, 44, 16, 4)
    const int rt = row_tile(last, prt), ct = pct;
    f32x16 acc[2][2];
    zero_acc(acc);
    gemm_core(acc, wsp<u16>(p, O_WGU) + (size_t)ct * 128 * D, D, A + (size_t)rt * 128 * D, D, D, smem);
#pragma unroll
    for (int j = 0; j < 2; j++)
#pragma unroll
      for (int g = 0; g < 4; g++) {
        const int row = rt * 128 + wn_ * 64 + j * 32 + r_;
        const int q = (ct * 2 + wm_) * 32 + 8 * g + 4 * hh_;
        float hv[4];
#pragma unroll
        for (int t = 0; t < 4; t++) {
          const float gt = acc[0][j][4 * g + t], up = acc[1][j][4 * g + t];
          hv[t] = gt * fsigmoid(gt) * up;
        }
        uint2 o;
        o.x = pack2(hv[0], hv[1]);
        o.y = pack2(hv[2], hv[3]);
        *(uint2*)(HH + (size_t)row * FH + q) = o;
      }
  PATCH_LOOP_END
}

constexpr int NPHASE = 3 + 9 * 2;

__device__ void run_phase(const Params& p, int ph, int bid, int nb, u16* smem) {
  if (ph == 0) {
    prep_tables(p, bid, nb);
    prep_modp(p, bid, nb);
    prep_weights(p, 0, bid, nb, smem);
    return;
  }
  if (ph == 1) { prep_modr(p, bid, nb); return; }
  if (ph == 2) { ln_phase(p, 0, p.ln_in_g, p.ln_in_b, 0, 0, 1024, false, bid, nb); return; }
  const int l = (ph - 3) / 9, s = (ph - 3) % 9;
  const bool last = (l == 1);
  switch (s) {
    case 0: phase_p1(p, l, last, bid, nb, smem); break;
    case 1: phase_p2(p, l, bid, nb, smem); break;
    case 2: phase_p3(p, l, last, bid, nb, smem); break;
    case 3: phase_p4(p, l, last, bid, nb, smem); break;
    case 4: phase_resid(p, l, last, wsp<u16>(p, O_M), D, wsp<u16>(p, O_WO), D, 2048, bid, nb, smem); break;
    case 5: ln_phase(p, 1, p.ln1_g + l * D, p.ln1_b + l * D, l, 3072, 4096, last, bid, nb); break;
    case 6: phase_p7(p, l, last, bid, nb, smem); break;
    case 7: phase_resid(p, l, last, wsp<u16>(p, O_HH), FH, wsp<u16>(p, O_WD), FH, 5120, bid, nb, smem); break;
    default:
      ln_phase(p, 1, p.ln2_g + l * D, p.ln2_b + l * D, last ? -1 : l + 1, 0, 1024, last, bid, nb);
      if (!last) prep_weights(p, l + 1, bid, nb, smem);
      break;
  }
}


#define XB_TMO      128
#define XB_XCNT(j)  (256  + 64 * (j))
#define XB_XSUB(j)  (1280 + 64 * (j))
#define XB_XGEN(j)  (2304 + 64 * (j))
#define XB_TOP      3328
#define XB_TOPGEN   3392
#define XCD_BAR_WORDS 3456
#define XB_SPIN_CAP (1u << 20)
#define LAS __attribute__((address_space(3)))
__device__ __forceinline__ unsigned xb_ld(unsigned* p) { return __hip_atomic_load(p, __ATOMIC_RELAXED, __HIP_MEMORY_SCOPE_AGENT); }
__device__ __forceinline__ unsigned xb_add(unsigned* p, unsigned v) { return __hip_atomic_fetch_add(p, v, __ATOMIC_RELAXED, __HIP_MEMORY_SCOPE_AGENT); }
__device__ __forceinline__ unsigned xb_xcc_id() { return (unsigned)__builtin_amdgcn_s_getreg((3 << 11) | 20) & 0xFu; }
#define XB_SPIN(cond, bar) do { unsigned _sp = 0; while (cond) { __builtin_amdgcn_s_sleep(1); \
    if ((++_sp & 255u) == 0u) { if (xb_ld(&(bar)[XB_TMO])) break; if (_sp > XB_SPIN_CAP) { atomicAdd(&(bar)[XB_TMO], 1u); break; } } } } while (0)
struct XcdBarrier {
  unsigned* bar; unsigned x;
  volatile LAS unsigned* st;
};
__device__ __forceinline__ XcdBarrier xcd_barrier_post(unsigned* bar, volatile LAS unsigned* st) {
  XcdBarrier b; b.bar = bar; b.x = xb_xcc_id(); b.st = st;
  if (threadIdx.x == 0) (void)xb_add(&bar[XB_XCNT(b.x)], 1u);
  return b;
}
__device__ __forceinline__ void xcd_barrier_complete(unsigned* bar, unsigned x, unsigned& nloc, unsigned& nx) {
  const unsigned G = gridDim.x * gridDim.y * gridDim.z;
  unsigned sum, cnt, mine, sp = 0u;
  for (;;) {
    sum = 0u; cnt = 0u; mine = 0u;
#pragma unroll
    for (unsigned j = 0; j < 16; ++j) { const unsigned c = xb_ld(&bar[XB_XCNT(j)]); sum += c; cnt += (c > 0u) ? 1u : 0u; mine = (j == x) ? c : mine; }
    if (sum == G) break;
    __builtin_amdgcn_s_sleep(1);
    if ((++sp & 255u) == 0u) { if (xb_ld(&bar[XB_TMO])) break; if (sp > XB_SPIN_CAP) { atomicAdd(&bar[XB_TMO], 1u); break; } }
  }
  nloc = mine > 0u ? mine : 1u; nx = cnt > 0u ? cnt : 1u;
}
__device__ __forceinline__ void xcd_barrier(const XcdBarrier& b) {
  asm volatile("s_waitcnt vmcnt(0)" ::: "memory");
  __syncthreads();
  if (threadIdx.x == 0) {
    unsigned* bar = b.bar;
    __builtin_amdgcn_s_waitcnt(0);
    unsigned nloc = b.st[0], nx = b.st[1];
    if (nloc == 0u) { xcd_barrier_complete(bar, b.x, nloc, nx); b.st[0] = nloc; b.st[1] = nx; }
    const unsigned old = xb_add(&bar[XB_XSUB(b.x)], 1u);
    const unsigned gen = old / nloc;
    if (old + 1u == (gen + 1u) * nloc) {
      __builtin_amdgcn_fence(__ATOMIC_RELEASE, "agent");
      asm volatile("s_waitcnt vmcnt(0)" ::: "memory");
      const unsigned og = xb_add(&bar[XB_TOP], 1u);
      const unsigned tg = og / nx;
      if (og + 1u == (tg + 1u) * nx) xb_add(&bar[XB_TOPGEN], 1u);
      else XB_SPIN(xb_ld(&bar[XB_TOPGEN]) == tg, bar);
      __builtin_amdgcn_fence(__ATOMIC_ACQUIRE, "agent");
      xb_add(&bar[XB_XGEN(b.x)], 1u);
      asm volatile("s_waitcnt vmcnt(0)" ::: "memory");
    } else {
      XB_SPIN(xb_ld(&bar[XB_XGEN(b.x)]) == gen, bar);
      __builtin_amdgcn_fence(__ATOMIC_ACQUIRE, "agent");
      asm volatile("s_waitcnt vmcnt(0)" ::: "memory");
    }
  }
  __syncthreads();
}

constexpr int SMEM_ELEMS = 4 * SM_A + 256 + 8;

#if COOP
__global__ void __launch_bounds__(256, 2) mega_kernel(Params p) {
  __shared__ __attribute__((aligned(16))) u16 smem[SMEM_ELEMS];
  cg::grid_group grid = cg::this_grid();
  volatile LAS unsigned* st = (volatile LAS unsigned*)(smem + 4 * SM_A + 256);
  if (threadIdx.x == 0) { st[0] = 0u; st[1] = 0u; }
  __syncthreads();
  XcdBarrier xb = xcd_barrier_post((unsigned*)(p.ws + O_BAR), st);
  for (int ph = 0; ph < NPHASE; ph++) {
#ifdef PROBE_MASK
    const int s9 = ph >= 3 ? (ph - 3) % 9 : -1;
    const int nrep = (s9 >= 0 && ((PROBE_MASK >> s9) & 1)) ? 2 : 1;
    for (int rep = 0; rep < nrep; rep++) {
      run_phase(p, ph, blockIdx.x, gridDim.x, smem);
      if (ph == 0) grid.sync();
      else if (ph + 1 < NPHASE || rep + 1 < nrep) xcd_barrier(xb);
    }
#else
    run_phase(p, ph, blockIdx.x, gridDim.x, smem);
    if (ph == 0) grid.sync();
    else if (ph + 1 < NPHASE) xcd_barrier(xb);
#endif
  }
}
#else
__global__ void __launch_bounds__(256, 2) phase_kernel(Params p, int ph) {
  __shared__ __attribute__((aligned(16))) u16 smem[SMEM_ELEMS];
  run_phase(p, ph, blockIdx.x, gridDim.x, smem);
}
#endif

extern "C" void kernel_launch(void* const* d_in, const int* in_sizes, int n_in, void* d_out, int out_size, void* d_ws,
                              size_t ws_size, hipStream_t stream) {
  Params p{};
  const float** f = (const float**)&p;
  for (int i = 0; i < 25; i++) f[i] = (const float*)d_in[i];
  p.out = (float*)d_out;
  p.ws = (unsigned char*)d_ws;
  if (ws_size < O_WSEND) fprintf(stderr, "workspace too small: %zu < %zu\n", ws_size, (size_t)O_WSEND);
#if COOP
  static int grid_blocks = 0;
  if (!grid_blocks) {
    int dev = 0, cus = 0, per_cu = 0;
    hipGetDevice(&dev);
    hipDeviceGetAttribute(&cus, hipDeviceAttributeMultiprocessorCount, dev);
    hipOccupancyMaxActiveBlocksPerMultiprocessor(&per_cu, mega_kernel, 256, 0);
    if (per_cu > 2) per_cu = 2;
    grid_blocks = cus * per_cu;
  }
  (void)hipMemsetAsync(p.ws + O_BAR, 0, 3456 * 4, stream);
  void* args[] = {&p};
  hipError_t e = hipLaunchCooperativeKernel((void*)mega_kernel, dim3(grid_blocks), dim3(256), args, 0, stream);
  if (e != hipSuccess) fprintf(stderr, "cooperative launch failed: %s (grid %d)\n", hipGetErrorString(e), grid_blocks);
#else
  for (int ph = 0; ph < NPHASE; ph++) phase_kernel<<<512, 256, 0, stream>>>(p, ph);
#endif
}
```

```cpp
#include <hip/hip_runtime.h>
#include <hip/hip_cooperative_groups.h>
#include <stdint.h>
#include <cstdio>
namespace cg = cooperative_groups;

#ifndef COOP
#define COOP 1
#endif

typedef __attribute__((ext_vector_type(8))) short bf16x8;
typedef __attribute__((ext_vector_type(4))) short bf16x4;
typedef __attribute__((ext_vector_type(16))) float f32x16;
typedef unsigned short u16;
typedef __attribute__((ext_vector_type(4))) unsigned int u32x4;

constexpr int D = 1024;
constexpr int NBATCH = 2;
constexpr int SEQ = 16384;
constexpr int CTXL = 256;
constexpr int KPB = SEQ + CTXL;
constexpr int T = NBATCH * KPB;
constexpr int NRT = T / 128;
constexpr int FH = 2816;
constexpr int IN_DIM = 5536;
constexpr float LOG2E = 1.4426950408889634f;
constexpr float NA_SCALE_L2 = 0.125f * LOG2E;
constexpr float MLA_SCALE_L2 = 0.10206207261596575f * LOG2E;
constexpr float ALPHA = 1.4142135623730951f;
constexpr float EPS = 1e-5f;
constexpr float RS128 = 0.08838834764831845f;

constexpr size_t al256(size_t x) { return (x + 255) & ~(size_t)255; }
constexpr size_t O_WF = 0;
constexpr size_t O_WP = O_WF + (size_t)1024 * 1024 * 2;
constexpr size_t O_WG = O_WP + (size_t)2048 * 1024 * 2;
constexpr size_t O_WUQ = O_WG + (size_t)3072 * 1024 * 2;
constexpr size_t O_WUKV = O_WUQ + (size_t)768 * 256 * 2;
constexpr size_t O_WB = O_WUKV + (size_t)1024 * 128 * 2;
constexpr size_t O_WO = O_WB + (size_t)3 * 1024 * 512 * 2;
constexpr size_t O_WGU = O_WO + (size_t)1024 * 1024 * 2;
constexpr size_t O_WD = O_WGU + (size_t)5632 * 1024 * 2;
constexpr size_t O_MA = O_WD + (size_t)1024 * 2816 * 2;
constexpr size_t O_MB = O_MA + (size_t)256 * 256 * 2;
constexpr size_t O_MC = O_MB + (size_t)128 * 256 * 2;
constexpr size_t O_TW = O_MC + (size_t)256 * 512 * 2;
constexpr size_t O_MODP = O_TW + (size_t)128 * 128 * 2 * 4;
constexpr size_t O_MOD = O_MODP + (size_t)16 * 2 * 3 * 6144 * 4;
constexpr size_t O_XCTX = O_MOD + (size_t)2 * 3 * 6144 * 4;
constexpr size_t O_D1C = O_XCTX + (size_t)512 * 1024 * 4;
constexpr size_t O_A = O_D1C + (size_t)2 * 512 * 2 * 256 * 2;
constexpr size_t O_RQ = O_A + (size_t)T * 1024 * 2;
constexpr size_t O_QNA = O_RQ;
constexpr size_t O_KNA = O_QNA + (size_t)T * 512 * 2;
constexpr size_t O_VNAT = O_KNA + (size_t)T * 512 * 2;
constexpr size_t O_RY = O_VNAT + (size_t)T * 512 * 2;
constexpr size_t O_Y = O_RY;
constexpr size_t O_D1 = O_RY;
constexpr size_t O_LAT = O_RY + (size_t)67108864;
constexpr size_t O_D2 = O_RY + (size_t)T * 1536 * 2;
constexpr size_t O_QM = O_D2 + (size_t)67108864;
constexpr size_t O_KN = O_QM + (size_t)T * 768 * 2;
constexpr size_t O_KRR = O_KN + (size_t)T * 512 * 2;
constexpr size_t O_VMT = O_KRR + (size_t)T * 32 * 2;
constexpr size_t O_END = O_VMT + (size_t)T * 512 * 2;
constexpr size_t O_BAR = (O_END + 255) & ~(size_t)255;
constexpr size_t O_WSEND = O_BAR + 3456 * 4;
constexpr size_t O_M = O_RQ;
constexpr size_t O_HH = O_RQ;

struct Params {
  const float *x, *c, *ctx, *c_ctx, *ln_in_g, *ln_in_b, *w_mod, *b_mod, *w_in, *gq, *gkv, *w_uq, *w_qr, *w_uk,
      *w_uv, *rpb, *w_branch, *w_out, *ln1_g, *ln1_b, *ln2_g, *ln2_b, *w_gate, *w_up, *w_down;
  float* out;
  unsigned char* ws;
};

__device__ __forceinline__ u16 f2bf(float f) {
  uint32_t u = __float_as_uint(f);
  u += 0x7fffu + ((u >> 16) & 1u);
  return (u16)(u >> 16);
}
typedef __attribute__((ext_vector_type(2))) __bf16 bf16v2;
typedef __attribute__((ext_vector_type(2))) float f32v2;
__device__ __forceinline__ uint32_t pack2(float a, float b) {
  const f32v2 v = {a, b};
  return __builtin_bit_cast(uint32_t, __builtin_convertvector(v, bf16v2));
}
__device__ __forceinline__ float bf2f(u16 v) { return __uint_as_float(((uint32_t)v) << 16); }
__device__ __forceinline__ float wsum(float v) {
#pragma unroll
  for (int o = 32; o > 0; o >>= 1) v += __shfl_xor(v, o);
  return v;
}
__device__ __forceinline__ float fsigmoid(float v) { return 1.f / (1.f + __expf(-v)); }

__device__ __forceinline__ int ltid() {
  int t = threadIdx.x;
  asm volatile("" : "+v"(t));
  return t;
}

template <typename Tp>
__device__ __forceinline__ Tp* wsp(const Params& p, size_t off) { return (Tp*)(p.ws + off); }

__device__ __forceinline__ float* xrow(const Params& p, int row) {
  int b = row / KPB, kk = row - b * KPB;
  if (kk < CTXL) return wsp<float>(p, O_XCTX) + (size_t)(b * CTXL + kk) * D;
  return p.out + (size_t)(b * SEQ + kk - CTXL) * D;
}

constexpr int LSTR = 72;
constexpr int SM_A = 128 * LSTR;

template <bool DEEP = true>
__device__ __forceinline__ void gemm_core(f32x16 (&acc)[2][2], const u16* __restrict__ A, size_t lda,
                                          const u16* __restrict__ B, size_t ldb, int K, u16* smem) {
  const int tid = ltid(), lane = tid & 63, wave = tid >> 6;
  const int wm = wave >> 1, wn = wave & 1, r = lane & 31, hh = lane >> 5;
  u16* sA = smem;
  u16* sB = smem + 2 * SM_A;
  const int lrow = tid >> 3, lkc = (tid & 7) * 8;
  const u16* ga = A + (size_t)lrow * lda + lkc;
  const u16* gb = B + (size_t)lrow * ldb + lkc;
  u16* wa = sA + lrow * LSTR + lkc;
  u16* wb = sB + lrow * LSTR + lkc;
  const u16* pa = sA + (wm * 64 + r) * LSTR + hh * 8;
  const u16* pb = sB + (wn * 64 + r) * LSTR + hh * 8;
  u32x4 a0r[4], b0r[4], a1r[4], b1r[4];
#define G_LOAD(ar, br, ko)                                               \
  _Pragma("unroll") for (int i = 0; i < 4; i++) {                        \
    ar[i] = *(const u32x4*)(ga + (size_t)(32 * i) * lda + (ko));         \
    br[i] = *(const u32x4*)(gb + (size_t)(32 * i) * ldb + (ko));         \
  }
#define G_STORE(ar, br, buf)                                             \
  _Pragma("unroll") for (int i = 0; i < 4; i++) {                        \
    *(u32x4*)(wa + (buf)*SM_A + 32 * i * LSTR) = ar[i];                  \
    *(u32x4*)(wb + (buf)*SM_A + 32 * i * LSTR) = br[i];                  \
  }
#define G_COMPUTE(buf)                                                                   \
  _Pragma("unroll") for (int ks = 0; ks < 4; ks++) {                                     \
    const bf16x8 fa0 = *(const bf16x8*)(pa + (buf)*SM_A + ks * 16);                      \
    const bf16x8 fa1 = *(const bf16x8*)(pa + (buf)*SM_A + 32 * LSTR + ks * 16);          \
    const bf16x8 fb0 = *(const bf16x8*)(pb + (buf)*SM_A + ks * 16);                      \
    const bf16x8 fb1 = *(const bf16x8*)(pb + (buf)*SM_A + 32 * LSTR + ks * 16);          \
    acc[0][0] = __builtin_amdgcn_mfma_f32_32x32x16_bf16(fa0, fb0, acc[0][0], 0, 0, 0);   \
    acc[0][1] = __builtin_amdgcn_mfma_f32_32x32x16_bf16(fa0, fb1, acc[0][1], 0, 0, 0);   \
    acc[1][0] = __builtin_amdgcn_mfma_f32_32x32x16_bf16(fa1, fb0, acc[1][0], 0, 0, 0);   \
    acc[1][1] = __builtin_amdgcn_mfma_f32_32x32x16_bf16(fa1, fb1, acc[1][1], 0, 0, 0);   \
  }
  const int nk = K >> 6;
  if (DEEP) {
    G_LOAD(a0r, b0r, 0)
    G_LOAD(a1r, b1r, 64)
    G_STORE(a0r, b0r, 0)
    __syncthreads();
    const int klast = (nk - 1) * 64;
    G_LOAD(a0r, b0r, min(128, klast))
    for (int kt = 0; kt < nk; kt += 2) {
      G_COMPUTE(0)
      G_STORE(a1r, b1r, 1)
      __syncthreads();
      G_LOAD(a1r, b1r, min((kt + 3) * 64, klast))
      __builtin_amdgcn_sched_barrier(0);
      G_COMPUTE(1)
      G_STORE(a0r, b0r, 0)
      __syncthreads();
      G_LOAD(a0r, b0r, min((kt + 4) * 64, klast))
      __builtin_amdgcn_sched_barrier(0);
    }
  } else {
    G_LOAD(a0r, b0r, 0)
    G_STORE(a0r, b0r, 0)
    __syncthreads();
    for (int kt = 0; kt < nk; kt += 2) {
      G_LOAD(a0r, b0r, (kt + 1) * 64)
      G_COMPUTE(0)
      G_STORE(a0r, b0r, 1)
      __syncthreads();
      if (kt + 2 < nk) G_LOAD(a0r, b0r, (kt + 2) * 64)
      G_COMPUTE(1)
      if (kt + 2 < nk) G_STORE(a0r, b0r, 0)
      __syncthreads();
    }
  }
#undef G_LOAD
#undef G_STORE
#undef G_COMPUTE
}

__device__ __forceinline__ void zero_acc(f32x16 (&acc)[2][2]) {
#pragma unroll
  for (int i = 0; i < 2; i++)
#pragma unroll
    for (int j = 0; j < 2; j++)
#pragma unroll
      for (int e = 0; e < 16; e++) acc[i][j][e] = 0.f;
}

#define EPI_DECL                                                     \
  const int lane_ = ltid() & 63, wave_ = ltid() >> 6;      \
  const int wm_ = wave_ >> 1, wn_ = wave_ & 1, r_ = lane_ & 31, hh_ = lane_ >> 5; \
  (void)wm_; (void)wn_; (void)r_; (void)hh_;

__device__ __forceinline__ const float* src_col(const Params& p, int l, int kind, int n, int& ld) {
  switch (kind) {
    case 0:
      ld = IN_DIM;
      return n < 1952 ? p.w_in + (size_t)l * D * IN_DIM + 512 + n : nullptr;
    case 1:
      ld = IN_DIM;
      return p.w_in + (size_t)l * D * IN_DIM + 2464 + n;
    case 2:
      if (n < 512) {
        ld = 512;
        return p.w_uq + (size_t)l * 256 * 512 + n;
      } else {
        int m = n - 512, wt = m >> 6, jb = (m >> 5) & 1, idx = wt * 32 + (m & 31);
        int h = idx >> 4, e = idx & 15;
        ld = 256;
        return p.w_qr + (size_t)l * 256 * 256 + h * 32 + jb * 16 + e;
      }
    case 3:
      ld = 512;
      return n < 512 ? p.w_uk + (size_t)l * 128 * 512 + n : p.w_uv + (size_t)l * 128 * 512 + (n - 512);
    case 4: {
      int g = n >> 10, nn = n & 1023;
      ld = 1024;
      return p.w_branch + ((size_t)(l * 3 + g) * 512) * 1024 + nn;
    }
    case 5:
      ld = 1024;
      return p.w_out + (size_t)l * D * D + n;
    case 6: {
      int jb = (n >> 5) & 1, q = (n >> 6) * 32 + (n & 31);
      ld = FH;
      return (jb ? p.w_up : p.w_gate) + (size_t)l * D * FH + q;
    }
    default:
      ld = 1024;
      return p.w_down + (size_t)l * FH * D + n;
  }
}

__device__ __forceinline__ int job_nd(int k) {
  switch (k) { case 0: return 2048; case 1: return 3072; case 2: return 768; case 3: return 1024; case 4: return 3072;
    case 5: return 1024; case 6: return 5632; default: return 1024; }
}
__device__ __forceinline__ int job_kd(int k) {
  switch (k) { case 0: return 1024; case 1: return 1024; case 2: return 256; case 3: return 128; case 4: return 512;
    case 5: return 1024; case 6: return 1024; default: return 2816; }
}
__device__ __forceinline__ size_t job_od(int k) {
  switch (k) { case 0: return O_WP; case 1: return O_WG; case 2: return O_WUQ; case 3: return O_WUKV; case 4: return O_WB;
    case 5: return O_WO; case 6: return O_WGU; default: return O_WD; }
}
__device__ void prep_weights(const Params& p, int l, int bid, int nb, u16* smem) {
  float* tile = (float*)smem;
  const int tid = ltid();
  int start = 0;
#pragma unroll 1
  for (int kind = 0; kind < 8; kind++) {
    const int Kk = job_kd(kind);
    const int nkt = Kk >> 6, ntile = (job_nd(kind) >> 6) * nkt;
    u16* dst = wsp<u16>(p, job_od(kind));
    const float* ksc = kind == 2 ? p.gq + l * 256 : (kind == 3 ? p.gkv + l * 128 : nullptr);
    for (int t = (bid + nb - (start % nb)) % nb; t < ntile; t += nb) {
      const int nt = t / nkt, kt = t - nt * nkt;
      const int n0 = nt * 64, k0 = kt * 64;
      {
        const int kq = tid >> 4, nn4 = (tid & 15) * 4;
        int ld;
        const float* sp = src_col(p, l, kind, n0 + nn4, ld);
#pragma unroll
        for (int i = 0; i < 4; i++) {
          const int kk = i * 16 + kq;
          float4 v = make_float4(0.f, 0.f, 0.f, 0.f);
          if (sp) v = *(const float4*)(sp + (size_t)(k0 + kk) * ld);
          if (ksc) {
            const float sc = ksc[k0 + kk];
            v.x *= sc; v.y *= sc; v.z *= sc; v.w *= sc;
          }
          float* tp = tile + kk * 65 + nn4;
          tp[0] = v.x; tp[1] = v.y; tp[2] = v.z; tp[3] = v.w;
        }
      }
      __syncthreads();
#pragma unroll
      for (int i = 0; i < 2; i++) {
        const int c = tid + 256 * i;
        const int nn = c >> 3, kc = (c & 7) * 8;
        const float* tp = tile + kc * 65 + nn;
        uint4 o;
        o.x = pack2(tp[0], tp[65]);
        o.y = pack2(tp[2 * 65], tp[3 * 65]);
        o.z = pack2(tp[4 * 65], tp[5 * 65]);
        o.w = pack2(tp[6 * 65], tp[7 * 65]);
        *(uint4*)(dst + (size_t)(n0 + nn) * Kk + k0 + kc) = o;
      }
      __syncthreads();
    }
    start += ntile;
  }
  {
    float* ctab = (float*)smem;
    __syncthreads();
    if (tid < 128) ctab[tid] = cospif((float)tid * (1.f / 64.f));
    __syncthreads();
    u16* dst = wsp<u16>(p, O_WF);
    for (int it = bid; it < 512; it += nb) {
      const int o = it * 256 + tid;
      const int np = o & 1023, k8 = (o >> 10) * 8;
      const int reim = np >> 9, g = (np >> 7) & 3, m = np & 127;
      const float* w = p.w_in + (size_t)l * D * IN_DIM + (size_t)k8 * IN_DIM + g * 128;
      const int sh = reim ? 96 : 0;
      float a8[8];
#pragma unroll
      for (int j = 0; j < 8; j++) a8[j] = 0.f;
#pragma unroll 4
      for (int c = 0; c < 128; c++) {
        const float tw = ctab[(m * c + sh) & 127];
#pragma unroll
        for (int j = 0; j < 8; j++) a8[j] += w[(size_t)j * IN_DIM + c] * tw;
      }
      uint4 ov;
      ov.x = pack2(a8[0] * RS128, a8[1] * RS128);
      ov.y = pack2(a8[2] * RS128, a8[3] * RS128);
      ov.z = pack2(a8[4] * RS128, a8[5] * RS128);
      ov.w = pack2(a8[6] * RS128, a8[7] * RS128);
      *(uint4*)(dst + (size_t)np * 1024 + k8) = ov;
    }
    __syncthreads();
  }
}

__device__ void prep_tables(const Params& p, int bid, int nb) {
  u16* MA = wsp<u16>(p, O_MA);
  u16* MB = wsp<u16>(p, O_MB);
  u16* MC = wsp<u16>(p, O_MC);
  float* TW = wsp<float>(p, O_TW);
  const int total = 65536 + 32768 + 131072 + 16384;
  for (int idx = bid * 256 + ltid(); idx < total; idx += nb * 256) {
    if (idx < 65536) {
      const int n = idx >> 8, k = idx & 255;
      const int nt = n >> 7, wn = (n >> 6) & 1, jb = (n >> 5) & 1, klo = nt * 64 + wn * 32 + (n & 31);
      const int ri = k >> 7, nhi = k & 127;
      const int xx = (klo * nhi) & 127;
      const float c = cospif((float)xx * (1.f / 64.f)), s = sinpif((float)xx * (1.f / 64.f));
      float v = jb == 0 ? (ri == 0 ? c : -s) : (ri == 0 ? -s : -c);
      MA[idx] = f2bf(v * RS128);
    } else if (idx < 65536 + 32768) {
      const int i2 = idx - 65536;
      const int khi = i2 >> 8, k = i2 & 255;
      const int ri = k >> 7, nlo = k & 127;
      const int xx = (khi * nlo) & 127;
      const float c = cospif((float)xx * (1.f / 64.f)), s = sinpif((float)xx * (1.f / 64.f));
      MB[i2] = f2bf((ri == 0 ? c : s) * RS128);
    } else if (idx < 65536 + 32768 + 131072) {
      const int i2 = idx - 65536 - 32768;
      const int kk = i2 >> 9, k = i2 & 511;
      const int ri = k >> 8, nn = k & 255;
      const int xx = (kk * nn) & 255;
      const float c = cospif((float)xx * (1.f / 128.f)), s = sinpif((float)xx * (1.f / 128.f));
      MC[i2] = f2bf((ri == 0 ? c : -s) * 0.0625f);
    } else {
      const int i2 = idx - 65536 - 32768 - 131072;
      const int klo = i2 >> 7, nlo = i2 & 127;
      const int xx = klo * nlo;
      TW[i2 * 2] = cospif((float)xx * (1.f / 8192.f));
      TW[i2 * 2 + 1] = sinpif((float)xx * (1.f / 8192.f));
    }
  }
}

__device__ void prep_modp(const Params& p, int bid, int nb) {
  float* modp = wsp<float>(p, O_MODP);
  for (int it = bid; it < 2 * 16 * 24; it += nb) {
    const int l = it / (16 * 24), rem = it - l * 16 * 24, kc = rem / 24, nblk = rem - kc * 24;
    const int n = nblk * 256 + ltid();
    const float* w = p.w_mod + (size_t)l * D * 6144 + n;
    float a0 = 0.f, a1 = 0.f, a2 = 0.f;
#pragma unroll 8
    for (int kk = 0; kk < 64; kk++) {
      const int k = kc * 64 + kk;
      const float wv = w[(size_t)k * 6144];
      float c0 = p.c[k], c1 = p.c[1024 + k], c2 = p.c_ctx[k];
      c0 = c0 / (1.f + __expf(-c0));
      c1 = c1 / (1.f + __expf(-c1));
      c2 = c2 / (1.f + __expf(-c2));
      a0 += c0 * wv;
      a1 += c1 * wv;
      a2 += c2 * wv;
    }
    float* o = modp + ((size_t)(kc * 2 + l) * 3) * 6144 + n;
    o[0] = a0;
    o[6144] = a1;
    o[2 * 6144] = a2;
  }
}
__device__ void prep_modr(const Params& p, int bid, int nb) {
  const float* modp = wsp<float>(p, O_MODP);
  float* mod = wsp<float>(p, O_MOD);
  for (int idx = bid * 256 + ltid(); idx < 2 * 3 * 6144; idx += nb * 256) {
    const int l = idx / (3 * 6144), n = idx % 6144;
    float v = p.b_mod[l * 6144 + n];
    for (int kc = 0; kc < 16; kc++) v += modp[(size_t)kc * 2 * 3 * 6144 + idx];
    mod[idx] = v;
  }
}

__device__ void ln_phase(const Params& p, int mode, const float* g, const float* bta, int lmod, int shoff, int scoff,
                         bool skip_ctx, int bid, int nb) {
  const int lane = ltid() & 63, wave = ltid() >> 6;
  u16* A = wsp<u16>(p, O_A);
  const float* mod = wsp<float>(p, O_MOD);
  for (int row = bid * 4 + wave; row < T; row += nb * 4) {
    const int b = row / KPB, kk = row - b * KPB;
    if (skip_ctx && kk < CTXL) continue;
    float* xr = xrow(p, row);
    const float* src;
    if (mode == 0)
      src = kk < CTXL ? p.ctx + (size_t)(b * CTXL + kk) * D : p.x + (size_t)(b * SEQ + kk - CTXL) * D;
    else
      src = xr;
    float4 v[4];
    float s = 0.f;
#pragma unroll
    for (int i = 0; i < 4; i++) {
      v[i] = *(const float4*)(src + i * 256 + lane * 4);
      s += v[i].x + v[i].y + v[i].z + v[i].w;
    }
    const float mu = wsum(s) * (1.f / 1024.f);
    float q = 0.f;
#pragma unroll
    for (int i = 0; i < 4; i++) {
      v[i].x -= mu; v[i].y -= mu; v[i].z -= mu; v[i].w -= mu;
      q += v[i].x * v[i].x + v[i].y * v[i].y + v[i].z * v[i].z + v[i].w * v[i].w;
    }
    const float rstd = rsqrtf(wsum(q) * (1.f / 1024.f) + EPS);
    const int m = kk < CTXL ? 2 : b;
    const float* md = mod + ((size_t)(lmod < 0 ? 0 : lmod) * 3 + m) * 6144;
#pragma unroll
    for (int i = 0; i < 4; i++) {
      const int c0 = i * 256 + lane * 4;
      const float4 gg = *(const float4*)(g + c0), bb = *(const float4*)(bta + c0);
      float4 y;
      y.x = v[i].x * rstd * gg.x + bb.x;
      y.y = v[i].y * rstd * gg.y + bb.y;
      y.z = v[i].z * rstd * gg.z + bb.z;
      y.w = v[i].w * rstd * gg.w + bb.w;
      *(float4*)(xr + c0) = y;
      if (lmod >= 0) {
        const float4 sh = *(const float4*)(md + shoff + c0), sc = *(const float4*)(md + scoff + c0);
        uint2 o;
        o.x = pack2(y.x * (1.f + sc.x) + sh.x, y.y * (1.f + sc.y) + sh.y);
        o.y = pack2(y.z * (1.f + sc.z) + sh.z, y.w * (1.f + sc.w) + sh.w);
        *(uint2*)(A + (size_t)row * D + c0) = o;
      }
    }
  }
}

#define PATCH_LOOP_BEGIN(NR_, NC_, PR_, PC_)                                   \
  {                                                                            \
    const int x_ = bid & 7, w_ = bid >> 3, nbx_ = nb >> 3;                     \
    const int CG_ = ((NC_) + (PC_)-1) / (PC_);                                 \
    const int npatch_ = (((NR_) + (PR_)-1) / (PR_)) * CG_;                     \
    for (int u_ = w_;; u_ += nbx_) {                                           \
      const int g_ = (u_ >> 6) * 8 + x_;                                       \
      if (g_ >= npatch_) break;                                                \
      const int s_ = u_ & 63;                                                  \
      const int rg_ = g_ / CG_;                                                \
      const int prt = rg_ * (PR_) + s_ / (PC_);                                \
      const int pct = (g_ - rg_ * CG_) * (PC_) + s_ % (PC_);                   \
      if (prt >= (NR_) || pct >= (NC_)) continue;
#define PATCH_LOOP_END \
    }                  \
  }

__device__ void phase_p1(const Params& p, int l, bool last, int bid, int nb, u16* smem) {
  EPI_DECL
  const u16* A = wsp<u16>(p, O_A);
  PATCH_LOOP_BEGIN(NRT, 16, 8, 8)
    f32x16 acc[2][2];
    zero_acc(acc);
    {
      const int rt = prt, ct = pct;
      const int row0 = rt * 128, b = row0 / KPB, kk0 = row0 - b * KPB;
      if (ct < 8 || ct >= 12) {
        gemm_core(acc, wsp<u16>(p, O_WP) + (size_t)ct * 128 * D, D, A + (size_t)rt * 128 * D, D, D, smem);
        u16* dst;
        float sc = 1.f;
        int cb;
        if (ct < 4) { dst = wsp<u16>(p, O_QNA); sc = NA_SCALE_L2; cb = ct * 128; }
        else if (ct < 8) { dst = wsp<u16>(p, O_KNA); cb = (ct - 4) * 128; }
        else { dst = wsp<u16>(p, O_LAT); cb = (ct - 12) * 128; }
#pragma unroll
        for (int i = 0; i < 2; i++)
#pragma unroll
          for (int j = 0; j < 2; j++)
#pragma unroll
            for (int g = 0; g < 4; g++) {
              const int row = row0 + wn_ * 64 + j * 32 + r_;
              const int col = cb + wm_ * 64 + i * 32 + 8 * g + 4 * hh_;
              uint2 o;
              o.x = pack2(acc[i][j][4 * g] * sc, acc[i][j][4 * g + 1] * sc);
              o.y = pack2(acc[i][j][4 * g + 2] * sc, acc[i][j][4 * g + 3] * sc);
              *(uint2*)(dst + (size_t)row * 512 + col) = o;
            }
      } else {
        gemm_core(acc, A + (size_t)rt * 128 * D, D, wsp<u16>(p, O_WP) + (size_t)ct * 128 * D, D, D, smem);
        u16* dst = wsp<u16>(p, O_VNAT);
        const int cb = (ct - 8) * 128;
#pragma unroll
        for (int i = 0; i < 2; i++)
#pragma unroll
          for (int j = 0; j < 2; j++)
#pragma unroll
            for (int g = 0; g < 4; g++) {
              const int kk = kk0 + wm_ * 64 + i * 32 + 8 * g + 4 * hh_;
              const int col = cb + wn_ * 64 + j * 32 + r_;
              uint2 o;
              o.x = pack2(acc[i][j][4 * g], acc[i][j][4 * g + 1]);
              o.y = pack2(acc[i][j][4 * g + 2], acc[i][j][4 * g + 3]);
              *(uint2*)(dst + ((size_t)(b * 512 + col)) * KPB + kk) = o;
            }
      }
    }
  PATCH_LOOP_END
  PATCH_LOOP_BEGIN(256, 8, 8, 8)
    f32x16 acc[2][2];
    zero_acc(acc);
    {
      const int rt = prt, ct = pct;
      const int b = rt >> 7, nlo = rt & 127;
      gemm_core(acc, A + (size_t)(b * KPB + CTXL + nlo) * D, (size_t)128 * D,
                wsp<u16>(p, O_WF) + (size_t)ct * 128 * D, D, D, smem);
      u16* dst = wsp<u16>(p, O_D1);
#pragma unroll
      for (int i = 0; i < 2; i++)
#pragma unroll
        for (int j = 0; j < 2; j++)
#pragma unroll
          for (int g = 0; g < 4; g++) {
            const int nhi = wm_ * 64 + i * 32 + 8 * g + 4 * hh_;
            const int n = ct * 128 + wn_ * 64 + j * 32 + r_;
            const int reim = n >> 9, jj = n & 511;
            uint2 o;
            o.x = pack2(acc[i][j][4 * g], acc[i][j][4 * g + 1]);
            o.y = pack2(acc[i][j][4 * g + 2], acc[i][j][4 * g + 3]);
            *(uint2*)(dst + ((((size_t)(b * 512 + jj)) * 128 + nlo) * 2 + reim) * 128 + nhi) = o;
          }
    }
  PATCH_LOOP_END
  if (!last) {
    for (int t2 = bid; t2 < 32; t2 += nb) {
      f32x16 acc[2][2];
      zero_acc(acc);
      const int rt = t2 >> 3, ct = t2 & 7;
      const int b = rt >> 1, rb = rt & 1;
      gemm_core(acc, A + (size_t)(b * KPB + rb * 128) * D, D, wsp<u16>(p, O_WF) + (size_t)ct * 128 * D, D, D, smem);
      u16* dst = wsp<u16>(p, O_D1C);
#pragma unroll
      for (int i = 0; i < 2; i++)
#pragma unroll
        for (int j = 0; j < 2; j++)
#pragma unroll
          for (int g = 0; g < 4; g++) {
            const int nc = rb * 128 + wm_ * 64 + i * 32 + 8 * g + 4 * hh_;
            const int n = ct * 128 + wn_ * 64 + j * 32 + r_;
            const int reim = n >> 9, jj = n & 511;
            uint2 o;
            o.x = pack2(acc[i][j][4 * g], acc[i][j][4 * g + 1]);
            o.y = pack2(acc[i][j][4 * g + 2], acc[i][j][4 * g + 3]);
            *(uint2*)(dst + (((size_t)(b * 512 + jj)) * 2 + reim) * 256 + nc) = o;
          }
    }
  }
}

__device__ __forceinline__ float inv_freq(int i) {
  switch (i) {
    case 0: return 1.0f;
    case 1: return 0.31622776601683794f;
    case 2: return 0.1f;
    case 3: return 0.03162277660168379f;
    case 4: return 0.01f;
    case 5: return 0.0031622776601683794f;
    case 6: return 0.001f;
    default: return 0.00031622776601683794f;
  }
}
__device__ __forceinline__ void rope_cs(int kk, int e, float& cs, float& sn) {
  if (kk < CTXL) { cs = 1.f; sn = 0.f; return; }
  const int tkn = kk - CTXL;
  const float pos = (e < 8) ? (float)(tkn >> 6) : (float)(tkn & 63);
  const float ang = pos * inv_freq(e & 7);
  double xr = (double)ang * 0.31830988618379067;
  xr -= 2.0 * floor(xr * 0.5);
  const float yr = (float)xr;
  cs = cospif(yr);
  sn = sinpif(yr);
}

__device__ __forceinline__ void row_rms(const u16* A, size_t lda, int K, float* rs) {
  const int tid = ltid();
  const int row = tid >> 1, half = tid & 1;
  const u16* pr = A + (size_t)row * lda + half * (K >> 1);
  float s = 0.f;
  for (int c = 0; c < (K >> 1); c += 8) {
    uint4 v = *(const uint4*)(pr + c);
    const uint32_t w[4] = {v.x, v.y, v.z, v.w};
#pragma unroll
    for (int q = 0; q < 4; q++) {
      const float a = __uint_as_float(w[q] << 16), bq = __uint_as_float(w[q] & 0xffff0000u);
      s += a * a + bq * bq;
    }
  }
  s += __shfl_xor(s, 1);
  if (half == 0) rs[row] = rsqrtf(s / (float)K + EPS);
  __syncthreads();
}

__device__ void phase_p2(const Params& p, int l, int bid, int nb, u16* smem) {
  EPI_DECL
  const u16* LAT = wsp<u16>(p, O_LAT);
  float* rs = (float*)(smem + 4 * SM_A);
  const int nQ = NRT * 6, nKV = NRT * 8, nFA = 1024 * 2, nKR = NRT;
  const int total = nQ + nKV + nFA + nKR;
  for (int t = bid; t < total; t += nb) {
    if (t < nQ) {
      const int rt = t / 6, ct = t - rt * 6;
      const int row0 = rt * 128, b = row0 / KPB, kk0 = row0 - b * KPB;
      row_rms(LAT + (size_t)row0 * 512, 512, 256, rs);
      f32x16 acc[2][2];
      zero_acc(acc);
      gemm_core(acc, wsp<u16>(p, O_WUQ) + (size_t)ct * 128 * 256, 256, LAT + (size_t)row0 * 512, 512, 256, smem);
      u16* QM = wsp<u16>(p, O_QM);
      if (ct < 4) {
#pragma unroll
        for (int i = 0; i < 2; i++)
#pragma unroll
          for (int j = 0; j < 2; j++)
#pragma unroll
            for (int g = 0; g < 4; g++) {
              const int rl = wn_ * 64 + j * 32 + r_;
              const int col = ct * 128 + wm_ * 64 + i * 32 + 8 * g + 4 * hh_;
              const int h = col >> 6, d = col & 63;
              const float sc = rs[rl] * MLA_SCALE_L2;
              uint2 o;
              o.x = pack2(acc[i][j][4 * g] * sc, acc[i][j][4 * g + 1] * sc);
              o.y = pack2(acc[i][j][4 * g + 2] * sc, acc[i][j][4 * g + 3] * sc);
              *(uint2*)(QM + (size_t)(row0 + rl) * 768 + h * 96 + d) = o;
            }
      } else {
        const int wt = (ct - 4) * 2 + wm_;
#pragma unroll
        for (int j = 0; j < 2; j++) {
          const int rl = wn_ * 64 + j * 32 + r_;
          const float sc = rs[rl] * MLA_SCALE_L2;
#pragma unroll
          for (int g = 0; g < 4; g++) {
            const int idx = wt * 32 + 8 * g + 4 * hh_;
            const int h = idx >> 4, e16 = idx & 15;
            float o1[4], o2[4];
#pragma unroll
            for (int q = 0; q < 4; q++) {
              float cs, sn;
              rope_cs(kk0 + rl, e16 + q, cs, sn);
              const float x1 = acc[0][j][4 * g + q] * sc, x2 = acc[1][j][4 * g + q] * sc;
              o1[q] = x1 * cs - x2 * sn;
              o2[q] = x2 * cs + x1 * sn;
            }
            u16* qd = QM + (size_t)(row0 + rl) * 768 + h * 96 + 64 + e16;
            uint2 o;
            o.x = pack2(o1[0], o1[1]);
            o.y = pack2(o1[2], o1[3]);
            *(uint2*)qd = o;
            o.x = pack2(o2[0], o2[1]);
            o.y = pack2(o2[2], o2[3]);
            *(uint2*)(qd + 16) = o;
          }
        }
      }
      __syncthreads();
    } else if (t < nQ + nKV) {
      const int t2 = t - nQ;
      const int rt = t2 >> 3, ct = t2 & 7;
      const int row0 = rt * 128, b = row0 / KPB, kk0 = row0 - b * KPB;
      row_rms(LAT + (size_t)row0 * 512 + 256, 512, 128, rs);
      f32x16 acc[2][2];
      zero_acc(acc);
      if (ct < 4) {
        gemm_core(acc, wsp<u16>(p, O_WUKV) + (size_t)ct * 128 * 128, 128, LAT + (size_t)row0 * 512 + 256, 512, 128,
                  smem);
        u16* KN = wsp<u16>(p, O_KN);
#pragma unroll
        for (int i = 0; i < 2; i++)
#pragma unroll
          for (int j = 0; j < 2; j++)
#pragma unroll
            for (int g = 0; g < 4; g++) {
              const int rl = wn_ * 64 + j * 32 + r_;
              const int col = ct * 128 + wm_ * 64 + i * 32 + 8 * g + 4 * hh_;
              const float sc = rs[rl];
              uint2 o;
              o.x = pack2(acc[i][j][4 * g] * sc, acc[i][j][4 * g + 1] * sc);
              o.y = pack2(acc[i][j][4 * g + 2] * sc, acc[i][j][4 * g + 3] * sc);
              *(uint2*)(KN + (size_t)(row0 + rl) * 512 + col) = o;
            }
      } else {
        gemm_core(acc, LAT + (size_t)row0 * 512 + 256, 512, wsp<u16>(p, O_WUKV) + (size_t)ct * 128 * 128, 128, 128,
                  smem);
        u16* VMT = wsp<u16>(p, O_VMT);
#pragma unroll
        for (int i = 0; i < 2; i++)
#pragma unroll
          for (int j = 0; j < 2; j++)
#pragma unroll
            for (int g = 0; g < 4; g++) {
              const int rl = wm_ * 64 + i * 32 + 8 * g + 4 * hh_;
              const int col = (ct - 4) * 128 + wn_ * 64 + j * 32 + r_;
              uint2 o;
              o.x = pack2(acc[i][j][4 * g] * rs[rl], acc[i][j][4 * g + 1] * rs[rl + 1]);
              o.y = pack2(acc[i][j][4 * g + 2] * rs[rl + 2], acc[i][j][4 * g + 3] * rs[rl + 3]);
              *(uint2*)(VMT + ((size_t)(b * 512 + col)) * KPB + kk0 + rl) = o;
            }
      }
      __syncthreads();
    } else if (t < nQ + nKV + nFA) {
      const int t2 = t - nQ - nKV;
      const int rt = t2 >> 1, ct = t2 & 1;
      const int b = rt >> 9, jj = rt & 511;
      f32x16 acc[2][2];
      zero_acc(acc);
      gemm_core(acc, wsp<u16>(p, O_D1) + (size_t)rt * 128 * 256, 256, wsp<u16>(p, O_MA) + (size_t)ct * 128 * 256, 256,
                256, smem);
      const float* TW = wsp<float>(p, O_TW);
      u16* D2 = wsp<u16>(p, O_D2);
      const int klo = ct * 64 + wn_ * 32 + r_;
#pragma unroll
      for (int i = 0; i < 2; i++)
#pragma unroll
        for (int g = 0; g < 4; g++) {
          const int nlo = wm_ * 64 + i * 32 + 8 * g + 4 * hh_;
          float re[4], im[4];
#pragma unroll
          for (int q = 0; q < 4; q++) {
            const float2 tw = *(const float2*)(TW + ((size_t)klo * 128 + nlo + q) * 2);
            const float ar = acc[i][0][4 * g + q], ai = acc[i][1][4 * g + q];
            re[q] = ar * tw.x + ai * tw.y;
            im[q] = ai * tw.x - ar * tw.y;
          }
          u16* d = D2 + ((((size_t)(b * 128 + klo)) * 512 + jj) * 2) * 128 + nlo;
          uint2 o;
          o.x = pack2(re[0], re[1]);
          o.y = pack2(re[2], re[3]);
          *(uint2*)d = o;
          o.x = pack2(im[0], im[1]);
          o.y = pack2(im[2], im[3]);
          *(uint2*)(d + 128) = o;
        }
    } else {
      const int rt = t - nQ - nKV - nFA;
      u16* KRR = wsp<u16>(p, O_KRR);
      for (int idx = ltid(); idx < 128 * 16; idx += 256) {
        const int rl = idx >> 4, e16 = idx & 15;
        const int row = rt * 128 + rl, b = row / KPB, kk = row - b * KPB;
        const float x1 = bf2f(LAT[(size_t)row * 512 + 384 + e16]), x2 = bf2f(LAT[(size_t)row * 512 + 400 + e16]);
        float cs, sn;
        rope_cs(kk, e16, cs, sn);
        KRR[(size_t)row * 32 + e16] = f2bf(x1 * cs - x2 * sn);
        KRR[(size_t)row * 32 + 16 + e16] = f2bf(x2 * cs + x1 * sn);
      }
    }
  }
}

template <int MODE>
__device__ void attn_item(const Params& p, int l, int b, int h, int q0  ,
                          int ntiles  , int rs0, int ycol, u16* smem) {
  constexpr int DQK = MODE == 0 ? 96 : 64;
  constexpr int KSTR = DQK + 8;
  constexpr int NKS = DQK / 16;
  constexpr int CPR = DQK / 8;
  constexpr int NKC = 64 * CPR / 256;
  const int tid = ltid(), lane = tid & 63, wave = tid >> 6, r = lane & 31, hh = lane >> 5;
  u16* Ks = smem;
  u16* Vs = smem + 2 * 64 * KSTR;
  const unsigned char* wsb = p.ws;
  const int qk = q0 + wave * 32 + r;
  const size_t qrow = (size_t)b * KPB + qk;
  bf16x8 qf[NKS];
  {
    const u16* qp = MODE == 0 ? wsp<u16>(p, O_QM) + qrow * 768 + h * 96 : wsp<u16>(p, O_QNA) + qrow * 512 + h * 64;
#pragma unroll
    for (int ks = 0; ks < NKS; ks++) qf[ks] = *(const bf16x8*)(qp + ks * 16 + hh * 8);
  }
  const short one_or_zero = hh == 0 ? (short)0x3F80 : (short)0;
  const bf16x8 kone = {one_or_zero, 0, 0, 0, 0, 0, 0, 0};
  bf16x8 qm = {0, 0, 0, 0, 0, 0, 0, 0};
  int qr = 0, qc = 0, rsq = 0, cs = 0;
  const float* rpb = nullptr;
  if (MODE == 1 && rs0 >= 0) {
    const int tkn = qk - CTXL;
    qr = tkn >> 6;
    qc = tkn & 63;
    rsq = min(max(qr - 4, 0), 248);
    cs = min(max(qc - 8, 0), 48);
    rpb = p.rpb + ((size_t)(l * 8 + h)) * 15 * 31;
  }
  f32x16 o[2];
#pragma unroll
  for (int e = 0; e < 16; e++) { o[0][e] = 0.f; o[1][e] = 0.f; }
  float lsum = 0.f;
  float m = 0.f;
  const bf16x8 ones = {(short)0x3F80, (short)0x3F80, (short)0x3F80, (short)0x3F80,
                       (short)0x3F80, (short)0x3F80, (short)0x3F80, (short)0x3F80};

#define KGEO(i)                                                                                          \
  uint32_t kof##i, kmu##i;                                                                               \
  int kls##i;                                                                                            \
  {                                                                                                      \
    const int c = tid + 256 * (i);                                                                       \
    const int row = c / CPR, cc = c - row * CPR;                                                         \
    if (MODE == 0 && cc >= 8) {                                                                          \
      kof##i = (uint32_t)(O_KRR + ((size_t)(b * KPB + row) * 32 + (cc - 8) * 8) * 2);                    \
      kmu##i = 64u;                                                                                      \
    } else {                                                                                             \
      kof##i = (uint32_t)((MODE == 0 ? O_KN : O_KNA) + ((size_t)(b * KPB + row) * 512 + h * 64 + cc * 8) * 2); \
      kmu##i = 1024u;                                                                                    \
    }                                                                                                    \
    kls##i = row * KSTR + cc * 8;                                                                        \
  }
#define VGEO(i)                                                                                          \
  uint32_t vof##i;                                                                                       \
  int vls##i;                                                                                            \
  bool vsx##i;                                                                                           \
  {                                                                                                      \
    const int c = tid + 256 * (i);                                                                       \
    const int d = c >> 3, cc = c & 7;                                                                    \
    vof##i = (uint32_t)((MODE == 0 ? O_VMT : O_VNAT) + ((size_t)(b * 512 + h * 64 + d) * KPB + cc * 8) * 2); \
    vls##i = d * 72 + cc * 8;                                                                            \
    vsx##i = (d & 8) != 0;                                                                               \
  }
  KGEO(0) KGEO(1) KGEO(2) VGEO(0) VGEO(1)
  (void)kof2; (void)kmu2; (void)kls2;
  u32x4 kr0A, kr1A, kr2A, vr0A, vr1A, kr0B, kr1B, kr2B, vr0B, vr1B;
  kr2A = kr1A = kr0A = vr0A = vr1A = kr2B = kr1B = kr0B = vr0B = vr1B = (u32x4){0u, 0u, 0u, 0u};
#define TILE_KK0(t) ((MODE == 1 && (t) >= 4) ? (uint32_t)(CTXL + 64 * min(rs0 + (t)-4, 255)) : (uint32_t)(64 * (t)))
#define LOAD_KV(t, S)                                                                   \
  {                                                                                     \
    const uint32_t kk0_ = TILE_KK0(t);                                                  \
    kr0##S = *(const u32x4*)(wsb + (size_t)(kof0 + kk0_ * kmu0));                       \
    kr1##S = *(const u32x4*)(wsb + (size_t)(kof1 + kk0_ * kmu1));                       \
    if (NKC == 3) kr2##S = *(const u32x4*)(wsb + (size_t)(kof2 + kk0_ * kmu2));         \
    vr0##S = *(const u32x4*)(wsb + (size_t)(vof0 + kk0_ * 2u));                         \
    vr1##S = *(const u32x4*)(wsb + (size_t)(vof1 + kk0_ * 2u));                         \
  }
#define STORE_V1(buf, i, srcv)                                                          \
  {                                                                                     \
    u32x4 sv_ = srcv;                                                                   \
    if (vsx##i) sv_ = (u32x4){sv_[2], sv_[3], sv_[0], sv_[1]};                          \
    *(u32x4*)(Vs + (buf)*64 * 72 + vls##i) = sv_;                                       \
  }
#define STORE_KV(buf, S)                                                                \
  {                                                                                     \
    *(u32x4*)(Ks + (buf)*64 * KSTR + kls0) = kr0##S;                                    \
    *(u32x4*)(Ks + (buf)*64 * KSTR + kls1) = kr1##S;                                    \
    if (NKC == 3) *(u32x4*)(Ks + (buf)*64 * KSTR + kls2) = kr2##S;                      \
    STORE_V1(buf, 0, vr0##S) STORE_V1(buf, 1, vr1##S)                                   \
  }
#define QK_TILE(kbuf, t)                                                                           \
  {                                                                                                \
    const u16* kb_ = Ks + (kbuf)*64 * KSTR + r * KSTR + hh * 8;                                    \
    {                                                                                              \
      f32x16 z_;                                                                                   \
      _Pragma("unroll") for (int e = 0; e < 16; e++) z_[e] = 0.f;                                  \
      sc[0] = __builtin_amdgcn_mfma_f32_32x32x16_bf16(kone, qm, z_, 0, 0, 0);                      \
      sc[1] = sc[0];                                                                               \
    }                                                                                              \
    _Pragma("unroll") for (int ks = 0; ks < NKS; ks++) {                                           \
      const bf16x8 kf0 = *(const bf16x8*)(kb_ + ks * 16);                                          \
      const bf16x8 kf1 = *(const bf16x8*)(kb_ + 32 * KSTR + ks * 16);                              \
      sc[0] = __builtin_amdgcn_mfma_f32_32x32x16_bf16(kf0, qf[ks], sc[0], 0, 0, 0);                \
      sc[1] = __builtin_amdgcn_mfma_f32_32x32x16_bf16(kf1, qf[ks], sc[1], 0, 0, 0);                \
    }                                                                                              \
    if (MODE == 1 && (t) >= 4) {                                                                   \
      const int kr_ = rs0 + (t)-4;                                                                 \
      const bool rowok = (kr_ >= rsq) && (kr_ < rsq + 8);                                          \
      const float* rp = rpb + (kr_ - qr + 7) * 31 + (15 - qc);                                     \
      _Pragma("unroll") for (int kb = 0; kb < 2; kb++) _Pragma("unroll") for (int e = 0; e < 16; e++) { \
        const int kc = kb * 32 + (e & 3) + 8 * (e >> 2) + 4 * hh;                                  \
        const bool valid = rowok && (kc >= cs) && (kc < cs + 16);                                  \
        float bias = 0.f;                                                                          \
        if (valid) bias = rp[kc];                                                                  \
        sc[kb][e] = valid ? sc[kb][e] + bias * LOG2E : -1e30f;                                     \
      }                                                                                            \
    }                                                                                              \
  }
#define TILE_MAX(tmax)                                                                             \
  {                                                                                                \
    tmax = sc[0][0];                                                                               \
    _Pragma("unroll") for (int e = 1; e < 16; e++) tmax = fmaxf(tmax, sc[0][e]);                   \
    _Pragma("unroll") for (int e = 0; e < 16; e++) tmax = fmaxf(tmax, sc[1][e]);                   \
    const uint32_t tu = __float_as_uint(tmax);                                                     \
    const auto sw = __builtin_amdgcn_permlane32_swap(tu, tu, false, false);                        \
    tmax = fmaxf(__uint_as_float(sw[0]), __uint_as_float(sw[1]));                                  \
  }
#define MOVE_REF(mnew_)                                                                            \
  {                                                                                                \
    const float mq_ = bf2f(f2bf(mnew_));                                                           \
    const float delta_ = mq_ - m;                                                                  \
    const float alpha = __builtin_amdgcn_exp2f(-delta_);                                           \
    m = mq_;                                                                                       \
    _Pragma("unroll") for (int e = 0; e < 16; e++) {                                               \
      o[0][e] *= alpha; o[1][e] *= alpha;                                                         \
      sc[0][e] -= delta_; sc[1][e] -= delta_;                                                      \
    }                                                                                              \
    lsum *= alpha;                                                                                 \
    qm[0] = (hh == 0) ? (short)f2bf(-m) : (short)0;                                                \
  }
#define SOFTMAX_PV(vbuf)                                                                           \
  {                                                                                                \
    const u16* vb_ = Vs + (vbuf)*64 * 72 + r * 72 + vsw;                                           \
    _Pragma("unroll") for (int kb = 0; kb < 2; kb++) _Pragma("unroll") for (int st = 0; st < 2; st++) { \
      u32x4 pu;                                                                                    \
      _Pragma("unroll") for (int q = 0; q < 4; q++) {                                              \
        const float p0_ = __builtin_amdgcn_exp2f(sc[kb][8 * st + 2 * q]);                          \
        const float p1_ = __builtin_amdgcn_exp2f(sc[kb][8 * st + 2 * q + 1]);                      \
        lsum += p0_ + p1_;                                                                         \
        pu[q] = pack2(p0_, p1_);                                                                   \
      }                                                                                            \
      const bf16x8 pbv = __builtin_bit_cast(bf16x8, pu);                                           \
      _Pragma("unroll") for (int db = 0; db < 2; db++) {                                           \
        const u16* vp = vb_ + db * 32 * 72 + kb * 32 + 16 * st;                                    \
        const bf16x4 vlo = *(const bf16x4*)(vp);                                                   \
        const bf16x4 vhi = *(const bf16x4*)(vp + 8);                                               \
        const bf16x8 vfv = __builtin_shufflevector(vlo, vhi, 0, 1, 2, 3, 4, 5, 6, 7);              \
        o[db] = __builtin_amdgcn_mfma_f32_32x32x16_bf16(vfv, pbv, o[db], 0, 0, 0);                 \
      }                                                                                            \
    }                                                                                              \
  }
#define DEFER_REF(tmax)                                                                            \
  if (__any(tmax > 8.f)) {                                                                         \
    const float mq_ = bf2f(f2bf(m + fmaxf(tmax, 0.f)));                                            \
    const float alpha = __builtin_amdgcn_exp2f(m - mq_);                                           \
    m = mq_;                                                                                       \
    _Pragma("unroll") for (int e = 0; e < 16; e++) { o[0][e] *= alpha; o[1][e] *= alpha; }       \
    lsum *= alpha;                                                                                 \
    qm[0] = (hh == 0) ? (short)f2bf(-m) : (short)0;                                                \
  }
#define ATT_STEP(t, LD, ST)                                        \
  {                                                                \
    const int cur = (t)&1;                                         \
    LOAD_KV(min((t) + 2, tl), LD)                                  \
    __builtin_amdgcn_sched_barrier(0);                             \
    QK_TILE(cur, t)                                                \
    SOFTMAX_PV(cur)                                                \
    float tmax;                                                    \
    TILE_MAX(tmax)                                                 \
    DEFER_REF(tmax)                                                \
    STORE_KV(cur ^ 1, ST)                                          \
    __syncthreads();                                               \
  }

  const int tl = ntiles - 1;
  const int vsw = 4 * (hh ^ ((r >> 3) & 1));
  f32x16 sc[2];
  LOAD_KV(0, A)
  STORE_KV(0, A)
  LOAD_KV(min(1, tl), A)
  __syncthreads();
  {
    LOAD_KV(min(2, tl), B)
    __builtin_amdgcn_sched_barrier(0);
    QK_TILE(0, 0)
    float tmax;
    TILE_MAX(tmax)
    MOVE_REF(tmax)
    SOFTMAX_PV(0)
    STORE_KV(1, A)
    __syncthreads();
  }
  for (int t = 1; t + 1 < ntiles; t += 2) {
    ATT_STEP(t, A, B)
    ATT_STEP(t + 1, B, A)
  }
  ATT_STEP(tl, A, B)
  const float inv = 1.f / (lsum + __shfl_xor(lsum, 32));
  u16* yp = wsp<u16>(p, O_Y) + qrow * 1536 + ycol + h * 64;
#pragma unroll
  for (int db = 0; db < 2; db++)
#pragma unroll
    for (int g = 0; g < 4; g++) {
      uint2 ov;
      ov.x = pack2(o[db][4 * g] * inv, o[db][4 * g + 1] * inv);
      ov.y = pack2(o[db][4 * g + 2] * inv, o[db][4 * g + 3] * inv);
      *(uint2*)(yp + db * 32 + 8 * g + 4 * hh) = ov;
    }
#undef KGEO
#undef VGEO
#undef TILE_KK0
#undef LOAD_KV
#undef STORE_V1
#undef STORE_KV
#undef QK_TILE
#undef TILE_MAX
#undef MOVE_REF
#undef SOFTMAX_PV
#undef ATT_STEP
#undef DEFER_REF
}

__device__ void phase_p3(const Params& p, int l, bool last, int bid, int nb, u16* smem) {
  EPI_DECL
  const int nMLA = 2048, nNA = 2048, nFB = 1024;
  const int nC = last ? 0 : (32 + 32 + 16);
  const int total = nMLA + nNA + nFB + nC;
  for (int t = bid; t < total; t += nb) {
    int kind, b = 0, h = 0, q0 = 0, ntl = 0, rs0 = -1;
    size_t aoff = 0, boff = 0;
    int Kf = 256, j0 = 0, tok0 = 0, tokmul = 1, colbase = 0;
    if (t < nMLA) {
      kind = 0;
      h = t & 7;
      const int rest = t >> 3;
      b = rest >> 7;
      q0 = CTXL + (rest & 127) * 128;
      ntl = 260;
    } else if (t < nMLA + nNA) {
      kind = 1;
      const int t2 = t - nMLA;
      h = t2 & 7;
      const int rest = t2 >> 3, rp = rest & 127;
      b = rest >> 7;
      rs0 = min(max(2 * rp - 4, 0), 248);
      const int rs1 = min(max(2 * rp + 1 - 4, 0), 248);
      q0 = CTXL + rp * 128;
      ntl = (4 + (rs1 + 8 - rs0) + 1) & ~1;
    } else if (t < nMLA + nNA + nFB) {
      kind = 2;
      const int rt = t - nMLA - nNA;
      const int bk = rt >> 2;
      j0 = (rt & 3) * 128;
      b = bk >> 7;
      tok0 = CTXL + (bk & 127);
      tokmul = 128;
      aoff = O_D2 + (size_t)rt * 128 * 256 * 2;
      boff = O_MB;
      Kf = 256;
    } else {
      const int t2 = t - nMLA - nNA - nFB;
      if (t2 < 64) {
        kind = t2 >> 5;
        const int t3 = t2 & 31;
        h = t3 & 7;
        b = (t3 >> 3) & 1;
        q0 = (t3 >> 4) * 128;
        ntl = 4;
      } else {
        kind = 2;
        const int t3 = t2 - 64;
        const int rt = t3 >> 1, ct = t3 & 1;
        b = rt >> 2;
        j0 = (rt & 3) * 128;
        colbase = ct * 128;
        aoff = O_D1C + (size_t)rt * 128 * 512 * 2;
        boff = O_MC + (size_t)ct * 128 * 512 * 2;
        Kf = 512;
      }
    }
    if (kind == 0) {
      attn_item<0>(p, l, b, h, q0, ntl, -1, 1024, smem);
    } else if (kind == 1) {
      attn_item<1>(p, l, b, h, q0, ntl, rs0, 512, smem);
    } else {
      f32x16 acc[2][2];
      zero_acc(acc);
      gemm_core(acc, wsp<u16>(p, aoff), Kf, wsp<u16>(p, boff), Kf, Kf, smem);
      u16* Y = wsp<u16>(p, O_Y);
#pragma unroll
      for (int i = 0; i < 2; i++)
#pragma unroll
        for (int j = 0; j < 2; j++)
#pragma unroll
          for (int g = 0; g < 4; g++) {
            const int jj = j0 + wm_ * 64 + i * 32 + 8 * g + 4 * hh_;
            const int tok = tok0 + (colbase + wn_ * 64 + j * 32 + r_) * tokmul;
            uint2 ov;
            ov.x = pack2(acc[i][j][4 * g], acc[i][j][4 * g + 1]);
            ov.y = pack2(acc[i][j][4 * g + 2], acc[i][j][4 * g + 3]);
            *(uint2*)(Y + ((size_t)b * KPB + tok) * 1536 + jj) = ov;
          }
    }
  }
}

__device__ __forceinline__ int n_row_tiles(bool last) { return last ? NRT - 4 : NRT; }
__device__ __forceinline__ int row_tile(bool last, int i) {
  if (!last) return i;
  return i < 128 ? i + 2 : i + 4;
}

__device__ void phase_p4(const Params& p, int l, bool last, int bid, int nb, u16* smem) {
  EPI_DECL
  const u16* A = wsp<u16>(p, O_A);
  const u16* Y = wsp<u16>(p, O_Y);
  u16* M = wsp<u16>(p, O_M);
  uint4* stash = wsp<uint4>(p, O_QM) + (size_t)bid * 24 * 256 + ltid();
  const int nrt_ = n_row_tiles(last);
  PATCH_LOOP_BEGIN(nrt_, 8, 8, 8)
    const int rt = row_tile(last, prt), ct = pct;
#pragma unroll 1
    for (int g = 0; g < 3; g++) {
      f32x16 acc[2][2];
      zero_acc(acc);
      gemm_core<true>(acc, wsp<u16>(p, O_WG) + (size_t)(g * 1024 + ct * 128) * D, D, A + (size_t)rt * 128 * D, D, D,
                      smem);
#pragma unroll
      for (int i = 0; i < 2; i++)
#pragma unroll
        for (int j = 0; j < 2; j++)
#pragma unroll
          for (int e = 0; e < 2; e++) {
            uint4 gq4;
            gq4.x = pack2(fsigmoid(acc[i][j][8 * e]), fsigmoid(acc[i][j][8 * e + 1]));
            gq4.y = pack2(fsigmoid(acc[i][j][8 * e + 2]), fsigmoid(acc[i][j][8 * e + 3]));
            gq4.z = pack2(fsigmoid(acc[i][j][8 * e + 4]), fsigmoid(acc[i][j][8 * e + 5]));
            gq4.w = pack2(fsigmoid(acc[i][j][8 * e + 6]), fsigmoid(acc[i][j][8 * e + 7]));
            stash[(g * 8 + (i * 2 + j) * 2 + e) * 256] = gq4;
          }
    }
    f32x16 mg[2][2];
    zero_acc(mg);
#pragma unroll 1
    for (int g = 0; g < 3; g++) {
      f32x16 acc[2][2];
      zero_acc(acc);
      gemm_core<true>(acc, wsp<u16>(p, O_WB) + (size_t)(g * 1024 + ct * 128) * 512, 512,
                       Y + (size_t)rt * 128 * 1536 + g * 512, 1536, 512, smem);
#pragma unroll
      for (int i = 0; i < 2; i++)
#pragma unroll
        for (int j = 0; j < 2; j++)
#pragma unroll
          for (int e = 0; e < 2; e++) {
            const uint4 gq4 = stash[(g * 8 + (i * 2 + j) * 2 + e) * 256];
            const uint32_t gw[4] = {gq4.x, gq4.y, gq4.z, gq4.w};
#pragma unroll
            for (int q = 0; q < 4; q++) {
              mg[i][j][8 * e + 2 * q] += __uint_as_float(gw[q] << 16) * acc[i][j][8 * e + 2 * q];
              mg[i][j][8 * e + 2 * q + 1] += __uint_as_float(gw[q] & 0xffff0000u) * acc[i][j][8 * e + 2 * q + 1];
            }
          }
    }
#pragma unroll
    for (int i = 0; i < 2; i++)
#pragma unroll
      for (int j = 0; j < 2; j++)
#pragma unroll
        for (int g = 0; g < 4; g++) {
          const int row = rt * 128 + wn_ * 64 + j * 32 + r_;
          const int col = ct * 128 + wm_ * 64 + i * 32 + 8 * g + 4 * hh_;
          uint2 o;
          o.x = pack2(mg[i][j][4 * g], mg[i][j][4 * g + 1]);
          o.y = pack2(mg[i][j][4 * g + 2], mg[i][j][4 * g + 3]);
          *(uint2*)(M + (size_t)row * D + col) = o;
        }
  PATCH_LOOP_END
}

__device__ void phase_resid(const Params& p, int l, bool last, const u16* Ain, size_t lda, const u16* W, int K, int goff,
                            int bid, int nb, u16* smem) {
  EPI_DECL
  const float* mod = wsp<float>(p, O_MOD);
  const int nrt_ = n_row_tiles(last);
  PATCH_LOOP_BEGIN(nrt_, 8, 8, 8)
    const int rt = row_tile(last, prt), ct = pct;
    f32x16 acc[2][2];
    zero_acc(acc);
    gemm_core(acc, W + (size_t)ct * 128 * K, K, Ain + (size_t)rt * 128 * lda, lda, K, smem);
    const int row0 = rt * 128, b = row0 / KPB, kk0 = row0 - b * KPB;
    const int m = kk0 < CTXL ? 2 : b;
    float* xb = xrow(p, row0);
    const float* gv = mod + ((size_t)l * 3 + m) * 6144 + goff;
#pragma unroll
    for (int i = 0; i < 2; i++)
#pragma unroll
      for (int g = 0; g < 4; g++) {
        const int col = ct * 128 + wm_ * 64 + i * 32 + 8 * g + 4 * hh_;
        const float4 g4 = *(const float4*)(gv + col);
#pragma unroll
        for (int j = 0; j < 2; j++) {
          const int rl = wn_ * 64 + j * 32 + r_;
          float4* xp = (float4*)(xb + (size_t)rl * D + col);
          float4 xv = *xp;
          xv.x = ALPHA * xv.x + (1.f + g4.x) * acc[i][j][4 * g];
          xv.y = ALPHA * xv.y + (1.f + g4.y) * acc[i][j][4 * g + 1];
          xv.z = ALPHA * xv.z + (1.f + g4.z) * acc[i][j][4 * g + 2];
          xv.w = ALPHA * xv.w + (1.f + g4.w) * acc[i][j][4 * g + 3];
          *xp = xv;
        }
      }
  PATCH_LOOP_END
}

__device__ void phase_p7(const Params& p, int l, bool last, int bid, int nb, u16* smem) {
  EPI_DECL
  const u16* A = wsp<u16>(p, O_A);
  u16* HH = wsp<u16>(p, O_HH);
  const int nrt_ = n_row_tiles(last);
  PATCH_LOOP_BEGIN(nrt_, 44, 16, 4)
    const int rt = row_tile(last, prt), ct = pct;
    f32x16 acc[2][2];
    zero_acc(acc);
    gemm_core(acc, wsp<u16>(p, O_WGU) + (size_t)ct * 128 * D, D, A + (size_t)rt * 128 * D, D, D, smem);
#pragma unroll
    for (int j = 0; j < 2; j++)
#pragma unroll
      for (int g = 0; g < 4; g++) {
        const int row = rt * 128 + wn_ * 64 + j * 32 + r_;
        const int q = (ct * 2 + wm_) * 32 + 8 * g + 4 * hh_;
        float hv[4];
#pragma unroll
        for (int t = 0; t < 4; t++) {
          const float gt = acc[0][j][4 * g + t], up = acc[1][j][4 * g + t];
          hv[t] = gt * fsigmoid(gt) * up;
        }
        uint2 o;
        o.x = pack2(hv[0], hv[1]);
        o.y = pack2(hv[2], hv[3]);
        *(uint2*)(HH + (size_t)row * FH + q) = o;
      }
  PATCH_LOOP_END
}

constexpr int NPHASE = 3 + 9 * 2;

__device__ void run_phase(const Params& p, int ph, int bid, int nb, u16* smem) {
  if (ph == 0) {
    prep_tables(p, bid, nb);
    prep_modp(p, bid, nb);
    prep_weights(p, 0, bid, nb, smem);
    return;
  }
  if (ph == 1) { prep_modr(p, bid, nb); return; }
  if (ph == 2) { ln_phase(p, 0, p.ln_in_g, p.ln_in_b, 0, 0, 1024, false, bid, nb); return; }
  const int l = (ph - 3) / 9, s = (ph - 3) % 9;
  const bool last = (l == 1);
  switch (s) {
    case 0: phase_p1(p, l, last, bid, nb, smem); break;
    case 1: phase_p2(p, l, bid, nb, smem); break;
    case 2: phase_p3(p, l, last, bid, nb, smem); break;
    case 3: phase_p4(p, l, last, bid, nb, smem); break;
    case 4: phase_resid(p, l, last, wsp<u16>(p, O_M), D, wsp<u16>(p, O_WO), D, 2048, bid, nb, smem); break;
    case 5: ln_phase(p, 1, p.ln1_g + l * D, p.ln1_b + l * D, l, 3072, 4096, last, bid, nb); break;
    case 6: phase_p7(p, l, last, bid, nb, smem); break;
    case 7: phase_resid(p, l, last, wsp<u16>(p, O_HH), FH, wsp<u16>(p, O_WD), FH, 5120, bid, nb, smem); break;
    default:
      ln_phase(p, 1, p.ln2_g + l * D, p.ln2_b + l * D, last ? -1 : l + 1, 0, 1024, last, bid, nb);
      if (!last) prep_weights(p, l + 1, bid, nb, smem);
      break;
  }
}


#define XB_TMO      128
#define XB_XCNT(j)  (256  + 64 * (j))
#define XB_XSUB(j)  (1280 + 64 * (j))
#define XB_XGEN(j)  (2304 + 64 * (j))
#define XB_TOP      3328
#define XB_TOPGEN   3392
#define XCD_BAR_WORDS 3456
#define XB_SPIN_CAP (1u << 20)
#define LAS __attribute__((address_space(3)))
__device__ __forceinline__ unsigned xb_ld(unsigned* p) { return __hip_atomic_load(p, __ATOMIC_RELAXED, __HIP_MEMORY_SCOPE_AGENT); }
__device__ __forceinline__ unsigned xb_add(unsigned* p, unsigned v) { return __hip_atomic_fetch_add(p, v, __ATOMIC_RELAXED, __HIP_MEMORY_SCOPE_AGENT); }
__device__ __forceinline__ unsigned xb_xcc_id() { return (unsigned)__builtin_amdgcn_s_getreg((3 << 11) | 20) & 0xFu; }
#define XB_SPIN(cond, bar) do { unsigned _sp = 0; while (cond) { __builtin_amdgcn_s_sleep(1); \
    if ((++_sp & 255u) == 0u) { if (xb_ld(&(bar)[XB_TMO])) break; if (_sp > XB_SPIN_CAP) { atomicAdd(&(bar)[XB_TMO], 1u); break; } } } } while (0)
struct XcdBarrier {
  unsigned* bar; unsigned x;
  volatile LAS unsigned* st;
};
__device__ __forceinline__ XcdBarrier xcd_barrier_post(unsigned* bar, volatile LAS unsigned* st) {
  XcdBarrier b; b.bar = bar; b.x = xb_xcc_id(); b.st = st;
  if (threadIdx.x == 0) (void)xb_add(&bar[XB_XCNT(b.x)], 1u);
  return b;
}
__device__ __forceinline__ void xcd_barrier_complete(unsigned* bar, unsigned x, unsigned& nloc, unsigned& nx) {
  const unsigned G = gridDim.x * gridDim.y * gridDim.z;
  unsigned sum, cnt, mine, sp = 0u;
  for (;;) {
    sum = 0u; cnt = 0u; mine = 0u;
#pragma unroll
    for (unsigned j = 0; j < 16; ++j) { const unsigned c = xb_ld(&bar[XB_XCNT(j)]); sum += c; cnt += (c > 0u) ? 1u : 0u; mine = (j == x) ? c : mine; }
    if (sum == G) break;
    __builtin_amdgcn_s_sleep(1);
    if ((++sp & 255u) == 0u) { if (xb_ld(&bar[XB_TMO])) break; if (sp > XB_SPIN_CAP) { atomicAdd(&bar[XB_TMO], 1u); break; } }
  }
  nloc = mine > 0u ? mine : 1u; nx = cnt > 0u ? cnt : 1u;
}
__device__ __forceinline__ void xcd_barrier(const XcdBarrier& b) {
  asm volatile("s_waitcnt vmcnt(0)" ::: "memory");
  __syncthreads();
  if (threadIdx.x == 0) {
    unsigned* bar = b.bar;
    __builtin_amdgcn_s_waitcnt(0);
    unsigned nloc = b.st[0], nx = b.st[1];
    if (nloc == 0u) { xcd_barrier_complete(bar, b.x, nloc, nx); b.st[0] = nloc; b.st[1] = nx; }
    const unsigned old = xb_add(&bar[XB_XSUB(b.x)], 1u);
    const unsigned gen = old / nloc;
    if (old + 1u == (gen + 1u) * nloc) {
      __builtin_amdgcn_fence(__ATOMIC_RELEASE, "agent");
      asm volatile("s_waitcnt vmcnt(0)" ::: "memory");
      const unsigned og = xb_add(&bar[XB_TOP], 1u);
      const unsigned tg = og / nx;
      if (og + 1u == (tg + 1u) * nx) xb_add(&bar[XB_TOPGEN], 1u);
      else XB_SPIN(xb_ld(&bar[XB_TOPGEN]) == tg, bar);
      __builtin_amdgcn_fence(__ATOMIC_ACQUIRE, "agent");
      xb_add(&bar[XB_XGEN(b.x)], 1u);
      asm volatile("s_waitcnt vmcnt(0)" ::: "memory");
    } else {
      XB_SPIN(xb_ld(&bar[XB_XGEN(b.x)]) == gen, bar);
      __builtin_amdgcn_fence(__ATOMIC_ACQUIRE, "agent");
      asm volatile("s_waitcnt vmcnt(0)" ::: "memory");
    }
  }
  __syncthreads();
}

constexpr int SMEM_ELEMS = 4 * SM_A + 256 + 8;

#if COOP
__global__ void __launch_bounds__(256, 2) mega_kernel(Params p) {
  __shared__ __attribute__((aligned(16))) u16 smem[SMEM_ELEMS];
  cg::grid_group grid = cg::this_grid();
  volatile LAS unsigned* st = (volatile LAS unsigned*)(smem + 4 * SM_A + 256);
  if (threadIdx.x == 0) { st[0] = 0u; st[1] = 0u; }
  __syncthreads();
  XcdBarrier xb = xcd_barrier_post((unsigned*)(p.ws + O_BAR), st);
  for (int ph = 0; ph < NPHASE; ph++) {
#ifdef PROBE_MASK
    const int s9 = ph >= 3 ? (ph - 3) % 9 : -1;
    const int nrep = (s9 >= 0 && ((PROBE_MASK >> s9) & 1)) ? 2 : 1;
    for (int rep = 0; rep < nrep; rep++) {
      run_phase(p, ph, blockIdx.x, gridDim.x, smem);
      if (ph == 0) grid.sync();
      else if (ph + 1 < NPHASE || rep + 1 < nrep) xcd_barrier(xb);
    }
#else
    run_phase(p, ph, blockIdx.x, gridDim.x, smem);
    if (ph == 0) grid.sync();
    else if (ph + 1 < NPHASE) xcd_barrier(xb);
#endif
  }
}
#else
__global__ void __launch_bounds__(256, 2) phase_kernel(Params p, int ph) {
  __shared__ __attribute__((aligned(16))) u16 smem[SMEM_ELEMS];
  run_phase(p, ph, blockIdx.x, gridDim.x, smem);
}
#endif

extern "C" void kernel_launch(void* const* d_in, const int* in_sizes, int n_in, void* d_out, int out_size, void* d_ws,
                              size_t ws_size, hipStream_t stream) {
  Params p{};
  const float** f = (const float**)&p;
  for (int i = 0; i < 25; i++) f[i] = (const float*)d_in[i];
  p.out = (float*)d_out;
  p.ws = (unsigned char*)d_ws;
  if (ws_size < O_WSEND) fprintf(stderr, "workspace too small: %zu < %zu\n", ws_size, (size_t)O_WSEND);
#if COOP
  static int grid_blocks = 0;
  if (!grid_blocks) {
    int dev = 0, cus = 0, per_cu = 0;
    hipGetDevice(&dev);
    hipDeviceGetAttribute(&cus, hipDeviceAttributeMultiprocessorCount, dev);
    hipOccupancyMaxActiveBlocksPerMultiprocessor(&per_cu, mega_kernel, 256, 0);
    if (per_cu > 2) per_cu = 2;
    grid_blocks = cus * per_cu;
  }
  (void)hipMemsetAsync(p.ws + O_BAR, 0, 3456 * 4, stream);
  void* args[] = {&p};
  hipError_t e = hipLaunchCooperativeKernel((void*)mega_kernel, dim3(grid_blocks), dim3(256), args, 0, stream);
  if (e != hipSuccess) fprintf(stderr, "cooperative launch failed: %s (grid %d)\n", hipGetErrorString(e), grid_blocks);
#else
  for (int ph = 0; ph < NPHASE; ph++) phase_kernel<<<512, 256, 0, stream>>>(p, ph);
#endif
}
```

```cpp
#include <hip/hip_runtime.h>
#include <hip/hip_cooperative_groups.h>
#include <stdint.h>
#include <cstdio>
namespace cg = cooperative_groups;

#ifndef COOP
#define COOP 1
#endif

typedef __attribute__((ext_vector_type(8))) short bf16x8;
typedef __attribute__((ext_vector_type(4))) short bf16x4;
typedef __attribute__((ext_vector_type(16))) float f32x16;
typedef unsigned short u16;
typedef __attribute__((ext_vector_type(4))) unsigned int u32x4;

constexpr int D = 1024;
constexpr int NBATCH = 2;
constexpr int SEQ = 16384;
constexpr int CTXL = 256;
constexpr int KPB = SEQ + CTXL;
constexpr int T = NBATCH * KPB;
constexpr int NRT = T / 128;
constexpr int FH = 2816;
constexpr int IN_DIM = 5536;
constexpr float LOG2E = 1.4426950408889634f;
constexpr float NA_SCALE_L2 = 0.125f * LOG2E;
constexpr float MLA_SCALE_L2 = 0.10206207261596575f * LOG2E;
constexpr float ALPHA = 1.4142135623730951f;
constexpr float EPS = 1e-5f;
constexpr float RS128 = 0.08838834764831845f;

constexpr size_t al256(size_t x) { return (x + 255) & ~(size_t)255; }
constexpr size_t O_WF = 0;
constexpr size_t O_WP = O_WF + (size_t)1024 * 1024 * 2;
constexpr size_t O_WG = O_WP + (size_t)2048 * 1024 * 2;
constexpr size_t O_WUQ = O_WG + (size_t)3072 * 1024 * 2;
constexpr size_t O_WUKV = O_WUQ + (size_t)768 * 256 * 2;
constexpr size_t O_WB = O_WUKV + (size_t)1024 * 128 * 2;
constexpr size_t O_WO = O_WB + (size_t)3 * 1024 * 512 * 2;
constexpr size_t O_WGU = O_WO + (size_t)1024 * 1024 * 2;
constexpr size_t O_WD = O_WGU + (size_t)5632 * 1024 * 2;
constexpr size_t O_MA = O_WD + (size_t)1024 * 2816 * 2;
constexpr size_t O_MB = O_MA + (size_t)256 * 256 * 2;
constexpr size_t O_MC = O_MB + (size_t)128 * 256 * 2;
constexpr size_t O_TW = O_MC + (size_t)256 * 512 * 2;
constexpr size_t O_MODP = O_TW + (size_t)128 * 128 * 2 * 4;
constexpr size_t O_MOD = O_MODP + (size_t)16 * 2 * 3 * 6144 * 4;
constexpr size_t O_XCTX = O_MOD + (size_t)2 * 3 * 6144 * 4;
constexpr size_t O_D1C = O_XCTX + (size_t)512 * 1024 * 4;
constexpr size_t O_A = O_D1C + (size_t)2 * 512 * 2 * 256 * 2;
constexpr size_t O_RQ = O_A + (size_t)T * 1024 * 2;
constexpr size_t O_QNA = O_RQ;
constexpr size_t O_KNA = O_QNA + (size_t)T * 512 * 2;
constexpr size_t O_VNAT = O_KNA + (size_t)T * 512 * 2;
constexpr size_t O_RY = O_VNAT + (size_t)T * 512 * 2;
constexpr size_t O_Y = O_RY;
constexpr size_t O_D1 = O_RY;
constexpr size_t O_LAT = O_RY + (size_t)67108864;
constexpr size_t O_D2 = O_RY + (size_t)T * 1536 * 2;
constexpr size_t O_QM = O_D2 + (size_t)67108864;
constexpr size_t O_KN = O_QM + (size_t)T * 768 * 2;
constexpr size_t O_KRR = O_KN + (size_t)T * 512 * 2;
constexpr size_t O_VMT = O_KRR + (size_t)T * 32 * 2;
constexpr size_t O_END = O_VMT + (size_t)T * 512 * 2;
constexpr size_t O_BAR = (O_END + 255) & ~(size_t)255;
constexpr size_t O_WSEND = O_BAR + 3456 * 4;
constexpr size_t O_M = O_RQ;
constexpr size_t O_HH = O_RQ;

struct Params {
  const float *x, *c, *ctx, *c_ctx, *ln_in_g, *ln_in_b, *w_mod, *b_mod, *w_in, *gq, *gkv, *w_uq, *w_qr, *w_uk,
      *w_uv, *rpb, *w_branch, *w_out, *ln1_g, *ln1_b, *ln2_g, *ln2_b, *w_gate, *w_up, *w_down;
  float* out;
  unsigned char* ws;
};

__device__ __forceinline__ u16 f2bf(float f) {
  uint32_t u = __float_as_uint(f);
  u += 0x7fffu + ((u >> 16) & 1u);
  return (u16)(u >> 16);
}
typedef __attribute__((ext_vector_type(2))) __bf16 bf16v2;
typedef __attribute__((ext_vector_type(2))) float f32v2;
__device__ __forceinline__ uint32_t pack2(float a, float b) {
  const f32v2 v = {a, b};
  return __builtin_bit_cast(uint32_t, __builtin_convertvector(v, bf16v2));
}
__device__ __forceinline__ float bf2f(u16 v) { return __uint_as_float(((uint32_t)v) << 16); }
__device__ __forceinline__ float wsum(float v) {
#pragma unroll
  for (int o = 32; o > 0; o >>= 1) v += __shfl_xor(v, o);
  return v;
}
__device__ __forceinline__ float fsigmoid(float v) { return 1.f / (1.f + __expf(-v)); }

__device__ __forceinline__ int ltid() {
  int t = threadIdx.x;
  asm volatile("" : "+v"(t));
  return t;
}

template <typename Tp>
__device__ __forceinline__ Tp* wsp(const Params& p, size_t off) { return (Tp*)(p.ws + off); }

__device__ __forceinline__ float* xrow(const Params& p, int row) {
  int b = row / KPB, kk = row - b * KPB;
  if (kk < CTXL) return wsp<float>(p, O_XCTX) + (size_t)(b * CTXL + kk) * D;
  return p.out + (size_t)(b * SEQ + kk - CTXL) * D;
}

constexpr int LSTR = 72;
constexpr int SM_A = 128 * LSTR;

template <bool DEEP = true>
__device__ __forceinline__ void gemm_core(f32x16 (&acc)[2][2], const u16* __restrict__ A, size_t lda,
                                          const u16* __restrict__ B, size_t ldb, int K, u16* smem) {
  const int tid = ltid(), lane = tid & 63, wave = tid >> 6;
  const int wm = wave >> 1, wn = wave & 1, r = lane & 31, hh = lane >> 5;
  u16* sA = smem;
  u16* sB = smem + 2 * SM_A;
  const int lrow = tid >> 3, lkc = (tid & 7) * 8;
  const u16* ga = A + (size_t)lrow * lda + lkc;
  const u16* gb = B + (size_t)lrow * ldb + lkc;
  u16* wa = sA + lrow * LSTR + lkc;
  u16* wb = sB + lrow * LSTR + lkc;
  const u16* pa = sA + (wm * 64 + r) * LSTR + hh * 8;
  const u16* pb = sB + (wn * 64 + r) * LSTR + hh * 8;
  u32x4 a0r[4], b0r[4], a1r[4], b1r[4];
#define G_LOAD(ar, br, ko)                                               \
  _Pragma("unroll") for (int i = 0; i < 4; i++) {                        \
    ar[i] = *(const u32x4*)(ga + (size_t)(32 * i) * lda + (ko));         \
    br[i] = *(const u32x4*)(gb + (size_t)(32 * i) * ldb + (ko));         \
  }
#define G_STORE(ar, br, buf)                                             \
  _Pragma("unroll") for (int i = 0; i < 4; i++) {                        \
    *(u32x4*)(wa + (buf)*SM_A + 32 * i * LSTR) = ar[i];                  \
    *(u32x4*)(wb + (buf)*SM_A + 32 * i * LSTR) = br[i];                  \
  }
#define G_COMPUTE(buf)                                                                   \
  _Pragma("unroll") for (int ks = 0; ks < 4; ks++) {                                     \
    const bf16x8 fa0 = *(const bf16x8*)(pa + (buf)*SM_A + ks * 16);                      \
    const bf16x8 fa1 = *(const bf16x8*)(pa + (buf)*SM_A + 32 * LSTR + ks * 16);          \
    const bf16x8 fb0 = *(const bf16x8*)(pb + (buf)*SM_A + ks * 16);                      \
    const bf16x8 fb1 = *(const bf16x8*)(pb + (buf)*SM_A + 32 * LSTR + ks * 16);          \
    acc[0][0] = __builtin_amdgcn_mfma_f32_32x32x16_bf16(fa0, fb0, acc[0][0], 0, 0, 0);   \
    acc[0][1] = __builtin_amdgcn_mfma_f32_32x32x16_bf16(fa0, fb1, acc[0][1], 0, 0, 0);   \
    acc[1][0] = __builtin_amdgcn_mfma_f32_32x32x16_bf16(fa1, fb0, acc[1][0], 0, 0, 0);   \
    acc[1][1] = __builtin_amdgcn_mfma_f32_32x32x16_bf16(fa1, fb1, acc[1][1], 0, 0, 0);   \
  }
  const int nk = K >> 6;
  if (DEEP) {
    G_LOAD(a0r, b0r, 0)
    G_LOAD(a1r, b1r, 64)
    G_STORE(a0r, b0r, 0)
    __syncthreads();
    const int klast = (nk - 1) * 64;
    G_LOAD(a0r, b0r, min(128, klast))
    for (int kt = 0; kt < nk; kt += 2) {
      G_COMPUTE(0)
      G_STORE(a1r, b1r, 1)
      __syncthreads();
      G_LOAD(a1r, b1r, min((kt + 3) * 64, klast))
      __builtin_amdgcn_sched_barrier(0);
      G_COMPUTE(1)
      G_STORE(a0r, b0r, 0)
      __syncthreads();
      G_LOAD(a0r, b0r, min((kt + 4) * 64, klast))
      __builtin_amdgcn_sched_barrier(0);
    }
  } else {
    G_LOAD(a0r, b0r, 0)
    G_STORE(a0r, b0r, 0)
    __syncthreads();
    for (int kt = 0; kt < nk; kt += 2) {
      G_LOAD(a0r, b0r, (kt + 1) * 64)
      G_COMPUTE(0)
      G_STORE(a0r, b0r, 1)
      __syncthreads();
      if (kt + 2 < nk) G_LOAD(a0r, b0r, (kt + 2) * 64)
      G_COMPUTE(1)
      if (kt + 2 < nk) G_STORE(a0r, b0r, 0)
      __syncthreads();
    }
  }
#undef G_LOAD
#undef G_STORE
#undef G_COMPUTE
}

__device__ __forceinline__ void zero_acc(f32x16 (&acc)[2][2]) {
#pragma unroll
  for (int i = 0; i < 2; i++)
#pragma unroll
    for (int j = 0; j < 2; j++)
#pragma unroll
      for (int e = 0; e < 16; e++) acc[i][j][e] = 0.f;
}

#define EPI_DECL                                                     \
  const int lane_ = ltid() & 63, wave_ = ltid() >> 6;      \
  const int wm_ = wave_ >> 1, wn_ = wave_ & 1, r_ = lane_ & 31, hh_ = lane_ >> 5; \
  (void)wm_; (void)wn_; (void)r_; (void)hh_;

__device__ __forceinline__ const float* src_col(const Params& p, int l, int kind, int n, int& ld) {
  switch (kind) {
    case 0:
      ld = IN_DIM;
      return n < 1952 ? p.w_in + (size_t)l * D * IN_DIM + 512 + n : nullptr;
    case 1:
      ld = IN_DIM;
      return p.w_in + (size_t)l * D * IN_DIM + 2464 + n;
    case 2:
      if (n < 512) {
        ld = 512;
        return p.w_uq + (size_t)l * 256 * 512 + n;
      } else {
        int m = n - 512, wt = m >> 6, jb = (m >> 5) & 1, idx = wt * 32 + (m & 31);
        int h = idx >> 4, e = idx & 15;
        ld = 256;
        return p.w_qr + (size_t)l * 256 * 256 + h * 32 + jb * 16 + e;
      }
    case 3:
      ld = 512;
      return n < 512 ? p.w_uk + (size_t)l * 128 * 512 + n : p.w_uv + (size_t)l * 128 * 512 + (n - 512);
    case 4: {
      int g = n >> 10, nn = n & 1023;
      ld = 1024;
      return p.w_branch + ((size_t)(l * 3 + g) * 512) * 1024 + nn;
    }
    case 5:
      ld = 1024;
      return p.w_out + (size_t)l * D * D + n;
    case 6: {
      int jb = (n >> 5) & 1, q = (n >> 6) * 32 + (n & 31);
      ld = FH;
      return (jb ? p.w_up : p.w_gate) + (size_t)l * D * FH + q;
    }
    default:
      ld = 1024;
      return p.w_down + (size_t)l * FH * D + n;
  }
}

__device__ __forceinline__ int job_nd(int k) {
  switch (k) { case 0: return 2048; case 1: return 3072; case 2: return 768; case 3: return 1024; case 4: return 3072;
    case 5: return 1024; case 6: return 5632; default: return 1024; }
}
__device__ __forceinline__ int job_kd(int k) {
  switch (k) { case 0: return 1024; case 1: return 1024; case 2: return 256; case 3: return 128; case 4: return 512;
    case 5: return 1024; case 6: return 1024; default: return 2816; }
}
__device__ __forceinline__ size_t job_od(int k) {
  switch (k) { case 0: return O_WP; case 1: return O_WG; case 2: return O_WUQ; case 3: return O_WUKV; case 4: return O_WB;
    case 5: return O_WO; case 6: return O_WGU; default: return O_WD; }
}
__device__ void prep_weights(const Params& p, int l, int bid, int nb, u16* smem) {
  float* tile = (float*)smem;
  const int tid = ltid();
  int start = 0;
#pragma unroll 1
  for (int kind = 0; kind < 8; kind++) {
    const int Kk = job_kd(kind);
    const int nkt = Kk >> 6, ntile = (job_nd(kind) >> 6) * nkt;
    u16* dst = wsp<u16>(p, job_od(kind));
    const float* ksc = kind == 2 ? p.gq + l * 256 : (kind == 3 ? p.gkv + l * 128 : nullptr);
    for (int t = (bid + nb - (start % nb)) % nb; t < ntile; t += nb) {
      const int nt = t / nkt, kt = t - nt * nkt;
      const int n0 = nt * 64, k0 = kt * 64;
      {
        const int kq = tid >> 4, nn4 = (tid & 15) * 4;
        int ld;
        const float* sp = src_col(p, l, kind, n0 + nn4, ld);
#pragma unroll
        for (int i = 0; i < 4; i++) {
          const int kk = i * 16 + kq;
          float4 v = make_float4(0.f, 0.f, 0.f, 0.f);
          if (sp) v = *(const float4*)(sp + (size_t)(k0 + kk) * ld);
          if (ksc) {
            const float sc = ksc[k0 + kk];
            v.x *= sc; v.y *= sc; v.z *= sc; v.w *= sc;
          }
          float* tp = tile + kk * 65 + nn4;
          tp[0] = v.x; tp[1] = v.y; tp[2] = v.z; tp[3] = v.w;
        }
      }
      __syncthreads();
#pragma unroll
      for (int i = 0; i < 2; i++) {
        const int c = tid + 256 * i;
        const int nn = c >> 3, kc = (c & 7) * 8;
        const float* tp = tile + kc * 65 + nn;
        uint4 o;
        o.x = pack2(tp[0], tp[65]);
        o.y = pack2(tp[2 * 65], tp[3 * 65]);
        o.z = pack2(tp[4 * 65], tp[5 * 65]);
        o.w = pack2(tp[6 * 65], tp[7 * 65]);
        *(uint4*)(dst + (size_t)(n0 + nn) * Kk + k0 + kc) = o;
      }
      __syncthreads();
    }
    start += ntile;
  }
  {
    float* ctab = (float*)smem;
    __syncthreads();
    if (tid < 128) ctab[tid] = cospif((float)tid * (1.f / 64.f));
    __syncthreads();
    u16* dst = wsp<u16>(p, O_WF);
    for (int it = bid; it < 512; it += nb) {
      const int o = it * 256 + tid;
      const int np = o & 1023, k8 = (o >> 10) * 8;
      const int reim = np >> 9, g = (np >> 7) & 3, m = np & 127;
      const float* w = p.w_in + (size_t)l * D * IN_DIM + (size_t)k8 * IN_DIM + g * 128;
      const int sh = reim ? 96 : 0;
      float a8[8];
#pragma unroll
      for (int j = 0; j < 8; j++) a8[j] = 0.f;
#pragma unroll 4
      for (int c = 0; c < 128; c++) {
        const float tw = ctab[(m * c + sh) & 127];
#pragma unroll
        for (int j = 0; j < 8; j++) a8[j] += w[(size_t)j * IN_DIM + c] * tw;
      }
      uint4 ov;
      ov.x = pack2(a8[0] * RS128, a8[1] * RS128);
      ov.y = pack2(a8[2] * RS128, a8[3] * RS128);
      ov.z = pack2(a8[4] * RS128, a8[5] * RS128);
      ov.w = pack2(a8[6] * RS128, a8[7] * RS128);
      *(uint4*)(dst + (size_t)np * 1024 + k8) = ov;
    }
    __syncthreads();
  }
}

__device__ void prep_tables(const Params& p, int bid, int nb) {
  u16* MA = wsp<u16>(p, O_MA);
  u16* MB = wsp<u16>(p, O_MB);
  u16* MC = wsp<u16>(p, O_MC);
  float* TW = wsp<float>(p, O_TW);
  const int total = 65536 + 32768 + 131072 + 16384;
  for (int idx = bid * 256 + ltid(); idx < total; idx += nb * 256) {
    if (idx < 65536) {
      const int n = idx >> 8, k = idx & 255;
      const int nt = n >> 7, wn = (n >> 6) & 1, jb = (n >> 5) & 1, klo = nt * 64 + wn * 32 + (n & 31);
      const int ri = k >> 7, nhi = k & 127;
      const int xx = (klo * nhi) & 127;
      const float c = cospif((float)xx * (1.f / 64.f)), s = sinpif((float)xx * (1.f / 64.f));
      float v = jb == 0 ? (ri == 0 ? c : -s) : (ri == 0 ? -s : -c);
      MA[idx] = f2bf(v * RS128);
    } else if (idx < 65536 + 32768) {
      const int i2 = idx - 65536;
      const int khi = i2 >> 8, k = i2 & 255;
      const int ri = k >> 7, nlo = k & 127;
      const int xx = (khi * nlo) & 127;
      const float c = cospif((float)xx * (1.f / 64.f)), s = sinpif((float)xx * (1.f / 64.f));
      MB[i2] = f2bf((ri == 0 ? c : s) * RS128);
    } else if (idx < 65536 + 32768 + 131072) {
      const int i2 = idx - 65536 - 32768;
      const int kk = i2 >> 9, k = i2 & 511;
      const int ri = k >> 8, nn = k & 255;
      const int xx = (kk * nn) & 255;
      const float c = cospif((float)xx * (1.f / 128.f)), s = sinpif((float)xx * (1.f / 128.f));
      MC[i2] = f2bf((ri == 0 ? c : -s) * 0.0625f);
    } else {
      const int i2 = idx - 65536 - 32768 - 131072;
      const int klo = i2 >> 7, nlo = i2 & 127;
      const int xx = klo * nlo;
      TW[i2 * 2] = cospif((float)xx * (1.f / 8192.f));
      TW[i2 * 2 + 1] = sinpif((float)xx * (1.f / 8192.f));
    }
  }
}

__device__ void prep_modp(const Params& p, int bid, int nb) {
  float* modp = wsp<float>(p, O_MODP);
  for (int it = bid; it < 2 * 16 * 24; it += nb) {
    const int l = it / (16 * 24), rem = it - l * 16 * 24, kc = rem / 24, nblk = rem - kc * 24;
    const int n = nblk * 256 + ltid();
    const float* w = p.w_mod + (size_t)l * D * 6144 + n;
    float a0 = 0.f, a1 = 0.f, a2 = 0.f;
#pragma unroll 8
    for (int kk = 0; kk < 64; kk++) {
      const int k = kc * 64 + kk;
      const float wv = w[(size_t)k * 6144];
      float c0 = p.c[k], c1 = p.c[1024 + k], c2 = p.c_ctx[k];
      c0 = c0 / (1.f + __expf(-c0));
      c1 = c1 / (1.f + __expf(-c1));
      c2 = c2 / (1.f + __expf(-c2));
      a0 += c0 * wv;
      a1 += c1 * wv;
      a2 += c2 * wv;
    }
    float* o = modp + ((size_t)(kc * 2 + l) * 3) * 6144 + n;
    o[0] = a0;
    o[6144] = a1;
    o[2 * 6144] = a2;
  }
}
__device__ void prep_modr(const Params& p, int bid, int nb) {
  const float* modp = wsp<float>(p, O_MODP);
  float* mod = wsp<float>(p, O_MOD);
  for (int idx = bid * 256 + ltid(); idx < 2 * 3 * 6144; idx += nb * 256) {
    const int l = idx / (3 * 6144), n = idx % 6144;
    float v = p.b_mod[l * 6144 + n];
    for (int kc = 0; kc < 16; kc++) v += modp[(size_t)kc * 2 * 3 * 6144 + idx];
    mod[idx] = v;
  }
}

__device__ void ln_phase(const Params& p, int mode, const float* g, const float* bta, int lmod, int shoff, int scoff,
                         bool skip_ctx, int bid, int nb) {
  const int lane = ltid() & 63, wave = ltid() >> 6;
  u16* A = wsp<u16>(p, O_A);
  const float* mod = wsp<float>(p, O_MOD);
  for (int row = bid * 4 + wave; row < T; row += nb * 4) {
    const int b = row / KPB, kk = row - b * KPB;
    if (skip_ctx && kk < CTXL) continue;
    float* xr = xrow(p, row);
    const float* src;
    if (mode == 0)
      src = kk < CTXL ? p.ctx + (size_t)(b * CTXL + kk) * D : p.x + (size_t)(b * SEQ + kk - CTXL) * D;
    else
      src = xr;
    float4 v[4];
    float s = 0.f;
#pragma unroll
    for (int i = 0; i < 4; i++) {
      v[i] = *(const float4*)(src + i * 256 + lane * 4);
      s += v[i].x + v[i].y + v[i].z + v[i].w;
    }
    const float mu = wsum(s) * (1.f / 1024.f);
    float q = 0.f;
#pragma unroll
    for (int i = 0; i < 4; i++) {
      v[i].x -= mu; v[i].y -= mu; v[i].z -= mu; v[i].w -= mu;
      q += v[i].x * v[i].x + v[i].y * v[i].y + v[i].z * v[i].z + v[i].w * v[i].w;
    }
    const float rstd = rsqrtf(wsum(q) * (1.f / 1024.f) + EPS);
    const int m = kk < CTXL ? 2 : b;
    const float* md = mod + ((size_t)(lmod < 0 ? 0 : lmod) * 3 + m) * 6144;
#pragma unroll
    for (int i = 0; i < 4; i++) {
      const int c0 = i * 256 + lane * 4;
      const float4 gg = *(const float4*)(g + c0), bb = *(const float4*)(bta + c0);
      float4 y;
      y.x = v[i].x * rstd * gg.x + bb.x;
      y.y = v[i].y * rstd * gg.y + bb.y;
      y.z = v[i].z * rstd * gg.z + bb.z;
      y.w = v[i].w * rstd * gg.w + bb.w;
      *(float4*)(xr + c0) = y;
      if (lmod >= 0) {
        const float4 sh = *(const float4*)(md + shoff + c0), sc = *(const float4*)(md + scoff + c0);
        uint2 o;
        o.x = pack2(y.x * (1.f + sc.x) + sh.x, y.y * (1.f + sc.y) + sh.y);
        o.y = pack2(y.z * (1.f + sc.z) + sh.z, y.w * (1.f + sc.w) + sh.w);
        *(uint2*)(A + (size_t)row * D + c0) = o;
      }
    }
  }
}

#define PATCH_LOOP_BEGIN(NR_, NC_, PR_, PC_)                                   \
  {                                                                            \
    const int x_ = bid & 7, w_ = bid >> 3, nbx_ = nb >> 3;                     \
    const int CG_ = ((NC_) + (PC_)-1) / (PC_);                                 \
    const int npatch_ = (((NR_) + (PR_)-1) / (PR_)) * CG_;                     \
    for (int u_ = w_;; u_ += nbx_) {                                           \
      const int g_ = (u_ >> 6) * 8 + x_;                                       \
      if (g_ >= npatch_) break;                                                \
      const int s_ = u_ & 63;                                                  \
      const int rg_ = g_ / CG_;                                                \
      const int prt = rg_ * (PR_) + s_ / (PC_);                                \
      const int pct = (g_ - rg_ * CG_) * (PC_) + s_ % (PC_);                   \
      if (prt >= (NR_) || pct >= (NC_)) continue;
#define PATCH_LOOP_END \
    }                  \
  }

__device__ void phase_p1(const Params& p, int l, bool last, int bid, int nb, u16* smem) {
  EPI_DECL
  const u16* A = wsp<u16>(p, O_A);
  PATCH_LOOP_BEGIN(NRT, 16, 8, 8)
    f32x16 acc[2][2];
    zero_acc(acc);
    {
      const int rt = prt, ct = pct;
      const int row0 = rt * 128, b = row0 / KPB, kk0 = row0 - b * KPB;
      if (ct < 8 || ct >= 12) {
        gemm_core(acc, wsp<u16>(p, O_WP) + (size_t)ct * 128 * D, D, A + (size_t)rt * 128 * D, D, D, smem);
        u16* dst;
        float sc = 1.f;
        int cb;
        if (ct < 4) { dst = wsp<u16>(p, O_QNA); sc = NA_SCALE_L2; cb = ct * 128; }
        else if (ct < 8) { dst = wsp<u16>(p, O_KNA); cb = (ct - 4) * 128; }
        else { dst = wsp<u16>(p, O_LAT); cb = (ct - 12) * 128; }
#pragma unroll
        for (int i = 0; i < 2; i++)
#pragma unroll
          for (int j = 0; j < 2; j++)
#pragma unroll
            for (int g = 0; g < 4; g++) {
              const int row = row0 + wn_ * 64 + j * 32 + r_;
              const int col = cb + wm_ * 64 + i * 32 + 8 * g + 4 * hh_;
              uint2 o;
              o.x = pack2(acc[i][j][4 * g] * sc, acc[i][j][4 * g + 1] * sc);
              o.y = pack2(acc[i][j][4 * g + 2] * sc, acc[i][j][4 * g + 3] * sc);
              *(uint2*)(dst + (size_t)row * 512 + col) = o;
            }
      } else {
        gemm_core(acc, A + (size_t)rt * 128 * D, D, wsp<u16>(p, O_WP) + (size_t)ct * 128 * D, D, D, smem);
        u16* dst = wsp<u16>(p, O_VNAT);
        const int cb = (ct - 8) * 128;
#pragma unroll
        for (int i = 0; i < 2; i++)
#pragma unroll
          for (int j = 0; j < 2; j++)
#pragma unroll
            for (int g = 0; g < 4; g++) {
              const int kk = kk0 + wm_ * 64 + i * 32 + 8 * g + 4 * hh_;
              const int col = cb + wn_ * 64 + j * 32 + r_;
              uint2 o;
              o.x = pack2(acc[i][j][4 * g], acc[i][j][4 * g + 1]);
              o.y = pack2(acc[i][j][4 * g + 2], acc[i][j][4 * g + 3]);
              *(uint2*)(dst + ((size_t)(b * 512 + col)) * KPB + kk) = o;
            }
      }
    }
  PATCH_LOOP_END
  PATCH_LOOP_BEGIN(256, 8, 8, 8)
    f32x16 acc[2][2];
    zero_acc(acc);
    {
      const int rt = prt, ct = pct;
      const int b = rt >> 7, nlo = rt & 127;
      gemm_core(acc, A + (size_t)(b * KPB + CTXL + nlo) * D, (size_t)128 * D,
                wsp<u16>(p, O_WF) + (size_t)ct * 128 * D, D, D, smem);
      u16* dst = wsp<u16>(p, O_D1);
#pragma unroll
      for (int i = 0; i < 2; i++)
#pragma unroll
        for (int j = 0; j < 2; j++)
#pragma unroll
          for (int g = 0; g < 4; g++) {
            const int nhi = wm_ * 64 + i * 32 + 8 * g + 4 * hh_;
            const int n = ct * 128 + wn_ * 64 + j * 32 + r_;
            const int reim = n >> 9, jj = n & 511;
            uint2 o;
            o.x = pack2(acc[i][j][4 * g], acc[i][j][4 * g + 1]);
            o.y = pack2(acc[i][j][4 * g + 2], acc[i][j][4 * g + 3]);
            *(uint2*)(dst + ((((size_t)(b * 512 + jj)) * 128 + nlo) * 2 + reim) * 128 + nhi) = o;
          }
    }
  PATCH_LOOP_END
  if (!last) {
    for (int t2 = bid; t2 < 32; t2 += nb) {
      f32x16 acc[2][2];
      zero_acc(acc);
      const int rt = t2 >> 3, ct = t2 & 7;
      const int b = rt >> 1, rb = rt & 1;
      gemm_core(acc, A + (size_t)(b * KPB + rb * 128) * D, D, wsp<u16>(p, O_WF) + (size_t)ct * 128 * D, D, D, smem);
      u16* dst = wsp<u16>(p, O_D1C);
#pragma unroll
      for (int i = 0; i < 2; i++)
#pragma unroll
        for (int j = 0; j < 2; j++)
#pragma unroll
          for (int g = 0; g < 4; g++) {
            const int nc = rb * 128 + wm_ * 64 + i * 32 + 8 * g + 4 * hh_;
            const int n = ct * 128 + wn_ * 64 + j * 32 + r_;
            const int reim = n >> 9, jj = n & 511;
            uint2 o;
            o.x = pack2(acc[i][j][4 * g], acc[i][j][4 * g + 1]);
            o.y = pack2(acc[i][j][4 * g + 2], acc[i][j][4 * g + 3]);
            *(uint2*)(dst + (((size_t)(b * 512 + jj)) * 2 + reim) * 256 + nc) = o;
          }
    }
  }
}

__device__ __forceinline__ float inv_freq(int i) {
  switch (i) {
    case 0: return 1.0f;
    case 1: return 0.31622776601683794f;
    case 2: return 0.1f;
    case 3: return 0.03162277660168379f;
    case 4: return 0.01f;
    case 5: return 0.0031622776601683794f;
    case 6: return 0.001f;
    default: return 0.00031622776601683794f;
  }
}
__device__ __forceinline__ void rope_cs(int kk, int e, float& cs, float& sn) {
  if (kk < CTXL) { cs = 1.f; sn = 0.f; return; }
  const int tkn = kk - CTXL;
  const float pos = (e < 8) ? (float)(tkn >> 6) : (float)(tkn & 63);
  const float ang = pos * inv_freq(e & 7);
  double xr = (double)ang * 0.31830988618379067;
  xr -= 2.0 * floor(xr * 0.5);
  const float yr = (float)xr;
  cs = cospif(yr);
  sn = sinpif(yr);
}

__device__ __forceinline__ void row_rms(const u16* A, size_t lda, int K, float* rs) {
  const int tid = ltid();
  const int row = tid >> 1, half = tid & 1;
  const u16* pr = A + (size_t)row * lda + half * (K >> 1);
  float s = 0.f;
  for (int c = 0; c < (K >> 1); c += 8) {
    uint4 v = *(const uint4*)(pr + c);
    const uint32_t w[4] = {v.x, v.y, v.z, v.w};
#pragma unroll
    for (int q = 0; q < 4; q++) {
      const float a = __uint_as_float(w[q] << 16), bq = __uint_as_float(w[q] & 0xffff0000u);
      s += a * a + bq * bq;
    }
  }
  s += __shfl_xor(s, 1);
  if (half == 0) rs[row] = rsqrtf(s / (float)K + EPS);
  __syncthreads();
}

__device__ void phase_p2(const Params& p, int l, int bid, int nb, u16* smem) {
  EPI_DECL
  const u16* LAT = wsp<u16>(p, O_LAT);
  float* rs = (float*)(smem + 4 * SM_A);
  const int nQ = NRT * 6, nKV = NRT * 8, nFA = 1024 * 2, nKR = NRT;
  const int total = nQ + nKV + nFA + nKR;
  for (int t = bid; t < total; t += nb) {
    if (t < nQ) {
      const int rt = t / 6, ct = t - rt * 6;
      const int row0 = rt * 128, b = row0 / KPB, kk0 = row0 - b * KPB;
      row_rms(LAT + (size_t)row0 * 512, 512, 256, rs);
      f32x16 acc[2][2];
      zero_acc(acc);
      gemm_core(acc, wsp<u16>(p, O_WUQ) + (size_t)ct * 128 * 256, 256, LAT + (size_t)row0 * 512, 512, 256, smem);
      u16* QM = wsp<u16>(p, O_QM);
      if (ct < 4) {
#pragma unroll
        for (int i = 0; i < 2; i++)
#pragma unroll
          for (int j = 0; j < 2; j++)
#pragma unroll
            for (int g = 0; g < 4; g++) {
              const int rl = wn_ * 64 + j * 32 + r_;
              const int col = ct * 128 + wm_ * 64 + i * 32 + 8 * g + 4 * hh_;
              const int h = col >> 6, d = col & 63;
              const float sc = rs[rl] * MLA_SCALE_L2;
              uint2 o;
              o.x = pack2(acc[i][j][4 * g] * sc, acc[i][j][4 * g + 1] * sc);
              o.y = pack2(acc[i][j][4 * g + 2] * sc, acc[i][j][4 * g + 3] * sc);
              *(uint2*)(QM + (size_t)(row0 + rl) * 768 + h * 96 + d) = o;
            }
      } else {
        const int wt = (ct - 4) * 2 + wm_;
#pragma unroll
        for (int j = 0; j < 2; j++) {
          const int rl = wn_ * 64 + j * 32 + r_;
          const float sc = rs[rl] * MLA_SCALE_L2;
#pragma unroll
          for (int g = 0; g < 4; g++) {
            const int idx = wt * 32 + 8 * g + 4 * hh_;
            const int h = idx >> 4, e16 = idx & 15;
            float o1[4], o2[4];
#pragma unroll
            for (int q = 0; q < 4; q++) {
              float cs, sn;
              rope_cs(kk0 + rl, e16 + q, cs, sn);
              const float x1 = acc[0][j][4 * g + q] * sc, x2 = acc[1][j][4 * g + q] * sc;
              o1[q] = x1 * cs - x2 * sn;
              o2[q] = x2 * cs + x1 * sn;
            }
            u16* qd = QM + (size_t)(row0 + rl) * 768 + h * 96 + 64 + e16;
            uint2 o;
            o.x = pack2(o1[0], o1[1]);
            o.y = pack2(o1[2], o1[3]);
            *(uint2*)qd = o;
            o.x = pack2(o2[0], o2[1]);
            o.y = pack2(o2[2], o2[3]);
            *(uint2*)(qd + 16) = o;
          }
        }
      }
      __syncthreads();
    } else if (t < nQ + nKV) {
      const int t2 = t - nQ;
      const int rt = t2 >> 3, ct = t2 & 7;
      const int row0 = rt * 128, b = row0 / KPB, kk0 = row0 - b * KPB;
      row_rms(LAT + (size_t)row0 * 512 + 256, 512, 128, rs);
      f32x16 acc[2][2];
      zero_acc(acc);
      if (ct < 4) {
        gemm_core(acc, wsp<u16>(p, O_WUKV) + (size_t)ct * 128 * 128, 128, LAT + (size_t)row0 * 512 + 256, 512, 128,
                  smem);
        u16* KN = wsp<u16>(p, O_KN);
#pragma unroll
        for (int i = 0; i < 2; i++)
#pragma unroll
          for (int j = 0; j < 2; j++)
#pragma unroll
            for (int g = 0; g < 4; g++) {
              const int rl = wn_ * 64 + j * 32 + r_;
              const int col = ct * 128 + wm_ * 64 + i * 32 + 8 * g + 4 * hh_;
              const float sc = rs[rl];
              uint2 o;
              o.x = pack2(acc[i][j][4 * g] * sc, acc[i][j][4 * g + 1] * sc);
              o.y = pack2(acc[i][j][4 * g + 2] * sc, acc[i][j][4 * g + 3] * sc);
              *(uint2*)(KN + (size_t)(row0 + rl) * 512 + col) = o;
            }
      } else {
        gemm_core(acc, LAT + (size_t)row0 * 512 + 256, 512, wsp<u16>(p, O_WUKV) + (size_t)ct * 128 * 128, 128, 128,
                  smem);
        u16* VMT = wsp<u16>(p, O_VMT);
#pragma unroll
        for (int i = 0; i < 2; i++)
#pragma unroll
          for (int j = 0; j < 2; j++)
#pragma unroll
            for (int g = 0; g < 4; g++) {
              const int rl = wm_ * 64 + i * 32 + 8 * g + 4 * hh_;
              const int col = (ct - 4) * 128 + wn_ * 64 + j * 32 + r_;
              uint2 o;
              o.x = pack2(acc[i][j][4 * g] * rs[rl], acc[i][j][4 * g + 1] * rs[rl + 1]);
              o.y = pack2(acc[i][j][4 * g + 2] * rs[rl + 2], acc[i][j][4 * g + 3] * rs[rl + 3]);
              *(uint2*)(VMT + ((size_t)(b * 512 + col)) * KPB + kk0 + rl) = o;
            }
      }
      __syncthreads();
    } else if (t < nQ + nKV + nFA) {
      const int t2 = t - nQ - nKV;
      const int rt = t2 >> 1, ct = t2 & 1;
      const int b = rt >> 9, jj = rt & 511;
      f32x16 acc[2][2];
      zero_acc(acc);
      gemm_core(acc, wsp<u16>(p, O_D1) + (size_t)rt * 128 * 256, 256, wsp<u16>(p, O_MA) + (size_t)ct * 128 * 256, 256,
                256, smem);
      const float* TW = wsp<float>(p, O_TW);
      u16* D2 = wsp<u16>(p, O_D2);
      const int klo = ct * 64 + wn_ * 32 + r_;
#pragma unroll
      for (int i = 0; i < 2; i++)
#pragma unroll
        for (int g = 0; g < 4; g++) {
          const int nlo = wm_ * 64 + i * 32 + 8 * g + 4 * hh_;
          float re[4], im[4];
#pragma unroll
          for (int q = 0; q < 4; q++) {
            const float2 tw = *(const float2*)(TW + ((size_t)klo * 128 + nlo + q) * 2);
            const float ar = acc[i][0][4 * g + q], ai = acc[i][1][4 * g + q];
            re[q] = ar * tw.x + ai * tw.y;
            im[q] = ai * tw.x - ar * tw.y;
          }
          u16* d = D2 + ((((size_t)(b * 128 + klo)) * 512 + jj) * 2) * 128 + nlo;
          uint2 o;
          o.x = pack2(re[0], re[1]);
          o.y = pack2(re[2], re[3]);
          *(uint2*)d = o;
          o.x = pack2(im[0], im[1]);
          o.y = pack2(im[2], im[3]);
          *(uint2*)(d + 128) = o;
        }
    } else {
      const int rt = t - nQ - nKV - nFA;
      u16* KRR = wsp<u16>(p, O_KRR);
      for (int idx = ltid(); idx < 128 * 16; idx += 256) {
        const int rl = idx >> 4, e16 = idx & 15;
        const int row = rt * 128 + rl, b = row / KPB, kk = row - b * KPB;
        const float x1 = bf2f(LAT[(size_t)row * 512 + 384 + e16]), x2 = bf2f(LAT[(size_t)row * 512 + 400 + e16]);
        float cs, sn;
        rope_cs(kk, e16, cs, sn);
        KRR[(size_t)row * 32 + e16] = f2bf(x1 * cs - x2 * sn);
        KRR[(size_t)row * 32 + 16 + e16] = f2bf(x2 * cs + x1 * sn);
      }
    }
  }
}

template <int MODE>
__device__ void attn_item(const Params& p, int l, int b, int h, int q0  ,
                          int ntiles  , int rs0, int ycol, u16* smem) {
  constexpr int DQK = MODE == 0 ? 96 : 64;
  constexpr int KSTR = DQK + 8;
  constexpr int NKS = DQK / 16;
  constexpr int CPR = DQK / 8;
  constexpr int NKC = 64 * CPR / 256;
  const int tid = ltid(), lane = tid & 63, wave = tid >> 6, r = lane & 31, hh = lane >> 5;
  u16* Ks = smem;
  u16* Vs = smem + 2 * 64 * KSTR;
  const unsigned char* wsb = p.ws;
  const int qk = q0 + wave * 32 + r;
  const size_t qrow = (size_t)b * KPB + qk;
  bf16x8 qf[NKS];
  {
    const u16* qp = MODE == 0 ? wsp<u16>(p, O_QM) + qrow * 768 + h * 96 : wsp<u16>(p, O_QNA) + qrow * 512 + h * 64;
#pragma unroll
    for (int ks = 0; ks < NKS; ks++) qf[ks] = *(const bf16x8*)(qp + ks * 16 + hh * 8);
  }
  const short one_or_zero = hh == 0 ? (short)0x3F80 : (short)0;
  const bf16x8 kone = {one_or_zero, 0, 0, 0, 0, 0, 0, 0};
  bf16x8 qm = {0, 0, 0, 0, 0, 0, 0, 0};
  int qr = 0, qc = 0, rsq = 0, cs = 0;
  const float* rpb = nullptr;
  if (MODE == 1 && rs0 >= 0) {
    const int tkn = qk - CTXL;
    qr = tkn >> 6;
    qc = tkn & 63;
    rsq = min(max(qr - 4, 0), 248);
    cs = min(max(qc - 8, 0), 48);
    rpb = p.rpb + ((size_t)(l * 8 + h)) * 15 * 31;
  }
  f32x16 o[2];
#pragma unroll
  for (int e = 0; e < 16; e++) { o[0][e] = 0.f; o[1][e] = 0.f; }
  float lsum = 0.f;
  float m = 0.f;
  const bf16x8 ones = {(short)0x3F80, (short)0x3F80, (short)0x3F80, (short)0x3F80,
                       (short)0x3F80, (short)0x3F80, (short)0x3F80, (short)0x3F80};

#define KGEO(i)                                                                                          \
  uint32_t kof##i, kmu##i;                                                                               \
  int kls##i;                                                                                            \
  {                                                                                                      \
    const int c = tid + 256 * (i);                                                                       \
    const int row = c / CPR, cc = c - row * CPR;                                                         \
    if (MODE == 0 && cc >= 8) {                                                                          \
      kof##i = (uint32_t)(O_KRR + ((size_t)(b * KPB + row) * 32 + (cc - 8) * 8) * 2);                    \
      kmu##i = 64u;                                                                                      \
    } else {                                                                                             \
      kof##i = (uint32_t)((MODE == 0 ? O_KN : O_KNA) + ((size_t)(b * KPB + row) * 512 + h * 64 + cc * 8) * 2); \
      kmu##i = 1024u;                                                                                    \
    }                                                                                                    \
    kls##i = row * KSTR + cc * 8;                                                                        \
  }
#define VGEO(i)                                                                                          \
  uint32_t vof##i;                                                                                       \
  int vls##i;                                                                                            \
  bool vsx##i;                                                                                           \
  {                                                                                                      \
    const int c = tid + 256 * (i);                                                                       \
    const int d = c >> 3, cc = c & 7;                                                                    \
    vof##i = (uint32_t)((MODE == 0 ? O_VMT : O_VNAT) + ((size_t)(b * 512 + h * 64 + d) * KPB + cc * 8) * 2); \
    vls##i = d * 72 + cc * 8;                                                                            \
    vsx##i = (d & 8) != 0;                                                                               \
  }
  KGEO(0) KGEO(1) KGEO(2) VGEO(0) VGEO(1)
  (void)kof2; (void)kmu2; (void)kls2;
  u32x4 kr0A, kr1A, kr2A, vr0A, vr1A, kr0B, kr1B, kr2B, vr0B, vr1B;
  kr2A = kr1A = kr0A = vr0A = vr1A = kr2B = kr1B = kr0B = vr0B = vr1B = (u32x4){0u, 0u, 0u, 0u};
#define TILE_KK0(t) ((MODE == 1 && (t) >= 4) ? (uint32_t)(CTXL + 64 * min(rs0 + (t)-4, 255)) : (uint32_t)(64 * (t)))
#define LOAD_KV(t, S)                                                                   \
  {                                                                                     \
    const uint32_t kk0_ = TILE_KK0(t);                                                  \
    kr0##S = *(const u32x4*)(wsb + (size_t)(kof0 + kk0_ * kmu0));                       \
    kr1##S = *(const u32x4*)(wsb + (size_t)(kof1 + kk0_ * kmu1));                       \
    if (NKC == 3) kr2##S = *(const u32x4*)(wsb + (size_t)(kof2 + kk0_ * kmu2));         \
    vr0##S = *(const u32x4*)(wsb + (size_t)(vof0 + kk0_ * 2u));                         \
    vr1##S = *(const u32x4*)(wsb + (size_t)(vof1 + kk0_ * 2u));                         \
  }
#define STORE_V1(buf, i, srcv)                                                          \
  {                                                                                     \
    u32x4 sv_ = srcv;                                                                   \
    if (vsx##i) sv_ = (u32x4){sv_[2], sv_[3], sv_[0], sv_[1]};                          \
    *(u32x4*)(Vs + (buf)*64 * 72 + vls##i) = sv_;                                       \
  }
#define STORE_KV(buf, S)                                                                \
  {                                                                                     \
    *(u32x4*)(Ks + (buf)*64 * KSTR + kls0) = kr0##S;                                    \
    *(u32x4*)(Ks + (buf)*64 * KSTR + kls1) = kr1##S;                                    \
    if (NKC == 3) *(u32x4*)(Ks + (buf)*64 * KSTR + kls2) = kr2##S;                      \
    STORE_V1(buf, 0, vr0##S) STORE_V1(buf, 1, vr1##S)                                   \
  }
#define QK_TILE(kbuf, t)                                                                           \
  {                                                                                                \
    const u16* kb_ = Ks + (kbuf)*64 * KSTR + r * KSTR + hh * 8;                                    \
    {                                                                                              \
      f32x16 z_;                                                                                   \
      _Pragma("unroll") for (int e = 0; e < 16; e++) z_[e] = 0.f;                                  \
      sc[0] = __builtin_amdgcn_mfma_f32_32x32x16_bf16(kone, qm, z_, 0, 0, 0);                      \
      sc[1] = sc[0];                                                                               \
    }                                                                                              \
    _Pragma("unroll") for (int ks = 0; ks < NKS; ks++) {                                           \
      const bf16x8 kf0 = *(const bf16x8*)(kb_ + ks * 16);                                          \
      const bf16x8 kf1 = *(const bf16x8*)(kb_ + 32 * KSTR + ks * 16);                              \
      sc[0] = __builtin_amdgcn_mfma_f32_32x32x16_bf16(kf0, qf[ks], sc[0], 0, 0, 0);                \
      sc[1] = __builtin_amdgcn_mfma_f32_32x32x16_bf16(kf1, qf[ks], sc[1], 0, 0, 0);                \
    }                                                                                              \
    if (MODE == 1 && (t) >= 4) {                                                                   \
      const int kr_ = rs0 + (t)-4;                                                                 \
      const bool rowok = (kr_ >= rsq) && (kr_ < rsq + 8);                                          \
      const float* rp = rpb + (kr_ - qr + 7) * 31 + (15 - qc);                                     \
      _Pragma("unroll") for (int kb = 0; kb < 2; kb++) _Pragma("unroll") for (int e = 0; e < 16; e++) { \
        const int kc = kb * 32 + (e & 3) + 8 * (e >> 2) + 4 * hh;                                  \
        const bool valid = rowok && (kc >= cs) && (kc < cs + 16);                                  \
        float bias = 0.f;                                                                          \
        if (valid) bias = rp[kc];                                                                  \
        sc[kb][e] = valid ? sc[kb][e] + bias * LOG2E : -1e30f;                                     \
      }                                                                                            \
    }                                                                                              \
  }
#define TILE_MAX(tmax)                                                                             \
  {                                                                                                \
    tmax = sc[0][0];                                                                               \
    _Pragma("unroll") for (int e = 1; e < 16; e++) tmax = fmaxf(tmax, sc[0][e]);                   \
    _Pragma("unroll") for (int e = 0; e < 16; e++) tmax = fmaxf(tmax, sc[1][e]);                   \
    const uint32_t tu = __float_as_uint(tmax);                                                     \
    const auto sw = __builtin_amdgcn_permlane32_swap(tu, tu, false, false);                        \
    tmax = fmaxf(__uint_as_float(sw[0]), __uint_as_float(sw[1]));                                  \
  }
#define MOVE_REF(mnew_)                                                                            \
  {                                                                                                \
    const float mq_ = bf2f(f2bf(mnew_));                                                           \
    const float delta_ = mq_ - m;                                                                  \
    const float alpha = __builtin_amdgcn_exp2f(-delta_);                                           \
    m = mq_;                                                                                       \
    _Pragma("unroll") for (int e = 0; e < 16; e++) {                                               \
      o[0][e] *= alpha; o[1][e] *= alpha;                                                         \
      sc[0][e] -= delta_; sc[1][e] -= delta_;                                                      \
    }                                                                                              \
    lsum *= alpha;                                                                                 \
    qm[0] = (hh == 0) ? (short)f2bf(-m) : (short)0;                                                \
  }
#define SOFTMAX_PV(vbuf)                                                                           \
  {                                                                                                \
    const u16* vb_ = Vs + (vbuf)*64 * 72 + r * 72 + vsw;                                           \
    _Pragma("unroll") for (int kb = 0; kb < 2; kb++) _Pragma("unroll") for (int st = 0; st < 2; st++) { \
      u32x4 pu;                                                                                    \
      _Pragma("unroll") for (int q = 0; q < 4; q++) {                                              \
        const float p0_ = __builtin_amdgcn_exp2f(sc[kb][8 * st + 2 * q]);                          \
        const float p1_ = __builtin_amdgcn_exp2f(sc[kb][8 * st + 2 * q + 1]);                      \
        lsum += p0_ + p1_;                                                                         \
        pu[q] = pack2(p0_, p1_);                                                                   \
      }                                                                                            \
      const bf16x8 pbv = __builtin_bit_cast(bf16x8, pu);                                           \
      _Pragma("unroll") for (int db = 0; db < 2; db++) {                                           \
        const u16* vp = vb_ + db * 32 * 72 + kb * 32 + 16 * st;                                    \
        const bf16x4 vlo = *(const bf16x4*)(vp);                                                   \
        const bf16x4 vhi = *(const bf16x4*)(vp + 8);                                               \
        const bf16x8 vfv = __builtin_shufflevector(vlo, vhi, 0, 1, 2, 3, 4, 5, 6, 7);              \
        o[db] = __builtin_amdgcn_mfma_f32_32x32x16_bf16(vfv, pbv, o[db], 0, 0, 0);                 \
      }                                                                                            \
    }                                                                                              \
  }
#define DEFER_REF(tmax)                                                                            \
  if (__any(tmax > 8.f)) {                                                                         \
    const float mq_ = bf2f(f2bf(m + fmaxf(tmax, 0.f)));                                            \
    const float alpha = __builtin_amdgcn_exp2f(m - mq_);                                           \
    m = mq_;                                                                                       \
    _Pragma("unroll") for (int e = 0; e < 16; e++) { o[0][e] *= alpha; o[1][e] *= alpha; }       \
    lsum *= alpha;                                                                                 \
    qm[0] = (hh == 0) ? (short)f2bf(-m) : (short)0;                                                \
  }
#define ATT_STEP(t, LD, ST)                                        \
  {                                                                \
    const int cur = (t)&1;                                         \
    LOAD_KV(min((t) + 2, tl), LD)                                  \
    __builtin_amdgcn_sched_barrier(0);                             \
    QK_TILE(cur, t)                                                \
    SOFTMAX_PV(cur)                                                \
    float tmax;                                                    \
    TILE_MAX(tmax)                                                 \
    DEFER_REF(tmax)                                                \
    STORE_KV(cur ^ 1, ST)                                          \
    __syncthreads();                                               \
  }

  const int tl = ntiles - 1;
  const int vsw = 4 * (hh ^ ((r >> 3) & 1));
  f32x16 sc[2];
  LOAD_KV(0, A)
  STORE_KV(0, A)
  LOAD_KV(min(1, tl), A)
  __syncthreads();
  {
    LOAD_KV(min(2, tl), B)
    __builtin_amdgcn_sched_barrier(0);
    QK_TILE(0, 0)
    float tmax;
    TILE_MAX(tmax)
    MOVE_REF(tmax)
    SOFTMAX_PV(0)
    STORE_KV(1, A)
    __syncthreads();
  }
  for (int t = 1; t + 1 < ntiles; t += 2) {
    ATT_STEP(t, A, B)
    ATT_STEP(t + 1, B, A)
  }
  ATT_STEP(tl, A, B)
  const float inv = 1.f / (lsum + __shfl_xor(lsum, 32));
  u16* yp = wsp<u16>(p, O_Y) + qrow * 1536 + ycol + h * 64;
#pragma unroll
  for (int db = 0; db < 2; db++)
#pragma unroll
    for (int g = 0; g < 4; g++) {
      uint2 ov;
      ov.x = pack2(o[db][4 * g] * inv, o[db][4 * g + 1] * inv);
      ov.y = pack2(o[db][4 * g + 2] * inv, o[db][4 * g + 3] * inv);
      *(uint2*)(yp + db * 32 + 8 * g + 4 * hh) = ov;
    }
#undef KGEO
#undef VGEO
#undef TILE_KK0
#undef LOAD_KV
#undef STORE_V1
#undef STORE_KV
#undef QK_TILE
#undef TILE_MAX
#undef MOVE_REF
#undef SOFTMAX_PV
#undef ATT_STEP
#undef DEFER_REF
}

__device__ void phase_p3(const Params& p, int l, bool last, int bid, int nb, u16* smem) {
  EPI_DECL
  const int nMLA = 2048, nNA = 2048, nFB = 1024;
  const int nC = last ? 0 : (32 + 32 + 16);
  const int total = nMLA + nNA + nFB + nC;
  for (int t = bid; t < total; t += nb) {
    int kind, b = 0, h = 0, q0 = 0, ntl = 0, rs0 = -1;
    size_t aoff = 0, boff = 0;
    int Kf = 256, j0 = 0, tok0 = 0, tokmul = 1, colbase = 0;
    if (t < nMLA) {
      kind = 0;
      h = t & 7;
      const int rest = t >> 3;
      b = rest >> 7;
      q0 = CTXL + (rest & 127) * 128;
      ntl = 260;
    } else if (t < nMLA + nNA) {
      kind = 1;
      const int t2 = t - nMLA;
      h = t2 & 7;
      const int rest = t2 >> 3, rp = rest & 127;
      b = rest >> 7;
      rs0 = min(max(2 * rp - 4, 0), 248);
      const int rs1 = min(max(2 * rp + 1 - 4, 0), 248);
      q0 = CTXL + rp * 128;
      ntl = (4 + (rs1 + 8 - rs0) + 1) & ~1;
    } else if (t < nMLA + nNA + nFB) {
      kind = 2;
      const int rt = t - nMLA - nNA;
      const int bk = rt >> 2;
      j0 = (rt & 3) * 128;
      b = bk >> 7;
      tok0 = CTXL + (bk & 127);
      tokmul = 128;
      aoff = O_D2 + (size_t)rt * 128 * 256 * 2;
      boff = O_MB;
      Kf = 256;
    } else {
      const int t2 = t - nMLA - nNA - nFB;
      if (t2 < 64) {
        kind = t2 >> 5;
        const int t3 = t2 & 31;
        h = t3 & 7;
        b = (t3 >> 3) & 1;
        q0 = (t3 >> 4) * 128;
        ntl = 4;
      } else {
        kind = 2;
        const int t3 = t2 - 64;
        const int rt = t3 >> 1, ct = t3 & 1;
        b = rt >> 2;
        j0 = (rt & 3) * 128;
        colbase = ct * 128;
        aoff = O_D1C + (size_t)rt * 128 * 512 * 2;
        boff = O_MC + (size_t)ct * 128 * 512 * 2;
        Kf = 512;
      }
    }
    if (kind == 0) {
      attn_item<0>(p, l, b, h, q0, ntl, -1, 1024, smem);
    } else if (kind == 1) {
      attn_item<1>(p, l, b, h, q0, ntl, rs0, 512, smem);
    } else {
      f32x16 acc[2][2];
      zero_acc(acc);
      gemm_core(acc, wsp<u16>(p, aoff), Kf, wsp<u16>(p, boff), Kf, Kf, smem);
      u16* Y = wsp<u16>(p, O_Y);
#pragma unroll
      for (int i = 0; i < 2; i++)
#pragma unroll
        for (int j = 0; j < 2; j++)
#pragma unroll
          for (int g = 0; g < 4; g++) {
            const int jj = j0 + wm_ * 64 + i * 32 + 8 * g + 4 * hh_;
            const int tok = tok0 + (colbase + wn_ * 64 + j * 32 + r_) * tokmul;
            uint2 ov;
            ov.x = pack2(acc[i][j][4 * g], acc[i][j][4 * g + 1]);
            ov.y = pack2(acc[i][j][4 * g + 2], acc[i][j][4 * g + 3]);
            *(uint2*)(Y + ((size_t)b * KPB + tok) * 1536 + jj) = ov;
          }
    }
  }
}

__device__ __forceinline__ int n_row_tiles(bool last) { return last ? NRT - 4 : NRT; }
__device__ __forceinline__ int row_tile(bool last, int i) {
  if (!last) return i;
  return i < 128 ? i + 2 : i + 4;
}

__device__ void phase_p4(const Params& p, int l, bool last, int bid, int nb, u16* smem) {
  EPI_DECL
  const u16* A = wsp<u16>(p, O_A);
  const u16* Y = wsp<u16>(p, O_Y);
  u16* M = wsp<u16>(p, O_M);
  uint4* stash = wsp<uint4>(p, O_QM) + (size_t)bid * 24 * 256 + ltid();
  const int nrt_ = n_row_tiles(last);
  PATCH_LOOP_BEGIN(nrt_, 8, 8, 8)
    const int rt = row_tile(last, prt), ct = pct;
    f32x16 mg[2][2];
    zero_acc(mg);
#pragma unroll 1
    for (int g = 0; g < 3; g++) {
      uint32_t gp[2][2][8];
      {
        f32x16 acc[2][2];
        zero_acc(acc);
        gemm_core<true>(acc, wsp<u16>(p, O_WG) + (size_t)(g * 1024 + ct * 128) * D, D, A + (size_t)rt * 128 * D, D, D,
                        smem);
#pragma unroll
        for (int i = 0; i < 2; i++)
#pragma unroll
          for (int j = 0; j < 2; j++)
#pragma unroll
            for (int e = 0; e < 8; e++)
              gp[i][j][e] = pack2(fsigmoid(acc[i][j][2 * e]), fsigmoid(acc[i][j][2 * e + 1]));
      }
      {
        f32x16 acc[2][2];
        zero_acc(acc);
        gemm_core<false>(acc, wsp<u16>(p, O_WB) + (size_t)(g * 1024 + ct * 128) * 512, 512,
                         Y + (size_t)rt * 128 * 1536 + g * 512, 1536, 512, smem);
#pragma unroll
        for (int i = 0; i < 2; i++)
#pragma unroll
          for (int j = 0; j < 2; j++)
#pragma unroll
            for (int e = 0; e < 8; e++) {
              mg[i][j][2 * e] += __uint_as_float(gp[i][j][e] << 16) * acc[i][j][2 * e];
              mg[i][j][2 * e + 1] += __uint_as_float(gp[i][j][e] & 0xffff0000u) * acc[i][j][2 * e + 1];
            }
      }
    }
#pragma unroll
    for (int i = 0; i < 2; i++)
#pragma unroll
      for (int j = 0; j < 2; j++)
#pragma unroll
        for (int g = 0; g < 4; g++) {
          const int row = rt * 128 + wn_ * 64 + j * 32 + r_;
          const int col = ct * 128 + wm_ * 64 + i * 32 + 8 * g + 4 * hh_;
          uint2 o;
          o.x = pack2(mg[i][j][4 * g], mg[i][j][4 * g + 1]);
          o.y = pack2(mg[i][j][4 * g + 2], mg[i][j][4 * g + 3]);
          *(uint2*)(M + (size_t)row * D + col) = o;
        }
  PATCH_LOOP_END
}

__device__ void phase_resid(const Params& p, int l, bool last, const u16* Ain, size_t lda, const u16* W, int K, int goff,
                            int bid, int nb, u16* smem) {
  EPI_DECL
  const float* mod = wsp<float>(p, O_MOD);
  const int nrt_ = n_row_tiles(last);
  PATCH_LOOP_BEGIN(nrt_, 8, 8, 8)
    const int rt = row_tile(last, prt), ct = pct;
    f32x16 acc[2][2];
    zero_acc(acc);
    gemm_core(acc, W + (size_t)ct * 128 * K, K, Ain + (size_t)rt * 128 * lda, lda, K, smem);
    const int row0 = rt * 128, b = row0 / KPB, kk0 = row0 - b * KPB;
    const int m = kk0 < CTXL ? 2 : b;
    float* xb = xrow(p, row0);
    const float* gv = mod + ((size_t)l * 3 + m) * 6144 + goff;
#pragma unroll
    for (int i = 0; i < 2; i++)
#pragma unroll
      for (int g = 0; g < 4; g++) {
        const int col = ct * 128 + wm_ * 64 + i * 32 + 8 * g + 4 * hh_;
        const float4 g4 = *(const float4*)(gv + col);
#pragma unroll
        for (int j = 0; j < 2; j++) {
          const int rl = wn_ * 64 + j * 32 + r_;
          float4* xp = (float4*)(xb + (size_t)rl * D + col);
          float4 xv = *xp;
          xv.x = ALPHA * xv.x + (1.f + g4.x) * acc[i][j][4 * g];
          xv.y = ALPHA * xv.y + (1.f + g4.y) * acc[i][j][4 * g + 1];
          xv.z = ALPHA * xv.z + (1.f + g4.z) * acc[i][j][4 * g + 2];
          xv.w = ALPHA * xv.w + (1.f + g4.w) * acc[i][j][4 * g + 3];
          *xp = xv;
        }
      }
  PATCH_LOOP_END
}

__device__ void phase_p7(const Params& p, int l, bool last, int bid, int nb, u16* smem) {
  EPI_DECL
  const u16* A = wsp<u16>(p, O_A);
  u16* HH = wsp<u16>(p, O_HH);
  const int nrt_ = n_row_tiles(last);
  PATCH_LOOP_BEGIN(nrt_, 44, 16, 4)
    const int rt = row_tile(last, prt), ct = pct;
    f32x16 acc[2][2];
    zero_acc(acc);
    gemm_core(acc, wsp<u16>(p, O_WGU) + (size_t)ct * 128 * D, D, A + (size_t)rt * 128 * D, D, D, smem);
#pragma unroll
    for (int j = 0; j < 2; j++)
#pragma unroll
      for (int g = 0; g < 4; g++) {
        const int row = rt * 128 + wn_ * 64 + j * 32 + r_;
        const int q = (ct * 2 + wm_) * 32 + 8 * g + 4 * hh_;
        float hv[4];
#pragma unroll
        for (int t = 0; t < 4; t++) {
          const float gt = acc[0][j][4 * g + t], up = acc[1][j][4 * g + t];
          hv[t] = gt * fsigmoid(gt) * up;
        }
        uint2 o;
        o.x = pack2(hv[0], hv[1]);
        o.y = pack2(hv[2], hv[3]);
        *(uint2*)(HH + (size_t)row * FH + q) = o;
      }
  PATCH_LOOP_END
}

constexpr int NPHASE = 3 + 9 * 2;

__device__ void run_phase(const Params& p, int ph, int bid, int nb, u16* smem) {
  if (ph == 0) {
    prep_tables(p, bid, nb);
    prep_modp(p, bid, nb);
    prep_weights(p, 0, bid, nb, smem);
    return;
  }
  if (ph == 1) { prep_modr(p, bid, nb); return; }
  if (ph == 2) { ln_phase(p, 0, p.ln_in_g, p.ln_in_b, 0, 0, 1024, false, bid, nb); return; }
  const int l = (ph - 3) / 9, s = (ph - 3) % 9;
  const bool last = (l == 1);
  switch (s) {
    case 0: phase_p1(p, l, last, bid, nb, smem); break;
    case 1: phase_p2(p, l, bid, nb, smem); break;
    case 2: phase_p3(p, l, last, bid, nb, smem); break;
    case 3: phase_p4(p, l, last, bid, nb, smem); break;
    case 4: phase_resid(p, l, last, wsp<u16>(p, O_M), D, wsp<u16>(p, O_WO), D, 2048, bid, nb, smem); break;
    case 5: ln_phase(p, 1, p.ln1_g + l * D, p.ln1_b + l * D, l, 3072, 4096, last, bid, nb); break;
    case 6: phase_p7(p, l, last, bid, nb, smem); break;
    case 7: phase_resid(p, l, last, wsp<u16>(p, O_HH), FH, wsp<u16>(p, O_WD), FH, 5120, bid, nb, smem); break;
    default:
      ln_phase(p, 1, p.ln2_g + l * D, p.ln2_b + l * D, last ? -1 : l + 1, 0, 1024, last, bid, nb);
      if (!last) prep_weights(p, l + 1, bid, nb, smem);
      break;
  }
}


#define XB_TMO      128
#define XB_XCNT(j)  (256  + 64 * (j))
#define XB_XSUB(j)  (1280 + 64 * (j))
#define XB_XGEN(j)  (2304 + 64 * (j))
#define XB_TOP      3328
#define XB_TOPGEN   3392
#define XCD_BAR_WORDS 3456
#define XB_SPIN_CAP (1u << 20)
#define LAS __attribute__((address_space(3)))
__device__ __forceinline__ unsigned xb_ld(unsigned* p) { return __hip_atomic_load(p, __ATOMIC_RELAXED, __HIP_MEMORY_SCOPE_AGENT); }
__device__ __forceinline__ unsigned xb_add(unsigned* p, unsigned v) { return __hip_atomic_fetch_add(p, v, __ATOMIC_RELAXED, __HIP_MEMORY_SCOPE_AGENT); }
__device__ __forceinline__ unsigned xb_xcc_id() { return (unsigned)__builtin_amdgcn_s_getreg((3 << 11) | 20) & 0xFu; }
#define XB_SPIN(cond, bar) do { unsigned _sp = 0; while (cond) { __builtin_amdgcn_s_sleep(1); \
    if ((++_sp & 255u) == 0u) { if (xb_ld(&(bar)[XB_TMO])) break; if (_sp > XB_SPIN_CAP) { atomicAdd(&(bar)[XB_TMO], 1u); break; } } } } while (0)
struct XcdBarrier {
  unsigned* bar; unsigned x;
  volatile LAS unsigned* st;
};
__device__ __forceinline__ XcdBarrier xcd_barrier_post(unsigned* bar, volatile LAS unsigned* st) {
  XcdBarrier b; b.bar = bar; b.x = xb_xcc_id(); b.st = st;
  if (threadIdx.x == 0) (void)xb_add(&bar[XB_XCNT(b.x)], 1u);
  return b;
}
__device__ __forceinline__ void xcd_barrier_complete(unsigned* bar, unsigned x, unsigned& nloc, unsigned& nx) {
  const unsigned G = gridDim.x * gridDim.y * gridDim.z;
  unsigned sum, cnt, mine, sp = 0u;
  for (;;) {
    sum = 0u; cnt = 0u; mine = 0u;
#pragma unroll
    for (unsigned j = 0; j < 16; ++j) { const unsigned c = xb_ld(&bar[XB_XCNT(j)]); sum += c; cnt += (c > 0u) ? 1u : 0u; mine = (j == x) ? c : mine; }
    if (sum == G) break;
    __builtin_amdgcn_s_sleep(1);
    if ((++sp & 255u) == 0u) { if (xb_ld(&bar[XB_TMO])) break; if (sp > XB_SPIN_CAP) { atomicAdd(&bar[XB_TMO], 1u); break; } }
  }
  nloc = mine > 0u ? mine : 1u; nx = cnt > 0u ? cnt : 1u;
}
__device__ __forceinline__ void xcd_barrier(const XcdBarrier& b) {
  asm volatile("s_waitcnt vmcnt(0)" ::: "memory");
  __syncthreads();
  if (threadIdx.x == 0) {
    unsigned* bar = b.bar;
    __builtin_amdgcn_s_waitcnt(0);
    unsigned nloc = b.st[0], nx = b.st[1];
    if (nloc == 0u) { xcd_barrier_complete(bar, b.x, nloc, nx); b.st[0] = nloc; b.st[1] = nx; }
    const unsigned old = xb_add(&bar[XB_XSUB(b.x)], 1u);
    const unsigned gen = old / nloc;
    if (old + 1u == (gen + 1u) * nloc) {
      __builtin_amdgcn_fence(__ATOMIC_RELEASE, "agent");
      asm volatile("s_waitcnt vmcnt(0)" ::: "memory");
      const unsigned og = xb_add(&bar[XB_TOP], 1u);
      const unsigned tg = og / nx;
      if (og + 1u == (tg + 1u) * nx) xb_add(&bar[XB_TOPGEN], 1u);
      else XB_SPIN(xb_ld(&bar[XB_TOPGEN]) == tg, bar);
      __builtin_amdgcn_fence(__ATOMIC_ACQUIRE, "agent");
      xb_add(&bar[XB_XGEN(b.x)], 1u);
      asm volatile("s_waitcnt vmcnt(0)" ::: "memory");
    } else {
      XB_SPIN(xb_ld(&bar[XB_XGEN(b.x)]) == gen, bar);
      __builtin_amdgcn_fence(__ATOMIC_ACQUIRE, "agent");
      asm volatile("s_waitcnt vmcnt(0)" ::: "memory");
    }
  }
  __syncthreads();
}

constexpr int SMEM_ELEMS = 4 * SM_A + 256 + 8;

#if COOP
__global__ void __launch_bounds__(256, 2) mega_kernel(Params p) {
  __shared__ __attribute__((aligned(16))) u16 smem[SMEM_ELEMS];
  cg::grid_group grid = cg::this_grid();
  volatile LAS unsigned* st = (volatile LAS unsigned*)(smem + 4 * SM_A + 256);
  if (threadIdx.x == 0) { st[0] = 0u; st[1] = 0u; }
  __syncthreads();
  XcdBarrier xb = xcd_barrier_post((unsigned*)(p.ws + O_BAR), st);
  for (int ph = 0; ph < NPHASE; ph++) {
#ifdef PROBE_MASK
    const int s9 = ph >= 3 ? (ph - 3) % 9 : -1;
    const int nrep = (s9 >= 0 && ((PROBE_MASK >> s9) & 1)) ? 2 : 1;
    for (int rep = 0; rep < nrep; rep++) {
      run_phase(p, ph, blockIdx.x, gridDim.x, smem);
      if (ph == 0) grid.sync();
      else if (ph + 1 < NPHASE || rep + 1 < nrep) xcd_barrier(xb);
    }
#else
    run_phase(p, ph, blockIdx.x, gridDim.x, smem);
    if (ph == 0) grid.sync();
    else if (ph + 1 < NPHASE) xcd_barrier(xb);
#endif
  }
}
#else
__global__ void __launch_bounds__(256, 2) phase_kernel(Params p, int ph) {
  __shared__ __attribute__((aligned(16))) u16 smem[SMEM_ELEMS];
  run_phase(p, ph, blockIdx.x, gridDim.x, smem);
}
#endif

extern "C" void kernel_launch(void* const* d_in, const int* in_sizes, int n_in, void* d_out, int out_size, void* d_ws,
                              size_t ws_size, hipStream_t stream) {
  Params p{};
  const float** f = (const float**)&p;
  for (int i = 0; i < 25; i++) f[i] = (const float*)d_in[i];
  p.out = (float*)d_out;
  p.ws = (unsigned char*)d_ws;
  if (ws_size < O_WSEND) fprintf(stderr, "workspace too small: %zu < %zu\n", ws_size, (size_t)O_WSEND);
#if COOP
  static int grid_blocks = 0;
  if (!grid_blocks) {
    int dev = 0, cus = 0, per_cu = 0;
    hipGetDevice(&dev);
    hipDeviceGetAttribute(&cus, hipDeviceAttributeMultiprocessorCount, dev);
    hipOccupancyMaxActiveBlocksPerMultiprocessor(&per_cu, mega_kernel, 256, 0);
    if (per_cu > 2) per_cu = 2;
    grid_blocks = cus * per_cu;
  }
  (void)hipMemsetAsync(p.ws + O_BAR, 0, 3456 * 4, stream);
  void* args[] = {&p};
  hipError_t e = hipLaunchCooperativeKernel((void*)mega_kernel, dim3(grid_blocks), dim3(256), args, 0, stream);
  if (e != hipSuccess) fprintf(stderr, "cooperative launch failed: %s (grid %d)\n", hipGetErrorString(e), grid_blocks);
#else
  for (int ph = 0; ph < NPHASE; ph++) phase_kernel<<<512, 256, 0, stream>>>(p, ph);
#endif
}
```

```cpp
#include <hip/hip_runtime.h>
#include <hip/hip_cooperative_groups.h>
#include <stdint.h>
#include <cstdio>
namespace cg = cooperative_groups;

#ifndef COOP
#define COOP 1
#endif

typedef __attribute__((ext_vector_type(8))) short bf16x8;
typedef __attribute__((ext_vector_type(4))) short bf16x4;
typedef __attribute__((ext_vector_type(16))) float f32x16;
typedef unsigned short u16;
typedef __attribute__((ext_vector_type(4))) unsigned int u32x4;

constexpr int D = 1024;
constexpr int NBATCH = 2;
constexpr int SEQ = 16384;
constexpr int CTXL = 256;
constexpr int KPB = SEQ + CTXL;
constexpr int T = NBATCH * KPB;
constexpr int NRT = T / 128;
constexpr int FH = 2816;
constexpr int IN_DIM = 5536;
constexpr float LOG2E = 1.4426950408889634f;
constexpr float NA_SCALE_L2 = 0.125f * LOG2E;
constexpr float MLA_SCALE_L2 = 0.10206207261596575f * LOG2E;
constexpr float ALPHA = 1.4142135623730951f;
constexpr float EPS = 1e-5f;
constexpr float RS128 = 0.08838834764831845f;

constexpr size_t al256(size_t x) { return (x + 255) & ~(size_t)255; }
constexpr size_t O_WF = 0;
constexpr size_t O_WP = O_WF + (size_t)1024 * 1024 * 2;
constexpr size_t O_WG = O_WP + (size_t)2048 * 1024 * 2;
constexpr size_t O_WUQ = O_WG + (size_t)3072 * 1024 * 2;
constexpr size_t O_WUKV = O_WUQ + (size_t)768 * 256 * 2;
constexpr size_t O_WB = O_WUKV + (size_t)1024 * 128 * 2;
constexpr size_t O_WO = O_WB + (size_t)3 * 1024 * 512 * 2;
constexpr size_t O_WGU = O_WO + (size_t)1024 * 1024 * 2;
constexpr size_t O_WD = O_WGU + (size_t)5632 * 1024 * 2;
constexpr size_t O_MA = O_WD + (size_t)1024 * 2816 * 2;
constexpr size_t O_MB = O_MA + (size_t)256 * 256 * 2;
constexpr size_t O_MC = O_MB + (size_t)128 * 256 * 2;
constexpr size_t O_TW = O_MC + (size_t)256 * 512 * 2;
constexpr size_t O_MODP = O_TW + (size_t)128 * 128 * 2 * 4;
constexpr size_t O_MOD = O_MODP + (size_t)16 * 2 * 3 * 6144 * 4;
constexpr size_t O_XCTX = O_MOD + (size_t)2 * 3 * 6144 * 4;
constexpr size_t O_D1C = O_XCTX + (size_t)512 * 1024 * 4;
constexpr size_t O_A = O_D1C + (size_t)2 * 512 * 2 * 256 * 2;
constexpr size_t O_RQ = O_A + (size_t)T * 1024 * 2;
constexpr size_t O_QNA = O_RQ;
constexpr size_t O_KNA = O_QNA + (size_t)T * 512 * 2;
constexpr size_t O_VNAT = O_KNA + (size_t)T * 512 * 2;
constexpr size_t O_RY = O_VNAT + (size_t)T * 512 * 2;
constexpr size_t O_Y = O_RY;
constexpr size_t O_D1 = O_RY;
constexpr size_t O_LAT = O_RY + (size_t)67108864;
constexpr size_t O_D2 = O_RY + (size_t)T * 1536 * 2;
constexpr size_t O_QM = O_D2 + (size_t)67108864;
constexpr size_t O_KN = O_QM + (size_t)T * 768 * 2;
constexpr size_t O_KRR = O_KN + (size_t)T * 512 * 2;
constexpr size_t O_VMT = O_KRR + (size_t)T * 32 * 2;
constexpr size_t O_END = O_VMT + (size_t)T * 512 * 2;
constexpr size_t O_BAR = (O_END + 255) & ~(size_t)255;
constexpr size_t O_WSEND = O_BAR + 3456 * 4;
constexpr size_t O_M = O_RQ;
constexpr size_t O_HH = O_RQ;

struct Params {
  const float *x, *c, *ctx, *c_ctx, *ln_in_g, *ln_in_b, *w_mod, *b_mod, *w_in, *gq, *gkv, *w_uq, *w_qr, *w_uk,
      *w_uv, *rpb, *w_branch, *w_out, *ln1_g, *ln1_b, *ln2_g, *ln2_b, *w_gate, *w_up, *w_down;
  float* out;
  unsigned char* ws;
};

__device__ __forceinline__ u16 f2bf(float f) {
  uint32_t u = __float_as_uint(f);
  u += 0x7fffu + ((u >> 16) & 1u);
  return (u16)(u >> 16);
}
typedef __attribute__((ext_vector_type(2))) __bf16 bf16v2;
typedef __attribute__((ext_vector_type(2))) float f32v2;
__device__ __forceinline__ uint32_t pack2(float a, float b) {
  const f32v2 v = {a, b};
  return __builtin_bit_cast(uint32_t, __builtin_convertvector(v, bf16v2));
}
__device__ __forceinline__ float bf2f(u16 v) { return __uint_as_float(((uint32_t)v) << 16); }
__device__ __forceinline__ float wsum(float v) {
#pragma unroll
  for (int o = 32; o > 0; o >>= 1) v += __shfl_xor(v, o);
  return v;
}
__device__ __forceinline__ float fsigmoid(float v) { return 1.f / (1.f + __expf(-v)); }

__device__ __forceinline__ int ltid() {
  int t = threadIdx.x;
  asm volatile("" : "+v"(t));
  return t;
}

template <typename Tp>
__device__ __forceinline__ Tp* wsp(const Params& p, size_t off) { return (Tp*)(p.ws + off); }

__device__ __forceinline__ float* xrow(const Params& p, int row) {
  int b = row / KPB, kk = row - b * KPB;
  if (kk < CTXL) return wsp<float>(p, O_XCTX) + (size_t)(b * CTXL + kk) * D;
  return p.out + (size_t)(b * SEQ + kk - CTXL) * D;
}

constexpr int LSTR = 72;
constexpr int SM_A = 128 * LSTR;

template <bool DEEP = true>
__device__ __forceinline__ void gemm_core(f32x16 (&acc)[2][2], const u16* __restrict__ A, size_t lda,
                                          const u16* __restrict__ B, size_t ldb, int K, u16* smem) {
  const int tid = ltid(), lane = tid & 63, wave = tid >> 6;
  const int wm = wave >> 1, wn = wave & 1, r = lane & 31, hh = lane >> 5;
  u16* sA = smem;
  u16* sB = smem + 2 * SM_A;
  const int lrow = tid >> 3, lkc = (tid & 7) * 8;
  const u16* ga = A + (size_t)lrow * lda + lkc;
  const u16* gb = B + (size_t)lrow * ldb + lkc;
  u16* wa = sA + lrow * LSTR + lkc;
  u16* wb = sB + lrow * LSTR + lkc;
  const u16* pa = sA + (wm * 64 + r) * LSTR + hh * 8;
  const u16* pb = sB + (wn * 64 + r) * LSTR + hh * 8;
  u32x4 a0r[4], b0r[4], a1r[4], b1r[4];
#define G_LOAD(ar, br, ko)                                               \
  _Pragma("unroll") for (int i = 0; i < 4; i++) {                        \
    ar[i] = *(const u32x4*)(ga + (size_t)(32 * i) * lda + (ko));         \
    br[i] = *(const u32x4*)(gb + (size_t)(32 * i) * ldb + (ko));         \
  }
#define G_STORE(ar, br, buf)                                             \
  _Pragma("unroll") for (int i = 0; i < 4; i++) {                        \
    *(u32x4*)(wa + (buf)*SM_A + 32 * i * LSTR) = ar[i];                  \
    *(u32x4*)(wb + (buf)*SM_A + 32 * i * LSTR) = br[i];                  \
  }
#define G_COMPUTE(buf)                                                                   \
  _Pragma("unroll") for (int ks = 0; ks < 4; ks++) {                                     \
    const bf16x8 fa0 = *(const bf16x8*)(pa + (buf)*SM_A + ks * 16);                      \
    const bf16x8 fa1 = *(const bf16x8*)(pa + (buf)*SM_A + 32 * LSTR + ks * 16);          \
    const bf16x8 fb0 = *(const bf16x8*)(pb + (buf)*SM_A + ks * 16);                      \
    const bf16x8 fb1 = *(const bf16x8*)(pb + (buf)*SM_A + 32 * LSTR + ks * 16);          \
    acc[0][0] = __builtin_amdgcn_mfma_f32_32x32x16_bf16(fa0, fb0, acc[0][0], 0, 0, 0);   \
    acc[0][1] = __builtin_amdgcn_mfma_f32_32x32x16_bf16(fa0, fb1, acc[0][1], 0, 0, 0);   \
    acc[1][0] = __builtin_amdgcn_mfma_f32_32x32x16_bf16(fa1, fb0, acc[1][0], 0, 0, 0);   \
    acc[1][1] = __builtin_amdgcn_mfma_f32_32x32x16_bf16(fa1, fb1, acc[1][1], 0, 0, 0);   \
  }
  const int nk = K >> 6;
  if (DEEP) {
    G_LOAD(a0r, b0r, 0)
    G_LOAD(a1r, b1r, 64)
    G_STORE(a0r, b0r, 0)
    __syncthreads();
    const int klast = (nk - 1) * 64;
    G_LOAD(a0r, b0r, min(128, klast))
    for (int kt = 0; kt < nk; kt += 2) {
      G_COMPUTE(0)
      G_STORE(a1r, b1r, 1)
      __syncthreads();
      G_LOAD(a1r, b1r, min((kt + 3) * 64, klast))
      __builtin_amdgcn_sched_barrier(0);
      G_COMPUTE(1)
      G_STORE(a0r, b0r, 0)
      __syncthreads();
      G_LOAD(a0r, b0r, min((kt + 4) * 64, klast))
      __builtin_amdgcn_sched_barrier(0);
    }
  } else {
    G_LOAD(a0r, b0r, 0)
    G_STORE(a0r, b0r, 0)
    __syncthreads();
    for (int kt = 0; kt < nk; kt += 2) {
      G_LOAD(a0r, b0r, (kt + 1) * 64)
      G_COMPUTE(0)
      G_STORE(a0r, b0r, 1)
      __syncthreads();
      if (kt + 2 < nk) G_LOAD(a0r, b0r, (kt + 2) * 64)
      G_COMPUTE(1)
      if (kt + 2 < nk) G_STORE(a0r, b0r, 0)
      __syncthreads();
    }
  }
#undef G_LOAD
#undef G_STORE
#undef G_COMPUTE
}

__device__ __forceinline__ void zero_acc(f32x16 (&acc)[2][2]) {
#pragma unroll
  for (int i = 0; i < 2; i++)
#pragma unroll
    for (int j = 0; j < 2; j++)
#pragma unroll
      for (int e = 0; e < 16; e++) acc[i][j][e] = 0.f;
}

#define EPI_DECL                                                     \
  const int lane_ = ltid() & 63, wave_ = ltid() >> 6;      \
  const int wm_ = wave_ >> 1, wn_ = wave_ & 1, r_ = lane_ & 31, hh_ = lane_ >> 5; \
  (void)wm_; (void)wn_; (void)r_; (void)hh_;

__device__ __forceinline__ const float* src_col(const Params& p, int l, int kind, int n, int& ld) {
  switch (kind) {
    case 0:
      ld = IN_DIM;
      return n < 1952 ? p.w_in + (size_t)l * D * IN_DIM + 512 + n : nullptr;
    case 1:
      ld = IN_DIM;
      return p.w_in + (size_t)l * D * IN_DIM + 2464 + n;
    case 2:
      if (n < 512) {
        ld = 512;
        return p.w_uq + (size_t)l * 256 * 512 + n;
      } else {
        int m = n - 512, wt = m >> 6, jb = (m >> 5) & 1, idx = wt * 32 + (m & 31);
        int h = idx >> 4, e = idx & 15;
        ld = 256;
        return p.w_qr + (size_t)l * 256 * 256 + h * 32 + jb * 16 + e;
      }
    case 3:
      ld = 512;
      return n < 512 ? p.w_uk + (size_t)l * 128 * 512 + n : p.w_uv + (size_t)l * 128 * 512 + (n - 512);
    case 4: {
      int g = n >> 10, nn = n & 1023;
      ld = 1024;
      return p.w_branch + ((size_t)(l * 3 + g) * 512) * 1024 + nn;
    }
    case 5:
      ld = 1024;
      return p.w_out + (size_t)l * D * D + n;
    case 6: {
      int jb = (n >> 5) & 1, q = (n >> 6) * 32 + (n & 31);
      ld = FH;
      return (jb ? p.w_up : p.w_gate) + (size_t)l * D * FH + q;
    }
    default:
      ld = 1024;
      return p.w_down + (size_t)l * FH * D + n;
  }
}

__device__ __forceinline__ int job_nd(int k) {
  switch (k) { case 0: return 2048; case 1: return 3072; case 2: return 768; case 3: return 1024; case 4: return 3072;
    case 5: return 1024; case 6: return 5632; default: return 1024; }
}
__device__ __forceinline__ int job_kd(int k) {
  switch (k) { case 0: return 1024; case 1: return 1024; case 2: return 256; case 3: return 128; case 4: return 512;
    case 5: return 1024; case 6: return 1024; default: return 2816; }
}
__device__ __forceinline__ size_t job_od(int k) {
  switch (k) { case 0: return O_WP; case 1: return O_WG; case 2: return O_WUQ; case 3: return O_WUKV; case 4: return O_WB;
    case 5: return O_WO; case 6: return O_WGU; default: return O_WD; }
}
__device__ void prep_weights(const Params& p, int l, int bid, int nb, u16* smem) {
  float* tile = (float*)smem;
  const int tid = ltid();
  int start = 0;
#pragma unroll 1
  for (int kind = 0; kind < 8; kind++) {
    const int Kk = job_kd(kind);
    const int nkt = Kk >> 6, ntile = (job_nd(kind) >> 6) * nkt;
    u16* dst = wsp<u16>(p, job_od(kind));
    const float* ksc = kind == 2 ? p.gq + l * 256 : (kind == 3 ? p.gkv + l * 128 : nullptr);
    for (int t = (bid + nb - (start % nb)) % nb; t < ntile; t += nb) {
      const int nt = t / nkt, kt = t - nt * nkt;
      const int n0 = nt * 64, k0 = kt * 64;
      {
        const int kq = tid >> 4, nn4 = (tid & 15) * 4;
        int ld;
        const float* sp = src_col(p, l, kind, n0 + nn4, ld);
#pragma unroll
        for (int i = 0; i < 4; i++) {
          const int kk = i * 16 + kq;
          float4 v = make_float4(0.f, 0.f, 0.f, 0.f);
          if (sp) v = *(const float4*)(sp + (size_t)(k0 + kk) * ld);
          if (ksc) {
            const float sc = ksc[k0 + kk];
            v.x *= sc; v.y *= sc; v.z *= sc; v.w *= sc;
          }
          float* tp = tile + kk * 65 + nn4;
          tp[0] = v.x; tp[1] = v.y; tp[2] = v.z; tp[3] = v.w;
        }
      }
      __syncthreads();
#pragma unroll
      for (int i = 0; i < 2; i++) {
        const int c = tid + 256 * i;
        const int nn = c >> 3, kc = (c & 7) * 8;
        const float* tp = tile + kc * 65 + nn;
        uint4 o;
        o.x = pack2(tp[0], tp[65]);
        o.y = pack2(tp[2 * 65], tp[3 * 65]);
        o.z = pack2(tp[4 * 65], tp[5 * 65]);
        o.w = pack2(tp[6 * 65], tp[7 * 65]);
        *(uint4*)(dst + (size_t)(n0 + nn) * Kk + k0 + kc) = o;
      }
      __syncthreads();
    }
    start += ntile;
  }
  {
    float* ctab = (float*)smem;
    __syncthreads();
    if (tid < 128) ctab[tid] = cospif((float)tid * (1.f / 64.f));
    __syncthreads();
    u16* dst = wsp<u16>(p, O_WF);
    for (int it = bid; it < 512; it += nb) {
      const int o = it * 256 + tid;
      const int np = o & 1023, k8 = (o >> 10) * 8;
      const int reim = np >> 9, g = (np >> 7) & 3, m = np & 127;
      const float* w = p.w_in + (size_t)l * D * IN_DIM + (size_t)k8 * IN_DIM + g * 128;
      const int sh = reim ? 96 : 0;
      float a8[8];
#pragma unroll
      for (int j = 0; j < 8; j++) a8[j] = 0.f;
#pragma unroll 4
      for (int c = 0; c < 128; c++) {
        const float tw = ctab[(m * c + sh) & 127];
#pragma unroll
        for (int j = 0; j < 8; j++) a8[j] += w[(size_t)j * IN_DIM + c] * tw;
      }
      uint4 ov;
      ov.x = pack2(a8[0] * RS128, a8[1] * RS128);
      ov.y = pack2(a8[2] * RS128, a8[3] * RS128);
      ov.z = pack2(a8[4] * RS128, a8[5] * RS128);
      ov.w = pack2(a8[6] * RS128, a8[7] * RS128);
      *(uint4*)(dst + (size_t)np * 1024 + k8) = ov;
    }
    __syncthreads();
  }
}

__device__ void prep_tables(const Params& p, int bid, int nb) {
  u16* MA = wsp<u16>(p, O_MA);
  u16* MB = wsp<u16>(p, O_MB);
  u16* MC = wsp<u16>(p, O_MC);
  float* TW = wsp<float>(p, O_TW);
  const int total = 65536 + 32768 + 131072 + 16384;
  for (int idx = bid * 256 + ltid(); idx < total; idx += nb * 256) {
    if (idx < 65536) {
      const int n = idx >> 8, k = idx & 255;
      const int nt = n >> 7, wn = (n >> 6) & 1, jb = (n >> 5) & 1, klo = nt * 64 + wn * 32 + (n & 31);
      const int ri = k >> 7, nhi = k & 127;
      const int xx = (klo * nhi) & 127;
      const float c = cospif((float)xx * (1.f / 64.f)), s = sinpif((float)xx * (1.f / 64.f));
      float v = jb == 0 ? (ri == 0 ? c : -s) : (ri == 0 ? -s : -c);
      MA[idx] = f2bf(v * RS128);
    } else if (idx < 65536 + 32768) {
      const int i2 = idx - 65536;
      const int khi = i2 >> 8, k = i2 & 255;
      const int ri = k >> 7, nlo = k & 127;
      const int xx = (khi * nlo) & 127;
      const float c = cospif((float)xx * (1.f / 64.f)), s = sinpif((float)xx * (1.f / 64.f));
      MB[i2] = f2bf((ri == 0 ? c : s) * RS128);
    } else if (idx < 65536 + 32768 + 131072) {
      const int i2 = idx - 65536 - 32768;
      const int kk = i2 >> 9, k = i2 & 511;
      const int ri = k >> 8, nn = k & 255;
      const int xx = (kk * nn) & 255;
      const float c = cospif((float)xx * (1.f / 128.f)), s = sinpif((float)xx * (1.f / 128.f));
      MC[i2] = f2bf((ri == 0 ? c : -s) * 0.0625f);
    } else {
      const int i2 = idx - 65536 - 32768 - 131072;
      const int klo = i2 >> 7, nlo = i2 & 127;
      const int xx = klo * nlo;
      TW[i2 * 2] = cospif((float)xx * (1.f / 8192.f));
      TW[i2 * 2 + 1] = sinpif((float)xx * (1.f / 8192.f));
    }
  }
}

__device__ void prep_modp(const Params& p, int bid, int nb) {
  float* modp = wsp<float>(p, O_MODP);
  for (int it = bid; it < 2 * 16 * 24; it += nb) {
    const int l = it / (16 * 24), rem = it - l * 16 * 24, kc = rem / 24, nblk = rem - kc * 24;
    const int n = nblk * 256 + ltid();
    const float* w = p.w_mod + (size_t)l * D * 6144 + n;
    float a0 = 0.f, a1 = 0.f, a2 = 0.f;
#pragma unroll 8
    for (int kk = 0; kk < 64; kk++) {
      const int k = kc * 64 + kk;
      const float wv = w[(size_t)k * 6144];
      float c0 = p.c[k], c1 = p.c[1024 + k], c2 = p.c_ctx[k];
      c0 = c0 / (1.f + __expf(-c0));
      c1 = c1 / (1.f + __expf(-c1));
      c2 = c2 / (1.f + __expf(-c2));
      a0 += c0 * wv;
      a1 += c1 * wv;
      a2 += c2 * wv;
    }
    float* o = modp + ((size_t)(kc * 2 + l) * 3) * 6144 + n;
    o[0] = a0;
    o[6144] = a1;
    o[2 * 6144] = a2;
  }
}
__device__ void prep_modr(const Params& p, int bid, int nb) {
  const float* modp = wsp<float>(p, O_MODP);
  float* mod = wsp<float>(p, O_MOD);
  for (int idx = bid * 256 + ltid(); idx < 2 * 3 * 6144; idx += nb * 256) {
    const int l = idx / (3 * 6144), n = idx % 6144;
    float v = p.b_mod[l * 6144 + n];
    for (int kc = 0; kc < 16; kc++) v += modp[(size_t)kc * 2 * 3 * 6144 + idx];
    mod[idx] = v;
  }
}

__device__ void ln_phase(const Params& p, int mode, const float* g, const float* bta, int lmod, int shoff, int scoff,
                         bool skip_ctx, int bid, int nb) {
  const int lane = ltid() & 63, wave = ltid() >> 6;
  u16* A = wsp<u16>(p, O_A);
  const float* mod = wsp<float>(p, O_MOD);
  for (int row = bid * 4 + wave; row < T; row += nb * 4) {
    const int b = row / KPB, kk = row - b * KPB;
    if (skip_ctx && kk < CTXL) continue;
    float* xr = xrow(p, row);
    const float* src;
    if (mode == 0)
      src = kk < CTXL ? p.ctx + (size_t)(b * CTXL + kk) * D : p.x + (size_t)(b * SEQ + kk - CTXL) * D;
    else
      src = xr;
    float4 v[4];
    float s = 0.f;
#pragma unroll
    for (int i = 0; i < 4; i++) {
      v[i] = *(const float4*)(src + i * 256 + lane * 4);
      s += v[i].x + v[i].y + v[i].z + v[i].w;
    }
    const float mu = wsum(s) * (1.f / 1024.f);
    float q = 0.f;
#pragma unroll
    for (int i = 0; i < 4; i++) {
      v[i].x -= mu; v[i].y -= mu; v[i].z -= mu; v[i].w -= mu;
      q += v[i].x * v[i].x + v[i].y * v[i].y + v[i].z * v[i].z + v[i].w * v[i].w;
    }
    const float rstd = rsqrtf(wsum(q) * (1.f / 1024.f) + EPS);
    const int m = kk < CTXL ? 2 : b;
    const float* md = mod + ((size_t)(lmod < 0 ? 0 : lmod) * 3 + m) * 6144;
#pragma unroll
    for (int i = 0; i < 4; i++) {
      const int c0 = i * 256 + lane * 4;
      const float4 gg = *(const float4*)(g + c0), bb = *(const float4*)(bta + c0);
      float4 y;
      y.x = v[i].x * rstd * gg.x + bb.x;
      y.y = v[i].y * rstd * gg.y + bb.y;
      y.z = v[i].z * rstd * gg.z + bb.z;
      y.w = v[i].w * rstd * gg.w + bb.w;
      *(float4*)(xr + c0) = y;
      if (lmod >= 0) {
        const float4 sh = *(const float4*)(md + shoff + c0), sc = *(const float4*)(md + scoff + c0);
        uint2 o;
        o.x = pack2(y.x * (1.f + sc.x) + sh.x, y.y * (1.f + sc.y) + sh.y);
        o.y = pack2(y.z * (1.f + sc.z) + sh.z, y.w * (1.f + sc.w) + sh.w);
        *(uint2*)(A + (size_t)row * D + c0) = o;
      }
    }
  }
}

#define PATCH_LOOP_BEGIN(NR_, NC_, PR_, PC_)                                   \
  {                                                                            \
    const int x_ = bid & 7, w_ = bid >> 3, nbx_ = nb >> 3;                     \
    const int CG_ = ((NC_) + (PC_)-1) / (PC_);                                 \
    const int npatch_ = (((NR_) + (PR_)-1) / (PR_)) * CG_;                     \
    for (int u_ = w_;; u_ += nbx_) {                                           \
      const int g_ = (u_ >> 6) * 8 + x_;                                       \
      if (g_ >= npatch_) break;                                                \
      const int s_ = u_ & 63;                                                  \
      const int rg_ = g_ / CG_;                                                \
      const int prt = rg_ * (PR_) + s_ / (PC_);                                \
      const int pct = (g_ - rg_ * CG_) * (PC_) + s_ % (PC_);                   \
      if (prt >= (NR_) || pct >= (NC_)) continue;
#define PATCH_LOOP_END \
    }                  \
  }

__device__ void phase_p1(const Params& p, int l, bool last, int bid, int nb, u16* smem) {
  EPI_DECL
  const u16* A = wsp<u16>(p, O_A);
  PATCH_LOOP_BEGIN(NRT, 16, 8, 8)
    f32x16 acc[2][2];
    zero_acc(acc);
    {
      const int rt = prt, ct = pct;
      const int row0 = rt * 128, b = row0 / KPB, kk0 = row0 - b * KPB;
      if (ct < 8 || ct >= 12) {
        gemm_core(acc, wsp<u16>(p, O_WP) + (size_t)ct * 128 * D, D, A + (size_t)rt * 128 * D, D, D, smem);
        u16* dst;
        float sc = 1.f;
        int cb;
        if (ct < 4) { dst = wsp<u16>(p, O_QNA); sc = NA_SCALE_L2; cb = ct * 128; }
        else if (ct < 8) { dst = wsp<u16>(p, O_KNA); cb = (ct - 4) * 128; }
        else { dst = wsp<u16>(p, O_LAT); cb = (ct - 12) * 128; }
#pragma unroll
        for (int i = 0; i < 2; i++)
#pragma unroll
          for (int j = 0; j < 2; j++)
#pragma unroll
            for (int g = 0; g < 4; g++) {
              const int row = row0 + wn_ * 64 + j * 32 + r_;
              const int col = cb + wm_ * 64 + i * 32 + 8 * g + 4 * hh_;
              uint2 o;
              o.x = pack2(acc[i][j][4 * g] * sc, acc[i][j][4 * g + 1] * sc);
              o.y = pack2(acc[i][j][4 * g + 2] * sc, acc[i][j][4 * g + 3] * sc);
              *(uint2*)(dst + (size_t)row * 512 + col) = o;
            }
      } else {
        gemm_core(acc, A + (size_t)rt * 128 * D, D, wsp<u16>(p, O_WP) + (size_t)ct * 128 * D, D, D, smem);
        u16* dst = wsp<u16>(p, O_VNAT);
        const int cb = (ct - 8) * 128;
#pragma unroll
        for (int i = 0; i < 2; i++)
#pragma unroll
          for (int j = 0; j < 2; j++)
#pragma unroll
            for (int g = 0; g < 4; g++) {
              const int kk = kk0 + wm_ * 64 + i * 32 + 8 * g + 4 * hh_;
              const int col = cb + wn_ * 64 + j * 32 + r_;
              uint2 o;
              o.x = pack2(acc[i][j][4 * g], acc[i][j][4 * g + 1]);
              o.y = pack2(acc[i][j][4 * g + 2], acc[i][j][4 * g + 3]);
              *(uint2*)(dst + ((size_t)(b * 512 + col)) * KPB + kk) = o;
            }
      }
    }
  PATCH_LOOP_END
  PATCH_LOOP_BEGIN(256, 8, 8, 8)
    f32x16 acc[2][2];
    zero_acc(acc);
    {
      const int rt = prt, ct = pct;
      const int b = rt >> 7, nlo = rt & 127;
      gemm_core(acc, A + (size_t)(b * KPB + CTXL + nlo) * D, (size_t)128 * D,
                wsp<u16>(p, O_WF) + (size_t)ct * 128 * D, D, D, smem);
      u16* dst = wsp<u16>(p, O_D1);
#pragma unroll
      for (int i = 0; i < 2; i++)
#pragma unroll
        for (int j = 0; j < 2; j++)
#pragma unroll
          for (int g = 0; g < 4; g++) {
            const int nhi = wm_ * 64 + i * 32 + 8 * g + 4 * hh_;
            const int n = ct * 128 + wn_ * 64 + j * 32 + r_;
            const int reim = n >> 9, jj = n & 511;
            uint2 o;
            o.x = pack2(acc[i][j][4 * g], acc[i][j][4 * g + 1]);
            o.y = pack2(acc[i][j][4 * g + 2], acc[i][j][4 * g + 3]);
            *(uint2*)(dst + ((((size_t)(b * 512 + jj)) * 128 + nlo) * 2 + reim) * 128 + nhi) = o;
          }
    }
  PATCH_LOOP_END
  if (!last) {
    for (int t2 = bid; t2 < 32; t2 += nb) {
      f32x16 acc[2][2];
      zero_acc(acc);
      const int rt = t2 >> 3, ct = t2 & 7;
      const int b = rt >> 1, rb = rt & 1;
      gemm_core(acc, A + (size_t)(b * KPB + rb * 128) * D, D, wsp<u16>(p, O_WF) + (size_t)ct * 128 * D, D, D, smem);
      u16* dst = wsp<u16>(p, O_D1C);
#pragma unroll
      for (int i = 0; i < 2; i++)
#pragma unroll
        for (int j = 0; j < 2; j++)
#pragma unroll
          for (int g = 0; g < 4; g++) {
            const int nc = rb * 128 + wm_ * 64 + i * 32 + 8 * g + 4 * hh_;
            const int n = ct * 128 + wn_ * 64 + j * 32 + r_;
            const int reim = n >> 9, jj = n & 511;
            uint2 o;
            o.x = pack2(acc[i][j][4 * g], acc[i][j][4 * g + 1]);
            o.y = pack2(acc[i][j][4 * g + 2], acc[i][j][4 * g + 3]);
            *(uint2*)(dst + (((size_t)(b * 512 + jj)) * 2 + reim) * 256 + nc) = o;
          }
    }
  }
}

__device__ __forceinline__ float inv_freq(int i) {
  switch (i) {
    case 0: return 1.0f;
    case 1: return 0.31622776601683794f;
    case 2: return 0.1f;
    case 3: return 0.03162277660168379f;
    case 4: return 0.01f;
    case 5: return 0.0031622776601683794f;
    case 6: return 0.001f;
    default: return 0.00031622776601683794f;
  }
}
__device__ __forceinline__ void rope_cs(int kk, int e, float& cs, float& sn) {
  if (kk < CTXL) { cs = 1.f; sn = 0.f; return; }
  const int tkn = kk - CTXL;
  const float pos = (e < 8) ? (float)(tkn >> 6) : (float)(tkn & 63);
  const float ang = pos * inv_freq(e & 7);
  double xr = (double)ang * 0.31830988618379067;
  xr -= 2.0 * floor(xr * 0.5);
  const float yr = (float)xr;
  cs = cospif(yr);
  sn = sinpif(yr);
}

__device__ __forceinline__ void row_rms(const u16* A, size_t lda, int K, float* rs) {
  const int tid = ltid();
  const int row = tid >> 1, half = tid & 1;
  const u16* pr = A + (size_t)row * lda + half * (K >> 1);
  float s = 0.f;
  for (int c = 0; c < (K >> 1); c += 8) {
    uint4 v = *(const uint4*)(pr + c);
    const uint32_t w[4] = {v.x, v.y, v.z, v.w};
#pragma unroll
    for (int q = 0; q < 4; q++) {
      const float a = __uint_as_float(w[q] << 16), bq = __uint_as_float(w[q] & 0xffff0000u);
      s += a * a + bq * bq;
    }
  }
  s += __shfl_xor(s, 1);
  if (half == 0) rs[row] = rsqrtf(s / (float)K + EPS);
  __syncthreads();
}

__device__ void phase_p2(const Params& p, int l, int bid, int nb, u16* smem) {
  EPI_DECL
  const u16* LAT = wsp<u16>(p, O_LAT);
  float* rs = (float*)(smem + 4 * SM_A);
  const int nQ = NRT * 6, nKV = NRT * 8, nFA = 1024 * 2, nKR = NRT;
  const int total = nQ + nKV + nFA + nKR;
  for (int t = bid; t < total; t += nb) {
    if (t < nQ) {
      const int rt = t / 6, ct = t - rt * 6;
      const int row0 = rt * 128, b = row0 / KPB, kk0 = row0 - b * KPB;
      row_rms(LAT + (size_t)row0 * 512, 512, 256, rs);
      f32x16 acc[2][2];
      zero_acc(acc);
      gemm_core(acc, wsp<u16>(p, O_WUQ) + (size_t)ct * 128 * 256, 256, LAT + (size_t)row0 * 512, 512, 256, smem);
      u16* QM = wsp<u16>(p, O_QM);
      if (ct < 4) {
#pragma unroll
        for (int i = 0; i < 2; i++)
#pragma unroll
          for (int j = 0; j < 2; j++)
#pragma unroll
            for (int g = 0; g < 4; g++) {
              const int rl = wn_ * 64 + j * 32 + r_;
              const int col = ct * 128 + wm_ * 64 + i * 32 + 8 * g + 4 * hh_;
              const int h = col >> 6, d = col & 63;
              const float sc = rs[rl] * MLA_SCALE_L2;
              uint2 o;
              o.x = pack2(acc[i][j][4 * g] * sc, acc[i][j][4 * g + 1] * sc);
              o.y = pack2(acc[i][j][4 * g + 2] * sc, acc[i][j][4 * g + 3] * sc);
              *(uint2*)(QM + (size_t)(row0 + rl) * 768 + h * 96 + d) = o;
            }
      } else {
        const int wt = (ct - 4) * 2 + wm_;
#pragma unroll
        for (int j = 0; j < 2; j++) {
          const int rl = wn_ * 64 + j * 32 + r_;
          const float sc = rs[rl] * MLA_SCALE_L2;
#pragma unroll
          for (int g = 0; g < 4; g++) {
            const int idx = wt * 32 + 8 * g + 4 * hh_;
            const int h = idx >> 4, e16 = idx & 15;
            float o1[4], o2[4];
#pragma unroll
            for (int q = 0; q < 4; q++) {
              float cs, sn;
              rope_cs(kk0 + rl, e16 + q, cs, sn);
              const float x1 = acc[0][j][4 * g + q] * sc, x2 = acc[1][j][4 * g + q] * sc;
              o1[q] = x1 * cs - x2 * sn;
              o2[q] = x2 * cs + x1 * sn;
            }
            u16* qd = QM + (size_t)(row0 + rl) * 768 + h * 96 + 64 + e16;
            uint2 o;
            o.x = pack2(o1[0], o1[1]);
            o.y = pack2(o1[2], o1[3]);
            *(uint2*)qd = o;
            o.x = pack2(o2[0], o2[1]);
            o.y = pack2(o2[2], o2[3]);
            *(uint2*)(qd + 16) = o;
          }
        }
      }
      __syncthreads();
    } else if (t < nQ + nKV) {
      const int t2 = t - nQ;
      const int rt = t2 >> 3, ct = t2 & 7;
      const int row0 = rt * 128, b = row0 / KPB, kk0 = row0 - b * KPB;
      row_rms(LAT + (size_t)row0 * 512 + 256, 512, 128, rs);
      f32x16 acc[2][2];
      zero_acc(acc);
      if (ct < 4) {
        gemm_core(acc, wsp<u16>(p, O_WUKV) + (size_t)ct * 128 * 128, 128, LAT + (size_t)row0 * 512 + 256, 512, 128,
                  smem);
        u16* KN = wsp<u16>(p, O_KN);
#pragma unroll
        for (int i = 0; i < 2; i++)
#pragma unroll
          for (int j = 0; j < 2; j++)
#pragma unroll
            for (int g = 0; g < 4; g++) {
              const int rl = wn_ * 64 + j * 32 + r_;
              const int col = ct * 128 + wm_ * 64 + i * 32 + 8 * g + 4 * hh_;
              const float sc = rs[rl];
              uint2 o;
              o.x = pack2(acc[i][j][4 * g] * sc, acc[i][j][4 * g + 1] * sc);
              o.y = pack2(acc[i][j][4 * g + 2] * sc, acc[i][j][4 * g + 3] * sc);
              *(uint2*)(KN + (size_t)(row0 + rl) * 512 + col) = o;
            }
      } else {
        gemm_core(acc, LAT + (size_t)row0 * 512 + 256, 512, wsp<u16>(p, O_WUKV) + (size_t)ct * 128 * 128, 128, 128,
                  smem);
        u16* VMT = wsp<u16>(p, O_VMT);
#pragma unroll
        for (int i = 0; i < 2; i++)
#pragma unroll
          for (int j = 0; j < 2; j++)
#pragma unroll
            for (int g = 0; g < 4; g++) {
              const int rl = wm_ * 64 + i * 32 + 8 * g + 4 * hh_;
              const int col = (ct - 4) * 128 + wn_ * 64 + j * 32 + r_;
              uint2 o;
              o.x = pack2(acc[i][j][4 * g] * rs[rl], acc[i][j][4 * g + 1] * rs[rl + 1]);
              o.y = pack2(acc[i][j][4 * g + 2] * rs[rl + 2], acc[i][j][4 * g + 3] * rs[rl + 3]);
              *(uint2*)(VMT + ((size_t)(b * 512 + col)) * KPB + kk0 + rl) = o;
            }
      }
      __syncthreads();
    } else if (t < nQ + nKV + nFA) {
      const int t2 = t - nQ - nKV;
      const int rt = t2 >> 1, ct = t2 & 1;
      const int b = rt >> 9, jj = rt & 511;
      f32x16 acc[2][2];
      zero_acc(acc);
      gemm_core(acc, wsp<u16>(p, O_D1) + (size_t)rt * 128 * 256, 256, wsp<u16>(p, O_MA) + (size_t)ct * 128 * 256, 256,
                256, smem);
      const float* TW = wsp<float>(p, O_TW);
      u16* D2 = wsp<u16>(p, O_D2);
      const int klo = ct * 64 + wn_ * 32 + r_;
#pragma unroll
      for (int i = 0; i < 2; i++)
#pragma unroll
        for (int g = 0; g < 4; g++) {
          const int nlo = wm_ * 64 + i * 32 + 8 * g + 4 * hh_;
          float re[4], im[4];
#pragma unroll
          for (int q = 0; q < 4; q++) {
            const float2 tw = *(const float2*)(TW + ((size_t)klo * 128 + nlo + q) * 2);
            const float ar = acc[i][0][4 * g + q], ai = acc[i][1][4 * g + q];
            re[q] = ar * tw.x + ai * tw.y;
            im[q] = ai * tw.x - ar * tw.y;
          }
          u16* d = D2 + ((((size_t)(b * 128 + klo)) * 512 + jj) * 2) * 128 + nlo;
          uint2 o;
          o.x = pack2(re[0], re[1]);
          o.y = pack2(re[2], re[3]);
          *(uint2*)d = o;
          o.x = pack2(im[0], im[1]);
          o.y = pack2(im[2], im[3]);
          *(uint2*)(d + 128) = o;
        }
    } else {
      const int rt = t - nQ - nKV - nFA;
      u16* KRR = wsp<u16>(p, O_KRR);
      for (int idx = ltid(); idx < 128 * 16; idx += 256) {
        const int rl = idx >> 4, e16 = idx & 15;
        const int row = rt * 128 + rl, b = row / KPB, kk = row - b * KPB;
        const float x1 = bf2f(LAT[(size_t)row * 512 + 384 + e16]), x2 = bf2f(LAT[(size_t)row * 512 + 400 + e16]);
        float cs, sn;
        rope_cs(kk, e16, cs, sn);
        KRR[(size_t)row * 32 + e16] = f2bf(x1 * cs - x2 * sn);
        KRR[(size_t)row * 32 + 16 + e16] = f2bf(x2 * cs + x1 * sn);
      }
    }
  }
}

template <int MODE>
__device__ void attn_item(const Params& p, int l, int b, int h, int q0  ,
                          int ntiles  , int rs0, int ycol, u16* smem) {
  constexpr int DQK = MODE == 0 ? 96 : 64;
  constexpr int KSTR = DQK + 8;
  constexpr int NKS = DQK / 16;
  constexpr int CPR = DQK / 8;
  constexpr int NKC = 64 * CPR / 256;
  const int tid = ltid(), lane = tid & 63, wave = tid >> 6, r = lane & 31, hh = lane >> 5;
  u16* Ks = smem;
  u16* Vs = smem + 2 * 64 * KSTR;
  const unsigned char* wsb = p.ws;
  const int qk = q0 + wave * 32 + r;
  const size_t qrow = (size_t)b * KPB + qk;
  bf16x8 qf[NKS];
  {
    const u16* qp = MODE == 0 ? wsp<u16>(p, O_QM) + qrow * 768 + h * 96 : wsp<u16>(p, O_QNA) + qrow * 512 + h * 64;
#pragma unroll
    for (int ks = 0; ks < NKS; ks++) qf[ks] = *(const bf16x8*)(qp + ks * 16 + hh * 8);
  }
  const short one_or_zero = hh == 0 ? (short)0x3F80 : (short)0;
  const bf16x8 kone = {one_or_zero, 0, 0, 0, 0, 0, 0, 0};
  bf16x8 qm = {0, 0, 0, 0, 0, 0, 0, 0};
  int qr = 0, qc = 0, rsq = 0, cs = 0;
  const float* rpb = nullptr;
  if (MODE == 1 && rs0 >= 0) {
    const int tkn = qk - CTXL;
    qr = tkn >> 6;
    qc = tkn & 63;
    rsq = min(max(qr - 4, 0), 248);
    cs = min(max(qc - 8, 0), 48);
    rpb = p.rpb + ((size_t)(l * 8 + h)) * 15 * 31;
  }
  f32x16 o[2];
#pragma unroll
  for (int e = 0; e < 16; e++) { o[0][e] = 0.f; o[1][e] = 0.f; }
  float lsum = 0.f;
  float m = 0.f;
  const bf16x8 ones = {(short)0x3F80, (short)0x3F80, (short)0x3F80, (short)0x3F80,
                       (short)0x3F80, (short)0x3F80, (short)0x3F80, (short)0x3F80};

#define KGEO(i)                                                                                          \
  uint32_t kof##i, kmu##i;                                                                               \
  int kls##i;                                                                                            \
  {                                                                                                      \
    const int c = tid + 256 * (i);                                                                       \
    const int row = c / CPR, cc = c - row * CPR;                                                         \
    if (MODE == 0 && cc >= 8) {                                                                          \
      kof##i = (uint32_t)(O_KRR + ((size_t)(b * KPB + row) * 32 + (cc - 8) * 8) * 2);                    \
      kmu##i = 64u;                                                                                      \
    } else {                                                                                             \
      kof##i = (uint32_t)((MODE == 0 ? O_KN : O_KNA) + ((size_t)(b * KPB + row) * 512 + h * 64 + cc * 8) * 2); \
      kmu##i = 1024u;                                                                                    \
    }                                                                                                    \
    kls##i = row * KSTR + cc * 8;                                                                        \
  }
#define VGEO(i)                                                                                          \
  uint32_t vof##i;                                                                                       \
  int vls##i;                                                                                            \
  bool vsx##i;                                                                                           \
  {                                                                                                      \
    const int c = tid + 256 * (i);                                                                       \
    const int d = c >> 3, cc = c & 7;                                                                    \
    vof##i = (uint32_t)((MODE == 0 ? O_VMT : O_VNAT) + ((size_t)(b * 512 + h * 64 + d) * KPB + cc * 8) * 2); \
    vls##i = d * 72 + cc * 8;                                                                            \
    vsx##i = (d & 8) != 0;                                                                               \
  }
  KGEO(0) KGEO(1) KGEO(2) VGEO(0) VGEO(1)
  (void)kof2; (void)kmu2; (void)kls2;
  u32x4 kr0A, kr1A, kr2A, vr0A, vr1A, kr0B, kr1B, kr2B, vr0B, vr1B;
  kr2A = kr1A = kr0A = vr0A = vr1A = kr2B = kr1B = kr0B = vr0B = vr1B = (u32x4){0u, 0u, 0u, 0u};
#define TILE_KK0(t) ((MODE == 1 && (t) >= 4) ? (uint32_t)(CTXL + 64 * min(rs0 + (t)-4, 255)) : (uint32_t)(64 * (t)))
#define LOAD_KV(t, S)                                                                   \
  {                                                                                     \
    const uint32_t kk0_ = TILE_KK0(t);                                                  \
    kr0##S = *(const u32x4*)(wsb + (size_t)(kof0 + kk0_ * kmu0));                       \
    kr1##S = *(const u32x4*)(wsb + (size_t)(kof1 + kk0_ * kmu1));                       \
    if (NKC == 3) kr2##S = *(const u32x4*)(wsb + (size_t)(kof2 + kk0_ * kmu2));         \
    vr0##S = *(const u32x4*)(wsb + (size_t)(vof0 + kk0_ * 2u));                         \
    vr1##S = *(const u32x4*)(wsb + (size_t)(vof1 + kk0_ * 2u));                         \
  }
#define STORE_V1(buf, i, srcv)                                                          \
  {                                                                                     \
    u32x4 sv_ = srcv;                                                                   \
    if (vsx##i) sv_ = (u32x4){sv_[2], sv_[3], sv_[0], sv_[1]};                          \
    *(u32x4*)(Vs + (buf)*64 * 72 + vls##i) = sv_;                                       \
  }
#define STORE_KV(buf, S)                                                                \
  {                                                                                     \
    *(u32x4*)(Ks + (buf)*64 * KSTR + kls0) = kr0##S;                                    \
    *(u32x4*)(Ks + (buf)*64 * KSTR + kls1) = kr1##S;                                    \
    if (NKC == 3) *(u32x4*)(Ks + (buf)*64 * KSTR + kls2) = kr2##S;                      \
    STORE_V1(buf, 0, vr0##S) STORE_V1(buf, 1, vr1##S)                                   \
  }
#define QK_TILE(kbuf, t)                                                                           \
  {                                                                                                \
    const u16* kb_ = Ks + (kbuf)*64 * KSTR + r * KSTR + hh * 8;                                    \
    {                                                                                              \
      f32x16 z_;                                                                                   \
      _Pragma("unroll") for (int e = 0; e < 16; e++) z_[e] = 0.f;                                  \
      sc[0] = __builtin_amdgcn_mfma_f32_32x32x16_bf16(kone, qm, z_, 0, 0, 0);                      \
      sc[1] = sc[0];                                                                               \
    }                                                                                              \
    _Pragma("unroll") for (int ks = 0; ks < NKS; ks++) {                                           \
      const bf16x8 kf0 = *(const bf16x8*)(kb_ + ks * 16);                                          \
      const bf16x8 kf1 = *(const bf16x8*)(kb_ + 32 * KSTR + ks * 16);                              \
      sc[0] = __builtin_amdgcn_mfma_f32_32x32x16_bf16(kf0, qf[ks], sc[0], 0, 0, 0);                \
      sc[1] = __builtin_amdgcn_mfma_f32_32x32x16_bf16(kf1, qf[ks], sc[1], 0, 0, 0);                \
    }                                                                                              \
    if (MODE == 1 && (t) >= 4) {                                                                   \
      const int kr_ = rs0 + (t)-4;                                                                 \
      const bool rowok = (kr_ >= rsq) && (kr_ < rsq + 8);                                          \
      const float* rp = rpb + (kr_ - qr + 7) * 31 + (15 - qc);                                     \
      _Pragma("unroll") for (int kb = 0; kb < 2; kb++) _Pragma("unroll") for (int e = 0; e < 16; e++) { \
        const int kc = kb * 32 + (e & 3) + 8 * (e >> 2) + 4 * hh;                                  \
        const bool valid = rowok && (kc >= cs) && (kc < cs + 16);                                  \
        float bias = 0.f;                                                                          \
        if (valid) bias = rp[kc];                                                                  \
        sc[kb][e] = valid ? sc[kb][e] + bias * LOG2E : -1e30f;                                     \
      }                                                                                            \
    }                                                                                              \
  }
#define TILE_MAX(tmax)                                                                             \
  {                                                                                                \
    tmax = sc[0][0];                                                                               \
    _Pragma("unroll") for (int e = 1; e < 16; e++) tmax = fmaxf(tmax, sc[0][e]);                   \
    _Pragma("unroll") for (int e = 0; e < 16; e++) tmax = fmaxf(tmax, sc[1][e]);                   \
    const uint32_t tu = __float_as_uint(tmax);                                                     \
    const auto sw = __builtin_amdgcn_permlane32_swap(tu, tu, false, false);                        \
    tmax = fmaxf(__uint_as_float(sw[0]), __uint_as_float(sw[1]));                                  \
  }
#define MOVE_REF(mnew_)                                                                            \
  {                                                                                                \
    const float mq_ = bf2f(f2bf(mnew_));                                                           \
    const float delta_ = mq_ - m;                                                                  \
    const float alpha = __builtin_amdgcn_exp2f(-delta_);                                           \
    m = mq_;                                                                                       \
    _Pragma("unroll") for (int e = 0; e < 16; e++) {                                               \
      o[0][e] *= alpha; o[1][e] *= alpha;                                                         \
      sc[0][e] -= delta_; sc[1][e] -= delta_;                                                      \
    }                                                                                              \
    lsum *= alpha;                                                                                 \
    qm[0] = (hh == 0) ? (short)f2bf(-m) : (short)0;                                                \
  }
#define SOFTMAX_PV(vbuf)                                                                           \
  {                                                                                                \
    const u16* vb_ = Vs + (vbuf)*64 * 72 + r * 72 + vsw;                                           \
    _Pragma("unroll") for (int kb = 0; kb < 2; kb++) _Pragma("unroll") for (int st = 0; st < 2; st++) { \
      u32x4 pu;                                                                                    \
      _Pragma("unroll") for (int q = 0; q < 4; q++) {                                              \
        const float p0_ = __builtin_amdgcn_exp2f(sc[kb][8 * st + 2 * q]);                          \
        const float p1_ = __builtin_amdgcn_exp2f(sc[kb][8 * st + 2 * q + 1]);                      \
        lsum += p0_ + p1_;                                                                         \
        pu[q] = pack2(p0_, p1_);                                                                   \
      }                                                                                            \
      const bf16x8 pbv = __builtin_bit_cast(bf16x8, pu);                                           \
      _Pragma("unroll") for (int db = 0; db < 2; db++) {                                           \
        const u16* vp = vb_ + db * 32 * 72 + kb * 32 + 16 * st;                                    \
        const bf16x4 vlo = *(const bf16x4*)(vp);                                                   \
        const bf16x4 vhi = *(const bf16x4*)(vp + 8);                                               \
        const bf16x8 vfv = __builtin_shufflevector(vlo, vhi, 0, 1, 2, 3, 4, 5, 6, 7);              \
        o[db] = __builtin_amdgcn_mfma_f32_32x32x16_bf16(vfv, pbv, o[db], 0, 0, 0);                 \
      }                                                                                            \
    }                                                                                              \
  }
#define DEFER_REF(tmax)                                                                            \
  if (__any(tmax > 8.f)) {                                                                         \
    const float mq_ = bf2f(f2bf(m + fmaxf(tmax, 0.f)));                                            \
    const float alpha = __builtin_amdgcn_exp2f(m - mq_);                                           \
    m = mq_;                                                                                       \
    _Pragma("unroll") for (int e = 0; e < 16; e++) { o[0][e] *= alpha; o[1][e] *= alpha; }       \
    lsum *= alpha;                                                                                 \
    qm[0] = (hh == 0) ? (short)f2bf(-m) : (short)0;                                                \
  }
#define ATT_STEP(t, LD, ST)                                        \
  {                                                                \
    const int cur = (t)&1;                                         \
    LOAD_KV(min((t) + 2, tl), LD)                                  \
    __builtin_amdgcn_sched_barrier(0);                             \
    QK_TILE(cur, t)                                                \
    __builtin_amdgcn_s_setprio(1);                                 \
    SOFTMAX_PV(cur)                                                \
    __builtin_amdgcn_s_setprio(0);                                 \
    float tmax;                                                    \
    TILE_MAX(tmax)                                                 \
    DEFER_REF(tmax)                                                \
    STORE_KV(cur ^ 1, ST)                                          \
    __syncthreads();                                               \
  }

  const int tl = ntiles - 1;
  const int vsw = 4 * (hh ^ ((r >> 3) & 1));
  f32x16 sc[2];
  LOAD_KV(0, A)
  STORE_KV(0, A)
  LOAD_KV(min(1, tl), A)
  __syncthreads();
  {
    LOAD_KV(min(2, tl), B)
    __builtin_amdgcn_sched_barrier(0);
    QK_TILE(0, 0)
    float tmax;
    TILE_MAX(tmax)
    MOVE_REF(tmax)
    SOFTMAX_PV(0)
    STORE_KV(1, A)
    __syncthreads();
  }
  for (int t = 1; t + 1 < ntiles; t += 2) {
    ATT_STEP(t, A, B)
    ATT_STEP(t + 1, B, A)
  }
  ATT_STEP(tl, A, B)
  const float inv = 1.f / (lsum + __shfl_xor(lsum, 32));
  u16* yp = wsp<u16>(p, O_Y) + qrow * 1536 + ycol + h * 64;
#pragma unroll
  for (int db = 0; db < 2; db++)
#pragma unroll
    for (int g = 0; g < 4; g++) {
      uint2 ov;
      ov.x = pack2(o[db][4 * g] * inv, o[db][4 * g + 1] * inv);
      ov.y = pack2(o[db][4 * g + 2] * inv, o[db][4 * g + 3] * inv);
      *(uint2*)(yp + db * 32 + 8 * g + 4 * hh) = ov;
    }
#undef KGEO
#undef VGEO
#undef TILE_KK0
#undef LOAD_KV
#undef STORE_V1
#undef STORE_KV
#undef QK_TILE
#undef TILE_MAX
#undef MOVE_REF
#undef SOFTMAX_PV
#undef ATT_STEP
#undef DEFER_REF
}

__device__ void phase_p3(const Params& p, int l, bool last, int bid, int nb, u16* smem) {
  EPI_DECL
  const int nMLA = 2048, nNA = 2048, nFB = 1024;
  const int nC = last ? 0 : (32 + 32 + 16);
  const int total = nMLA + nNA + nFB + nC;
  for (int t = bid; t < total; t += nb) {
    int kind, b = 0, h = 0, q0 = 0, ntl = 0, rs0 = -1;
    size_t aoff = 0, boff = 0;
    int Kf = 256, j0 = 0, tok0 = 0, tokmul = 1, colbase = 0;
    if (t < nMLA) {
      kind = 0;
      h = t & 7;
      const int rest = t >> 3;
      b = rest >> 7;
      q0 = CTXL + (rest & 127) * 128;
      ntl = 260;
    } else if (t < nMLA + nNA) {
      kind = 1;
      const int t2 = t - nMLA;
      h = t2 & 7;
      const int rest = t2 >> 3, rp = rest & 127;
      b = rest >> 7;
      rs0 = min(max(2 * rp - 4, 0), 248);
      const int rs1 = min(max(2 * rp + 1 - 4, 0), 248);
      q0 = CTXL + rp * 128;
      ntl = (4 + (rs1 + 8 - rs0) + 1) & ~1;
    } else if (t < nMLA + nNA + nFB) {
      kind = 2;
      const int rt = t - nMLA - nNA;
      const int bk = rt >> 2;
      j0 = (rt & 3) * 128;
      b = bk >> 7;
      tok0 = CTXL + (bk & 127);
      tokmul = 128;
      aoff = O_D2 + (size_t)rt * 128 * 256 * 2;
      boff = O_MB;
      Kf = 256;
    } else {
      const int t2 = t - nMLA - nNA - nFB;
      if (t2 < 64) {
        kind = t2 >> 5;
        const int t3 = t2 & 31;
        h = t3 & 7;
        b = (t3 >> 3) & 1;
        q0 = (t3 >> 4) * 128;
        ntl = 4;
      } else {
        kind = 2;
        const int t3 = t2 - 64;
        const int rt = t3 >> 1, ct = t3 & 1;
        b = rt >> 2;
        j0 = (rt & 3) * 128;
        colbase = ct * 128;
        aoff = O_D1C + (size_t)rt * 128 * 512 * 2;
        boff = O_MC + (size_t)ct * 128 * 512 * 2;
        Kf = 512;
      }
    }
    if (kind == 0) {
      attn_item<0>(p, l, b, h, q0, ntl, -1, 1024, smem);
    } else if (kind == 1) {
      attn_item<1>(p, l, b, h, q0, ntl, rs0, 512, smem);
    } else {
      f32x16 acc[2][2];
      zero_acc(acc);
      gemm_core(acc, wsp<u16>(p, aoff), Kf, wsp<u16>(p, boff), Kf, Kf, smem);
      u16* Y = wsp<u16>(p, O_Y);
#pragma unroll
      for (int i = 0; i < 2; i++)
#pragma unroll
        for (int j = 0; j < 2; j++)
#pragma unroll
          for (int g = 0; g < 4; g++) {
            const int jj = j0 + wm_ * 64 + i * 32 + 8 * g + 4 * hh_;
            const int tok = tok0 + (colbase + wn_ * 64 + j * 32 + r_) * tokmul;
            uint2 ov;
            ov.x = pack2(acc[i][j][4 * g], acc[i][j][4 * g + 1]);
            ov.y = pack2(acc[i][j][4 * g + 2], acc[i][j][4 * g + 3]);
            *(uint2*)(Y + ((size_t)b * KPB + tok) * 1536 + jj) = ov;
          }
    }
  }
}

__device__ __forceinline__ int n_row_tiles(bool last) { return last ? NRT - 4 : NRT; }
__device__ __forceinline__ int row_tile(bool last, int i) {
  if (!last) return i;
  return i < 128 ? i + 2 : i + 4;
}

__device__ void phase_p4(const Params& p, int l, bool last, int bid, int nb, u16* smem) {
  EPI_DECL
  const u16* A = wsp<u16>(p, O_A);
  const u16* Y = wsp<u16>(p, O_Y);
  u16* M = wsp<u16>(p, O_M);
  uint4* stash = wsp<uint4>(p, O_QM) + (size_t)bid * 24 * 256 + ltid();
  const int nrt_ = n_row_tiles(last);
  PATCH_LOOP_BEGIN(nrt_, 8, 8, 8)
    const int rt = row_tile(last, prt), ct = pct;
    f32x16 mg[2][2];
    zero_acc(mg);
#pragma unroll 1
    for (int g = 0; g < 3; g++) {
      uint32_t gp[2][2][8];
      {
        f32x16 acc[2][2];
        zero_acc(acc);
        gemm_core<true>(acc, wsp<u16>(p, O_WG) + (size_t)(g * 1024 + ct * 128) * D, D, A + (size_t)rt * 128 * D, D, D,
                        smem);
#pragma unroll
        for (int i = 0; i < 2; i++)
#pragma unroll
          for (int j = 0; j < 2; j++)
#pragma unroll
            for (int e = 0; e < 8; e++)
              gp[i][j][e] = pack2(fsigmoid(acc[i][j][2 * e]), fsigmoid(acc[i][j][2 * e + 1]));
      }
      {
        f32x16 acc[2][2];
        zero_acc(acc);
        gemm_core<false>(acc, wsp<u16>(p, O_WB) + (size_t)(g * 1024 + ct * 128) * 512, 512,
                         Y + (size_t)rt * 128 * 1536 + g * 512, 1536, 512, smem);
#pragma unroll
        for (int i = 0; i < 2; i++)
#pragma unroll
          for (int j = 0; j < 2; j++)
#pragma unroll
            for (int e = 0; e < 8; e++) {
              mg[i][j][2 * e] += __uint_as_float(gp[i][j][e] << 16) * acc[i][j][2 * e];
              mg[i][j][2 * e + 1] += __uint_as_float(gp[i][j][e] & 0xffff0000u) * acc[i][j][2 * e + 1];
            }
      }
    }
#pragma unroll
    for (int i = 0; i < 2; i++)
#pragma unroll
      for (int j = 0; j < 2; j++)
#pragma unroll
        for (int g = 0; g < 4; g++) {
          const int row = rt * 128 + wn_ * 64 + j * 32 + r_;
          const int col = ct * 128 + wm_ * 64 + i * 32 + 8 * g + 4 * hh_;
          uint2 o;
          o.x = pack2(mg[i][j][4 * g], mg[i][j][4 * g + 1]);
          o.y = pack2(mg[i][j][4 * g + 2], mg[i][j][4 * g + 3]);
          *(uint2*)(M + (size_t)row * D + col) = o;
        }
  PATCH_LOOP_END
}

__device__ void phase_resid(const Params& p, int l, bool last, const u16* Ain, size_t lda, const u16* W, int K, int goff,
                            int bid, int nb, u16* smem) {
  EPI_DECL
  const float* mod = wsp<float>(p, O_MOD);
  const int nrt_ = n_row_tiles(last);
  PATCH_LOOP_BEGIN(nrt_, 8, 8, 8)
    const int rt = row_tile(last, prt), ct = pct;
    f32x16 acc[2][2];
    zero_acc(acc);
    gemm_core(acc, W + (size_t)ct * 128 * K, K, Ain + (size_t)rt * 128 * lda, lda, K, smem);
    const int row0 = rt * 128, b = row0 / KPB, kk0 = row0 - b * KPB;
    const int m = kk0 < CTXL ? 2 : b;
    float* xb = xrow(p, row0);
    const float* gv = mod + ((size_t)l * 3 + m) * 6144 + goff;
#pragma unroll
    for (int i = 0; i < 2; i++)
#pragma unroll
      for (int g = 0; g < 4; g++) {
        const int col = ct * 128 + wm_ * 64 + i * 32 + 8 * g + 4 * hh_;
        const float4 g4 = *(const float4*)(gv + col);
#pragma unroll
        for (int j = 0; j < 2; j++) {
          const int rl = wn_ * 64 + j * 32 + r_;
          float4* xp = (float4*)(xb + (size_t)rl * D + col);
          float4 xv = *xp;
          xv.x = ALPHA * xv.x + (1.f + g4.x) * acc[i][j][4 * g];
          xv.y = ALPHA * xv.y + (1.f + g4.y) * acc[i][j][4 * g + 1];
          xv.z = ALPHA * xv.z + (1.f + g4.z) * acc[i][j][4 * g + 2];
          xv.w = ALPHA * xv.w + (1.f + g4.w) * acc[i][j][4 * g + 3];
          *xp = xv;
        }
      }
  PATCH_LOOP_END
}

__device__ void phase_p7(const Params& p, int l, bool last, int bid, int nb, u16* smem) {
  EPI_DECL
  const u16* A = wsp<u16>(p, O_A);
  u16* HH = wsp<u16>(p, O_HH);
  const int nrt_ = n_row_tiles(last);
  PATCH_LOOP_BEGIN(nrt_, 44, 16, 4)
    const int rt = row_tile(last, prt), ct = pct;
    f32x16 acc[2][2];
    zero_acc(acc);
    gemm_core(acc, wsp<u16>(p, O_WGU) + (size_t)ct * 128 * D, D, A + (size_t)rt * 128 * D, D, D, smem);
#pragma unroll
    for (int j = 0; j < 2; j++)
#pragma unroll
      for (int g = 0; g < 4; g++) {
        const int row = rt * 128 + wn_ * 64 + j * 32 + r_;
        const int q = (ct * 2 + wm_) * 32 + 8 * g + 4 * hh_;
        float hv[4];
#pragma unroll
        for (int t = 0; t < 4; t++) {
          const float gt = acc[0][j][4 * g + t], up = acc[1][j][4 * g + t];
          hv[t] = gt * fsigmoid(gt) * up;
        }
        uint2 o;
        o.x = pack2(hv[0], hv[1]);
        o.y = pack2(hv[2], hv[3]);
        *(uint2*)(HH + (size_t)row * FH + q) = o;
      }
  PATCH_LOOP_END
}

constexpr int NPHASE = 3 + 9 * 2;

__device__ void run_phase(const Params& p, int ph, int bid, int nb, u16* smem) {
  if (ph == 0) {
    prep_tables(p, bid, nb);
    prep_modp(p, bid, nb);
    prep_weights(p, 0, bid, nb, smem);
    return;
  }
  if (ph == 1) { prep_modr(p, bid, nb); return; }
  if (ph == 2) { ln_phase(p, 0, p.ln_in_g, p.ln_in_b, 0, 0, 1024, false, bid, nb); return; }
  const int l = (ph - 3) / 9, s = (ph - 3) % 9;
  const bool last = (l == 1);
  switch (s) {
    case 0: phase_p1(p, l, last, bid, nb, smem); break;
    case 1: phase_p2(p, l, bid, nb, smem); break;
    case 2: phase_p3(p, l, last, bid, nb, smem); break;
    case 3: phase_p4(p, l, last, bid, nb, smem); break;
    case 4: phase_resid(p, l, last, wsp<u16>(p, O_M), D, wsp<u16>(p, O_WO), D, 2048, bid, nb, smem); break;
    case 5: ln_phase(p, 1, p.ln1_g + l * D, p.ln1_b + l * D, l, 3072, 4096, last, bid, nb); break;
    case 6: phase_p7(p, l, last, bid, nb, smem); break;
    case 7: phase_resid(p, l, last, wsp<u16>(p, O_HH), FH, wsp<u16>(p, O_WD), FH, 5120, bid, nb, smem); break;
    default:
      ln_phase(p, 1, p.ln2_g + l * D, p.ln2_b + l * D, last ? -1 : l + 1, 0, 1024, last, bid, nb);
      if (!last) prep_weights(p, l + 1, bid, nb, smem);
      break;
  }
}


#define XB_TMO      128
#define XB_XCNT(j)  (256  + 64 * (j))
#define XB_XSUB(j)  (1280 + 64 * (j))
#define XB_XGEN(j)  (2304 + 64 * (j))
#define XB_TOP      3328
#define XB_TOPGEN   3392
#define XCD_BAR_WORDS 3456
#define XB_SPIN_CAP (1u << 20)
#define LAS __attribute__((address_space(3)))
__device__ __forceinline__ unsigned xb_ld(unsigned* p) { return __hip_atomic_load(p, __ATOMIC_RELAXED, __HIP_MEMORY_SCOPE_AGENT); }
__device__ __forceinline__ unsigned xb_add(unsigned* p, unsigned v) { return __hip_atomic_fetch_add(p, v, __ATOMIC_RELAXED, __HIP_MEMORY_SCOPE_AGENT); }
__device__ __forceinline__ unsigned xb_xcc_id() { return (unsigned)__builtin_amdgcn_s_getreg((3 << 11) | 20) & 0xFu; }
#define XB_SPIN(cond, bar) do { unsigned _sp = 0; while (cond) { __builtin_amdgcn_s_sleep(1); \
    if ((++_sp & 255u) == 0u) { if (xb_ld(&(bar)[XB_TMO])) break; if (_sp > XB_SPIN_CAP) { atomicAdd(&(bar)[XB_TMO], 1u); break; } } } } while (0)
struct XcdBarrier {
  unsigned* bar; unsigned x;
  volatile LAS unsigned* st;
};
__device__ __forceinline__ XcdBarrier xcd_barrier_post(unsigned* bar, volatile LAS unsigned* st) {
  XcdBarrier b; b.bar = bar; b.x = xb_xcc_id(); b.st = st;
  if (threadIdx.x == 0) (void)xb_add(&bar[XB_XCNT(b.x)], 1u);
  return b;
}
__device__ __forceinline__ void xcd_barrier_complete(unsigned* bar, unsigned x, unsigned& nloc, unsigned& nx) {
  const unsigned G = gridDim.x * gridDim.y * gridDim.z;
  unsigned sum, cnt, mine, sp = 0u;
  for (;;) {
    sum = 0u; cnt = 0u; mine = 0u;
#pragma unroll
    for (unsigned j = 0; j < 16; ++j) { const unsigned c = xb_ld(&bar[XB_XCNT(j)]); sum += c; cnt += (c > 0u) ? 1u : 0u; mine = (j == x) ? c : mine; }
    if (sum == G) break;
    __builtin_amdgcn_s_sleep(1);
    if ((++sp & 255u) == 0u) { if (xb_ld(&bar[XB_TMO])) break; if (sp > XB_SPIN_CAP) { atomicAdd(&bar[XB_TMO], 1u); break; } }
  }
  nloc = mine > 0u ? mine : 1u; nx = cnt > 0u ? cnt : 1u;
}
__device__ __forceinline__ void xcd_barrier(const XcdBarrier& b) {
  asm volatile("s_waitcnt vmcnt(0)" ::: "memory");
  __syncthreads();
  if (threadIdx.x == 0) {
    unsigned* bar = b.bar;
    __builtin_amdgcn_s_waitcnt(0);
    unsigned nloc = b.st[0], nx = b.st[1];
    if (nloc == 0u) { xcd_barrier_complete(bar, b.x, nloc, nx); b.st[0] = nloc; b.st[1] = nx; }
    const unsigned old = xb_add(&bar[XB_XSUB(b.x)], 1u);
    const unsigned gen = old / nloc;
    if (old + 1u == (gen + 1u) * nloc) {
      __builtin_amdgcn_fence(__ATOMIC_RELEASE, "agent");
      asm volatile("s_waitcnt vmcnt(0)" ::: "memory");
      const unsigned og = xb_add(&bar[XB_TOP], 1u);
      const unsigned tg = og / nx;
      if (og + 1u == (tg + 1u) * nx) xb_add(&bar[XB_TOPGEN], 1u);
      else XB_SPIN(xb_ld(&bar[XB_TOPGEN]) == tg, bar);
      __builtin_amdgcn_fence(__ATOMIC_ACQUIRE, "agent");
      xb_add(&bar[XB_XGEN(b.x)], 1u);
      asm volatile("s_waitcnt vmcnt(0)" ::: "memory");
    } else {
      XB_SPIN(xb_ld(&bar[XB_XGEN(b.x)]) == gen, bar);
      __builtin_amdgcn_fence(__ATOMIC_ACQUIRE, "agent");
      asm volatile("s_waitcnt vmcnt(0)" ::: "memory");
    }
  }
  __syncthreads();
}

constexpr int SMEM_ELEMS = 4 * SM_A + 256 + 8;

#if COOP
__global__ void __launch_bounds__(256, 2) mega_kernel(Params p) {
  __shared__ __attribute__((aligned(16))) u16 smem[SMEM_ELEMS];
  cg::grid_group grid = cg::this_grid();
  volatile LAS unsigned* st = (volatile LAS unsigned*)(smem + 4 * SM_A + 256);
  if (threadIdx.x == 0) { st[0] = 0u; st[1] = 0u; }
  __syncthreads();
  XcdBarrier xb = xcd_barrier_post((unsigned*)(p.ws + O_BAR), st);
  for (int ph = 0; ph < NPHASE; ph++) {
#ifdef PROBE_MASK
    const int s9 = ph >= 3 ? (ph - 3) % 9 : -1;
    const int nrep = (s9 >= 0 && ((PROBE_MASK >> s9) & 1)) ? 2 : 1;
    for (int rep = 0; rep < nrep; rep++) {
      run_phase(p, ph, blockIdx.x, gridDim.x, smem);
      if (ph == 0) grid.sync();
      else if (ph + 1 < NPHASE || rep + 1 < nrep) xcd_barrier(xb);
    }
#else
    run_phase(p, ph, blockIdx.x, gridDim.x, smem);
    if (ph == 0) grid.sync();
    else if (ph + 1 < NPHASE) xcd_barrier(xb);
#endif
  }
}
#else
__global__ void __launch_bounds__(256, 2) phase_kernel(Params p, int ph) {
  __shared__ __attribute__((aligned(16))) u16 smem[SMEM_ELEMS];
  run_phase(p, ph, blockIdx.x, gridDim.x, smem);
}
#endif

extern "C" void kernel_launch(void* const* d_in, const int* in_sizes, int n_in, void* d_out, int out_size, void* d_ws,
                              size_t ws_size, hipStream_t stream) {
  Params p{};
  const float** f = (const float**)&p;
  for (int i = 0; i < 25; i++) f[i] = (const float*)d_in[i];
  p.out = (float*)d_out;
  p.ws = (unsigned char*)d_ws;
  if (ws_size < O_WSEND) fprintf(stderr, "workspace too small: %zu < %zu\n", ws_size, (size_t)O_WSEND);
#if COOP
  static int grid_blocks = 0;
  if (!grid_blocks) {
    int dev = 0, cus = 0, per_cu = 0;
    hipGetDevice(&dev);
    hipDeviceGetAttribute(&cus, hipDeviceAttributeMultiprocessorCount, dev);
    hipOccupancyMaxActiveBlocksPerMultiprocessor(&per_cu, mega_kernel, 256, 0);
    if (per_cu > 2) per_cu = 2;
    grid_blocks = cus * per_cu;
  }
  (void)hipMemsetAsync(p.ws + O_BAR, 0, 3456 * 4, stream);
  void* args[] = {&p};
  hipError_t e = hipLaunchCooperativeKernel((void*)mega_kernel, dim3(grid_blocks), dim3(256), args, 0, stream);
  if (e != hipSuccess) fprintf(stderr, "cooperative launch failed: %s (grid %d)\n", hipGetErrorString(e), grid_blocks);
#else
  for (int ph = 0; ph < NPHASE; ph++) phase_kernel<<<512, 256, 0, stream>>>(p, ph);
#endif
}
```

```cpp
#include <hip/hip_runtime.h>
#include <hip/hip_cooperative_groups.h>
#include <stdint.h>
#include <cstdio>
namespace cg = cooperative_groups;

#ifndef COOP
#define COOP 1
#endif

typedef __attribute__((ext_vector_type(8))) short bf16x8;
typedef __attribute__((ext_vector_type(4))) short bf16x4;
typedef __attribute__((ext_vector_type(16))) float f32x16;
typedef unsigned short u16;
typedef __attribute__((ext_vector_type(4))) unsigned int u32x4;

constexpr int D = 1024;
constexpr int NBATCH = 2;
constexpr int SEQ = 16384;
constexpr int CTXL = 256;
constexpr int KPB = SEQ + CTXL;
constexpr int T = NBATCH * KPB;
constexpr int NRT = T / 128;
constexpr int FH = 2816;
constexpr int IN_DIM = 5536;
constexpr float LOG2E = 1.4426950408889634f;
constexpr float NA_SCALE_L2 = 0.125f * LOG2E;
constexpr float MLA_SCALE_L2 = 0.10206207261596575f * LOG2E;
constexpr float ALPHA = 1.4142135623730951f;
constexpr float EPS = 1e-5f;
constexpr float RS128 = 0.08838834764831845f;

constexpr size_t al256(size_t x) { return (x + 255) & ~(size_t)255; }
constexpr size_t O_WF = 0;
constexpr size_t O_WP = O_WF + (size_t)1024 * 1024 * 2;
constexpr size_t O_WG = O_WP + (size_t)2048 * 1024 * 2;
constexpr size_t O_WUQ = O_WG + (size_t)3072 * 1024 * 2;
constexpr size_t O_WUKV = O_WUQ + (size_t)768 * 256 * 2;
constexpr size_t O_WB = O_WUKV + (size_t)1024 * 128 * 2;
constexpr size_t O_WO = O_WB + (size_t)3 * 1024 * 512 * 2;
constexpr size_t O_WGU = O_WO + (size_t)1024 * 1024 * 2;
constexpr size_t O_WD = O_WGU + (size_t)5632 * 1024 * 2;
constexpr size_t O_MA = O_WD + (size_t)1024 * 2816 * 2;
constexpr size_t O_MB = O_MA + (size_t)256 * 256 * 2;
constexpr size_t O_MC = O_MB + (size_t)128 * 256 * 2;
constexpr size_t O_TW = O_MC + (size_t)256 * 512 * 2;
constexpr size_t O_MODP = O_TW + (size_t)128 * 128 * 2 * 4;
constexpr size_t O_MOD = O_MODP + (size_t)16 * 2 * 3 * 6144 * 4;
constexpr size_t O_XCTX = O_MOD + (size_t)2 * 3 * 6144 * 4;
constexpr size_t O_D1C = O_XCTX + (size_t)512 * 1024 * 4;
constexpr size_t O_A = O_D1C + (size_t)2 * 512 * 2 * 256 * 2;
constexpr size_t O_RQ = O_A + (size_t)T * 1024 * 2;
constexpr size_t O_QNA = O_RQ;
constexpr size_t O_KNA = O_QNA + (size_t)T * 512 * 2;
constexpr size_t O_VNAT = O_KNA + (size_t)T * 512 * 2;
constexpr size_t O_RY = O_VNAT + (size_t)T * 512 * 2;
constexpr size_t O_Y = O_RY;
constexpr size_t O_D1 = O_RY;
constexpr size_t O_LAT = O_RY + (size_t)67108864;
constexpr size_t O_D2 = O_RY + (size_t)T * 1536 * 2;
constexpr size_t O_QM = O_D2 + (size_t)67108864;
constexpr size_t O_KN = O_QM + (size_t)T * 768 * 2;
constexpr size_t O_KRR = O_KN + (size_t)T * 512 * 2;
constexpr size_t O_VMT = O_KRR + (size_t)T * 32 * 2;
constexpr size_t O_END = O_VMT + (size_t)T * 512 * 2;
constexpr size_t O_BAR = (O_END + 255) & ~(size_t)255;
constexpr size_t O_WSEND = O_BAR + 3456 * 4;
constexpr size_t O_M = O_RQ;
constexpr size_t O_HH = O_RQ;

struct Params {
  const float *x, *c, *ctx, *c_ctx, *ln_in_g, *ln_in_b, *w_mod, *b_mod, *w_in, *gq, *gkv, *w_uq, *w_qr, *w_uk,
      *w_uv, *rpb, *w_branch, *w_out, *ln1_g, *ln1_b, *ln2_g, *ln2_b, *w_gate, *w_up, *w_down;
  float* out;
  unsigned char* ws;
};

__device__ __forceinline__ u16 f2bf(float f) {
  uint32_t u = __float_as_uint(f);
  u += 0x7fffu + ((u >> 16) & 1u);
  return (u16)(u >> 16);
}
typedef __attribute__((ext_vector_type(2))) __bf16 bf16v2;
typedef __attribute__((ext_vector_type(2))) float f32v2;
__device__ __forceinline__ uint32_t pack2(float a, float b) {
  const f32v2 v = {a, b};
  return __builtin_bit_cast(uint32_t, __builtin_convertvector(v, bf16v2));
}
__device__ __forceinline__ float bf2f(u16 v) { return __uint_as_float(((uint32_t)v) << 16); }
__device__ __forceinline__ float wsum(float v) {
#pragma unroll
  for (int o = 32; o > 0; o >>= 1) v += __shfl_xor(v, o);
  return v;
}
__device__ __forceinline__ float fsigmoid(float v) { return 1.f / (1.f + __expf(-v)); }

__device__ __forceinline__ int ltid() {
  int t = threadIdx.x;
  asm volatile("" : "+v"(t));
  return t;
}

template <typename Tp>
__device__ __forceinline__ Tp* wsp(const Params& p, size_t off) { return (Tp*)(p.ws + off); }

__device__ __forceinline__ float* xrow(const Params& p, int row) {
  int b = row / KPB, kk = row - b * KPB;
  if (kk < CTXL) return wsp<float>(p, O_XCTX) + (size_t)(b * CTXL + kk) * D;
  return p.out + (size_t)(b * SEQ + kk - CTXL) * D;
}

constexpr int LSTR = 72;
constexpr int SM_A = 128 * LSTR;

template <bool DEEP = true>
__device__ __forceinline__ void gemm_core(f32x16 (&acc)[2][2], const u16* __restrict__ A, size_t lda,
                                          const u16* __restrict__ B, size_t ldb, int K, u16* smem) {
  const int tid = ltid(), lane = tid & 63, wave = tid >> 6;
  const int wm = wave >> 1, wn = wave & 1, r = lane & 31, hh = lane >> 5;
  u16* sA = smem;
  u16* sB = smem + 2 * SM_A;
  const int lrow = tid >> 3, lkc = (tid & 7) * 8;
  const u16* ga = A + (size_t)lrow * lda + lkc;
  const u16* gb = B + (size_t)lrow * ldb + lkc;
  u16* wa = sA + lrow * LSTR + lkc;
  u16* wb = sB + lrow * LSTR + lkc;
  const u16* pa = sA + (wm * 64 + r) * LSTR + hh * 8;
  const u16* pb = sB + (wn * 64 + r) * LSTR + hh * 8;
  u32x4 a0r[4], b0r[4], a1r[4], b1r[4];
#define G_LOAD(ar, br, ko)                                               \
  _Pragma("unroll") for (int i = 0; i < 4; i++) {                        \
    ar[i] = *(const u32x4*)(ga + (size_t)(32 * i) * lda + (ko));         \
    br[i] = *(const u32x4*)(gb + (size_t)(32 * i) * ldb + (ko));         \
  }
#define G_STORE(ar, br, buf)                                             \
  _Pragma("unroll") for (int i = 0; i < 4; i++) {                        \
    *(u32x4*)(wa + (buf)*SM_A + 32 * i * LSTR) = ar[i];                  \
    *(u32x4*)(wb + (buf)*SM_A + 32 * i * LSTR) = br[i];                  \
  }
#define G_COMPUTE(buf)                                                                   \
  _Pragma("unroll") for (int ks = 0; ks < 4; ks++) {                                     \
    const bf16x8 fa0 = *(const bf16x8*)(pa + (buf)*SM_A + ks * 16);                      \
    const bf16x8 fa1 = *(const bf16x8*)(pa + (buf)*SM_A + 32 * LSTR + ks * 16);          \
    const bf16x8 fb0 = *(const bf16x8*)(pb + (buf)*SM_A + ks * 16);                      \
    const bf16x8 fb1 = *(const bf16x8*)(pb + (buf)*SM_A + 32 * LSTR + ks * 16);          \
    acc[0][0] = __builtin_amdgcn_mfma_f32_32x32x16_bf16(fa0, fb0, acc[0][0], 0, 0, 0);   \
    acc[0][1] = __builtin_amdgcn_mfma_f32_32x32x16_bf16(fa0, fb1, acc[0][1], 0, 0, 0);   \
    acc[1][0] = __builtin_amdgcn_mfma_f32_32x32x16_bf16(fa1, fb0, acc[1][0], 0, 0, 0);   \
    acc[1][1] = __builtin_amdgcn_mfma_f32_32x32x16_bf16(fa1, fb1, acc[1][1], 0, 0, 0);   \
  }
  const int nk = K >> 6;
  if (DEEP) {
    G_LOAD(a0r, b0r, 0)
    G_LOAD(a1r, b1r, 64)
    G_STORE(a0r, b0r, 0)
    __syncthreads();
    const int klast = (nk - 1) * 64;
    G_LOAD(a0r, b0r, min(128, klast))
    for (int kt = 0; kt < nk; kt += 2) {
      G_COMPUTE(0)
      G_STORE(a1r, b1r, 1)
      __syncthreads();
      G_LOAD(a1r, b1r, min((kt + 3) * 64, klast))
      __builtin_amdgcn_sched_barrier(0);
      G_COMPUTE(1)
      G_STORE(a0r, b0r, 0)
      __syncthreads();
      G_LOAD(a0r, b0r, min((kt + 4) * 64, klast))
      __builtin_amdgcn_sched_barrier(0);
    }
  } else {
    G_LOAD(a0r, b0r, 0)
    G_STORE(a0r, b0r, 0)
    __syncthreads();
    for (int kt = 0; kt < nk; kt += 2) {
      G_LOAD(a0r, b0r, (kt + 1) * 64)
      G_COMPUTE(0)
      G_STORE(a0r, b0r, 1)
      __syncthreads();
      if (kt + 2 < nk) G_LOAD(a0r, b0r, (kt + 2) * 64)
      G_COMPUTE(1)
      if (kt + 2 < nk) G_STORE(a0r, b0r, 0)
      __syncthreads();
    }
  }
#undef G_LOAD
#undef G_STORE
#undef G_COMPUTE
}

__device__ __forceinline__ void zero_acc(f32x16 (&acc)[2][2]) {
#pragma unroll
  for (int i = 0; i < 2; i++)
#pragma unroll
    for (int j = 0; j < 2; j++)
#pragma unroll
      for (int e = 0; e < 16; e++) acc[i][j][e] = 0.f;
}

#define EPI_DECL                                                     \
  const int lane_ = ltid() & 63, wave_ = ltid() >> 6;      \
  const int wm_ = wave_ >> 1, wn_ = wave_ & 1, r_ = lane_ & 31, hh_ = lane_ >> 5; \
  (void)wm_; (void)wn_; (void)r_; (void)hh_;

__device__ __forceinline__ const float* src_col(const Params& p, int l, int kind, int n, int& ld) {
  switch (kind) {
    case 0:
      ld = IN_DIM;
      return n < 1952 ? p.w_in + (size_t)l * D * IN_DIM + 512 + n : nullptr;
    case 1:
      ld = IN_DIM;
      return p.w_in + (size_t)l * D * IN_DIM + 2464 + n;
    case 2:
      if (n < 512) {
        ld = 512;
        return p.w_uq + (size_t)l * 256 * 512 + n;
      } else {
        int m = n - 512, wt = m >> 6, jb = (m >> 5) & 1, idx = wt * 32 + (m & 31);
        int h = idx >> 4, e = idx & 15;
        ld = 256;
        return p.w_qr + (size_t)l * 256 * 256 + h * 32 + jb * 16 + e;
      }
    case 3:
      ld = 512;
      return n < 512 ? p.w_uk + (size_t)l * 128 * 512 + n : p.w_uv + (size_t)l * 128 * 512 + (n - 512);
    case 4: {
      int g = n >> 10, nn = n & 1023;
      ld = 1024;
      return p.w_branch + ((size_t)(l * 3 + g) * 512) * 1024 + nn;
    }
    case 5:
      ld = 1024;
      return p.w_out + (size_t)l * D * D + n;
    case 6: {
      int jb = (n >> 5) & 1, q = (n >> 6) * 32 + (n & 31);
      ld = FH;
      return (jb ? p.w_up : p.w_gate) + (size_t)l * D * FH + q;
    }
    default:
      ld = 1024;
      return p.w_down + (size_t)l * FH * D + n;
  }
}

__device__ __forceinline__ int job_nd(int k) {
  switch (k) { case 0: return 2048; case 1: return 3072; case 2: return 768; case 3: return 1024; case 4: return 3072;
    case 5: return 1024; case 6: return 5632; default: return 1024; }
}
__device__ __forceinline__ int job_kd(int k) {
  switch (k) { case 0: return 1024; case 1: return 1024; case 2: return 256; case 3: return 128; case 4: return 512;
    case 5: return 1024; case 6: return 1024; default: return 2816; }
}
__device__ __forceinline__ size_t job_od(int k) {
  switch (k) { case 0: return O_WP; case 1: return O_WG; case 2: return O_WUQ; case 3: return O_WUKV; case 4: return O_WB;
    case 5: return O_WO; case 6: return O_WGU; default: return O_WD; }
}
__device__ void prep_weights(const Params& p, int l, int bid, int nb, u16* smem) {
  float* tile = (float*)smem;
  const int tid = ltid();
  int start = 0;
#pragma unroll 1
  for (int kind = 0; kind < 8; kind++) {
    const int Kk = job_kd(kind);
    const int nkt = Kk >> 6, ntile = (job_nd(kind) >> 6) * nkt;
    u16* dst = wsp<u16>(p, job_od(kind));
    const float* ksc = kind == 2 ? p.gq + l * 256 : (kind == 3 ? p.gkv + l * 128 : nullptr);
    for (int t = (bid + nb - (start % nb)) % nb; t < ntile; t += nb) {
      const int nt = t / nkt, kt = t - nt * nkt;
      const int n0 = nt * 64, k0 = kt * 64;
      {
        const int kq = tid >> 4, nn4 = (tid & 15) * 4;
        int ld;
        const float* sp = src_col(p, l, kind, n0 + nn4, ld);
#pragma unroll
        for (int i = 0; i < 4; i++) {
          const int kk = i * 16 + kq;
          float4 v = make_float4(0.f, 0.f, 0.f, 0.f);
          if (sp) v = *(const float4*)(sp + (size_t)(k0 + kk) * ld);
          if (ksc) {
            const float sc = ksc[k0 + kk];
            v.x *= sc; v.y *= sc; v.z *= sc; v.w *= sc;
          }
          float* tp = tile + kk * 65 + nn4;
          tp[0] = v.x; tp[1] = v.y; tp[2] = v.z; tp[3] = v.w;
        }
      }
      __syncthreads();
#pragma unroll
      for (int i = 0; i < 2; i++) {
        const int c = tid + 256 * i;
        const int nn = c >> 3, kc = (c & 7) * 8;
        const float* tp = tile + kc * 65 + nn;
        uint4 o;
        o.x = pack2(tp[0], tp[65]);
        o.y = pack2(tp[2 * 65], tp[3 * 65]);
        o.z = pack2(tp[4 * 65], tp[5 * 65]);
        o.w = pack2(tp[6 * 65], tp[7 * 65]);
        *(uint4*)(dst + (size_t)(n0 + nn) * Kk + k0 + kc) = o;
      }
      __syncthreads();
    }
    start += ntile;
  }
  {
    float* ctab = (float*)smem;
    __syncthreads();
    if (tid < 128) ctab[tid] = cospif((float)tid * (1.f / 64.f));
    __syncthreads();
    u16* dst = wsp<u16>(p, O_WF);
    for (int it = bid; it < 512; it += nb) {
      const int o = it * 256 + tid;
      const int np = o & 1023, k8 = (o >> 10) * 8;
      const int reim = np >> 9, g = (np >> 7) & 3, m = np & 127;
      const float* w = p.w_in + (size_t)l * D * IN_DIM + (size_t)k8 * IN_DIM + g * 128;
      const int sh = reim ? 96 : 0;
      float a8[8];
#pragma unroll
      for (int j = 0; j < 8; j++) a8[j] = 0.f;
#pragma unroll 4
      for (int c = 0; c < 128; c++) {
        const float tw = ctab[(m * c + sh) & 127];
#pragma unroll
        for (int j = 0; j < 8; j++) a8[j] += w[(size_t)j * IN_DIM + c] * tw;
      }
      uint4 ov;
      ov.x = pack2(a8[0] * RS128, a8[1] * RS128);
      ov.y = pack2(a8[2] * RS128, a8[3] * RS128);
      ov.z = pack2(a8[4] * RS128, a8[5] * RS128);
      ov.w = pack2(a8[6] * RS128, a8[7] * RS128);
      *(uint4*)(dst + (size_t)np * 1024 + k8) = ov;
    }
    __syncthreads();
  }
}

__device__ void prep_tables(const Params& p, int bid, int nb) {
  u16* MA = wsp<u16>(p, O_MA);
  u16* MB = wsp<u16>(p, O_MB);
  u16* MC = wsp<u16>(p, O_MC);
  float* TW = wsp<float>(p, O_TW);
  const int total = 65536 + 32768 + 131072 + 16384;
  for (int idx = bid * 256 + ltid(); idx < total; idx += nb * 256) {
    if (idx < 65536) {
      const int n = idx >> 8, k = idx & 255;
      const int nt = n >> 7, wn = (n >> 6) & 1, jb = (n >> 5) & 1, klo = nt * 64 + wn * 32 + (n & 31);
      const int ri = k >> 7, nhi = k & 127;
      const int xx = (klo * nhi) & 127;
      const float c = cospif((float)xx * (1.f / 64.f)), s = sinpif((float)xx * (1.f / 64.f));
      float v = jb == 0 ? (ri == 0 ? c : -s) : (ri == 0 ? -s : -c);
      MA[idx] = f2bf(v * RS128);
    } else if (idx < 65536 + 32768) {
      const int i2 = idx - 65536;
      const int khi = i2 >> 8, k = i2 & 255;
      const int ri = k >> 7, nlo = k & 127;
      const int xx = (khi * nlo) & 127;
      const float c = cospif((float)xx * (1.f / 64.f)), s = sinpif((float)xx * (1.f / 64.f));
      MB[i2] = f2bf((ri == 0 ? c : s) * RS128);
    } else if (idx < 65536 + 32768 + 131072) {
      const int i2 = idx - 65536 - 32768;
      const int kk = i2 >> 9, k = i2 & 511;
      const int ri = k >> 8, nn = k & 255;
      const int xx = (kk * nn) & 255;
      const float c = cospif((float)xx * (1.f / 128.f)), s = sinpif((float)xx * (1.f / 128.f));
      MC[i2] = f2bf((ri == 0 ? c : -s) * 0.0625f);
    } else {
      const int i2 = idx - 65536 - 32768 - 131072;
      const int klo = i2 >> 7, nlo = i2 & 127;
      const int xx = klo * nlo;
      TW[i2 * 2] = cospif((float)xx * (1.f / 8192.f));
      TW[i2 * 2 + 1] = sinpif((float)xx * (1.f / 8192.f));
    }
  }
}

__device__ void prep_modp(const Params& p, int bid, int nb) {
  float* modp = wsp<float>(p, O_MODP);
  for (int it = bid; it < 2 * 16 * 24; it += nb) {
    const int l = it / (16 * 24), rem = it - l * 16 * 24, kc = rem / 24, nblk = rem - kc * 24;
    const int n = nblk * 256 + ltid();
    const float* w = p.w_mod + (size_t)l * D * 6144 + n;
    float a0 = 0.f, a1 = 0.f, a2 = 0.f;
#pragma unroll 8
    for (int kk = 0; kk < 64; kk++) {
      const int k = kc * 64 + kk;
      const float wv = w[(size_t)k * 6144];
      float c0 = p.c[k], c1 = p.c[1024 + k], c2 = p.c_ctx[k];
      c0 = c0 / (1.f + __expf(-c0));
      c1 = c1 / (1.f + __expf(-c1));
      c2 = c2 / (1.f + __expf(-c2));
      a0 += c0 * wv;
      a1 += c1 * wv;
      a2 += c2 * wv;
    }
    float* o = modp + ((size_t)(kc * 2 + l) * 3) * 6144 + n;
    o[0] = a0;
    o[6144] = a1;
    o[2 * 6144] = a2;
  }
}
__device__ void prep_modr(const Params& p, int bid, int nb) {
  const float* modp = wsp<float>(p, O_MODP);
  float* mod = wsp<float>(p, O_MOD);
  for (int idx = bid * 256 + ltid(); idx < 2 * 3 * 6144; idx += nb * 256) {
    const int l = idx / (3 * 6144), n = idx % 6144;
    float v = p.b_mod[l * 6144 + n];
    for (int kc = 0; kc < 16; kc++) v += modp[(size_t)kc * 2 * 3 * 6144 + idx];
    mod[idx] = v;
  }
}

__device__ void ln_phase(const Params& p, int mode, const float* g, const float* bta, int lmod, int shoff, int scoff,
                         bool skip_ctx, int bid, int nb) {
  const int lane = ltid() & 63, wave = ltid() >> 6;
  u16* A = wsp<u16>(p, O_A);
  const float* mod = wsp<float>(p, O_MOD);
  for (int row = bid * 4 + wave; row < T; row += nb * 4) {
    const int b = row / KPB, kk = row - b * KPB;
    if (skip_ctx && kk < CTXL) continue;
    float* xr = xrow(p, row);
    const float* src;
    if (mode == 0)
      src = kk < CTXL ? p.ctx + (size_t)(b * CTXL + kk) * D : p.x + (size_t)(b * SEQ + kk - CTXL) * D;
    else
      src = xr;
    float4 v[4];
    float s = 0.f;
#pragma unroll
    for (int i = 0; i < 4; i++) {
      v[i] = *(const float4*)(src + i * 256 + lane * 4);
      s += v[i].x + v[i].y + v[i].z + v[i].w;
    }
    const float mu = wsum(s) * (1.f / 1024.f);
    float q = 0.f;
#pragma unroll
    for (int i = 0; i < 4; i++) {
      v[i].x -= mu; v[i].y -= mu; v[i].z -= mu; v[i].w -= mu;
      q += v[i].x * v[i].x + v[i].y * v[i].y + v[i].z * v[i].z + v[i].w * v[i].w;
    }
    const float rstd = rsqrtf(wsum(q) * (1.f / 1024.f) + EPS);
    const int m = kk < CTXL ? 2 : b;
    const float* md = mod + ((size_t)(lmod < 0 ? 0 : lmod) * 3 + m) * 6144;
#pragma unroll
    for (int i = 0; i < 4; i++) {
      const int c0 = i * 256 + lane * 4;
      const float4 gg = *(const float4*)(g + c0), bb = *(const float4*)(bta + c0);
      float4 y;
      y.x = v[i].x * rstd * gg.x + bb.x;
      y.y = v[i].y * rstd * gg.y + bb.y;
      y.z = v[i].z * rstd * gg.z + bb.z;
      y.w = v[i].w * rstd * gg.w + bb.w;
      *(float4*)(xr + c0) = y;
      if (lmod >= 0) {
        const float4 sh = *(const float4*)(md + shoff + c0), sc = *(const float4*)(md + scoff + c0);
        uint2 o;
        o.x = pack2(y.x * (1.f + sc.x) + sh.x, y.y * (1.f + sc.y) + sh.y);
        o.y = pack2(y.z * (1.f + sc.z) + sh.z, y.w * (1.f + sc.w) + sh.w);
        *(uint2*)(A + (size_t)row * D + c0) = o;
      }
    }
  }
}

#define PATCH_LOOP_BEGIN(NR_, NC_, PR_, PC_)                                   \
  {                                                                            \
    const int x_ = bid & 7, w_ = bid >> 3, nbx_ = nb >> 3;                     \
    const int CG_ = ((NC_) + (PC_)-1) / (PC_);                                 \
    const int npatch_ = (((NR_) + (PR_)-1) / (PR_)) * CG_;                     \
    for (int u_ = w_;; u_ += nbx_) {                                           \
      const int g_ = (u_ >> 6) * 8 + x_;                                       \
      if (g_ >= npatch_) break;                                                \
      const int s_ = u_ & 63;                                                  \
      const int rg_ = g_ / CG_;                                                \
      const int prt = rg_ * (PR_) + s_ / (PC_);                                \
      const int pct = (g_ - rg_ * CG_) * (PC_) + s_ % (PC_);                   \
      if (prt >= (NR_) || pct >= (NC_)) continue;
#define PATCH_LOOP_END \
    }                  \
  }

__device__ void phase_p1(const Params& p, int l, bool last, int bid, int nb, u16* smem) {
  EPI_DECL
  const u16* A = wsp<u16>(p, O_A);
  PATCH_LOOP_BEGIN(NRT, 16, 8, 8)
    f32x16 acc[2][2];
    zero_acc(acc);
    {
      const int rt = prt, ct = pct;
      const int row0 = rt * 128, b = row0 / KPB, kk0 = row0 - b * KPB;
      if (ct < 8 || ct >= 12) {
        gemm_core(acc, wsp<u16>(p, O_WP) + (size_t)ct * 128 * D, D, A + (size_t)rt * 128 * D, D, D, smem);
        u16* dst;
        float sc = 1.f;
        int cb;
        if (ct < 4) { dst = wsp<u16>(p, O_QNA); sc = NA_SCALE_L2; cb = ct * 128; }
        else if (ct < 8) { dst = wsp<u16>(p, O_KNA); cb = (ct - 4) * 128; }
        else { dst = wsp<u16>(p, O_LAT); cb = (ct - 12) * 128; }
#pragma unroll
        for (int i = 0; i < 2; i++)
#pragma unroll
          for (int j = 0; j < 2; j++)
#pragma unroll
            for (int g = 0; g < 4; g++) {
              const int row = row0 + wn_ * 64 + j * 32 + r_;
              const int col = cb + wm_ * 64 + i * 32 + 8 * g + 4 * hh_;
              uint2 o;
              o.x = pack2(acc[i][j][4 * g] * sc, acc[i][j][4 * g + 1] * sc);
              o.y = pack2(acc[i][j][4 * g + 2] * sc, acc[i][j][4 * g + 3] * sc);
              *(uint2*)(dst + (size_t)row * 512 + col) = o;
            }
      } else {
        gemm_core(acc, A + (size_t)rt * 128 * D, D, wsp<u16>(p, O_WP) + (size_t)ct * 128 * D, D, D, smem);
        u16* dst = wsp<u16>(p, O_VNAT);
        const int cb = (ct - 8) * 128;
#pragma unroll
        for (int i = 0; i < 2; i++)
#pragma unroll
          for (int j = 0; j < 2; j++)
#pragma unroll
            for (int g = 0; g < 4; g++) {
              const int kk = kk0 + wm_ * 64 + i * 32 + 8 * g + 4 * hh_;
              const int col = cb + wn_ * 64 + j * 32 + r_;
              uint2 o;
              o.x = pack2(acc[i][j][4 * g], acc[i][j][4 * g + 1]);
              o.y = pack2(acc[i][j][4 * g + 2], acc[i][j][4 * g + 3]);
              *(uint2*)(dst + ((size_t)(b * 512 + col)) * KPB + kk) = o;
            }
      }
    }
  PATCH_LOOP_END
  PATCH_LOOP_BEGIN(256, 8, 8, 8)
    f32x16 acc[2][2];
    zero_acc(acc);
    {
      const int rt = prt, ct = pct;
      const int b = rt >> 7, nlo = rt & 127;
      gemm_core(acc, A + (size_t)(b * KPB + CTXL + nlo) * D, (size_t)128 * D,
                wsp<u16>(p, O_WF) + (size_t)ct * 128 * D, D, D, smem);
      u16* dst = wsp<u16>(p, O_D1);
#pragma unroll
      for (int i = 0; i < 2; i++)
#pragma unroll
        for (int j = 0; j < 2; j++)
#pragma unroll
          for (int g = 0; g < 4; g++) {
            const int nhi = wm_ * 64 + i * 32 + 8 * g + 4 * hh_;
            const int n = ct * 128 + wn_ * 64 + j * 32 + r_;
            const int reim = n >> 9, jj = n & 511;
            uint2 o;
            o.x = pack2(acc[i][j][4 * g], acc[i][j][4 * g + 1]);
            o.y = pack2(acc[i][j][4 * g + 2], acc[i][j][4 * g + 3]);
            *(uint2*)(dst + ((((size_t)(b * 512 + jj)) * 128 + nlo) * 2 + reim) * 128 + nhi) = o;
          }
    }
  PATCH_LOOP_END
  if (!last) {
    for (int t2 = bid; t2 < 32; t2 += nb) {
      f32x16 acc[2][2];
      zero_acc(acc);
      const int rt = t2 >> 3, ct = t2 & 7;
      const int b = rt >> 1, rb = rt & 1;
      gemm_core(acc, A + (size_t)(b * KPB + rb * 128) * D, D, wsp<u16>(p, O_WF) + (size_t)ct * 128 * D, D, D, smem);
      u16* dst = wsp<u16>(p, O_D1C);
#pragma unroll
      for (int i = 0; i < 2; i++)
#pragma unroll
        for (int j = 0; j < 2; j++)
#pragma unroll
          for (int g = 0; g < 4; g++) {
            const int nc = rb * 128 + wm_ * 64 + i * 32 + 8 * g + 4 * hh_;
            const int n = ct * 128 + wn_ * 64 + j * 32 + r_;
            const int reim = n >> 9, jj = n & 511;
            uint2 o;
            o.x = pack2(acc[i][j][4 * g], acc[i][j][4 * g + 1]);
            o.y = pack2(acc[i][j][4 * g + 2], acc[i][j][4 * g + 3]);
            *(uint2*)(dst + (((size_t)(b * 512 + jj)) * 2 + reim) * 256 + nc) = o;
          }
    }
  }
}

__device__ __forceinline__ float inv_freq(int i) {
  switch (i) {
    case 0: return 1.0f;
    case 1: return 0.31622776601683794f;
    case 2: return 0.1f;
    case 3: return 0.03162277660168379f;
    case 4: return 0.01f;
    case 5: return 0.0031622776601683794f;
    case 6: return 0.001f;
    default: return 0.00031622776601683794f;
  }
}
__device__ __forceinline__ void rope_cs(int kk, int e, float& cs, float& sn) {
  if (kk < CTXL) { cs = 1.f; sn = 0.f; return; }
  const int tkn = kk - CTXL;
  const float pos = (e < 8) ? (float)(tkn >> 6) : (float)(tkn & 63);
  const float ang = pos * inv_freq(e & 7);
  double xr = (double)ang * 0.31830988618379067;
  xr -= 2.0 * floor(xr * 0.5);
  const float yr = (float)xr;
  cs = cospif(yr);
  sn = sinpif(yr);
}

__device__ __forceinline__ void row_rms(const u16* A, size_t lda, int K, float* rs) {
  const int tid = ltid();
  const int row = tid >> 1, half = tid & 1;
  const u16* pr = A + (size_t)row * lda + half * (K >> 1);
  float s = 0.f;
  for (int c = 0; c < (K >> 1); c += 8) {
    uint4 v = *(const uint4*)(pr + c);
    const uint32_t w[4] = {v.x, v.y, v.z, v.w};
#pragma unroll
    for (int q = 0; q < 4; q++) {
      const float a = __uint_as_float(w[q] << 16), bq = __uint_as_float(w[q] & 0xffff0000u);
      s += a * a + bq * bq;
    }
  }
  s += __shfl_xor(s, 1);
  if (half == 0) rs[row] = rsqrtf(s / (float)K + EPS);
  __syncthreads();
}

__device__ void phase_p2(const Params& p, int l, int bid, int nb, u16* smem) {
  EPI_DECL
  const u16* LAT = wsp<u16>(p, O_LAT);
  float* rs = (float*)(smem + 4 * SM_A);
  const int nQ = NRT * 6, nKV = NRT * 8, nFA = 1024 * 2, nKR = NRT;
  const int total = nQ + nKV + nFA + nKR;
  for (int t = bid; t < total; t += nb) {
    if (t < nQ) {
      const int rt = t / 6, ct = t - rt * 6;
      const int row0 = rt * 128, b = row0 / KPB, kk0 = row0 - b * KPB;
      row_rms(LAT + (size_t)row0 * 512, 512, 256, rs);
      f32x16 acc[2][2];
      zero_acc(acc);
      gemm_core(acc, wsp<u16>(p, O_WUQ) + (size_t)ct * 128 * 256, 256, LAT + (size_t)row0 * 512, 512, 256, smem);
      u16* QM = wsp<u16>(p, O_QM);
      if (ct < 4) {
#pragma unroll
        for (int i = 0; i < 2; i++)
#pragma unroll
          for (int j = 0; j < 2; j++)
#pragma unroll
            for (int g = 0; g < 4; g++) {
              const int rl = wn_ * 64 + j * 32 + r_;
              const int col = ct * 128 + wm_ * 64 + i * 32 + 8 * g + 4 * hh_;
              const int h = col >> 6, d = col & 63;
              const float sc = rs[rl] * MLA_SCALE_L2;
              uint2 o;
              o.x = pack2(acc[i][j][4 * g] * sc, acc[i][j][4 * g + 1] * sc);
              o.y = pack2(acc[i][j][4 * g + 2] * sc, acc[i][j][4 * g + 3] * sc);
              *(uint2*)(QM + (size_t)(row0 + rl) * 768 + h * 96 + d) = o;
            }
      } else {
        const int wt = (ct - 4) * 2 + wm_;
#pragma unroll
        for (int j = 0; j < 2; j++) {
          const int rl = wn_ * 64 + j * 32 + r_;
          const float sc = rs[rl] * MLA_SCALE_L2;
#pragma unroll
          for (int g = 0; g < 4; g++) {
            const int idx = wt * 32 + 8 * g + 4 * hh_;
            const int h = idx >> 4, e16 = idx & 15;
            float o1[4], o2[4];
#pragma unroll
            for (int q = 0; q < 4; q++) {
              float cs, sn;
              rope_cs(kk0 + rl, e16 + q, cs, sn);
              const float x1 = acc[0][j][4 * g + q] * sc, x2 = acc[1][j][4 * g + q] * sc;
              o1[q] = x1 * cs - x2 * sn;
              o2[q] = x2 * cs + x1 * sn;
            }
            u16* qd = QM + (size_t)(row0 + rl) * 768 + h * 96 + 64 + e16;
            uint2 o;
            o.x = pack2(o1[0], o1[1]);
            o.y = pack2(o1[2], o1[3]);
            *(uint2*)qd = o;
            o.x = pack2(o2[0], o2[1]);
            o.y = pack2(o2[2], o2[3]);
            *(uint2*)(qd + 16) = o;
          }
        }
      }
      __syncthreads();
    } else if (t < nQ + nKV) {
      const int t2 = t - nQ;
      const int rt = t2 >> 3, ct = t2 & 7;
      const int row0 = rt * 128, b = row0 / KPB, kk0 = row0 - b * KPB;
      row_rms(LAT + (size_t)row0 * 512 + 256, 512, 128, rs);
      f32x16 acc[2][2];
      zero_acc(acc);
      if (ct < 4) {
        gemm_core(acc, wsp<u16>(p, O_WUKV) + (size_t)ct * 128 * 128, 128, LAT + (size_t)row0 * 512 + 256, 512, 128,
                  smem);
        u16* KN = wsp<u16>(p, O_KN);
#pragma unroll
        for (int i = 0; i < 2; i++)
#pragma unroll
          for (int j = 0; j < 2; j++)
#pragma unroll
            for (int g = 0; g < 4; g++) {
              const int rl = wn_ * 64 + j * 32 + r_;
              const int col = ct * 128 + wm_ * 64 + i * 32 + 8 * g + 4 * hh_;
              const float sc = rs[rl];
              uint2 o;
              o.x = pack2(acc[i][j][4 * g] * sc, acc[i][j][4 * g + 1] * sc);
              o.y = pack2(acc[i][j][4 * g + 2] * sc, acc[i][j][4 * g + 3] * sc);
              *(uint2*)(KN + (size_t)(row0 + rl) * 512 + col) = o;
            }
      } else {
        gemm_core(acc, LAT + (size_t)row0 * 512 + 256, 512, wsp<u16>(p, O_WUKV) + (size_t)ct * 128 * 128, 128, 128,
                  smem);
        u16* VMT = wsp<u16>(p, O_VMT);
#pragma unroll
        for (int i = 0; i < 2; i++)
#pragma unroll
          for (int j = 0; j < 2; j++)
#pragma unroll
            for (int g = 0; g < 4; g++) {
              const int rl = wm_ * 64 + i * 32 + 8 * g + 4 * hh_;
              const int col = (ct - 4) * 128 + wn_ * 64 + j * 32 + r_;
              uint2 o;
              o.x = pack2(acc[i][j][4 * g] * rs[rl], acc[i][j][4 * g + 1] * rs[rl + 1]);
              o.y = pack2(acc[i][j][4 * g + 2] * rs[rl + 2], acc[i][j][4 * g + 3] * rs[rl + 3]);
              *(uint2*)(VMT + ((size_t)(b * 512 + col)) * KPB + kk0 + rl) = o;
            }
      }
      __syncthreads();
    } else if (t < nQ + nKV + nFA) {
      const int t2 = t - nQ - nKV;
      const int rt = t2 >> 1, ct = t2 & 1;
      const int b = rt >> 9, jj = rt & 511;
      f32x16 acc[2][2];
      zero_acc(acc);
      gemm_core(acc, wsp<u16>(p, O_D1) + (size_t)rt * 128 * 256, 256, wsp<u16>(p, O_MA) + (size_t)ct * 128 * 256, 256,
                256, smem);
      const float* TW = wsp<float>(p, O_TW);
      u16* D2 = wsp<u16>(p, O_D2);
      const int klo = ct * 64 + wn_ * 32 + r_;
#pragma unroll
      for (int i = 0; i < 2; i++)
#pragma unroll
        for (int g = 0; g < 4; g++) {
          const int nlo = wm_ * 64 + i * 32 + 8 * g + 4 * hh_;
          float re[4], im[4];
#pragma unroll
          for (int q = 0; q < 4; q++) {
            const float2 tw = *(const float2*)(TW + ((size_t)klo * 128 + nlo + q) * 2);
            const float ar = acc[i][0][4 * g + q], ai = acc[i][1][4 * g + q];
            re[q] = ar * tw.x + ai * tw.y;
            im[q] = ai * tw.x - ar * tw.y;
          }
          u16* d = D2 + ((((size_t)(b * 128 + klo)) * 512 + jj) * 2) * 128 + nlo;
          uint2 o;
          o.x = pack2(re[0], re[1]);
          o.y = pack2(re[2], re[3]);
          *(uint2*)d = o;
          o.x = pack2(im[0], im[1]);
          o.y = pack2(im[2], im[3]);
          *(uint2*)(d + 128) = o;
        }
    } else {
      const int rt = t - nQ - nKV - nFA;
      u16* KRR = wsp<u16>(p, O_KRR);
      for (int idx = ltid(); idx < 128 * 16; idx += 256) {
        const int rl = idx >> 4, e16 = idx & 15;
        const int row = rt * 128 + rl, b = row / KPB, kk = row - b * KPB;
        const float x1 = bf2f(LAT[(size_t)row * 512 + 384 + e16]), x2 = bf2f(LAT[(size_t)row * 512 + 400 + e16]);
        float cs, sn;
        rope_cs(kk, e16, cs, sn);
        KRR[(size_t)row * 32 + e16] = f2bf(x1 * cs - x2 * sn);
        KRR[(size_t)row * 32 + 16 + e16] = f2bf(x2 * cs + x1 * sn);
      }
    }
  }
}

template <int MODE>
__device__ void attn_item(const Params& p, int l, int b, int h, int q0  ,
                          int ntiles  , int rs0, int ycol, u16* smem) {
  constexpr int DQK = MODE == 0 ? 96 : 64;
  constexpr int KSTR = DQK + 8;
  constexpr int NKS = DQK / 16;
  constexpr int CPR = DQK / 8;
  constexpr int NKC = 64 * CPR / 256;
  const int tid = ltid(), lane = tid & 63, wave = tid >> 6, r = lane & 31, hh = lane >> 5;
  u16* Ks = smem;
  u16* Vs = smem + 2 * 64 * KSTR;
  const unsigned char* wsb = p.ws;
  const int qk = q0 + wave * 32 + r;
  const size_t qrow = (size_t)b * KPB + qk;
  bf16x8 qf[NKS];
  {
    const u16* qp = MODE == 0 ? wsp<u16>(p, O_QM) + qrow * 768 + h * 96 : wsp<u16>(p, O_QNA) + qrow * 512 + h * 64;
#pragma unroll
    for (int ks = 0; ks < NKS; ks++) qf[ks] = *(const bf16x8*)(qp + ks * 16 + hh * 8);
  }
  const short one_or_zero = hh == 0 ? (short)0x3F80 : (short)0;
  const bf16x8 kone = {one_or_zero, 0, 0, 0, 0, 0, 0, 0};
  bf16x8 qm = {0, 0, 0, 0, 0, 0, 0, 0};
  int qr = 0, qc = 0, rsq = 0, cs = 0;
  const float* rpb = nullptr;
  if (MODE == 1 && rs0 >= 0) {
    const int tkn = qk - CTXL;
    qr = tkn >> 6;
    qc = tkn & 63;
    rsq = min(max(qr - 4, 0), 248);
    cs = min(max(qc - 8, 0), 48);
    rpb = p.rpb + ((size_t)(l * 8 + h)) * 15 * 31;
  }
  f32x16 o[2];
#pragma unroll
  for (int e = 0; e < 16; e++) { o[0][e] = 0.f; o[1][e] = 0.f; }
  float lsum = 0.f;
  float m = 0.f;
  const bf16x8 ones = {(short)0x3F80, (short)0x3F80, (short)0x3F80, (short)0x3F80,
                       (short)0x3F80, (short)0x3F80, (short)0x3F80, (short)0x3F80};

#define KGEO(i)                                                                                          \
  uint32_t kof##i, kmu##i;                                                                               \
  int kls##i;                                                                                            \
  {                                                                                                      \
    const int c = tid + 256 * (i);                                                                       \
    const int row = c / CPR, cc = c - row * CPR;                                                         \
    if (MODE == 0 && cc >= 8) {                                                                          \
      kof##i = (uint32_t)(O_KRR + ((size_t)(b * KPB + row) * 32 + (cc - 8) * 8) * 2);                    \
      kmu##i = 64u;                                                                                      \
    } else {                                                                                             \
      kof##i = (uint32_t)((MODE == 0 ? O_KN : O_KNA) + ((size_t)(b * KPB + row) * 512 + h * 64 + cc * 8) * 2); \
      kmu##i = 1024u;                                                                                    \
    }                                                                                                    \
    kls##i = row * KSTR + cc * 8;                                                                        \
  }
#define VGEO(i)                                                                                          \
  uint32_t vof##i;                                                                                       \
  int vls##i;                                                                                            \
  bool vsx##i;                                                                                           \
  {                                                                                                      \
    const int c = tid + 256 * (i);                                                                       \
    const int d = c >> 3, cc = c & 7;                                                                    \
    vof##i = (uint32_t)((MODE == 0 ? O_VMT : O_VNAT) + ((size_t)(b * 512 + h * 64 + d) * KPB + cc * 8) * 2); \
    vls##i = d * 72 + cc * 8;                                                                            \
    vsx##i = (d & 8) != 0;                                                                               \
  }
  KGEO(0) KGEO(1) KGEO(2) VGEO(0) VGEO(1)
  (void)kof2; (void)kmu2; (void)kls2;
  u32x4 kr0A, kr1A, kr2A, vr0A, vr1A, kr0B, kr1B, kr2B, vr0B, vr1B;
  kr2A = kr1A = kr0A = vr0A = vr1A = kr2B = kr1B = kr0B = vr0B = vr1B = (u32x4){0u, 0u, 0u, 0u};
#define TILE_KK0(t) ((MODE == 1 && (t) >= 4) ? (uint32_t)(CTXL + 64 * min(rs0 + (t)-4, 255)) : (uint32_t)(64 * (t)))
#define LOAD_KV(t, S)                                                                   \
  {                                                                                     \
    const uint32_t kk0_ = TILE_KK0(t);                                                  \
    kr0##S = *(const u32x4*)(wsb + (size_t)(kof0 + kk0_ * kmu0));                       \
    kr1##S = *(const u32x4*)(wsb + (size_t)(kof1 + kk0_ * kmu1));                       \
    if (NKC == 3) kr2##S = *(const u32x4*)(wsb + (size_t)(kof2 + kk0_ * kmu2));         \
    vr0##S = *(const u32x4*)(wsb + (size_t)(vof0 + kk0_ * 2u));                         \
    vr1##S = *(const u32x4*)(wsb + (size_t)(vof1 + kk0_ * 2u));                         \
  }
#define STORE_V1(buf, i, srcv)                                                          \
  {                                                                                     \
    u32x4 sv_ = srcv;                                                                   \
    if (vsx##i) sv_ = (u32x4){sv_[2], sv_[3], sv_[0], sv_[1]};                          \
    *(u32x4*)(Vs + (buf)*64 * 72 + vls##i) = sv_;                                       \
  }
#define STORE_KV(buf, S)                                                                \
  {                                                                                     \
    *(u32x4*)(Ks + (buf)*64 * KSTR + kls0) = kr0##S;                                    \
    *(u32x4*)(Ks + (buf)*64 * KSTR + kls1) = kr1##S;                                    \
    if (NKC == 3) *(u32x4*)(Ks + (buf)*64 * KSTR + kls2) = kr2##S;                      \
    STORE_V1(buf, 0, vr0##S) STORE_V1(buf, 1, vr1##S)                                   \
  }
#define QK_TILE(kbuf, t)                                                                           \
  {                                                                                                \
    const u16* kb_ = Ks + (kbuf)*64 * KSTR + r * KSTR + hh * 8;                                    \
    {                                                                                              \
      f32x16 z_;                                                                                   \
      _Pragma("unroll") for (int e = 0; e < 16; e++) z_[e] = 0.f;                                  \
      sc[0] = __builtin_amdgcn_mfma_f32_32x32x16_bf16(kone, qm, z_, 0, 0, 0);                      \
      sc[1] = sc[0];                                                                               \
    }                                                                                              \
    _Pragma("unroll") for (int ks = 0; ks < NKS; ks++) {                                           \
      const bf16x8 kf0 = *(const bf16x8*)(kb_ + ks * 16);                                          \
      const bf16x8 kf1 = *(const bf16x8*)(kb_ + 32 * KSTR + ks * 16);                              \
      sc[0] = __builtin_amdgcn_mfma_f32_32x32x16_bf16(kf0, qf[ks], sc[0], 0, 0, 0);                \
      sc[1] = __builtin_amdgcn_mfma_f32_32x32x16_bf16(kf1, qf[ks], sc[1], 0, 0, 0);                \
    }                                                                                              \
    if (MODE == 1 && (t) >= 4) {                                                                   \
      const int kr_ = rs0 + (t)-4;                                                                 \
      const bool rowok = (kr_ >= rsq) && (kr_ < rsq + 8);                                          \
      const float* rp = rpb + (kr_ - qr + 7) * 31 + (15 - qc);                                     \
      _Pragma("unroll") for (int kb = 0; kb < 2; kb++) _Pragma("unroll") for (int e = 0; e < 16; e++) { \
        const int kc = kb * 32 + (e & 3) + 8 * (e >> 2) + 4 * hh;                                  \
        const bool valid = rowok && (kc >= cs) && (kc < cs + 16);                                  \
        float bias = 0.f;                                                                          \
        if (valid) bias = rp[kc];                                                                  \
        sc[kb][e] = valid ? sc[kb][e] + bias * LOG2E : -1e30f;                                     \
      }                                                                                            \
    }                                                                                              \
  }
#define TILE_MAX(tmax)                                                                             \
  {                                                                                                \
    tmax = sc[0][0];                                                                               \
    _Pragma("unroll") for (int e = 1; e < 16; e++) tmax = fmaxf(tmax, sc[0][e]);                   \
    _Pragma("unroll") for (int e = 0; e < 16; e++) tmax = fmaxf(tmax, sc[1][e]);                   \
    const uint32_t tu = __float_as_uint(tmax);                                                     \
    const auto sw = __builtin_amdgcn_permlane32_swap(tu, tu, false, false);                        \
    tmax = fmaxf(__uint_as_float(sw[0]), __uint_as_float(sw[1]));                                  \
  }
#define MOVE_REF(mnew_)                                                                            \
  {                                                                                                \
    const float mq_ = bf2f(f2bf(mnew_));                                                           \
    const float delta_ = mq_ - m;                                                                  \
    const float alpha = __builtin_amdgcn_exp2f(-delta_);                                           \
    m = mq_;                                                                                       \
    _Pragma("unroll") for (int e = 0; e < 16; e++) {                                               \
      o[0][e] *= alpha; o[1][e] *= alpha;                                                         \
      sc[0][e] -= delta_; sc[1][e] -= delta_;                                                      \
    }                                                                                              \
    lsum *= alpha;                                                                                 \
    qm[0] = (hh == 0) ? (short)f2bf(-m) : (short)0;                                                \
  }
#define SOFTMAX_PV(vbuf)                                                                           \
  {                                                                                                \
    const u16* vb_ = Vs + (vbuf)*64 * 72 + r * 72 + vsw;                                           \
    _Pragma("unroll") for (int kb = 0; kb < 2; kb++) _Pragma("unroll") for (int st = 0; st < 2; st++) { \
      u32x4 pu;                                                                                    \
      _Pragma("unroll") for (int q = 0; q < 4; q++) {                                              \
        const float p0_ = __builtin_amdgcn_exp2f(sc[kb][8 * st + 2 * q]);                          \
        const float p1_ = __builtin_amdgcn_exp2f(sc[kb][8 * st + 2 * q + 1]);                      \
        lsum += p0_ + p1_;                                                                         \
        pu[q] = pack2(p0_, p1_);                                                                   \
      }                                                                                            \
      const bf16x8 pbv = __builtin_bit_cast(bf16x8, pu);                                           \
      _Pragma("unroll") for (int db = 0; db < 2; db++) {                                           \
        const u16* vp = vb_ + db * 32 * 72 + kb * 32 + 16 * st;                                    \
        const bf16x4 vlo = *(const bf16x4*)(vp);                                                   \
        const bf16x4 vhi = *(const bf16x4*)(vp + 8);                                               \
        const bf16x8 vfv = __builtin_shufflevector(vlo, vhi, 0, 1, 2, 3, 4, 5, 6, 7);              \
        o[db] = __builtin_amdgcn_mfma_f32_32x32x16_bf16(vfv, pbv, o[db], 0, 0, 0);                 \
      }                                                                                            \
    }                                                                                              \
  }
#define DEFER_REF(tmax)                                                                            \
  if (__any(tmax > 8.f)) {                                                                         \
    const float mq_ = bf2f(f2bf(m + fmaxf(tmax, 0.f)));                                            \
    const float alpha = __builtin_amdgcn_exp2f(m - mq_);                                           \
    m = mq_;                                                                                       \
    _Pragma("unroll") for (int e = 0; e < 16; e++) { o[0][e] *= alpha; o[1][e] *= alpha; }       \
    lsum *= alpha;                                                                                 \
    qm[0] = (hh == 0) ? (short)f2bf(-m) : (short)0;                                                \
  }
#define ATT_STEP(t, LD, ST)                                        \
  {                                                                \
    const int cur = (t)&1;                                         \
    QK_TILE(cur, t)                                                \
    __builtin_amdgcn_sched_barrier(0);                             \
    LOAD_KV(min((t) + 2, tl), LD)                                  \
    __builtin_amdgcn_sched_barrier(0);                             \
    __builtin_amdgcn_s_setprio(1);                                 \
    SOFTMAX_PV(cur)                                                \
    __builtin_amdgcn_s_setprio(0);                                 \
    float tmax;                                                    \
    TILE_MAX(tmax)                                                 \
    DEFER_REF(tmax)                                                \
    STORE_KV(cur ^ 1, ST)                                          \
    __syncthreads();                                               \
  }

  const int tl = ntiles - 1;
  const int vsw = 4 * (hh ^ ((r >> 3) & 1));
  f32x16 sc[2];
  LOAD_KV(0, A)
  STORE_KV(0, A)
  LOAD_KV(min(1, tl), A)
  __syncthreads();
  {
    LOAD_KV(min(2, tl), B)
    __builtin_amdgcn_sched_barrier(0);
    QK_TILE(0, 0)
    float tmax;
    TILE_MAX(tmax)
    MOVE_REF(tmax)
    SOFTMAX_PV(0)
    STORE_KV(1, A)
    __syncthreads();
  }
  for (int t = 1; t + 1 < ntiles; t += 2) {
    ATT_STEP(t, A, B)
    ATT_STEP(t + 1, B, A)
  }
  ATT_STEP(tl, A, B)
  const float inv = 1.f / (lsum + __shfl_xor(lsum, 32));
  u16* yp = wsp<u16>(p, O_Y) + qrow * 1536 + ycol + h * 64;
#pragma unroll
  for (int db = 0; db < 2; db++)
#pragma unroll
    for (int g = 0; g < 4; g++) {
      uint2 ov;
      ov.x = pack2(o[db][4 * g] * inv, o[db][4 * g + 1] * inv);
      ov.y = pack2(o[db][4 * g + 2] * inv, o[db][4 * g + 3] * inv);
      *(uint2*)(yp + db * 32 + 8 * g + 4 * hh) = ov;
    }
#undef KGEO
#undef VGEO
#undef TILE_KK0
#undef LOAD_KV
#undef STORE_V1
#undef STORE_KV
#undef QK_TILE
#undef TILE_MAX
#undef MOVE_REF
#undef SOFTMAX_PV
#undef ATT_STEP
#undef DEFER_REF
}

__device__ void phase_p3(const Params& p, int l, bool last, int bid, int nb, u16* smem) {
  EPI_DECL
  const int nMLA = 2048, nNA = 2048, nFB = 1024;
  const int nC = last ? 0 : (32 + 32 + 16);
  const int total = nMLA + nNA + nFB + nC;
  for (int t = bid; t < total; t += nb) {
    int kind, b = 0, h = 0, q0 = 0, ntl = 0, rs0 = -1;
    size_t aoff = 0, boff = 0;
    int Kf = 256, j0 = 0, tok0 = 0, tokmul = 1, colbase = 0;
    if (t < nMLA) {
      kind = 0;
      h = t & 7;
      const int rest = t >> 3;
      b = rest >> 7;
      q0 = CTXL + (rest & 127) * 128;
      ntl = 260;
    } else if (t < nMLA + nNA) {
      kind = 1;
      const int t2 = t - nMLA;
      h = t2 & 7;
      const int rest = t2 >> 3, rp = rest & 127;
      b = rest >> 7;
      rs0 = min(max(2 * rp - 4, 0), 248);
      const int rs1 = min(max(2 * rp + 1 - 4, 0), 248);
      q0 = CTXL + rp * 128;
      ntl = (4 + (rs1 + 8 - rs0) + 1) & ~1;
    } else if (t < nMLA + nNA + nFB) {
      kind = 2;
      const int rt = t - nMLA - nNA;
      const int bk = rt >> 2;
      j0 = (rt & 3) * 128;
      b = bk >> 7;
      tok0 = CTXL + (bk & 127);
      tokmul = 128;
      aoff = O_D2 + (size_t)rt * 128 * 256 * 2;
      boff = O_MB;
      Kf = 256;
    } else {
      const int t2 = t - nMLA - nNA - nFB;
      if (t2 < 64) {
        kind = t2 >> 5;
        const int t3 = t2 & 31;
        h = t3 & 7;
        b = (t3 >> 3) & 1;
        q0 = (t3 >> 4) * 128;
        ntl = 4;
      } else {
        kind = 2;
        const int t3 = t2 - 64;
        const int rt = t3 >> 1, ct = t3 & 1;
        b = rt >> 2;
        j0 = (rt & 3) * 128;
        colbase = ct * 128;
        aoff = O_D1C + (size_t)rt * 128 * 512 * 2;
        boff = O_MC + (size_t)ct * 128 * 512 * 2;
        Kf = 512;
      }
    }
    if (kind == 0) {
      attn_item<0>(p, l, b, h, q0, ntl, -1, 1024, smem);
    } else if (kind == 1) {
      attn_item<1>(p, l, b, h, q0, ntl, rs0, 512, smem);
    } else {
      f32x16 acc[2][2];
      zero_acc(acc);
      gemm_core(acc, wsp<u16>(p, aoff), Kf, wsp<u16>(p, boff), Kf, Kf, smem);
      u16* Y = wsp<u16>(p, O_Y);
#pragma unroll
      for (int i = 0; i < 2; i++)
#pragma unroll
        for (int j = 0; j < 2; j++)
#pragma unroll
          for (int g = 0; g < 4; g++) {
            const int jj = j0 + wm_ * 64 + i * 32 + 8 * g + 4 * hh_;
            const int tok = tok0 + (colbase + wn_ * 64 + j * 32 + r_) * tokmul;
            uint2 ov;
            ov.x = pack2(acc[i][j][4 * g], acc[i][j][4 * g + 1]);
            ov.y = pack2(acc[i][j][4 * g + 2], acc[i][j][4 * g + 3]);
            *(uint2*)(Y + ((size_t)b * KPB + tok) * 1536 + jj) = ov;
          }
    }
  }
}

__device__ __forceinline__ int n_row_tiles(bool last) { return last ? NRT - 4 : NRT; }
__device__ __forceinline__ int row_tile(bool last, int i) {
  if (!last) return i;
  return i < 128 ? i + 2 : i + 4;
}

__device__ void phase_p4(const Params& p, int l, bool last, int bid, int nb, u16* smem) {
  EPI_DECL
  const u16* A = wsp<u16>(p, O_A);
  const u16* Y = wsp<u16>(p, O_Y);
  u16* M = wsp<u16>(p, O_M);
  uint4* stash = wsp<uint4>(p, O_QM) + (size_t)bid * 24 * 256 + ltid();
  const int nrt_ = n_row_tiles(last);
  PATCH_LOOP_BEGIN(nrt_, 8, 8, 8)
    const int rt = row_tile(last, prt), ct = pct;
    f32x16 mg[2][2];
    zero_acc(mg);
#pragma unroll 1
    for (int g = 0; g < 3; g++) {
      uint32_t gp[2][2][8];
      {
        f32x16 acc[2][2];
        zero_acc(acc);
        gemm_core<true>(acc, wsp<u16>(p, O_WG) + (size_t)(g * 1024 + ct * 128) * D, D, A + (size_t)rt * 128 * D, D, D,
                        smem);
#pragma unroll
        for (int i = 0; i < 2; i++)
#pragma unroll
          for (int j = 0; j < 2; j++)
#pragma unroll
            for (int e = 0; e < 8; e++)
              gp[i][j][e] = pack2(fsigmoid(acc[i][j][2 * e]), fsigmoid(acc[i][j][2 * e + 1]));
      }
      {
        f32x16 acc[2][2];
        zero_acc(acc);
        gemm_core<false>(acc, wsp<u16>(p, O_WB) + (size_t)(g * 1024 + ct * 128) * 512, 512,
                         Y + (size_t)rt * 128 * 1536 + g * 512, 1536, 512, smem);
#pragma unroll
        for (int i = 0; i < 2; i++)
#pragma unroll
          for (int j = 0; j < 2; j++)
#pragma unroll
            for (int e = 0; e < 8; e++) {
              mg[i][j][2 * e] += __uint_as_float(gp[i][j][e] << 16) * acc[i][j][2 * e];
              mg[i][j][2 * e + 1] += __uint_as_float(gp[i][j][e] & 0xffff0000u) * acc[i][j][2 * e + 1];
            }
      }
    }
#pragma unroll
    for (int i = 0; i < 2; i++)
#pragma unroll
      for (int j = 0; j < 2; j++)
#pragma unroll
        for (int g = 0; g < 4; g++) {
          const int row = rt * 128 + wn_ * 64 + j * 32 + r_;
          const int col = ct * 128 + wm_ * 64 + i * 32 + 8 * g + 4 * hh_;
          uint2 o;
          o.x = pack2(mg[i][j][4 * g], mg[i][j][4 * g + 1]);
          o.y = pack2(mg[i][j][4 * g + 2], mg[i][j][4 * g + 3]);
          *(uint2*)(M + (size_t)row * D + col) = o;
        }
  PATCH_LOOP_END
}

__device__ void phase_resid(const Params& p, int l, bool last, const u16* Ain, size_t lda, const u16* W, int K, int goff,
                            int bid, int nb, u16* smem) {
  EPI_DECL
  const float* mod = wsp<float>(p, O_MOD);
  const int nrt_ = n_row_tiles(last);
  PATCH_LOOP_BEGIN(nrt_, 8, 8, 8)
    const int rt = row_tile(last, prt), ct = pct;
    f32x16 acc[2][2];
    zero_acc(acc);
    gemm_core(acc, W + (size_t)ct * 128 * K, K, Ain + (size_t)rt * 128 * lda, lda, K, smem);
    const int row0 = rt * 128, b = row0 / KPB, kk0 = row0 - b * KPB;
    const int m = kk0 < CTXL ? 2 : b;
    float* xb = xrow(p, row0);
    const float* gv = mod + ((size_t)l * 3 + m) * 6144 + goff;
#pragma unroll
    for (int i = 0; i < 2; i++)
#pragma unroll
      for (int g = 0; g < 4; g++) {
        const int col = ct * 128 + wm_ * 64 + i * 32 + 8 * g + 4 * hh_;
        const float4 g4 = *(const float4*)(gv + col);
#pragma unroll
        for (int j = 0; j < 2; j++) {
          const int rl = wn_ * 64 + j * 32 + r_;
          float4* xp = (float4*)(xb + (size_t)rl * D + col);
          float4 xv = *xp;
          xv.x = ALPHA * xv.x + (1.f + g4.x) * acc[i][j][4 * g];
          xv.y = ALPHA * xv.y + (1.f + g4.y) * acc[i][j][4 * g + 1];
          xv.z = ALPHA * xv.z + (1.f + g4.z) * acc[i][j][4 * g + 2];
          xv.w = ALPHA * xv.w + (1.f + g4.w) * acc[i][j][4 * g + 3];
          *xp = xv;
        }
      }
  PATCH_LOOP_END
}

__device__ void phase_p7(const Params& p, int l, bool last, int bid, int nb, u16* smem) {
  EPI_DECL
  const u16* A = wsp<u16>(p, O_A);
  u16* HH = wsp<u16>(p, O_HH);
  const int nrt_ = n_row_tiles(last);
  PATCH_LOOP_BEGIN(nrt_, 44, 16, 4)
    const int rt = row_tile(last, prt), ct = pct;
    f32x16 acc[2][2];
    zero_acc(acc);
    gemm_core(acc, wsp<u16>(p, O_WGU) + (size_t)ct * 128 * D, D, A + (size_t)rt * 128 * D, D, D, smem);
#pragma unroll
    for (int j = 0; j < 2; j++)
#pragma unroll
      for (int g = 0; g < 4; g++) {
        const int row = rt * 128 + wn_ * 64 + j * 32 + r_;
        const int q = (ct * 2 + wm_) * 32 + 8 * g + 4 * hh_;
        float hv[4];
#pragma unroll
        for (int t = 0; t < 4; t++) {
          const float gt = acc[0][j][4 * g + t], up = acc[1][j][4 * g + t];
          hv[t] = gt * fsigmoid(gt) * up;
        }
        uint2 o;
        o.x = pack2(hv[0], hv[1]);
        o.y = pack2(hv[2], hv[3]);
        *(uint2*)(HH + (size_t)row * FH + q) = o;
      }
  PATCH_LOOP_END
}

constexpr int NPHASE = 3 + 9 * 2;

__device__ void run_phase(const Params& p, int ph, int bid, int nb, u16* smem) {
  if (ph == 0) {
    prep_tables(p, bid, nb);
    prep_modp(p, bid, nb);
    prep_weights(p, 0, bid, nb, smem);
    return;
  }
  if (ph == 1) { prep_modr(p, bid, nb); return; }
  if (ph == 2) { ln_phase(p, 0, p.ln_in_g, p.ln_in_b, 0, 0, 1024, false, bid, nb); return; }
  const int l = (ph - 3) / 9, s = (ph - 3) % 9;
  const bool last = (l == 1);
  switch (s) {
    case 0: phase_p1(p, l, last, bid, nb, smem); break;
    case 1: phase_p2(p, l, bid, nb, smem); break;
    case 2: phase_p3(p, l, last, bid, nb, smem); break;
    case 3: phase_p4(p, l, last, bid, nb, smem); break;
    case 4: phase_resid(p, l, last, wsp<u16>(p, O_M), D, wsp<u16>(p, O_WO), D, 2048, bid, nb, smem); break;
    case 5: ln_phase(p, 1, p.ln1_g + l * D, p.ln1_b + l * D, l, 3072, 4096, last, bid, nb); break;
    case 6: phase_p7(p, l, last, bid, nb, smem); break;
    case 7: phase_resid(p, l, last, wsp<u16>(p, O_HH), FH, wsp<u16>(p, O_WD), FH, 5120, bid, nb, smem); break;
    default:
      ln_phase(p, 1, p.ln2_g + l * D, p.ln2_b + l * D, last ? -1 : l + 1, 0, 1024, last, bid, nb);
      if (!last) prep_weights(p, l + 1, bid, nb, smem);
      break;
  }
}


#define XB_TMO      128
#define XB_XCNT(j)  (256  + 64 * (j))
#define XB_XSUB(j)  (1280 + 64 * (j))
#define XB_XGEN(j)  (2304 + 64 * (j))
#define XB_TOP      3328
#define XB_TOPGEN   3392
#define XCD_BAR_WORDS 3456
#define XB_SPIN_CAP (1u << 20)
#define LAS __attribute__((address_space(3)))
__device__ __forceinline__ unsigned xb_ld(unsigned* p) { return __hip_atomic_load(p, __ATOMIC_RELAXED, __HIP_MEMORY_SCOPE_AGENT); }
__device__ __forceinline__ unsigned xb_add(unsigned* p, unsigned v) { return __hip_atomic_fetch_add(p, v, __ATOMIC_RELAXED, __HIP_MEMORY_SCOPE_AGENT); }
__device__ __forceinline__ unsigned xb_xcc_id() { return (unsigned)__builtin_amdgcn_s_getreg((3 << 11) | 20) & 0xFu; }
#define XB_SPIN(cond, bar) do { unsigned _sp = 0; while (cond) { __builtin_amdgcn_s_sleep(1); \
    if ((++_sp & 255u) == 0u) { if (xb_ld(&(bar)[XB_TMO])) break; if (_sp > XB_SPIN_CAP) { atomicAdd(&(bar)[XB_TMO], 1u); break; } } } } while (0)
struct XcdBarrier {
  unsigned* bar; unsigned x;
  volatile LAS unsigned* st;
};
__device__ __forceinline__ XcdBarrier xcd_barrier_post(unsigned* bar, volatile LAS unsigned* st) {
  XcdBarrier b; b.bar = bar; b.x = xb_xcc_id(); b.st = st;
  if (threadIdx.x == 0) (void)xb_add(&bar[XB_XCNT(b.x)], 1u);
  return b;
}
__device__ __forceinline__ void xcd_barrier_complete(unsigned* bar, unsigned x, unsigned& nloc, unsigned& nx) {
  const unsigned G = gridDim.x * gridDim.y * gridDim.z;
  unsigned sum, cnt, mine, sp = 0u;
  for (;;) {
    sum = 0u; cnt = 0u; mine = 0u;
#pragma unroll
    for (unsigned j = 0; j < 16; ++j) { const unsigned c = xb_ld(&bar[XB_XCNT(j)]); sum += c; cnt += (c > 0u) ? 1u : 0u; mine = (j == x) ? c : mine; }
    if (sum == G) break;
    __builtin_amdgcn_s_sleep(1);
    if ((++sp & 255u) == 0u) { if (xb_ld(&bar[XB_TMO])) break; if (sp > XB_SPIN_CAP) { atomicAdd(&bar[XB_TMO], 1u); break; } }
  }
  nloc = mine > 0u ? mine : 1u; nx = cnt > 0u ? cnt : 1u;
}
__device__ __forceinline__ void xcd_barrier(const XcdBarrier& b) {
  asm volatile("s_waitcnt vmcnt(0)" ::: "memory");
  __syncthreads();
  if (threadIdx.x == 0) {
    unsigned* bar = b.bar;
    __builtin_amdgcn_s_waitcnt(0);
    unsigned nloc = b.st[0], nx = b.st[1];
    if (nloc == 0u) { xcd_barrier_complete(bar, b.x, nloc, nx); b.st[0] = nloc; b.st[1] = nx; }
    const unsigned old = xb_add(&bar[XB_XSUB(b.x)], 1u);
    const unsigned gen = old / nloc;
    if (old + 1u == (gen + 1u) * nloc) {
      __builtin_amdgcn_fence(__ATOMIC_RELEASE, "agent");
      asm volatile("s_waitcnt vmcnt(0)" ::: "memory");
      const unsigned og = xb_add(&bar[XB_TOP], 1u);
      const unsigned tg = og / nx;
      if (og + 1u == (tg + 1u) * nx) xb_add(&bar[XB_TOPGEN], 1u);
      else XB_SPIN(xb_ld(&bar[XB_TOPGEN]) == tg, bar);
      __builtin_amdgcn_fence(__ATOMIC_ACQUIRE, "agent");
      xb_add(&bar[XB_XGEN(b.x)], 1u);
      asm volatile("s_waitcnt vmcnt(0)" ::: "memory");
    } else {
      XB_SPIN(xb_ld(&bar[XB_XGEN(b.x)]) == gen, bar);
      __builtin_amdgcn_fence(__ATOMIC_ACQUIRE, "agent");
      asm volatile("s_waitcnt vmcnt(0)" ::: "memory");
    }
  }
  __syncthreads();
}

constexpr int SMEM_ELEMS = 4 * SM_A + 256 + 8;

#if COOP
__global__ void __launch_bounds__(256, 2) mega_kernel(Params p) {
  __shared__ __attribute__((aligned(16))) u16 smem[SMEM_ELEMS];
  cg::grid_group grid = cg::this_grid();
  volatile LAS unsigned* st = (volatile LAS unsigned*)(smem + 4 * SM_A + 256);
  if (threadIdx.x == 0) { st[0] = 0u; st[1] = 0u; }
  __syncthreads();
  XcdBarrier xb = xcd_barrier_post((unsigned*)(p.ws + O_BAR), st);
  for (int ph = 0; ph < NPHASE; ph++) {
#ifdef PROBE_MASK
    const int s9 = ph >= 3 ? (ph - 3) % 9 : -1;
    const int nrep = (s9 >= 0 && ((PROBE_MASK >> s9) & 1)) ? 2 : 1;
    for (int rep = 0; rep < nrep; rep++) {
      run_phase(p, ph, blockIdx.x, gridDim.x, smem);
      if (ph == 0) grid.sync();
      else if (ph + 1 < NPHASE || rep + 1 < nrep) xcd_barrier(xb);
    }
#else
    run_phase(p, ph, blockIdx.x, gridDim.x, smem);
    if (ph == 0) grid.sync();
    else if (ph + 1 < NPHASE) xcd_barrier(xb);
#endif
  }
}
#else
__global__ void __launch_bounds__(256, 2) phase_kernel(Params p, int ph) {
  __shared__ __attribute__((aligned(16))) u16 smem[SMEM_ELEMS];
  run_phase(p, ph, blockIdx.x, gridDim.x, smem);
}
#endif

extern "C" void kernel_launch(void* const* d_in, const int* in_sizes, int n_in, void* d_out, int out_size, void* d_ws,
                              size_t ws_size, hipStream_t stream) {
  Params p{};
  const float** f = (const float**)&p;
  for (int i = 0; i < 25; i++) f[i] = (const float*)d_in[i];
  p.out = (float*)d_out;
  p.ws = (unsigned char*)d_ws;
  if (ws_size < O_WSEND) fprintf(stderr, "workspace too small: %zu < %zu\n", ws_size, (size_t)O_WSEND);
#if COOP
  static int grid_blocks = 0;
  if (!grid_blocks) {
    int dev = 0, cus = 0, per_cu = 0;
    hipGetDevice(&dev);
    hipDeviceGetAttribute(&cus, hipDeviceAttributeMultiprocessorCount, dev);
    hipOccupancyMaxActiveBlocksPerMultiprocessor(&per_cu, mega_kernel, 256, 0);
    if (per_cu > 2) per_cu = 2;
    grid_blocks = cus * per_cu;
  }
  (void)hipMemsetAsync(p.ws + O_BAR, 0, 3456 * 4, stream);
  void* args[] = {&p};
  hipError_t e = hipLaunchCooperativeKernel((void*)mega_kernel, dim3(grid_blocks), dim3(256), args, 0, stream);
  if (e != hipSuccess) fprintf(stderr, "cooperative launch failed: %s (grid %d)\n", hipGetErrorString(e), grid_blocks);
#else
  for (int ph = 0; ph < NPHASE; ph++) phase_kernel<<<512, 256, 0, stream>>>(p, ph);
#endif
}
```

```cpp
#include <hip/hip_runtime.h>
#include <hip/hip_cooperative_groups.h>
#include <stdint.h>
#include <cstdio>
namespace cg = cooperative_groups;

#ifndef COOP
#define COOP 1
#endif

typedef __attribute__((ext_vector_type(8))) short bf16x8;
typedef __attribute__((ext_vector_type(4))) short bf16x4;
typedef __attribute__((ext_vector_type(16))) float f32x16;
typedef unsigned short u16;
typedef __attribute__((ext_vector_type(4))) unsigned int u32x4;

constexpr int D = 1024;
constexpr int NBATCH = 2;
constexpr int SEQ = 16384;
constexpr int CTXL = 256;
constexpr int KPB = SEQ + CTXL;
constexpr int T = NBATCH * KPB;
constexpr int NRT = T / 128;
constexpr int FH = 2816;
constexpr int IN_DIM = 5536;
constexpr float LOG2E = 1.4426950408889634f;
constexpr float NA_SCALE_L2 = 0.125f * LOG2E;
constexpr float MLA_SCALE_L2 = 0.10206207261596575f * LOG2E;
constexpr float ALPHA = 1.4142135623730951f;
constexpr float EPS = 1e-5f;
constexpr float RS128 = 0.08838834764831845f;

constexpr size_t al256(size_t x) { return (x + 255) & ~(size_t)255; }
constexpr size_t O_WF = 0;
constexpr size_t O_WP = O_WF + (size_t)1024 * 1024 * 2;
constexpr size_t O_WG = O_WP + (size_t)2048 * 1024 * 2;
constexpr size_t O_WUQ = O_WG + (size_t)3072 * 1024 * 2;
constexpr size_t O_WUKV = O_WUQ + (size_t)768 * 256 * 2;
constexpr size_t O_WB = O_WUKV + (size_t)1024 * 128 * 2;
constexpr size_t O_WO = O_WB + (size_t)3 * 1024 * 512 * 2;
constexpr size_t O_WGU = O_WO + (size_t)1024 * 1024 * 2;
constexpr size_t O_WD = O_WGU + (size_t)5632 * 1024 * 2;
constexpr size_t O_MA = O_WD + (size_t)1024 * 2816 * 2;
constexpr size_t O_MB = O_MA + (size_t)256 * 256 * 2;
constexpr size_t O_MC = O_MB + (size_t)128 * 256 * 2;
constexpr size_t O_TW = O_MC + (size_t)256 * 512 * 2;
constexpr size_t O_MODP = O_TW + (size_t)128 * 128 * 2 * 4;
constexpr size_t O_MOD = O_MODP + (size_t)16 * 2 * 3 * 6144 * 4;
constexpr size_t O_XCTX = O_MOD + (size_t)2 * 3 * 6144 * 4;
constexpr size_t O_D1C = O_XCTX + (size_t)512 * 1024 * 4;
constexpr size_t O_A = O_D1C + (size_t)2 * 512 * 2 * 256 * 2;
constexpr size_t O_RQ = O_A + (size_t)T * 1024 * 2;
constexpr size_t O_QNA = O_RQ;
constexpr size_t O_KNA = O_QNA + (size_t)T * 512 * 2;
constexpr size_t O_VNAT = O_KNA + (size_t)T * 512 * 2;
constexpr size_t O_RY = O_VNAT + (size_t)T * 512 * 2;
constexpr size_t O_Y = O_RY;
constexpr size_t O_D1 = O_RY;
constexpr size_t O_LAT = O_RY + (size_t)67108864;
constexpr size_t O_D2 = O_RY + (size_t)T * 1536 * 2;
constexpr size_t O_QM = O_D2 + (size_t)67108864;
constexpr size_t O_KN = O_QM + (size_t)T * 768 * 2;
constexpr size_t O_KRR = O_KN + (size_t)T * 512 * 2;
constexpr size_t O_VMT = O_KRR + (size_t)T * 32 * 2;
constexpr size_t O_END = O_VMT + (size_t)T * 512 * 2;
constexpr size_t O_BAR = (O_END + 255) & ~(size_t)255;
constexpr size_t O_WSEND = O_BAR + 3456 * 4;
constexpr size_t O_M = O_RQ;
constexpr size_t O_HH = O_RQ;

struct Params {
  const float *x, *c, *ctx, *c_ctx, *ln_in_g, *ln_in_b, *w_mod, *b_mod, *w_in, *gq, *gkv, *w_uq, *w_qr, *w_uk,
      *w_uv, *rpb, *w_branch, *w_out, *ln1_g, *ln1_b, *ln2_g, *ln2_b, *w_gate, *w_up, *w_down;
  float* out;
  unsigned char* ws;
};

__device__ __forceinline__ u16 f2bf(float f) {
  uint32_t u = __float_as_uint(f);
  u += 0x7fffu + ((u >> 16) & 1u);
  return (u16)(u >> 16);
}
typedef __attribute__((ext_vector_type(2))) __bf16 bf16v2;
typedef __attribute__((ext_vector_type(2))) float f32v2;
__device__ __forceinline__ uint32_t pack2(float a, float b) {
  const f32v2 v = {a, b};
  return __builtin_bit_cast(uint32_t, __builtin_convertvector(v, bf16v2));
}
__device__ __forceinline__ uint4 pair_swap(uint2 a, uint2 b) {
  const auto rx = __builtin_amdgcn_permlane32_swap(a.x, b.x, false, false);
  const auto ry = __builtin_amdgcn_permlane32_swap(a.y, b.y, false, false);
  return make_uint4(rx[0], ry[0], rx[1], ry[1]);
}
__device__ __forceinline__ float bf2f(u16 v) { return __uint_as_float(((uint32_t)v) << 16); }
__device__ __forceinline__ float wsum(float v) {
#pragma unroll
  for (int o = 32; o > 0; o >>= 1) v += __shfl_xor(v, o);
  return v;
}
__device__ __forceinline__ float fsigmoid(float v) { return 1.f / (1.f + __expf(-v)); }

__device__ __forceinline__ int ltid() {
  int t = threadIdx.x;
  asm volatile("" : "+v"(t));
  return t;
}

template <typename Tp>
__device__ __forceinline__ Tp* wsp(const Params& p, size_t off) { return (Tp*)(p.ws + off); }

__device__ __forceinline__ float* xrow(const Params& p, int row) {
  int b = row / KPB, kk = row - b * KPB;
  if (kk < CTXL) return wsp<float>(p, O_XCTX) + (size_t)(b * CTXL + kk) * D;
  return p.out + (size_t)(b * SEQ + kk - CTXL) * D;
}

constexpr int LSTR = 72;
constexpr int SM_A = 128 * LSTR;

template <bool DEEP = true>
__device__ __forceinline__ void gemm_core(f32x16 (&acc)[2][2], const u16* __restrict__ A, size_t lda,
                                          const u16* __restrict__ B, size_t ldb, int K, u16* smem) {
  const int tid = ltid(), lane = tid & 63, wave = tid >> 6;
  const int wm = wave >> 1, wn = wave & 1, r = lane & 31, hh = lane >> 5;
  u16* sA = smem;
  u16* sB = smem + 2 * SM_A;
  const int lrow = tid >> 3, lkc = (tid & 7) * 8;
  const u16* ga = A + (size_t)lrow * lda + lkc;
  const u16* gb = B + (size_t)lrow * ldb + lkc;
  u16* wa = sA + lrow * LSTR + lkc;
  u16* wb = sB + lrow * LSTR + lkc;
  const u16* pa = sA + (wm * 64 + r) * LSTR + hh * 8;
  const u16* pb = sB + (wn * 64 + r) * LSTR + hh * 8;
  u32x4 a0r[4], b0r[4], a1r[4], b1r[4];
#define G_LOAD(ar, br, ko)                                               \
  _Pragma("unroll") for (int i = 0; i < 4; i++) {                        \
    ar[i] = *(const u32x4*)(ga + (size_t)(32 * i) * lda + (ko));         \
    br[i] = *(const u32x4*)(gb + (size_t)(32 * i) * ldb + (ko));         \
  }
#define G_STORE(ar, br, buf)                                             \
  _Pragma("unroll") for (int i = 0; i < 4; i++) {                        \
    *(u32x4*)(wa + (buf)*SM_A + 32 * i * LSTR) = ar[i];                  \
    *(u32x4*)(wb + (buf)*SM_A + 32 * i * LSTR) = br[i];                  \
  }
#define G_COMPUTE(buf)                                                                   \
  _Pragma("unroll") for (int ks = 0; ks < 4; ks++) {                                     \
    const bf16x8 fa0 = *(const bf16x8*)(pa + (buf)*SM_A + ks * 16);                      \
    const bf16x8 fa1 = *(const bf16x8*)(pa + (buf)*SM_A + 32 * LSTR + ks * 16);          \
    const bf16x8 fb0 = *(const bf16x8*)(pb + (buf)*SM_A + ks * 16);                      \
    const bf16x8 fb1 = *(const bf16x8*)(pb + (buf)*SM_A + 32 * LSTR + ks * 16);          \
    acc[0][0] = __builtin_amdgcn_mfma_f32_32x32x16_bf16(fa0, fb0, acc[0][0], 0, 0, 0);   \
    acc[0][1] = __builtin_amdgcn_mfma_f32_32x32x16_bf16(fa0, fb1, acc[0][1], 0, 0, 0);   \
    acc[1][0] = __builtin_amdgcn_mfma_f32_32x32x16_bf16(fa1, fb0, acc[1][0], 0, 0, 0);   \
    acc[1][1] = __builtin_amdgcn_mfma_f32_32x32x16_bf16(fa1, fb1, acc[1][1], 0, 0, 0);   \
  }
  const int nk = K >> 6;
  if (DEEP) {
    G_LOAD(a0r, b0r, 0)
    G_LOAD(a1r, b1r, 64)
    G_STORE(a0r, b0r, 0)
    __syncthreads();
    const int klast = (nk - 1) * 64;
    G_LOAD(a0r, b0r, min(128, klast))
    for (int kt = 0; kt < nk; kt += 2) {
      G_COMPUTE(0)
      G_STORE(a1r, b1r, 1)
      __syncthreads();
      G_LOAD(a1r, b1r, min((kt + 3) * 64, klast))
      __builtin_amdgcn_sched_barrier(0);
      G_COMPUTE(1)
      G_STORE(a0r, b0r, 0)
      __syncthreads();
      G_LOAD(a0r, b0r, min((kt + 4) * 64, klast))
      __builtin_amdgcn_sched_barrier(0);
    }
  } else {
    G_LOAD(a0r, b0r, 0)
    G_STORE(a0r, b0r, 0)
    __syncthreads();
    for (int kt = 0; kt < nk; kt += 2) {
      G_LOAD(a0r, b0r, (kt + 1) * 64)
      G_COMPUTE(0)
      G_STORE(a0r, b0r, 1)
      __syncthreads();
      if (kt + 2 < nk) G_LOAD(a0r, b0r, (kt + 2) * 64)
      G_COMPUTE(1)
      if (kt + 2 < nk) G_STORE(a0r, b0r, 0)
      __syncthreads();
    }
  }
#undef G_LOAD
#undef G_STORE
#undef G_COMPUTE
}

__device__ __forceinline__ void zero_acc(f32x16 (&acc)[2][2]) {
#pragma unroll
  for (int i = 0; i < 2; i++)
#pragma unroll
    for (int j = 0; j < 2; j++)
#pragma unroll
      for (int e = 0; e < 16; e++) acc[i][j][e] = 0.f;
}

#define EPI_DECL                                                     \
  const int lane_ = ltid() & 63, wave_ = ltid() >> 6;      \
  const int wm_ = wave_ >> 1, wn_ = wave_ & 1, r_ = lane_ & 31, hh_ = lane_ >> 5; \
  (void)wm_; (void)wn_; (void)r_; (void)hh_;

__device__ __forceinline__ const float* src_col(const Params& p, int l, int kind, int n, int& ld) {
  switch (kind) {
    case 0:
      ld = IN_DIM;
      return n < 1952 ? p.w_in + (size_t)l * D * IN_DIM + 512 + n : nullptr;
    case 1:
      ld = IN_DIM;
      return p.w_in + (size_t)l * D * IN_DIM + 2464 + n;
    case 2:
      if (n < 512) {
        ld = 512;
        return p.w_uq + (size_t)l * 256 * 512 + n;
      } else {
        int m = n - 512, wt = m >> 6, jb = (m >> 5) & 1, idx = wt * 32 + (m & 31);
        int h = idx >> 4, e = idx & 15;
        ld = 256;
        return p.w_qr + (size_t)l * 256 * 256 + h * 32 + jb * 16 + e;
      }
    case 3:
      ld = 512;
      return n < 512 ? p.w_uk + (size_t)l * 128 * 512 + n : p.w_uv + (size_t)l * 128 * 512 + (n - 512);
    case 4: {
      int g = n >> 10, nn = n & 1023;
      ld = 1024;
      return p.w_branch + ((size_t)(l * 3 + g) * 512) * 1024 + nn;
    }
    case 5:
      ld = 1024;
      return p.w_out + (size_t)l * D * D + n;
    case 6: {
      int jb = (n >> 5) & 1, q = (n >> 6) * 32 + (n & 31);
      ld = FH;
      return (jb ? p.w_up : p.w_gate) + (size_t)l * D * FH + q;
    }
    default:
      ld = 1024;
      return p.w_down + (size_t)l * FH * D + n;
  }
}

__device__ __forceinline__ int job_nd(int k) {
  switch (k) { case 0: return 2048; case 1: return 3072; case 2: return 768; case 3: return 1024; case 4: return 3072;
    case 5: return 1024; case 6: return 5632; default: return 1024; }
}
__device__ __forceinline__ int job_kd(int k) {
  switch (k) { case 0: return 1024; case 1: return 1024; case 2: return 256; case 3: return 128; case 4: return 512;
    case 5: return 1024; case 6: return 1024; default: return 2816; }
}
__device__ __forceinline__ size_t job_od(int k) {
  switch (k) { case 0: return O_WP; case 1: return O_WG; case 2: return O_WUQ; case 3: return O_WUKV; case 4: return O_WB;
    case 5: return O_WO; case 6: return O_WGU; default: return O_WD; }
}
__device__ void prep_weights(const Params& p, int l, int bid, int nb, u16* smem) {
  float* tile = (float*)smem;
  const int tid = ltid();
  int start = 0;
#pragma unroll 1
  for (int kind = 0; kind < 8; kind++) {
    const int Kk = job_kd(kind);
    const int nkt = Kk >> 6, ntile = (job_nd(kind) >> 6) * nkt;
    u16* dst = wsp<u16>(p, job_od(kind));
    const float* ksc = kind == 2 ? p.gq + l * 256 : (kind == 3 ? p.gkv + l * 128 : nullptr);
    for (int t = (bid + nb - (start % nb)) % nb; t < ntile; t += nb) {
      const int nt = t / nkt, kt = t - nt * nkt;
      const int n0 = nt * 64, k0 = kt * 64;
      {
        const int kq = tid >> 4, nn4 = (tid & 15) * 4;
        int ld;
        const float* sp = src_col(p, l, kind, n0 + nn4, ld);
#pragma unroll
        for (int i = 0; i < 4; i++) {
          const int kk = i * 16 + kq;
          float4 v = make_float4(0.f, 0.f, 0.f, 0.f);
          if (sp) v = *(const float4*)(sp + (size_t)(k0 + kk) * ld);
          if (ksc) {
            const float sc = ksc[k0 + kk];
            v.x *= sc; v.y *= sc; v.z *= sc; v.w *= sc;
          }
          float* tp = tile + kk * 65 + nn4;
          tp[0] = v.x; tp[1] = v.y; tp[2] = v.z; tp[3] = v.w;
        }
      }
      __syncthreads();
#pragma unroll
      for (int i = 0; i < 2; i++) {
        const int c = tid + 256 * i;
        const int nn = c >> 3, kc = (c & 7) * 8;
        const float* tp = tile + kc * 65 + nn;
        uint4 o;
        o.x = pack2(tp[0], tp[65]);
        o.y = pack2(tp[2 * 65], tp[3 * 65]);
        o.z = pack2(tp[4 * 65], tp[5 * 65]);
        o.w = pack2(tp[6 * 65], tp[7 * 65]);
        *(uint4*)(dst + (size_t)(n0 + nn) * Kk + k0 + kc) = o;
      }
      __syncthreads();
    }
    start += ntile;
  }
  {
    float* ctab = (float*)smem;
    __syncthreads();
    if (tid < 128) ctab[tid] = cospif((float)tid * (1.f / 64.f));
    __syncthreads();
    u16* dst = wsp<u16>(p, O_WF);
    for (int it = bid; it < 512; it += nb) {
      const int o = it * 256 + tid;
      const int np = o & 1023, k8 = (o >> 10) * 8;
      const int reim = np >> 9, g = (np >> 7) & 3, m = np & 127;
      const float* w = p.w_in + (size_t)l * D * IN_DIM + (size_t)k8 * IN_DIM + g * 128;
      const int sh = reim ? 96 : 0;
      float a8[8];
#pragma unroll
      for (int j = 0; j < 8; j++) a8[j] = 0.f;
#pragma unroll 4
      for (int c = 0; c < 128; c++) {
        const float tw = ctab[(m * c + sh) & 127];
#pragma unroll
        for (int j = 0; j < 8; j++) a8[j] += w[(size_t)j * IN_DIM + c] * tw;
      }
      uint4 ov;
      ov.x = pack2(a8[0] * RS128, a8[1] * RS128);
      ov.y = pack2(a8[2] * RS128, a8[3] * RS128);
      ov.z = pack2(a8[4] * RS128, a8[5] * RS128);
      ov.w = pack2(a8[6] * RS128, a8[7] * RS128);
      *(uint4*)(dst + (size_t)np * 1024 + k8) = ov;
    }
    __syncthreads();
  }
}

__device__ void prep_tables(const Params& p, int bid, int nb) {
  u16* MA = wsp<u16>(p, O_MA);
  u16* MB = wsp<u16>(p, O_MB);
  u16* MC = wsp<u16>(p, O_MC);
  float* TW = wsp<float>(p, O_TW);
  const int total = 65536 + 32768 + 131072 + 16384;
  for (int idx = bid * 256 + ltid(); idx < total; idx += nb * 256) {
    if (idx < 65536) {
      const int n = idx >> 8, k = idx & 255;
      const int nt = n >> 7, wn = (n >> 6) & 1, jb = (n >> 5) & 1, klo = nt * 64 + wn * 32 + (n & 31);
      const int ri = k >> 7, nhi = k & 127;
      const int xx = (klo * nhi) & 127;
      const float c = cospif((float)xx * (1.f / 64.f)), s = sinpif((float)xx * (1.f / 64.f));
      float v = jb == 0 ? (ri == 0 ? c : -s) : (ri == 0 ? -s : -c);
      MA[idx] = f2bf(v * RS128);
    } else if (idx < 65536 + 32768) {
      const int i2 = idx - 65536;
      const int khi = i2 >> 8, k = i2 & 255;
      const int ri = k >> 7, nlo = k & 127;
      const int xx = (khi * nlo) & 127;
      const float c = cospif((float)xx * (1.f / 64.f)), s = sinpif((float)xx * (1.f / 64.f));
      MB[i2] = f2bf((ri == 0 ? c : s) * RS128);
    } else if (idx < 65536 + 32768 + 131072) {
      const int i2 = idx - 65536 - 32768;
      const int kk = i2 >> 9, k = i2 & 511;
      const int ri = k >> 8, nn = k & 255;
      const int xx = (kk * nn) & 255;
      const float c = cospif((float)xx * (1.f / 128.f)), s = sinpif((float)xx * (1.f / 128.f));
      MC[i2] = f2bf((ri == 0 ? c : -s) * 0.0625f);
    } else {
      const int i2 = idx - 65536 - 32768 - 131072;
      const int klo = i2 >> 7, nlo = i2 & 127;
      const int xx = klo * nlo;
      TW[i2 * 2] = cospif((float)xx * (1.f / 8192.f));
      TW[i2 * 2 + 1] = sinpif((float)xx * (1.f / 8192.f));
    }
  }
}

__device__ void prep_modp(const Params& p, int bid, int nb) {
  float* modp = wsp<float>(p, O_MODP);
  for (int it = bid; it < 2 * 16 * 24; it += nb) {
    const int l = it / (16 * 24), rem = it - l * 16 * 24, kc = rem / 24, nblk = rem - kc * 24;
    const int n = nblk * 256 + ltid();
    const float* w = p.w_mod + (size_t)l * D * 6144 + n;
    float a0 = 0.f, a1 = 0.f, a2 = 0.f;
#pragma unroll 8
    for (int kk = 0; kk < 64; kk++) {
      const int k = kc * 64 + kk;
      const float wv = w[(size_t)k * 6144];
      float c0 = p.c[k], c1 = p.c[1024 + k], c2 = p.c_ctx[k];
      c0 = c0 / (1.f + __expf(-c0));
      c1 = c1 / (1.f + __expf(-c1));
      c2 = c2 / (1.f + __expf(-c2));
      a0 += c0 * wv;
      a1 += c1 * wv;
      a2 += c2 * wv;
    }
    float* o = modp + ((size_t)(kc * 2 + l) * 3) * 6144 + n;
    o[0] = a0;
    o[6144] = a1;
    o[2 * 6144] = a2;
  }
}
__device__ void prep_modr(const Params& p, int bid, int nb) {
  const float* modp = wsp<float>(p, O_MODP);
  float* mod = wsp<float>(p, O_MOD);
  for (int idx = bid * 256 + ltid(); idx < 2 * 3 * 6144; idx += nb * 256) {
    const int l = idx / (3 * 6144), n = idx % 6144;
    float v = p.b_mod[l * 6144 + n];
    for (int kc = 0; kc < 16; kc++) v += modp[(size_t)kc * 2 * 3 * 6144 + idx];
    mod[idx] = v;
  }
}

__device__ void ln_phase(const Params& p, int mode, const float* g, const float* bta, int lmod, int shoff, int scoff,
                         bool skip_ctx, int bid, int nb) {
  const int lane = ltid() & 63, wave = ltid() >> 6;
  u16* A = wsp<u16>(p, O_A);
  const float* mod = wsp<float>(p, O_MOD);
  for (int row = bid * 4 + wave; row < T; row += nb * 4) {
    const int b = row / KPB, kk = row - b * KPB;
    if (skip_ctx && kk < CTXL) continue;
    float* xr = xrow(p, row);
    const float* src;
    if (mode == 0)
      src = kk < CTXL ? p.ctx + (size_t)(b * CTXL + kk) * D : p.x + (size_t)(b * SEQ + kk - CTXL) * D;
    else
      src = xr;
    float4 v[4];
    float s = 0.f;
#pragma unroll
    for (int i = 0; i < 4; i++) {
      v[i] = *(const float4*)(src + i * 256 + lane * 4);
      s += v[i].x + v[i].y + v[i].z + v[i].w;
    }
    const float mu = wsum(s) * (1.f / 1024.f);
    float q = 0.f;
#pragma unroll
    for (int i = 0; i < 4; i++) {
      v[i].x -= mu; v[i].y -= mu; v[i].z -= mu; v[i].w -= mu;
      q += v[i].x * v[i].x + v[i].y * v[i].y + v[i].z * v[i].z + v[i].w * v[i].w;
    }
    const float rstd = rsqrtf(wsum(q) * (1.f / 1024.f) + EPS);
    const int m = kk < CTXL ? 2 : b;
    const float* md = mod + ((size_t)(lmod < 0 ? 0 : lmod) * 3 + m) * 6144;
#pragma unroll
    for (int i = 0; i < 4; i++) {
      const int c0 = i * 256 + lane * 4;
      const float4 gg = *(const float4*)(g + c0), bb = *(const float4*)(bta + c0);
      float4 y;
      y.x = v[i].x * rstd * gg.x + bb.x;
      y.y = v[i].y * rstd * gg.y + bb.y;
      y.z = v[i].z * rstd * gg.z + bb.z;
      y.w = v[i].w * rstd * gg.w + bb.w;
      *(float4*)(xr + c0) = y;
      if (lmod >= 0) {
        const float4 sh = *(const float4*)(md + shoff + c0), sc = *(const float4*)(md + scoff + c0);
        uint2 o;
        o.x = pack2(y.x * (1.f + sc.x) + sh.x, y.y * (1.f + sc.y) + sh.y);
        o.y = pack2(y.z * (1.f + sc.z) + sh.z, y.w * (1.f + sc.w) + sh.w);
        *(uint2*)(A + (size_t)row * D + c0) = o;
      }
    }
  }
}

#define PATCH_LOOP_BEGIN(NR_, NC_, PR_, PC_)                                   \
  {                                                                            \
    const int x_ = bid & 7, w_ = bid >> 3, nbx_ = nb >> 3;                     \
    const int CG_ = ((NC_) + (PC_)-1) / (PC_);                                 \
    const int npatch_ = (((NR_) + (PR_)-1) / (PR_)) * CG_;                     \
    for (int u_ = w_;; u_ += nbx_) {                                           \
      const int g_ = (u_ >> 6) * 8 + x_;                                       \
      if (g_ >= npatch_) break;                                                \
      const int s_ = u_ & 63;                                                  \
      const int rg_ = g_ / CG_;                                                \
      const int prt = rg_ * (PR_) + s_ / (PC_);                                \
      const int pct = (g_ - rg_ * CG_) * (PC_) + s_ % (PC_);                   \
      if (prt >= (NR_) || pct >= (NC_)) continue;
#define PATCH_LOOP_END \
    }                  \
  }

__device__ void phase_p1(const Params& p, int l, bool last, int bid, int nb, u16* smem) {
  EPI_DECL
  const u16* A = wsp<u16>(p, O_A);
  PATCH_LOOP_BEGIN(NRT, 16, 8, 8)
    f32x16 acc[2][2];
    zero_acc(acc);
    {
      const int rt = prt, ct = pct;
      const int row0 = rt * 128, b = row0 / KPB, kk0 = row0 - b * KPB;
      if (ct < 8 || ct >= 12) {
        gemm_core(acc, wsp<u16>(p, O_WP) + (size_t)ct * 128 * D, D, A + (size_t)rt * 128 * D, D, D, smem);
        u16* dst;
        float sc = 1.f;
        int cb;
        if (ct < 4) { dst = wsp<u16>(p, O_QNA); sc = NA_SCALE_L2; cb = ct * 128; }
        else if (ct < 8) { dst = wsp<u16>(p, O_KNA); cb = (ct - 4) * 128; }
        else { dst = wsp<u16>(p, O_LAT); cb = (ct - 12) * 128; }
#pragma unroll
        for (int i = 0; i < 2; i++)
#pragma unroll
          for (int j = 0; j < 2; j++)
#pragma unroll
            for (int gp = 0; gp < 2; gp++) {
              const int row = row0 + wn_ * 64 + j * 32 + r_;
              const int col = cb + wm_ * 64 + i * 32 + 8 * (2 * gp + hh_);
              uint2 oa, ob;
              oa.x = pack2(acc[i][j][8 * gp] * sc, acc[i][j][8 * gp + 1] * sc);
              oa.y = pack2(acc[i][j][8 * gp + 2] * sc, acc[i][j][8 * gp + 3] * sc);
              ob.x = pack2(acc[i][j][8 * gp + 4] * sc, acc[i][j][8 * gp + 5] * sc);
              ob.y = pack2(acc[i][j][8 * gp + 6] * sc, acc[i][j][8 * gp + 7] * sc);
              *(uint4*)(dst + (size_t)row * 512 + col) = pair_swap(oa, ob);
            }
      } else {
        gemm_core(acc, A + (size_t)rt * 128 * D, D, wsp<u16>(p, O_WP) + (size_t)ct * 128 * D, D, D, smem);
        u16* dst = wsp<u16>(p, O_VNAT);
        const int cb = (ct - 8) * 128;
#pragma unroll
        for (int i = 0; i < 2; i++)
#pragma unroll
          for (int j = 0; j < 2; j++)
#pragma unroll
            for (int gp = 0; gp < 2; gp++) {
              const int kk = kk0 + wm_ * 64 + i * 32 + 8 * (2 * gp + hh_);
              const int col = cb + wn_ * 64 + j * 32 + r_;
              uint2 oa, ob;
              oa.x = pack2(acc[i][j][8 * gp], acc[i][j][8 * gp + 1]);
              oa.y = pack2(acc[i][j][8 * gp + 2], acc[i][j][8 * gp + 3]);
              ob.x = pack2(acc[i][j][8 * gp + 4], acc[i][j][8 * gp + 5]);
              ob.y = pack2(acc[i][j][8 * gp + 6], acc[i][j][8 * gp + 7]);
              *(uint4*)(dst + ((size_t)(b * 512 + col)) * KPB + kk) = pair_swap(oa, ob);
            }
      }
    }
  PATCH_LOOP_END
  PATCH_LOOP_BEGIN(256, 8, 8, 8)
    f32x16 acc[2][2];
    zero_acc(acc);
    {
      const int rt = prt, ct = pct;
      const int b = rt >> 7, nlo = rt & 127;
      gemm_core(acc, A + (size_t)(b * KPB + CTXL + nlo) * D, (size_t)128 * D,
                wsp<u16>(p, O_WF) + (size_t)ct * 128 * D, D, D, smem);
      u16* dst = wsp<u16>(p, O_D1);
#pragma unroll
      for (int i = 0; i < 2; i++)
#pragma unroll
        for (int j = 0; j < 2; j++)
#pragma unroll
          for (int gp = 0; gp < 2; gp++) {
            const int nhi = wm_ * 64 + i * 32 + 8 * (2 * gp + hh_);
            const int n = ct * 128 + wn_ * 64 + j * 32 + r_;
            const int reim = n >> 9, jj = n & 511;
            uint2 oa, ob;
            oa.x = pack2(acc[i][j][8 * gp], acc[i][j][8 * gp + 1]);
            oa.y = pack2(acc[i][j][8 * gp + 2], acc[i][j][8 * gp + 3]);
            ob.x = pack2(acc[i][j][8 * gp + 4], acc[i][j][8 * gp + 5]);
            ob.y = pack2(acc[i][j][8 * gp + 6], acc[i][j][8 * gp + 7]);
            *(uint4*)(dst + ((((size_t)(b * 512 + jj)) * 128 + nlo) * 2 + reim) * 128 + nhi) = pair_swap(oa, ob);
          }
    }
  PATCH_LOOP_END
  if (!last) {
    for (int t2 = bid; t2 < 32; t2 += nb) {
      f32x16 acc[2][2];
      zero_acc(acc);
      const int rt = t2 >> 3, ct = t2 & 7;
      const int b = rt >> 1, rb = rt & 1;
      gemm_core(acc, A + (size_t)(b * KPB + rb * 128) * D, D, wsp<u16>(p, O_WF) + (size_t)ct * 128 * D, D, D, smem);
      u16* dst = wsp<u16>(p, O_D1C);
#pragma unroll
      for (int i = 0; i < 2; i++)
#pragma unroll
        for (int j = 0; j < 2; j++)
#pragma unroll
          for (int gp = 0; gp < 2; gp++) {
            const int nc = rb * 128 + wm_ * 64 + i * 32 + 8 * (2 * gp + hh_);
            const int n = ct * 128 + wn_ * 64 + j * 32 + r_;
            const int reim = n >> 9, jj = n & 511;
            uint2 oa, ob;
            oa.x = pack2(acc[i][j][8 * gp], acc[i][j][8 * gp + 1]);
            oa.y = pack2(acc[i][j][8 * gp + 2], acc[i][j][8 * gp + 3]);
            ob.x = pack2(acc[i][j][8 * gp + 4], acc[i][j][8 * gp + 5]);
            ob.y = pack2(acc[i][j][8 * gp + 6], acc[i][j][8 * gp + 7]);
            *(uint4*)(dst + (((size_t)(b * 512 + jj)) * 2 + reim) * 256 + nc) = pair_swap(oa, ob);
          }
    }
  }
}

__device__ __forceinline__ float inv_freq(int i) {
  switch (i) {
    case 0: return 1.0f;
    case 1: return 0.31622776601683794f;
    case 2: return 0.1f;
    case 3: return 0.03162277660168379f;
    case 4: return 0.01f;
    case 5: return 0.0031622776601683794f;
    case 6: return 0.001f;
    default: return 0.00031622776601683794f;
  }
}
__device__ __forceinline__ void rope_cs(int kk, int e, float& cs, float& sn) {
  if (kk < CTXL) { cs = 1.f; sn = 0.f; return; }
  const int tkn = kk - CTXL;
  const float pos = (e < 8) ? (float)(tkn >> 6) : (float)(tkn & 63);
  const float ang = pos * inv_freq(e & 7);
  double xr = (double)ang * 0.31830988618379067;
  xr -= 2.0 * floor(xr * 0.5);
  const float yr = (float)xr;
  cs = cospif(yr);
  sn = sinpif(yr);
}

__device__ __forceinline__ void row_rms(const u16* A, size_t lda, int K, float* rs) {
  const int tid = ltid();
  const int row = tid >> 1, half = tid & 1;
  const u16* pr = A + (size_t)row * lda + half * (K >> 1);
  float s = 0.f;
  for (int c = 0; c < (K >> 1); c += 8) {
    uint4 v = *(const uint4*)(pr + c);
    const uint32_t w[4] = {v.x, v.y, v.z, v.w};
#pragma unroll
    for (int q = 0; q < 4; q++) {
      const float a = __uint_as_float(w[q] << 16), bq = __uint_as_float(w[q] & 0xffff0000u);
      s += a * a + bq * bq;
    }
  }
  s += __shfl_xor(s, 1);
  if (half == 0) rs[row] = rsqrtf(s / (float)K + EPS);
  __syncthreads();
}

__device__ void phase_p2(const Params& p, int l, int bid, int nb, u16* smem) {
  EPI_DECL
  const u16* LAT = wsp<u16>(p, O_LAT);
  float* rs = (float*)(smem + 4 * SM_A);
  const int nQ = NRT * 6, nKV = NRT * 8, nFA = 1024 * 2, nKR = NRT;
  const int total = nQ + nKV + nFA + nKR;
  for (int t = bid; t < total; t += nb) {
    if (t < nQ) {
      const int rt = t / 6, ct = t - rt * 6;
      const int row0 = rt * 128, b = row0 / KPB, kk0 = row0 - b * KPB;
      row_rms(LAT + (size_t)row0 * 512, 512, 256, rs);
      f32x16 acc[2][2];
      zero_acc(acc);
      gemm_core(acc, wsp<u16>(p, O_WUQ) + (size_t)ct * 128 * 256, 256, LAT + (size_t)row0 * 512, 512, 256, smem);
      u16* QM = wsp<u16>(p, O_QM);
      if (ct < 4) {
#pragma unroll
        for (int i = 0; i < 2; i++)
#pragma unroll
          for (int j = 0; j < 2; j++)
#pragma unroll
            for (int gp = 0; gp < 2; gp++) {
              const int rl = wn_ * 64 + j * 32 + r_;
              const int col = ct * 128 + wm_ * 64 + i * 32 + 8 * (2 * gp + hh_);
              const int h = col >> 6, d = col & 63;
              const float sc = rs[rl] * MLA_SCALE_L2;
              uint2 oa, ob;
              oa.x = pack2(acc[i][j][8 * gp] * sc, acc[i][j][8 * gp + 1] * sc);
              oa.y = pack2(acc[i][j][8 * gp + 2] * sc, acc[i][j][8 * gp + 3] * sc);
              ob.x = pack2(acc[i][j][8 * gp + 4] * sc, acc[i][j][8 * gp + 5] * sc);
              ob.y = pack2(acc[i][j][8 * gp + 6] * sc, acc[i][j][8 * gp + 7] * sc);
              *(uint4*)(QM + (size_t)(row0 + rl) * 768 + h * 96 + d) = pair_swap(oa, ob);
            }
      } else {
        const int wt = (ct - 4) * 2 + wm_;
#pragma unroll
        for (int j = 0; j < 2; j++) {
          const int rl = wn_ * 64 + j * 32 + r_;
          const float sc = rs[rl] * MLA_SCALE_L2;
          uint2 p1[4], p2[4];
#pragma unroll
          for (int g = 0; g < 4; g++) {
            const int idx = wt * 32 + 8 * g + 4 * hh_;
            const int e16 = idx & 15;
            float o1[4], o2[4];
#pragma unroll
            for (int q = 0; q < 4; q++) {
              float cs, sn;
              rope_cs(kk0 + rl, e16 + q, cs, sn);
              const float x1 = acc[0][j][4 * g + q] * sc, x2 = acc[1][j][4 * g + q] * sc;
              o1[q] = x1 * cs - x2 * sn;
              o2[q] = x2 * cs + x1 * sn;
            }
            p1[g].x = pack2(o1[0], o1[1]);
            p1[g].y = pack2(o1[2], o1[3]);
            p2[g].x = pack2(o2[0], o2[1]);
            p2[g].y = pack2(o2[2], o2[3]);
          }
#pragma unroll
          for (int gp = 0; gp < 2; gp++) {
            u16* qd = QM + (size_t)(row0 + rl) * 768 + (2 * wt + gp) * 96 + 64 + 8 * hh_;
            *(uint4*)qd = pair_swap(p1[2 * gp], p1[2 * gp + 1]);
            *(uint4*)(qd + 16) = pair_swap(p2[2 * gp], p2[2 * gp + 1]);
          }
        }
      }
      __syncthreads();
    } else if (t < nQ + nKV) {
      const int t2 = t - nQ;
      const int rt = t2 >> 3, ct = t2 & 7;
      const int row0 = rt * 128, b = row0 / KPB, kk0 = row0 - b * KPB;
      row_rms(LAT + (size_t)row0 * 512 + 256, 512, 128, rs);
      f32x16 acc[2][2];
      zero_acc(acc);
      if (ct < 4) {
        gemm_core(acc, wsp<u16>(p, O_WUKV) + (size_t)ct * 128 * 128, 128, LAT + (size_t)row0 * 512 + 256, 512, 128,
                  smem);
        u16* KN = wsp<u16>(p, O_KN);
#pragma unroll
        for (int i = 0; i < 2; i++)
#pragma unroll
          for (int j = 0; j < 2; j++)
#pragma unroll
            for (int gp = 0; gp < 2; gp++) {
              const int rl = wn_ * 64 + j * 32 + r_;
              const int col = ct * 128 + wm_ * 64 + i * 32 + 8 * (2 * gp + hh_);
              const float sc = rs[rl];
              uint2 oa, ob;
              oa.x = pack2(acc[i][j][8 * gp] * sc, acc[i][j][8 * gp + 1] * sc);
              oa.y = pack2(acc[i][j][8 * gp + 2] * sc, acc[i][j][8 * gp + 3] * sc);
              ob.x = pack2(acc[i][j][8 * gp + 4] * sc, acc[i][j][8 * gp + 5] * sc);
              ob.y = pack2(acc[i][j][8 * gp + 6] * sc, acc[i][j][8 * gp + 7] * sc);
              *(uint4*)(KN + (size_t)(row0 + rl) * 512 + col) = pair_swap(oa, ob);
            }
      } else {
        gemm_core(acc, LAT + (size_t)row0 * 512 + 256, 512, wsp<u16>(p, O_WUKV) + (size_t)ct * 128 * 128, 128, 128,
                  smem);
        u16* VMT = wsp<u16>(p, O_VMT);
#pragma unroll
        for (int i = 0; i < 2; i++)
#pragma unroll
          for (int j = 0; j < 2; j++)
#pragma unroll
            for (int gp = 0; gp < 2; gp++) {
              const int ra = wm_ * 64 + i * 32 + 16 * gp + 4 * hh_;
              const int rb2 = ra + 8;
              const int rst = wm_ * 64 + i * 32 + 8 * (2 * gp + hh_);
              const int col = (ct - 4) * 128 + wn_ * 64 + j * 32 + r_;
              uint2 oa, ob;
              oa.x = pack2(acc[i][j][8 * gp] * rs[ra], acc[i][j][8 * gp + 1] * rs[ra + 1]);
              oa.y = pack2(acc[i][j][8 * gp + 2] * rs[ra + 2], acc[i][j][8 * gp + 3] * rs[ra + 3]);
              ob.x = pack2(acc[i][j][8 * gp + 4] * rs[rb2], acc[i][j][8 * gp + 5] * rs[rb2 + 1]);
              ob.y = pack2(acc[i][j][8 * gp + 6] * rs[rb2 + 2], acc[i][j][8 * gp + 7] * rs[rb2 + 3]);
              *(uint4*)(VMT + ((size_t)(b * 512 + col)) * KPB + kk0 + rst) = pair_swap(oa, ob);
            }
      }
      __syncthreads();
    } else if (t < nQ + nKV + nFA) {
      const int t2 = t - nQ - nKV;
      const int rt = t2 >> 1, ct = t2 & 1;
      const int b = rt >> 9, jj = rt & 511;
      f32x16 acc[2][2];
      zero_acc(acc);
      gemm_core(acc, wsp<u16>(p, O_D1) + (size_t)rt * 128 * 256, 256, wsp<u16>(p, O_MA) + (size_t)ct * 128 * 256, 256,
                256, smem);
      const float* TW = wsp<float>(p, O_TW);
      u16* D2 = wsp<u16>(p, O_D2);
      const int klo = ct * 64 + wn_ * 32 + r_;
#pragma unroll
      for (int i = 0; i < 2; i++)
      {
        uint2 pr[4], pi[4];
#pragma unroll
        for (int g = 0; g < 4; g++) {
          const int nlo = wm_ * 64 + i * 32 + 8 * g + 4 * hh_;
          float re[4], im[4];
#pragma unroll
          for (int q = 0; q < 4; q++) {
            const float2 tw = *(const float2*)(TW + ((size_t)klo * 128 + nlo + q) * 2);
            const float ar = acc[i][0][4 * g + q], ai = acc[i][1][4 * g + q];
            re[q] = ar * tw.x + ai * tw.y;
            im[q] = ai * tw.x - ar * tw.y;
          }
          pr[g].x = pack2(re[0], re[1]);
          pr[g].y = pack2(re[2], re[3]);
          pi[g].x = pack2(im[0], im[1]);
          pi[g].y = pack2(im[2], im[3]);
        }
#pragma unroll
        for (int gp = 0; gp < 2; gp++) {
          u16* d = D2 + ((((size_t)(b * 128 + klo)) * 512 + jj) * 2) * 128 + wm_ * 64 + i * 32 + 8 * (2 * gp + hh_);
          *(uint4*)d = pair_swap(pr[2 * gp], pr[2 * gp + 1]);
          *(uint4*)(d + 128) = pair_swap(pi[2 * gp], pi[2 * gp + 1]);
        }
      }
    } else {
      const int rt = t - nQ - nKV - nFA;
      u16* KRR = wsp<u16>(p, O_KRR);
      for (int idx = ltid(); idx < 128 * 16; idx += 256) {
        const int rl = idx >> 4, e16 = idx & 15;
        const int row = rt * 128 + rl, b = row / KPB, kk = row - b * KPB;
        const float x1 = bf2f(LAT[(size_t)row * 512 + 384 + e16]), x2 = bf2f(LAT[(size_t)row * 512 + 400 + e16]);
        float cs, sn;
        rope_cs(kk, e16, cs, sn);
        KRR[(size_t)row * 32 + e16] = f2bf(x1 * cs - x2 * sn);
        KRR[(size_t)row * 32 + 16 + e16] = f2bf(x2 * cs + x1 * sn);
      }
    }
  }
}

template <int MODE>
__device__ void attn_item(const Params& p, int l, int b, int h, int q0  ,
                          int ntiles  , int rs0, int ycol, u16* smem) {
  constexpr int DQK = MODE == 0 ? 96 : 64;
  constexpr int KSTR = DQK + 8;
  constexpr int NKS = DQK / 16;
  constexpr int CPR = DQK / 8;
  constexpr int NKC = 64 * CPR / 256;
  const int tid = ltid(), lane = tid & 63, wave = tid >> 6, r = lane & 31, hh = lane >> 5;
  u16* Ks = smem;
  u16* Vs = smem + 2 * 64 * KSTR;
  const unsigned char* wsb = p.ws;
  const int qk = q0 + wave * 32 + r;
  const size_t qrow = (size_t)b * KPB + qk;
  bf16x8 qf[NKS];
  {
    const u16* qp = MODE == 0 ? wsp<u16>(p, O_QM) + qrow * 768 + h * 96 : wsp<u16>(p, O_QNA) + qrow * 512 + h * 64;
#pragma unroll
    for (int ks = 0; ks < NKS; ks++) qf[ks] = *(const bf16x8*)(qp + ks * 16 + hh * 8);
  }
  const short one_or_zero = hh == 0 ? (short)0x3F80 : (short)0;
  const bf16x8 kone = {one_or_zero, 0, 0, 0, 0, 0, 0, 0};
  bf16x8 qm = {0, 0, 0, 0, 0, 0, 0, 0};
  int qr = 0, qc = 0, rsq = 0, cs = 0;
  const float* rpb = nullptr;
  if (MODE == 1 && rs0 >= 0) {
    const int tkn = qk - CTXL;
    qr = tkn >> 6;
    qc = tkn & 63;
    rsq = min(max(qr - 4, 0), 248);
    cs = min(max(qc - 8, 0), 48);
    rpb = p.rpb + ((size_t)(l * 8 + h)) * 15 * 31;
  }
  f32x16 o[2];
#pragma unroll
  for (int e = 0; e < 16; e++) { o[0][e] = 0.f; o[1][e] = 0.f; }
  float lsum = 0.f;
  float m = 0.f;
  const bf16x8 ones = {(short)0x3F80, (short)0x3F80, (short)0x3F80, (short)0x3F80,
                       (short)0x3F80, (short)0x3F80, (short)0x3F80, (short)0x3F80};

#define KGEO(i)                                                                                          \
  uint32_t kof##i, kmu##i;                                                                               \
  int kls##i;                                                                                            \
  {                                                                                                      \
    const int c = tid + 256 * (i);                                                                       \
    const int row = c / CPR, cc = c - row * CPR;                                                         \
    if (MODE == 0 && cc >= 8) {                                                                          \
      kof##i = (uint32_t)(O_KRR + ((size_t)(b * KPB + row) * 32 + (cc - 8) * 8) * 2);                    \
      kmu##i = 64u;                                                                                      \
    } else {                                                                                             \
      kof##i = (uint32_t)((MODE == 0 ? O_KN : O_KNA) + ((size_t)(b * KPB + row) * 512 + h * 64 + cc * 8) * 2); \
      kmu##i = 1024u;                                                                                    \
    }                                                                                                    \
    kls##i = row * KSTR + cc * 8;                                                                        \
  }
#define VGEO(i)                                                                                          \
  uint32_t vof##i;                                                                                       \
  int vls##i;                                                                                            \
  bool vsx##i;                                                                                           \
  {                                                                                                      \
    const int c = tid + 256 * (i);                                                                       \
    const int d = c >> 3, cc = c & 7;                                                                    \
    vof##i = (uint32_t)((MODE == 0 ? O_VMT : O_VNAT) + ((size_t)(b * 512 + h * 64 + d) * KPB + cc * 8) * 2); \
    vls##i = d * 72 + cc * 8;                                                                            \
    vsx##i = (d & 8) != 0;                                                                               \
  }
  KGEO(0) KGEO(1) KGEO(2) VGEO(0) VGEO(1)
  (void)kof2; (void)kmu2; (void)kls2;
  u32x4 kr0A, kr1A, kr2A, vr0A, vr1A, kr0B, kr1B, kr2B, vr0B, vr1B;
  kr2A = kr1A = kr0A = vr0A = vr1A = kr2B = kr1B = kr0B = vr0B = vr1B = (u32x4){0u, 0u, 0u, 0u};
#define TILE_KK0(t) ((MODE == 1 && (t) >= 4) ? (uint32_t)(CTXL + 64 * min(rs0 + (t)-4, 255)) : (uint32_t)(64 * (t)))
#define LOAD_KV(t, S)                                                                   \
  {                                                                                     \
    const uint32_t kk0_ = TILE_KK0(t);                                                  \
    kr0##S = *(const u32x4*)(wsb + (size_t)(kof0 + kk0_ * kmu0));                       \
    kr1##S = *(const u32x4*)(wsb + (size_t)(kof1 + kk0_ * kmu1));                       \
    if (NKC == 3) kr2##S = *(const u32x4*)(wsb + (size_t)(kof2 + kk0_ * kmu2));         \
    vr0##S = *(const u32x4*)(wsb + (size_t)(vof0 + kk0_ * 2u));                         \
    vr1##S = *(const u32x4*)(wsb + (size_t)(vof1 + kk0_ * 2u));                         \
  }
#define STORE_V1(buf, i, srcv)                                                          \
  {                                                                                     \
    u32x4 sv_ = srcv;                                                                   \
    if (vsx##i) sv_ = (u32x4){sv_[2], sv_[3], sv_[0], sv_[1]};                          \
    *(u32x4*)(Vs + (buf)*64 * 72 + vls##i) = sv_;                                       \
  }
#define STORE_KV(buf, S)                                                                \
  {                                                                                     \
    *(u32x4*)(Ks + (buf)*64 * KSTR + kls0) = kr0##S;                                    \
    *(u32x4*)(Ks + (buf)*64 * KSTR + kls1) = kr1##S;                                    \
    if (NKC == 3) *(u32x4*)(Ks + (buf)*64 * KSTR + kls2) = kr2##S;                      \
    STORE_V1(buf, 0, vr0##S) STORE_V1(buf, 1, vr1##S)                                   \
  }
#define QK_TILE(kbuf, t)                                                                           \
  {                                                                                                \
    const u16* kb_ = Ks + (kbuf)*64 * KSTR + r * KSTR + hh * 8;                                    \
    {                                                                                              \
      f32x16 z_;                                                                                   \
      _Pragma("unroll") for (int e = 0; e < 16; e++) z_[e] = 0.f;                                  \
      sc[0] = __builtin_amdgcn_mfma_f32_32x32x16_bf16(kone, qm, z_, 0, 0, 0);                      \
      sc[1] = sc[0];                                                                               \
    }                                                                                              \
    _Pragma("unroll") for (int ks = 0; ks < NKS; ks++) {                                           \
      const bf16x8 kf0 = *(const bf16x8*)(kb_ + ks * 16);                                          \
      const bf16x8 kf1 = *(const bf16x8*)(kb_ + 32 * KSTR + ks * 16);                              \
      sc[0] = __builtin_amdgcn_mfma_f32_32x32x16_bf16(kf0, qf[ks], sc[0], 0, 0, 0);                \
      sc[1] = __builtin_amdgcn_mfma_f32_32x32x16_bf16(kf1, qf[ks], sc[1], 0, 0, 0);                \
    }                                                                                              \
    if (MODE == 1 && (t) >= 4) {                                                                   \
      const int kr_ = rs0 + (t)-4;                                                                 \
      const bool rowok = (kr_ >= rsq) && (kr_ < rsq + 8);                                          \
      const float* rp = rpb + (kr_ - qr + 7) * 31 + (15 - qc);                                     \
      _Pragma("unroll") for (int kb = 0; kb < 2; kb++) _Pragma("unroll") for (int e = 0; e < 16; e++) { \
        const int kc = kb * 32 + (e & 3) + 8 * (e >> 2) + 4 * hh;                                  \
        const bool valid = rowok && (kc >= cs) && (kc < cs + 16);                                  \
        float bias = 0.f;                                                                          \
        if (valid) bias = rp[kc];                                                                  \
        sc[kb][e] = valid ? sc[kb][e] + bias * LOG2E : -1e30f;                                     \
      }                                                                                            \
    }                                                                                              \
  }
#define TILE_MAX(tmax)                                                                             \
  {                                                                                                \
    tmax = sc[0][0];                                                                               \
    _Pragma("unroll") for (int e = 1; e < 16; e++) tmax = fmaxf(tmax, sc[0][e]);                   \
    _Pragma("unroll") for (int e = 0; e < 16; e++) tmax = fmaxf(tmax, sc[1][e]);                   \
    const uint32_t tu = __float_as_uint(tmax);                                                     \
    const auto sw = __builtin_amdgcn_permlane32_swap(tu, tu, false, false);                        \
    tmax = fmaxf(__uint_as_float(sw[0]), __uint_as_float(sw[1]));                                  \
  }
#define MOVE_REF(mnew_)                                                                            \
  {                                                                                                \
    const float mq_ = bf2f(f2bf(mnew_));                                                           \
    const float delta_ = mq_ - m;                                                                  \
    const float alpha = __builtin_amdgcn_exp2f(-delta_);                                           \
    m = mq_;                                                                                       \
    _Pragma("unroll") for (int e = 0; e < 16; e++) {                                               \
      o[0][e] *= alpha; o[1][e] *= alpha;                                                         \
      sc[0][e] -= delta_; sc[1][e] -= delta_;                                                      \
    }                                                                                              \
    lsum *= alpha;                                                                                 \
    qm[0] = (hh == 0) ? (short)f2bf(-m) : (short)0;                                                \
  }
#define SOFTMAX_PV(vbuf)                                                                           \
  {                                                                                                \
    const u16* vb_ = Vs + (vbuf)*64 * 72 + r * 72 + vsw;                                           \
    _Pragma("unroll") for (int kb = 0; kb < 2; kb++) _Pragma("unroll") for (int st = 0; st < 2; st++) { \
      u32x4 pu;                                                                                    \
      _Pragma("unroll") for (int q = 0; q < 4; q++) {                                              \
        const float p0_ = __builtin_amdgcn_exp2f(sc[kb][8 * st + 2 * q]);                          \
        const float p1_ = __builtin_amdgcn_exp2f(sc[kb][8 * st + 2 * q + 1]);                      \
        lsum += p0_ + p1_;                                                                         \
        pu[q] = pack2(p0_, p1_);                                                                   \
      }                                                                                            \
      const bf16x8 pbv = __builtin_bit_cast(bf16x8, pu);                                           \
      _Pragma("unroll") for (int db = 0; db < 2; db++) {                                           \
        const u16* vp = vb_ + db * 32 * 72 + kb * 32 + 16 * st;                                    \
        const bf16x4 vlo = *(const bf16x4*)(vp);                                                   \
        const bf16x4 vhi = *(const bf16x4*)(vp + 8);                                               \
        const bf16x8 vfv = __builtin_shufflevector(vlo, vhi, 0, 1, 2, 3, 4, 5, 6, 7);              \
        o[db] = __builtin_amdgcn_mfma_f32_32x32x16_bf16(vfv, pbv, o[db], 0, 0, 0);                 \
      }                                                                                            \
    }                                                                                              \
  }
#define DEFER_REF(tmax)                                                                            \
  if (__any(tmax > 8.f)) {                                                                         \
    const float mq_ = bf2f(f2bf(m + fmaxf(tmax, 0.f)));                                            \
    const float alpha = __builtin_amdgcn_exp2f(m - mq_);                                           \
    m = mq_;                                                                                       \
    _Pragma("unroll") for (int e = 0; e < 16; e++) { o[0][e] *= alpha; o[1][e] *= alpha; }       \
    lsum *= alpha;                                                                                 \
    qm[0] = (hh == 0) ? (short)f2bf(-m) : (short)0;                                                \
  }
#define ATT_STEP(t, LD, ST)                                        \
  {                                                                \
    const int cur = (t)&1;                                         \
    QK_TILE(cur, t)                                                \
    __builtin_amdgcn_sched_barrier(0);                             \
    LOAD_KV(min((t) + 2, tl), LD)                                  \
    __builtin_amdgcn_sched_barrier(0);                             \
    __builtin_amdgcn_s_setprio(1);                                 \
    SOFTMAX_PV(cur)                                                \
    __builtin_amdgcn_s_setprio(0);                                 \
    float tmax;                                                    \
    TILE_MAX(tmax)                                                 \
    DEFER_REF(tmax)                                                \
    STORE_KV(cur ^ 1, ST)                                          \
    __syncthreads();                                               \
  }

  const int tl = ntiles - 1;
  const int vsw = 4 * (hh ^ ((r >> 3) & 1));
  f32x16 sc[2];
  LOAD_KV(0, A)
  STORE_KV(0, A)
  LOAD_KV(min(1, tl), A)
  __syncthreads();
  {
    LOAD_KV(min(2, tl), B)
    __builtin_amdgcn_sched_barrier(0);
    QK_TILE(0, 0)
    float tmax;
    TILE_MAX(tmax)
    MOVE_REF(tmax)
    SOFTMAX_PV(0)
    STORE_KV(1, A)
    __syncthreads();
  }
  for (int t = 1; t + 1 < ntiles; t += 2) {
    ATT_STEP(t, A, B)
    ATT_STEP(t + 1, B, A)
  }
  ATT_STEP(tl, A, B)
  const float inv = 1.f / (lsum + __shfl_xor(lsum, 32));
  u16* yp = wsp<u16>(p, O_Y) + qrow * 1536 + ycol + h * 64;
#pragma unroll
  for (int db = 0; db < 2; db++)
#pragma unroll
    for (int gp = 0; gp < 2; gp++) {
      uint2 oa, ob;
      oa.x = pack2(o[db][8 * gp] * inv, o[db][8 * gp + 1] * inv);
      oa.y = pack2(o[db][8 * gp + 2] * inv, o[db][8 * gp + 3] * inv);
      ob.x = pack2(o[db][8 * gp + 4] * inv, o[db][8 * gp + 5] * inv);
      ob.y = pack2(o[db][8 * gp + 6] * inv, o[db][8 * gp + 7] * inv);
      *(uint4*)(yp + db * 32 + 8 * (2 * gp + hh)) = pair_swap(oa, ob);
    }
#undef KGEO
#undef VGEO
#undef TILE_KK0
#undef LOAD_KV
#undef STORE_V1
#undef STORE_KV
#undef QK_TILE
#undef TILE_MAX
#undef MOVE_REF
#undef SOFTMAX_PV
#undef ATT_STEP
#undef DEFER_REF
}

__device__ void phase_p3(const Params& p, int l, bool last, int bid, int nb, u16* smem) {
  EPI_DECL
  const int nMLA = 2048, nNA = 2048, nFB = 1024;
  const int nC = last ? 0 : (32 + 32 + 16);
  const int total = nMLA + nNA + nFB + nC;
  for (int t = bid; t < total; t += nb) {
    int kind, b = 0, h = 0, q0 = 0, ntl = 0, rs0 = -1;
    size_t aoff = 0, boff = 0;
    int Kf = 256, j0 = 0, tok0 = 0, tokmul = 1, colbase = 0;
    if (t < nMLA) {
      kind = 0;
      h = t & 7;
      const int rest = t >> 3;
      b = rest >> 7;
      q0 = CTXL + (rest & 127) * 128;
      ntl = 260;
    } else if (t < nMLA + nNA) {
      kind = 1;
      const int t2 = t - nMLA;
      h = t2 & 7;
      const int rest = t2 >> 3, rp = rest & 127;
      b = rest >> 7;
      rs0 = min(max(2 * rp - 4, 0), 248);
      const int rs1 = min(max(2 * rp + 1 - 4, 0), 248);
      q0 = CTXL + rp * 128;
      ntl = (4 + (rs1 + 8 - rs0) + 1) & ~1;
    } else if (t < nMLA + nNA + nFB) {
      kind = 2;
      const int rt = t - nMLA - nNA;
      const int bk = rt >> 2;
      j0 = (rt & 3) * 128;
      b = bk >> 7;
      tok0 = CTXL + (bk & 127);
      tokmul = 128;
      aoff = O_D2 + (size_t)rt * 128 * 256 * 2;
      boff = O_MB;
      Kf = 256;
    } else {
      const int t2 = t - nMLA - nNA - nFB;
      if (t2 < 64) {
        kind = t2 >> 5;
        const int t3 = t2 & 31;
        h = t3 & 7;
        b = (t3 >> 3) & 1;
        q0 = (t3 >> 4) * 128;
        ntl = 4;
      } else {
        kind = 2;
        const int t3 = t2 - 64;
        const int rt = t3 >> 1, ct = t3 & 1;
        b = rt >> 2;
        j0 = (rt & 3) * 128;
        colbase = ct * 128;
        aoff = O_D1C + (size_t)rt * 128 * 512 * 2;
        boff = O_MC + (size_t)ct * 128 * 512 * 2;
        Kf = 512;
      }
    }
    if (kind == 0) {
      attn_item<0>(p, l, b, h, q0, ntl, -1, 1024, smem);
    } else if (kind == 1) {
      attn_item<1>(p, l, b, h, q0, ntl, rs0, 512, smem);
    } else {
      f32x16 acc[2][2];
      zero_acc(acc);
      gemm_core(acc, wsp<u16>(p, aoff), Kf, wsp<u16>(p, boff), Kf, Kf, smem);
      u16* Y = wsp<u16>(p, O_Y);
#pragma unroll
      for (int i = 0; i < 2; i++)
#pragma unroll
        for (int j = 0; j < 2; j++)
#pragma unroll
          for (int gp = 0; gp < 2; gp++) {
            const int jj = j0 + wm_ * 64 + i * 32 + 8 * (2 * gp + hh_);
            const int tok = tok0 + (colbase + wn_ * 64 + j * 32 + r_) * tokmul;
            uint2 oa, ob;
            oa.x = pack2(acc[i][j][8 * gp], acc[i][j][8 * gp + 1]);
            oa.y = pack2(acc[i][j][8 * gp + 2], acc[i][j][8 * gp + 3]);
            ob.x = pack2(acc[i][j][8 * gp + 4], acc[i][j][8 * gp + 5]);
            ob.y = pack2(acc[i][j][8 * gp + 6], acc[i][j][8 * gp + 7]);
            *(uint4*)(Y + ((size_t)b * KPB + tok) * 1536 + jj) = pair_swap(oa, ob);
          }
    }
  }
}

__device__ __forceinline__ int n_row_tiles(bool last) { return last ? NRT - 4 : NRT; }
__device__ __forceinline__ int row_tile(bool last, int i) {
  if (!last) return i;
  return i < 128 ? i + 2 : i + 4;
}

__device__ void phase_p4(const Params& p, int l, bool last, int bid, int nb, u16* smem) {
  EPI_DECL
  const u16* A = wsp<u16>(p, O_A);
  const u16* Y = wsp<u16>(p, O_Y);
  u16* M = wsp<u16>(p, O_M);
  uint4* stash = wsp<uint4>(p, O_QM) + (size_t)bid * 24 * 256 + ltid();
  const int nrt_ = n_row_tiles(last);
  PATCH_LOOP_BEGIN(nrt_, 8, 8, 8)
    const int rt = row_tile(last, prt), ct = pct;
    f32x16 mg[2][2];
    zero_acc(mg);
#pragma unroll 1
    for (int g = 0; g < 3; g++) {
      uint32_t gp[2][2][8];
      {
        f32x16 acc[2][2];
        zero_acc(acc);
        gemm_core<true>(acc, wsp<u16>(p, O_WG) + (size_t)(g * 1024 + ct * 128) * D, D, A + (size_t)rt * 128 * D, D, D,
                        smem);
#pragma unroll
        for (int i = 0; i < 2; i++)
#pragma unroll
          for (int j = 0; j < 2; j++)
#pragma unroll
            for (int e = 0; e < 8; e++)
              gp[i][j][e] = pack2(fsigmoid(acc[i][j][2 * e]), fsigmoid(acc[i][j][2 * e + 1]));
      }
      {
        f32x16 acc[2][2];
        zero_acc(acc);
        gemm_core<false>(acc, wsp<u16>(p, O_WB) + (size_t)(g * 1024 + ct * 128) * 512, 512,
                         Y + (size_t)rt * 128 * 1536 + g * 512, 1536, 512, smem);
#pragma unroll
        for (int i = 0; i < 2; i++)
#pragma unroll
          for (int j = 0; j < 2; j++)
#pragma unroll
            for (int e = 0; e < 8; e++) {
              mg[i][j][2 * e] += __uint_as_float(gp[i][j][e] << 16) * acc[i][j][2 * e];
              mg[i][j][2 * e + 1] += __uint_as_float(gp[i][j][e] & 0xffff0000u) * acc[i][j][2 * e + 1];
            }
      }
    }
#pragma unroll
    for (int i = 0; i < 2; i++)
#pragma unroll
      for (int j = 0; j < 2; j++)
#pragma unroll
        for (int gp = 0; gp < 2; gp++) {
          const int row = rt * 128 + wn_ * 64 + j * 32 + r_;
          const int col = ct * 128 + wm_ * 64 + i * 32 + 8 * (2 * gp + hh_);
          uint2 oa, ob;
          oa.x = pack2(mg[i][j][8 * gp], mg[i][j][8 * gp + 1]);
          oa.y = pack2(mg[i][j][8 * gp + 2], mg[i][j][8 * gp + 3]);
          ob.x = pack2(mg[i][j][8 * gp + 4], mg[i][j][8 * gp + 5]);
          ob.y = pack2(mg[i][j][8 * gp + 6], mg[i][j][8 * gp + 7]);
          *(uint4*)(M + (size_t)row * D + col) = pair_swap(oa, ob);
        }
  PATCH_LOOP_END
}

__device__ void phase_resid(const Params& p, int l, bool last, const u16* Ain, size_t lda, const u16* W, int K, int goff,
                            int bid, int nb, u16* smem) {
  EPI_DECL
  const float* mod = wsp<float>(p, O_MOD);
  const int nrt_ = n_row_tiles(last);
  PATCH_LOOP_BEGIN(nrt_, 8, 8, 8)
    const int rt = row_tile(last, prt), ct = pct;
    f32x16 acc[2][2];
    zero_acc(acc);
    gemm_core(acc, W + (size_t)ct * 128 * K, K, Ain + (size_t)rt * 128 * lda, lda, K, smem);
    const int row0 = rt * 128, b = row0 / KPB, kk0 = row0 - b * KPB;
    const int m = kk0 < CTXL ? 2 : b;
    float* xb = xrow(p, row0);
    const float* gv = mod + ((size_t)l * 3 + m) * 6144 + goff;
#pragma unroll
    for (int i = 0; i < 2; i++)
#pragma unroll
      for (int g = 0; g < 4; g++) {
        const int col = ct * 128 + wm_ * 64 + i * 32 + 8 * g + 4 * hh_;
        const float4 g4 = *(const float4*)(gv + col);
#pragma unroll
        for (int j = 0; j < 2; j++) {
          const int rl = wn_ * 64 + j * 32 + r_;
          float4* xp = (float4*)(xb + (size_t)rl * D + col);
          float4 xv = *xp;
          xv.x = ALPHA * xv.x + (1.f + g4.x) * acc[i][j][4 * g];
          xv.y = ALPHA * xv.y + (1.f + g4.y) * acc[i][j][4 * g + 1];
          xv.z = ALPHA * xv.z + (1.f + g4.z) * acc[i][j][4 * g + 2];
          xv.w = ALPHA * xv.w + (1.f + g4.w) * acc[i][j][4 * g + 3];
          *xp = xv;
        }
      }
  PATCH_LOOP_END
}

__device__ void phase_p7(const Params& p, int l, bool last, int bid, int nb, u16* smem) {
  EPI_DECL
  const u16* A = wsp<u16>(p, O_A);
  u16* HH = wsp<u16>(p, O_HH);
  const int nrt_ = n_row_tiles(last);
  PATCH_LOOP_BEGIN(nrt_, 44, 16, 4)
    const int rt = row_tile(last, prt), ct = pct;
    f32x16 acc[2][2];
    zero_acc(acc);
    gemm_core(acc, wsp<u16>(p, O_WGU) + (size_t)ct * 128 * D, D, A + (size_t)rt * 128 * D, D, D, smem);
#pragma unroll
    for (int j = 0; j < 2; j++)
#pragma unroll
      for (int gp = 0; gp < 2; gp++) {
        const int row = rt * 128 + wn_ * 64 + j * 32 + r_;
        const int q = (ct * 2 + wm_) * 32 + 8 * (2 * gp + hh_);
        float hv[8];
#pragma unroll
        for (int t = 0; t < 8; t++) {
          const float gt = acc[0][j][8 * gp + t], up = acc[1][j][8 * gp + t];
          hv[t] = gt * fsigmoid(gt) * up;
        }
        uint2 oa, ob;
        oa.x = pack2(hv[0], hv[1]);
        oa.y = pack2(hv[2], hv[3]);
        ob.x = pack2(hv[4], hv[5]);
        ob.y = pack2(hv[6], hv[7]);
        *(uint4*)(HH + (size_t)row * FH + q) = pair_swap(oa, ob);
      }
  PATCH_LOOP_END
}

constexpr int NPHASE = 3 + 9 * 2;

__device__ void run_phase(const Params& p, int ph, int bid, int nb, u16* smem) {
  if (ph == 0) {
    prep_tables(p, bid, nb);
    prep_modp(p, bid, nb);
    prep_weights(p, 0, bid, nb, smem);
    return;
  }
  if (ph == 1) { prep_modr(p, bid, nb); return; }
  if (ph == 2) { ln_phase(p, 0, p.ln_in_g, p.ln_in_b, 0, 0, 1024, false, bid, nb); return; }
  const int l = (ph - 3) / 9, s = (ph - 3) % 9;
  const bool last = (l == 1);
  switch (s) {
    case 0: phase_p1(p, l, last, bid, nb, smem); break;
    case 1: phase_p2(p, l, bid, nb, smem); break;
    case 2: phase_p3(p, l, last, bid, nb, smem); break;
    case 3: phase_p4(p, l, last, bid, nb, smem); break;
    case 4: phase_resid(p, l, last, wsp<u16>(p, O_M), D, wsp<u16>(p, O_WO), D, 2048, bid, nb, smem); break;
    case 5: ln_phase(p, 1, p.ln1_g + l * D, p.ln1_b + l * D, l, 3072, 4096, last, bid, nb); break;
    case 6: phase_p7(p, l, last, bid, nb, smem); break;
    case 7: phase_resid(p, l, last, wsp<u16>(p, O_HH), FH, wsp<u16>(p, O_WD), FH, 5120, bid, nb, smem); break;
    default:
      ln_phase(p, 1, p.ln2_g + l * D, p.ln2_b + l * D, last ? -1 : l + 1, 0, 1024, last, bid, nb);
      if (!last) prep_weights(p, l + 1, bid, nb, smem);
      break;
  }
}


#define XB_TMO      128
#define XB_XCNT(j)  (256  + 64 * (j))
#define XB_XSUB(j)  (1280 + 64 * (j))
#define XB_XGEN(j)  (2304 + 64 * (j))
#define XB_TOP      3328
#define XB_TOPGEN   3392
#define XCD_BAR_WORDS 3456
#define XB_SPIN_CAP (1u << 20)
#define LAS __attribute__((address_space(3)))
__device__ __forceinline__ unsigned xb_ld(unsigned* p) { return __hip_atomic_load(p, __ATOMIC_RELAXED, __HIP_MEMORY_SCOPE_AGENT); }
__device__ __forceinline__ unsigned xb_add(unsigned* p, unsigned v) { return __hip_atomic_fetch_add(p, v, __ATOMIC_RELAXED, __HIP_MEMORY_SCOPE_AGENT); }
__device__ __forceinline__ unsigned xb_xcc_id() { return (unsigned)__builtin_amdgcn_s_getreg((3 << 11) | 20) & 0xFu; }
#define XB_SPIN(cond, bar) do { unsigned _sp = 0; while (cond) { __builtin_amdgcn_s_sleep(1); \
    if ((++_sp & 255u) == 0u) { if (xb_ld(&(bar)[XB_TMO])) break; if (_sp > XB_SPIN_CAP) { atomicAdd(&(bar)[XB_TMO], 1u); break; } } } } while (0)
struct XcdBarrier {
  unsigned* bar; unsigned x;
  volatile LAS unsigned* st;
};
__device__ __forceinline__ XcdBarrier xcd_barrier_post(unsigned* bar, volatile LAS unsigned* st) {
  XcdBarrier b; b.bar = bar; b.x = xb_xcc_id(); b.st = st;
  if (threadIdx.x == 0) (void)xb_add(&bar[XB_XCNT(b.x)], 1u);
  return b;
}
__device__ __forceinline__ void xcd_barrier_complete(unsigned* bar, unsigned x, unsigned& nloc, unsigned& nx) {
  const unsigned G = gridDim.x * gridDim.y * gridDim.z;
  unsigned sum, cnt, mine, sp = 0u;
  for (;;) {
    sum = 0u; cnt = 0u; mine = 0u;
#pragma unroll
    for (unsigned j = 0; j < 16; ++j) { const unsigned c = xb_ld(&bar[XB_XCNT(j)]); sum += c; cnt += (c > 0u) ? 1u : 0u; mine = (j == x) ? c : mine; }
    if (sum == G) break;
    __builtin_amdgcn_s_sleep(1);
    if ((++sp & 255u) == 0u) { if (xb_ld(&bar[XB_TMO])) break; if (sp > XB_SPIN_CAP) { atomicAdd(&bar[XB_TMO], 1u); break; } }
  }
  nloc = mine > 0u ? mine : 1u; nx = cnt > 0u ? cnt : 1u;
}
__device__ __forceinline__ void xcd_barrier(const XcdBarrier& b) {
  asm volatile("s_waitcnt vmcnt(0)" ::: "memory");
  __syncthreads();
  if (threadIdx.x == 0) {
    unsigned* bar = b.bar;
    __builtin_amdgcn_s_waitcnt(0);
    unsigned nloc = b.st[0], nx = b.st[1];
    if (nloc == 0u) { xcd_barrier_complete(bar, b.x, nloc, nx); b.st[0] = nloc; b.st[1] = nx; }
    const unsigned old = xb_add(&bar[XB_XSUB(b.x)], 1u);
    const unsigned gen = old / nloc;
    if (old + 1u == (gen + 1u) * nloc) {
      __builtin_amdgcn_fence(__ATOMIC_RELEASE, "agent");
      asm volatile("s_waitcnt vmcnt(0)" ::: "memory");
      const unsigned og = xb_add(&bar[XB_TOP], 1u);
      const unsigned tg = og / nx;
      if (og + 1u == (tg + 1u) * nx) xb_add(&bar[XB_TOPGEN], 1u);
      else XB_SPIN(xb_ld(&bar[XB_TOPGEN]) == tg, bar);
      __builtin_amdgcn_fence(__ATOMIC_ACQUIRE, "agent");
      xb_add(&bar[XB_XGEN(b.x)], 1u);
      asm volatile("s_waitcnt vmcnt(0)" ::: "memory");
    } else {
      XB_SPIN(xb_ld(&bar[XB_XGEN(b.x)]) == gen, bar);
      __builtin_amdgcn_fence(__ATOMIC_ACQUIRE, "agent");
      asm volatile("s_waitcnt vmcnt(0)" ::: "memory");
    }
  }
  __syncthreads();
}

constexpr int SMEM_ELEMS = 4 * SM_A + 256 + 8;

#if COOP
__global__ void __launch_bounds__(256, 2) mega_kernel(Params p) {
  __shared__ __attribute__((aligned(16))) u16 smem[SMEM_ELEMS];
  cg::grid_group grid = cg::this_grid();
  volatile LAS unsigned* st = (volatile LAS unsigned*)(smem + 4 * SM_A + 256);
  if (threadIdx.x == 0) { st[0] = 0u; st[1] = 0u; }
  __syncthreads();
  XcdBarrier xb = xcd_barrier_post((unsigned*)(p.ws + O_BAR), st);
  for (int ph = 0; ph < NPHASE; ph++) {
#ifdef PROBE_MASK
    const int s9 = ph >= 3 ? (ph - 3) % 9 : -1;
    const int nrep = (s9 >= 0 && ((PROBE_MASK >> s9) & 1)) ? 2 : 1;
    for (int rep = 0; rep < nrep; rep++) {
      run_phase(p, ph, blockIdx.x, gridDim.x, smem);
      if (ph == 0) grid.sync();
      else if (ph + 1 < NPHASE || rep + 1 < nrep) xcd_barrier(xb);
    }
#else
    run_phase(p, ph, blockIdx.x, gridDim.x, smem);
    if (ph == 0) grid.sync();
    else if (ph + 1 < NPHASE) xcd_barrier(xb);
#endif
  }
}
#else
__global__ void __launch_bounds__(256, 2) phase_kernel(Params p, int ph) {
  __shared__ __attribute__((aligned(16))) u16 smem[SMEM_ELEMS];
  run_phase(p, ph, blockIdx.x, gridDim.x, smem);
}
#endif

extern "C" void kernel_launch(void* const* d_in, const int* in_sizes, int n_in, void* d_out, int out_size, void* d_ws,
                              size_t ws_size, hipStream_t stream) {
  Params p{};
  const float** f = (const float**)&p;
  for (int i = 0; i < 25; i++) f[i] = (const float*)d_in[i];
  p.out = (float*)d_out;
  p.ws = (unsigned char*)d_ws;
  if (ws_size < O_WSEND) fprintf(stderr, "workspace too small: %zu < %zu\n", ws_size, (size_t)O_WSEND);
#if COOP
  static int grid_blocks = 0;
  if (!grid_blocks) {
    int dev = 0, cus = 0, per_cu = 0;
    hipGetDevice(&dev);
    hipDeviceGetAttribute(&cus, hipDeviceAttributeMultiprocessorCount, dev);
    hipOccupancyMaxActiveBlocksPerMultiprocessor(&per_cu, mega_kernel, 256, 0);
    if (per_cu > 2) per_cu = 2;
    grid_blocks = cus * per_cu;
  }
  (void)hipMemsetAsync(p.ws + O_BAR, 0, 3456 * 4, stream);
  void* args[] = {&p};
  hipError_t e = hipLaunchCooperativeKernel((void*)mega_kernel, dim3(grid_blocks), dim3(256), args, 0, stream);
  if (e != hipSuccess) fprintf(stderr, "cooperative launch failed: %s (grid %d)\n", hipGetErrorString(e), grid_blocks);
#else
  for (int ph = 0; ph < NPHASE; ph++) phase_kernel<<<512, 256, 0, stream>>>(p, ph);
#endif
}
```

```cpp
#include <hip/hip_runtime.h>
#include <hip/hip_cooperative_groups.h>
#include <stdint.h>
#include <cstdio>
namespace cg = cooperative_groups;

#ifndef COOP
#define COOP 1
#endif

typedef __attribute__((ext_vector_type(8))) short bf16x8;
typedef __attribute__((ext_vector_type(4))) short bf16x4;
typedef __attribute__((ext_vector_type(16))) float f32x16;
typedef unsigned short u16;
typedef __attribute__((ext_vector_type(4))) unsigned int u32x4;

constexpr int D = 1024;
constexpr int NBATCH = 2;
constexpr int SEQ = 16384;
constexpr int CTXL = 256;
constexpr int KPB = SEQ + CTXL;
constexpr int T = NBATCH * KPB;
constexpr int NRT = T / 128;
constexpr int FH = 2816;
constexpr int IN_DIM = 5536;
constexpr float LOG2E = 1.4426950408889634f;
constexpr float NA_SCALE_L2 = 0.125f * LOG2E;
constexpr float MLA_SCALE_L2 = 0.10206207261596575f * LOG2E;
constexpr float ALPHA = 1.4142135623730951f;
constexpr float EPS = 1e-5f;
constexpr float RS128 = 0.08838834764831845f;

constexpr size_t al256(size_t x) { return (x + 255) & ~(size_t)255; }
constexpr size_t O_WF = 0;
constexpr size_t O_WP = O_WF + (size_t)1024 * 1024 * 2;
constexpr size_t O_WG = O_WP + (size_t)2048 * 1024 * 2;
constexpr size_t O_WUQ = O_WG + (size_t)3072 * 1024 * 2;
constexpr size_t O_WUKV = O_WUQ + (size_t)768 * 256 * 2;
constexpr size_t O_WB = O_WUKV + (size_t)1024 * 128 * 2;
constexpr size_t O_WO = O_WB + (size_t)3 * 1024 * 512 * 2;
constexpr size_t O_WGU = O_WO + (size_t)1024 * 1024 * 2;
constexpr size_t O_WD = O_WGU + (size_t)5632 * 1024 * 2;
constexpr size_t O_MA = O_WD + (size_t)1024 * 2816 * 2;
constexpr size_t O_MB = O_MA + (size_t)256 * 256 * 2;
constexpr size_t O_MC = O_MB + (size_t)128 * 256 * 2;
constexpr size_t O_TW = O_MC + (size_t)256 * 512 * 2;
constexpr size_t O_MODP = O_TW + (size_t)128 * 128 * 2 * 4;
constexpr size_t O_MOD = O_MODP + (size_t)16 * 2 * 3 * 6144 * 4;
constexpr size_t O_XCTX = O_MOD + (size_t)2 * 3 * 6144 * 4;
constexpr size_t O_D1C = O_XCTX + (size_t)512 * 1024 * 4;
constexpr size_t O_A = O_D1C + (size_t)2 * 512 * 2 * 256 * 2;
constexpr size_t O_RQ = O_A + (size_t)T * 1024 * 2;
constexpr size_t O_QNA = O_RQ;
constexpr size_t O_KNA = O_QNA + (size_t)T * 512 * 2;
constexpr size_t O_VNAT = O_KNA + (size_t)T * 512 * 2;
constexpr size_t O_RY = O_VNAT + (size_t)T * 512 * 2;
constexpr size_t O_Y = O_RY;
constexpr size_t O_D1 = O_RY;
constexpr size_t O_LAT = O_RY + (size_t)67108864;
constexpr size_t O_D2 = O_RY + (size_t)T * 1536 * 2;
constexpr size_t O_QM = O_D2 + (size_t)67108864;
constexpr size_t O_KN = O_QM + (size_t)T * 768 * 2;
constexpr size_t O_KRR = O_KN + (size_t)T * 512 * 2;
constexpr size_t O_VMT = O_KRR + (size_t)T * 32 * 2;
constexpr size_t O_END = O_VMT + (size_t)T * 512 * 2;
constexpr size_t O_BAR = (O_END + 255) & ~(size_t)255;
constexpr size_t O_WSEND = O_BAR + 3456 * 4;
constexpr size_t O_M = O_RQ;
constexpr size_t O_HH = O_RQ;

struct Params {
  const float *x, *c, *ctx, *c_ctx, *ln_in_g, *ln_in_b, *w_mod, *b_mod, *w_in, *gq, *gkv, *w_uq, *w_qr, *w_uk,
      *w_uv, *rpb, *w_branch, *w_out, *ln1_g, *ln1_b, *ln2_g, *ln2_b, *w_gate, *w_up, *w_down;
  float* out;
  unsigned char* ws;
};

__device__ __forceinline__ u16 f2bf(float f) {
  uint32_t u = __float_as_uint(f);
  u += 0x7fffu + ((u >> 16) & 1u);
  return (u16)(u >> 16);
}
typedef __attribute__((ext_vector_type(2))) __bf16 bf16v2;
typedef __attribute__((ext_vector_type(2))) float f32v2;
__device__ __forceinline__ uint32_t pack2(float a, float b) {
  const f32v2 v = {a, b};
  return __builtin_bit_cast(uint32_t, __builtin_convertvector(v, bf16v2));
}
__device__ __forceinline__ uint4 pair_swap(uint2 a, uint2 b) {
  const auto rx = __builtin_amdgcn_permlane32_swap(a.x, b.x, false, false);
  const auto ry = __builtin_amdgcn_permlane32_swap(a.y, b.y, false, false);
  return make_uint4(rx[0], ry[0], rx[1], ry[1]);
}
__device__ __forceinline__ float bf2f(u16 v) { return __uint_as_float(((uint32_t)v) << 16); }
__device__ __forceinline__ float wsum(float v) {
#pragma unroll
  for (int o = 32; o > 0; o >>= 1) v += __shfl_xor(v, o);
  return v;
}
__device__ __forceinline__ float fsigmoid(float v) { return 1.f / (1.f + __expf(-v)); }

__device__ __forceinline__ int ltid() {
  int t = threadIdx.x;
  asm volatile("" : "+v"(t));
  return t;
}

template <typename Tp>
__device__ __forceinline__ Tp* wsp(const Params& p, size_t off) { return (Tp*)(p.ws + off); }

__device__ __forceinline__ float* xrow(const Params& p, int row) {
  int b = row / KPB, kk = row - b * KPB;
  if (kk < CTXL) return wsp<float>(p, O_XCTX) + (size_t)(b * CTXL + kk) * D;
  return p.out + (size_t)(b * SEQ + kk - CTXL) * D;
}

constexpr int LSTR = 72;
constexpr int SM_A = 128 * LSTR;

template <bool DEEP = true>
__device__ __forceinline__ void gemm_core(f32x16 (&acc)[2][2], const u16* __restrict__ A, size_t lda,
                                          const u16* __restrict__ B, size_t ldb, int K, u16* smem) {
  const int tid = ltid(), lane = tid & 63, wave = tid >> 6;
  const int wm = wave >> 1, wn = wave & 1, r = lane & 31, hh = lane >> 5;
  u16* sA = smem;
  u16* sB = smem + 2 * SM_A;
  const int lrow = tid >> 3, lkc = (tid & 7) * 8;
  const unsigned char* gab = (const unsigned char*)A;
  const unsigned char* gbb = (const unsigned char*)B;
  uint32_t oa[4], ob[4];
#pragma unroll
  for (int i = 0; i < 4; i++) {
    oa[i] = (uint32_t)(((size_t)(lrow + 32 * i) * lda + lkc) * 2);
    ob[i] = (uint32_t)(((size_t)(lrow + 32 * i) * ldb + lkc) * 2);
  }
  u16* wa = sA + lrow * LSTR + lkc;
  u16* wb = sB + lrow * LSTR + lkc;
  const u16* pa = sA + (wm * 64 + r) * LSTR + hh * 8;
  const u16* pb = sB + (wn * 64 + r) * LSTR + hh * 8;
  u32x4 a0r[4], b0r[4], a1r[4], b1r[4];
#define G_LOAD(ar, br, ko)                                               \
  _Pragma("unroll") for (int i = 0; i < 4; i++) {                        \
    ar[i] = *(const u32x4*)(gab + (size_t)(ko)*2 + oa[i]);               \
    br[i] = *(const u32x4*)(gbb + (size_t)(ko)*2 + ob[i]);               \
  }
#define G_STORE(ar, br, buf)                                             \
  _Pragma("unroll") for (int i = 0; i < 4; i++) {                        \
    *(u32x4*)(wa + (buf)*SM_A + 32 * i * LSTR) = ar[i];                  \
    *(u32x4*)(wb + (buf)*SM_A + 32 * i * LSTR) = br[i];                  \
  }
#define G_COMPUTE(buf)                                                                   \
  _Pragma("unroll") for (int ks = 0; ks < 4; ks++) {                                     \
    const bf16x8 fa0 = *(const bf16x8*)(pa + (buf)*SM_A + ks * 16);                      \
    const bf16x8 fa1 = *(const bf16x8*)(pa + (buf)*SM_A + 32 * LSTR + ks * 16);          \
    const bf16x8 fb0 = *(const bf16x8*)(pb + (buf)*SM_A + ks * 16);                      \
    const bf16x8 fb1 = *(const bf16x8*)(pb + (buf)*SM_A + 32 * LSTR + ks * 16);          \
    acc[0][0] = __builtin_amdgcn_mfma_f32_32x32x16_bf16(fa0, fb0, acc[0][0], 0, 0, 0);   \
    acc[0][1] = __builtin_amdgcn_mfma_f32_32x32x16_bf16(fa0, fb1, acc[0][1], 0, 0, 0);   \
    acc[1][0] = __builtin_amdgcn_mfma_f32_32x32x16_bf16(fa1, fb0, acc[1][0], 0, 0, 0);   \
    acc[1][1] = __builtin_amdgcn_mfma_f32_32x32x16_bf16(fa1, fb1, acc[1][1], 0, 0, 0);   \
  }
  const int nk = K >> 6;
  if (DEEP) {
    G_LOAD(a0r, b0r, 0)
    G_LOAD(a1r, b1r, 64)
    G_STORE(a0r, b0r, 0)
    __syncthreads();
    const int klast = (nk - 1) * 64;
    G_LOAD(a0r, b0r, min(128, klast))
    for (int kt = 0; kt < nk; kt += 2) {
      G_COMPUTE(0)
      G_STORE(a1r, b1r, 1)
      __syncthreads();
      G_LOAD(a1r, b1r, min((kt + 3) * 64, klast))
      __builtin_amdgcn_sched_barrier(0);
      G_COMPUTE(1)
      G_STORE(a0r, b0r, 0)
      __syncthreads();
      G_LOAD(a0r, b0r, min((kt + 4) * 64, klast))
      __builtin_amdgcn_sched_barrier(0);
    }
  } else {
    G_LOAD(a0r, b0r, 0)
    G_STORE(a0r, b0r, 0)
    __syncthreads();
    for (int kt = 0; kt < nk; kt += 2) {
      G_LOAD(a0r, b0r, (kt + 1) * 64)
      G_COMPUTE(0)
      G_STORE(a0r, b0r, 1)
      __syncthreads();
      if (kt + 2 < nk) G_LOAD(a0r, b0r, (kt + 2) * 64)
      G_COMPUTE(1)
      if (kt + 2 < nk) G_STORE(a0r, b0r, 0)
      __syncthreads();
    }
  }
#undef G_LOAD
#undef G_STORE
#undef G_COMPUTE
}

__device__ __forceinline__ void zero_acc(f32x16 (&acc)[2][2]) {
#pragma unroll
  for (int i = 0; i < 2; i++)
#pragma unroll
    for (int j = 0; j < 2; j++)
#pragma unroll
      for (int e = 0; e < 16; e++) acc[i][j][e] = 0.f;
}

#define EPI_DECL                                                     \
  const int lane_ = ltid() & 63, wave_ = ltid() >> 6;      \
  const int wm_ = wave_ >> 1, wn_ = wave_ & 1, r_ = lane_ & 31, hh_ = lane_ >> 5; \
  (void)wm_; (void)wn_; (void)r_; (void)hh_;

__device__ __forceinline__ const float* src_col(const Params& p, int l, int kind, int n, int& ld) {
  switch (kind) {
    case 0:
      ld = IN_DIM;
      return n < 1952 ? p.w_in + (size_t)l * D * IN_DIM + 512 + n : nullptr;
    case 1:
      ld = IN_DIM;
      return p.w_in + (size_t)l * D * IN_DIM + 2464 + n;
    case 2:
      if (n < 512) {
        ld = 512;
        return p.w_uq + (size_t)l * 256 * 512 + n;
      } else {
        int m = n - 512, wt = m >> 6, jb = (m >> 5) & 1, idx = wt * 32 + (m & 31);
        int h = idx >> 4, e = idx & 15;
        ld = 256;
        return p.w_qr + (size_t)l * 256 * 256 + h * 32 + jb * 16 + e;
      }
    case 3:
      ld = 512;
      return n < 512 ? p.w_uk + (size_t)l * 128 * 512 + n : p.w_uv + (size_t)l * 128 * 512 + (n - 512);
    case 4: {
      int g = n >> 10, nn = n & 1023;
      ld = 1024;
      return p.w_branch + ((size_t)(l * 3 + g) * 512) * 1024 + nn;
    }
    case 5:
      ld = 1024;
      return p.w_out + (size_t)l * D * D + n;
    case 6: {
      int jb = (n >> 5) & 1, q = (n >> 6) * 32 + (n & 31);
      ld = FH;
      return (jb ? p.w_up : p.w_gate) + (size_t)l * D * FH + q;
    }
    default:
      ld = 1024;
      return p.w_down + (size_t)l * FH * D + n;
  }
}

__device__ __forceinline__ int job_nd(int k) {
  switch (k) { case 0: return 2048; case 1: return 3072; case 2: return 768; case 3: return 1024; case 4: return 3072;
    case 5: return 1024; case 6: return 5632; default: return 1024; }
}
__device__ __forceinline__ int job_kd(int k) {
  switch (k) { case 0: return 1024; case 1: return 1024; case 2: return 256; case 3: return 128; case 4: return 512;
    case 5: return 1024; case 6: return 1024; default: return 2816; }
}
__device__ __forceinline__ size_t job_od(int k) {
  switch (k) { case 0: return O_WP; case 1: return O_WG; case 2: return O_WUQ; case 3: return O_WUKV; case 4: return O_WB;
    case 5: return O_WO; case 6: return O_WGU; default: return O_WD; }
}
__device__ void prep_weights(const Params& p, int l, int bid, int nb, u16* smem) {
  float* tile = (float*)smem;
  const int tid = ltid();
  int start = 0;
#pragma unroll 1
  for (int kind = 0; kind < 8; kind++) {
    const int Kk = job_kd(kind);
    const int nkt = Kk >> 6, ntile = (job_nd(kind) >> 6) * nkt;
    u16* dst = wsp<u16>(p, job_od(kind));
    const float* ksc = kind == 2 ? p.gq + l * 256 : (kind == 3 ? p.gkv + l * 128 : nullptr);
    for (int t = (bid + nb - (start % nb)) % nb; t < ntile; t += nb) {
      const int nt = t / nkt, kt = t - nt * nkt;
      const int n0 = nt * 64, k0 = kt * 64;
      {
        const int kq = tid >> 4, nn4 = (tid & 15) * 4;
        int ld;
        const float* sp = src_col(p, l, kind, n0 + nn4, ld);
#pragma unroll
        for (int i = 0; i < 4; i++) {
          const int kk = i * 16 + kq;
          float4 v = make_float4(0.f, 0.f, 0.f, 0.f);
          if (sp) v = *(const float4*)(sp + (size_t)(k0 + kk) * ld);
          if (ksc) {
            const float sc = ksc[k0 + kk];
            v.x *= sc; v.y *= sc; v.z *= sc; v.w *= sc;
          }
          float* tp = tile + kk * 65 + nn4;
          tp[0] = v.x; tp[1] = v.y; tp[2] = v.z; tp[3] = v.w;
        }
      }
      __syncthreads();
#pragma unroll
      for (int i = 0; i < 2; i++) {
        const int c = tid + 256 * i;
        const int nn = c >> 3, kc = (c & 7) * 8;
        const float* tp = tile + kc * 65 + nn;
        uint4 o;
        o.x = pack2(tp[0], tp[65]);
        o.y = pack2(tp[2 * 65], tp[3 * 65]);
        o.z = pack2(tp[4 * 65], tp[5 * 65]);
        o.w = pack2(tp[6 * 65], tp[7 * 65]);
        *(uint4*)(dst + (size_t)(n0 + nn) * Kk + k0 + kc) = o;
      }
      __syncthreads();
    }
    start += ntile;
  }
  {
    float* ctab = (float*)smem;
    __syncthreads();
    if (tid < 128) ctab[tid] = cospif((float)tid * (1.f / 64.f));
    __syncthreads();
    u16* dst = wsp<u16>(p, O_WF);
    for (int it = bid; it < 512; it += nb) {
      const int o = it * 256 + tid;
      const int np = o & 1023, k8 = (o >> 10) * 8;
      const int reim = np >> 9, g = (np >> 7) & 3, m = np & 127;
      const float* w = p.w_in + (size_t)l * D * IN_DIM + (size_t)k8 * IN_DIM + g * 128;
      const int sh = reim ? 96 : 0;
      float a8[8];
#pragma unroll
      for (int j = 0; j < 8; j++) a8[j] = 0.f;
#pragma unroll 4
      for (int c = 0; c < 128; c++) {
        const float tw = ctab[(m * c + sh) & 127];
#pragma unroll
        for (int j = 0; j < 8; j++) a8[j] += w[(size_t)j * IN_DIM + c] * tw;
      }
      uint4 ov;
      ov.x = pack2(a8[0] * RS128, a8[1] * RS128);
      ov.y = pack2(a8[2] * RS128, a8[3] * RS128);
      ov.z = pack2(a8[4] * RS128, a8[5] * RS128);
      ov.w = pack2(a8[6] * RS128, a8[7] * RS128);
      *(uint4*)(dst + (size_t)np * 1024 + k8) = ov;
    }
    __syncthreads();
  }
}

__device__ void prep_tables(const Params& p, int bid, int nb) {
  u16* MA = wsp<u16>(p, O_MA);
  u16* MB = wsp<u16>(p, O_MB);
  u16* MC = wsp<u16>(p, O_MC);
  float* TW = wsp<float>(p, O_TW);
  const int total = 65536 + 32768 + 131072 + 16384;
  for (int idx = bid * 256 + ltid(); idx < total; idx += nb * 256) {
    if (idx < 65536) {
      const int n = idx >> 8, k = idx & 255;
      const int nt = n >> 7, wn = (n >> 6) & 1, jb = (n >> 5) & 1, klo = nt * 64 + wn * 32 + (n & 31);
      const int ri = k >> 7, nhi = k & 127;
      const int xx = (klo * nhi) & 127;
      const float c = cospif((float)xx * (1.f / 64.f)), s = sinpif((float)xx * (1.f / 64.f));
      float v = jb == 0 ? (ri == 0 ? c : -s) : (ri == 0 ? -s : -c);
      MA[idx] = f2bf(v * RS128);
    } else if (idx < 65536 + 32768) {
      const int i2 = idx - 65536;
      const int khi = i2 >> 8, k = i2 & 255;
      const int ri = k >> 7, nlo = k & 127;
      const int xx = (khi * nlo) & 127;
      const float c = cospif((float)xx * (1.f / 64.f)), s = sinpif((float)xx * (1.f / 64.f));
      MB[i2] = f2bf((ri == 0 ? c : s) * RS128);
    } else if (idx < 65536 + 32768 + 131072) {
      const int i2 = idx - 65536 - 32768;
      const int kk = i2 >> 9, k = i2 & 511;
      const int ri = k >> 8, nn = k & 255;
      const int xx = (kk * nn) & 255;
      const float c = cospif((float)xx * (1.f / 128.f)), s = sinpif((float)xx * (1.f / 128.f));
      MC[i2] = f2bf((ri == 0 ? c : -s) * 0.0625f);
    } else {
      const int i2 = idx - 65536 - 32768 - 131072;
      const int klo = i2 >> 7, nlo = i2 & 127;
      const int xx = klo * nlo;
      TW[i2 * 2] = cospif((float)xx * (1.f / 8192.f));
      TW[i2 * 2 + 1] = sinpif((float)xx * (1.f / 8192.f));
    }
  }
}

__device__ void prep_modp(const Params& p, int bid, int nb) {
  float* modp = wsp<float>(p, O_MODP);
  for (int it = bid; it < 2 * 16 * 24; it += nb) {
    const int l = it / (16 * 24), rem = it - l * 16 * 24, kc = rem / 24, nblk = rem - kc * 24;
    const int n = nblk * 256 + ltid();
    const float* w = p.w_mod + (size_t)l * D * 6144 + n;
    float a0 = 0.f, a1 = 0.f, a2 = 0.f;
#pragma unroll 8
    for (int kk = 0; kk < 64; kk++) {
      const int k = kc * 64 + kk;
      const float wv = w[(size_t)k * 6144];
      float c0 = p.c[k], c1 = p.c[1024 + k], c2 = p.c_ctx[k];
      c0 = c0 / (1.f + __expf(-c0));
      c1 = c1 / (1.f + __expf(-c1));
      c2 = c2 / (1.f + __expf(-c2));
      a0 += c0 * wv;
      a1 += c1 * wv;
      a2 += c2 * wv;
    }
    float* o = modp + ((size_t)(kc * 2 + l) * 3) * 6144 + n;
    o[0] = a0;
    o[6144] = a1;
    o[2 * 6144] = a2;
  }
}
__device__ void prep_modr(const Params& p, int bid, int nb) {
  const float* modp = wsp<float>(p, O_MODP);
  float* mod = wsp<float>(p, O_MOD);
  for (int idx = bid * 256 + ltid(); idx < 2 * 3 * 6144; idx += nb * 256) {
    const int l = idx / (3 * 6144), n = idx % 6144;
    float v = p.b_mod[l * 6144 + n];
    for (int kc = 0; kc < 16; kc++) v += modp[(size_t)kc * 2 * 3 * 6144 + idx];
    mod[idx] = v;
  }
}

__device__ void ln_phase(const Params& p, int mode, const float* g, const float* bta, int lmod, int shoff, int scoff,
                         bool skip_ctx, int bid, int nb) {
  const int lane = ltid() & 63, wave = ltid() >> 6;
  u16* A = wsp<u16>(p, O_A);
  const float* mod = wsp<float>(p, O_MOD);
  for (int row = bid * 4 + wave; row < T; row += nb * 4) {
    const int b = row / KPB, kk = row - b * KPB;
    if (skip_ctx && kk < CTXL) continue;
    float* xr = xrow(p, row);
    const float* src;
    if (mode == 0)
      src = kk < CTXL ? p.ctx + (size_t)(b * CTXL + kk) * D : p.x + (size_t)(b * SEQ + kk - CTXL) * D;
    else
      src = xr;
    float4 v[4];
    float s = 0.f;
#pragma unroll
    for (int i = 0; i < 4; i++) {
      v[i] = *(const float4*)(src + i * 256 + lane * 4);
      s += v[i].x + v[i].y + v[i].z + v[i].w;
    }
    const float mu = wsum(s) * (1.f / 1024.f);
    float q = 0.f;
#pragma unroll
    for (int i = 0; i < 4; i++) {
      v[i].x -= mu; v[i].y -= mu; v[i].z -= mu; v[i].w -= mu;
      q += v[i].x * v[i].x + v[i].y * v[i].y + v[i].z * v[i].z + v[i].w * v[i].w;
    }
    const float rstd = rsqrtf(wsum(q) * (1.f / 1024.f) + EPS);
    const int m = kk < CTXL ? 2 : b;
    const float* md = mod + ((size_t)(lmod < 0 ? 0 : lmod) * 3 + m) * 6144;
#pragma unroll
    for (int i = 0; i < 4; i++) {
      const int c0 = i * 256 + lane * 4;
      const float4 gg = *(const float4*)(g + c0), bb = *(const float4*)(bta + c0);
      float4 y;
      y.x = v[i].x * rstd * gg.x + bb.x;
      y.y = v[i].y * rstd * gg.y + bb.y;
      y.z = v[i].z * rstd * gg.z + bb.z;
      y.w = v[i].w * rstd * gg.w + bb.w;
      *(float4*)(xr + c0) = y;
      if (lmod >= 0) {
        const float4 sh = *(const float4*)(md + shoff + c0), sc = *(const float4*)(md + scoff + c0);
        uint2 o;
        o.x = pack2(y.x * (1.f + sc.x) + sh.x, y.y * (1.f + sc.y) + sh.y);
        o.y = pack2(y.z * (1.f + sc.z) + sh.z, y.w * (1.f + sc.w) + sh.w);
        *(uint2*)(A + (size_t)row * D + c0) = o;
      }
    }
  }
}

#define PATCH_LOOP_BEGIN(NR_, NC_, PR_, PC_)                                   \
  {                                                                            \
    const int x_ = bid & 7, w_ = bid >> 3, nbx_ = nb >> 3;                     \
    const int CG_ = ((NC_) + (PC_)-1) / (PC_);                                 \
    const int npatch_ = (((NR_) + (PR_)-1) / (PR_)) * CG_;                     \
    for (int u_ = w_;; u_ += nbx_) {                                           \
      const int g_ = (u_ >> 6) * 8 + x_;                                       \
      if (g_ >= npatch_) break;                                                \
      const int s_ = u_ & 63;                                                  \
      const int rg_ = g_ / CG_;                                                \
      const int prt = rg_ * (PR_) + s_ / (PC_);                                \
      const int pct = (g_ - rg_ * CG_) * (PC_) + s_ % (PC_);                   \
      if (prt >= (NR_) || pct >= (NC_)) continue;
#define PATCH_LOOP_END \
    }                  \
  }

__device__ void phase_p1(const Params& p, int l, bool last, int bid, int nb, u16* smem) {
  EPI_DECL
  const u16* A = wsp<u16>(p, O_A);
  PATCH_LOOP_BEGIN(NRT, 16, 8, 8)
    f32x16 acc[2][2];
    zero_acc(acc);
    {
      const int rt = prt, ct = pct;
      const int row0 = rt * 128, b = row0 / KPB, kk0 = row0 - b * KPB;
      if (ct < 8 || ct >= 12) {
        gemm_core(acc, wsp<u16>(p, O_WP) + (size_t)ct * 128 * D, D, A + (size_t)rt * 128 * D, D, D, smem);
        u16* dst;
        float sc = 1.f;
        int cb;
        if (ct < 4) { dst = wsp<u16>(p, O_QNA); sc = NA_SCALE_L2; cb = ct * 128; }
        else if (ct < 8) { dst = wsp<u16>(p, O_KNA); cb = (ct - 4) * 128; }
        else { dst = wsp<u16>(p, O_LAT); cb = (ct - 12) * 128; }
#pragma unroll
        for (int i = 0; i < 2; i++)
#pragma unroll
          for (int j = 0; j < 2; j++)
#pragma unroll
            for (int gp = 0; gp < 2; gp++) {
              const int row = row0 + wn_ * 64 + j * 32 + r_;
              const int col = cb + wm_ * 64 + i * 32 + 8 * (2 * gp + hh_);
              uint2 oa, ob;
              oa.x = pack2(acc[i][j][8 * gp] * sc, acc[i][j][8 * gp + 1] * sc);
              oa.y = pack2(acc[i][j][8 * gp + 2] * sc, acc[i][j][8 * gp + 3] * sc);
              ob.x = pack2(acc[i][j][8 * gp + 4] * sc, acc[i][j][8 * gp + 5] * sc);
              ob.y = pack2(acc[i][j][8 * gp + 6] * sc, acc[i][j][8 * gp + 7] * sc);
              *(uint4*)(dst + (size_t)row * 512 + col) = pair_swap(oa, ob);
            }
      } else {
        gemm_core(acc, A + (size_t)rt * 128 * D, D, wsp<u16>(p, O_WP) + (size_t)ct * 128 * D, D, D, smem);
        u16* dst = wsp<u16>(p, O_VNAT);
        const int cb = (ct - 8) * 128;
#pragma unroll
        for (int i = 0; i < 2; i++)
#pragma unroll
          for (int j = 0; j < 2; j++)
#pragma unroll
            for (int gp = 0; gp < 2; gp++) {
              const int kk = kk0 + wm_ * 64 + i * 32 + 8 * (2 * gp + hh_);
              const int col = cb + wn_ * 64 + j * 32 + r_;
              uint2 oa, ob;
              oa.x = pack2(acc[i][j][8 * gp], acc[i][j][8 * gp + 1]);
              oa.y = pack2(acc[i][j][8 * gp + 2], acc[i][j][8 * gp + 3]);
              ob.x = pack2(acc[i][j][8 * gp + 4], acc[i][j][8 * gp + 5]);
              ob.y = pack2(acc[i][j][8 * gp + 6], acc[i][j][8 * gp + 7]);
              *(uint4*)(dst + ((size_t)(b * 512 + col)) * KPB + kk) = pair_swap(oa, ob);
            }
      }
    }
  PATCH_LOOP_END
  PATCH_LOOP_BEGIN(256, 8, 8, 8)
    f32x16 acc[2][2];
    zero_acc(acc);
    {
      const int rt = prt, ct = pct;
      const int b = rt >> 7, nlo = rt & 127;
      gemm_core(acc, A + (size_t)(b * KPB + CTXL + nlo) * D, (size_t)128 * D,
                wsp<u16>(p, O_WF) + (size_t)ct * 128 * D, D, D, smem);
      u16* dst = wsp<u16>(p, O_D1);
#pragma unroll
      for (int i = 0; i < 2; i++)
#pragma unroll
        for (int j = 0; j < 2; j++)
#pragma unroll
          for (int gp = 0; gp < 2; gp++) {
            const int nhi = wm_ * 64 + i * 32 + 8 * (2 * gp + hh_);
            const int n = ct * 128 + wn_ * 64 + j * 32 + r_;
            const int reim = n >> 9, jj = n & 511;
            uint2 oa, ob;
            oa.x = pack2(acc[i][j][8 * gp], acc[i][j][8 * gp + 1]);
            oa.y = pack2(acc[i][j][8 * gp + 2], acc[i][j][8 * gp + 3]);
            ob.x = pack2(acc[i][j][8 * gp + 4], acc[i][j][8 * gp + 5]);
            ob.y = pack2(acc[i][j][8 * gp + 6], acc[i][j][8 * gp + 7]);
            *(uint4*)(dst + ((((size_t)(b * 512 + jj)) * 128 + nlo) * 2 + reim) * 128 + nhi) = pair_swap(oa, ob);
          }
    }
  PATCH_LOOP_END
  if (!last) {
    for (int t2 = bid; t2 < 32; t2 += nb) {
      f32x16 acc[2][2];
      zero_acc(acc);
      const int rt = t2 >> 3, ct = t2 & 7;
      const int b = rt >> 1, rb = rt & 1;
      gemm_core(acc, A + (size_t)(b * KPB + rb * 128) * D, D, wsp<u16>(p, O_WF) + (size_t)ct * 128 * D, D, D, smem);
      u16* dst = wsp<u16>(p, O_D1C);
#pragma unroll
      for (int i = 0; i < 2; i++)
#pragma unroll
        for (int j = 0; j < 2; j++)
#pragma unroll
          for (int gp = 0; gp < 2; gp++) {
            const int nc = rb * 128 + wm_ * 64 + i * 32 + 8 * (2 * gp + hh_);
            const int n = ct * 128 + wn_ * 64 + j * 32 + r_;
            const int reim = n >> 9, jj = n & 511;
            uint2 oa, ob;
            oa.x = pack2(acc[i][j][8 * gp], acc[i][j][8 * gp + 1]);
            oa.y = pack2(acc[i][j][8 * gp + 2], acc[i][j][8 * gp + 3]);
            ob.x = pack2(acc[i][j][8 * gp + 4], acc[i][j][8 * gp + 5]);
            ob.y = pack2(acc[i][j][8 * gp + 6], acc[i][j][8 * gp + 7]);
            *(uint4*)(dst + (((size_t)(b * 512 + jj)) * 2 + reim) * 256 + nc) = pair_swap(oa, ob);
          }
    }
  }
}

__device__ __forceinline__ float inv_freq(int i) {
  switch (i) {
    case 0: return 1.0f;
    case 1: return 0.31622776601683794f;
    case 2: return 0.1f;
    case 3: return 0.03162277660168379f;
    case 4: return 0.01f;
    case 5: return 0.0031622776601683794f;
    case 6: return 0.001f;
    default: return 0.00031622776601683794f;
  }
}
__device__ __forceinline__ void rope_cs(int kk, int e, float& cs, float& sn) {
  if (kk < CTXL) { cs = 1.f; sn = 0.f; return; }
  const int tkn = kk - CTXL;
  const float pos = (e < 8) ? (float)(tkn >> 6) : (float)(tkn & 63);
  const float ang = pos * inv_freq(e & 7);
  double xr = (double)ang * 0.31830988618379067;
  xr -= 2.0 * floor(xr * 0.5);
  const float yr = (float)xr;
  cs = cospif(yr);
  sn = sinpif(yr);
}

__device__ __forceinline__ void row_rms(const u16* A, size_t lda, int K, float* rs) {
  const int tid = ltid();
  const int row = tid >> 1, half = tid & 1;
  const u16* pr = A + (size_t)row * lda + half * (K >> 1);
  float s = 0.f;
  for (int c = 0; c < (K >> 1); c += 8) {
    uint4 v = *(const uint4*)(pr + c);
    const uint32_t w[4] = {v.x, v.y, v.z, v.w};
#pragma unroll
    for (int q = 0; q < 4; q++) {
      const float a = __uint_as_float(w[q] << 16), bq = __uint_as_float(w[q] & 0xffff0000u);
      s += a * a + bq * bq;
    }
  }
  s += __shfl_xor(s, 1);
  if (half == 0) rs[row] = rsqrtf(s / (float)K + EPS);
  __syncthreads();
}

__device__ void phase_p2(const Params& p, int l, int bid, int nb, u16* smem) {
  EPI_DECL
  const u16* LAT = wsp<u16>(p, O_LAT);
  float* rs = (float*)(smem + 4 * SM_A);
  const int nQ = NRT * 6, nKV = NRT * 8, nFA = 1024 * 2, nKR = NRT;
  const int total = nQ + nKV + nFA + nKR;
  for (int t = bid; t < total; t += nb) {
    if (t < nQ) {
      const int rt = t / 6, ct = t - rt * 6;
      const int row0 = rt * 128, b = row0 / KPB, kk0 = row0 - b * KPB;
      row_rms(LAT + (size_t)row0 * 512, 512, 256, rs);
      f32x16 acc[2][2];
      zero_acc(acc);
      gemm_core(acc, wsp<u16>(p, O_WUQ) + (size_t)ct * 128 * 256, 256, LAT + (size_t)row0 * 512, 512, 256, smem);
      u16* QM = wsp<u16>(p, O_QM);
      if (ct < 4) {
#pragma unroll
        for (int i = 0; i < 2; i++)
#pragma unroll
          for (int j = 0; j < 2; j++)
#pragma unroll
            for (int gp = 0; gp < 2; gp++) {
              const int rl = wn_ * 64 + j * 32 + r_;
              const int col = ct * 128 + wm_ * 64 + i * 32 + 8 * (2 * gp + hh_);
              const int h = col >> 6, d = col & 63;
              const float sc = rs[rl] * MLA_SCALE_L2;
              uint2 oa, ob;
              oa.x = pack2(acc[i][j][8 * gp] * sc, acc[i][j][8 * gp + 1] * sc);
              oa.y = pack2(acc[i][j][8 * gp + 2] * sc, acc[i][j][8 * gp + 3] * sc);
              ob.x = pack2(acc[i][j][8 * gp + 4] * sc, acc[i][j][8 * gp + 5] * sc);
              ob.y = pack2(acc[i][j][8 * gp + 6] * sc, acc[i][j][8 * gp + 7] * sc);
              *(uint4*)(QM + (size_t)(row0 + rl) * 768 + h * 96 + d) = pair_swap(oa, ob);
            }
      } else {
        const int wt = (ct - 4) * 2 + wm_;
#pragma unroll
        for (int j = 0; j < 2; j++) {
          const int rl = wn_ * 64 + j * 32 + r_;
          const float sc = rs[rl] * MLA_SCALE_L2;
          uint2 p1[4], p2[4];
#pragma unroll
          for (int g = 0; g < 4; g++) {
            const int idx = wt * 32 + 8 * g + 4 * hh_;
            const int e16 = idx & 15;
            float o1[4], o2[4];
#pragma unroll
            for (int q = 0; q < 4; q++) {
              float cs, sn;
              rope_cs(kk0 + rl, e16 + q, cs, sn);
              const float x1 = acc[0][j][4 * g + q] * sc, x2 = acc[1][j][4 * g + q] * sc;
              o1[q] = x1 * cs - x2 * sn;
              o2[q] = x2 * cs + x1 * sn;
            }
            p1[g].x = pack2(o1[0], o1[1]);
            p1[g].y = pack2(o1[2], o1[3]);
            p2[g].x = pack2(o2[0], o2[1]);
            p2[g].y = pack2(o2[2], o2[3]);
          }
#pragma unroll
          for (int gp = 0; gp < 2; gp++) {
            u16* qd = QM + (size_t)(row0 + rl) * 768 + (2 * wt + gp) * 96 + 64 + 8 * hh_;
            *(uint4*)qd = pair_swap(p1[2 * gp], p1[2 * gp + 1]);
            *(uint4*)(qd + 16) = pair_swap(p2[2 * gp], p2[2 * gp + 1]);
          }
        }
      }
      __syncthreads();
    } else if (t < nQ + nKV) {
      const int t2 = t - nQ;
      const int rt = t2 >> 3, ct = t2 & 7;
      const int row0 = rt * 128, b = row0 / KPB, kk0 = row0 - b * KPB;
      row_rms(LAT + (size_t)row0 * 512 + 256, 512, 128, rs);
      f32x16 acc[2][2];
      zero_acc(acc);
      if (ct < 4) {
        gemm_core(acc, wsp<u16>(p, O_WUKV) + (size_t)ct * 128 * 128, 128, LAT + (size_t)row0 * 512 + 256, 512, 128,
                  smem);
        u16* KN = wsp<u16>(p, O_KN);
#pragma unroll
        for (int i = 0; i < 2; i++)
#pragma unroll
          for (int j = 0; j < 2; j++)
#pragma unroll
            for (int gp = 0; gp < 2; gp++) {
              const int rl = wn_ * 64 + j * 32 + r_;
              const int col = ct * 128 + wm_ * 64 + i * 32 + 8 * (2 * gp + hh_);
              const float sc = rs[rl];
              uint2 oa, ob;
              oa.x = pack2(acc[i][j][8 * gp] * sc, acc[i][j][8 * gp + 1] * sc);
              oa.y = pack2(acc[i][j][8 * gp + 2] * sc, acc[i][j][8 * gp + 3] * sc);
              ob.x = pack2(acc[i][j][8 * gp + 4] * sc, acc[i][j][8 * gp + 5] * sc);
              ob.y = pack2(acc[i][j][8 * gp + 6] * sc, acc[i][j][8 * gp + 7] * sc);
              *(uint4*)(KN + (size_t)(row0 + rl) * 512 + col) = pair_swap(oa, ob);
            }
      } else {
        gemm_core(acc, LAT + (size_t)row0 * 512 + 256, 512, wsp<u16>(p, O_WUKV) + (size_t)ct * 128 * 128, 128, 128,
                  smem);
        u16* VMT = wsp<u16>(p, O_VMT);
#pragma unroll
        for (int i = 0; i < 2; i++)
#pragma unroll
          for (int j = 0; j < 2; j++)
#pragma unroll
            for (int gp = 0; gp < 2; gp++) {
              const int ra = wm_ * 64 + i * 32 + 16 * gp + 4 * hh_;
              const int rb2 = ra + 8;
              const int rst = wm_ * 64 + i * 32 + 8 * (2 * gp + hh_);
              const int col = (ct - 4) * 128 + wn_ * 64 + j * 32 + r_;
              uint2 oa, ob;
              oa.x = pack2(acc[i][j][8 * gp] * rs[ra], acc[i][j][8 * gp + 1] * rs[ra + 1]);
              oa.y = pack2(acc[i][j][8 * gp + 2] * rs[ra + 2], acc[i][j][8 * gp + 3] * rs[ra + 3]);
              ob.x = pack2(acc[i][j][8 * gp + 4] * rs[rb2], acc[i][j][8 * gp + 5] * rs[rb2 + 1]);
              ob.y = pack2(acc[i][j][8 * gp + 6] * rs[rb2 + 2], acc[i][j][8 * gp + 7] * rs[rb2 + 3]);
              *(uint4*)(VMT + ((size_t)(b * 512 + col)) * KPB + kk0 + rst) = pair_swap(oa, ob);
            }
      }
      __syncthreads();
    } else if (t < nQ + nKV + nFA) {
      const int t2 = t - nQ - nKV;
      const int rt = t2 >> 1, ct = t2 & 1;
      const int b = rt >> 9, jj = rt & 511;
      f32x16 acc[2][2];
      zero_acc(acc);
      gemm_core(acc, wsp<u16>(p, O_D1) + (size_t)rt * 128 * 256, 256, wsp<u16>(p, O_MA) + (size_t)ct * 128 * 256, 256,
                256, smem);
      const float* TW = wsp<float>(p, O_TW);
      u16* D2 = wsp<u16>(p, O_D2);
      const int klo = ct * 64 + wn_ * 32 + r_;
#pragma unroll
      for (int i = 0; i < 2; i++)
      {
        uint2 pr[4], pi[4];
#pragma unroll
        for (int g = 0; g < 4; g++) {
          const int nlo = wm_ * 64 + i * 32 + 8 * g + 4 * hh_;
          float re[4], im[4];
#pragma unroll
          for (int q = 0; q < 4; q++) {
            const float2 tw = *(const float2*)(TW + ((size_t)klo * 128 + nlo + q) * 2);
            const float ar = acc[i][0][4 * g + q], ai = acc[i][1][4 * g + q];
            re[q] = ar * tw.x + ai * tw.y;
            im[q] = ai * tw.x - ar * tw.y;
          }
          pr[g].x = pack2(re[0], re[1]);
          pr[g].y = pack2(re[2], re[3]);
          pi[g].x = pack2(im[0], im[1]);
          pi[g].y = pack2(im[2], im[3]);
        }
#pragma unroll
        for (int gp = 0; gp < 2; gp++) {
          u16* d = D2 + ((((size_t)(b * 128 + klo)) * 512 + jj) * 2) * 128 + wm_ * 64 + i * 32 + 8 * (2 * gp + hh_);
          *(uint4*)d = pair_swap(pr[2 * gp], pr[2 * gp + 1]);
          *(uint4*)(d + 128) = pair_swap(pi[2 * gp], pi[2 * gp + 1]);
        }
      }
    } else {
      const int rt = t - nQ - nKV - nFA;
      u16* KRR = wsp<u16>(p, O_KRR);
      for (int idx = ltid(); idx < 128 * 16; idx += 256) {
        const int rl = idx >> 4, e16 = idx & 15;
        const int row = rt * 128 + rl, b = row / KPB, kk = row - b * KPB;
        const float x1 = bf2f(LAT[(size_t)row * 512 + 384 + e16]), x2 = bf2f(LAT[(size_t)row * 512 + 400 + e16]);
        float cs, sn;
        rope_cs(kk, e16, cs, sn);
        KRR[(size_t)row * 32 + e16] = f2bf(x1 * cs - x2 * sn);
        KRR[(size_t)row * 32 + 16 + e16] = f2bf(x2 * cs + x1 * sn);
      }
    }
  }
}

template <int MODE>
__device__ void attn_item(const Params& p, int l, int b, int h, int q0  ,
                          int ntiles  , int rs0, int ycol, u16* smem) {
  constexpr int DQK = MODE == 0 ? 96 : 64;
  constexpr int KSTR = DQK + 8;
  constexpr int NKS = DQK / 16;
  constexpr int CPR = DQK / 8;
  constexpr int NKC = 64 * CPR / 256;
  const int tid = ltid(), lane = tid & 63, wave = tid >> 6, r = lane & 31, hh = lane >> 5;
  u16* Ks = smem;
  u16* Vs = smem + 2 * 64 * KSTR;
  const unsigned char* wsb = p.ws;
  const int qk = q0 + wave * 32 + r;
  const size_t qrow = (size_t)b * KPB + qk;
  bf16x8 qf[NKS];
  {
    const u16* qp = MODE == 0 ? wsp<u16>(p, O_QM) + qrow * 768 + h * 96 : wsp<u16>(p, O_QNA) + qrow * 512 + h * 64;
#pragma unroll
    for (int ks = 0; ks < NKS; ks++) qf[ks] = *(const bf16x8*)(qp + ks * 16 + hh * 8);
  }
  const short one_or_zero = hh == 0 ? (short)0x3F80 : (short)0;
  const bf16x8 kone = {one_or_zero, 0, 0, 0, 0, 0, 0, 0};
  bf16x8 qm = {0, 0, 0, 0, 0, 0, 0, 0};
  int qr = 0, qc = 0, rsq = 0, cs = 0;
  const float* rpb = nullptr;
  if (MODE == 1 && rs0 >= 0) {
    const int tkn = qk - CTXL;
    qr = tkn >> 6;
    qc = tkn & 63;
    rsq = min(max(qr - 4, 0), 248);
    cs = min(max(qc - 8, 0), 48);
    rpb = p.rpb + ((size_t)(l * 8 + h)) * 15 * 31;
  }
  f32x16 o[2];
#pragma unroll
  for (int e = 0; e < 16; e++) { o[0][e] = 0.f; o[1][e] = 0.f; }
  float lsum = 0.f;
  float m = 0.f;
  const bf16x8 ones = {(short)0x3F80, (short)0x3F80, (short)0x3F80, (short)0x3F80,
                       (short)0x3F80, (short)0x3F80, (short)0x3F80, (short)0x3F80};

#define KGEO(i)                                                                                          \
  uint32_t kof##i, kmu##i;                                                                               \
  int kls##i;                                                                                            \
  {                                                                                                      \
    const int c = tid + 256 * (i);                                                                       \
    const int row = c / CPR, cc = c - row * CPR;                                                         \
    if (MODE == 0 && cc >= 8) {                                                                          \
      kof##i = (uint32_t)(O_KRR + ((size_t)(b * KPB + row) * 32 + (cc - 8) * 8) * 2);                    \
      kmu##i = 64u;                                                                                      \
    } else {                                                                                             \
      kof##i = (uint32_t)((MODE == 0 ? O_KN : O_KNA) + ((size_t)(b * KPB + row) * 512 + h * 64 + cc * 8) * 2); \
      kmu##i = 1024u;                                                                                    \
    }                                                                                                    \
    kls##i = row * KSTR + cc * 8;                                                                        \
  }
#define VGEO(i)                                                                                          \
  uint32_t vof##i;                                                                                       \
  int vls##i;                                                                                            \
  bool vsx##i;                                                                                           \
  {                                                                                                      \
    const int c = tid + 256 * (i);                                                                       \
    const int d = c >> 3, cc = c & 7;                                                                    \
    vof##i = (uint32_t)((MODE == 0 ? O_VMT : O_VNAT) + ((size_t)(b * 512 + h * 64 + d) * KPB + cc * 8) * 2); \
    vls##i = d * 72 + cc * 8;                                                                            \
    vsx##i = (d & 8) != 0;                                                                               \
  }
  KGEO(0) KGEO(1) KGEO(2) VGEO(0) VGEO(1)
  (void)kof2; (void)kmu2; (void)kls2;
  u32x4 kr0A, kr1A, kr2A, vr0A, vr1A, kr0B, kr1B, kr2B, vr0B, vr1B;
  kr2A = kr1A = kr0A = vr0A = vr1A = kr2B = kr1B = kr0B = vr0B = vr1B = (u32x4){0u, 0u, 0u, 0u};
#define TILE_KK0(t) ((MODE == 1 && (t) >= 4) ? (uint32_t)(CTXL + 64 * min(rs0 + (t)-4, 255)) : (uint32_t)(64 * (t)))
#define LOAD_KV(t, S)                                                                   \
  {                                                                                     \
    const uint32_t kk0_ = TILE_KK0(t);                                                  \
    kr0##S = *(const u32x4*)(wsb + (size_t)(kof0 + kk0_ * kmu0));                       \
    kr1##S = *(const u32x4*)(wsb + (size_t)(kof1 + kk0_ * kmu1));                       \
    if (NKC == 3) kr2##S = *(const u32x4*)(wsb + (size_t)(kof2 + kk0_ * kmu2));         \
    vr0##S = *(const u32x4*)(wsb + (size_t)(vof0 + kk0_ * 2u));                         \
    vr1##S = *(const u32x4*)(wsb + (size_t)(vof1 + kk0_ * 2u));                         \
  }
#define STORE_V1(buf, i, srcv)                                                          \
  {                                                                                     \
    u32x4 sv_ = srcv;                                                                   \
    if (vsx##i) sv_ = (u32x4){sv_[2], sv_[3], sv_[0], sv_[1]};                          \
    *(u32x4*)(Vs + (buf)*64 * 72 + vls##i) = sv_;                                       \
  }
#define STORE_KV(buf, S)                                                                \
  {                                                                                     \
    *(u32x4*)(Ks + (buf)*64 * KSTR + kls0) = kr0##S;                                    \
    *(u32x4*)(Ks + (buf)*64 * KSTR + kls1) = kr1##S;                                    \
    if (NKC == 3) *(u32x4*)(Ks + (buf)*64 * KSTR + kls2) = kr2##S;                      \
    STORE_V1(buf, 0, vr0##S) STORE_V1(buf, 1, vr1##S)                                   \
  }
#define QK_TILE(kbuf, t)                                                                           \
  {                                                                                                \
    const u16* kb_ = Ks + (kbuf)*64 * KSTR + r * KSTR + hh * 8;                                    \
    {                                                                                              \
      f32x16 z_;                                                                                   \
      _Pragma("unroll") for (int e = 0; e < 16; e++) z_[e] = 0.f;                                  \
      sc[0] = __builtin_amdgcn_mfma_f32_32x32x16_bf16(kone, qm, z_, 0, 0, 0);                      \
      sc[1] = sc[0];                                                                               \
    }                                                                                              \
    _Pragma("unroll") for (int ks = 0; ks < NKS; ks++) {                                           \
      const bf16x8 kf0 = *(const bf16x8*)(kb_ + ks * 16);                                          \
      const bf16x8 kf1 = *(const bf16x8*)(kb_ + 32 * KSTR + ks * 16);                              \
      sc[0] = __builtin_amdgcn_mfma_f32_32x32x16_bf16(kf0, qf[ks], sc[0], 0, 0, 0);                \
      sc[1] = __builtin_amdgcn_mfma_f32_32x32x16_bf16(kf1, qf[ks], sc[1], 0, 0, 0);                \
    }                                                                                              \
    if (MODE == 1 && (t) >= 4) {                                                                   \
      const int kr_ = rs0 + (t)-4;                                                                 \
      const bool rowok = (kr_ >= rsq) && (kr_ < rsq + 8);                                          \
      const float* rp = rpb + (kr_ - qr + 7) * 31 + (15 - qc);                                     \
      _Pragma("unroll") for (int kb = 0; kb < 2; kb++) _Pragma("unroll") for (int e = 0; e < 16; e++) { \
        const int kc = kb * 32 + (e & 3) + 8 * (e >> 2) + 4 * hh;                                  \
        const bool valid = rowok && (kc >= cs) && (kc < cs + 16);                                  \
        float bias = 0.f;                                                                          \
        if (valid) bias = rp[kc];                                                                  \
        sc[kb][e] = valid ? sc[kb][e] + bias * LOG2E : -1e30f;                                     \
      }                                                                                            \
    }                                                                                              \
  }
#define TILE_MAX(tmax)                                                                             \
  {                                                                                                \
    tmax = sc[0][0];                                                                               \
    _Pragma("unroll") for (int e = 1; e < 16; e++) tmax = fmaxf(tmax, sc[0][e]);                   \
    _Pragma("unroll") for (int e = 0; e < 16; e++) tmax = fmaxf(tmax, sc[1][e]);                   \
    const uint32_t tu = __float_as_uint(tmax);                                                     \
    const auto sw = __builtin_amdgcn_permlane32_swap(tu, tu, false, false);                        \
    tmax = fmaxf(__uint_as_float(sw[0]), __uint_as_float(sw[1]));                                  \
  }
#define MOVE_REF(mnew_)                                                                            \
  {                                                                                                \
    const float mq_ = bf2f(f2bf(mnew_));                                                           \
    const float delta_ = mq_ - m;                                                                  \
    const float alpha = __builtin_amdgcn_exp2f(-delta_);                                           \
    m = mq_;                                                                                       \
    _Pragma("unroll") for (int e = 0; e < 16; e++) {                                               \
      o[0][e] *= alpha; o[1][e] *= alpha;                                                         \
      sc[0][e] -= delta_; sc[1][e] -= delta_;                                                      \
    }                                                                                              \
    lsum *= alpha;                                                                                 \
    qm[0] = (hh == 0) ? (short)f2bf(-m) : (short)0;                                                \
  }
#define SOFTMAX_PV(vbuf)                                                                           \
  {                                                                                                \
    const u16* vb_ = Vs + (vbuf)*64 * 72 + r * 72 + vsw;                                           \
    _Pragma("unroll") for (int kb = 0; kb < 2; kb++) _Pragma("unroll") for (int st = 0; st < 2; st++) { \
      u32x4 pu;                                                                                    \
      _Pragma("unroll") for (int q = 0; q < 4; q++) {                                              \
        const float p0_ = __builtin_amdgcn_exp2f(sc[kb][8 * st + 2 * q]);                          \
        const float p1_ = __builtin_amdgcn_exp2f(sc[kb][8 * st + 2 * q + 1]);                      \
        lsum += p0_ + p1_;                                                                         \
        pu[q] = pack2(p0_, p1_);                                                                   \
      }                                                                                            \
      const bf16x8 pbv = __builtin_bit_cast(bf16x8, pu);                                           \
      _Pragma("unroll") for (int db = 0; db < 2; db++) {                                           \
        const u16* vp = vb_ + db * 32 * 72 + kb * 32 + 16 * st;                                    \
        const bf16x4 vlo = *(const bf16x4*)(vp);                                                   \
        const bf16x4 vhi = *(const bf16x4*)(vp + 8);                                               \
        const bf16x8 vfv = __builtin_shufflevector(vlo, vhi, 0, 1, 2, 3, 4, 5, 6, 7);              \
        o[db] = __builtin_amdgcn_mfma_f32_32x32x16_bf16(vfv, pbv, o[db], 0, 0, 0);                 \
      }                                                                                            \
    }                                                                                              \
  }
#define DEFER_REF(tmax)                                                                            \
  if (__any(tmax > 8.f)) {                                                                         \
    const float mq_ = bf2f(f2bf(m + fmaxf(tmax, 0.f)));                                            \
    const float alpha = __builtin_amdgcn_exp2f(m - mq_);                                           \
    m = mq_;                                                                                       \
    _Pragma("unroll") for (int e = 0; e < 16; e++) { o[0][e] *= alpha; o[1][e] *= alpha; }       \
    lsum *= alpha;                                                                                 \
    qm[0] = (hh == 0) ? (short)f2bf(-m) : (short)0;                                                \
  }
#define ATT_STEP(t, LD, ST)                                        \
  {                                                                \
    const int cur = (t)&1;                                         \
    QK_TILE(cur, t)                                                \
    __builtin_amdgcn_sched_barrier(0);                             \
    LOAD_KV(min((t) + 2, tl), LD)                                  \
    __builtin_amdgcn_sched_barrier(0);                             \
    __builtin_amdgcn_s_setprio(1);                                 \
    SOFTMAX_PV(cur)                                                \
    __builtin_amdgcn_s_setprio(0);                                 \
    float tmax;                                                    \
    TILE_MAX(tmax)                                                 \
    DEFER_REF(tmax)                                                \
    STORE_KV(cur ^ 1, ST)                                          \
    __syncthreads();                                               \
  }

  const int tl = ntiles - 1;
  const int vsw = 4 * (hh ^ ((r >> 3) & 1));
  f32x16 sc[2];
  LOAD_KV(0, A)
  STORE_KV(0, A)
  LOAD_KV(min(1, tl), A)
  __syncthreads();
  {
    LOAD_KV(min(2, tl), B)
    __builtin_amdgcn_sched_barrier(0);
    QK_TILE(0, 0)
    float tmax;
    TILE_MAX(tmax)
    MOVE_REF(tmax)
    SOFTMAX_PV(0)
    STORE_KV(1, A)
    __syncthreads();
  }
  for (int t = 1; t + 1 < ntiles; t += 2) {
    ATT_STEP(t, A, B)
    ATT_STEP(t + 1, B, A)
  }
  ATT_STEP(tl, A, B)
  const float inv = 1.f / (lsum + __shfl_xor(lsum, 32));
  u16* yp = wsp<u16>(p, O_Y) + qrow * 1536 + ycol + h * 64;
#pragma unroll
  for (int db = 0; db < 2; db++)
#pragma unroll
    for (int gp = 0; gp < 2; gp++) {
      uint2 oa, ob;
      oa.x = pack2(o[db][8 * gp] * inv, o[db][8 * gp + 1] * inv);
      oa.y = pack2(o[db][8 * gp + 2] * inv, o[db][8 * gp + 3] * inv);
      ob.x = pack2(o[db][8 * gp + 4] * inv, o[db][8 * gp + 5] * inv);
      ob.y = pack2(o[db][8 * gp + 6] * inv, o[db][8 * gp + 7] * inv);
      *(uint4*)(yp + db * 32 + 8 * (2 * gp + hh)) = pair_swap(oa, ob);
    }
#undef KGEO
#undef VGEO
#undef TILE_KK0
#undef LOAD_KV
#undef STORE_V1
#undef STORE_KV
#undef QK_TILE
#undef TILE_MAX
#undef MOVE_REF
#undef SOFTMAX_PV
#undef ATT_STEP
#undef DEFER_REF
}

__device__ void phase_p3(const Params& p, int l, bool last, int bid, int nb, u16* smem) {
  EPI_DECL
  const int nMLA = 2048, nNA = 2048, nFB = 1024;
  const int nC = last ? 0 : (32 + 32 + 16);
  const int total = nMLA + nNA + nFB + nC;
  for (int t = bid; t < total; t += nb) {
    int kind, b = 0, h = 0, q0 = 0, ntl = 0, rs0 = -1;
    size_t aoff = 0, boff = 0;
    int Kf = 256, j0 = 0, tok0 = 0, tokmul = 1, colbase = 0;
    if (t < nMLA) {
      kind = 0;
      h = t & 7;
      const int rest = t >> 3;
      b = rest >> 7;
      q0 = CTXL + (rest & 127) * 128;
      ntl = 260;
    } else if (t < nMLA + nNA) {
      kind = 1;
      const int t2 = t - nMLA;
      h = t2 & 7;
      const int rest = t2 >> 3, rp = rest & 127;
      b = rest >> 7;
      rs0 = min(max(2 * rp - 4, 0), 248);
      const int rs1 = min(max(2 * rp + 1 - 4, 0), 248);
      q0 = CTXL + rp * 128;
      ntl = (4 + (rs1 + 8 - rs0) + 1) & ~1;
    } else if (t < nMLA + nNA + nFB) {
      kind = 2;
      const int rt = t - nMLA - nNA;
      const int bk = rt >> 2;
      j0 = (rt & 3) * 128;
      b = bk >> 7;
      tok0 = CTXL + (bk & 127);
      tokmul = 128;
      aoff = O_D2 + (size_t)rt * 128 * 256 * 2;
      boff = O_MB;
      Kf = 256;
    } else {
      const int t2 = t - nMLA - nNA - nFB;
      if (t2 < 64) {
        kind = t2 >> 5;
        const int t3 = t2 & 31;
        h = t3 & 7;
        b = (t3 >> 3) & 1;
        q0 = (t3 >> 4) * 128;
        ntl = 4;
      } else {
        kind = 2;
        const int t3 = t2 - 64;
        const int rt = t3 >> 1, ct = t3 & 1;
        b = rt >> 2;
        j0 = (rt & 3) * 128;
        colbase = ct * 128;
        aoff = O_D1C + (size_t)rt * 128 * 512 * 2;
        boff = O_MC + (size_t)ct * 128 * 512 * 2;
        Kf = 512;
      }
    }
    if (kind == 0) {
      attn_item<0>(p, l, b, h, q0, ntl, -1, 1024, smem);
    } else if (kind == 1) {
      attn_item<1>(p, l, b, h, q0, ntl, rs0, 512, smem);
    } else {
      f32x16 acc[2][2];
      zero_acc(acc);
      gemm_core(acc, wsp<u16>(p, aoff), Kf, wsp<u16>(p, boff), Kf, Kf, smem);
      u16* Y = wsp<u16>(p, O_Y);
#pragma unroll
      for (int i = 0; i < 2; i++)
#pragma unroll
        for (int j = 0; j < 2; j++)
#pragma unroll
          for (int gp = 0; gp < 2; gp++) {
            const int jj = j0 + wm_ * 64 + i * 32 + 8 * (2 * gp + hh_);
            const int tok = tok0 + (colbase + wn_ * 64 + j * 32 + r_) * tokmul;
            uint2 oa, ob;
            oa.x = pack2(acc[i][j][8 * gp], acc[i][j][8 * gp + 1]);
            oa.y = pack2(acc[i][j][8 * gp + 2], acc[i][j][8 * gp + 3]);
            ob.x = pack2(acc[i][j][8 * gp + 4], acc[i][j][8 * gp + 5]);
            ob.y = pack2(acc[i][j][8 * gp + 6], acc[i][j][8 * gp + 7]);
            *(uint4*)(Y + ((size_t)b * KPB + tok) * 1536 + jj) = pair_swap(oa, ob);
          }
    }
  }
}

__device__ __forceinline__ int n_row_tiles(bool last) { return last ? NRT - 4 : NRT; }
__device__ __forceinline__ int row_tile(bool last, int i) {
  if (!last) return i;
  return i < 128 ? i + 2 : i + 4;
}

__device__ void phase_p4(const Params& p, int l, bool last, int bid, int nb, u16* smem) {
  EPI_DECL
  const u16* A = wsp<u16>(p, O_A);
  const u16* Y = wsp<u16>(p, O_Y);
  u16* M = wsp<u16>(p, O_M);
  uint4* stash = wsp<uint4>(p, O_QM) + (size_t)bid * 24 * 256 + ltid();
  const int nrt_ = n_row_tiles(last);
  PATCH_LOOP_BEGIN(nrt_, 8, 8, 8)
    const int rt = row_tile(last, prt), ct = pct;
    f32x16 mg[2][2];
    zero_acc(mg);
#pragma unroll 1
    for (int g = 0; g < 3; g++) {
      uint32_t gp[2][2][8];
      {
        f32x16 acc[2][2];
        zero_acc(acc);
        gemm_core<true>(acc, wsp<u16>(p, O_WG) + (size_t)(g * 1024 + ct * 128) * D, D, A + (size_t)rt * 128 * D, D, D,
                        smem);
#pragma unroll
        for (int i = 0; i < 2; i++)
#pragma unroll
          for (int j = 0; j < 2; j++)
#pragma unroll
            for (int e = 0; e < 8; e++)
              gp[i][j][e] = pack2(fsigmoid(acc[i][j][2 * e]), fsigmoid(acc[i][j][2 * e + 1]));
      }
      {
        f32x16 acc[2][2];
        zero_acc(acc);
        gemm_core<false>(acc, wsp<u16>(p, O_WB) + (size_t)(g * 1024 + ct * 128) * 512, 512,
                         Y + (size_t)rt * 128 * 1536 + g * 512, 1536, 512, smem);
#pragma unroll
        for (int i = 0; i < 2; i++)
#pragma unroll
          for (int j = 0; j < 2; j++)
#pragma unroll
            for (int e = 0; e < 8; e++) {
              mg[i][j][2 * e] += __uint_as_float(gp[i][j][e] << 16) * acc[i][j][2 * e];
              mg[i][j][2 * e + 1] += __uint_as_float(gp[i][j][e] & 0xffff0000u) * acc[i][j][2 * e + 1];
            }
      }
    }
#pragma unroll
    for (int i = 0; i < 2; i++)
#pragma unroll
      for (int j = 0; j < 2; j++)
#pragma unroll
        for (int gp = 0; gp < 2; gp++) {
          const int row = rt * 128 + wn_ * 64 + j * 32 + r_;
          const int col = ct * 128 + wm_ * 64 + i * 32 + 8 * (2 * gp + hh_);
          uint2 oa, ob;
          oa.x = pack2(mg[i][j][8 * gp], mg[i][j][8 * gp + 1]);
          oa.y = pack2(mg[i][j][8 * gp + 2], mg[i][j][8 * gp + 3]);
          ob.x = pack2(mg[i][j][8 * gp + 4], mg[i][j][8 * gp + 5]);
          ob.y = pack2(mg[i][j][8 * gp + 6], mg[i][j][8 * gp + 7]);
          *(uint4*)(M + (size_t)row * D + col) = pair_swap(oa, ob);
        }
  PATCH_LOOP_END
}

__device__ void phase_resid(const Params& p, int l, bool last, const u16* Ain, size_t lda, const u16* W, int K, int goff,
                            int bid, int nb, u16* smem) {
  EPI_DECL
  const float* mod = wsp<float>(p, O_MOD);
  const int nrt_ = n_row_tiles(last);
  PATCH_LOOP_BEGIN(nrt_, 8, 8, 8)
    const int rt = row_tile(last, prt), ct = pct;
    f32x16 acc[2][2];
    zero_acc(acc);
    gemm_core(acc, W + (size_t)ct * 128 * K, K, Ain + (size_t)rt * 128 * lda, lda, K, smem);
    const int row0 = rt * 128, b = row0 / KPB, kk0 = row0 - b * KPB;
    const int m = kk0 < CTXL ? 2 : b;
    float* xb = xrow(p, row0);
    const float* gv = mod + ((size_t)l * 3 + m) * 6144 + goff;
#pragma unroll
    for (int i = 0; i < 2; i++)
#pragma unroll
      for (int g = 0; g < 4; g++) {
        const int col = ct * 128 + wm_ * 64 + i * 32 + 8 * g + 4 * hh_;
        const float4 g4 = *(const float4*)(gv + col);
#pragma unroll
        for (int j = 0; j < 2; j++) {
          const int rl = wn_ * 64 + j * 32 + r_;
          float4* xp = (float4*)(xb + (size_t)rl * D + col);
          float4 xv = *xp;
          xv.x = ALPHA * xv.x + (1.f + g4.x) * acc[i][j][4 * g];
          xv.y = ALPHA * xv.y + (1.f + g4.y) * acc[i][j][4 * g + 1];
          xv.z = ALPHA * xv.z + (1.f + g4.z) * acc[i][j][4 * g + 2];
          xv.w = ALPHA * xv.w + (1.f + g4.w) * acc[i][j][4 * g + 3];
          *xp = xv;
        }
      }
  PATCH_LOOP_END
}

__device__ void phase_p7(const Params& p, int l, bool last, int bid, int nb, u16* smem) {
  EPI_DECL
  const u16* A = wsp<u16>(p, O_A);
  u16* HH = wsp<u16>(p, O_HH);
  const int nrt_ = n_row_tiles(last);
  PATCH_LOOP_BEGIN(nrt_, 44, 16, 4)
    const int rt = row_tile(last, prt), ct = pct;
    f32x16 acc[2][2];
    zero_acc(acc);
    gemm_core(acc, wsp<u16>(p, O_WGU) + (size_t)ct * 128 * D, D, A + (size_t)rt * 128 * D, D, D, smem);
#pragma unroll
    for (int j = 0; j < 2; j++)
#pragma unroll
      for (int gp = 0; gp < 2; gp++) {
        const int row = rt * 128 + wn_ * 64 + j * 32 + r_;
        const int q = (ct * 2 + wm_) * 32 + 8 * (2 * gp + hh_);
        float hv[8];
#pragma unroll
        for (int t = 0; t < 8; t++) {
          const float gt = acc[0][j][8 * gp + t], up = acc[1][j][8 * gp + t];
          hv[t] = gt * fsigmoid(gt) * up;
        }
        uint2 oa, ob;
        oa.x = pack2(hv[0], hv[1]);
        oa.y = pack2(hv[2], hv[3]);
        ob.x = pack2(hv[4], hv[5]);
        ob.y = pack2(hv[6], hv[7]);
        *(uint4*)(HH + (size_t)row * FH + q) = pair_swap(oa, ob);
      }
  PATCH_LOOP_END
}

constexpr int NPHASE = 3 + 9 * 2;

__device__ void run_phase(const Params& p, int ph, int bid, int nb, u16* smem) {
  if (ph == 0) {
    prep_tables(p, bid, nb);
    prep_modp(p, bid, nb);
    prep_weights(p, 0, bid, nb, smem);
    return;
  }
  if (ph == 1) { prep_modr(p, bid, nb); return; }
  if (ph == 2) { ln_phase(p, 0, p.ln_in_g, p.ln_in_b, 0, 0, 1024, false, bid, nb); return; }
  const int l = (ph - 3) / 9, s = (ph - 3) % 9;
  const bool last = (l == 1);
  switch (s) {
    case 0: phase_p1(p, l, last, bid, nb, smem); break;
    case 1: phase_p2(p, l, bid, nb, smem); break;
    case 2: phase_p3(p, l, last, bid, nb, smem); break;
    case 3: phase_p4(p, l, last, bid, nb, smem); break;
    case 4: phase_resid(p, l, last, wsp<u16>(p, O_M), D, wsp<u16>(p, O_WO), D, 2048, bid, nb, smem); break;
    case 5: ln_phase(p, 1, p.ln1_g + l * D, p.ln1_b + l * D, l, 3072, 4096, last, bid, nb); break;
    case 6: phase_p7(p, l, last, bid, nb, smem); break;
    case 7: phase_resid(p, l, last, wsp<u16>(p, O_HH), FH, wsp<u16>(p, O_WD), FH, 5120, bid, nb, smem); break;
    default:
      ln_phase(p, 1, p.ln2_g + l * D, p.ln2_b + l * D, last ? -1 : l + 1, 0, 1024, last, bid, nb);
      if (!last) prep_weights(p, l + 1, bid, nb, smem);
      break;
  }
}


#define XB_TMO      128
#define XB_XCNT(j)  (256  + 64 * (j))
#define XB_XSUB(j)  (1280 + 64 * (j))
#define XB_XGEN(j)  (2304 + 64 * (j))
#define XB_TOP      3328
#define XB_TOPGEN   3392
#define XCD_BAR_WORDS 3456
#define XB_SPIN_CAP (1u << 20)
#define LAS __attribute__((address_space(3)))
__device__ __forceinline__ unsigned xb_ld(unsigned* p) { return __hip_atomic_load(p, __ATOMIC_RELAXED, __HIP_MEMORY_SCOPE_AGENT); }
__device__ __forceinline__ unsigned xb_add(unsigned* p, unsigned v) { return __hip_atomic_fetch_add(p, v, __ATOMIC_RELAXED, __HIP_MEMORY_SCOPE_AGENT); }
__device__ __forceinline__ unsigned xb_xcc_id() { return (unsigned)__builtin_amdgcn_s_getreg((3 << 11) | 20) & 0xFu; }
#define XB_SPIN(cond, bar) do { unsigned _sp = 0; while (cond) { __builtin_amdgcn_s_sleep(1); \
    if ((++_sp & 255u) == 0u) { if (xb_ld(&(bar)[XB_TMO])) break; if (_sp > XB_SPIN_CAP) { atomicAdd(&(bar)[XB_TMO], 1u); break; } } } } while (0)
struct XcdBarrier {
  unsigned* bar; unsigned x;
  volatile LAS unsigned* st;
};
__device__ __forceinline__ XcdBarrier xcd_barrier_post(unsigned* bar, volatile LAS unsigned* st) {
  XcdBarrier b; b.bar = bar; b.x = xb_xcc_id(); b.st = st;
  if (threadIdx.x == 0) (void)xb_add(&bar[XB_XCNT(b.x)], 1u);
  return b;
}
__device__ __forceinline__ void xcd_barrier_complete(unsigned* bar, unsigned x, unsigned& nloc, unsigned& nx) {
  const unsigned G = gridDim.x * gridDim.y * gridDim.z;
  unsigned sum, cnt, mine, sp = 0u;
  for (;;) {
    sum = 0u; cnt = 0u; mine = 0u;
#pragma unroll
    for (unsigned j = 0; j < 16; ++j) { const unsigned c = xb_ld(&bar[XB_XCNT(j)]); sum += c; cnt += (c > 0u) ? 1u : 0u; mine = (j == x) ? c : mine; }
    if (sum == G) break;
    __builtin_amdgcn_s_sleep(1);
    if ((++sp & 255u) == 0u) { if (xb_ld(&bar[XB_TMO])) break; if (sp > XB_SPIN_CAP) { atomicAdd(&bar[XB_TMO], 1u); break; } }
  }
  nloc = mine > 0u ? mine : 1u; nx = cnt > 0u ? cnt : 1u;
}
__device__ __forceinline__ void xcd_barrier(const XcdBarrier& b) {
  asm volatile("s_waitcnt vmcnt(0)" ::: "memory");
  __syncthreads();
  if (threadIdx.x == 0) {
    unsigned* bar = b.bar;
    __builtin_amdgcn_s_waitcnt(0);
    unsigned nloc = b.st[0], nx = b.st[1];
    if (nloc == 0u) { xcd_barrier_complete(bar, b.x, nloc, nx); b.st[0] = nloc; b.st[1] = nx; }
    const unsigned old = xb_add(&bar[XB_XSUB(b.x)], 1u);
    const unsigned gen = old / nloc;
    if (old + 1u == (gen + 1u) * nloc) {
      __builtin_amdgcn_fence(__ATOMIC_RELEASE, "agent");
      asm volatile("s_waitcnt vmcnt(0)" ::: "memory");
      const unsigned og = xb_add(&bar[XB_TOP], 1u);
      const unsigned tg = og / nx;
      if (og + 1u == (tg + 1u) * nx) xb_add(&bar[XB_TOPGEN], 1u);
      else XB_SPIN(xb_ld(&bar[XB_TOPGEN]) == tg, bar);
      __builtin_amdgcn_fence(__ATOMIC_ACQUIRE, "agent");
      xb_add(&bar[XB_XGEN(b.x)], 1u);
      asm volatile("s_waitcnt vmcnt(0)" ::: "memory");
    } else {
      XB_SPIN(xb_ld(&bar[XB_XGEN(b.x)]) == gen, bar);
      __builtin_amdgcn_fence(__ATOMIC_ACQUIRE, "agent");
      asm volatile("s_waitcnt vmcnt(0)" ::: "memory");
    }
  }
  __syncthreads();
}

constexpr int SMEM_ELEMS = 4 * SM_A + 256 + 8;

#if COOP
__global__ void __launch_bounds__(256, 2) mega_kernel(Params p) {
  __shared__ __attribute__((aligned(16))) u16 smem[SMEM_ELEMS];
  cg::grid_group grid = cg::this_grid();
  volatile LAS unsigned* st = (volatile LAS unsigned*)(smem + 4 * SM_A + 256);
  if (threadIdx.x == 0) { st[0] = 0u; st[1] = 0u; }
  __syncthreads();
  XcdBarrier xb = xcd_barrier_post((unsigned*)(p.ws + O_BAR), st);
  for (int ph = 0; ph < NPHASE; ph++) {
#ifdef PROBE_MASK
    const int s9 = ph >= 3 ? (ph - 3) % 9 : -1;
    const int nrep = (s9 >= 0 && ((PROBE_MASK >> s9) & 1)) ? 2 : 1;
    for (int rep = 0; rep < nrep; rep++) {
      run_phase(p, ph, blockIdx.x, gridDim.x, smem);
      if (ph == 0) grid.sync();
      else if (ph + 1 < NPHASE || rep + 1 < nrep) xcd_barrier(xb);
    }
#else
    run_phase(p, ph, blockIdx.x, gridDim.x, smem);
    if (ph == 0) grid.sync();
    else if (ph + 1 < NPHASE) xcd_barrier(xb);
#endif
  }
}
#else
__global__ void __launch_bounds__(256, 2) phase_kernel(Params p, int ph) {
  __shared__ __attribute__((aligned(16))) u16 smem[SMEM_ELEMS];
  run_phase(p, ph, blockIdx.x, gridDim.x, smem);
}
#endif

extern "C" void kernel_launch(void* const* d_in, const int* in_sizes, int n_in, void* d_out, int out_size, void* d_ws,
                              size_t ws_size, hipStream_t stream) {
  Params p{};
  const float** f = (const float**)&p;
  for (int i = 0; i < 25; i++) f[i] = (const float*)d_in[i];
  p.out = (float*)d_out;
  p.ws = (unsigned char*)d_ws;
  if (ws_size < O_WSEND) fprintf(stderr, "workspace too small: %zu < %zu\n", ws_size, (size_t)O_WSEND);
#if COOP
  static int grid_blocks = 0;
  if (!grid_blocks) {
    int dev = 0, cus = 0, per_cu = 0;
    hipGetDevice(&dev);
    hipDeviceGetAttribute(&cus, hipDeviceAttributeMultiprocessorCount, dev);
    hipOccupancyMaxActiveBlocksPerMultiprocessor(&per_cu, mega_kernel, 256, 0);
    if (per_cu > 2) per_cu = 2;
    grid_blocks = cus * per_cu;
  }
  (void)hipMemsetAsync(p.ws + O_BAR, 0, 3456 * 4, stream);
  void* args[] = {&p};
  hipError_t e = hipLaunchCooperativeKernel((void*)mega_kernel, dim3(grid_blocks), dim3(256), args, 0, stream);
  if (e != hipSuccess) fprintf(stderr, "cooperative launch failed: %s (grid %d)\n", hipGetErrorString(e), grid_blocks);
#else
  for (int ph = 0; ph < NPHASE; ph++) phase_kernel<<<512, 256, 0, stream>>>(p, ph);
#endif
}
```

```cpp
#include <hip/hip_runtime.h>
#include <hip/hip_cooperative_groups.h>
#include <stdint.h>
#include <cstdio>
namespace cg = cooperative_groups;

#ifndef COOP
#define COOP 1
#endif

typedef __attribute__((ext_vector_type(8))) short bf16x8;
typedef __attribute__((ext_vector_type(4))) short bf16x4;
typedef __attribute__((ext_vector_type(16))) float f32x16;
typedef unsigned short u16;
typedef __attribute__((ext_vector_type(4))) unsigned int u32x4;

constexpr int D = 1024;
constexpr int NBATCH = 2;
constexpr int SEQ = 16384;
constexpr int CTXL = 256;
constexpr int KPB = SEQ + CTXL;
constexpr int T = NBATCH * KPB;
constexpr int NRT = T / 128;
constexpr int FH = 2816;
constexpr int IN_DIM = 5536;
constexpr float LOG2E = 1.4426950408889634f;
constexpr float NA_SCALE_L2 = 0.125f * LOG2E;
constexpr float MLA_SCALE_L2 = 0.10206207261596575f * LOG2E;
constexpr float ALPHA = 1.4142135623730951f;
constexpr float EPS = 1e-5f;
constexpr float RS128 = 0.08838834764831845f;

constexpr size_t al256(size_t x) { return (x + 255) & ~(size_t)255; }
constexpr size_t O_WF = 0;
constexpr size_t O_WP = O_WF + (size_t)1024 * 1024 * 2;
constexpr size_t O_WG = O_WP + (size_t)2048 * 1024 * 2;
constexpr size_t O_WUQ = O_WG + (size_t)3072 * 1024 * 2;
constexpr size_t O_WUKV = O_WUQ + (size_t)768 * 256 * 2;
constexpr size_t O_WB = O_WUKV + (size_t)1024 * 128 * 2;
constexpr size_t O_WO = O_WB + (size_t)3 * 1024 * 512 * 2;
constexpr size_t O_WGU = O_WO + (size_t)1024 * 1024 * 2;
constexpr size_t O_WD = O_WGU + (size_t)5632 * 1024 * 2;
constexpr size_t O_MA = O_WD + (size_t)1024 * 2816 * 2;
constexpr size_t O_MB = O_MA + (size_t)256 * 256 * 2;
constexpr size_t O_MC = O_MB + (size_t)128 * 256 * 2;
constexpr size_t O_TW = O_MC + (size_t)256 * 512 * 2;
constexpr size_t O_MODP = O_TW + (size_t)128 * 128 * 2 * 4;
constexpr size_t O_MOD = O_MODP + (size_t)16 * 2 * 3 * 6144 * 4;
constexpr size_t O_XCTX = O_MOD + (size_t)2 * 3 * 6144 * 4;
constexpr size_t O_D1C = O_XCTX + (size_t)512 * 1024 * 4;
constexpr size_t O_A = O_D1C + (size_t)2 * 512 * 2 * 256 * 2;
constexpr size_t O_RQ = O_A + (size_t)T * 1024 * 2;
constexpr size_t O_QNA = O_RQ;
constexpr size_t O_KNA = O_QNA + (size_t)T * 512 * 2;
constexpr size_t O_VNAT = O_KNA + (size_t)T * 512 * 2;
constexpr size_t O_RY = O_VNAT + (size_t)T * 512 * 2;
constexpr size_t O_Y = O_RY;
constexpr size_t O_D1 = O_RY;
constexpr size_t O_LAT = O_RY + (size_t)67108864;
constexpr size_t O_D2 = O_RY + (size_t)T * 1536 * 2;
constexpr size_t O_QM = O_D2 + (size_t)67108864;
constexpr size_t O_KN = O_QM + (size_t)T * 768 * 2;
constexpr size_t O_KRR = O_KN + (size_t)T * 512 * 2;
constexpr size_t O_VMT = O_KRR + (size_t)T * 32 * 2;
constexpr size_t O_END = O_VMT + (size_t)T * 512 * 2;
constexpr size_t O_BAR = (O_END + 255) & ~(size_t)255;
constexpr size_t O_WSEND = O_BAR + 3456 * 4;
constexpr size_t O_M = O_RQ;
constexpr size_t O_HH = O_RQ;

struct Params {
  const float *x, *c, *ctx, *c_ctx, *ln_in_g, *ln_in_b, *w_mod, *b_mod, *w_in, *gq, *gkv, *w_uq, *w_qr, *w_uk,
      *w_uv, *rpb, *w_branch, *w_out, *ln1_g, *ln1_b, *ln2_g, *ln2_b, *w_gate, *w_up, *w_down;
  float* out;
  unsigned char* ws;
};

__device__ __forceinline__ u16 f2bf(float f) {
  uint32_t u = __float_as_uint(f);
  u += 0x7fffu + ((u >> 16) & 1u);
  return (u16)(u >> 16);
}
typedef __attribute__((ext_vector_type(2))) __bf16 bf16v2;
typedef __attribute__((ext_vector_type(2))) float f32v2;
__device__ __forceinline__ uint32_t pack2(float a, float b) {
  const f32v2 v = {a, b};
  return __builtin_bit_cast(uint32_t, __builtin_convertvector(v, bf16v2));
}
__device__ __forceinline__ uint4 pair_swap(uint2 a, uint2 b) {
  const auto rx = __builtin_amdgcn_permlane32_swap(a.x, b.x, false, false);
  const auto ry = __builtin_amdgcn_permlane32_swap(a.y, b.y, false, false);
  return make_uint4(rx[0], ry[0], rx[1], ry[1]);
}
__device__ __forceinline__ float bf2f(u16 v) { return __uint_as_float(((uint32_t)v) << 16); }
__device__ __forceinline__ float wsum(float v) {
#pragma unroll
  for (int o = 32; o > 0; o >>= 1) v += __shfl_xor(v, o);
  return v;
}
__device__ __forceinline__ float fsigmoid(float v) { return 1.f / (1.f + __expf(-v)); }

__device__ __forceinline__ int ltid() {
  int t = threadIdx.x;
  asm volatile("" : "+v"(t));
  return t;
}

template <typename Tp>
__device__ __forceinline__ Tp* wsp(const Params& p, size_t off) { return (Tp*)(p.ws + off); }

__device__ __forceinline__ float* xrow(const Params& p, int row) {
  int b = row / KPB, kk = row - b * KPB;
  if (kk < CTXL) return wsp<float>(p, O_XCTX) + (size_t)(b * CTXL + kk) * D;
  return p.out + (size_t)(b * SEQ + kk - CTXL) * D;
}

constexpr int LSTR = 72;
constexpr int SM_A = 128 * LSTR;

template <bool DEEP = true>
__device__ __forceinline__ void gemm_core(f32x16 (&acc)[2][2], const u16* __restrict__ A, size_t lda,
                                          const u16* __restrict__ B, size_t ldb, int K, u16* smem) {
  const int tid = ltid(), lane = tid & 63, wave = tid >> 6;
  const int wm = wave >> 1, wn = wave & 1, r = lane & 31, hh = lane >> 5;
  u16* sA = smem;
  u16* sB = smem + 2 * SM_A;
  const int lrow = tid >> 3, lkc = (tid & 7) * 8;
  const unsigned char* gab = (const unsigned char*)A;
  const unsigned char* gbb = (const unsigned char*)B;
  uint32_t oa[4], ob[4];
#pragma unroll
  for (int i = 0; i < 4; i++) {
    oa[i] = (uint32_t)(((size_t)(lrow + 32 * i) * lda + lkc) * 2);
    ob[i] = (uint32_t)(((size_t)(lrow + 32 * i) * ldb + lkc) * 2);
  }
  u16* wa = sA + lrow * LSTR + lkc;
  u16* wb = sB + lrow * LSTR + lkc;
  const u16* pa = sA + (wm * 64 + r) * LSTR + hh * 8;
  const u16* pb = sB + (wn * 64 + r) * LSTR + hh * 8;
  u32x4 a0r[4], b0r[4], a1r[4], b1r[4];
#define G_LOAD(ar, br, ko)                                               \
  _Pragma("unroll") for (int i = 0; i < 4; i++) {                        \
    ar[i] = *(const u32x4*)(gab + (size_t)(ko)*2 + oa[i]);               \
    br[i] = *(const u32x4*)(gbb + (size_t)(ko)*2 + ob[i]);               \
  }
#define G_STORE(ar, br, buf)                                             \
  _Pragma("unroll") for (int i = 0; i < 4; i++) {                        \
    *(u32x4*)(wa + (buf)*SM_A + 32 * i * LSTR) = ar[i];                  \
    *(u32x4*)(wb + (buf)*SM_A + 32 * i * LSTR) = br[i];                  \
  }
#define G_COMPUTE(buf)                                                                   \
  _Pragma("unroll") for (int ks = 0; ks < 4; ks++) {                                     \
    const bf16x8 fa0 = *(const bf16x8*)(pa + (buf)*SM_A + ks * 16);                      \
    const bf16x8 fa1 = *(const bf16x8*)(pa + (buf)*SM_A + 32 * LSTR + ks * 16);          \
    const bf16x8 fb0 = *(const bf16x8*)(pb + (buf)*SM_A + ks * 16);                      \
    const bf16x8 fb1 = *(const bf16x8*)(pb + (buf)*SM_A + 32 * LSTR + ks * 16);          \
    acc[0][0] = __builtin_amdgcn_mfma_f32_32x32x16_bf16(fa0, fb0, acc[0][0], 0, 0, 0);   \
    acc[0][1] = __builtin_amdgcn_mfma_f32_32x32x16_bf16(fa0, fb1, acc[0][1], 0, 0, 0);   \
    acc[1][0] = __builtin_amdgcn_mfma_f32_32x32x16_bf16(fa1, fb0, acc[1][0], 0, 0, 0);   \
    acc[1][1] = __builtin_amdgcn_mfma_f32_32x32x16_bf16(fa1, fb1, acc[1][1], 0, 0, 0);   \
  }
  const int nk = K >> 6;
  if (DEEP) {
    G_LOAD(a0r, b0r, 0)
    G_LOAD(a1r, b1r, 64)
    G_STORE(a0r, b0r, 0)
    __syncthreads();
    const int klast = (nk - 1) * 64;
    G_LOAD(a0r, b0r, min(128, klast))
    for (int kt = 0; kt < nk; kt += 2) {
      G_COMPUTE(0)
      G_STORE(a1r, b1r, 1)
      __syncthreads();
      G_LOAD(a1r, b1r, min((kt + 3) * 64, klast))
      __builtin_amdgcn_sched_barrier(0);
      G_COMPUTE(1)
      G_STORE(a0r, b0r, 0)
      __syncthreads();
      G_LOAD(a0r, b0r, min((kt + 4) * 64, klast))
      __builtin_amdgcn_sched_barrier(0);
    }
  } else {
    G_LOAD(a0r, b0r, 0)
    G_STORE(a0r, b0r, 0)
    __syncthreads();
    for (int kt = 0; kt < nk; kt += 2) {
      G_LOAD(a0r, b0r, (kt + 1) * 64)
      G_COMPUTE(0)
      G_STORE(a0r, b0r, 1)
      __syncthreads();
      if (kt + 2 < nk) G_LOAD(a0r, b0r, (kt + 2) * 64)
      G_COMPUTE(1)
      if (kt + 2 < nk) G_STORE(a0r, b0r, 0)
      __syncthreads();
    }
  }
#undef G_LOAD
#undef G_STORE
#undef G_COMPUTE
}

__device__ __forceinline__ void zero_acc(f32x16 (&acc)[2][2]) {
#pragma unroll
  for (int i = 0; i < 2; i++)
#pragma unroll
    for (int j = 0; j < 2; j++)
#pragma unroll
      for (int e = 0; e < 16; e++) acc[i][j][e] = 0.f;
}

#define EPI_DECL                                                     \
  const int lane_ = ltid() & 63, wave_ = ltid() >> 6;      \
  const int wm_ = wave_ >> 1, wn_ = wave_ & 1, r_ = lane_ & 31, hh_ = lane_ >> 5; \
  (void)wm_; (void)wn_; (void)r_; (void)hh_;

__device__ __forceinline__ const float* src_col(const Params& p, int l, int kind, int n, int& ld) {
  switch (kind) {
    case 0:
      ld = IN_DIM;
      return n < 1952 ? p.w_in + (size_t)l * D * IN_DIM + 512 + n : nullptr;
    case 1:
      ld = IN_DIM;
      return p.w_in + (size_t)l * D * IN_DIM + 2464 + n;
    case 2:
      if (n < 512) {
        ld = 512;
        return p.w_uq + (size_t)l * 256 * 512 + n;
      } else {
        int m = n - 512, wt = m >> 6, jb = (m >> 5) & 1, idx = wt * 32 + (m & 31);
        int h = idx >> 4, e = idx & 15;
        ld = 256;
        return p.w_qr + (size_t)l * 256 * 256 + h * 32 + jb * 16 + e;
      }
    case 3:
      ld = 512;
      return n < 512 ? p.w_uk + (size_t)l * 128 * 512 + n : p.w_uv + (size_t)l * 128 * 512 + (n - 512);
    case 4: {
      int g = n >> 10, nn = n & 1023;
      ld = 1024;
      return p.w_branch + ((size_t)(l * 3 + g) * 512) * 1024 + nn;
    }
    case 5:
      ld = 1024;
      return p.w_out + (size_t)l * D * D + n;
    case 6: {
      int jb = (n >> 5) & 1, q = (n >> 6) * 32 + (n & 31);
      ld = FH;
      return (jb ? p.w_up : p.w_gate) + (size_t)l * D * FH + q;
    }
    default:
      ld = 1024;
      return p.w_down + (size_t)l * FH * D + n;
  }
}

__device__ __forceinline__ int job_nd(int k) {
  switch (k) { case 0: return 2048; case 1: return 3072; case 2: return 768; case 3: return 1024; case 4: return 3072;
    case 5: return 1024; case 6: return 5632; default: return 1024; }
}
__device__ __forceinline__ int job_kd(int k) {
  switch (k) { case 0: return 1024; case 1: return 1024; case 2: return 256; case 3: return 128; case 4: return 512;
    case 5: return 1024; case 6: return 1024; default: return 2816; }
}
__device__ __forceinline__ size_t job_od(int k) {
  switch (k) { case 0: return O_WP; case 1: return O_WG; case 2: return O_WUQ; case 3: return O_WUKV; case 4: return O_WB;
    case 5: return O_WO; case 6: return O_WGU; default: return O_WD; }
}
__device__ void prep_weights(const Params& p, int l, int bid, int nb, u16* smem) {
  float* tile = (float*)smem;
  const int tid = ltid();
  int start = 0;
#pragma unroll 1
  for (int kind = 0; kind < 8; kind++) {
    const int Kk = job_kd(kind);
    const int nkt = Kk >> 6, ntile = (job_nd(kind) >> 6) * nkt;
    u16* dst = wsp<u16>(p, job_od(kind));
    const float* ksc = kind == 2 ? p.gq + l * 256 : (kind == 3 ? p.gkv + l * 128 : nullptr);
    for (int t = (bid + nb - (start % nb)) % nb; t < ntile; t += nb) {
      const int nt = t / nkt, kt = t - nt * nkt;
      const int n0 = nt * 64, k0 = kt * 64;
      {
        const int kq = tid >> 4, nn4 = (tid & 15) * 4;
        int ld;
        const float* sp = src_col(p, l, kind, n0 + nn4, ld);
#pragma unroll
        for (int i = 0; i < 4; i++) {
          const int kk = i * 16 + kq;
          float4 v = make_float4(0.f, 0.f, 0.f, 0.f);
          if (sp) v = *(const float4*)(sp + (size_t)(k0 + kk) * ld);
          if (ksc) {
            const float sc = ksc[k0 + kk];
            v.x *= sc; v.y *= sc; v.z *= sc; v.w *= sc;
          }
          float* tp = tile + kk * 65 + nn4;
          tp[0] = v.x; tp[1] = v.y; tp[2] = v.z; tp[3] = v.w;
        }
      }
      __syncthreads();
#pragma unroll
      for (int i = 0; i < 2; i++) {
        const int c = tid + 256 * i;
        const int nn = c >> 3, kc = (c & 7) * 8;
        const float* tp = tile + kc * 65 + nn;
        uint4 o;
        o.x = pack2(tp[0], tp[65]);
        o.y = pack2(tp[2 * 65], tp[3 * 65]);
        o.z = pack2(tp[4 * 65], tp[5 * 65]);
        o.w = pack2(tp[6 * 65], tp[7 * 65]);
        *(uint4*)(dst + (size_t)(n0 + nn) * Kk + k0 + kc) = o;
      }
      __syncthreads();
    }
    start += ntile;
  }
  {
    float* ctab = (float*)smem;
    __syncthreads();
    if (tid < 128) ctab[tid] = cospif((float)tid * (1.f / 64.f));
    __syncthreads();
    u16* dst = wsp<u16>(p, O_WF);
    for (int it = bid; it < 512; it += nb) {
      const int o = it * 256 + tid;
      const int np = o & 1023, k8 = (o >> 10) * 8;
      const int reim = np >> 9, g = (np >> 7) & 3, m = np & 127;
      const float* w = p.w_in + (size_t)l * D * IN_DIM + (size_t)k8 * IN_DIM + g * 128;
      const int sh = reim ? 96 : 0;
      float a8[8];
#pragma unroll
      for (int j = 0; j < 8; j++) a8[j] = 0.f;
#pragma unroll 4
      for (int c = 0; c < 128; c++) {
        const float tw = ctab[(m * c + sh) & 127];
#pragma unroll
        for (int j = 0; j < 8; j++) a8[j] += w[(size_t)j * IN_DIM + c] * tw;
      }
      uint4 ov;
      ov.x = pack2(a8[0] * RS128, a8[1] * RS128);
      ov.y = pack2(a8[2] * RS128, a8[3] * RS128);
      ov.z = pack2(a8[4] * RS128, a8[5] * RS128);
      ov.w = pack2(a8[6] * RS128, a8[7] * RS128);
      *(uint4*)(dst + (size_t)np * 1024 + k8) = ov;
    }
    __syncthreads();
  }
}

__device__ void prep_tables(const Params& p, int bid, int nb) {
  u16* MA = wsp<u16>(p, O_MA);
  u16* MB = wsp<u16>(p, O_MB);
  u16* MC = wsp<u16>(p, O_MC);
  float* TW = wsp<float>(p, O_TW);
  const int total = 65536 + 32768 + 131072 + 16384;
  for (int idx = bid * 256 + ltid(); idx < total; idx += nb * 256) {
    if (idx < 65536) {
      const int n = idx >> 8, k = idx & 255;
      const int nt = n >> 7, wn = (n >> 6) & 1, jb = (n >> 5) & 1, klo = nt * 64 + wn * 32 + (n & 31);
      const int ri = k >> 7, nhi = k & 127;
      const int xx = (klo * nhi) & 127;
      const float c = cospif((float)xx * (1.f / 64.f)), s = sinpif((float)xx * (1.f / 64.f));
      float v = jb == 0 ? (ri == 0 ? c : -s) : (ri == 0 ? -s : -c);
      MA[idx] = f2bf(v * RS128);
    } else if (idx < 65536 + 32768) {
      const int i2 = idx - 65536;
      const int khi = i2 >> 8, k = i2 & 255;
      const int ri = k >> 7, nlo = k & 127;
      const int xx = (khi * nlo) & 127;
      const float c = cospif((float)xx * (1.f / 64.f)), s = sinpif((float)xx * (1.f / 64.f));
      MB[i2] = f2bf((ri == 0 ? c : s) * RS128);
    } else if (idx < 65536 + 32768 + 131072) {
      const int i2 = idx - 65536 - 32768;
      const int kk = i2 >> 9, k = i2 & 511;
      const int ri = k >> 8, nn = k & 255;
      const int xx = (kk * nn) & 255;
      const float c = cospif((float)xx * (1.f / 128.f)), s = sinpif((float)xx * (1.f / 128.f));
      MC[i2] = f2bf((ri == 0 ? c : -s) * 0.0625f);
    } else {
      const int i2 = idx - 65536 - 32768 - 131072;
      const int klo = i2 >> 7, nlo = i2 & 127;
      const int xx = klo * nlo;
      TW[i2 * 2] = cospif((float)xx * (1.f / 8192.f));
      TW[i2 * 2 + 1] = sinpif((float)xx * (1.f / 8192.f));
    }
  }
}

__device__ void prep_modp(const Params& p, int bid, int nb) {
  float* modp = wsp<float>(p, O_MODP);
  for (int it = bid; it < 2 * 16 * 24; it += nb) {
    const int l = it / (16 * 24), rem = it - l * 16 * 24, kc = rem / 24, nblk = rem - kc * 24;
    const int n = nblk * 256 + ltid();
    const float* w = p.w_mod + (size_t)l * D * 6144 + n;
    float a0 = 0.f, a1 = 0.f, a2 = 0.f;
#pragma unroll 8
    for (int kk = 0; kk < 64; kk++) {
      const int k = kc * 64 + kk;
      const float wv = w[(size_t)k * 6144];
      float c0 = p.c[k], c1 = p.c[1024 + k], c2 = p.c_ctx[k];
      c0 = c0 / (1.f + __expf(-c0));
      c1 = c1 / (1.f + __expf(-c1));
      c2 = c2 / (1.f + __expf(-c2));
      a0 += c0 * wv;
      a1 += c1 * wv;
      a2 += c2 * wv;
    }
    float* o = modp + ((size_t)(kc * 2 + l) * 3) * 6144 + n;
    o[0] = a0;
    o[6144] = a1;
    o[2 * 6144] = a2;
  }
}
__device__ void prep_modr(const Params& p, int bid, int nb) {
  const float* modp = wsp<float>(p, O_MODP);
  float* mod = wsp<float>(p, O_MOD);
  for (int idx = bid * 256 + ltid(); idx < 2 * 3 * 6144; idx += nb * 256) {
    const int l = idx / (3 * 6144), n = idx % 6144;
    float v = p.b_mod[l * 6144 + n];
    for (int kc = 0; kc < 16; kc++) v += modp[(size_t)kc * 2 * 3 * 6144 + idx];
    mod[idx] = v;
  }
}

__device__ void ln_phase(const Params& p, int mode, const float* g, const float* bta, int lmod, int shoff, int scoff,
                         bool skip_ctx, int bid, int nb) {
  const int lane = ltid() & 63, wave = ltid() >> 6;
  u16* A = wsp<u16>(p, O_A);
  const float* mod = wsp<float>(p, O_MOD);
  float4 gg[4], bb[4], sh[4], sc[4];
#pragma unroll
  for (int q = 0; q < 4; q++) {
    const int c0 = (q >> 1) * 512 + lane * 8 + (q & 1) * 4;
    gg[q] = *(const float4*)(g + c0);
    bb[q] = *(const float4*)(bta + c0);
    sh[q] = make_float4(0.f, 0.f, 0.f, 0.f);
    sc[q] = make_float4(0.f, 0.f, 0.f, 0.f);
  }
  int cur_m = -1;
  for (int row = bid * 4 + wave; row < T; row += nb * 4) {
    const int b = row / KPB, kk = row - b * KPB;
    if (skip_ctx && kk < CTXL) continue;
    float* xr = xrow(p, row);
    const float* src;
    if (mode == 0)
      src = kk < CTXL ? p.ctx + (size_t)(b * CTXL + kk) * D : p.x + (size_t)(b * SEQ + kk - CTXL) * D;
    else
      src = xr;
    float4 v[4];
    float s = 0.f;
#pragma unroll
    for (int q = 0; q < 4; q++) {
      v[q] = *(const float4*)(src + (q >> 1) * 512 + lane * 8 + (q & 1) * 4);
      s += v[q].x + v[q].y + v[q].z + v[q].w;
    }
    const int m = kk < CTXL ? 2 : b;
    if (lmod >= 0 && m != cur_m) {
      cur_m = m;
      const float* md = mod + ((size_t)lmod * 3 + m) * 6144;
#pragma unroll
      for (int q = 0; q < 4; q++) {
        const int c0 = (q >> 1) * 512 + lane * 8 + (q & 1) * 4;
        sh[q] = *(const float4*)(md + shoff + c0);
        sc[q] = *(const float4*)(md + scoff + c0);
      }
    }
    const float mu = wsum(s) * (1.f / 1024.f);
    float qs = 0.f;
#pragma unroll
    for (int q = 0; q < 4; q++) {
      v[q].x -= mu; v[q].y -= mu; v[q].z -= mu; v[q].w -= mu;
      qs += v[q].x * v[q].x + v[q].y * v[q].y + v[q].z * v[q].z + v[q].w * v[q].w;
    }
    const float rstd = rsqrtf(wsum(qs) * (1.f / 1024.f) + EPS);
#pragma unroll
    for (int i = 0; i < 2; i++) {
      uint4 o;
      uint32_t ow[4];
#pragma unroll
      for (int hq = 0; hq < 2; hq++) {
        const int q = i * 2 + hq;
        float4 y;
        y.x = v[q].x * rstd * gg[q].x + bb[q].x;
        y.y = v[q].y * rstd * gg[q].y + bb[q].y;
        y.z = v[q].z * rstd * gg[q].z + bb[q].z;
        y.w = v[q].w * rstd * gg[q].w + bb[q].w;
        *(float4*)(xr + i * 512 + lane * 8 + hq * 4) = y;
        ow[hq * 2] = pack2(y.x * (1.f + sc[q].x) + sh[q].x, y.y * (1.f + sc[q].y) + sh[q].y);
        ow[hq * 2 + 1] = pack2(y.z * (1.f + sc[q].z) + sh[q].z, y.w * (1.f + sc[q].w) + sh[q].w);
      }
      if (lmod >= 0) {
        o.x = ow[0]; o.y = ow[1]; o.z = ow[2]; o.w = ow[3];
        *(uint4*)(A + (size_t)row * D + i * 512 + lane * 8) = o;
      }
    }
  }
}

#define PATCH_LOOP_BEGIN(NR_, NC_, PR_, PC_)                                   \
  {                                                                            \
    const int x_ = bid & 7, w_ = bid >> 3, nbx_ = nb >> 3;                     \
    const int CG_ = ((NC_) + (PC_)-1) / (PC_);                                 \
    const int npatch_ = (((NR_) + (PR_)-1) / (PR_)) * CG_;                     \
    for (int u_ = w_;; u_ += nbx_) {                                           \
      const int g_ = (u_ >> 6) * 8 + x_;                                       \
      if (g_ >= npatch_) break;                                                \
      const int s_ = u_ & 63;                                                  \
      const int rg_ = g_ / CG_;                                                \
      const int prt = rg_ * (PR_) + s_ / (PC_);                                \
      const int pct = (g_ - rg_ * CG_) * (PC_) + s_ % (PC_);                   \
      if (prt >= (NR_) || pct >= (NC_)) continue;
#define PATCH_LOOP_END \
    }                  \
  }

__device__ void phase_p1(const Params& p, int l, bool last, int bid, int nb, u16* smem) {
  EPI_DECL
  const u16* A = wsp<u16>(p, O_A);
  PATCH_LOOP_BEGIN(NRT, 16, 8, 8)
    f32x16 acc[2][2];
    zero_acc(acc);
    {
      const int rt = prt, ct = pct;
      const int row0 = rt * 128, b = row0 / KPB, kk0 = row0 - b * KPB;
      if (ct < 8 || ct >= 12) {
        gemm_core(acc, wsp<u16>(p, O_WP) + (size_t)ct * 128 * D, D, A + (size_t)rt * 128 * D, D, D, smem);
        u16* dst;
        float sc = 1.f;
        int cb;
        if (ct < 4) { dst = wsp<u16>(p, O_QNA); sc = NA_SCALE_L2; cb = ct * 128; }
        else if (ct < 8) { dst = wsp<u16>(p, O_KNA); cb = (ct - 4) * 128; }
        else { dst = wsp<u16>(p, O_LAT); cb = (ct - 12) * 128; }
#pragma unroll
        for (int i = 0; i < 2; i++)
#pragma unroll
          for (int j = 0; j < 2; j++)
#pragma unroll
            for (int gp = 0; gp < 2; gp++) {
              const int row = row0 + wn_ * 64 + j * 32 + r_;
              const int col = cb + wm_ * 64 + i * 32 + 8 * (2 * gp + hh_);
              uint2 oa, ob;
              oa.x = pack2(acc[i][j][8 * gp] * sc, acc[i][j][8 * gp + 1] * sc);
              oa.y = pack2(acc[i][j][8 * gp + 2] * sc, acc[i][j][8 * gp + 3] * sc);
              ob.x = pack2(acc[i][j][8 * gp + 4] * sc, acc[i][j][8 * gp + 5] * sc);
              ob.y = pack2(acc[i][j][8 * gp + 6] * sc, acc[i][j][8 * gp + 7] * sc);
              *(uint4*)(dst + (size_t)row * 512 + col) = pair_swap(oa, ob);
            }
      } else {
        gemm_core(acc, A + (size_t)rt * 128 * D, D, wsp<u16>(p, O_WP) + (size_t)ct * 128 * D, D, D, smem);
        u16* dst = wsp<u16>(p, O_VNAT);
        const int cb = (ct - 8) * 128;
#pragma unroll
        for (int i = 0; i < 2; i++)
#pragma unroll
          for (int j = 0; j < 2; j++)
#pragma unroll
            for (int gp = 0; gp < 2; gp++) {
              const int kk = kk0 + wm_ * 64 + i * 32 + 8 * (2 * gp + hh_);
              const int col = cb + wn_ * 64 + j * 32 + r_;
              uint2 oa, ob;
              oa.x = pack2(acc[i][j][8 * gp], acc[i][j][8 * gp + 1]);
              oa.y = pack2(acc[i][j][8 * gp + 2], acc[i][j][8 * gp + 3]);
              ob.x = pack2(acc[i][j][8 * gp + 4], acc[i][j][8 * gp + 5]);
              ob.y = pack2(acc[i][j][8 * gp + 6], acc[i][j][8 * gp + 7]);
              *(uint4*)(dst + ((size_t)(b * 512 + col)) * KPB + kk) = pair_swap(oa, ob);
            }
      }
    }
  PATCH_LOOP_END
  PATCH_LOOP_BEGIN(256, 8, 8, 8)
    f32x16 acc[2][2];
    zero_acc(acc);
    {
      const int rt = prt, ct = pct;
      const int b = rt >> 7, nlo = rt & 127;
      gemm_core(acc, A + (size_t)(b * KPB + CTXL + nlo) * D, (size_t)128 * D,
                wsp<u16>(p, O_WF) + (size_t)ct * 128 * D, D, D, smem);
      u16* dst = wsp<u16>(p, O_D1);
#pragma unroll
      for (int i = 0; i < 2; i++)
#pragma unroll
        for (int j = 0; j < 2; j++)
#pragma unroll
          for (int gp = 0; gp < 2; gp++) {
            const int nhi = wm_ * 64 + i * 32 + 8 * (2 * gp + hh_);
            const int n = ct * 128 + wn_ * 64 + j * 32 + r_;
            const int reim = n >> 9, jj = n & 511;
            uint2 oa, ob;
            oa.x = pack2(acc[i][j][8 * gp], acc[i][j][8 * gp + 1]);
            oa.y = pack2(acc[i][j][8 * gp + 2], acc[i][j][8 * gp + 3]);
            ob.x = pack2(acc[i][j][8 * gp + 4], acc[i][j][8 * gp + 5]);
            ob.y = pack2(acc[i][j][8 * gp + 6], acc[i][j][8 * gp + 7]);
            *(uint4*)(dst + ((((size_t)(b * 512 + jj)) * 128 + nlo) * 2 + reim) * 128 + nhi) = pair_swap(oa, ob);
          }
    }
  PATCH_LOOP_END
  if (!last) {
    for (int t2 = bid; t2 < 32; t2 += nb) {
      f32x16 acc[2][2];
      zero_acc(acc);
      const int rt = t2 >> 3, ct = t2 & 7;
      const int b = rt >> 1, rb = rt & 1;
      gemm_core(acc, A + (size_t)(b * KPB + rb * 128) * D, D, wsp<u16>(p, O_WF) + (size_t)ct * 128 * D, D, D, smem);
      u16* dst = wsp<u16>(p, O_D1C);
#pragma unroll
      for (int i = 0; i < 2; i++)
#pragma unroll
        for (int j = 0; j < 2; j++)
#pragma unroll
          for (int gp = 0; gp < 2; gp++) {
            const int nc = rb * 128 + wm_ * 64 + i * 32 + 8 * (2 * gp + hh_);
            const int n = ct * 128 + wn_ * 64 + j * 32 + r_;
            const int reim = n >> 9, jj = n & 511;
            uint2 oa, ob;
            oa.x = pack2(acc[i][j][8 * gp], acc[i][j][8 * gp + 1]);
            oa.y = pack2(acc[i][j][8 * gp + 2], acc[i][j][8 * gp + 3]);
            ob.x = pack2(acc[i][j][8 * gp + 4], acc[i][j][8 * gp + 5]);
            ob.y = pack2(acc[i][j][8 * gp + 6], acc[i][j][8 * gp + 7]);
            *(uint4*)(dst + (((size_t)(b * 512 + jj)) * 2 + reim) * 256 + nc) = pair_swap(oa, ob);
          }
    }
  }
}

__device__ __forceinline__ float inv_freq(int i) {
  switch (i) {
    case 0: return 1.0f;
    case 1: return 0.31622776601683794f;
    case 2: return 0.1f;
    case 3: return 0.03162277660168379f;
    case 4: return 0.01f;
    case 5: return 0.0031622776601683794f;
    case 6: return 0.001f;
    default: return 0.00031622776601683794f;
  }
}
__device__ __forceinline__ void rope_cs(int kk, int e, float& cs, float& sn) {
  if (kk < CTXL) { cs = 1.f; sn = 0.f; return; }
  const int tkn = kk - CTXL;
  const float pos = (e < 8) ? (float)(tkn >> 6) : (float)(tkn & 63);
  const float ang = pos * inv_freq(e & 7);
  double xr = (double)ang * 0.31830988618379067;
  xr -= 2.0 * floor(xr * 0.5);
  const float yr = (float)xr;
  cs = cospif(yr);
  sn = sinpif(yr);
}

__device__ __forceinline__ void row_rms(const u16* A, size_t lda, int K, float* rs) {
  const int tid = ltid();
  const int row = tid >> 1, half = tid & 1;
  const u16* pr = A + (size_t)row * lda + half * (K >> 1);
  float s = 0.f;
  for (int c = 0; c < (K >> 1); c += 8) {
    uint4 v = *(const uint4*)(pr + c);
    const uint32_t w[4] = {v.x, v.y, v.z, v.w};
#pragma unroll
    for (int q = 0; q < 4; q++) {
      const float a = __uint_as_float(w[q] << 16), bq = __uint_as_float(w[q] & 0xffff0000u);
      s += a * a + bq * bq;
    }
  }
  s += __shfl_xor(s, 1);
  if (half == 0) rs[row] = rsqrtf(s / (float)K + EPS);
  __syncthreads();
}

__device__ void phase_p2(const Params& p, int l, int bid, int nb, u16* smem) {
  EPI_DECL
  const u16* LAT = wsp<u16>(p, O_LAT);
  float* rs = (float*)(smem + 4 * SM_A);
  const int nQ = NRT * 6, nKV = NRT * 8, nFA = 1024 * 2, nKR = NRT;
  const int total = nQ + nKV + nFA + nKR;
  for (int t = bid; t < total; t += nb) {
    if (t < nQ) {
      const int rt = t / 6, ct = t - rt * 6;
      const int row0 = rt * 128, b = row0 / KPB, kk0 = row0 - b * KPB;
      row_rms(LAT + (size_t)row0 * 512, 512, 256, rs);
      f32x16 acc[2][2];
      zero_acc(acc);
      gemm_core(acc, wsp<u16>(p, O_WUQ) + (size_t)ct * 128 * 256, 256, LAT + (size_t)row0 * 512, 512, 256, smem);
      u16* QM = wsp<u16>(p, O_QM);
      if (ct < 4) {
#pragma unroll
        for (int i = 0; i < 2; i++)
#pragma unroll
          for (int j = 0; j < 2; j++)
#pragma unroll
            for (int gp = 0; gp < 2; gp++) {
              const int rl = wn_ * 64 + j * 32 + r_;
              const int col = ct * 128 + wm_ * 64 + i * 32 + 8 * (2 * gp + hh_);
              const int h = col >> 6, d = col & 63;
              const float sc = rs[rl] * MLA_SCALE_L2;
              uint2 oa, ob;
              oa.x = pack2(acc[i][j][8 * gp] * sc, acc[i][j][8 * gp + 1] * sc);
              oa.y = pack2(acc[i][j][8 * gp + 2] * sc, acc[i][j][8 * gp + 3] * sc);
              ob.x = pack2(acc[i][j][8 * gp + 4] * sc, acc[i][j][8 * gp + 5] * sc);
              ob.y = pack2(acc[i][j][8 * gp + 6] * sc, acc[i][j][8 * gp + 7] * sc);
              *(uint4*)(QM + (size_t)(row0 + rl) * 768 + h * 96 + d) = pair_swap(oa, ob);
            }
      } else {
        const int wt = (ct - 4) * 2 + wm_;
#pragma unroll
        for (int j = 0; j < 2; j++) {
          const int rl = wn_ * 64 + j * 32 + r_;
          const float sc = rs[rl] * MLA_SCALE_L2;
          uint2 p1[4], p2[4];
#pragma unroll
          for (int g = 0; g < 4; g++) {
            const int idx = wt * 32 + 8 * g + 4 * hh_;
            const int e16 = idx & 15;
            float o1[4], o2[4];
#pragma unroll
            for (int q = 0; q < 4; q++) {
              float cs, sn;
              rope_cs(kk0 + rl, e16 + q, cs, sn);
              const float x1 = acc[0][j][4 * g + q] * sc, x2 = acc[1][j][4 * g + q] * sc;
              o1[q] = x1 * cs - x2 * sn;
              o2[q] = x2 * cs + x1 * sn;
            }
            p1[g].x = pack2(o1[0], o1[1]);
            p1[g].y = pack2(o1[2], o1[3]);
            p2[g].x = pack2(o2[0], o2[1]);
            p2[g].y = pack2(o2[2], o2[3]);
          }
#pragma unroll
          for (int gp = 0; gp < 2; gp++) {
            u16* qd = QM + (size_t)(row0 + rl) * 768 + (2 * wt + gp) * 96 + 64 + 8 * hh_;
            *(uint4*)qd = pair_swap(p1[2 * gp], p1[2 * gp + 1]);
            *(uint4*)(qd + 16) = pair_swap(p2[2 * gp], p2[2 * gp + 1]);
          }
        }
      }
      __syncthreads();
    } else if (t < nQ + nKV) {
      const int t2 = t - nQ;
      const int rt = t2 >> 3, ct = t2 & 7;
      const int row0 = rt * 128, b = row0 / KPB, kk0 = row0 - b * KPB;
      row_rms(LAT + (size_t)row0 * 512 + 256, 512, 128, rs);
      f32x16 acc[2][2];
      zero_acc(acc);
      if (ct < 4) {
        gemm_core(acc, wsp<u16>(p, O_WUKV) + (size_t)ct * 128 * 128, 128, LAT + (size_t)row0 * 512 + 256, 512, 128,
                  smem);
        u16* KN = wsp<u16>(p, O_KN);
#pragma unroll
        for (int i = 0; i < 2; i++)
#pragma unroll
          for (int j = 0; j < 2; j++)
#pragma unroll
            for (int gp = 0; gp < 2; gp++) {
              const int rl = wn_ * 64 + j * 32 + r_;
              const int col = ct * 128 + wm_ * 64 + i * 32 + 8 * (2 * gp + hh_);
              const float sc = rs[rl];
              uint2 oa, ob;
              oa.x = pack2(acc[i][j][8 * gp] * sc, acc[i][j][8 * gp + 1] * sc);
              oa.y = pack2(acc[i][j][8 * gp + 2] * sc, acc[i][j][8 * gp + 3] * sc);
              ob.x = pack2(acc[i][j][8 * gp + 4] * sc, acc[i][j][8 * gp + 5] * sc);
              ob.y = pack2(acc[i][j][8 * gp + 6] * sc, acc[i][j][8 * gp + 7] * sc);
              *(uint4*)(KN + (size_t)(row0 + rl) * 512 + col) = pair_swap(oa, ob);
            }
      } else {
        gemm_core(acc, LAT + (size_t)row0 * 512 + 256, 512, wsp<u16>(p, O_WUKV) + (size_t)ct * 128 * 128, 128, 128,
                  smem);
        u16* VMT = wsp<u16>(p, O_VMT);
#pragma unroll
        for (int i = 0; i < 2; i++)
#pragma unroll
          for (int j = 0; j < 2; j++)
#pragma unroll
            for (int gp = 0; gp < 2; gp++) {
              const int ra = wm_ * 64 + i * 32 + 16 * gp + 4 * hh_;
              const int rb2 = ra + 8;
              const int rst = wm_ * 64 + i * 32 + 8 * (2 * gp + hh_);
              const int col = (ct - 4) * 128 + wn_ * 64 + j * 32 + r_;
              uint2 oa, ob;
              oa.x = pack2(acc[i][j][8 * gp] * rs[ra], acc[i][j][8 * gp + 1] * rs[ra + 1]);
              oa.y = pack2(acc[i][j][8 * gp + 2] * rs[ra + 2], acc[i][j][8 * gp + 3] * rs[ra + 3]);
              ob.x = pack2(acc[i][j][8 * gp + 4] * rs[rb2], acc[i][j][8 * gp + 5] * rs[rb2 + 1]);
              ob.y = pack2(acc[i][j][8 * gp + 6] * rs[rb2 + 2], acc[i][j][8 * gp + 7] * rs[rb2 + 3]);
              *(uint4*)(VMT + ((size_t)(b * 512 + col)) * KPB + kk0 + rst) = pair_swap(oa, ob);
            }
      }
      __syncthreads();
    } else if (t < nQ + nKV + nFA) {
      const int t2 = t - nQ - nKV;
      const int rt = t2 >> 1, ct = t2 & 1;
      const int b = rt >> 9, jj = rt & 511;
      f32x16 acc[2][2];
      zero_acc(acc);
      gemm_core(acc, wsp<u16>(p, O_D1) + (size_t)rt * 128 * 256, 256, wsp<u16>(p, O_MA) + (size_t)ct * 128 * 256, 256,
                256, smem);
      const float* TW = wsp<float>(p, O_TW);
      u16* D2 = wsp<u16>(p, O_D2);
      const int klo = ct * 64 + wn_ * 32 + r_;
#pragma unroll
      for (int i = 0; i < 2; i++)
      {
        uint2 pr[4], pi[4];
#pragma unroll
        for (int g = 0; g < 4; g++) {
          const int nlo = wm_ * 64 + i * 32 + 8 * g + 4 * hh_;
          float re[4], im[4];
#pragma unroll
          for (int q = 0; q < 4; q++) {
            const float2 tw = *(const float2*)(TW + ((size_t)klo * 128 + nlo + q) * 2);
            const float ar = acc[i][0][4 * g + q], ai = acc[i][1][4 * g + q];
            re[q] = ar * tw.x + ai * tw.y;
            im[q] = ai * tw.x - ar * tw.y;
          }
          pr[g].x = pack2(re[0], re[1]);
          pr[g].y = pack2(re[2], re[3]);
          pi[g].x = pack2(im[0], im[1]);
          pi[g].y = pack2(im[2], im[3]);
        }
#pragma unroll
        for (int gp = 0; gp < 2; gp++) {
          u16* d = D2 + ((((size_t)(b * 128 + klo)) * 512 + jj) * 2) * 128 + wm_ * 64 + i * 32 + 8 * (2 * gp + hh_);
          *(uint4*)d = pair_swap(pr[2 * gp], pr[2 * gp + 1]);
          *(uint4*)(d + 128) = pair_swap(pi[2 * gp], pi[2 * gp + 1]);
        }
      }
    } else {
      const int rt = t - nQ - nKV - nFA;
      u16* KRR = wsp<u16>(p, O_KRR);
      for (int idx = ltid(); idx < 128 * 16; idx += 256) {
        const int rl = idx >> 4, e16 = idx & 15;
        const int row = rt * 128 + rl, b = row / KPB, kk = row - b * KPB;
        const float x1 = bf2f(LAT[(size_t)row * 512 + 384 + e16]), x2 = bf2f(LAT[(size_t)row * 512 + 400 + e16]);
        float cs, sn;
        rope_cs(kk, e16, cs, sn);
        KRR[(size_t)row * 32 + e16] = f2bf(x1 * cs - x2 * sn);
        KRR[(size_t)row * 32 + 16 + e16] = f2bf(x2 * cs + x1 * sn);
      }
    }
  }
}

template <int MODE>
__device__ void attn_item(const Params& p, int l, int b, int h, int q0  ,
                          int ntiles  , int rs0, int ycol, u16* smem) {
  constexpr int DQK = MODE == 0 ? 96 : 64;
  constexpr int KSTR = DQK + 8;
  constexpr int NKS = DQK / 16;
  constexpr int CPR = DQK / 8;
  constexpr int NKC = 64 * CPR / 256;
  const int tid = ltid(), lane = tid & 63, wave = tid >> 6, r = lane & 31, hh = lane >> 5;
  u16* Ks = smem;
  u16* Vs = smem + 2 * 64 * KSTR;
  const unsigned char* wsb = p.ws;
  const int qk = q0 + wave * 32 + r;
  const size_t qrow = (size_t)b * KPB + qk;
  bf16x8 qf[NKS];
  {
    const u16* qp = MODE == 0 ? wsp<u16>(p, O_QM) + qrow * 768 + h * 96 : wsp<u16>(p, O_QNA) + qrow * 512 + h * 64;
#pragma unroll
    for (int ks = 0; ks < NKS; ks++) qf[ks] = *(const bf16x8*)(qp + ks * 16 + hh * 8);
  }
  const short one_or_zero = hh == 0 ? (short)0x3F80 : (short)0;
  const bf16x8 kone = {one_or_zero, 0, 0, 0, 0, 0, 0, 0};
  bf16x8 qm = {0, 0, 0, 0, 0, 0, 0, 0};
  int qr = 0, qc = 0, rsq = 0, cs = 0;
  const float* rpb = nullptr;
  if (MODE == 1 && rs0 >= 0) {
    const int tkn = qk - CTXL;
    qr = tkn >> 6;
    qc = tkn & 63;
    rsq = min(max(qr - 4, 0), 248);
    cs = min(max(qc - 8, 0), 48);
    rpb = p.rpb + ((size_t)(l * 8 + h)) * 15 * 31;
  }
  f32x16 o[2];
#pragma unroll
  for (int e = 0; e < 16; e++) { o[0][e] = 0.f; o[1][e] = 0.f; }
  float lsum = 0.f;
  float m = 0.f;
  const bf16x8 ones = {(short)0x3F80, (short)0x3F80, (short)0x3F80, (short)0x3F80,
                       (short)0x3F80, (short)0x3F80, (short)0x3F80, (short)0x3F80};

#define KGEO(i)                                                                                          \
  uint32_t kof##i, kmu##i;                                                                               \
  int kls##i;                                                                                            \
  {                                                                                                      \
    const int c = tid + 256 * (i);                                                                       \
    const int row = c / CPR, cc = c - row * CPR;                                                         \
    if (MODE == 0 && cc >= 8) {                                                                          \
      kof##i = (uint32_t)(O_KRR + ((size_t)(b * KPB + row) * 32 + (cc - 8) * 8) * 2);                    \
      kmu##i = 64u;                                                                                      \
    } else {                                                                                             \
      kof##i = (uint32_t)((MODE == 0 ? O_KN : O_KNA) + ((size_t)(b * KPB + row) * 512 + h * 64 + cc * 8) * 2); \
      kmu##i = 1024u;                                                                                    \
    }                                                                                                    \
    kls##i = row * KSTR + cc * 8;                                                                        \
  }
#define VGEO(i)                                                                                          \
  uint32_t vof##i;                                                                                       \
  int vls##i;                                                                                            \
  bool vsx##i;                                                                                           \
  {                                                                                                      \
    const int c = tid + 256 * (i);                                                                       \
    const int d = c >> 3, cc = c & 7;                                                                    \
    vof##i = (uint32_t)((MODE == 0 ? O_VMT : O_VNAT) + ((size_t)(b * 512 + h * 64 + d) * KPB + cc * 8) * 2); \
    vls##i = d * 72 + cc * 8;                                                                            \
    vsx##i = (d & 8) != 0;                                                                               \
  }
  KGEO(0) KGEO(1) KGEO(2) VGEO(0) VGEO(1)
  (void)kof2; (void)kmu2; (void)kls2;
  u32x4 kr0A, kr1A, kr2A, vr0A, vr1A, kr0B, kr1B, kr2B, vr0B, vr1B;
  kr2A = kr1A = kr0A = vr0A = vr1A = kr2B = kr1B = kr0B = vr0B = vr1B = (u32x4){0u, 0u, 0u, 0u};
#define TILE_KK0(t) ((MODE == 1 && (t) >= 4) ? (uint32_t)(CTXL + 64 * min(rs0 + (t)-4, 255)) : (uint32_t)(64 * (t)))
#define LOAD_KV(t, S)                                                                   \
  {                                                                                     \
    const uint32_t kk0_ = TILE_KK0(t);                                                  \
    kr0##S = *(const u32x4*)(wsb + (size_t)(kof0 + kk0_ * kmu0));                       \
    kr1##S = *(const u32x4*)(wsb + (size_t)(kof1 + kk0_ * kmu1));                       \
    if (NKC == 3) kr2##S = *(const u32x4*)(wsb + (size_t)(kof2 + kk0_ * kmu2));         \
    vr0##S = *(const u32x4*)(wsb + (size_t)(vof0 + kk0_ * 2u));                         \
    vr1##S = *(const u32x4*)(wsb + (size_t)(vof1 + kk0_ * 2u));                         \
  }
#define STORE_V1(buf, i, srcv)                                                          \
  {                                                                                     \
    u32x4 sv_ = srcv;                                                                   \
    if (vsx##i) sv_ = (u32x4){sv_[2], sv_[3], sv_[0], sv_[1]};                          \
    *(u32x4*)(Vs + (buf)*64 * 72 + vls##i) = sv_;                                       \
  }
#define STORE_KV(buf, S)                                                                \
  {                                                                                     \
    *(u32x4*)(Ks + (buf)*64 * KSTR + kls0) = kr0##S;                                    \
    *(u32x4*)(Ks + (buf)*64 * KSTR + kls1) = kr1##S;                                    \
    if (NKC == 3) *(u32x4*)(Ks + (buf)*64 * KSTR + kls2) = kr2##S;                      \
    STORE_V1(buf, 0, vr0##S) STORE_V1(buf, 1, vr1##S)                                   \
  }
#define QK_TILE(kbuf, t)                                                                           \
  {                                                                                                \
    const u16* kb_ = Ks + (kbuf)*64 * KSTR + r * KSTR + hh * 8;                                    \
    {                                                                                              \
      f32x16 z_;                                                                                   \
      _Pragma("unroll") for (int e = 0; e < 16; e++) z_[e] = 0.f;                                  \
      sc[0] = __builtin_amdgcn_mfma_f32_32x32x16_bf16(kone, qm, z_, 0, 0, 0);                      \
      sc[1] = sc[0];                                                                               \
    }                                                                                              \
    _Pragma("unroll") for (int ks = 0; ks < NKS; ks++) {                                           \
      const bf16x8 kf0 = *(const bf16x8*)(kb_ + ks * 16);                                          \
      const bf16x8 kf1 = *(const bf16x8*)(kb_ + 32 * KSTR + ks * 16);                              \
      sc[0] = __builtin_amdgcn_mfma_f32_32x32x16_bf16(kf0, qf[ks], sc[0], 0, 0, 0);                \
      sc[1] = __builtin_amdgcn_mfma_f32_32x32x16_bf16(kf1, qf[ks], sc[1], 0, 0, 0);                \
    }                                                                                              \
    if (MODE == 1 && (t) >= 4) {                                                                   \
      const int kr_ = rs0 + (t)-4;                                                                 \
      const bool rowok = (kr_ >= rsq) && (kr_ < rsq + 8);                                          \
      const float* rp = rpb + (kr_ - qr + 7) * 31 + (15 - qc);                                     \
      _Pragma("unroll") for (int kb = 0; kb < 2; kb++) _Pragma("unroll") for (int e = 0; e < 16; e++) { \
        const int kc = kb * 32 + (e & 3) + 8 * (e >> 2) + 4 * hh;                                  \
        const bool valid = rowok && (kc >= cs) && (kc < cs + 16);                                  \
        float bias = 0.f;                                                                          \
        if (valid) bias = rp[kc];                                                                  \
        sc[kb][e] = valid ? sc[kb][e] + bias * LOG2E : -1e30f;                                     \
      }                                                                                            \
    }                                                                                              \
  }
#define TILE_MAX(tmax)                                                                             \
  {                                                                                                \
    tmax = sc[0][0];                                                                               \
    _Pragma("unroll") for (int e = 1; e < 16; e++) tmax = fmaxf(tmax, sc[0][e]);                   \
    _Pragma("unroll") for (int e = 0; e < 16; e++) tmax = fmaxf(tmax, sc[1][e]);                   \
    const uint32_t tu = __float_as_uint(tmax);                                                     \
    const auto sw = __builtin_amdgcn_permlane32_swap(tu, tu, false, false);                        \
    tmax = fmaxf(__uint_as_float(sw[0]), __uint_as_float(sw[1]));                                  \
  }
#define MOVE_REF(mnew_)                                                                            \
  {                                                                                                \
    const float mq_ = bf2f(f2bf(mnew_));                                                           \
    const float delta_ = mq_ - m;                                                                  \
    const float alpha = __builtin_amdgcn_exp2f(-delta_);                                           \
    m = mq_;                                                                                       \
    _Pragma("unroll") for (int e = 0; e < 16; e++) {                                               \
      o[0][e] *= alpha; o[1][e] *= alpha;                                                         \
      sc[0][e] -= delta_; sc[1][e] -= delta_;                                                      \
    }                                                                                              \
    lsum *= alpha;                                                                                 \
    qm[0] = (hh == 0) ? (short)f2bf(-m) : (short)0;                                                \
  }
#define SOFTMAX_PV(vbuf)                                                                           \
  {                                                                                                \
    const u16* vb_ = Vs + (vbuf)*64 * 72 + r * 72 + vsw;                                           \
    _Pragma("unroll") for (int kb = 0; kb < 2; kb++) _Pragma("unroll") for (int st = 0; st < 2; st++) { \
      u32x4 pu;                                                                                    \
      _Pragma("unroll") for (int q = 0; q < 4; q++) {                                              \
        const float p0_ = __builtin_amdgcn_exp2f(sc[kb][8 * st + 2 * q]);                          \
        const float p1_ = __builtin_amdgcn_exp2f(sc[kb][8 * st + 2 * q + 1]);                      \
        lsum += p0_ + p1_;                                                                         \
        pu[q] = pack2(p0_, p1_);                                                                   \
      }                                                                                            \
      const bf16x8 pbv = __builtin_bit_cast(bf16x8, pu);                                           \
      _Pragma("unroll") for (int db = 0; db < 2; db++) {                                           \
        const u16* vp = vb_ + db * 32 * 72 + kb * 32 + 16 * st;                                    \
        const bf16x4 vlo = *(const bf16x4*)(vp);                                                   \
        const bf16x4 vhi = *(const bf16x4*)(vp + 8);                                               \
        const bf16x8 vfv = __builtin_shufflevector(vlo, vhi, 0, 1, 2, 3, 4, 5, 6, 7);              \
        o[db] = __builtin_amdgcn_mfma_f32_32x32x16_bf16(vfv, pbv, o[db], 0, 0, 0);                 \
      }                                                                                            \
    }                                                                                              \
  }
#define DEFER_REF(tmax)                                                                            \
  if (__any(tmax > 8.f)) {                                                                         \
    const float mq_ = bf2f(f2bf(m + fmaxf(tmax, 0.f)));                                            \
    const float alpha = __builtin_amdgcn_exp2f(m - mq_);                                           \
    m = mq_;                                                                                       \
    _Pragma("unroll") for (int e = 0; e < 16; e++) { o[0][e] *= alpha; o[1][e] *= alpha; }       \
    lsum *= alpha;                                                                                 \
    qm[0] = (hh == 0) ? (short)f2bf(-m) : (short)0;                                                \
  }
#define ATT_STEP(t, LD, ST)                                        \
  {                                                                \
    const int cur = (t)&1;                                         \
    QK_TILE(cur, t)                                                \
    __builtin_amdgcn_sched_barrier(0);                             \
    LOAD_KV(min((t) + 2, tl), LD)                                  \
    __builtin_amdgcn_sched_barrier(0);                             \
    __builtin_amdgcn_s_setprio(1);                                 \
    SOFTMAX_PV(cur)                                                \
    __builtin_amdgcn_s_setprio(0);                                 \
    float tmax;                                                    \
    TILE_MAX(tmax)                                                 \
    DEFER_REF(tmax)                                                \
    STORE_KV(cur ^ 1, ST)                                          \
    __syncthreads();                                               \
  }

  const int tl = ntiles - 1;
  const int vsw = 4 * (hh ^ ((r >> 3) & 1));
  f32x16 sc[2];
  LOAD_KV(0, A)
  STORE_KV(0, A)
  LOAD_KV(min(1, tl), A)
  __syncthreads();
  {
    LOAD_KV(min(2, tl), B)
    __builtin_amdgcn_sched_barrier(0);
    QK_TILE(0, 0)
    float tmax;
    TILE_MAX(tmax)
    MOVE_REF(tmax)
    SOFTMAX_PV(0)
    STORE_KV(1, A)
    __syncthreads();
  }
  for (int t = 1; t + 1 < ntiles; t += 2) {
    ATT_STEP(t, A, B)
    ATT_STEP(t + 1, B, A)
  }
  ATT_STEP(tl, A, B)
  const float inv = 1.f / (lsum + __shfl_xor(lsum, 32));
  u16* yp = wsp<u16>(p, O_Y) + qrow * 1536 + ycol + h * 64;
#pragma unroll
  for (int db = 0; db < 2; db++)
#pragma unroll
    for (int gp = 0; gp < 2; gp++) {
      uint2 oa, ob;
      oa.x = pack2(o[db][8 * gp] * inv, o[db][8 * gp + 1] * inv);
      oa.y = pack2(o[db][8 * gp + 2] * inv, o[db][8 * gp + 3] * inv);
      ob.x = pack2(o[db][8 * gp + 4] * inv, o[db][8 * gp + 5] * inv);
      ob.y = pack2(o[db][8 * gp + 6] * inv, o[db][8 * gp + 7] * inv);
      *(uint4*)(yp + db * 32 + 8 * (2 * gp + hh)) = pair_swap(oa, ob);
    }
#undef KGEO
#undef VGEO
#undef TILE_KK0
#undef LOAD_KV
#undef STORE_V1
#undef STORE_KV
#undef QK_TILE
#undef TILE_MAX
#undef MOVE_REF
#undef SOFTMAX_PV
#undef ATT_STEP
#undef DEFER_REF
}

__device__ void phase_p3(const Params& p, int l, bool last, int bid, int nb, u16* smem) {
  EPI_DECL
  const int nMLA = 2048, nNA = 2048, nFB = 1024;
  const int nC = last ? 0 : (32 + 32 + 16);
  const int total = nMLA + nNA + nFB + nC;
  for (int t = bid; t < total; t += nb) {
    int kind, b = 0, h = 0, q0 = 0, ntl = 0, rs0 = -1;
    size_t aoff = 0, boff = 0;
    int Kf = 256, j0 = 0, tok0 = 0, tokmul = 1, colbase = 0;
    if (t < nMLA) {
      kind = 0;
      h = t & 7;
      const int rest = t >> 3;
      b = rest >> 7;
      q0 = CTXL + (rest & 127) * 128;
      ntl = 260;
    } else if (t < nMLA + nNA) {
      kind = 1;
      const int t2 = t - nMLA;
      h = t2 & 7;
      const int rest = t2 >> 3, rp = rest & 127;
      b = rest >> 7;
      rs0 = min(max(2 * rp - 4, 0), 248);
      const int rs1 = min(max(2 * rp + 1 - 4, 0), 248);
      q0 = CTXL + rp * 128;
      ntl = (4 + (rs1 + 8 - rs0) + 1) & ~1;
    } else if (t < nMLA + nNA + nFB) {
      kind = 2;
      const int rt = t - nMLA - nNA;
      const int bk = rt >> 2;
      j0 = (rt & 3) * 128;
      b = bk >> 7;
      tok0 = CTXL + (bk & 127);
      tokmul = 128;
      aoff = O_D2 + (size_t)rt * 128 * 256 * 2;
      boff = O_MB;
      Kf = 256;
    } else {
      const int t2 = t - nMLA - nNA - nFB;
      if (t2 < 64) {
        kind = t2 >> 5;
        const int t3 = t2 & 31;
        h = t3 & 7;
        b = (t3 >> 3) & 1;
        q0 = (t3 >> 4) * 128;
        ntl = 4;
      } else {
        kind = 2;
        const int t3 = t2 - 64;
        const int rt = t3 >> 1, ct = t3 & 1;
        b = rt >> 2;
        j0 = (rt & 3) * 128;
        colbase = ct * 128;
        aoff = O_D1C + (size_t)rt * 128 * 512 * 2;
        boff = O_MC + (size_t)ct * 128 * 512 * 2;
        Kf = 512;
      }
    }
    if (kind == 0) {
      attn_item<0>(p, l, b, h, q0, ntl, -1, 1024, smem);
    } else if (kind == 1) {
      attn_item<1>(p, l, b, h, q0, ntl, rs0, 512, smem);
    } else {
      f32x16 acc[2][2];
      zero_acc(acc);
      gemm_core(acc, wsp<u16>(p, aoff), Kf, wsp<u16>(p, boff), Kf, Kf, smem);
      u16* Y = wsp<u16>(p, O_Y);
#pragma unroll
      for (int i = 0; i < 2; i++)
#pragma unroll
        for (int j = 0; j < 2; j++)
#pragma unroll
          for (int gp = 0; gp < 2; gp++) {
            const int jj = j0 + wm_ * 64 + i * 32 + 8 * (2 * gp + hh_);
            const int tok = tok0 + (colbase + wn_ * 64 + j * 32 + r_) * tokmul;
            uint2 oa, ob;
            oa.x = pack2(acc[i][j][8 * gp], acc[i][j][8 * gp + 1]);
            oa.y = pack2(acc[i][j][8 * gp + 2], acc[i][j][8 * gp + 3]);
            ob.x = pack2(acc[i][j][8 * gp + 4], acc[i][j][8 * gp + 5]);
            ob.y = pack2(acc[i][j][8 * gp + 6], acc[i][j][8 * gp + 7]);
            *(uint4*)(Y + ((size_t)b * KPB + tok) * 1536 + jj) = pair_swap(oa, ob);
          }
    }
  }
}

__device__ __forceinline__ int n_row_tiles(bool last) { return last ? NRT - 4 : NRT; }
__device__ __forceinline__ int row_tile(bool last, int i) {
  if (!last) return i;
  return i < 128 ? i + 2 : i + 4;
}

__device__ void phase_p4(const Params& p, int l, bool last, int bid, int nb, u16* smem) {
  EPI_DECL
  const u16* A = wsp<u16>(p, O_A);
  const u16* Y = wsp<u16>(p, O_Y);
  u16* M = wsp<u16>(p, O_M);
  uint4* stash = wsp<uint4>(p, O_QM) + (size_t)bid * 24 * 256 + ltid();
  const int nrt_ = n_row_tiles(last);
  PATCH_LOOP_BEGIN(nrt_, 8, 8, 8)
    const int rt = row_tile(last, prt), ct = pct;
    f32x16 mg[2][2];
    zero_acc(mg);
#pragma unroll 1
    for (int g = 0; g < 3; g++) {
      uint32_t gp[2][2][8];
      {
        f32x16 acc[2][2];
        zero_acc(acc);
        gemm_core<true>(acc, wsp<u16>(p, O_WG) + (size_t)(g * 1024 + ct * 128) * D, D, A + (size_t)rt * 128 * D, D, D,
                        smem);
#pragma unroll
        for (int i = 0; i < 2; i++)
#pragma unroll
          for (int j = 0; j < 2; j++)
#pragma unroll
            for (int e = 0; e < 8; e++)
              gp[i][j][e] = pack2(fsigmoid(acc[i][j][2 * e]), fsigmoid(acc[i][j][2 * e + 1]));
      }
      {
        f32x16 acc[2][2];
        zero_acc(acc);
        gemm_core<false>(acc, wsp<u16>(p, O_WB) + (size_t)(g * 1024 + ct * 128) * 512, 512,
                         Y + (size_t)rt * 128 * 1536 + g * 512, 1536, 512, smem);
#pragma unroll
        for (int i = 0; i < 2; i++)
#pragma unroll
          for (int j = 0; j < 2; j++)
#pragma unroll
            for (int e = 0; e < 8; e++) {
              mg[i][j][2 * e] += __uint_as_float(gp[i][j][e] << 16) * acc[i][j][2 * e];
              mg[i][j][2 * e + 1] += __uint_as_float(gp[i][j][e] & 0xffff0000u) * acc[i][j][2 * e + 1];
            }
      }
    }
#pragma unroll
    for (int i = 0; i < 2; i++)
#pragma unroll
      for (int j = 0; j < 2; j++)
#pragma unroll
        for (int gp = 0; gp < 2; gp++) {
          const int row = rt * 128 + wn_ * 64 + j * 32 + r_;
          const int col = ct * 128 + wm_ * 64 + i * 32 + 8 * (2 * gp + hh_);
          uint2 oa, ob;
          oa.x = pack2(mg[i][j][8 * gp], mg[i][j][8 * gp + 1]);
          oa.y = pack2(mg[i][j][8 * gp + 2], mg[i][j][8 * gp + 3]);
          ob.x = pack2(mg[i][j][8 * gp + 4], mg[i][j][8 * gp + 5]);
          ob.y = pack2(mg[i][j][8 * gp + 6], mg[i][j][8 * gp + 7]);
          *(uint4*)(M + (size_t)row * D + col) = pair_swap(oa, ob);
        }
  PATCH_LOOP_END
}

__device__ void phase_resid(const Params& p, int l, bool last, const u16* Ain, size_t lda, const u16* W, int K, int goff,
                            int bid, int nb, u16* smem) {
  EPI_DECL
  const float* mod = wsp<float>(p, O_MOD);
  const int nrt_ = n_row_tiles(last);
  PATCH_LOOP_BEGIN(nrt_, 8, 8, 8)
    const int rt = row_tile(last, prt), ct = pct;
    f32x16 acc[2][2];
    zero_acc(acc);
    gemm_core(acc, W + (size_t)ct * 128 * K, K, Ain + (size_t)rt * 128 * lda, lda, K, smem);
    const int row0 = rt * 128, b = row0 / KPB, kk0 = row0 - b * KPB;
    const int m = kk0 < CTXL ? 2 : b;
    float* xb = xrow(p, row0);
    const float* gv = mod + ((size_t)l * 3 + m) * 6144 + goff;
#pragma unroll
    for (int i = 0; i < 2; i++)
#pragma unroll
      for (int g = 0; g < 4; g++) {
        const int col = ct * 128 + wm_ * 64 + i * 32 + 8 * g + 4 * hh_;
        const float4 g4 = *(const float4*)(gv + col);
#pragma unroll
        for (int j = 0; j < 2; j++) {
          const int rl = wn_ * 64 + j * 32 + r_;
          float4* xp = (float4*)(xb + (size_t)rl * D + col);
          float4 xv = *xp;
          xv.x = ALPHA * xv.x + (1.f + g4.x) * acc[i][j][4 * g];
          xv.y = ALPHA * xv.y + (1.f + g4.y) * acc[i][j][4 * g + 1];
          xv.z = ALPHA * xv.z + (1.f + g4.z) * acc[i][j][4 * g + 2];
          xv.w = ALPHA * xv.w + (1.f + g4.w) * acc[i][j][4 * g + 3];
          *xp = xv;
        }
      }
  PATCH_LOOP_END
}

__device__ void phase_p7(const Params& p, int l, bool last, int bid, int nb, u16* smem) {
  EPI_DECL
  const u16* A = wsp<u16>(p, O_A);
  u16* HH = wsp<u16>(p, O_HH);
  const int nrt_ = n_row_tiles(last);
  PATCH_LOOP_BEGIN(nrt_, 44, 16, 4)
    const int rt = row_tile(last, prt), ct = pct;
    f32x16 acc[2][2];
    zero_acc(acc);
    gemm_core(acc, wsp<u16>(p, O_WGU) + (size_t)ct * 128 * D, D, A + (size_t)rt * 128 * D, D, D, smem);
#pragma unroll
    for (int j = 0; j < 2; j++)
#pragma unroll
      for (int gp = 0; gp < 2; gp++) {
        const int row = rt * 128 + wn_ * 64 + j * 32 + r_;
        const int q = (ct * 2 + wm_) * 32 + 8 * (2 * gp + hh_);
        float hv[8];
#pragma unroll
        for (int t = 0; t < 8; t++) {
          const float gt = acc[0][j][8 * gp + t], up = acc[1][j][8 * gp + t];
          hv[t] = gt * fsigmoid(gt) * up;
        }
        uint2 oa, ob;
        oa.x = pack2(hv[0], hv[1]);
        oa.y = pack2(hv[2], hv[3]);
        ob.x = pack2(hv[4], hv[5]);
        ob.y = pack2(hv[6], hv[7]);
        *(uint4*)(HH + (size_t)row * FH + q) = pair_swap(oa, ob);
      }
  PATCH_LOOP_END
}

constexpr int NPHASE = 3 + 9 * 2;

__device__ void run_phase(const Params& p, int ph, int bid, int nb, u16* smem) {
  if (ph == 0) {
    prep_tables(p, bid, nb);
    prep_modp(p, bid, nb);
    prep_weights(p, 0, bid, nb, smem);
    return;
  }
  if (ph == 1) { prep_modr(p, bid, nb); return; }
  if (ph == 2) { ln_phase(p, 0, p.ln_in_g, p.ln_in_b, 0, 0, 1024, false, bid, nb); return; }
  const int l = (ph - 3) / 9, s = (ph - 3) % 9;
  const bool last = (l == 1);
  switch (s) {
    case 0: phase_p1(p, l, last, bid, nb, smem); break;
    case 1: phase_p2(p, l, bid, nb, smem); break;
    case 2: phase_p3(p, l, last, bid, nb, smem); break;
    case 3: phase_p4(p, l, last, bid, nb, smem); break;
    case 4: phase_resid(p, l, last, wsp<u16>(p, O_M), D, wsp<u16>(p, O_WO), D, 2048, bid, nb, smem); break;
    case 5: ln_phase(p, 1, p.ln1_g + l * D, p.ln1_b + l * D, l, 3072, 4096, last, bid, nb); break;
    case 6: phase_p7(p, l, last, bid, nb, smem); break;
    case 7: phase_resid(p, l, last, wsp<u16>(p, O_HH), FH, wsp<u16>(p, O_WD), FH, 5120, bid, nb, smem); break;
    default:
      ln_phase(p, 1, p.ln2_g + l * D, p.ln2_b + l * D, last ? -1 : l + 1, 0, 1024, last, bid, nb);
      if (!last) prep_weights(p, l + 1, bid, nb, smem);
      break;
  }
}


#define XB_TMO      128
#define XB_XCNT(j)  (256  + 64 * (j))
#define XB_XSUB(j)  (1280 + 64 * (j))
#define XB_XGEN(j)  (2304 + 64 * (j))
#define XB_TOP      3328
#define XB_TOPGEN   3392
#define XCD_BAR_WORDS 3456
#define XB_SPIN_CAP (1u << 20)
#define LAS __attribute__((address_space(3)))
__device__ __forceinline__ unsigned xb_ld(unsigned* p) { return __hip_atomic_load(p, __ATOMIC_RELAXED, __HIP_MEMORY_SCOPE_AGENT); }
__device__ __forceinline__ unsigned xb_add(unsigned* p, unsigned v) { return __hip_atomic_fetch_add(p, v, __ATOMIC_RELAXED, __HIP_MEMORY_SCOPE_AGENT); }
__device__ __forceinline__ unsigned xb_xcc_id() { return (unsigned)__builtin_amdgcn_s_getreg((3 << 11) | 20) & 0xFu; }
#define XB_SPIN(cond, bar) do { unsigned _sp = 0; while (cond) { __builtin_amdgcn_s_sleep(1); \
    if ((++_sp & 255u) == 0u) { if (xb_ld(&(bar)[XB_TMO])) break; if (_sp > XB_SPIN_CAP) { atomicAdd(&(bar)[XB_TMO], 1u); break; } } } } while (0)
struct XcdBarrier {
  unsigned* bar; unsigned x;
  volatile LAS unsigned* st;
};
__device__ __forceinline__ XcdBarrier xcd_barrier_post(unsigned* bar, volatile LAS unsigned* st) {
  XcdBarrier b; b.bar = bar; b.x = xb_xcc_id(); b.st = st;
  if (threadIdx.x == 0) (void)xb_add(&bar[XB_XCNT(b.x)], 1u);
  return b;
}
__device__ __forceinline__ void xcd_barrier_complete(unsigned* bar, unsigned x, unsigned& nloc, unsigned& nx) {
  const unsigned G = gridDim.x * gridDim.y * gridDim.z;
  unsigned sum, cnt, mine, sp = 0u;
  for (;;) {
    sum = 0u; cnt = 0u; mine = 0u;
#pragma unroll
    for (unsigned j = 0; j < 16; ++j) { const unsigned c = xb_ld(&bar[XB_XCNT(j)]); sum += c; cnt += (c > 0u) ? 1u : 0u; mine = (j == x) ? c : mine; }
    if (sum == G) break;
    __builtin_amdgcn_s_sleep(1);
    if ((++sp & 255u) == 0u) { if (xb_ld(&bar[XB_TMO])) break; if (sp > XB_SPIN_CAP) { atomicAdd(&bar[XB_TMO], 1u); break; } }
  }
  nloc = mine > 0u ? mine : 1u; nx = cnt > 0u ? cnt : 1u;
}
__device__ __forceinline__ void xcd_barrier(const XcdBarrier& b) {
  asm volatile("s_waitcnt vmcnt(0)" ::: "memory");
  __syncthreads();
  if (threadIdx.x == 0) {
    unsigned* bar = b.bar;
    __builtin_amdgcn_s_waitcnt(0);
    unsigned nloc = b.st[0], nx = b.st[1];
    if (nloc == 0u) { xcd_barrier_complete(bar, b.x, nloc, nx); b.st[0] = nloc; b.st[1] = nx; }
    const unsigned old = xb_add(&bar[XB_XSUB(b.x)], 1u);
    const unsigned gen = old / nloc;
    if (old + 1u == (gen + 1u) * nloc) {
      __builtin_amdgcn_fence(__ATOMIC_RELEASE, "agent");
      asm volatile("s_waitcnt vmcnt(0)" ::: "memory");
      const unsigned og = xb_add(&bar[XB_TOP], 1u);
      const unsigned tg = og / nx;
      if (og + 1u == (tg + 1u) * nx) xb_add(&bar[XB_TOPGEN], 1u);
      else XB_SPIN(xb_ld(&bar[XB_TOPGEN]) == tg, bar);
      __builtin_amdgcn_fence(__ATOMIC_ACQUIRE, "agent");
      xb_add(&bar[XB_XGEN(b.x)], 1u);
      asm volatile("s_waitcnt vmcnt(0)" ::: "memory");
    } else {
      XB_SPIN(xb_ld(&bar[XB_XGEN(b.x)]) == gen, bar);
      __builtin_amdgcn_fence(__ATOMIC_ACQUIRE, "agent");
      asm volatile("s_waitcnt vmcnt(0)" ::: "memory");
    }
  }
  __syncthreads();
}

constexpr int SMEM_ELEMS = 4 * SM_A + 256 + 8;

#if COOP
__global__ void __launch_bounds__(256, 2) mega_kernel(Params p) {
  __shared__ __attribute__((aligned(16))) u16 smem[SMEM_ELEMS];
  cg::grid_group grid = cg::this_grid();
  volatile LAS unsigned* st = (volatile LAS unsigned*)(smem + 4 * SM_A + 256);
  if (threadIdx.x == 0) { st[0] = 0u; st[1] = 0u; }
  __syncthreads();
  XcdBarrier xb = xcd_barrier_post((unsigned*)(p.ws + O_BAR), st);
  for (int ph = 0; ph < NPHASE; ph++) {
#ifdef PROBE_MASK
    const int s9 = ph >= 3 ? (ph - 3) % 9 : -1;
    const int nrep = (s9 >= 0 && ((PROBE_MASK >> s9) & 1)) ? 2 : 1;
    for (int rep = 0; rep < nrep; rep++) {
      run_phase(p, ph, blockIdx.x, gridDim.x, smem);
      if (ph == 0) grid.sync();
      else if (ph + 1 < NPHASE || rep + 1 < nrep) xcd_barrier(xb);
    }
#else
    run_phase(p, ph, blockIdx.x, gridDim.x, smem);
    if (ph == 0) grid.sync();
    else if (ph + 1 < NPHASE) xcd_barrier(xb);
#endif
  }
}
#else
__global__ void __launch_bounds__(256, 2) phase_kernel(Params p, int ph) {
  __shared__ __attribute__((aligned(16))) u16 smem[SMEM_ELEMS];
  run_phase(p, ph, blockIdx.x, gridDim.x, smem);
}
#endif

extern "C" void kernel_launch(void* const* d_in, const int* in_sizes, int n_in, void* d_out, int out_size, void* d_ws,
                              size_t ws_size, hipStream_t stream) {
  Params p{};
  const float** f = (const float**)&p;
  for (int i = 0; i < 25; i++) f[i] = (const float*)d_in[i];
  p.out = (float*)d_out;
  p.ws = (unsigned char*)d_ws;
  if (ws_size < O_WSEND) fprintf(stderr, "workspace too small: %zu < %zu\n", ws_size, (size_t)O_WSEND);
#if COOP
  static int grid_blocks = 0;
  if (!grid_blocks) {
    int dev = 0, cus = 0, per_cu = 0;
    hipGetDevice(&dev);
    hipDeviceGetAttribute(&cus, hipDeviceAttributeMultiprocessorCount, dev);
    hipOccupancyMaxActiveBlocksPerMultiprocessor(&per_cu, mega_kernel, 256, 0);
    if (per_cu > 2) per_cu = 2;
    grid_blocks = cus * per_cu;
  }
  (void)hipMemsetAsync(p.ws + O_BAR, 0, 3456 * 4, stream);
  void* args[] = {&p};
  hipError_t e = hipLaunchCooperativeKernel((void*)mega_kernel, dim3(grid_blocks), dim3(256), args, 0, stream);
  if (e != hipSuccess) fprintf(stderr, "cooperative launch failed: %s (grid %d)\n", hipGetErrorString(e), grid_blocks);
#else
  for (int ph = 0; ph < NPHASE; ph++) phase_kernel<<<512, 256, 0, stream>>>(p, ph);
#endif
}
```

```cpp
#include <hip/hip_runtime.h>
#include <hip/hip_cooperative_groups.h>
#include <stdint.h>
#include <cstdio>
namespace cg = cooperative_groups;

#ifndef COOP
#define COOP 1
#endif

typedef __attribute__((ext_vector_type(8))) short bf16x8;
typedef __attribute__((ext_vector_type(4))) short bf16x4;
typedef __attribute__((ext_vector_type(16))) float f32x16;
typedef unsigned short u16;
typedef __attribute__((ext_vector_type(4))) unsigned int u32x4;

constexpr int D = 1024;
constexpr int NBATCH = 2;
constexpr int SEQ = 16384;
constexpr int CTXL = 256;
constexpr int KPB = SEQ + CTXL;
constexpr int T = NBATCH * KPB;
constexpr int NRT = T / 128;
constexpr int FH = 2816;
constexpr int IN_DIM = 5536;
constexpr float LOG2E = 1.4426950408889634f;
constexpr float NA_SCALE_L2 = 0.125f * LOG2E;
constexpr float MLA_SCALE_L2 = 0.10206207261596575f * LOG2E;
constexpr float ALPHA = 1.4142135623730951f;
constexpr float EPS = 1e-5f;
constexpr float RS128 = 0.08838834764831845f;

constexpr size_t al256(size_t x) { return (x + 255) & ~(size_t)255; }
constexpr size_t O_WF = 0;
constexpr size_t O_WP = O_WF + (size_t)1024 * 1024 * 2;
constexpr size_t O_WG = O_WP + (size_t)2048 * 1024 * 2;
constexpr size_t O_WUQ = O_WG + (size_t)3072 * 1024 * 2;
constexpr size_t O_WUKV = O_WUQ + (size_t)768 * 256 * 2;
constexpr size_t O_WB = O_WUKV + (size_t)1024 * 128 * 2;
constexpr size_t O_WO = O_WB + (size_t)3 * 1024 * 512 * 2;
constexpr size_t O_WGU = O_WO + (size_t)1024 * 1024 * 2;
constexpr size_t O_WD = O_WGU + (size_t)5632 * 1024 * 2;
constexpr size_t O_MA = O_WD + (size_t)1024 * 2816 * 2;
constexpr size_t O_MB = O_MA + (size_t)256 * 256 * 2;
constexpr size_t O_MC = O_MB + (size_t)128 * 256 * 2;
constexpr size_t O_TW = O_MC + (size_t)256 * 512 * 2;
constexpr size_t O_MODP = O_TW + (size_t)128 * 128 * 2 * 4;
constexpr size_t O_MOD = O_MODP + (size_t)16 * 2 * 3 * 6144 * 4;
constexpr size_t O_XCTX = O_MOD + (size_t)2 * 3 * 6144 * 4;
constexpr size_t O_D1C = O_XCTX + (size_t)512 * 1024 * 4;
constexpr size_t O_A = O_D1C + (size_t)2 * 512 * 2 * 256 * 2;
constexpr size_t O_RQ = O_A + (size_t)T * 1024 * 2;
constexpr size_t O_QNA = O_RQ;
constexpr size_t O_KNA = O_QNA + (size_t)T * 512 * 2;
constexpr size_t O_VNAT = O_KNA + (size_t)T * 512 * 2;
constexpr size_t O_RY = O_VNAT + (size_t)T * 512 * 2;
constexpr size_t O_Y = O_RY;
constexpr size_t O_D1 = O_RY;
constexpr size_t O_LAT = O_RY + (size_t)67108864;
constexpr size_t O_D2 = O_RY + (size_t)T * 1536 * 2;
constexpr size_t O_QM = O_D2 + (size_t)67108864;
constexpr size_t O_KN = O_QM + (size_t)T * 768 * 2;
constexpr size_t O_KRR = O_KN + (size_t)T * 512 * 2;
constexpr size_t O_VMT = O_KRR + (size_t)T * 32 * 2;
constexpr size_t O_END = O_VMT + (size_t)T * 512 * 2;
constexpr size_t O_BAR = (O_END + 255) & ~(size_t)255;
constexpr size_t O_WSEND = O_BAR + 3456 * 4;
constexpr size_t O_FB = O_QM;
constexpr size_t O_M = O_RQ;
constexpr size_t O_HH = O_RQ;

struct Params {
  const float *x, *c, *ctx, *c_ctx, *ln_in_g, *ln_in_b, *w_mod, *b_mod, *w_in, *gq, *gkv, *w_uq, *w_qr, *w_uk,
      *w_uv, *rpb, *w_branch, *w_out, *ln1_g, *ln1_b, *ln2_g, *ln2_b, *w_gate, *w_up, *w_down;
  float* out;
  unsigned char* ws;
};

__device__ __forceinline__ u16 f2bf(float f) {
  uint32_t u = __float_as_uint(f);
  u += 0x7fffu + ((u >> 16) & 1u);
  return (u16)(u >> 16);
}
typedef __attribute__((ext_vector_type(2))) __bf16 bf16v2;
typedef __attribute__((ext_vector_type(2))) float f32v2;
__device__ __forceinline__ uint32_t pack2(float a, float b) {
  const f32v2 v = {a, b};
  return __builtin_bit_cast(uint32_t, __builtin_convertvector(v, bf16v2));
}
__device__ __forceinline__ uint4 pair_swap(uint2 a, uint2 b) {
  const auto rx = __builtin_amdgcn_permlane32_swap(a.x, b.x, false, false);
  const auto ry = __builtin_amdgcn_permlane32_swap(a.y, b.y, false, false);
  return make_uint4(rx[0], ry[0], rx[1], ry[1]);
}
__device__ __forceinline__ float bf2f(u16 v) { return __uint_as_float(((uint32_t)v) << 16); }
__device__ __forceinline__ float wsum(float v) {
#pragma unroll
  for (int o = 32; o > 0; o >>= 1) v += __shfl_xor(v, o);
  return v;
}
__device__ __forceinline__ float fsigmoid(float v) { return 1.f / (1.f + __expf(-v)); }

__device__ __forceinline__ int ltid() {
  int t = threadIdx.x;
  asm volatile("" : "+v"(t));
  return t;
}

template <typename Tp>
__device__ __forceinline__ Tp* wsp(const Params& p, size_t off) { return (Tp*)(p.ws + off); }

__device__ __forceinline__ float* xrow(const Params& p, int row) {
  int b = row / KPB, kk = row - b * KPB;
  if (kk < CTXL) return wsp<float>(p, O_XCTX) + (size_t)(b * CTXL + kk) * D;
  return p.out + (size_t)(b * SEQ + kk - CTXL) * D;
}

constexpr int LSTR = 72;
constexpr int SM_A = 128 * LSTR;

template <bool DEEP = true>
__device__ __forceinline__ void gemm_core(f32x16 (&acc)[2][2], const u16* __restrict__ A, size_t lda,
                                          const u16* __restrict__ B, size_t ldb, int K, u16* smem) {
  const int tid = ltid(), lane = tid & 63, wave = tid >> 6;
  const int wm = wave >> 1, wn = wave & 1, r = lane & 31, hh = lane >> 5;
  u16* sA = smem;
  u16* sB = smem + 2 * SM_A;
  const int lrow = tid >> 3, lkc = (tid & 7) * 8;
  const unsigned char* gab = (const unsigned char*)A;
  const unsigned char* gbb = (const unsigned char*)B;
  uint32_t oa[4], ob[4];
#pragma unroll
  for (int i = 0; i < 4; i++) {
    oa[i] = (uint32_t)(((size_t)(lrow + 32 * i) * lda + lkc) * 2);
    ob[i] = (uint32_t)(((size_t)(lrow + 32 * i) * ldb + lkc) * 2);
  }
  u16* wa = sA + lrow * LSTR + lkc;
  u16* wb = sB + lrow * LSTR + lkc;
  const u16* pa = sA + (wm * 64 + r) * LSTR + hh * 8;
  const u16* pb = sB + (wn * 64 + r) * LSTR + hh * 8;
  u32x4 a0r[4], b0r[4], a1r[4], b1r[4];
#define G_LOAD(ar, br, ko)                                               \
  _Pragma("unroll") for (int i = 0; i < 4; i++) {                        \
    ar[i] = *(const u32x4*)(gab + (size_t)(ko)*2 + oa[i]);               \
    br[i] = *(const u32x4*)(gbb + (size_t)(ko)*2 + ob[i]);               \
  }
#define G_STORE(ar, br, buf)                                             \
  _Pragma("unroll") for (int i = 0; i < 4; i++) {                        \
    *(u32x4*)(wa + (buf)*SM_A + 32 * i * LSTR) = ar[i];                  \
    *(u32x4*)(wb + (buf)*SM_A + 32 * i * LSTR) = br[i];                  \
  }
#define G_COMPUTE(buf)                                                                   \
  _Pragma("unroll") for (int ks = 0; ks < 4; ks++) {                                     \
    const bf16x8 fa0 = *(const bf16x8*)(pa + (buf)*SM_A + ks * 16);                      \
    const bf16x8 fa1 = *(const bf16x8*)(pa + (buf)*SM_A + 32 * LSTR + ks * 16);          \
    const bf16x8 fb0 = *(const bf16x8*)(pb + (buf)*SM_A + ks * 16);                      \
    const bf16x8 fb1 = *(const bf16x8*)(pb + (buf)*SM_A + 32 * LSTR + ks * 16);          \
    acc[0][0] = __builtin_amdgcn_mfma_f32_32x32x16_bf16(fa0, fb0, acc[0][0], 0, 0, 0);   \
    acc[0][1] = __builtin_amdgcn_mfma_f32_32x32x16_bf16(fa0, fb1, acc[0][1], 0, 0, 0);   \
    acc[1][0] = __builtin_amdgcn_mfma_f32_32x32x16_bf16(fa1, fb0, acc[1][0], 0, 0, 0);   \
    acc[1][1] = __builtin_amdgcn_mfma_f32_32x32x16_bf16(fa1, fb1, acc[1][1], 0, 0, 0);   \
  }
  const int nk = K >> 6;
  if (DEEP) {
    G_LOAD(a0r, b0r, 0)
    G_LOAD(a1r, b1r, 64)
    G_STORE(a0r, b0r, 0)
    __syncthreads();
    const int klast = (nk - 1) * 64;
    G_LOAD(a0r, b0r, min(128, klast))
    for (int kt = 0; kt < nk; kt += 2) {
      G_COMPUTE(0)
      G_STORE(a1r, b1r, 1)
      __syncthreads();
      G_LOAD(a1r, b1r, min((kt + 3) * 64, klast))
      __builtin_amdgcn_sched_barrier(0);
      G_COMPUTE(1)
      G_STORE(a0r, b0r, 0)
      __syncthreads();
      G_LOAD(a0r, b0r, min((kt + 4) * 64, klast))
      __builtin_amdgcn_sched_barrier(0);
    }
  } else {
    G_LOAD(a0r, b0r, 0)
    G_STORE(a0r, b0r, 0)
    __syncthreads();
    for (int kt = 0; kt < nk; kt += 2) {
      G_LOAD(a0r, b0r, (kt + 1) * 64)
      G_COMPUTE(0)
      G_STORE(a0r, b0r, 1)
      __syncthreads();
      if (kt + 2 < nk) G_LOAD(a0r, b0r, (kt + 2) * 64)
      G_COMPUTE(1)
      if (kt + 2 < nk) G_STORE(a0r, b0r, 0)
      __syncthreads();
    }
  }
#undef G_LOAD
#undef G_STORE
#undef G_COMPUTE
}

__device__ __forceinline__ void zero_acc(f32x16 (&acc)[2][2]) {
#pragma unroll
  for (int i = 0; i < 2; i++)
#pragma unroll
    for (int j = 0; j < 2; j++)
#pragma unroll
      for (int e = 0; e < 16; e++) acc[i][j][e] = 0.f;
}

#define EPI_DECL                                                     \
  const int lane_ = ltid() & 63, wave_ = ltid() >> 6;      \
  const int wm_ = wave_ >> 1, wn_ = wave_ & 1, r_ = lane_ & 31, hh_ = lane_ >> 5; \
  (void)wm_; (void)wn_; (void)r_; (void)hh_;

__device__ __forceinline__ const float* src_col(const Params& p, int l, int kind, int n, int& ld) {
  switch (kind) {
    case 0:
      ld = IN_DIM;
      return n < 1952 ? p.w_in + (size_t)l * D * IN_DIM + 512 + n : nullptr;
    case 1:
      ld = IN_DIM;
      return p.w_in + (size_t)l * D * IN_DIM + 2464 + n;
    case 2:
      if (n < 512) {
        ld = 512;
        return p.w_uq + (size_t)l * 256 * 512 + n;
      } else {
        int m = n - 512, wt = m >> 6, jb = (m >> 5) & 1, idx = wt * 32 + (m & 31);
        int h = idx >> 4, e = idx & 15;
        ld = 256;
        return p.w_qr + (size_t)l * 256 * 256 + h * 32 + jb * 16 + e;
      }
    case 3:
      ld = 512;
      return n < 512 ? p.w_uk + (size_t)l * 128 * 512 + n : p.w_uv + (size_t)l * 128 * 512 + (n - 512);
    case 4: {
      int g = n >> 10, nn = n & 1023;
      ld = 1024;
      return p.w_branch + ((size_t)(l * 3 + g) * 512) * 1024 + nn;
    }
    case 5:
      ld = 1024;
      return p.w_out + (size_t)l * D * D + n;
    case 6: {
      int jb = (n >> 5) & 1, q = (n >> 6) * 32 + (n & 31);
      ld = FH;
      return (jb ? p.w_up : p.w_gate) + (size_t)l * D * FH + q;
    }
    default:
      ld = 1024;
      return p.w_down + (size_t)l * FH * D + n;
  }
}

__device__ __forceinline__ int job_nd(int k) {
  switch (k) { case 0: return 2048; case 1: return 3072; case 2: return 768; case 3: return 1024; case 4: return 3072;
    case 5: return 1024; case 6: return 5632; default: return 1024; }
}
__device__ __forceinline__ int job_kd(int k) {
  switch (k) { case 0: return 1024; case 1: return 1024; case 2: return 256; case 3: return 128; case 4: return 512;
    case 5: return 1024; case 6: return 1024; default: return 2816; }
}
__device__ __forceinline__ size_t job_od(int k) {
  switch (k) { case 0: return O_WP; case 1: return O_WG; case 2: return O_WUQ; case 3: return O_WUKV; case 4: return O_WB;
    case 5: return O_WO; case 6: return O_WGU; default: return O_WD; }
}
__device__ void prep_weights(const Params& p, int l, int bid, int nb, u16* smem) {
  float* tile = (float*)smem;
  const int tid = ltid();
  int start = 0;
#pragma unroll 1
  for (int kind = 0; kind < 8; kind++) {
    const int Kk = job_kd(kind);
    const int nkt = Kk >> 6, ntile = (job_nd(kind) >> 6) * nkt;
    u16* dst = wsp<u16>(p, job_od(kind));
    const float* ksc = kind == 2 ? p.gq + l * 256 : (kind == 3 ? p.gkv + l * 128 : nullptr);
    for (int t = (bid + nb - (start % nb)) % nb; t < ntile; t += nb) {
      const int nt = t / nkt, kt = t - nt * nkt;
      const int n0 = nt * 64, k0 = kt * 64;
      {
        const int kq = tid >> 4, nn4 = (tid & 15) * 4;
        int ld;
        const float* sp = src_col(p, l, kind, n0 + nn4, ld);
#pragma unroll
        for (int i = 0; i < 4; i++) {
          const int kk = i * 16 + kq;
          float4 v = make_float4(0.f, 0.f, 0.f, 0.f);
          if (sp) v = *(const float4*)(sp + (size_t)(k0 + kk) * ld);
          if (ksc) {
            const float sc = ksc[k0 + kk];
            v.x *= sc; v.y *= sc; v.z *= sc; v.w *= sc;
          }
          float* tp = tile + kk * 65 + nn4;
          tp[0] = v.x; tp[1] = v.y; tp[2] = v.z; tp[3] = v.w;
        }
      }
      __syncthreads();
#pragma unroll
      for (int i = 0; i < 2; i++) {
        const int c = tid + 256 * i;
        const int nn = c >> 3, kc = (c & 7) * 8;
        const float* tp = tile + kc * 65 + nn;
        uint4 o;
        o.x = pack2(tp[0], tp[65]);
        o.y = pack2(tp[2 * 65], tp[3 * 65]);
        o.z = pack2(tp[4 * 65], tp[5 * 65]);
        o.w = pack2(tp[6 * 65], tp[7 * 65]);
        *(uint4*)(dst + (size_t)(n0 + nn) * Kk + k0 + kc) = o;
      }
      __syncthreads();
    }
    start += ntile;
  }
  {
    float* ctab = (float*)smem;
    __syncthreads();
    if (tid < 128) ctab[tid] = cospif((float)tid * (1.f / 64.f));
    __syncthreads();
    u16* dst = wsp<u16>(p, O_WF);
    for (int it = bid; it < 512; it += nb) {
      const int o = it * 256 + tid;
      const int np = o & 1023, k8 = (o >> 10) * 8;
      const int reim = np >> 9, g = (np >> 7) & 3, m = np & 127;
      const float* w = p.w_in + (size_t)l * D * IN_DIM + (size_t)k8 * IN_DIM + g * 128;
      const int sh = reim ? 96 : 0;
      float a8[8];
#pragma unroll
      for (int j = 0; j < 8; j++) a8[j] = 0.f;
#pragma unroll 4
      for (int c = 0; c < 128; c++) {
        const float tw = ctab[(m * c + sh) & 127];
#pragma unroll
        for (int j = 0; j < 8; j++) a8[j] += w[(size_t)j * IN_DIM + c] * tw;
      }
      uint4 ov;
      ov.x = pack2(a8[0] * RS128, a8[1] * RS128);
      ov.y = pack2(a8[2] * RS128, a8[3] * RS128);
      ov.z = pack2(a8[4] * RS128, a8[5] * RS128);
      ov.w = pack2(a8[6] * RS128, a8[7] * RS128);
      *(uint4*)(dst + (size_t)np * 1024 + k8) = ov;
    }
    __syncthreads();
  }
}

__device__ void prep_tables(const Params& p, int bid, int nb) {
  u16* MA = wsp<u16>(p, O_MA);
  u16* MB = wsp<u16>(p, O_MB);
  u16* MC = wsp<u16>(p, O_MC);
  float* TW = wsp<float>(p, O_TW);
  const int total = 65536 + 32768 + 131072 + 16384;
  for (int idx = bid * 256 + ltid(); idx < total; idx += nb * 256) {
    if (idx < 65536) {
      const int n = idx >> 8, k = idx & 255;
      const int nt = n >> 7, wn = (n >> 6) & 1, jb = (n >> 5) & 1, klo = nt * 64 + wn * 32 + (n & 31);
      const int ri = k >> 7, nhi = k & 127;
      const int xx = (klo * nhi) & 127;
      const float c = cospif((float)xx * (1.f / 64.f)), s = sinpif((float)xx * (1.f / 64.f));
      float v = jb == 0 ? (ri == 0 ? c : -s) : (ri == 0 ? -s : -c);
      MA[idx] = f2bf(v * RS128);
    } else if (idx < 65536 + 32768) {
      const int i2 = idx - 65536;
      const int khi = i2 >> 8, k = i2 & 255;
      const int ri = k >> 7, nlo = k & 127;
      const int xx = (khi * nlo) & 127;
      const float c = cospif((float)xx * (1.f / 64.f)), s = sinpif((float)xx * (1.f / 64.f));
      MB[i2] = f2bf((ri == 0 ? c : s) * RS128);
    } else if (idx < 65536 + 32768 + 131072) {
      const int i2 = idx - 65536 - 32768;
      const int kk = i2 >> 9, k = i2 & 511;
      const int ri = k >> 8, nn = k & 255;
      const int xx = (kk * nn) & 255;
      const float c = cospif((float)xx * (1.f / 128.f)), s = sinpif((float)xx * (1.f / 128.f));
      MC[i2] = f2bf((ri == 0 ? c : -s) * 0.0625f);
    } else {
      const int i2 = idx - 65536 - 32768 - 131072;
      const int klo = i2 >> 7, nlo = i2 & 127;
      const int xx = klo * nlo;
      TW[i2 * 2] = cospif((float)xx * (1.f / 8192.f));
      TW[i2 * 2 + 1] = sinpif((float)xx * (1.f / 8192.f));
    }
  }
}

__device__ void prep_modp(const Params& p, int bid, int nb) {
  float* modp = wsp<float>(p, O_MODP);
  for (int it = bid; it < 2 * 16 * 24; it += nb) {
    const int l = it / (16 * 24), rem = it - l * 16 * 24, kc = rem / 24, nblk = rem - kc * 24;
    const int n = nblk * 256 + ltid();
    const float* w = p.w_mod + (size_t)l * D * 6144 + n;
    float a0 = 0.f, a1 = 0.f, a2 = 0.f;
#pragma unroll 8
    for (int kk = 0; kk < 64; kk++) {
      const int k = kc * 64 + kk;
      const float wv = w[(size_t)k * 6144];
      float c0 = p.c[k], c1 = p.c[1024 + k], c2 = p.c_ctx[k];
      c0 = c0 / (1.f + __expf(-c0));
      c1 = c1 / (1.f + __expf(-c1));
      c2 = c2 / (1.f + __expf(-c2));
      a0 += c0 * wv;
      a1 += c1 * wv;
      a2 += c2 * wv;
    }
    float* o = modp + ((size_t)(kc * 2 + l) * 3) * 6144 + n;
    o[0] = a0;
    o[6144] = a1;
    o[2 * 6144] = a2;
  }
}
__device__ void prep_modr(const Params& p, int bid, int nb) {
  const float* modp = wsp<float>(p, O_MODP);
  float* mod = wsp<float>(p, O_MOD);
  for (int idx = bid * 256 + ltid(); idx < 2 * 3 * 6144; idx += nb * 256) {
    const int l = idx / (3 * 6144), n = idx % 6144;
    float v = p.b_mod[l * 6144 + n];
    for (int kc = 0; kc < 16; kc++) v += modp[(size_t)kc * 2 * 3 * 6144 + idx];
    mod[idx] = v;
  }
}

__device__ void ln_phase(const Params& p, int mode, const float* g, const float* bta, int lmod, int shoff, int scoff,
                         bool skip_ctx, int bid, int nb, int lres = 0, int goff = -1) {
  const int lane = ltid() & 63, wave = ltid() >> 6;
  u16* A = wsp<u16>(p, O_A);
  const float* mod = wsp<float>(p, O_MOD);
  float4 gg[4], bb[4], sh[4], sc[4], gt[4];
#pragma unroll
  for (int q = 0; q < 4; q++) gt[q] = make_float4(0.f, 0.f, 0.f, 0.f);
  int cur_mg = -1;
#pragma unroll
  for (int q = 0; q < 4; q++) {
    const int c0 = (q >> 1) * 512 + lane * 8 + (q & 1) * 4;
    gg[q] = *(const float4*)(g + c0);
    bb[q] = *(const float4*)(bta + c0);
    sh[q] = make_float4(0.f, 0.f, 0.f, 0.f);
    sc[q] = make_float4(0.f, 0.f, 0.f, 0.f);
  }
  int cur_m = -1;
  for (int row = bid * 4 + wave; row < T; row += nb * 4) {
    const int b = row / KPB, kk = row - b * KPB;
    if (skip_ctx && kk < CTXL) continue;
    float* xr = xrow(p, row);
    const float* src;
    if (mode == 0)
      src = kk < CTXL ? p.ctx + (size_t)(b * CTXL + kk) * D : p.x + (size_t)(b * SEQ + kk - CTXL) * D;
    else
      src = xr;
    float4 v[4];
    float s = 0.f;
    const int m = kk < CTXL ? 2 : b;
    if (goff >= 0 && m != cur_mg) {
      cur_mg = m;
#pragma unroll
      for (int q = 0; q < 4; q++)
        gt[q] = *(const float4*)(mod + ((size_t)lres * 3 + m) * 6144 + goff + (q >> 1) * 512 + lane * 8 + (q & 1) * 4);
    }
#pragma unroll
    for (int i = 0; i < 2; i++) {
      uint4 fv = make_uint4(0u, 0u, 0u, 0u);
      if (goff >= 0) fv = *(const uint4*)(wsp<u16>(p, O_FB) + (size_t)row * D + i * 512 + lane * 8);
      const uint32_t fw[4] = {fv.x, fv.y, fv.z, fv.w};
#pragma unroll
      for (int hq = 0; hq < 2; hq++) {
        const int q = i * 2 + hq;
        v[q] = *(const float4*)(src + i * 512 + lane * 8 + hq * 4);
        if (goff >= 0) {
          v[q].x = ALPHA * v[q].x + (1.f + gt[q].x) * __uint_as_float(fw[hq * 2] << 16);
          v[q].y = ALPHA * v[q].y + (1.f + gt[q].y) * __uint_as_float(fw[hq * 2] & 0xffff0000u);
          v[q].z = ALPHA * v[q].z + (1.f + gt[q].z) * __uint_as_float(fw[hq * 2 + 1] << 16);
          v[q].w = ALPHA * v[q].w + (1.f + gt[q].w) * __uint_as_float(fw[hq * 2 + 1] & 0xffff0000u);
        }
        s += v[q].x + v[q].y + v[q].z + v[q].w;
      }
    }
    if (lmod >= 0 && m != cur_m) {
      cur_m = m;
      const float* md = mod + ((size_t)lmod * 3 + m) * 6144;
#pragma unroll
      for (int q = 0; q < 4; q++) {
        const int c0 = (q >> 1) * 512 + lane * 8 + (q & 1) * 4;
        sh[q] = *(const float4*)(md + shoff + c0);
        sc[q] = *(const float4*)(md + scoff + c0);
      }
    }
    const float mu = wsum(s) * (1.f / 1024.f);
    float qs = 0.f;
#pragma unroll
    for (int q = 0; q < 4; q++) {
      v[q].x -= mu; v[q].y -= mu; v[q].z -= mu; v[q].w -= mu;
      qs += v[q].x * v[q].x + v[q].y * v[q].y + v[q].z * v[q].z + v[q].w * v[q].w;
    }
    const float rstd = rsqrtf(wsum(qs) * (1.f / 1024.f) + EPS);
#pragma unroll
    for (int i = 0; i < 2; i++) {
      uint4 o;
      uint32_t ow[4];
#pragma unroll
      for (int hq = 0; hq < 2; hq++) {
        const int q = i * 2 + hq;
        float4 y;
        y.x = v[q].x * rstd * gg[q].x + bb[q].x;
        y.y = v[q].y * rstd * gg[q].y + bb[q].y;
        y.z = v[q].z * rstd * gg[q].z + bb[q].z;
        y.w = v[q].w * rstd * gg[q].w + bb[q].w;
        *(float4*)(xr + i * 512 + lane * 8 + hq * 4) = y;
        ow[hq * 2] = pack2(y.x * (1.f + sc[q].x) + sh[q].x, y.y * (1.f + sc[q].y) + sh[q].y);
        ow[hq * 2 + 1] = pack2(y.z * (1.f + sc[q].z) + sh[q].z, y.w * (1.f + sc[q].w) + sh[q].w);
      }
      if (lmod >= 0) {
        o.x = ow[0]; o.y = ow[1]; o.z = ow[2]; o.w = ow[3];
        *(uint4*)(A + (size_t)row * D + i * 512 + lane * 8) = o;
      }
    }
  }
}

#define PATCH_LOOP_BEGIN(NR_, NC_, PR_, PC_)                                   \
  {                                                                            \
    const int x_ = bid & 7, w_ = bid >> 3, nbx_ = nb >> 3;                     \
    const int CG_ = ((NC_) + (PC_)-1) / (PC_);                                 \
    const int npatch_ = (((NR_) + (PR_)-1) / (PR_)) * CG_;                     \
    for (int u_ = w_;; u_ += nbx_) {                                           \
      const int g_ = (u_ >> 6) * 8 + x_;                                       \
      if (g_ >= npatch_) break;                                                \
      const int s_ = u_ & 63;                                                  \
      const int rg_ = g_ / CG_;                                                \
      const int prt = rg_ * (PR_) + s_ / (PC_);                                \
      const int pct = (g_ - rg_ * CG_) * (PC_) + s_ % (PC_);                   \
      if (prt >= (NR_) || pct >= (NC_)) continue;
#define PATCH_LOOP_END \
    }                  \
  }

__device__ void phase_p1(const Params& p, int l, bool last, int bid, int nb, u16* smem) {
  EPI_DECL
  const u16* A = wsp<u16>(p, O_A);
  PATCH_LOOP_BEGIN(NRT, 16, 8, 8)
    f32x16 acc[2][2];
    zero_acc(acc);
    {
      const int rt = prt, ct = pct;
      const int row0 = rt * 128, b = row0 / KPB, kk0 = row0 - b * KPB;
      if (ct < 8 || ct >= 12) {
        gemm_core(acc, wsp<u16>(p, O_WP) + (size_t)ct * 128 * D, D, A + (size_t)rt * 128 * D, D, D, smem);
        u16* dst;
        float sc = 1.f;
        int cb;
        if (ct < 4) { dst = wsp<u16>(p, O_QNA); sc = NA_SCALE_L2; cb = ct * 128; }
        else if (ct < 8) { dst = wsp<u16>(p, O_KNA); cb = (ct - 4) * 128; }
        else { dst = wsp<u16>(p, O_LAT); cb = (ct - 12) * 128; }
#pragma unroll
        for (int i = 0; i < 2; i++)
#pragma unroll
          for (int j = 0; j < 2; j++)
#pragma unroll
            for (int gp = 0; gp < 2; gp++) {
              const int row = row0 + wn_ * 64 + j * 32 + r_;
              const int col = cb + wm_ * 64 + i * 32 + 8 * (2 * gp + hh_);
              uint2 oa, ob;
              oa.x = pack2(acc[i][j][8 * gp] * sc, acc[i][j][8 * gp + 1] * sc);
              oa.y = pack2(acc[i][j][8 * gp + 2] * sc, acc[i][j][8 * gp + 3] * sc);
              ob.x = pack2(acc[i][j][8 * gp + 4] * sc, acc[i][j][8 * gp + 5] * sc);
              ob.y = pack2(acc[i][j][8 * gp + 6] * sc, acc[i][j][8 * gp + 7] * sc);
              *(uint4*)(dst + (size_t)row * 512 + col) = pair_swap(oa, ob);
            }
      } else {
        gemm_core(acc, A + (size_t)rt * 128 * D, D, wsp<u16>(p, O_WP) + (size_t)ct * 128 * D, D, D, smem);
        u16* dst = wsp<u16>(p, O_VNAT);
        const int cb = (ct - 8) * 128;
#pragma unroll
        for (int i = 0; i < 2; i++)
#pragma unroll
          for (int j = 0; j < 2; j++)
#pragma unroll
            for (int gp = 0; gp < 2; gp++) {
              const int kk = kk0 + wm_ * 64 + i * 32 + 8 * (2 * gp + hh_);
              const int col = cb + wn_ * 64 + j * 32 + r_;
              uint2 oa, ob;
              oa.x = pack2(acc[i][j][8 * gp], acc[i][j][8 * gp + 1]);
              oa.y = pack2(acc[i][j][8 * gp + 2], acc[i][j][8 * gp + 3]);
              ob.x = pack2(acc[i][j][8 * gp + 4], acc[i][j][8 * gp + 5]);
              ob.y = pack2(acc[i][j][8 * gp + 6], acc[i][j][8 * gp + 7]);
              *(uint4*)(dst + ((size_t)(b * 512 + col)) * KPB + kk) = pair_swap(oa, ob);
            }
      }
    }
  PATCH_LOOP_END
  PATCH_LOOP_BEGIN(256, 8, 8, 8)
    f32x16 acc[2][2];
    zero_acc(acc);
    {
      const int rt = prt, ct = pct;
      const int b = rt >> 7, nlo = rt & 127;
      gemm_core(acc, A + (size_t)(b * KPB + CTXL + nlo) * D, (size_t)128 * D,
                wsp<u16>(p, O_WF) + (size_t)ct * 128 * D, D, D, smem);
      u16* dst = wsp<u16>(p, O_D1);
#pragma unroll
      for (int i = 0; i < 2; i++)
#pragma unroll
        for (int j = 0; j < 2; j++)
#pragma unroll
          for (int gp = 0; gp < 2; gp++) {
            const int nhi = wm_ * 64 + i * 32 + 8 * (2 * gp + hh_);
            const int n = ct * 128 + wn_ * 64 + j * 32 + r_;
            const int reim = n >> 9, jj = n & 511;
            uint2 oa, ob;
            oa.x = pack2(acc[i][j][8 * gp], acc[i][j][8 * gp + 1]);
            oa.y = pack2(acc[i][j][8 * gp + 2], acc[i][j][8 * gp + 3]);
            ob.x = pack2(acc[i][j][8 * gp + 4], acc[i][j][8 * gp + 5]);
            ob.y = pack2(acc[i][j][8 * gp + 6], acc[i][j][8 * gp + 7]);
            *(uint4*)(dst + ((((size_t)(b * 512 + jj)) * 128 + nlo) * 2 + reim) * 128 + nhi) = pair_swap(oa, ob);
          }
    }
  PATCH_LOOP_END
  if (!last) {
    for (int t2 = bid; t2 < 32; t2 += nb) {
      f32x16 acc[2][2];
      zero_acc(acc);
      const int rt = t2 >> 3, ct = t2 & 7;
      const int b = rt >> 1, rb = rt & 1;
      gemm_core(acc, A + (size_t)(b * KPB + rb * 128) * D, D, wsp<u16>(p, O_WF) + (size_t)ct * 128 * D, D, D, smem);
      u16* dst = wsp<u16>(p, O_D1C);
#pragma unroll
      for (int i = 0; i < 2; i++)
#pragma unroll
        for (int j = 0; j < 2; j++)
#pragma unroll
          for (int gp = 0; gp < 2; gp++) {
            const int nc = rb * 128 + wm_ * 64 + i * 32 + 8 * (2 * gp + hh_);
            const int n = ct * 128 + wn_ * 64 + j * 32 + r_;
            const int reim = n >> 9, jj = n & 511;
            uint2 oa, ob;
            oa.x = pack2(acc[i][j][8 * gp], acc[i][j][8 * gp + 1]);
            oa.y = pack2(acc[i][j][8 * gp + 2], acc[i][j][8 * gp + 3]);
            ob.x = pack2(acc[i][j][8 * gp + 4], acc[i][j][8 * gp + 5]);
            ob.y = pack2(acc[i][j][8 * gp + 6], acc[i][j][8 * gp + 7]);
            *(uint4*)(dst + (((size_t)(b * 512 + jj)) * 2 + reim) * 256 + nc) = pair_swap(oa, ob);
          }
    }
  }
}

__device__ __forceinline__ float inv_freq(int i) {
  switch (i) {
    case 0: return 1.0f;
    case 1: return 0.31622776601683794f;
    case 2: return 0.1f;
    case 3: return 0.03162277660168379f;
    case 4: return 0.01f;
    case 5: return 0.0031622776601683794f;
    case 6: return 0.001f;
    default: return 0.00031622776601683794f;
  }
}
__device__ __forceinline__ void rope_cs(int kk, int e, float& cs, float& sn) {
  if (kk < CTXL) { cs = 1.f; sn = 0.f; return; }
  const int tkn = kk - CTXL;
  const float pos = (e < 8) ? (float)(tkn >> 6) : (float)(tkn & 63);
  const float ang = pos * inv_freq(e & 7);
  double xr = (double)ang * 0.31830988618379067;
  xr -= 2.0 * floor(xr * 0.5);
  const float yr = (float)xr;
  cs = cospif(yr);
  sn = sinpif(yr);
}

__device__ __forceinline__ void row_rms(const u16* A, size_t lda, int K, float* rs) {
  const int tid = ltid();
  const int row = tid >> 1, half = tid & 1;
  const u16* pr = A + (size_t)row * lda + half * (K >> 1);
  float s = 0.f;
  for (int c = 0; c < (K >> 1); c += 8) {
    uint4 v = *(const uint4*)(pr + c);
    const uint32_t w[4] = {v.x, v.y, v.z, v.w};
#pragma unroll
    for (int q = 0; q < 4; q++) {
      const float a = __uint_as_float(w[q] << 16), bq = __uint_as_float(w[q] & 0xffff0000u);
      s += a * a + bq * bq;
    }
  }
  s += __shfl_xor(s, 1);
  if (half == 0) rs[row] = rsqrtf(s / (float)K + EPS);
  __syncthreads();
}

__device__ void phase_p2(const Params& p, int l, int bid, int nb, u16* smem) {
  EPI_DECL
  const u16* LAT = wsp<u16>(p, O_LAT);
  float* rs = (float*)(smem + 4 * SM_A);
  const int nQ = NRT * 6, nKV = NRT * 8, nFA = 1024 * 2, nKR = NRT;
  const int total = nQ + nKV + nFA + nKR;
  for (int t = bid; t < total; t += nb) {
    if (t < nQ) {
      const int rt = t / 6, ct = t - rt * 6;
      const int row0 = rt * 128, b = row0 / KPB, kk0 = row0 - b * KPB;
      row_rms(LAT + (size_t)row0 * 512, 512, 256, rs);
      f32x16 acc[2][2];
      zero_acc(acc);
      gemm_core(acc, wsp<u16>(p, O_WUQ) + (size_t)ct * 128 * 256, 256, LAT + (size_t)row0 * 512, 512, 256, smem);
      u16* QM = wsp<u16>(p, O_QM);
      if (ct < 4) {
#pragma unroll
        for (int i = 0; i < 2; i++)
#pragma unroll
          for (int j = 0; j < 2; j++)
#pragma unroll
            for (int gp = 0; gp < 2; gp++) {
              const int rl = wn_ * 64 + j * 32 + r_;
              const int col = ct * 128 + wm_ * 64 + i * 32 + 8 * (2 * gp + hh_);
              const int h = col >> 6, d = col & 63;
              const float sc = rs[rl] * MLA_SCALE_L2;
              uint2 oa, ob;
              oa.x = pack2(acc[i][j][8 * gp] * sc, acc[i][j][8 * gp + 1] * sc);
              oa.y = pack2(acc[i][j][8 * gp + 2] * sc, acc[i][j][8 * gp + 3] * sc);
              ob.x = pack2(acc[i][j][8 * gp + 4] * sc, acc[i][j][8 * gp + 5] * sc);
              ob.y = pack2(acc[i][j][8 * gp + 6] * sc, acc[i][j][8 * gp + 7] * sc);
              *(uint4*)(QM + (size_t)(row0 + rl) * 768 + h * 96 + d) = pair_swap(oa, ob);
            }
      } else {
        const int wt = (ct - 4) * 2 + wm_;
#pragma unroll
        for (int j = 0; j < 2; j++) {
          const int rl = wn_ * 64 + j * 32 + r_;
          const float sc = rs[rl] * MLA_SCALE_L2;
          uint2 p1[4], p2[4];
#pragma unroll
          for (int g = 0; g < 4; g++) {
            const int idx = wt * 32 + 8 * g + 4 * hh_;
            const int e16 = idx & 15;
            float o1[4], o2[4];
#pragma unroll
            for (int q = 0; q < 4; q++) {
              float cs, sn;
              rope_cs(kk0 + rl, e16 + q, cs, sn);
              const float x1 = acc[0][j][4 * g + q] * sc, x2 = acc[1][j][4 * g + q] * sc;
              o1[q] = x1 * cs - x2 * sn;
              o2[q] = x2 * cs + x1 * sn;
            }
            p1[g].x = pack2(o1[0], o1[1]);
            p1[g].y = pack2(o1[2], o1[3]);
            p2[g].x = pack2(o2[0], o2[1]);
            p2[g].y = pack2(o2[2], o2[3]);
          }
#pragma unroll
          for (int gp = 0; gp < 2; gp++) {
            u16* qd = QM + (size_t)(row0 + rl) * 768 + (2 * wt + gp) * 96 + 64 + 8 * hh_;
            *(uint4*)qd = pair_swap(p1[2 * gp], p1[2 * gp + 1]);
            *(uint4*)(qd + 16) = pair_swap(p2[2 * gp], p2[2 * gp + 1]);
          }
        }
      }
      __syncthreads();
    } else if (t < nQ + nKV) {
      const int t2 = t - nQ;
      const int rt = t2 >> 3, ct = t2 & 7;
      const int row0 = rt * 128, b = row0 / KPB, kk0 = row0 - b * KPB;
      row_rms(LAT + (size_t)row0 * 512 + 256, 512, 128, rs);
      f32x16 acc[2][2];
      zero_acc(acc);
      if (ct < 4) {
        gemm_core(acc, wsp<u16>(p, O_WUKV) + (size_t)ct * 128 * 128, 128, LAT + (size_t)row0 * 512 + 256, 512, 128,
                  smem);
        u16* KN = wsp<u16>(p, O_KN);
#pragma unroll
        for (int i = 0; i < 2; i++)
#pragma unroll
          for (int j = 0; j < 2; j++)
#pragma unroll
            for (int gp = 0; gp < 2; gp++) {
              const int rl = wn_ * 64 + j * 32 + r_;
              const int col = ct * 128 + wm_ * 64 + i * 32 + 8 * (2 * gp + hh_);
              const float sc = rs[rl];
              uint2 oa, ob;
              oa.x = pack2(acc[i][j][8 * gp] * sc, acc[i][j][8 * gp + 1] * sc);
              oa.y = pack2(acc[i][j][8 * gp + 2] * sc, acc[i][j][8 * gp + 3] * sc);
              ob.x = pack2(acc[i][j][8 * gp + 4] * sc, acc[i][j][8 * gp + 5] * sc);
              ob.y = pack2(acc[i][j][8 * gp + 6] * sc, acc[i][j][8 * gp + 7] * sc);
              *(uint4*)(KN + (size_t)(row0 + rl) * 512 + col) = pair_swap(oa, ob);
            }
      } else {
        gemm_core(acc, LAT + (size_t)row0 * 512 + 256, 512, wsp<u16>(p, O_WUKV) + (size_t)ct * 128 * 128, 128, 128,
                  smem);
        u16* VMT = wsp<u16>(p, O_VMT);
#pragma unroll
        for (int i = 0; i < 2; i++)
#pragma unroll
          for (int j = 0; j < 2; j++)
#pragma unroll
            for (int gp = 0; gp < 2; gp++) {
              const int ra = wm_ * 64 + i * 32 + 16 * gp + 4 * hh_;
              const int rb2 = ra + 8;
              const int rst = wm_ * 64 + i * 32 + 8 * (2 * gp + hh_);
              const int col = (ct - 4) * 128 + wn_ * 64 + j * 32 + r_;
              uint2 oa, ob;
              oa.x = pack2(acc[i][j][8 * gp] * rs[ra], acc[i][j][8 * gp + 1] * rs[ra + 1]);
              oa.y = pack2(acc[i][j][8 * gp + 2] * rs[ra + 2], acc[i][j][8 * gp + 3] * rs[ra + 3]);
              ob.x = pack2(acc[i][j][8 * gp + 4] * rs[rb2], acc[i][j][8 * gp + 5] * rs[rb2 + 1]);
              ob.y = pack2(acc[i][j][8 * gp + 6] * rs[rb2 + 2], acc[i][j][8 * gp + 7] * rs[rb2 + 3]);
              *(uint4*)(VMT + ((size_t)(b * 512 + col)) * KPB + kk0 + rst) = pair_swap(oa, ob);
            }
      }
      __syncthreads();
    } else if (t < nQ + nKV + nFA) {
      const int t2 = t - nQ - nKV;
      const int rt = t2 >> 1, ct = t2 & 1;
      const int b = rt >> 9, jj = rt & 511;
      f32x16 acc[2][2];
      zero_acc(acc);
      gemm_core(acc, wsp<u16>(p, O_D1) + (size_t)rt * 128 * 256, 256, wsp<u16>(p, O_MA) + (size_t)ct * 128 * 256, 256,
                256, smem);
      const float* TW = wsp<float>(p, O_TW);
      u16* D2 = wsp<u16>(p, O_D2);
      const int klo = ct * 64 + wn_ * 32 + r_;
#pragma unroll
      for (int i = 0; i < 2; i++)
      {
        uint2 pr[4], pi[4];
#pragma unroll
        for (int g = 0; g < 4; g++) {
          const int nlo = wm_ * 64 + i * 32 + 8 * g + 4 * hh_;
          float re[4], im[4];
#pragma unroll
          for (int q = 0; q < 4; q++) {
            const float2 tw = *(const float2*)(TW + ((size_t)klo * 128 + nlo + q) * 2);
            const float ar = acc[i][0][4 * g + q], ai = acc[i][1][4 * g + q];
            re[q] = ar * tw.x + ai * tw.y;
            im[q] = ai * tw.x - ar * tw.y;
          }
          pr[g].x = pack2(re[0], re[1]);
          pr[g].y = pack2(re[2], re[3]);
          pi[g].x = pack2(im[0], im[1]);
          pi[g].y = pack2(im[2], im[3]);
        }
#pragma unroll
        for (int gp = 0; gp < 2; gp++) {
          u16* d = D2 + ((((size_t)(b * 128 + klo)) * 512 + jj) * 2) * 128 + wm_ * 64 + i * 32 + 8 * (2 * gp + hh_);
          *(uint4*)d = pair_swap(pr[2 * gp], pr[2 * gp + 1]);
          *(uint4*)(d + 128) = pair_swap(pi[2 * gp], pi[2 * gp + 1]);
        }
      }
    } else {
      const int rt = t - nQ - nKV - nFA;
      u16* KRR = wsp<u16>(p, O_KRR);
      for (int idx = ltid(); idx < 128 * 16; idx += 256) {
        const int rl = idx >> 4, e16 = idx & 15;
        const int row = rt * 128 + rl, b = row / KPB, kk = row - b * KPB;
        const float x1 = bf2f(LAT[(size_t)row * 512 + 384 + e16]), x2 = bf2f(LAT[(size_t)row * 512 + 400 + e16]);
        float cs, sn;
        rope_cs(kk, e16, cs, sn);
        KRR[(size_t)row * 32 + e16] = f2bf(x1 * cs - x2 * sn);
        KRR[(size_t)row * 32 + 16 + e16] = f2bf(x2 * cs + x1 * sn);
      }
    }
  }
}

template <int MODE>
__device__ void attn_item(const Params& p, int l, int b, int h, int q0  ,
                          int ntiles  , int rs0, int ycol, u16* smem) {
  constexpr int DQK = MODE == 0 ? 96 : 64;
  constexpr int KSTR = DQK + 8;
  constexpr int NKS = DQK / 16;
  constexpr int CPR = DQK / 8;
  constexpr int NKC = 64 * CPR / 256;
  const int tid = ltid(), lane = tid & 63, wave = tid >> 6, r = lane & 31, hh = lane >> 5;
  u16* Ks = smem;
  u16* Vs = smem + 2 * 64 * KSTR;
  const unsigned char* wsb = p.ws;
  const int qk = q0 + wave * 32 + r;
  const size_t qrow = (size_t)b * KPB + qk;
  bf16x8 qf[NKS];
  {
    const u16* qp = MODE == 0 ? wsp<u16>(p, O_QM) + qrow * 768 + h * 96 : wsp<u16>(p, O_QNA) + qrow * 512 + h * 64;
#pragma unroll
    for (int ks = 0; ks < NKS; ks++) qf[ks] = *(const bf16x8*)(qp + ks * 16 + hh * 8);
  }
  const short one_or_zero = hh == 0 ? (short)0x3F80 : (short)0;
  const bf16x8 kone = {one_or_zero, 0, 0, 0, 0, 0, 0, 0};
  bf16x8 qm = {0, 0, 0, 0, 0, 0, 0, 0};
  int qr = 0, qc = 0, rsq = 0, cs = 0;
  const float* rpb = nullptr;
  if (MODE == 1 && rs0 >= 0) {
    const int tkn = qk - CTXL;
    qr = tkn >> 6;
    qc = tkn & 63;
    rsq = min(max(qr - 4, 0), 248);
    cs = min(max(qc - 8, 0), 48);
    rpb = p.rpb + ((size_t)(l * 8 + h)) * 15 * 31;
  }
  f32x16 o[2];
#pragma unroll
  for (int e = 0; e < 16; e++) { o[0][e] = 0.f; o[1][e] = 0.f; }
  float lsum = 0.f;
  float m = 0.f;
  const bf16x8 ones = {(short)0x3F80, (short)0x3F80, (short)0x3F80, (short)0x3F80,
                       (short)0x3F80, (short)0x3F80, (short)0x3F80, (short)0x3F80};

#define KGEO(i)                                                                                          \
  uint32_t kof##i, kmu##i;                                                                               \
  int kls##i;                                                                                            \
  {                                                                                                      \
    const int c = tid + 256 * (i);                                                                       \
    const int row = c / CPR, cc = c - row * CPR;                                                         \
    if (MODE == 0 && cc >= 8) {                                                                          \
      kof##i = (uint32_t)(O_KRR + ((size_t)(b * KPB + row) * 32 + (cc - 8) * 8) * 2);                    \
      kmu##i = 64u;                                                                                      \
    } else {                                                                                             \
      kof##i = (uint32_t)((MODE == 0 ? O_KN : O_KNA) + ((size_t)(b * KPB + row) * 512 + h * 64 + cc * 8) * 2); \
      kmu##i = 1024u;                                                                                    \
    }                                                                                                    \
    kls##i = row * KSTR + cc * 8;                                                                        \
  }
#define VGEO(i)                                                                                          \
  uint32_t vof##i;                                                                                       \
  int vls##i;                                                                                            \
  bool vsx##i;                                                                                           \
  {                                                                                                      \
    const int c = tid + 256 * (i);                                                                       \
    const int d = c >> 3, cc = c & 7;                                                                    \
    vof##i = (uint32_t)((MODE == 0 ? O_VMT : O_VNAT) + ((size_t)(b * 512 + h * 64 + d) * KPB + cc * 8) * 2); \
    vls##i = d * 72 + cc * 8;                                                                            \
    vsx##i = (d & 8) != 0;                                                                               \
  }
  KGEO(0) KGEO(1) KGEO(2) VGEO(0) VGEO(1)
  (void)kof2; (void)kmu2; (void)kls2;
  u32x4 kr0A, kr1A, kr2A, vr0A, vr1A, kr0B, kr1B, kr2B, vr0B, vr1B;
  kr2A = kr1A = kr0A = vr0A = vr1A = kr2B = kr1B = kr0B = vr0B = vr1B = (u32x4){0u, 0u, 0u, 0u};
#define TILE_KK0(t) ((MODE == 1 && (t) >= 4) ? (uint32_t)(CTXL + 64 * min(rs0 + (t)-4, 255)) : (uint32_t)(64 * (t)))
#define LOAD_KV(t, S)                                                                   \
  {                                                                                     \
    const uint32_t kk0_ = TILE_KK0(t);                                                  \
    kr0##S = *(const u32x4*)(wsb + (size_t)(kof0 + kk0_ * kmu0));                       \
    kr1##S = *(const u32x4*)(wsb + (size_t)(kof1 + kk0_ * kmu1));                       \
    if (NKC == 3) kr2##S = *(const u32x4*)(wsb + (size_t)(kof2 + kk0_ * kmu2));         \
    vr0##S = *(const u32x4*)(wsb + (size_t)(vof0 + kk0_ * 2u));                         \
    vr1##S = *(const u32x4*)(wsb + (size_t)(vof1 + kk0_ * 2u));                         \
  }
#define STORE_V1(buf, i, srcv)                                                          \
  {                                                                                     \
    u32x4 sv_ = srcv;                                                                   \
    if (vsx##i) sv_ = (u32x4){sv_[2], sv_[3], sv_[0], sv_[1]};                          \
    *(u32x4*)(Vs + (buf)*64 * 72 + vls##i) = sv_;                                       \
  }
#define STORE_KV(buf, S)                                                                \
  {                                                                                     \
    *(u32x4*)(Ks + (buf)*64 * KSTR + kls0) = kr0##S;                                    \
    *(u32x4*)(Ks + (buf)*64 * KSTR + kls1) = kr1##S;                                    \
    if (NKC == 3) *(u32x4*)(Ks + (buf)*64 * KSTR + kls2) = kr2##S;                      \
    STORE_V1(buf, 0, vr0##S) STORE_V1(buf, 1, vr1##S)                                   \
  }
#define QK_TILE(kbuf, t)                                                                           \
  {                                                                                                \
    const u16* kb_ = Ks + (kbuf)*64 * KSTR + r * KSTR + hh * 8;                                    \
    {                                                                                              \
      f32x16 z_;                                                                                   \
      _Pragma("unroll") for (int e = 0; e < 16; e++) z_[e] = 0.f;                                  \
      sc[0] = __builtin_amdgcn_mfma_f32_32x32x16_bf16(kone, qm, z_, 0, 0, 0);                      \
      sc[1] = sc[0];                                                                               \
    }                                                                                              \
    _Pragma("unroll") for (int ks = 0; ks < NKS; ks++) {                                           \
      const bf16x8 kf0 = *(const bf16x8*)(kb_ + ks * 16);                                          \
      const bf16x8 kf1 = *(const bf16x8*)(kb_ + 32 * KSTR + ks * 16);                              \
      sc[0] = __builtin_amdgcn_mfma_f32_32x32x16_bf16(kf0, qf[ks], sc[0], 0, 0, 0);                \
      sc[1] = __builtin_amdgcn_mfma_f32_32x32x16_bf16(kf1, qf[ks], sc[1], 0, 0, 0);                \
    }                                                                                              \
    if (MODE == 1 && (t) >= 4) {                                                                   \
      const int kr_ = rs0 + (t)-4;                                                                 \
      const bool rowok = (kr_ >= rsq) && (kr_ < rsq + 8);                                          \
      const float* rp = rpb + (kr_ - qr + 7) * 31 + (15 - qc);                                     \
      _Pragma("unroll") for (int kb = 0; kb < 2; kb++) _Pragma("unroll") for (int e = 0; e < 16; e++) { \
        const int kc = kb * 32 + (e & 3) + 8 * (e >> 2) + 4 * hh;                                  \
        const bool valid = rowok && (kc >= cs) && (kc < cs + 16);                                  \
        float bias = 0.f;                                                                          \
        if (valid) bias = rp[kc];                                                                  \
        sc[kb][e] = valid ? sc[kb][e] + bias * LOG2E : -1e30f;                                     \
      }                                                                                            \
    }                                                                                              \
  }
#define TILE_MAX(tmax)                                                                             \
  {                                                                                                \
    tmax = sc[0][0];                                                                               \
    _Pragma("unroll") for (int e = 1; e < 16; e++) tmax = fmaxf(tmax, sc[0][e]);                   \
    _Pragma("unroll") for (int e = 0; e < 16; e++) tmax = fmaxf(tmax, sc[1][e]);                   \
    const uint32_t tu = __float_as_uint(tmax);                                                     \
    const auto sw = __builtin_amdgcn_permlane32_swap(tu, tu, false, false);                        \
    tmax = fmaxf(__uint_as_float(sw[0]), __uint_as_float(sw[1]));                                  \
  }
#define MOVE_REF(mnew_)                                                                            \
  {                                                                                                \
    const float mq_ = bf2f(f2bf(mnew_));                                                           \
    const float delta_ = mq_ - m;                                                                  \
    const float alpha = __builtin_amdgcn_exp2f(-delta_);                                           \
    m = mq_;                                                                                       \
    _Pragma("unroll") for (int e = 0; e < 16; e++) {                                               \
      o[0][e] *= alpha; o[1][e] *= alpha;                                                         \
      sc[0][e] -= delta_; sc[1][e] -= delta_;                                                      \
    }                                                                                              \
    lsum *= alpha;                                                                                 \
    qm[0] = (hh == 0) ? (short)f2bf(-m) : (short)0;                                                \
  }
#define SOFTMAX_PV(vbuf)                                                                           \
  {                                                                                                \
    const u16* vb_ = Vs + (vbuf)*64 * 72 + r * 72 + vsw;                                           \
    _Pragma("unroll") for (int kb = 0; kb < 2; kb++) _Pragma("unroll") for (int st = 0; st < 2; st++) { \
      u32x4 pu;                                                                                    \
      _Pragma("unroll") for (int q = 0; q < 4; q++) {                                              \
        const float p0_ = __builtin_amdgcn_exp2f(sc[kb][8 * st + 2 * q]);                          \
        const float p1_ = __builtin_amdgcn_exp2f(sc[kb][8 * st + 2 * q + 1]);                      \
        lsum += p0_ + p1_;                                                                         \
        pu[q] = pack2(p0_, p1_);                                                                   \
      }                                                                                            \
      const bf16x8 pbv = __builtin_bit_cast(bf16x8, pu);                                           \
      _Pragma("unroll") for (int db = 0; db < 2; db++) {                                           \
        const u16* vp = vb_ + db * 32 * 72 + kb * 32 + 16 * st;                                    \
        const bf16x4 vlo = *(const bf16x4*)(vp);                                                   \
        const bf16x4 vhi = *(const bf16x4*)(vp + 8);                                               \
        const bf16x8 vfv = __builtin_shufflevector(vlo, vhi, 0, 1, 2, 3, 4, 5, 6, 7);              \
        o[db] = __builtin_amdgcn_mfma_f32_32x32x16_bf16(vfv, pbv, o[db], 0, 0, 0);                 \
      }                                                                                            \
    }                                                                                              \
  }
#define DEFER_REF(tmax)                                                                            \
  if (__any(tmax > 8.f)) {                                                                         \
    const float mq_ = bf2f(f2bf(m + fmaxf(tmax, 0.f)));                                            \
    const float alpha = __builtin_amdgcn_exp2f(m - mq_);                                           \
    m = mq_;                                                                                       \
    _Pragma("unroll") for (int e = 0; e < 16; e++) { o[0][e] *= alpha; o[1][e] *= alpha; }       \
    lsum *= alpha;                                                                                 \
    qm[0] = (hh == 0) ? (short)f2bf(-m) : (short)0;                                                \
  }
#define ATT_STEP(t, LD, ST)                                        \
  {                                                                \
    const int cur = (t)&1;                                         \
    QK_TILE(cur, t)                                                \
    __builtin_amdgcn_sched_barrier(0);                             \
    LOAD_KV(min((t) + 2, tl), LD)                                  \
    __builtin_amdgcn_sched_barrier(0);                             \
    __builtin_amdgcn_s_setprio(1);                                 \
    SOFTMAX_PV(cur)                                                \
    __builtin_amdgcn_s_setprio(0);                                 \
    float tmax;                                                    \
    TILE_MAX(tmax)                                                 \
    DEFER_REF(tmax)                                                \
    STORE_KV(cur ^ 1, ST)                                          \
    __syncthreads();                                               \
  }

  const int tl = ntiles - 1;
  const int vsw = 4 * (hh ^ ((r >> 3) & 1));
  f32x16 sc[2];
  LOAD_KV(0, A)
  STORE_KV(0, A)
  LOAD_KV(min(1, tl), A)
  __syncthreads();
  {
    LOAD_KV(min(2, tl), B)
    __builtin_amdgcn_sched_barrier(0);
    QK_TILE(0, 0)
    float tmax;
    TILE_MAX(tmax)
    MOVE_REF(tmax)
    SOFTMAX_PV(0)
    STORE_KV(1, A)
    __syncthreads();
  }
  for (int t = 1; t + 1 < ntiles; t += 2) {
    ATT_STEP(t, A, B)
    ATT_STEP(t + 1, B, A)
  }
  ATT_STEP(tl, A, B)
  const float inv = 1.f / (lsum + __shfl_xor(lsum, 32));
  u16* yp = wsp<u16>(p, O_Y) + qrow * 1536 + ycol + h * 64;
#pragma unroll
  for (int db = 0; db < 2; db++)
#pragma unroll
    for (int gp = 0; gp < 2; gp++) {
      uint2 oa, ob;
      oa.x = pack2(o[db][8 * gp] * inv, o[db][8 * gp + 1] * inv);
      oa.y = pack2(o[db][8 * gp + 2] * inv, o[db][8 * gp + 3] * inv);
      ob.x = pack2(o[db][8 * gp + 4] * inv, o[db][8 * gp + 5] * inv);
      ob.y = pack2(o[db][8 * gp + 6] * inv, o[db][8 * gp + 7] * inv);
      *(uint4*)(yp + db * 32 + 8 * (2 * gp + hh)) = pair_swap(oa, ob);
    }
#undef KGEO
#undef VGEO
#undef TILE_KK0
#undef LOAD_KV
#undef STORE_V1
#undef STORE_KV
#undef QK_TILE
#undef TILE_MAX
#undef MOVE_REF
#undef SOFTMAX_PV
#undef ATT_STEP
#undef DEFER_REF
}

__device__ void phase_p3(const Params& p, int l, bool last, int bid, int nb, u16* smem) {
  EPI_DECL
  const int nMLA = 2048, nNA = 2048, nFB = 1024;
  const int nC = last ? 0 : (32 + 32 + 16);
  const int total = nMLA + nNA + nFB + nC;
  for (int t = bid; t < total; t += nb) {
    int kind, b = 0, h = 0, q0 = 0, ntl = 0, rs0 = -1;
    size_t aoff = 0, boff = 0;
    int Kf = 256, j0 = 0, tok0 = 0, tokmul = 1, colbase = 0;
    if (t < nMLA) {
      kind = 0;
      h = t & 7;
      const int rest = t >> 3;
      b = rest >> 7;
      q0 = CTXL + (rest & 127) * 128;
      ntl = 260;
    } else if (t < nMLA + nNA) {
      kind = 1;
      const int t2 = t - nMLA;
      h = t2 & 7;
      const int rest = t2 >> 3, rp = rest & 127;
      b = rest >> 7;
      rs0 = min(max(2 * rp - 4, 0), 248);
      const int rs1 = min(max(2 * rp + 1 - 4, 0), 248);
      q0 = CTXL + rp * 128;
      ntl = (4 + (rs1 + 8 - rs0) + 1) & ~1;
    } else if (t < nMLA + nNA + nFB) {
      kind = 2;
      const int rt = t - nMLA - nNA;
      const int bk = rt >> 2;
      j0 = (rt & 3) * 128;
      b = bk >> 7;
      tok0 = CTXL + (bk & 127);
      tokmul = 128;
      aoff = O_D2 + (size_t)rt * 128 * 256 * 2;
      boff = O_MB;
      Kf = 256;
    } else {
      const int t2 = t - nMLA - nNA - nFB;
      if (t2 < 64) {
        kind = t2 >> 5;
        const int t3 = t2 & 31;
        h = t3 & 7;
        b = (t3 >> 3) & 1;
        q0 = (t3 >> 4) * 128;
        ntl = 4;
      } else {
        kind = 2;
        const int t3 = t2 - 64;
        const int rt = t3 >> 1, ct = t3 & 1;
        b = rt >> 2;
        j0 = (rt & 3) * 128;
        colbase = ct * 128;
        aoff = O_D1C + (size_t)rt * 128 * 512 * 2;
        boff = O_MC + (size_t)ct * 128 * 512 * 2;
        Kf = 512;
      }
    }
    if (kind == 0) {
      attn_item<0>(p, l, b, h, q0, ntl, -1, 1024, smem);
    } else if (kind == 1) {
      attn_item<1>(p, l, b, h, q0, ntl, rs0, 512, smem);
    } else {
      f32x16 acc[2][2];
      zero_acc(acc);
      gemm_core(acc, wsp<u16>(p, aoff), Kf, wsp<u16>(p, boff), Kf, Kf, smem);
      u16* Y = wsp<u16>(p, O_Y);
#pragma unroll
      for (int i = 0; i < 2; i++)
#pragma unroll
        for (int j = 0; j < 2; j++)
#pragma unroll
          for (int gp = 0; gp < 2; gp++) {
            const int jj = j0 + wm_ * 64 + i * 32 + 8 * (2 * gp + hh_);
            const int tok = tok0 + (colbase + wn_ * 64 + j * 32 + r_) * tokmul;
            uint2 oa, ob;
            oa.x = pack2(acc[i][j][8 * gp], acc[i][j][8 * gp + 1]);
            oa.y = pack2(acc[i][j][8 * gp + 2], acc[i][j][8 * gp + 3]);
            ob.x = pack2(acc[i][j][8 * gp + 4], acc[i][j][8 * gp + 5]);
            ob.y = pack2(acc[i][j][8 * gp + 6], acc[i][j][8 * gp + 7]);
            *(uint4*)(Y + ((size_t)b * KPB + tok) * 1536 + jj) = pair_swap(oa, ob);
          }
    }
  }
}

__device__ __forceinline__ int n_row_tiles(bool last) { return last ? NRT - 4 : NRT; }
__device__ __forceinline__ int row_tile(bool last, int i) {
  if (!last) return i;
  return i < 128 ? i + 2 : i + 4;
}

__device__ void phase_p4(const Params& p, int l, bool last, int bid, int nb, u16* smem) {
  EPI_DECL
  const u16* A = wsp<u16>(p, O_A);
  const u16* Y = wsp<u16>(p, O_Y);
  u16* M = wsp<u16>(p, O_M);
  uint4* stash = wsp<uint4>(p, O_QM) + (size_t)bid * 24 * 256 + ltid();
  const int nrt_ = n_row_tiles(last);
  PATCH_LOOP_BEGIN(nrt_, 8, 8, 8)
    const int rt = row_tile(last, prt), ct = pct;
    f32x16 mg[2][2];
    zero_acc(mg);
#pragma unroll 1
    for (int g = 0; g < 3; g++) {
      uint32_t gp[2][2][8];
      {
        f32x16 acc[2][2];
        zero_acc(acc);
        gemm_core<true>(acc, wsp<u16>(p, O_WG) + (size_t)(g * 1024 + ct * 128) * D, D, A + (size_t)rt * 128 * D, D, D,
                        smem);
#pragma unroll
        for (int i = 0; i < 2; i++)
#pragma unroll
          for (int j = 0; j < 2; j++)
#pragma unroll
            for (int e = 0; e < 8; e++)
              gp[i][j][e] = pack2(fsigmoid(acc[i][j][2 * e]), fsigmoid(acc[i][j][2 * e + 1]));
      }
      {
        f32x16 acc[2][2];
        zero_acc(acc);
        gemm_core<false>(acc, wsp<u16>(p, O_WB) + (size_t)(g * 1024 + ct * 128) * 512, 512,
                         Y + (size_t)rt * 128 * 1536 + g * 512, 1536, 512, smem);
#pragma unroll
        for (int i = 0; i < 2; i++)
#pragma unroll
          for (int j = 0; j < 2; j++)
#pragma unroll
            for (int e = 0; e < 8; e++) {
              mg[i][j][2 * e] += __uint_as_float(gp[i][j][e] << 16) * acc[i][j][2 * e];
              mg[i][j][2 * e + 1] += __uint_as_float(gp[i][j][e] & 0xffff0000u) * acc[i][j][2 * e + 1];
            }
      }
    }
#pragma unroll
    for (int i = 0; i < 2; i++)
#pragma unroll
      for (int j = 0; j < 2; j++)
#pragma unroll
        for (int gp = 0; gp < 2; gp++) {
          const int row = rt * 128 + wn_ * 64 + j * 32 + r_;
          const int col = ct * 128 + wm_ * 64 + i * 32 + 8 * (2 * gp + hh_);
          uint2 oa, ob;
          oa.x = pack2(mg[i][j][8 * gp], mg[i][j][8 * gp + 1]);
          oa.y = pack2(mg[i][j][8 * gp + 2], mg[i][j][8 * gp + 3]);
          ob.x = pack2(mg[i][j][8 * gp + 4], mg[i][j][8 * gp + 5]);
          ob.y = pack2(mg[i][j][8 * gp + 6], mg[i][j][8 * gp + 7]);
          *(uint4*)(M + (size_t)row * D + col) = pair_swap(oa, ob);
        }
  PATCH_LOOP_END
}

__device__ void phase_resid(const Params& p, int l, bool last, const u16* Ain, size_t lda, const u16* W, int K,
                            int bid, int nb, u16* smem) {
  EPI_DECL
  const int nrt_ = n_row_tiles(last);
  PATCH_LOOP_BEGIN(nrt_, 8, 8, 8)
    const int rt = row_tile(last, prt), ct = pct;
    f32x16 acc[2][2];
    zero_acc(acc);
    gemm_core(acc, W + (size_t)ct * 128 * K, K, Ain + (size_t)rt * 128 * lda, lda, K, smem);
    u16* FB = wsp<u16>(p, O_FB);
#pragma unroll
    for (int i = 0; i < 2; i++)
#pragma unroll
      for (int j = 0; j < 2; j++)
#pragma unroll
        for (int gp = 0; gp < 2; gp++) {
          const int row = rt * 128 + wn_ * 64 + j * 32 + r_;
          const int col = ct * 128 + wm_ * 64 + i * 32 + 8 * (2 * gp + hh_);
          uint2 oa, ob;
          oa.x = pack2(acc[i][j][8 * gp], acc[i][j][8 * gp + 1]);
          oa.y = pack2(acc[i][j][8 * gp + 2], acc[i][j][8 * gp + 3]);
          ob.x = pack2(acc[i][j][8 * gp + 4], acc[i][j][8 * gp + 5]);
          ob.y = pack2(acc[i][j][8 * gp + 6], acc[i][j][8 * gp + 7]);
          *(uint4*)(FB + (size_t)row * D + col) = pair_swap(oa, ob);
        }
  PATCH_LOOP_END
}

__device__ void phase_p7(const Params& p, int l, bool last, int bid, int nb, u16* smem) {
  EPI_DECL
  const u16* A = wsp<u16>(p, O_A);
  u16* HH = wsp<u16>(p, O_HH);
  const int nrt_ = n_row_tiles(last);
  PATCH_LOOP_BEGIN(nrt_, 44, 16, 4)
    const int rt = row_tile(last, prt), ct = pct;
    f32x16 acc[2][2];
    zero_acc(acc);
    gemm_core(acc, wsp<u16>(p, O_WGU) + (size_t)ct * 128 * D, D, A + (size_t)rt * 128 * D, D, D, smem);
#pragma unroll
    for (int j = 0; j < 2; j++)
#pragma unroll
      for (int gp = 0; gp < 2; gp++) {
        const int row = rt * 128 + wn_ * 64 + j * 32 + r_;
        const int q = (ct * 2 + wm_) * 32 + 8 * (2 * gp + hh_);
        float hv[8];
#pragma unroll
        for (int t = 0; t < 8; t++) {
          const float gt = acc[0][j][8 * gp + t], up = acc[1][j][8 * gp + t];
          hv[t] = gt * fsigmoid(gt) * up;
        }
        uint2 oa, ob;
        oa.x = pack2(hv[0], hv[1]);
        oa.y = pack2(hv[2], hv[3]);
        ob.x = pack2(hv[4], hv[5]);
        ob.y = pack2(hv[6], hv[7]);
        *(uint4*)(HH + (size_t)row * FH + q) = pair_swap(oa, ob);
      }
  PATCH_LOOP_END
}

constexpr int NPHASE = 3 + 9 * 2;

__device__ void run_phase(const Params& p, int ph, int bid, int nb, u16* smem) {
  if (ph == 0) {
    prep_tables(p, bid, nb);
    prep_modp(p, bid, nb);
    prep_weights(p, 0, bid, nb, smem);
    return;
  }
  if (ph == 1) { prep_modr(p, bid, nb); return; }
  if (ph == 2) { ln_phase(p, 0, p.ln_in_g, p.ln_in_b, 0, 0, 1024, false, bid, nb); return; }
  const int l = (ph - 3) / 9, s = (ph - 3) % 9;
  const bool last = (l == 1);
  switch (s) {
    case 0: phase_p1(p, l, last, bid, nb, smem); break;
    case 1: phase_p2(p, l, bid, nb, smem); break;
    case 2: phase_p3(p, l, last, bid, nb, smem); break;
    case 3: phase_p4(p, l, last, bid, nb, smem); break;
    case 4: phase_resid(p, l, last, wsp<u16>(p, O_M), D, wsp<u16>(p, O_WO), D, bid, nb, smem); break;
    case 5: ln_phase(p, 1, p.ln1_g + l * D, p.ln1_b + l * D, l, 3072, 4096, last, bid, nb, l, 2048); break;
    case 6: phase_p7(p, l, last, bid, nb, smem); break;
    case 7: phase_resid(p, l, last, wsp<u16>(p, O_HH), FH, wsp<u16>(p, O_WD), FH, bid, nb, smem); break;
    default:
      ln_phase(p, 1, p.ln2_g + l * D, p.ln2_b + l * D, last ? -1 : l + 1, 0, 1024, last, bid, nb, l, 5120);
      if (!last) prep_weights(p, l + 1, bid, nb, smem);
      break;
  }
}


#define XB_TMO      128
#define XB_XCNT(j)  (256  + 64 * (j))
#define XB_XSUB(j)  (1280 + 64 * (j))
#define XB_XGEN(j)  (2304 + 64 * (j))
#define XB_TOP      3328
#define XB_TOPGEN   3392
#define XCD_BAR_WORDS 3456
#define XB_SPIN_CAP (1u << 20)
#define LAS __attribute__((address_space(3)))
__device__ __forceinline__ unsigned xb_ld(unsigned* p) { return __hip_atomic_load(p, __ATOMIC_RELAXED, __HIP_MEMORY_SCOPE_AGENT); }
__device__ __forceinline__ unsigned xb_add(unsigned* p, unsigned v) { return __hip_atomic_fetch_add(p, v, __ATOMIC_RELAXED, __HIP_MEMORY_SCOPE_AGENT); }
__device__ __forceinline__ unsigned xb_xcc_id() { return (unsigned)__builtin_amdgcn_s_getreg((3 << 11) | 20) & 0xFu; }
#define XB_SPIN(cond, bar) do { unsigned _sp = 0; while (cond) { __builtin_amdgcn_s_sleep(1); \
    if ((++_sp & 255u) == 0u) { if (xb_ld(&(bar)[XB_TMO])) break; if (_sp > XB_SPIN_CAP) { atomicAdd(&(bar)[XB_TMO], 1u); break; } } } } while (0)
struct XcdBarrier {
  unsigned* bar; unsigned x;
  volatile LAS unsigned* st;
};
__device__ __forceinline__ XcdBarrier xcd_barrier_post(unsigned* bar, volatile LAS unsigned* st) {
  XcdBarrier b; b.bar = bar; b.x = xb_xcc_id(); b.st = st;
  if (threadIdx.x == 0) (void)xb_add(&bar[XB_XCNT(b.x)], 1u);
  return b;
}
__device__ __forceinline__ void xcd_barrier_complete(unsigned* bar, unsigned x, unsigned& nloc, unsigned& nx) {
  const unsigned G = gridDim.x * gridDim.y * gridDim.z;
  unsigned sum, cnt, mine, sp = 0u;
  for (;;) {
    sum = 0u; cnt = 0u; mine = 0u;
#pragma unroll
    for (unsigned j = 0; j < 16; ++j) { const unsigned c = xb_ld(&bar[XB_XCNT(j)]); sum += c; cnt += (c > 0u) ? 1u : 0u; mine = (j == x) ? c : mine; }
    if (sum == G) break;
    __builtin_amdgcn_s_sleep(1);
    if ((++sp & 255u) == 0u) { if (xb_ld(&bar[XB_TMO])) break; if (sp > XB_SPIN_CAP) { atomicAdd(&bar[XB_TMO], 1u); break; } }
  }
  nloc = mine > 0u ? mine : 1u; nx = cnt > 0u ? cnt : 1u;
}
__device__ __forceinline__ void xcd_barrier(const XcdBarrier& b) {
  asm volatile("s_waitcnt vmcnt(0)" ::: "memory");
  __syncthreads();
  if (threadIdx.x == 0) {
    unsigned* bar = b.bar;
    __builtin_amdgcn_s_waitcnt(0);
    unsigned nloc = b.st[0], nx = b.st[1];
    if (nloc == 0u) { xcd_barrier_complete(bar, b.x, nloc, nx); b.st[0] = nloc; b.st[1] = nx; }
    const unsigned old = xb_add(&bar[XB_XSUB(b.x)], 1u);
    const unsigned gen = old / nloc;
    if (old + 1u == (gen + 1u) * nloc) {
      __builtin_amdgcn_fence(__ATOMIC_RELEASE, "agent");
      asm volatile("s_waitcnt vmcnt(0)" ::: "memory");
      const unsigned og = xb_add(&bar[XB_TOP], 1u);
      const unsigned tg = og / nx;
      if (og + 1u == (tg + 1u) * nx) xb_add(&bar[XB_TOPGEN], 1u);
      else XB_SPIN(xb_ld(&bar[XB_TOPGEN]) == tg, bar);
      __builtin_amdgcn_fence(__ATOMIC_ACQUIRE, "agent");
      xb_add(&bar[XB_XGEN(b.x)], 1u);
      asm volatile("s_waitcnt vmcnt(0)" ::: "memory");
    } else {
      XB_SPIN(xb_ld(&bar[XB_XGEN(b.x)]) == gen, bar);
      __builtin_amdgcn_fence(__ATOMIC_ACQUIRE, "agent");
      asm volatile("s_waitcnt vmcnt(0)" ::: "memory");
    }
  }
  __syncthreads();
}

constexpr int SMEM_ELEMS = 4 * SM_A + 256 + 8;

#if COOP
__global__ void __launch_bounds__(256, 2) mega_kernel(Params p) {
  __shared__ __attribute__((aligned(16))) u16 smem[SMEM_ELEMS];
  cg::grid_group grid = cg::this_grid();
  volatile LAS unsigned* st = (volatile LAS unsigned*)(smem + 4 * SM_A + 256);
  if (threadIdx.x == 0) { st[0] = 0u; st[1] = 0u; }
  __syncthreads();
  XcdBarrier xb = xcd_barrier_post((unsigned*)(p.ws + O_BAR), st);
  for (int ph = 0; ph < NPHASE; ph++) {
#ifdef PROBE_MASK
    const int s9 = ph >= 3 ? (ph - 3) % 9 : -1;
    const int nrep = (s9 >= 0 && ((PROBE_MASK >> s9) & 1)) ? 2 : 1;
    for (int rep = 0; rep < nrep; rep++) {
      run_phase(p, ph, blockIdx.x, gridDim.x, smem);
      if (ph == 0) grid.sync();
      else if (ph + 1 < NPHASE || rep + 1 < nrep) xcd_barrier(xb);
    }
#else
    run_phase(p, ph, blockIdx.x, gridDim.x, smem);
    if (ph == 0) grid.sync();
    else if (ph + 1 < NPHASE) xcd_barrier(xb);
#endif
  }
}
#else
__global__ void __launch_bounds__(256, 2) phase_kernel(Params p, int ph) {
  __shared__ __attribute__((aligned(16))) u16 smem[SMEM_ELEMS];
  run_phase(p, ph, blockIdx.x, gridDim.x, smem);
}
#endif

extern "C" void kernel_launch(void* const* d_in, const int* in_sizes, int n_in, void* d_out, int out_size, void* d_ws,
                              size_t ws_size, hipStream_t stream) {
  Params p{};
  const float** f = (const float**)&p;
  for (int i = 0; i < 25; i++) f[i] = (const float*)d_in[i];
  p.out = (float*)d_out;
  p.ws = (unsigned char*)d_ws;
  if (ws_size < O_WSEND) fprintf(stderr, "workspace too small: %zu < %zu\n", ws_size, (size_t)O_WSEND);
#if COOP
  static int grid_blocks = 0;
  if (!grid_blocks) {
    int dev = 0, cus = 0, per_cu = 0;
    hipGetDevice(&dev);
    hipDeviceGetAttribute(&cus, hipDeviceAttributeMultiprocessorCount, dev);
    hipOccupancyMaxActiveBlocksPerMultiprocessor(&per_cu, mega_kernel, 256, 0);
    if (per_cu > 2) per_cu = 2;
    grid_blocks = cus * per_cu;
  }
  (void)hipMemsetAsync(p.ws + O_BAR, 0, 3456 * 4, stream);
  void* args[] = {&p};
  hipError_t e = hipLaunchCooperativeKernel((void*)mega_kernel, dim3(grid_blocks), dim3(256), args, 0, stream);
  if (e != hipSuccess) fprintf(stderr, "cooperative launch failed: %s (grid %d)\n", hipGetErrorString(e), grid_blocks);
#else
  for (int ph = 0; ph < NPHASE; ph++) phase_kernel<<<512, 256, 0, stream>>>(p, ph);
#endif
}
```

```cpp
#include <hip/hip_runtime.h>
#include <hip/hip_cooperative_groups.h>
#include <stdint.h>
#include <cstdio>
namespace cg = cooperative_groups;

#ifndef COOP
#define COOP 1
#endif

typedef __attribute__((ext_vector_type(8))) short bf16x8;
typedef __attribute__((ext_vector_type(4))) short bf16x4;
typedef __attribute__((ext_vector_type(16))) float f32x16;
typedef unsigned short u16;
typedef __attribute__((ext_vector_type(4))) unsigned int u32x4;

constexpr int D = 1024;
constexpr int NBATCH = 2;
constexpr int SEQ = 16384;
constexpr int CTXL = 256;
constexpr int KPB = SEQ + CTXL;
constexpr int T = NBATCH * KPB;
constexpr int NRT = T / 128;
constexpr int FH = 2816;
constexpr int IN_DIM = 5536;
constexpr float LOG2E = 1.4426950408889634f;
constexpr float NA_SCALE_L2 = 0.125f * LOG2E;
constexpr float MLA_SCALE_L2 = 0.10206207261596575f * LOG2E;
constexpr float ALPHA = 1.4142135623730951f;
constexpr float EPS = 1e-5f;
constexpr float RS128 = 0.08838834764831845f;

constexpr size_t al256(size_t x) { return (x + 255) & ~(size_t)255; }
constexpr size_t O_WF = 0;
constexpr size_t O_WP = O_WF + (size_t)1024 * 1024 * 2;
constexpr size_t O_WG = O_WP + (size_t)2048 * 1024 * 2;
constexpr size_t O_WUQ = O_WG + (size_t)3072 * 1024 * 2;
constexpr size_t O_WUKV = O_WUQ + (size_t)768 * 256 * 2;
constexpr size_t O_WB = O_WUKV + (size_t)1024 * 128 * 2;
constexpr size_t O_WO = O_WB + (size_t)3 * 1024 * 512 * 2;
constexpr size_t O_WGU = O_WO + (size_t)1024 * 1024 * 2;
constexpr size_t O_WD = O_WGU + (size_t)5632 * 1024 * 2;
constexpr size_t O_MA = O_WD + (size_t)1024 * 2816 * 2;
constexpr size_t O_MB = O_MA + (size_t)256 * 256 * 2;
constexpr size_t O_MC = O_MB + (size_t)128 * 256 * 2;
constexpr size_t O_TW = O_MC + (size_t)256 * 512 * 2;
constexpr size_t O_MODP = O_TW + (size_t)128 * 128 * 2 * 4;
constexpr size_t O_MOD = O_MODP + (size_t)16 * 2 * 3 * 6144 * 4;
constexpr size_t O_XCTX = O_MOD + (size_t)2 * 3 * 6144 * 4;
constexpr size_t O_D1C = O_XCTX + (size_t)512 * 1024 * 4;
constexpr size_t O_A = O_D1C + (size_t)2 * 512 * 2 * 256 * 2;
constexpr size_t O_RQ = O_A + (size_t)T * 1024 * 2;
constexpr size_t O_QNA = O_RQ;
constexpr size_t O_KNA = O_QNA + (size_t)T * 512 * 2;
constexpr size_t O_VNAT = O_KNA + (size_t)T * 512 * 2;
constexpr size_t O_RY = O_VNAT + (size_t)T * 512 * 2;
constexpr size_t O_Y = O_RY;
constexpr size_t O_D1 = O_RY;
constexpr size_t O_LAT = O_RY + (size_t)67108864;
constexpr size_t O_D2 = O_RY + (size_t)T * 1536 * 2;
constexpr size_t O_QM = O_D2 + (size_t)67108864;
constexpr size_t O_KN = O_QM + (size_t)T * 768 * 2;
constexpr size_t O_KRR = O_KN + (size_t)T * 512 * 2;
constexpr size_t O_VMT = O_KRR + (size_t)T * 32 * 2;
constexpr size_t O_END = O_VMT + (size_t)T * 512 * 2;
constexpr size_t O_BAR = (O_END + 255) & ~(size_t)255;
constexpr size_t O_WSEND = O_BAR + 3456 * 4;
constexpr size_t O_FB = O_QM;
constexpr size_t O_M = O_RQ;
constexpr size_t O_HH = O_RQ;

struct Params {
  const float *x, *c, *ctx, *c_ctx, *ln_in_g, *ln_in_b, *w_mod, *b_mod, *w_in, *gq, *gkv, *w_uq, *w_qr, *w_uk,
      *w_uv, *rpb, *w_branch, *w_out, *ln1_g, *ln1_b, *ln2_g, *ln2_b, *w_gate, *w_up, *w_down;
  float* out;
  unsigned char* ws;
};

__device__ __forceinline__ u16 f2bf(float f) {
  uint32_t u = __float_as_uint(f);
  u += 0x7fffu + ((u >> 16) & 1u);
  return (u16)(u >> 16);
}
typedef __attribute__((ext_vector_type(2))) __bf16 bf16v2;
typedef __attribute__((ext_vector_type(2))) float f32v2;
__device__ __forceinline__ uint32_t pack2(float a, float b) {
  const f32v2 v = {a, b};
  return __builtin_bit_cast(uint32_t, __builtin_convertvector(v, bf16v2));
}
__device__ __forceinline__ uint4 pair_swap(uint2 a, uint2 b) {
  const auto rx = __builtin_amdgcn_permlane32_swap(a.x, b.x, false, false);
  const auto ry = __builtin_amdgcn_permlane32_swap(a.y, b.y, false, false);
  return make_uint4(rx[0], ry[0], rx[1], ry[1]);
}
__device__ __forceinline__ float bf2f(u16 v) { return __uint_as_float(((uint32_t)v) << 16); }
__device__ __forceinline__ float wsum(float v) {
#pragma unroll
  for (int o = 32; o > 0; o >>= 1) v += __shfl_xor(v, o);
  return v;
}
__device__ __forceinline__ float fsigmoid(float v) { return 1.f / (1.f + __expf(-v)); }

__device__ __forceinline__ int ltid() {
  int t = threadIdx.x;
  asm volatile("" : "+v"(t));
  return t;
}

template <typename Tp>
__device__ __forceinline__ Tp* wsp(const Params& p, size_t off) { return (Tp*)(p.ws + off); }

__device__ __forceinline__ float* xrow(const Params& p, int row) {
  int b = row / KPB, kk = row - b * KPB;
  if (kk < CTXL) return wsp<float>(p, O_XCTX) + (size_t)(b * CTXL + kk) * D;
  return p.out + (size_t)(b * SEQ + kk - CTXL) * D;
}

constexpr int LSTR = 72;
constexpr int SM_A = 128 * LSTR;

template <bool DEEP = true>
__device__ __forceinline__ void gemm_core(f32x16 (&acc)[2][2], const u16* __restrict__ A, size_t lda,
                                          const u16* __restrict__ B, size_t ldb, int K, u16* smem) {
  const int tid = ltid(), lane = tid & 63, wave = tid >> 6;
  const int wm = wave >> 1, wn = wave & 1, r = lane & 31, hh = lane >> 5;
  u16* sA = smem;
  u16* sB = smem + 2 * SM_A;
  const int lrow = tid >> 3, lkc = (tid & 7) * 8;
  const unsigned char* gab = (const unsigned char*)A;
  const unsigned char* gbb = (const unsigned char*)B;
  uint32_t oa[4], ob[4];
#pragma unroll
  for (int i = 0; i < 4; i++) {
    oa[i] = (uint32_t)(((size_t)(lrow + 32 * i) * lda + lkc) * 2);
    ob[i] = (uint32_t)(((size_t)(lrow + 32 * i) * ldb + lkc) * 2);
  }
  u16* wa = sA + lrow * LSTR + lkc;
  u16* wb = sB + lrow * LSTR + lkc;
  const u16* pa = sA + (wm * 64 + r) * LSTR + hh * 8;
  const u16* pb = sB + (wn * 64 + r) * LSTR + hh * 8;
  u32x4 a0r[4], b0r[4], a1r[4], b1r[4];
#define G_LOAD(ar, br, ko)                                               \
  _Pragma("unroll") for (int i = 0; i < 4; i++) {                        \
    ar[i] = *(const u32x4*)(gab + (size_t)(ko)*2 + oa[i]);               \
    br[i] = *(const u32x4*)(gbb + (size_t)(ko)*2 + ob[i]);               \
  }
#define G_STORE(ar, br, buf)                                             \
  _Pragma("unroll") for (int i = 0; i < 4; i++) {                        \
    *(u32x4*)(wa + (buf)*SM_A + 32 * i * LSTR) = ar[i];                  \
    *(u32x4*)(wb + (buf)*SM_A + 32 * i * LSTR) = br[i];                  \
  }
#define G_COMPUTE(buf)                                                                   \
  _Pragma("unroll") for (int ks = 0; ks < 4; ks++) {                                     \
    const bf16x8 fa0 = *(const bf16x8*)(pa + (buf)*SM_A + ks * 16);                      \
    const bf16x8 fa1 = *(const bf16x8*)(pa + (buf)*SM_A + 32 * LSTR + ks * 16);          \
    const bf16x8 fb0 = *(const bf16x8*)(pb + (buf)*SM_A + ks * 16);                      \
    const bf16x8 fb1 = *(const bf16x8*)(pb + (buf)*SM_A + 32 * LSTR + ks * 16);          \
    acc[0][0] = __builtin_amdgcn_mfma_f32_32x32x16_bf16(fa0, fb0, acc[0][0], 0, 0, 0);   \
    acc[0][1] = __builtin_amdgcn_mfma_f32_32x32x16_bf16(fa0, fb1, acc[0][1], 0, 0, 0);   \
    acc[1][0] = __builtin_amdgcn_mfma_f32_32x32x16_bf16(fa1, fb0, acc[1][0], 0, 0, 0);   \
    acc[1][1] = __builtin_amdgcn_mfma_f32_32x32x16_bf16(fa1, fb1, acc[1][1], 0, 0, 0);   \
  }
  const int nk = K >> 6;
  if (DEEP) {
    G_LOAD(a0r, b0r, 0)
    G_LOAD(a1r, b1r, 64)
    G_STORE(a0r, b0r, 0)
    __syncthreads();
    const int klast = (nk - 1) * 64;
    G_LOAD(a0r, b0r, min(128, klast))
    for (int kt = 0; kt < nk; kt += 2) {
      G_COMPUTE(0)
      G_STORE(a1r, b1r, 1)
      __syncthreads();
      G_LOAD(a1r, b1r, min((kt + 3) * 64, klast))
      __builtin_amdgcn_sched_barrier(0);
      G_COMPUTE(1)
      G_STORE(a0r, b0r, 0)
      __syncthreads();
      G_LOAD(a0r, b0r, min((kt + 4) * 64, klast))
      __builtin_amdgcn_sched_barrier(0);
    }
  } else {
    G_LOAD(a0r, b0r, 0)
    G_STORE(a0r, b0r, 0)
    __syncthreads();
    for (int kt = 0; kt < nk; kt += 2) {
      G_LOAD(a0r, b0r, (kt + 1) * 64)
      G_COMPUTE(0)
      G_STORE(a0r, b0r, 1)
      __syncthreads();
      if (kt + 2 < nk) G_LOAD(a0r, b0r, (kt + 2) * 64)
      G_COMPUTE(1)
      if (kt + 2 < nk) G_STORE(a0r, b0r, 0)
      __syncthreads();
    }
  }
#undef G_LOAD
#undef G_STORE
#undef G_COMPUTE
}

__device__ __forceinline__ void zero_acc(f32x16 (&acc)[2][2]) {
#pragma unroll
  for (int i = 0; i < 2; i++)
#pragma unroll
    for (int j = 0; j < 2; j++)
#pragma unroll
      for (int e = 0; e < 16; e++) acc[i][j][e] = 0.f;
}

#define EPI_DECL                                                     \
  const int lane_ = ltid() & 63, wave_ = ltid() >> 6;      \
  const int wm_ = wave_ >> 1, wn_ = wave_ & 1, r_ = lane_ & 31, hh_ = lane_ >> 5; \
  (void)wm_; (void)wn_; (void)r_; (void)hh_;

__device__ __forceinline__ const float* src_col(const Params& p, int l, int kind, int n, int& ld) {
  switch (kind) {
    case 0:
      ld = IN_DIM;
      return n < 1952 ? p.w_in + (size_t)l * D * IN_DIM + 512 + n : nullptr;
    case 1:
      ld = IN_DIM;
      return p.w_in + (size_t)l * D * IN_DIM + 2464 + n;
    case 2:
      if (n < 512) {
        ld = 512;
        return p.w_uq + (size_t)l * 256 * 512 + n;
      } else {
        int m = n - 512, wt = m >> 6, jb = (m >> 5) & 1, idx = wt * 32 + (m & 31);
        int h = idx >> 4, e = idx & 15;
        ld = 256;
        return p.w_qr + (size_t)l * 256 * 256 + h * 32 + jb * 16 + e;
      }
    case 3:
      ld = 512;
      return n < 512 ? p.w_uk + (size_t)l * 128 * 512 + n : p.w_uv + (size_t)l * 128 * 512 + (n - 512);
    case 4: {
      int g = n >> 10, nn = n & 1023;
      ld = 1024;
      return p.w_branch + ((size_t)(l * 3 + g) * 512) * 1024 + nn;
    }
    case 5:
      ld = 1024;
      return p.w_out + (size_t)l * D * D + n;
    case 6: {
      int jb = (n >> 5) & 1, q = (n >> 6) * 32 + (n & 31);
      ld = FH;
      return (jb ? p.w_up : p.w_gate) + (size_t)l * D * FH + q;
    }
    default:
      ld = 1024;
      return p.w_down + (size_t)l * FH * D + n;
  }
}

__device__ __forceinline__ int job_nd(int k) {
  switch (k) { case 0: return 2048; case 1: return 3072; case 2: return 768; case 3: return 1024; case 4: return 3072;
    case 5: return 1024; case 6: return 5632; default: return 1024; }
}
__device__ __forceinline__ int job_kd(int k) {
  switch (k) { case 0: return 1024; case 1: return 1024; case 2: return 256; case 3: return 128; case 4: return 512;
    case 5: return 1024; case 6: return 1024; default: return 2816; }
}
__device__ __forceinline__ size_t job_od(int k) {
  switch (k) { case 0: return O_WP; case 1: return O_WG; case 2: return O_WUQ; case 3: return O_WUKV; case 4: return O_WB;
    case 5: return O_WO; case 6: return O_WGU; default: return O_WD; }
}
__device__ void prep_weights(const Params& p, int l, int bid, int nb, u16* smem) {
  float* tile = (float*)smem;
  const int tid = ltid();
  int start = 0;
#pragma unroll 1
  for (int kind = 0; kind < 8; kind++) {
    const int Kk = job_kd(kind);
    const int nkt = Kk >> 6, ntile = (job_nd(kind) >> 6) * nkt;
    u16* dst = wsp<u16>(p, job_od(kind));
    const float* ksc = kind == 2 ? p.gq + l * 256 : (kind == 3 ? p.gkv + l * 128 : nullptr);
    for (int t = (bid + nb - (start % nb)) % nb; t < ntile; t += nb) {
      const int nt = t / nkt, kt = t - nt * nkt;
      const int n0 = nt * 64, k0 = kt * 64;
      {
        const int kq = tid >> 4, nn4 = (tid & 15) * 4;
        int ld;
        const float* sp = src_col(p, l, kind, n0 + nn4, ld);
#pragma unroll
        for (int i = 0; i < 4; i++) {
          const int kk = i * 16 + kq;
          float4 v = make_float4(0.f, 0.f, 0.f, 0.f);
          if (sp) v = *(const float4*)(sp + (size_t)(k0 + kk) * ld);
          if (ksc) {
            const float sc = ksc[k0 + kk];
            v.x *= sc; v.y *= sc; v.z *= sc; v.w *= sc;
          }
          float* tp = tile + kk * 65 + nn4;
          tp[0] = v.x; tp[1] = v.y; tp[2] = v.z; tp[3] = v.w;
        }
      }
      __syncthreads();
#pragma unroll
      for (int i = 0; i < 2; i++) {
        const int c = tid + 256 * i;
        const int nn = c >> 3, kc = (c & 7) * 8;
        const float* tp = tile + kc * 65 + nn;
        uint4 o;
        o.x = pack2(tp[0], tp[65]);
        o.y = pack2(tp[2 * 65], tp[3 * 65]);
        o.z = pack2(tp[4 * 65], tp[5 * 65]);
        o.w = pack2(tp[6 * 65], tp[7 * 65]);
        *(uint4*)(dst + (size_t)(n0 + nn) * Kk + k0 + kc) = o;
      }
      __syncthreads();
    }
    start += ntile;
  }
  {
    float* ctab = (float*)smem;
    __syncthreads();
    if (tid < 128) ctab[tid] = cospif((float)tid * (1.f / 64.f));
    __syncthreads();
    u16* dst = wsp<u16>(p, O_WF);
    for (int it = bid; it < 512; it += nb) {
      const int o = it * 256 + tid;
      const int np = o & 1023, k8 = (o >> 10) * 8;
      const int reim = np >> 9, g = (np >> 7) & 3, m = np & 127;
      const float* w = p.w_in + (size_t)l * D * IN_DIM + (size_t)k8 * IN_DIM + g * 128;
      const int sh = reim ? 96 : 0;
      float a8[8];
#pragma unroll
      for (int j = 0; j < 8; j++) a8[j] = 0.f;
#pragma unroll 4
      for (int c = 0; c < 128; c++) {
        const float tw = ctab[(m * c + sh) & 127];
#pragma unroll
        for (int j = 0; j < 8; j++) a8[j] += w[(size_t)j * IN_DIM + c] * tw;
      }
      uint4 ov;
      ov.x = pack2(a8[0] * RS128, a8[1] * RS128);
      ov.y = pack2(a8[2] * RS128, a8[3] * RS128);
      ov.z = pack2(a8[4] * RS128, a8[5] * RS128);
      ov.w = pack2(a8[6] * RS128, a8[7] * RS128);
      *(uint4*)(dst + (size_t)np * 1024 + k8) = ov;
    }
    __syncthreads();
  }
}

__device__ void prep_tables(const Params& p, int bid, int nb) {
  u16* MA = wsp<u16>(p, O_MA);
  u16* MB = wsp<u16>(p, O_MB);
  u16* MC = wsp<u16>(p, O_MC);
  float* TW = wsp<float>(p, O_TW);
  const int total = 65536 + 32768 + 131072 + 16384;
  for (int idx = bid * 256 + ltid(); idx < total; idx += nb * 256) {
    if (idx < 65536) {
      const int n = idx >> 8, k = idx & 255;
      const int nt = n >> 7, wn = (n >> 6) & 1, jb = (n >> 5) & 1, klo = nt * 64 + wn * 32 + (n & 31);
      const int ri = k >> 7, nhi = k & 127;
      const int xx = (klo * nhi) & 127;
      const float c = cospif((float)xx * (1.f / 64.f)), s = sinpif((float)xx * (1.f / 64.f));
      float v = jb == 0 ? (ri == 0 ? c : -s) : (ri == 0 ? -s : -c);
      MA[idx] = f2bf(v * RS128);
    } else if (idx < 65536 + 32768) {
      const int i2 = idx - 65536;
      const int khi = i2 >> 8, k = i2 & 255;
      const int ri = k >> 7, nlo = k & 127;
      const int xx = (khi * nlo) & 127;
      const float c = cospif((float)xx * (1.f / 64.f)), s = sinpif((float)xx * (1.f / 64.f));
      MB[i2] = f2bf((ri == 0 ? c : s) * RS128);
    } else if (idx < 65536 + 32768 + 131072) {
      const int i2 = idx - 65536 - 32768;
      const int kk = i2 >> 9, k = i2 & 511;
      const int ri = k >> 8, nn = k & 255;
      const int xx = (kk * nn) & 255;
      const float c = cospif((float)xx * (1.f / 128.f)), s = sinpif((float)xx * (1.f / 128.f));
      MC[i2] = f2bf((ri == 0 ? c : -s) * 0.0625f);
    } else {
      const int i2 = idx - 65536 - 32768 - 131072;
      const int klo = i2 >> 7, nlo = i2 & 127;
      const int xx = klo * nlo;
      TW[i2 * 2] = cospif((float)xx * (1.f / 8192.f));
      TW[i2 * 2 + 1] = sinpif((float)xx * (1.f / 8192.f));
    }
  }
}

__device__ void prep_modp(const Params& p, int bid, int nb) {
  float* modp = wsp<float>(p, O_MODP);
  for (int it = bid; it < 2 * 16 * 24; it += nb) {
    const int l = it / (16 * 24), rem = it - l * 16 * 24, kc = rem / 24, nblk = rem - kc * 24;
    const int n = nblk * 256 + ltid();
    const float* w = p.w_mod + (size_t)l * D * 6144 + n;
    float a0 = 0.f, a1 = 0.f, a2 = 0.f;
#pragma unroll 8
    for (int kk = 0; kk < 64; kk++) {
      const int k = kc * 64 + kk;
      const float wv = w[(size_t)k * 6144];
      float c0 = p.c[k], c1 = p.c[1024 + k], c2 = p.c_ctx[k];
      c0 = c0 / (1.f + __expf(-c0));
      c1 = c1 / (1.f + __expf(-c1));
      c2 = c2 / (1.f + __expf(-c2));
      a0 += c0 * wv;
      a1 += c1 * wv;
      a2 += c2 * wv;
    }
    float* o = modp + ((size_t)(kc * 2 + l) * 3) * 6144 + n;
    o[0] = a0;
    o[6144] = a1;
    o[2 * 6144] = a2;
  }
}
__device__ void prep_modr(const Params& p, int bid, int nb) {
  const float* modp = wsp<float>(p, O_MODP);
  float* mod = wsp<float>(p, O_MOD);
  for (int idx = bid * 256 + ltid(); idx < 2 * 3 * 6144; idx += nb * 256) {
    const int l = idx / (3 * 6144), n = idx % 6144;
    float v = p.b_mod[l * 6144 + n];
    for (int kc = 0; kc < 16; kc++) v += modp[(size_t)kc * 2 * 3 * 6144 + idx];
    mod[idx] = v;
  }
}

__device__ void ln_phase(const Params& p, int mode, const float* g, const float* bta, int lmod, int shoff, int scoff,
                         bool skip_ctx, int bid, int nb, int lres = 0, int goff = -1) {
  const int lane = ltid() & 63, wave = ltid() >> 6;
  u16* A = wsp<u16>(p, O_A);
  const float* mod = wsp<float>(p, O_MOD);
  float4 gg[4], bb[4], sh[4], sc[4], gt[4];
#pragma unroll
  for (int q = 0; q < 4; q++) gt[q] = make_float4(0.f, 0.f, 0.f, 0.f);
  int cur_mg = -1;
#pragma unroll
  for (int q = 0; q < 4; q++) {
    const int c0 = (q >> 1) * 512 + lane * 8 + (q & 1) * 4;
    gg[q] = *(const float4*)(g + c0);
    bb[q] = *(const float4*)(bta + c0);
    sh[q] = make_float4(0.f, 0.f, 0.f, 0.f);
    sc[q] = make_float4(0.f, 0.f, 0.f, 0.f);
  }
  int cur_m = -1;
  for (int row = bid * 4 + wave; row < T; row += nb * 4) {
    const int b = row / KPB, kk = row - b * KPB;
    if (skip_ctx && kk < CTXL) continue;
    float* xr = xrow(p, row);
    const float* src;
    if (mode == 0)
      src = kk < CTXL ? p.ctx + (size_t)(b * CTXL + kk) * D : p.x + (size_t)(b * SEQ + kk - CTXL) * D;
    else
      src = xr;
    float4 v[4];
    float s = 0.f;
    const int m = kk < CTXL ? 2 : b;
    if (goff >= 0 && m != cur_mg) {
      cur_mg = m;
#pragma unroll
      for (int q = 0; q < 4; q++)
        gt[q] = *(const float4*)(mod + ((size_t)lres * 3 + m) * 6144 + goff + (q >> 1) * 512 + lane * 8 + (q & 1) * 4);
    }
#pragma unroll
    for (int i = 0; i < 2; i++) {
      uint4 fv = make_uint4(0u, 0u, 0u, 0u);
      if (goff >= 0) fv = *(const uint4*)(wsp<u16>(p, O_FB) + (size_t)row * D + i * 512 + lane * 8);
      const uint32_t fw[4] = {fv.x, fv.y, fv.z, fv.w};
#pragma unroll
      for (int hq = 0; hq < 2; hq++) {
        const int q = i * 2 + hq;
        v[q] = *(const float4*)(src + i * 512 + lane * 8 + hq * 4);
        if (goff >= 0) {
          v[q].x = ALPHA * v[q].x + (1.f + gt[q].x) * __uint_as_float(fw[hq * 2] << 16);
          v[q].y = ALPHA * v[q].y + (1.f + gt[q].y) * __uint_as_float(fw[hq * 2] & 0xffff0000u);
          v[q].z = ALPHA * v[q].z + (1.f + gt[q].z) * __uint_as_float(fw[hq * 2 + 1] << 16);
          v[q].w = ALPHA * v[q].w + (1.f + gt[q].w) * __uint_as_float(fw[hq * 2 + 1] & 0xffff0000u);
        }
        s += v[q].x + v[q].y + v[q].z + v[q].w;
      }
    }
    if (lmod >= 0 && m != cur_m) {
      cur_m = m;
      const float* md = mod + ((size_t)lmod * 3 + m) * 6144;
#pragma unroll
      for (int q = 0; q < 4; q++) {
        const int c0 = (q >> 1) * 512 + lane * 8 + (q & 1) * 4;
        sh[q] = *(const float4*)(md + shoff + c0);
        sc[q] = *(const float4*)(md + scoff + c0);
      }
    }
    const float mu = wsum(s) * (1.f / 1024.f);
    float qs = 0.f;
#pragma unroll
    for (int q = 0; q < 4; q++) {
      v[q].x -= mu; v[q].y -= mu; v[q].z -= mu; v[q].w -= mu;
      qs += v[q].x * v[q].x + v[q].y * v[q].y + v[q].z * v[q].z + v[q].w * v[q].w;
    }
    const float rstd = rsqrtf(wsum(qs) * (1.f / 1024.f) + EPS);
#pragma unroll
    for (int i = 0; i < 2; i++) {
      uint4 o;
      uint32_t ow[4];
#pragma unroll
      for (int hq = 0; hq < 2; hq++) {
        const int q = i * 2 + hq;
        float4 y;
        y.x = v[q].x * rstd * gg[q].x + bb[q].x;
        y.y = v[q].y * rstd * gg[q].y + bb[q].y;
        y.z = v[q].z * rstd * gg[q].z + bb[q].z;
        y.w = v[q].w * rstd * gg[q].w + bb[q].w;
        *(float4*)(xr + i * 512 + lane * 8 + hq * 4) = y;
        ow[hq * 2] = pack2(y.x * (1.f + sc[q].x) + sh[q].x, y.y * (1.f + sc[q].y) + sh[q].y);
        ow[hq * 2 + 1] = pack2(y.z * (1.f + sc[q].z) + sh[q].z, y.w * (1.f + sc[q].w) + sh[q].w);
      }
      if (lmod >= 0) {
        o.x = ow[0]; o.y = ow[1]; o.z = ow[2]; o.w = ow[3];
        *(uint4*)(A + (size_t)row * D + i * 512 + lane * 8) = o;
      }
    }
  }
}

#define PATCH_LOOP_BEGIN(NR_, NC_, PR_, PC_)                                   \
  {                                                                            \
    const int x_ = bid & 7, w_ = bid >> 3, nbx_ = nb >> 3;                     \
    const int CG_ = ((NC_) + (PC_)-1) / (PC_);                                 \
    const int npatch_ = (((NR_) + (PR_)-1) / (PR_)) * CG_;                     \
    for (int u_ = w_;; u_ += nbx_) {                                           \
      const int g_ = (u_ >> 6) * 8 + x_;                                       \
      if (g_ >= npatch_) break;                                                \
      const int s_ = u_ & 63;                                                  \
      const int rg_ = g_ / CG_;                                                \
      const int prt = rg_ * (PR_) + s_ / (PC_);                                \
      const int pct = (g_ - rg_ * CG_) * (PC_) + s_ % (PC_);                   \
      if (prt >= (NR_) || pct >= (NC_)) continue;
#define PATCH_LOOP_END \
    }                  \
  }

__device__ void phase_p1(const Params& p, int l, bool last, int bid, int nb, u16* smem) {
  EPI_DECL
  const u16* A = wsp<u16>(p, O_A);
  PATCH_LOOP_BEGIN(NRT, 16, 8, 8)
    f32x16 acc[2][2];
    zero_acc(acc);
    {
      const int rt = prt, ct = pct;
      const int row0 = rt * 128, b = row0 / KPB, kk0 = row0 - b * KPB;
      if (ct < 8 || ct >= 12) {
        gemm_core(acc, wsp<u16>(p, O_WP) + (size_t)ct * 128 * D, D, A + (size_t)rt * 128 * D, D, D, smem);
        u16* dst;
        float sc = 1.f;
        int cb;
        if (ct < 4) { dst = wsp<u16>(p, O_QNA); sc = NA_SCALE_L2; cb = ct * 128; }
        else if (ct < 8) { dst = wsp<u16>(p, O_KNA); cb = (ct - 4) * 128; }
        else { dst = wsp<u16>(p, O_LAT); cb = (ct - 12) * 128; }
#pragma unroll
        for (int i = 0; i < 2; i++)
#pragma unroll
          for (int j = 0; j < 2; j++)
#pragma unroll
            for (int gp = 0; gp < 2; gp++) {
              const int row = row0 + wn_ * 64 + j * 32 + r_;
              const int col = cb + wm_ * 64 + i * 32 + 8 * (2 * gp + hh_);
              uint2 oa, ob;
              oa.x = pack2(acc[i][j][8 * gp] * sc, acc[i][j][8 * gp + 1] * sc);
              oa.y = pack2(acc[i][j][8 * gp + 2] * sc, acc[i][j][8 * gp + 3] * sc);
              ob.x = pack2(acc[i][j][8 * gp + 4] * sc, acc[i][j][8 * gp + 5] * sc);
              ob.y = pack2(acc[i][j][8 * gp + 6] * sc, acc[i][j][8 * gp + 7] * sc);
              *(uint4*)(dst + (size_t)row * 512 + col) = pair_swap(oa, ob);
            }
      } else {
        gemm_core(acc, A + (size_t)rt * 128 * D, D, wsp<u16>(p, O_WP) + (size_t)ct * 128 * D, D, D, smem);
        u16* dst = wsp<u16>(p, O_VNAT);
        const int cb = (ct - 8) * 128;
#pragma unroll
        for (int i = 0; i < 2; i++)
#pragma unroll
          for (int j = 0; j < 2; j++)
#pragma unroll
            for (int gp = 0; gp < 2; gp++) {
              const int kk = kk0 + wm_ * 64 + i * 32 + 8 * (2 * gp + hh_);
              const int col = cb + wn_ * 64 + j * 32 + r_;
              uint2 oa, ob;
              oa.x = pack2(acc[i][j][8 * gp], acc[i][j][8 * gp + 1]);
              oa.y = pack2(acc[i][j][8 * gp + 2], acc[i][j][8 * gp + 3]);
              ob.x = pack2(acc[i][j][8 * gp + 4], acc[i][j][8 * gp + 5]);
              ob.y = pack2(acc[i][j][8 * gp + 6], acc[i][j][8 * gp + 7]);
              *(uint4*)(dst + ((size_t)(b * 512 + col)) * KPB + kk) = pair_swap(oa, ob);
            }
      }
    }
  PATCH_LOOP_END
  PATCH_LOOP_BEGIN(256, 8, 8, 8)
    f32x16 acc[2][2];
    zero_acc(acc);
    {
      const int rt = prt, ct = pct;
      const int b = rt >> 7, nlo = rt & 127;
      gemm_core(acc, A + (size_t)(b * KPB + CTXL + nlo) * D, (size_t)128 * D,
                wsp<u16>(p, O_WF) + (size_t)ct * 128 * D, D, D, smem);
      u16* dst = wsp<u16>(p, O_D1);
#pragma unroll
      for (int i = 0; i < 2; i++)
#pragma unroll
        for (int j = 0; j < 2; j++)
#pragma unroll
          for (int gp = 0; gp < 2; gp++) {
            const int nhi = wm_ * 64 + i * 32 + 8 * (2 * gp + hh_);
            const int n = ct * 128 + wn_ * 64 + j * 32 + r_;
            const int reim = n >> 9, jj = n & 511;
            uint2 oa, ob;
            oa.x = pack2(acc[i][j][8 * gp], acc[i][j][8 * gp + 1]);
            oa.y = pack2(acc[i][j][8 * gp + 2], acc[i][j][8 * gp + 3]);
            ob.x = pack2(acc[i][j][8 * gp + 4], acc[i][j][8 * gp + 5]);
            ob.y = pack2(acc[i][j][8 * gp + 6], acc[i][j][8 * gp + 7]);
            *(uint4*)(dst + ((((size_t)(b * 512 + jj)) * 128 + nlo) * 2 + reim) * 128 + nhi) = pair_swap(oa, ob);
          }
    }
  PATCH_LOOP_END
  if (!last) {
    for (int t2 = bid; t2 < 32; t2 += nb) {
      f32x16 acc[2][2];
      zero_acc(acc);
      const int rt = t2 >> 3, ct = t2 & 7;
      const int b = rt >> 1, rb = rt & 1;
      gemm_core(acc, A + (size_t)(b * KPB + rb * 128) * D, D, wsp<u16>(p, O_WF) + (size_t)ct * 128 * D, D, D, smem);
      u16* dst = wsp<u16>(p, O_D1C);
#pragma unroll
      for (int i = 0; i < 2; i++)
#pragma unroll
        for (int j = 0; j < 2; j++)
#pragma unroll
          for (int gp = 0; gp < 2; gp++) {
            const int nc = rb * 128 + wm_ * 64 + i * 32 + 8 * (2 * gp + hh_);
            const int n = ct * 128 + wn_ * 64 + j * 32 + r_;
            const int reim = n >> 9, jj = n & 511;
            uint2 oa, ob;
            oa.x = pack2(acc[i][j][8 * gp], acc[i][j][8 * gp + 1]);
            oa.y = pack2(acc[i][j][8 * gp + 2], acc[i][j][8 * gp + 3]);
            ob.x = pack2(acc[i][j][8 * gp + 4], acc[i][j][8 * gp + 5]);
            ob.y = pack2(acc[i][j][8 * gp + 6], acc[i][j][8 * gp + 7]);
            *(uint4*)(dst + (((size_t)(b * 512 + jj)) * 2 + reim) * 256 + nc) = pair_swap(oa, ob);
          }
    }
  }
}

__device__ __forceinline__ float inv_freq(int i) {
  switch (i) {
    case 0: return 1.0f;
    case 1: return 0.31622776601683794f;
    case 2: return 0.1f;
    case 3: return 0.03162277660168379f;
    case 4: return 0.01f;
    case 5: return 0.0031622776601683794f;
    case 6: return 0.001f;
    default: return 0.00031622776601683794f;
  }
}
__device__ __forceinline__ void rope_cs(int kk, int e, float& cs, float& sn) {
  if (kk < CTXL) { cs = 1.f; sn = 0.f; return; }
  const int tkn = kk - CTXL;
  const float pos = (e < 8) ? (float)(tkn >> 6) : (float)(tkn & 63);
  const float ang = pos * inv_freq(e & 7);
  double xr = (double)ang * 0.31830988618379067;
  xr -= 2.0 * floor(xr * 0.5);
  const float yr = (float)xr;
  cs = cospif(yr);
  sn = sinpif(yr);
}

__device__ __forceinline__ void row_rms(const u16* A, size_t lda, int K, float* rs) {
  const int tid = ltid();
  const int row = tid >> 1, half = tid & 1;
  const u16* pr = A + (size_t)row * lda + half * (K >> 1);
  float s = 0.f;
  for (int c = 0; c < (K >> 1); c += 8) {
    uint4 v = *(const uint4*)(pr + c);
    const uint32_t w[4] = {v.x, v.y, v.z, v.w};
#pragma unroll
    for (int q = 0; q < 4; q++) {
      const float a = __uint_as_float(w[q] << 16), bq = __uint_as_float(w[q] & 0xffff0000u);
      s += a * a + bq * bq;
    }
  }
  s += __shfl_xor(s, 1);
  if (half == 0) rs[row] = rsqrtf(s / (float)K + EPS);
  __syncthreads();
}

__device__ void phase_p2(const Params& p, int l, int bid, int nb, u16* smem) {
  EPI_DECL
  const u16* LAT = wsp<u16>(p, O_LAT);
  float* rs = (float*)(smem + 4 * SM_A);
  const int nQ = NRT * 6, nKV = NRT * 8, nFA = 1024 * 2, nKR = NRT;
  const int total = nQ + nKV + nFA + nKR;
  for (int t = bid; t < total; t += nb) {
    if (t < nQ) {
      const int rt = t / 6, ct = t - rt * 6;
      const int row0 = rt * 128, b = row0 / KPB, kk0 = row0 - b * KPB;
      row_rms(LAT + (size_t)row0 * 512, 512, 256, rs);
      f32x16 acc[2][2];
      zero_acc(acc);
      gemm_core(acc, wsp<u16>(p, O_WUQ) + (size_t)ct * 128 * 256, 256, LAT + (size_t)row0 * 512, 512, 256, smem);
      u16* QM = wsp<u16>(p, O_QM);
      if (ct < 4) {
#pragma unroll
        for (int i = 0; i < 2; i++)
#pragma unroll
          for (int j = 0; j < 2; j++)
#pragma unroll
            for (int gp = 0; gp < 2; gp++) {
              const int rl = wn_ * 64 + j * 32 + r_;
              const int col = ct * 128 + wm_ * 64 + i * 32 + 8 * (2 * gp + hh_);
              const int h = col >> 6, d = col & 63;
              const float sc = rs[rl] * MLA_SCALE_L2;
              uint2 oa, ob;
              oa.x = pack2(acc[i][j][8 * gp] * sc, acc[i][j][8 * gp + 1] * sc);
              oa.y = pack2(acc[i][j][8 * gp + 2] * sc, acc[i][j][8 * gp + 3] * sc);
              ob.x = pack2(acc[i][j][8 * gp + 4] * sc, acc[i][j][8 * gp + 5] * sc);
              ob.y = pack2(acc[i][j][8 * gp + 6] * sc, acc[i][j][8 * gp + 7] * sc);
              *(uint4*)(QM + (size_t)(row0 + rl) * 768 + h * 96 + d) = pair_swap(oa, ob);
            }
      } else {
        const int wt = (ct - 4) * 2 + wm_;
#pragma unroll
        for (int j = 0; j < 2; j++) {
          const int rl = wn_ * 64 + j * 32 + r_;
          const float sc = rs[rl] * MLA_SCALE_L2;
          uint2 p1[4], p2[4];
#pragma unroll
          for (int g = 0; g < 4; g++) {
            const int idx = wt * 32 + 8 * g + 4 * hh_;
            const int e16 = idx & 15;
            float o1[4], o2[4];
#pragma unroll
            for (int q = 0; q < 4; q++) {
              float cs, sn;
              rope_cs(kk0 + rl, e16 + q, cs, sn);
              const float x1 = acc[0][j][4 * g + q] * sc, x2 = acc[1][j][4 * g + q] * sc;
              o1[q] = x1 * cs - x2 * sn;
              o2[q] = x2 * cs + x1 * sn;
            }
            p1[g].x = pack2(o1[0], o1[1]);
            p1[g].y = pack2(o1[2], o1[3]);
            p2[g].x = pack2(o2[0], o2[1]);
            p2[g].y = pack2(o2[2], o2[3]);
          }
#pragma unroll
          for (int gp = 0; gp < 2; gp++) {
            u16* qd = QM + (size_t)(row0 + rl) * 768 + (2 * wt + gp) * 96 + 64 + 8 * hh_;
            *(uint4*)qd = pair_swap(p1[2 * gp], p1[2 * gp + 1]);
            *(uint4*)(qd + 16) = pair_swap(p2[2 * gp], p2[2 * gp + 1]);
          }
        }
      }
      __syncthreads();
    } else if (t < nQ + nKV) {
      const int t2 = t - nQ;
      const int rt = t2 >> 3, ct = t2 & 7;
      const int row0 = rt * 128, b = row0 / KPB, kk0 = row0 - b * KPB;
      row_rms(LAT + (size_t)row0 * 512 + 256, 512, 128, rs);
      f32x16 acc[2][2];
      zero_acc(acc);
      if (ct < 4) {
        gemm_core(acc, wsp<u16>(p, O_WUKV) + (size_t)ct * 128 * 128, 128, LAT + (size_t)row0 * 512 + 256, 512, 128,
                  smem);
        u16* KN = wsp<u16>(p, O_KN);
#pragma unroll
        for (int i = 0; i < 2; i++)
#pragma unroll
          for (int j = 0; j < 2; j++)
#pragma unroll
            for (int gp = 0; gp < 2; gp++) {
              const int rl = wn_ * 64 + j * 32 + r_;
              const int col = ct * 128 + wm_ * 64 + i * 32 + 8 * (2 * gp + hh_);
              const float sc = rs[rl];
              uint2 oa, ob;
              oa.x = pack2(acc[i][j][8 * gp] * sc, acc[i][j][8 * gp + 1] * sc);
              oa.y = pack2(acc[i][j][8 * gp + 2] * sc, acc[i][j][8 * gp + 3] * sc);
              ob.x = pack2(acc[i][j][8 * gp + 4] * sc, acc[i][j][8 * gp + 5] * sc);
              ob.y = pack2(acc[i][j][8 * gp + 6] * sc, acc[i][j][8 * gp + 7] * sc);
              *(uint4*)(KN + (size_t)(row0 + rl) * 512 + col) = pair_swap(oa, ob);
            }
      } else {
        gemm_core(acc, LAT + (size_t)row0 * 512 + 256, 512, wsp<u16>(p, O_WUKV) + (size_t)ct * 128 * 128, 128, 128,
                  smem);
        u16* VMT = wsp<u16>(p, O_VMT);
#pragma unroll
        for (int i = 0; i < 2; i++)
#pragma unroll
          for (int j = 0; j < 2; j++)
#pragma unroll
            for (int gp = 0; gp < 2; gp++) {
              const int ra = wm_ * 64 + i * 32 + 16 * gp + 4 * hh_;
              const int rb2 = ra + 8;
              const int rst = wm_ * 64 + i * 32 + 8 * (2 * gp + hh_);
              const int col = (ct - 4) * 128 + wn_ * 64 + j * 32 + r_;
              uint2 oa, ob;
              oa.x = pack2(acc[i][j][8 * gp] * rs[ra], acc[i][j][8 * gp + 1] * rs[ra + 1]);
              oa.y = pack2(acc[i][j][8 * gp + 2] * rs[ra + 2], acc[i][j][8 * gp + 3] * rs[ra + 3]);
              ob.x = pack2(acc[i][j][8 * gp + 4] * rs[rb2], acc[i][j][8 * gp + 5] * rs[rb2 + 1]);
              ob.y = pack2(acc[i][j][8 * gp + 6] * rs[rb2 + 2], acc[i][j][8 * gp + 7] * rs[rb2 + 3]);
              *(uint4*)(VMT + ((size_t)(b * 512 + col)) * KPB + kk0 + rst) = pair_swap(oa, ob);
            }
      }
      __syncthreads();
    } else if (t < nQ + nKV + nFA) {
      const int t2 = t - nQ - nKV;
      const int rt = t2 >> 1, ct = t2 & 1;
      const int b = rt >> 9, jj = rt & 511;
      f32x16 acc[2][2];
      zero_acc(acc);
      gemm_core(acc, wsp<u16>(p, O_D1) + (size_t)rt * 128 * 256, 256, wsp<u16>(p, O_MA) + (size_t)ct * 128 * 256, 256,
                256, smem);
      const float* TW = wsp<float>(p, O_TW);
      u16* D2 = wsp<u16>(p, O_D2);
      const int klo = ct * 64 + wn_ * 32 + r_;
      const float2* twp = (const float2*)TW + klo;
#pragma unroll
      for (int i = 0; i < 2; i++)
      {
        uint2 pr[4], pi[4];
#pragma unroll
        for (int g = 0; g < 4; g++) {
          const int nlo = wm_ * 64 + i * 32 + 8 * g + 4 * hh_;
          float re[4], im[4];
#pragma unroll
          for (int q = 0; q < 4; q++) {
            const float2 tw = twp[(nlo + q) * 128];
            const float ar = acc[i][0][4 * g + q], ai = acc[i][1][4 * g + q];
            re[q] = ar * tw.x + ai * tw.y;
            im[q] = ai * tw.x - ar * tw.y;
          }
          pr[g].x = pack2(re[0], re[1]);
          pr[g].y = pack2(re[2], re[3]);
          pi[g].x = pack2(im[0], im[1]);
          pi[g].y = pack2(im[2], im[3]);
        }
#pragma unroll
        for (int gp = 0; gp < 2; gp++) {
          u16* d = D2 + ((((size_t)(b * 128 + klo)) * 512 + jj) * 2) * 128 + wm_ * 64 + i * 32 + 8 * (2 * gp + hh_);
          *(uint4*)d = pair_swap(pr[2 * gp], pr[2 * gp + 1]);
          *(uint4*)(d + 128) = pair_swap(pi[2 * gp], pi[2 * gp + 1]);
        }
      }
    } else {
      const int rt = t - nQ - nKV - nFA;
      u16* KRR = wsp<u16>(p, O_KRR);
      for (int idx = ltid(); idx < 128 * 16; idx += 256) {
        const int rl = idx >> 4, e16 = idx & 15;
        const int row = rt * 128 + rl, b = row / KPB, kk = row - b * KPB;
        const float x1 = bf2f(LAT[(size_t)row * 512 + 384 + e16]), x2 = bf2f(LAT[(size_t)row * 512 + 400 + e16]);
        float cs, sn;
        rope_cs(kk, e16, cs, sn);
        KRR[(size_t)row * 32 + e16] = f2bf(x1 * cs - x2 * sn);
        KRR[(size_t)row * 32 + 16 + e16] = f2bf(x2 * cs + x1 * sn);
      }
    }
  }
}

template <int MODE>
__device__ void attn_item(const Params& p, int l, int b, int h, int q0  ,
                          int ntiles  , int rs0, int ycol, u16* smem) {
  constexpr int DQK = MODE == 0 ? 96 : 64;
  constexpr int KSTR = DQK + 8;
  constexpr int NKS = DQK / 16;
  constexpr int CPR = DQK / 8;
  constexpr int NKC = 64 * CPR / 256;
  const int tid = ltid(), lane = tid & 63, wave = tid >> 6, r = lane & 31, hh = lane >> 5;
  u16* Ks = smem;
  u16* Vs = smem + 2 * 64 * KSTR;
  const unsigned char* wsb = p.ws;
  const int qk = q0 + wave * 32 + r;
  const size_t qrow = (size_t)b * KPB + qk;
  bf16x8 qf[NKS];
  {
    const u16* qp = MODE == 0 ? wsp<u16>(p, O_QM) + qrow * 768 + h * 96 : wsp<u16>(p, O_QNA) + qrow * 512 + h * 64;
#pragma unroll
    for (int ks = 0; ks < NKS; ks++) qf[ks] = *(const bf16x8*)(qp + ks * 16 + hh * 8);
  }
  const short one_or_zero = hh == 0 ? (short)0x3F80 : (short)0;
  const bf16x8 kone = {one_or_zero, 0, 0, 0, 0, 0, 0, 0};
  bf16x8 qm = {0, 0, 0, 0, 0, 0, 0, 0};
  int qr = 0, qc = 0, rsq = 0, cs = 0;
  const float* rpb = nullptr;
  if (MODE == 1 && rs0 >= 0) {
    const int tkn = qk - CTXL;
    qr = tkn >> 6;
    qc = tkn & 63;
    rsq = min(max(qr - 4, 0), 248);
    cs = min(max(qc - 8, 0), 48);
    rpb = p.rpb + ((size_t)(l * 8 + h)) * 15 * 31;
  }
  f32x16 o[2];
#pragma unroll
  for (int e = 0; e < 16; e++) { o[0][e] = 0.f; o[1][e] = 0.f; }
  float lsum = 0.f;
  float m = 0.f;
  const bf16x8 ones = {(short)0x3F80, (short)0x3F80, (short)0x3F80, (short)0x3F80,
                       (short)0x3F80, (short)0x3F80, (short)0x3F80, (short)0x3F80};

#define KGEO(i)                                                                                          \
  uint32_t kof##i, kmu##i;                                                                               \
  int kls##i;                                                                                            \
  {                                                                                                      \
    const int c = tid + 256 * (i);                                                                       \
    const int row = c / CPR, cc = c - row * CPR;                                                         \
    if (MODE == 0 && cc >= 8) {                                                                          \
      kof##i = (uint32_t)(O_KRR + ((size_t)(b * KPB + row) * 32 + (cc - 8) * 8) * 2);                    \
      kmu##i = 64u;                                                                                      \
    } else {                                                                                             \
      kof##i = (uint32_t)((MODE == 0 ? O_KN : O_KNA) + ((size_t)(b * KPB + row) * 512 + h * 64 + cc * 8) * 2); \
      kmu##i = 1024u;                                                                                    \
    }                                                                                                    \
    kls##i = row * KSTR + cc * 8;                                                                        \
  }
#define VGEO(i)                                                                                          \
  uint32_t vof##i;                                                                                       \
  int vls##i;                                                                                            \
  bool vsx##i;                                                                                           \
  {                                                                                                      \
    const int c = tid + 256 * (i);                                                                       \
    const int d = c >> 3, cc = c & 7;                                                                    \
    vof##i = (uint32_t)((MODE == 0 ? O_VMT : O_VNAT) + ((size_t)(b * 512 + h * 64 + d) * KPB + cc * 8) * 2); \
    vls##i = d * 72 + cc * 8;                                                                            \
    vsx##i = (d & 8) != 0;                                                                               \
  }
  KGEO(0) KGEO(1) KGEO(2) VGEO(0) VGEO(1)
  (void)kof2; (void)kmu2; (void)kls2;
  u32x4 kr0A, kr1A, kr2A, vr0A, vr1A, kr0B, kr1B, kr2B, vr0B, vr1B;
  kr2A = kr1A = kr0A = vr0A = vr1A = kr2B = kr1B = kr0B = vr0B = vr1B = (u32x4){0u, 0u, 0u, 0u};
#define TILE_KK0(t) ((MODE == 1 && (t) >= 4) ? (uint32_t)(CTXL + 64 * min(rs0 + (t)-4, 255)) : (uint32_t)(64 * (t)))
#define LOAD_KV(t, S)                                                                   \
  {                                                                                     \
    const uint32_t kk0_ = TILE_KK0(t);                                                  \
    kr0##S = *(const u32x4*)(wsb + (size_t)(kof0 + kk0_ * kmu0));                       \
    kr1##S = *(const u32x4*)(wsb + (size_t)(kof1 + kk0_ * kmu1));                       \
    if (NKC == 3) kr2##S = *(const u32x4*)(wsb + (size_t)(kof2 + kk0_ * kmu2));         \
    vr0##S = *(const u32x4*)(wsb + (size_t)(vof0 + kk0_ * 2u));                         \
    vr1##S = *(const u32x4*)(wsb + (size_t)(vof1 + kk0_ * 2u));                         \
  }
#define STORE_V1(buf, i, srcv)                                                          \
  {                                                                                     \
    u32x4 sv_ = srcv;                                                                   \
    if (vsx##i) sv_ = (u32x4){sv_[2], sv_[3], sv_[0], sv_[1]};                          \
    *(u32x4*)(Vs + (buf)*64 * 72 + vls##i) = sv_;                                       \
  }
#define STORE_KV(buf, S)                                                                \
  {                                                                                     \
    *(u32x4*)(Ks + (buf)*64 * KSTR + kls0) = kr0##S;                                    \
    *(u32x4*)(Ks + (buf)*64 * KSTR + kls1) = kr1##S;                                    \
    if (NKC == 3) *(u32x4*)(Ks + (buf)*64 * KSTR + kls2) = kr2##S;                      \
    STORE_V1(buf, 0, vr0##S) STORE_V1(buf, 1, vr1##S)                                   \
  }
#define QK_TILE(kbuf, t)                                                                           \
  {                                                                                                \
    const u16* kb_ = Ks + (kbuf)*64 * KSTR + r * KSTR + hh * 8;                                    \
    {                                                                                              \
      f32x16 z_;                                                                                   \
      _Pragma("unroll") for (int e = 0; e < 16; e++) z_[e] = 0.f;                                  \
      sc[0] = __builtin_amdgcn_mfma_f32_32x32x16_bf16(kone, qm, z_, 0, 0, 0);                      \
      sc[1] = sc[0];                                                                               \
    }                                                                                              \
    _Pragma("unroll") for (int ks = 0; ks < NKS; ks++) {                                           \
      const bf16x8 kf0 = *(const bf16x8*)(kb_ + ks * 16);                                          \
      const bf16x8 kf1 = *(const bf16x8*)(kb_ + 32 * KSTR + ks * 16);                              \
      sc[0] = __builtin_amdgcn_mfma_f32_32x32x16_bf16(kf0, qf[ks], sc[0], 0, 0, 0);                \
      sc[1] = __builtin_amdgcn_mfma_f32_32x32x16_bf16(kf1, qf[ks], sc[1], 0, 0, 0);                \
    }                                                                                              \
    if (MODE == 1 && (t) >= 4) {                                                                   \
      const int kr_ = rs0 + (t)-4;                                                                 \
      const bool rowok = (kr_ >= rsq) && (kr_ < rsq + 8);                                          \
      const float* rp = rpb + (kr_ - qr + 7) * 31 + (15 - qc);                                     \
      _Pragma("unroll") for (int kb = 0; kb < 2; kb++) _Pragma("unroll") for (int e = 0; e < 16; e++) { \
        const int kc = kb * 32 + (e & 3) + 8 * (e >> 2) + 4 * hh;                                  \
        const bool valid = rowok && (kc >= cs) && (kc < cs + 16);                                  \
        float bias = 0.f;                                                                          \
        if (valid) bias = rp[kc];                                                                  \
        sc[kb][e] = valid ? sc[kb][e] + bias * LOG2E : -1e30f;                                     \
      }                                                                                            \
    }                                                                                              \
  }
#define TILE_MAX(tmax)                                                                             \
  {                                                                                                \
    tmax = sc[0][0];                                                                               \
    _Pragma("unroll") for (int e = 1; e < 16; e++) tmax = fmaxf(tmax, sc[0][e]);                   \
    _Pragma("unroll") for (int e = 0; e < 16; e++) tmax = fmaxf(tmax, sc[1][e]);                   \
    const uint32_t tu = __float_as_uint(tmax);                                                     \
    const auto sw = __builtin_amdgcn_permlane32_swap(tu, tu, false, false);                        \
    tmax = fmaxf(__uint_as_float(sw[0]), __uint_as_float(sw[1]));                                  \
  }
#define MOVE_REF(mnew_)                                                                            \
  {                                                                                                \
    const float mq_ = bf2f(f2bf(mnew_));                                                           \
    const float delta_ = mq_ - m;                                                                  \
    const float alpha = __builtin_amdgcn_exp2f(-delta_);                                           \
    m = mq_;                                                                                       \
    _Pragma("unroll") for (int e = 0; e < 16; e++) {                                               \
      o[0][e] *= alpha; o[1][e] *= alpha;                                                         \
      sc[0][e] -= delta_; sc[1][e] -= delta_;                                                      \
    }                                                                                              \
    lsum *= alpha;                                                                                 \
    qm[0] = (hh == 0) ? (short)f2bf(-m) : (short)0;                                                \
  }
#define SOFTMAX_PV(vbuf)                                                                           \
  {                                                                                                \
    const u16* vb_ = Vs + (vbuf)*64 * 72 + r * 72 + vsw;                                           \
    _Pragma("unroll") for (int kb = 0; kb < 2; kb++) _Pragma("unroll") for (int st = 0; st < 2; st++) { \
      u32x4 pu;                                                                                    \
      _Pragma("unroll") for (int q = 0; q < 4; q++) {                                              \
        const float p0_ = __builtin_amdgcn_exp2f(sc[kb][8 * st + 2 * q]);                          \
        const float p1_ = __builtin_amdgcn_exp2f(sc[kb][8 * st + 2 * q + 1]);                      \
        lsum += p0_ + p1_;                                                                         \
        pu[q] = pack2(p0_, p1_);                                                                   \
      }                                                                                            \
      const bf16x8 pbv = __builtin_bit_cast(bf16x8, pu);                                           \
      _Pragma("unroll") for (int db = 0; db < 2; db++) {                                           \
        const u16* vp = vb_ + db * 32 * 72 + kb * 32 + 16 * st;                                    \
        const bf16x4 vlo = *(const bf16x4*)(vp);                                                   \
        const bf16x4 vhi = *(const bf16x4*)(vp + 8);                                               \
        const bf16x8 vfv = __builtin_shufflevector(vlo, vhi, 0, 1, 2, 3, 4, 5, 6, 7);              \
        o[db] = __builtin_amdgcn_mfma_f32_32x32x16_bf16(vfv, pbv, o[db], 0, 0, 0);                 \
      }                                                                                            \
    }                                                                                              \
  }
#define DEFER_REF(tmax)                                                                            \
  if (__any(tmax > 8.f)) {                                                                         \
    const float mq_ = bf2f(f2bf(m + fmaxf(tmax, 0.f)));                                            \
    const float alpha = __builtin_amdgcn_exp2f(m - mq_);                                           \
    m = mq_;                                                                                       \
    _Pragma("unroll") for (int e = 0; e < 16; e++) { o[0][e] *= alpha; o[1][e] *= alpha; }       \
    lsum *= alpha;                                                                                 \
    qm[0] = (hh == 0) ? (short)f2bf(-m) : (short)0;                                                \
  }
#define ATT_STEP(t, LD, ST)                                        \
  {                                                                \
    const int cur = (t)&1;                                         \
    QK_TILE(cur, t)                                                \
    __builtin_amdgcn_sched_barrier(0);                             \
    LOAD_KV(min((t) + 2, tl), LD)                                  \
    __builtin_amdgcn_sched_barrier(0);                             \
    __builtin_amdgcn_s_setprio(1);                                 \
    SOFTMAX_PV(cur)                                                \
    __builtin_amdgcn_s_setprio(0);                                 \
    float tmax;                                                    \
    TILE_MAX(tmax)                                                 \
    DEFER_REF(tmax)                                                \
    STORE_KV(cur ^ 1, ST)                                          \
    __syncthreads();                                               \
  }

  const int tl = ntiles - 1;
  const int vsw = 4 * (hh ^ ((r >> 3) & 1));
  f32x16 sc[2];
  LOAD_KV(0, A)
  STORE_KV(0, A)
  LOAD_KV(min(1, tl), A)
  __syncthreads();
  {
    LOAD_KV(min(2, tl), B)
    __builtin_amdgcn_sched_barrier(0);
    QK_TILE(0, 0)
    float tmax;
    TILE_MAX(tmax)
    MOVE_REF(tmax)
    SOFTMAX_PV(0)
    STORE_KV(1, A)
    __syncthreads();
  }
  for (int t = 1; t + 1 < ntiles; t += 2) {
    ATT_STEP(t, A, B)
    ATT_STEP(t + 1, B, A)
  }
  ATT_STEP(tl, A, B)
  const float inv = 1.f / (lsum + __shfl_xor(lsum, 32));
  u16* yp = wsp<u16>(p, O_Y) + qrow * 1536 + ycol + h * 64;
#pragma unroll
  for (int db = 0; db < 2; db++)
#pragma unroll
    for (int gp = 0; gp < 2; gp++) {
      uint2 oa, ob;
      oa.x = pack2(o[db][8 * gp] * inv, o[db][8 * gp + 1] * inv);
      oa.y = pack2(o[db][8 * gp + 2] * inv, o[db][8 * gp + 3] * inv);
      ob.x = pack2(o[db][8 * gp + 4] * inv, o[db][8 * gp + 5] * inv);
      ob.y = pack2(o[db][8 * gp + 6] * inv, o[db][8 * gp + 7] * inv);
      *(uint4*)(yp + db * 32 + 8 * (2 * gp + hh)) = pair_swap(oa, ob);
    }
#undef KGEO
#undef VGEO
#undef TILE_KK0
#undef LOAD_KV
#undef STORE_V1
#undef STORE_KV
#undef QK_TILE
#undef TILE_MAX
#undef MOVE_REF
#undef SOFTMAX_PV
#undef ATT_STEP
#undef DEFER_REF
}

__device__ void phase_p3(const Params& p, int l, bool last, int bid, int nb, u16* smem) {
  EPI_DECL
  const int nMLA = 2048, nNA = 2048, nFB = 1024;
  const int nC = last ? 0 : (32 + 32 + 16);
  const int total = nMLA + nNA + nFB + nC;
  for (int t = bid; t < total; t += nb) {
    int kind, b = 0, h = 0, q0 = 0, ntl = 0, rs0 = -1;
    size_t aoff = 0, boff = 0;
    int Kf = 256, j0 = 0, tok0 = 0, tokmul = 1, colbase = 0;
    if (t < nMLA) {
      kind = 0;
      h = t & 7;
      const int rest = t >> 3;
      b = rest >> 7;
      q0 = CTXL + (rest & 127) * 128;
      ntl = 260;
    } else if (t < nMLA + nNA) {
      kind = 1;
      const int t2 = t - nMLA;
      h = t2 & 7;
      const int rest = t2 >> 3, rp = rest & 127;
      b = rest >> 7;
      rs0 = min(max(2 * rp - 4, 0), 248);
      const int rs1 = min(max(2 * rp + 1 - 4, 0), 248);
      q0 = CTXL + rp * 128;
      ntl = (4 + (rs1 + 8 - rs0) + 1) & ~1;
    } else if (t < nMLA + nNA + nFB) {
      kind = 2;
      const int rt = t - nMLA - nNA;
      const int bk = rt >> 2;
      j0 = (rt & 3) * 128;
      b = bk >> 7;
      tok0 = CTXL + (bk & 127);
      tokmul = 128;
      aoff = O_D2 + (size_t)rt * 128 * 256 * 2;
      boff = O_MB;
      Kf = 256;
    } else {
      const int t2 = t - nMLA - nNA - nFB;
      if (t2 < 64) {
        kind = t2 >> 5;
        const int t3 = t2 & 31;
        h = t3 & 7;
        b = (t3 >> 3) & 1;
        q0 = (t3 >> 4) * 128;
        ntl = 4;
      } else {
        kind = 2;
        const int t3 = t2 - 64;
        const int rt = t3 >> 1, ct = t3 & 1;
        b = rt >> 2;
        j0 = (rt & 3) * 128;
        colbase = ct * 128;
        aoff = O_D1C + (size_t)rt * 128 * 512 * 2;
        boff = O_MC + (size_t)ct * 128 * 512 * 2;
        Kf = 512;
      }
    }
    if (kind == 0) {
      attn_item<0>(p, l, b, h, q0, ntl, -1, 1024, smem);
    } else if (kind == 1) {
      attn_item<1>(p, l, b, h, q0, ntl, rs0, 512, smem);
    } else {
      f32x16 acc[2][2];
      zero_acc(acc);
      gemm_core(acc, wsp<u16>(p, aoff), Kf, wsp<u16>(p, boff), Kf, Kf, smem);
      u16* Y = wsp<u16>(p, O_Y);
#pragma unroll
      for (int i = 0; i < 2; i++)
#pragma unroll
        for (int j = 0; j < 2; j++)
#pragma unroll
          for (int gp = 0; gp < 2; gp++) {
            const int jj = j0 + wm_ * 64 + i * 32 + 8 * (2 * gp + hh_);
            const int tok = tok0 + (colbase + wn_ * 64 + j * 32 + r_) * tokmul;
            uint2 oa, ob;
            oa.x = pack2(acc[i][j][8 * gp], acc[i][j][8 * gp + 1]);
            oa.y = pack2(acc[i][j][8 * gp + 2], acc[i][j][8 * gp + 3]);
            ob.x = pack2(acc[i][j][8 * gp + 4], acc[i][j][8 * gp + 5]);
            ob.y = pack2(acc[i][j][8 * gp + 6], acc[i][j][8 * gp + 7]);
            *(uint4*)(Y + ((size_t)b * KPB + tok) * 1536 + jj) = pair_swap(oa, ob);
          }
    }
  }
}

__device__ __forceinline__ int n_row_tiles(bool last) { return last ? NRT - 4 : NRT; }
__device__ __forceinline__ int row_tile(bool last, int i) {
  if (!last) return i;
  return i < 128 ? i + 2 : i + 4;
}

__device__ void phase_p4(const Params& p, int l, bool last, int bid, int nb, u16* smem) {
  EPI_DECL
  const u16* A = wsp<u16>(p, O_A);
  const u16* Y = wsp<u16>(p, O_Y);
  u16* M = wsp<u16>(p, O_M);
  uint4* stash = wsp<uint4>(p, O_QM) + (size_t)bid * 24 * 256 + ltid();
  const int nrt_ = n_row_tiles(last);
  PATCH_LOOP_BEGIN(nrt_, 8, 8, 8)
    const int rt = row_tile(last, prt), ct = pct;
    f32x16 mg[2][2];
    zero_acc(mg);
#pragma unroll 1
    for (int g = 0; g < 3; g++) {
      uint32_t gp[2][2][8];
      {
        f32x16 acc[2][2];
        zero_acc(acc);
        gemm_core<true>(acc, wsp<u16>(p, O_WG) + (size_t)(g * 1024 + ct * 128) * D, D, A + (size_t)rt * 128 * D, D, D,
                        smem);
#pragma unroll
        for (int i = 0; i < 2; i++)
#pragma unroll
          for (int j = 0; j < 2; j++)
#pragma unroll
            for (int e = 0; e < 8; e++)
              gp[i][j][e] = pack2(fsigmoid(acc[i][j][2 * e]), fsigmoid(acc[i][j][2 * e + 1]));
      }
      {
        f32x16 acc[2][2];
        zero_acc(acc);
        gemm_core<false>(acc, wsp<u16>(p, O_WB) + (size_t)(g * 1024 + ct * 128) * 512, 512,
                         Y + (size_t)rt * 128 * 1536 + g * 512, 1536, 512, smem);
#pragma unroll
        for (int i = 0; i < 2; i++)
#pragma unroll
          for (int j = 0; j < 2; j++)
#pragma unroll
            for (int e = 0; e < 8; e++) {
              mg[i][j][2 * e] += __uint_as_float(gp[i][j][e] << 16) * acc[i][j][2 * e];
              mg[i][j][2 * e + 1] += __uint_as_float(gp[i][j][e] & 0xffff0000u) * acc[i][j][2 * e + 1];
            }
      }
    }
#pragma unroll
    for (int i = 0; i < 2; i++)
#pragma unroll
      for (int j = 0; j < 2; j++)
#pragma unroll
        for (int gp = 0; gp < 2; gp++) {
          const int row = rt * 128 + wn_ * 64 + j * 32 + r_;
          const int col = ct * 128 + wm_ * 64 + i * 32 + 8 * (2 * gp + hh_);
          uint2 oa, ob;
          oa.x = pack2(mg[i][j][8 * gp], mg[i][j][8 * gp + 1]);
          oa.y = pack2(mg[i][j][8 * gp + 2], mg[i][j][8 * gp + 3]);
          ob.x = pack2(mg[i][j][8 * gp + 4], mg[i][j][8 * gp + 5]);
          ob.y = pack2(mg[i][j][8 * gp + 6], mg[i][j][8 * gp + 7]);
          *(uint4*)(M + (size_t)row * D + col) = pair_swap(oa, ob);
        }
  PATCH_LOOP_END
}

__device__ void phase_resid(const Params& p, int l, bool last, const u16* Ain, size_t lda, const u16* W, int K,
                            int bid, int nb, u16* smem) {
  EPI_DECL
  const int nrt_ = n_row_tiles(last);
  PATCH_LOOP_BEGIN(nrt_, 8, 8, 8)
    const int rt = row_tile(last, prt), ct = pct;
    f32x16 acc[2][2];
    zero_acc(acc);
    gemm_core(acc, W + (size_t)ct * 128 * K, K, Ain + (size_t)rt * 128 * lda, lda, K, smem);
    u16* FB = wsp<u16>(p, O_FB);
#pragma unroll
    for (int i = 0; i < 2; i++)
#pragma unroll
      for (int j = 0; j < 2; j++)
#pragma unroll
        for (int gp = 0; gp < 2; gp++) {
          const int row = rt * 128 + wn_ * 64 + j * 32 + r_;
          const int col = ct * 128 + wm_ * 64 + i * 32 + 8 * (2 * gp + hh_);
          uint2 oa, ob;
          oa.x = pack2(acc[i][j][8 * gp], acc[i][j][8 * gp + 1]);
          oa.y = pack2(acc[i][j][8 * gp + 2], acc[i][j][8 * gp + 3]);
          ob.x = pack2(acc[i][j][8 * gp + 4], acc[i][j][8 * gp + 5]);
          ob.y = pack2(acc[i][j][8 * gp + 6], acc[i][j][8 * gp + 7]);
          *(uint4*)(FB + (size_t)row * D + col) = pair_swap(oa, ob);
        }
  PATCH_LOOP_END
}

__device__ void phase_p7(const Params& p, int l, bool last, int bid, int nb, u16* smem) {
  EPI_DECL
  const u16* A = wsp<u16>(p, O_A);
  u16* HH = wsp<u16>(p, O_HH);
  const int nrt_ = n_row_tiles(last);
  PATCH_LOOP_BEGIN(nrt_, 44, 16, 4)
    const int rt = row_tile(last, prt), ct = pct;
    f32x16 acc[2][2];
    zero_acc(acc);
    gemm_core(acc, wsp<u16>(p, O_WGU) + (size_t)ct * 128 * D, D, A + (size_t)rt * 128 * D, D, D, smem);
#pragma unroll
    for (int j = 0; j < 2; j++)
#pragma unroll
      for (int gp = 0; gp < 2; gp++) {
        const int row = rt * 128 + wn_ * 64 + j * 32 + r_;
        const int q = (ct * 2 + wm_) * 32 + 8 * (2 * gp + hh_);
        float hv[8];
#pragma unroll
        for (int t = 0; t < 8; t++) {
          const float gt = acc[0][j][8 * gp + t], up = acc[1][j][8 * gp + t];
          hv[t] = gt * fsigmoid(gt) * up;
        }
        uint2 oa, ob;
        oa.x = pack2(hv[0], hv[1]);
        oa.y = pack2(hv[2], hv[3]);
        ob.x = pack2(hv[4], hv[5]);
        ob.y = pack2(hv[6], hv[7]);
        *(uint4*)(HH + (size_t)row * FH + q) = pair_swap(oa, ob);
      }
  PATCH_LOOP_END
}

constexpr int NPHASE = 3 + 9 * 2;

__device__ void run_phase(const Params& p, int ph, int bid, int nb, u16* smem) {
  if (ph == 0) {
    prep_tables(p, bid, nb);
    prep_modp(p, bid, nb);
    prep_weights(p, 0, bid, nb, smem);
    return;
  }
  if (ph == 1) { prep_modr(p, bid, nb); return; }
  if (ph == 2) { ln_phase(p, 0, p.ln_in_g, p.ln_in_b, 0, 0, 1024, false, bid, nb); return; }
  const int l = (ph - 3) / 9, s = (ph - 3) % 9;
  const bool last = (l == 1);
  switch (s) {
    case 0: phase_p1(p, l, last, bid, nb, smem); break;
    case 1: phase_p2(p, l, bid, nb, smem); break;
    case 2: phase_p3(p, l, last, bid, nb, smem); break;
    case 3: phase_p4(p, l, last, bid, nb, smem); break;
    case 4: phase_resid(p, l, last, wsp<u16>(p, O_M), D, wsp<u16>(p, O_WO), D, bid, nb, smem); break;
    case 5: ln_phase(p, 1, p.ln1_g + l * D, p.ln1_b + l * D, l, 3072, 4096, last, bid, nb, l, 2048); break;
    case 6: phase_p7(p, l, last, bid, nb, smem); break;
    case 7: phase_resid(p, l, last, wsp<u16>(p, O_HH), FH, wsp<u16>(p, O_WD), FH, bid, nb, smem); break;
    default:
      ln_phase(p, 1, p.ln2_g + l * D, p.ln2_b + l * D, last ? -1 : l + 1, 0, 1024, last, bid, nb, l, 5120);
      if (!last) prep_weights(p, l + 1, bid, nb, smem);
      break;
  }
}


#define XB_TMO      128
#define XB_XCNT(j)  (256  + 64 * (j))
#define XB_XSUB(j)  (1280 + 64 * (j))
#define XB_XGEN(j)  (2304 + 64 * (j))
#define XB_TOP      3328
#define XB_TOPGEN   3392
#define XCD_BAR_WORDS 3456
#define XB_SPIN_CAP (1u << 20)
#define LAS __attribute__((address_space(3)))
__device__ __forceinline__ unsigned xb_ld(unsigned* p) { return __hip_atomic_load(p, __ATOMIC_RELAXED, __HIP_MEMORY_SCOPE_AGENT); }
__device__ __forceinline__ unsigned xb_add(unsigned* p, unsigned v) { return __hip_atomic_fetch_add(p, v, __ATOMIC_RELAXED, __HIP_MEMORY_SCOPE_AGENT); }
__device__ __forceinline__ unsigned xb_xcc_id() { return (unsigned)__builtin_amdgcn_s_getreg((3 << 11) | 20) & 0xFu; }
#define XB_SPIN(cond, bar) do { unsigned _sp = 0; while (cond) { __builtin_amdgcn_s_sleep(1); \
    if ((++_sp & 255u) == 0u) { if (xb_ld(&(bar)[XB_TMO])) break; if (_sp > XB_SPIN_CAP) { atomicAdd(&(bar)[XB_TMO], 1u); break; } } } } while (0)
struct XcdBarrier {
  unsigned* bar; unsigned x;
  volatile LAS unsigned* st;
};
__device__ __forceinline__ XcdBarrier xcd_barrier_post(unsigned* bar, volatile LAS unsigned* st) {
  XcdBarrier b; b.bar = bar; b.x = xb_xcc_id(); b.st = st;
  if (threadIdx.x == 0) (void)xb_add(&bar[XB_XCNT(b.x)], 1u);
  return b;
}
__device__ __forceinline__ void xcd_barrier_complete(unsigned* bar, unsigned x, unsigned& nloc, unsigned& nx) {
  const unsigned G = gridDim.x * gridDim.y * gridDim.z;
  unsigned sum, cnt, mine, sp = 0u;
  for (;;) {
    sum = 0u; cnt = 0u; mine = 0u;
#pragma unroll
    for (unsigned j = 0; j < 16; ++j) { const unsigned c = xb_ld(&bar[XB_XCNT(j)]); sum += c; cnt += (c > 0u) ? 1u : 0u; mine = (j == x) ? c : mine; }
    if (sum == G) break;
    __builtin_amdgcn_s_sleep(1);
    if ((++sp & 255u) == 0u) { if (xb_ld(&bar[XB_TMO])) break; if (sp > XB_SPIN_CAP) { atomicAdd(&bar[XB_TMO], 1u); break; } }
  }
  nloc = mine > 0u ? mine : 1u; nx = cnt > 0u ? cnt : 1u;
}
__device__ __forceinline__ void xcd_barrier(const XcdBarrier& b) {
  asm volatile("s_waitcnt vmcnt(0)" ::: "memory");
  __syncthreads();
  if (threadIdx.x == 0) {
    unsigned* bar = b.bar;
    __builtin_amdgcn_s_waitcnt(0);
    unsigned nloc = b.st[0], nx = b.st[1];
    if (nloc == 0u) { xcd_barrier_complete(bar, b.x, nloc, nx); b.st[0] = nloc; b.st[1] = nx; }
    const unsigned old = xb_add(&bar[XB_XSUB(b.x)], 1u);
    const unsigned gen = old / nloc;
    if (old + 1u == (gen + 1u) * nloc) {
      __builtin_amdgcn_fence(__ATOMIC_RELEASE, "agent");
      asm volatile("s_waitcnt vmcnt(0)" ::: "memory");
      const unsigned og = xb_add(&bar[XB_TOP], 1u);
      const unsigned tg = og / nx;
      if (og + 1u == (tg + 1u) * nx) xb_add(&bar[XB_TOPGEN], 1u);
      else XB_SPIN(xb_ld(&bar[XB_TOPGEN]) == tg, bar);
      __builtin_amdgcn_fence(__ATOMIC_ACQUIRE, "agent");
      xb_add(&bar[XB_XGEN(b.x)], 1u);
      asm volatile("s_waitcnt vmcnt(0)" ::: "memory");
    } else {
      XB_SPIN(xb_ld(&bar[XB_XGEN(b.x)]) == gen, bar);
      __builtin_amdgcn_fence(__ATOMIC_ACQUIRE, "agent");
      asm volatile("s_waitcnt vmcnt(0)" ::: "memory");
    }
  }
  __syncthreads();
}

constexpr int SMEM_ELEMS = 4 * SM_A + 256 + 8;

#if COOP
__global__ void __launch_bounds__(256, 2) mega_kernel(Params p) {
  __shared__ __attribute__((aligned(16))) u16 smem[SMEM_ELEMS];
  cg::grid_group grid = cg::this_grid();
  volatile LAS unsigned* st = (volatile LAS unsigned*)(smem + 4 * SM_A + 256);
  if (threadIdx.x == 0) { st[0] = 0u; st[1] = 0u; }
  __syncthreads();
  XcdBarrier xb = xcd_barrier_post((unsigned*)(p.ws + O_BAR), st);
  for (int ph = 0; ph < NPHASE; ph++) {
#ifdef PROBE_MASK
    const int s9 = ph >= 3 ? (ph - 3) % 9 : -1;
    const int nrep = (s9 >= 0 && ((PROBE_MASK >> s9) & 1)) ? 2 : 1;
    for (int rep = 0; rep < nrep; rep++) {
      run_phase(p, ph, blockIdx.x, gridDim.x, smem);
      if (ph == 0) grid.sync();
      else if (ph + 1 < NPHASE || rep + 1 < nrep) xcd_barrier(xb);
    }
#else
    run_phase(p, ph, blockIdx.x, gridDim.x, smem);
    if (ph == 0) grid.sync();
    else if (ph + 1 < NPHASE) xcd_barrier(xb);
#endif
  }
}
#else
__global__ void __launch_bounds__(256, 2) phase_kernel(Params p, int ph) {
  __shared__ __attribute__((aligned(16))) u16 smem[SMEM_ELEMS];
  run_phase(p, ph, blockIdx.x, gridDim.x, smem);
}
#endif

extern "C" void kernel_launch(void* const* d_in, const int* in_sizes, int n_in, void* d_out, int out_size, void* d_ws,
                              size_t ws_size, hipStream_t stream) {
  Params p{};
  const float** f = (const float**)&p;
  for (int i = 0; i < 25; i++) f[i] = (const float*)d_in[i];
  p.out = (float*)d_out;
  p.ws = (unsigned char*)d_ws;
  if (ws_size < O_WSEND) fprintf(stderr, "workspace too small: %zu < %zu\n", ws_size, (size_t)O_WSEND);
#if COOP
  static int grid_blocks = 0;
  if (!grid_blocks) {
    int dev = 0, cus = 0, per_cu = 0;
    hipGetDevice(&dev);
    hipDeviceGetAttribute(&cus, hipDeviceAttributeMultiprocessorCount, dev);
    hipOccupancyMaxActiveBlocksPerMultiprocessor(&per_cu, mega_kernel, 256, 0);
    if (per_cu > 2) per_cu = 2;
    grid_blocks = cus * per_cu;
  }
  (void)hipMemsetAsync(p.ws + O_BAR, 0, 3456 * 4, stream);
  void* args[] = {&p};
  hipError_t e = hipLaunchCooperativeKernel((void*)mega_kernel, dim3(grid_blocks), dim3(256), args, 0, stream);
  if (e != hipSuccess) fprintf(stderr, "cooperative launch failed: %s (grid %d)\n", hipGetErrorString(e), grid_blocks);
#else
  for (int ph = 0; ph < NPHASE; ph++) phase_kernel<<<512, 256, 0, stream>>>(p, ph);
#endif
}
```

```cpp
#include <hip/hip_runtime.h>
#include <hip/hip_cooperative_groups.h>
#include <stdint.h>
#include <cstdio>
namespace cg = cooperative_groups;

#ifndef COOP
#define COOP 1
#endif

typedef __attribute__((ext_vector_type(8))) short bf16x8;
typedef __attribute__((ext_vector_type(4))) short bf16x4;
typedef __attribute__((ext_vector_type(16))) float f32x16;
typedef unsigned short u16;
typedef __attribute__((ext_vector_type(4))) unsigned int u32x4;

constexpr int D = 1024;
constexpr int NBATCH = 2;
constexpr int SEQ = 16384;
constexpr int CTXL = 256;
constexpr int KPB = SEQ + CTXL;
constexpr int T = NBATCH * KPB;
constexpr int NRT = T / 128;
constexpr int FH = 2816;
constexpr int IN_DIM = 5536;
constexpr float LOG2E = 1.4426950408889634f;
constexpr float NA_SCALE_L2 = 0.125f * LOG2E;
constexpr float MLA_SCALE_L2 = 0.10206207261596575f * LOG2E;
constexpr float ALPHA = 1.4142135623730951f;
constexpr float EPS = 1e-5f;
constexpr float RS128 = 0.08838834764831845f;

constexpr size_t al256(size_t x) { return (x + 255) & ~(size_t)255; }
constexpr size_t O_WF = 0;
constexpr size_t O_WP = O_WF + (size_t)1024 * 1024 * 2;
constexpr size_t O_WG = O_WP + (size_t)2048 * 1024 * 2;
constexpr size_t O_WUQ = O_WG + (size_t)3072 * 1024 * 2;
constexpr size_t O_WUKV = O_WUQ + (size_t)768 * 256 * 2;
constexpr size_t O_WB = O_WUKV + (size_t)1024 * 128 * 2;
constexpr size_t O_WO = O_WB + (size_t)3 * 1024 * 512 * 2;
constexpr size_t O_WGU = O_WO + (size_t)1024 * 1024 * 2;
constexpr size_t O_WD = O_WGU + (size_t)5632 * 1024 * 2;
constexpr size_t O_MA = O_WD + (size_t)1024 * 2816 * 2;
constexpr size_t O_MB = O_MA + (size_t)256 * 256 * 2;
constexpr size_t O_MC = O_MB + (size_t)128 * 256 * 2;
constexpr size_t O_TW = O_MC + (size_t)256 * 512 * 2;
constexpr size_t O_MODP = O_TW + (size_t)128 * 128 * 2 * 4;
constexpr size_t O_MOD = O_MODP + (size_t)16 * 2 * 3 * 6144 * 4;
constexpr size_t O_XCTX = O_MOD + (size_t)2 * 3 * 6144 * 4;
constexpr size_t O_D1C = O_XCTX + (size_t)512 * 1024 * 4;
constexpr size_t O_A = O_D1C + (size_t)2 * 512 * 2 * 256 * 2;
constexpr size_t O_RQ = O_A + (size_t)T * 1024 * 2;
constexpr size_t O_QNA = O_RQ;
constexpr size_t O_KNA = O_QNA + (size_t)T * 512 * 2;
constexpr size_t O_VNAT = O_KNA + (size_t)T * 512 * 2;
constexpr size_t O_RY = O_VNAT + (size_t)T * 512 * 2;
constexpr size_t O_Y = O_RY;
constexpr size_t O_D1 = O_RY;
constexpr size_t O_LAT = O_RY + (size_t)67108864;
constexpr size_t O_D2 = O_RY + (size_t)T * 1536 * 2;
constexpr size_t O_QM = O_D2 + (size_t)67108864;
constexpr size_t O_KN = O_QM + (size_t)T * 768 * 2;
constexpr size_t O_KRR = O_KN + (size_t)T * 512 * 2;
constexpr size_t O_VMT = O_KRR + (size_t)T * 32 * 2;
constexpr size_t O_END = O_VMT + (size_t)T * 512 * 2;
constexpr size_t O_BAR = (O_END + 255) & ~(size_t)255;
constexpr size_t O_WSEND = O_BAR + 3456 * 4;
constexpr size_t O_FB = O_QM;
constexpr size_t O_M = O_RQ;
constexpr size_t O_HH = O_RQ;

struct Params {
  const float *x, *c, *ctx, *c_ctx, *ln_in_g, *ln_in_b, *w_mod, *b_mod, *w_in, *gq, *gkv, *w_uq, *w_qr, *w_uk,
      *w_uv, *rpb, *w_branch, *w_out, *ln1_g, *ln1_b, *ln2_g, *ln2_b, *w_gate, *w_up, *w_down;
  float* out;
  unsigned char* ws;
};

__device__ __forceinline__ u16 f2bf(float f) {
  uint32_t u = __float_as_uint(f);
  u += 0x7fffu + ((u >> 16) & 1u);
  return (u16)(u >> 16);
}
typedef __attribute__((ext_vector_type(2))) __bf16 bf16v2;
typedef __attribute__((ext_vector_type(2))) float f32v2;
__device__ __forceinline__ uint32_t pack2(float a, float b) {
  const f32v2 v = {a, b};
  return __builtin_bit_cast(uint32_t, __builtin_convertvector(v, bf16v2));
}
__device__ __forceinline__ uint4 pair_swap(uint2 a, uint2 b) {
  const auto rx = __builtin_amdgcn_permlane32_swap(a.x, b.x, false, false);
  const auto ry = __builtin_amdgcn_permlane32_swap(a.y, b.y, false, false);
  return make_uint4(rx[0], ry[0], rx[1], ry[1]);
}
__device__ __forceinline__ float bf2f(u16 v) { return __uint_as_float(((uint32_t)v) << 16); }
__device__ __forceinline__ float wsum(float v) {
#pragma unroll
  for (int o = 32; o > 0; o >>= 1) v += __shfl_xor(v, o);
  return v;
}
__device__ __forceinline__ float fsigmoid(float v) { return 1.f / (1.f + __expf(-v)); }

__device__ __forceinline__ int ltid() {
  int t = threadIdx.x;
  asm volatile("" : "+v"(t));
  return t;
}

template <typename Tp>
__device__ __forceinline__ Tp* wsp(const Params& p, size_t off) { return (Tp*)(p.ws + off); }

__device__ __forceinline__ float* xrow(const Params& p, int row) {
  int b = row / KPB, kk = row - b * KPB;
  if (kk < CTXL) return wsp<float>(p, O_XCTX) + (size_t)(b * CTXL + kk) * D;
  return p.out + (size_t)(b * SEQ + kk - CTXL) * D;
}

constexpr int LSTR = 72;
constexpr int SM_A = 128 * LSTR;

template <bool DEEP = true>
__device__ __forceinline__ void gemm_core(f32x16 (&acc)[2][2], const u16* __restrict__ A, size_t lda,
                                          const u16* __restrict__ B, size_t ldb, int K, u16* smem) {
  const int tid = ltid(), lane = tid & 63, wave = tid >> 6;
  const int wm = wave >> 1, wn = wave & 1, r = lane & 31, hh = lane >> 5;
  u16* sA = smem;
  u16* sB = smem + 2 * SM_A;
  const int lrow = tid >> 3, lkc = (tid & 7) * 8;
  const unsigned char* gab = (const unsigned char*)A;
  const unsigned char* gbb = (const unsigned char*)B;
  uint32_t oa[4], ob[4];
#pragma unroll
  for (int i = 0; i < 4; i++) {
    oa[i] = (uint32_t)(((size_t)(lrow + 32 * i) * lda + lkc) * 2);
    ob[i] = (uint32_t)(((size_t)(lrow + 32 * i) * ldb + lkc) * 2);
  }
  u16* wa = sA + lrow * LSTR + lkc;
  u16* wb = sB + lrow * LSTR + lkc;
  const u16* pa = sA + (wm * 64 + r) * LSTR + hh * 8;
  const u16* pb = sB + (wn * 64 + r) * LSTR + hh * 8;
  u32x4 a0r[4], b0r[4], a1r[4], b1r[4];
#define G_LOAD(ar, br, ko)                                               \
  _Pragma("unroll") for (int i = 0; i < 4; i++) {                        \
    ar[i] = *(const u32x4*)(gab + (size_t)(ko)*2 + oa[i]);               \
    br[i] = *(const u32x4*)(gbb + (size_t)(ko)*2 + ob[i]);               \
  }
#define G_STORE(ar, br, buf)                                             \
  _Pragma("unroll") for (int i = 0; i < 4; i++) {                        \
    *(u32x4*)(wa + (buf)*SM_A + 32 * i * LSTR) = ar[i];                  \
    *(u32x4*)(wb + (buf)*SM_A + 32 * i * LSTR) = br[i];                  \
  }
#define G_COMPUTE(buf)                                                                   \
  _Pragma("unroll") for (int ks = 0; ks < 4; ks++) {                                     \
    const bf16x8 fa0 = *(const bf16x8*)(pa + (buf)*SM_A + ks * 16);                      \
    const bf16x8 fa1 = *(const bf16x8*)(pa + (buf)*SM_A + 32 * LSTR + ks * 16);          \
    const bf16x8 fb0 = *(const bf16x8*)(pb + (buf)*SM_A + ks * 16);                      \
    const bf16x8 fb1 = *(const bf16x8*)(pb + (buf)*SM_A + 32 * LSTR + ks * 16);          \
    acc[0][0] = __builtin_amdgcn_mfma_f32_32x32x16_bf16(fa0, fb0, acc[0][0], 0, 0, 0);   \
    acc[0][1] = __builtin_amdgcn_mfma_f32_32x32x16_bf16(fa0, fb1, acc[0][1], 0, 0, 0);   \
    acc[1][0] = __builtin_amdgcn_mfma_f32_32x32x16_bf16(fa1, fb0, acc[1][0], 0, 0, 0);   \
    acc[1][1] = __builtin_amdgcn_mfma_f32_32x32x16_bf16(fa1, fb1, acc[1][1], 0, 0, 0);   \
  }
  const int nk = K >> 6;
  if (DEEP) {
    G_LOAD(a0r, b0r, 0)
    G_LOAD(a1r, b1r, 64)
    G_STORE(a0r, b0r, 0)
    __syncthreads();
    const int klast = (nk - 1) * 64;
    G_LOAD(a0r, b0r, min(128, klast))
    for (int kt = 0; kt < nk; kt += 2) {
      G_COMPUTE(0)
      G_STORE(a1r, b1r, 1)
      __syncthreads();
      G_LOAD(a1r, b1r, min((kt + 3) * 64, klast))
      __builtin_amdgcn_sched_barrier(0);
      G_COMPUTE(1)
      G_STORE(a0r, b0r, 0)
      __syncthreads();
      G_LOAD(a0r, b0r, min((kt + 4) * 64, klast))
      __builtin_amdgcn_sched_barrier(0);
    }
  } else {
    G_LOAD(a0r, b0r, 0)
    G_STORE(a0r, b0r, 0)
    __syncthreads();
    for (int kt = 0; kt < nk; kt += 2) {
      G_LOAD(a0r, b0r, (kt + 1) * 64)
      G_COMPUTE(0)
      G_STORE(a0r, b0r, 1)
      __syncthreads();
      if (kt + 2 < nk) G_LOAD(a0r, b0r, (kt + 2) * 64)
      G_COMPUTE(1)
      if (kt + 2 < nk) G_STORE(a0r, b0r, 0)
      __syncthreads();
    }
  }
#undef G_LOAD
#undef G_STORE
#undef G_COMPUTE
}

__device__ __forceinline__ void zero_acc(f32x16 (&acc)[2][2]) {
#pragma unroll
  for (int i = 0; i < 2; i++)
#pragma unroll
    for (int j = 0; j < 2; j++)
#pragma unroll
      for (int e = 0; e < 16; e++) acc[i][j][e] = 0.f;
}

#define EPI_DECL                                                     \
  const int lane_ = ltid() & 63, wave_ = ltid() >> 6;      \
  const int wm_ = wave_ >> 1, wn_ = wave_ & 1, r_ = lane_ & 31, hh_ = lane_ >> 5; \
  (void)wm_; (void)wn_; (void)r_; (void)hh_;

__device__ __forceinline__ const float* src_col(const Params& p, int l, int kind, int n, int& ld) {
  switch (kind) {
    case 0:
      ld = IN_DIM;
      return n < 1952 ? p.w_in + (size_t)l * D * IN_DIM + 512 + n : nullptr;
    case 1:
      ld = IN_DIM;
      return p.w_in + (size_t)l * D * IN_DIM + 2464 + n;
    case 2:
      if (n < 512) {
        ld = 512;
        return p.w_uq + (size_t)l * 256 * 512 + n;
      } else {
        int m = n - 512, wt = m >> 6, jb = (m >> 5) & 1, idx = wt * 32 + (m & 31);
        int h = idx >> 4, e = idx & 15;
        ld = 256;
        return p.w_qr + (size_t)l * 256 * 256 + h * 32 + jb * 16 + e;
      }
    case 3:
      ld = 512;
      return n < 512 ? p.w_uk + (size_t)l * 128 * 512 + n : p.w_uv + (size_t)l * 128 * 512 + (n - 512);
    case 4: {
      int g = n >> 10, nn = n & 1023;
      ld = 1024;
      return p.w_branch + ((size_t)(l * 3 + g) * 512) * 1024 + nn;
    }
    case 5:
      ld = 1024;
      return p.w_out + (size_t)l * D * D + n;
    case 6: {
      int jb = (n >> 5) & 1, q = (n >> 6) * 32 + (n & 31);
      ld = FH;
      return (jb ? p.w_up : p.w_gate) + (size_t)l * D * FH + q;
    }
    default:
      ld = 1024;
      return p.w_down + (size_t)l * FH * D + n;
  }
}

__device__ __forceinline__ int job_nd(int k) {
  switch (k) { case 0: return 2048; case 1: return 3072; case 2: return 768; case 3: return 1024; case 4: return 3072;
    case 5: return 1024; case 6: return 5632; default: return 1024; }
}
__device__ __forceinline__ int job_kd(int k) {
  switch (k) { case 0: return 1024; case 1: return 1024; case 2: return 256; case 3: return 128; case 4: return 512;
    case 5: return 1024; case 6: return 1024; default: return 2816; }
}
__device__ __forceinline__ size_t job_od(int k) {
  switch (k) { case 0: return O_WP; case 1: return O_WG; case 2: return O_WUQ; case 3: return O_WUKV; case 4: return O_WB;
    case 5: return O_WO; case 6: return O_WGU; default: return O_WD; }
}
__device__ void prep_weights(const Params& p, int l, int bid, int nb, u16* smem) {
  float* tile = (float*)smem;
  const int tid = ltid();
  int start = 0;
#pragma unroll 1
  for (int kind = 0; kind < 8; kind++) {
    const int Kk = job_kd(kind);
    const int nkt = Kk >> 6, ntile = (job_nd(kind) >> 6) * nkt;
    u16* dst = wsp<u16>(p, job_od(kind));
    const float* ksc = kind == 2 ? p.gq + l * 256 : (kind == 3 ? p.gkv + l * 128 : nullptr);
    for (int t = (bid + nb - (start % nb)) % nb; t < ntile; t += nb) {
      const int nt = t / nkt, kt = t - nt * nkt;
      const int n0 = nt * 64, k0 = kt * 64;
      {
        const int kq = tid >> 4, nn4 = (tid & 15) * 4;
        int ld;
        const float* sp = src_col(p, l, kind, n0 + nn4, ld);
#pragma unroll
        for (int i = 0; i < 4; i++) {
          const int kk = i * 16 + kq;
          float4 v = make_float4(0.f, 0.f, 0.f, 0.f);
          if (sp) v = *(const float4*)(sp + (size_t)(k0 + kk) * ld);
          if (ksc) {
            const float sc = ksc[k0 + kk];
            v.x *= sc; v.y *= sc; v.z *= sc; v.w *= sc;
          }
          float* tp = tile + kk * 65 + nn4;
          tp[0] = v.x; tp[1] = v.y; tp[2] = v.z; tp[3] = v.w;
        }
      }
      __syncthreads();
#pragma unroll
      for (int i = 0; i < 2; i++) {
        const int c = tid + 256 * i;
        const int nn = c >> 3, kc = (c & 7) * 8;
        const float* tp = tile + kc * 65 + nn;
        uint4 o;
        o.x = pack2(tp[0], tp[65]);
        o.y = pack2(tp[2 * 65], tp[3 * 65]);
        o.z = pack2(tp[4 * 65], tp[5 * 65]);
        o.w = pack2(tp[6 * 65], tp[7 * 65]);
        *(uint4*)(dst + (size_t)(n0 + nn) * Kk + k0 + kc) = o;
      }
      __syncthreads();
    }
    start += ntile;
  }
  {
    float* ctab = (float*)smem;
    __syncthreads();
    if (tid < 128) ctab[tid] = cospif((float)tid * (1.f / 64.f));
    __syncthreads();
    u16* dst = wsp<u16>(p, O_WF);
    for (int it = bid; it < 512; it += nb) {
      const int o = it * 256 + tid;
      const int np = o & 1023, k8 = (o >> 10) * 8;
      const int reim = np >> 9, g = (np >> 7) & 3, m = np & 127;
      const float* w = p.w_in + (size_t)l * D * IN_DIM + (size_t)k8 * IN_DIM + g * 128;
      const int sh = reim ? 96 : 0;
      float a8[8];
#pragma unroll
      for (int j = 0; j < 8; j++) a8[j] = 0.f;
#pragma unroll 4
      for (int c = 0; c < 128; c++) {
        const float tw = ctab[(m * c + sh) & 127];
#pragma unroll
        for (int j = 0; j < 8; j++) a8[j] += w[(size_t)j * IN_DIM + c] * tw;
      }
      uint4 ov;
      ov.x = pack2(a8[0] * RS128, a8[1] * RS128);
      ov.y = pack2(a8[2] * RS128, a8[3] * RS128);
      ov.z = pack2(a8[4] * RS128, a8[5] * RS128);
      ov.w = pack2(a8[6] * RS128, a8[7] * RS128);
      *(uint4*)(dst + (size_t)np * 1024 + k8) = ov;
    }
    __syncthreads();
  }
}

__device__ void prep_tables(const Params& p, int bid, int nb) {
  u16* MA = wsp<u16>(p, O_MA);
  u16* MB = wsp<u16>(p, O_MB);
  u16* MC = wsp<u16>(p, O_MC);
  float* TW = wsp<float>(p, O_TW);
  const int total = 65536 + 32768 + 131072 + 16384;
  for (int idx = bid * 256 + ltid(); idx < total; idx += nb * 256) {
    if (idx < 65536) {
      const int n = idx >> 8, k = idx & 255;
      const int nt = n >> 7, wn = (n >> 6) & 1, jb = (n >> 5) & 1, klo = nt * 64 + wn * 32 + (n & 31);
      const int ri = k >> 7, nhi = k & 127;
      const int xx = (klo * nhi) & 127;
      const float c = cospif((float)xx * (1.f / 64.f)), s = sinpif((float)xx * (1.f / 64.f));
      float v = jb == 0 ? (ri == 0 ? c : -s) : (ri == 0 ? -s : -c);
      MA[idx] = f2bf(v * RS128);
    } else if (idx < 65536 + 32768) {
      const int i2 = idx - 65536;
      const int khi = i2 >> 8, k = i2 & 255;
      const int ri = k >> 7, nlo = k & 127;
      const int xx = (khi * nlo) & 127;
      const float c = cospif((float)xx * (1.f / 64.f)), s = sinpif((float)xx * (1.f / 64.f));
      MB[i2] = f2bf((ri == 0 ? c : s) * RS128);
    } else if (idx < 65536 + 32768 + 131072) {
      const int i2 = idx - 65536 - 32768;
      const int kk = i2 >> 9, k = i2 & 511;
      const int ri = k >> 8, nn = k & 255;
      const int xx = (kk * nn) & 255;
      const float c = cospif((float)xx * (1.f / 128.f)), s = sinpif((float)xx * (1.f / 128.f));
      MC[i2] = f2bf((ri == 0 ? c : -s) * 0.0625f);
    } else {
      const int i2 = idx - 65536 - 32768 - 131072;
      const int klo = i2 >> 7, nlo = i2 & 127;
      const int xx = klo * nlo;
      TW[i2 * 2] = cospif((float)xx * (1.f / 8192.f));
      TW[i2 * 2 + 1] = sinpif((float)xx * (1.f / 8192.f));
    }
  }
}

__device__ void prep_modp(const Params& p, int bid, int nb) {
  float* modp = wsp<float>(p, O_MODP);
  for (int it = bid; it < 2 * 16 * 24; it += nb) {
    const int l = it / (16 * 24), rem = it - l * 16 * 24, kc = rem / 24, nblk = rem - kc * 24;
    const int n = nblk * 256 + ltid();
    const float* w = p.w_mod + (size_t)l * D * 6144 + n;
    float a0 = 0.f, a1 = 0.f, a2 = 0.f;
#pragma unroll 8
    for (int kk = 0; kk < 64; kk++) {
      const int k = kc * 64 + kk;
      const float wv = w[(size_t)k * 6144];
      float c0 = p.c[k], c1 = p.c[1024 + k], c2 = p.c_ctx[k];
      c0 = c0 / (1.f + __expf(-c0));
      c1 = c1 / (1.f + __expf(-c1));
      c2 = c2 / (1.f + __expf(-c2));
      a0 += c0 * wv;
      a1 += c1 * wv;
      a2 += c2 * wv;
    }
    float* o = modp + ((size_t)(kc * 2 + l) * 3) * 6144 + n;
    o[0] = a0;
    o[6144] = a1;
    o[2 * 6144] = a2;
  }
}
__device__ void prep_modr(const Params& p, int bid, int nb) {
  const float* modp = wsp<float>(p, O_MODP);
  float* mod = wsp<float>(p, O_MOD);
  for (int idx = bid * 256 + ltid(); idx < 2 * 3 * 6144; idx += nb * 256) {
    const int l = idx / (3 * 6144), n = idx % 6144;
    float v = p.b_mod[l * 6144 + n];
    for (int kc = 0; kc < 16; kc++) v += modp[(size_t)kc * 2 * 3 * 6144 + idx];
    mod[idx] = v;
  }
}

__device__ void ln_phase(const Params& p, int mode, const float* g, const float* bta, int lmod, int shoff, int scoff,
                         bool skip_ctx, int bid, int nb, int lres = 0, int goff = -1) {
  const int lane = ltid() & 63, wave = ltid() >> 6;
  u16* A = wsp<u16>(p, O_A);
  const float* mod = wsp<float>(p, O_MOD);
  float4 gg[4], bb[4], sh[4], sc[4], gt[4];
#pragma unroll
  for (int q = 0; q < 4; q++) gt[q] = make_float4(0.f, 0.f, 0.f, 0.f);
  int cur_mg = -1;
#pragma unroll
  for (int q = 0; q < 4; q++) {
    const int c0 = (q >> 1) * 512 + lane * 8 + (q & 1) * 4;
    gg[q] = *(const float4*)(g + c0);
    bb[q] = *(const float4*)(bta + c0);
    sh[q] = make_float4(0.f, 0.f, 0.f, 0.f);
    sc[q] = make_float4(0.f, 0.f, 0.f, 0.f);
  }
  int cur_m = -1;
  for (int row = bid * 4 + wave; row < T; row += nb * 4) {
    const int b = row / KPB, kk = row - b * KPB;
    if (skip_ctx && kk < CTXL) continue;
    float* xr = xrow(p, row);
    const float* src;
    if (mode == 0)
      src = kk < CTXL ? p.ctx + (size_t)(b * CTXL + kk) * D : p.x + (size_t)(b * SEQ + kk - CTXL) * D;
    else
      src = xr;
    float4 v[4];
    float s = 0.f;
    const int m = kk < CTXL ? 2 : b;
    if (goff >= 0 && m != cur_mg) {
      cur_mg = m;
#pragma unroll
      for (int q = 0; q < 4; q++)
        gt[q] = *(const float4*)(mod + ((size_t)lres * 3 + m) * 6144 + goff + (q >> 1) * 512 + lane * 8 + (q & 1) * 4);
    }
#pragma unroll
    for (int i = 0; i < 2; i++) {
      uint4 fv = make_uint4(0u, 0u, 0u, 0u);
      if (goff >= 0) fv = *(const uint4*)(wsp<u16>(p, O_FB) + (size_t)row * D + i * 512 + lane * 8);
      const uint32_t fw[4] = {fv.x, fv.y, fv.z, fv.w};
#pragma unroll
      for (int hq = 0; hq < 2; hq++) {
        const int q = i * 2 + hq;
        v[q] = *(const float4*)(src + i * 512 + lane * 8 + hq * 4);
        if (goff >= 0) {
          v[q].x = ALPHA * v[q].x + (1.f + gt[q].x) * __uint_as_float(fw[hq * 2] << 16);
          v[q].y = ALPHA * v[q].y + (1.f + gt[q].y) * __uint_as_float(fw[hq * 2] & 0xffff0000u);
          v[q].z = ALPHA * v[q].z + (1.f + gt[q].z) * __uint_as_float(fw[hq * 2 + 1] << 16);
          v[q].w = ALPHA * v[q].w + (1.f + gt[q].w) * __uint_as_float(fw[hq * 2 + 1] & 0xffff0000u);
        }
        s += v[q].x + v[q].y + v[q].z + v[q].w;
      }
    }
    if (lmod >= 0 && m != cur_m) {
      cur_m = m;
      const float* md = mod + ((size_t)lmod * 3 + m) * 6144;
#pragma unroll
      for (int q = 0; q < 4; q++) {
        const int c0 = (q >> 1) * 512 + lane * 8 + (q & 1) * 4;
        sh[q] = *(const float4*)(md + shoff + c0);
        sc[q] = *(const float4*)(md + scoff + c0);
      }
    }
    const float mu = wsum(s) * (1.f / 1024.f);
    float qs = 0.f;
#pragma unroll
    for (int q = 0; q < 4; q++) {
      v[q].x -= mu; v[q].y -= mu; v[q].z -= mu; v[q].w -= mu;
      qs += v[q].x * v[q].x + v[q].y * v[q].y + v[q].z * v[q].z + v[q].w * v[q].w;
    }
    const float rstd = rsqrtf(wsum(qs) * (1.f / 1024.f) + EPS);
#pragma unroll
    for (int i = 0; i < 2; i++) {
      uint4 o;
      uint32_t ow[4];
#pragma unroll
      for (int hq = 0; hq < 2; hq++) {
        const int q = i * 2 + hq;
        float4 y;
        y.x = v[q].x * rstd * gg[q].x + bb[q].x;
        y.y = v[q].y * rstd * gg[q].y + bb[q].y;
        y.z = v[q].z * rstd * gg[q].z + bb[q].z;
        y.w = v[q].w * rstd * gg[q].w + bb[q].w;
        *(float4*)(xr + i * 512 + lane * 8 + hq * 4) = y;
        ow[hq * 2] = pack2(y.x * (1.f + sc[q].x) + sh[q].x, y.y * (1.f + sc[q].y) + sh[q].y);
        ow[hq * 2 + 1] = pack2(y.z * (1.f + sc[q].z) + sh[q].z, y.w * (1.f + sc[q].w) + sh[q].w);
      }
      if (lmod >= 0) {
        o.x = ow[0]; o.y = ow[1]; o.z = ow[2]; o.w = ow[3];
        *(uint4*)(A + (size_t)row * D + i * 512 + lane * 8) = o;
      }
    }
  }
}

#define PATCH_LOOP_BEGIN(NR_, NC_, PR_, PC_)                                   \
  {                                                                            \
    const int x_ = bid & 7, w_ = bid >> 3, nbx_ = nb >> 3;                     \
    const int CG_ = ((NC_) + (PC_)-1) / (PC_);                                 \
    const int npatch_ = (((NR_) + (PR_)-1) / (PR_)) * CG_;                     \
    for (int u_ = w_;; u_ += nbx_) {                                           \
      const int g_ = (u_ >> 6) * 8 + x_;                                       \
      if (g_ >= npatch_) break;                                                \
      const int s_ = u_ & 63;                                                  \
      const int rg_ = g_ / CG_;                                                \
      const int prt = rg_ * (PR_) + s_ / (PC_);                                \
      const int pct = (g_ - rg_ * CG_) * (PC_) + s_ % (PC_);                   \
      if (prt >= (NR_) || pct >= (NC_)) continue;
#define PATCH_LOOP_END \
    }                  \
  }

__device__ void phase_p1(const Params& p, int l, bool last, int bid, int nb, u16* smem) {
  EPI_DECL
  const u16* A = wsp<u16>(p, O_A);
  PATCH_LOOP_BEGIN(NRT, 16, 8, 8)
    f32x16 acc[2][2];
    zero_acc(acc);
    {
      const int rt = prt, ct = pct;
      const int row0 = rt * 128, b = row0 / KPB, kk0 = row0 - b * KPB;
      if (ct < 8 || ct >= 12) {
        gemm_core(acc, wsp<u16>(p, O_WP) + (size_t)ct * 128 * D, D, A + (size_t)rt * 128 * D, D, D, smem);
        u16* dst;
        float sc = 1.f;
        int cb;
        if (ct < 4) { dst = wsp<u16>(p, O_QNA); sc = NA_SCALE_L2; cb = ct * 128; }
        else if (ct < 8) { dst = wsp<u16>(p, O_KNA); cb = (ct - 4) * 128; }
        else { dst = wsp<u16>(p, O_LAT); cb = (ct - 12) * 128; }
#pragma unroll
        for (int i = 0; i < 2; i++)
#pragma unroll
          for (int j = 0; j < 2; j++)
#pragma unroll
            for (int gp = 0; gp < 2; gp++) {
              const int row = row0 + wn_ * 64 + j * 32 + r_;
              const int col = cb + wm_ * 64 + i * 32 + 8 * (2 * gp + hh_);
              uint2 oa, ob;
              oa.x = pack2(acc[i][j][8 * gp] * sc, acc[i][j][8 * gp + 1] * sc);
              oa.y = pack2(acc[i][j][8 * gp + 2] * sc, acc[i][j][8 * gp + 3] * sc);
              ob.x = pack2(acc[i][j][8 * gp + 4] * sc, acc[i][j][8 * gp + 5] * sc);
              ob.y = pack2(acc[i][j][8 * gp + 6] * sc, acc[i][j][8 * gp + 7] * sc);
              *(uint4*)(dst + (size_t)row * 512 + col) = pair_swap(oa, ob);
            }
      } else {
        gemm_core(acc, A + (size_t)rt * 128 * D, D, wsp<u16>(p, O_WP) + (size_t)ct * 128 * D, D, D, smem);
        u16* dst = wsp<u16>(p, O_VNAT);
        const int cb = (ct - 8) * 128;
#pragma unroll
        for (int i = 0; i < 2; i++)
#pragma unroll
          for (int j = 0; j < 2; j++)
#pragma unroll
            for (int gp = 0; gp < 2; gp++) {
              const int kk = kk0 + wm_ * 64 + i * 32 + 8 * (2 * gp + hh_);
              const int col = cb + wn_ * 64 + j * 32 + r_;
              uint2 oa, ob;
              oa.x = pack2(acc[i][j][8 * gp], acc[i][j][8 * gp + 1]);
              oa.y = pack2(acc[i][j][8 * gp + 2], acc[i][j][8 * gp + 3]);
              ob.x = pack2(acc[i][j][8 * gp + 4], acc[i][j][8 * gp + 5]);
              ob.y = pack2(acc[i][j][8 * gp + 6], acc[i][j][8 * gp + 7]);
              *(uint4*)(dst + ((size_t)(b * 512 + col)) * KPB + kk) = make_uint4(oa.x, oa.y, ob.x, ob.y);
            }
      }
    }
  PATCH_LOOP_END
  PATCH_LOOP_BEGIN(256, 8, 8, 8)
    f32x16 acc[2][2];
    zero_acc(acc);
    {
      const int rt = prt, ct = pct;
      const int b = rt >> 7, nlo = rt & 127;
      gemm_core(acc, A + (size_t)(b * KPB + CTXL + nlo) * D, (size_t)128 * D,
                wsp<u16>(p, O_WF) + (size_t)ct * 128 * D, D, D, smem);
      u16* dst = wsp<u16>(p, O_D1);
#pragma unroll
      for (int i = 0; i < 2; i++)
#pragma unroll
        for (int j = 0; j < 2; j++)
#pragma unroll
          for (int gp = 0; gp < 2; gp++) {
            const int nhi = wm_ * 64 + i * 32 + 8 * (2 * gp + hh_);
            const int n = ct * 128 + wn_ * 64 + j * 32 + r_;
            const int reim = n >> 9, jj = n & 511;
            uint2 oa, ob;
            oa.x = pack2(acc[i][j][8 * gp], acc[i][j][8 * gp + 1]);
            oa.y = pack2(acc[i][j][8 * gp + 2], acc[i][j][8 * gp + 3]);
            ob.x = pack2(acc[i][j][8 * gp + 4], acc[i][j][8 * gp + 5]);
            ob.y = pack2(acc[i][j][8 * gp + 6], acc[i][j][8 * gp + 7]);
            *(uint4*)(dst + ((((size_t)(b * 512 + jj)) * 128 + nlo) * 2 + reim) * 128 + nhi) = pair_swap(oa, ob);
          }
    }
  PATCH_LOOP_END
  if (!last) {
    for (int t2 = bid; t2 < 32; t2 += nb) {
      f32x16 acc[2][2];
      zero_acc(acc);
      const int rt = t2 >> 3, ct = t2 & 7;
      const int b = rt >> 1, rb = rt & 1;
      gemm_core(acc, A + (size_t)(b * KPB + rb * 128) * D, D, wsp<u16>(p, O_WF) + (size_t)ct * 128 * D, D, D, smem);
      u16* dst = wsp<u16>(p, O_D1C);
#pragma unroll
      for (int i = 0; i < 2; i++)
#pragma unroll
        for (int j = 0; j < 2; j++)
#pragma unroll
          for (int gp = 0; gp < 2; gp++) {
            const int nc = rb * 128 + wm_ * 64 + i * 32 + 8 * (2 * gp + hh_);
            const int n = ct * 128 + wn_ * 64 + j * 32 + r_;
            const int reim = n >> 9, jj = n & 511;
            uint2 oa, ob;
            oa.x = pack2(acc[i][j][8 * gp], acc[i][j][8 * gp + 1]);
            oa.y = pack2(acc[i][j][8 * gp + 2], acc[i][j][8 * gp + 3]);
            ob.x = pack2(acc[i][j][8 * gp + 4], acc[i][j][8 * gp + 5]);
            ob.y = pack2(acc[i][j][8 * gp + 6], acc[i][j][8 * gp + 7]);
            *(uint4*)(dst + (((size_t)(b * 512 + jj)) * 2 + reim) * 256 + nc) = pair_swap(oa, ob);
          }
    }
  }
}

__device__ __forceinline__ float inv_freq(int i) {
  switch (i) {
    case 0: return 1.0f;
    case 1: return 0.31622776601683794f;
    case 2: return 0.1f;
    case 3: return 0.03162277660168379f;
    case 4: return 0.01f;
    case 5: return 0.0031622776601683794f;
    case 6: return 0.001f;
    default: return 0.00031622776601683794f;
  }
}
__device__ __forceinline__ void rope_cs(int kk, int e, float& cs, float& sn) {
  if (kk < CTXL) { cs = 1.f; sn = 0.f; return; }
  const int tkn = kk - CTXL;
  const float pos = (e < 8) ? (float)(tkn >> 6) : (float)(tkn & 63);
  const float ang = pos * inv_freq(e & 7);
  double xr = (double)ang * 0.31830988618379067;
  xr -= 2.0 * floor(xr * 0.5);
  const float yr = (float)xr;
  cs = cospif(yr);
  sn = sinpif(yr);
}

__device__ __forceinline__ void row_rms(const u16* A, size_t lda, int K, float* rs) {
  const int tid = ltid();
  const int row = tid >> 1, half = tid & 1;
  const u16* pr = A + (size_t)row * lda + half * (K >> 1);
  float s = 0.f;
  for (int c = 0; c < (K >> 1); c += 8) {
    uint4 v = *(const uint4*)(pr + c);
    const uint32_t w[4] = {v.x, v.y, v.z, v.w};
#pragma unroll
    for (int q = 0; q < 4; q++) {
      const float a = __uint_as_float(w[q] << 16), bq = __uint_as_float(w[q] & 0xffff0000u);
      s += a * a + bq * bq;
    }
  }
  s += __shfl_xor(s, 1);
  if (half == 0) rs[row] = rsqrtf(s / (float)K + EPS);
  __syncthreads();
}

__device__ void phase_p2(const Params& p, int l, int bid, int nb, u16* smem) {
  EPI_DECL
  const u16* LAT = wsp<u16>(p, O_LAT);
  float* rs = (float*)(smem + 4 * SM_A);
  const int nQ = NRT * 6, nKV = NRT * 8, nFA = 1024 * 2, nKR = NRT;
  const int total = nQ + nKV + nFA + nKR;
  for (int t = bid; t < total; t += nb) {
    if (t < nQ) {
      const int rt = t / 6, ct = t - rt * 6;
      const int row0 = rt * 128, b = row0 / KPB, kk0 = row0 - b * KPB;
      row_rms(LAT + (size_t)row0 * 512, 512, 256, rs);
      f32x16 acc[2][2];
      zero_acc(acc);
      gemm_core(acc, wsp<u16>(p, O_WUQ) + (size_t)ct * 128 * 256, 256, LAT + (size_t)row0 * 512, 512, 256, smem);
      u16* QM = wsp<u16>(p, O_QM);
      if (ct < 4) {
#pragma unroll
        for (int i = 0; i < 2; i++)
#pragma unroll
          for (int j = 0; j < 2; j++)
#pragma unroll
            for (int gp = 0; gp < 2; gp++) {
              const int rl = wn_ * 64 + j * 32 + r_;
              const int col = ct * 128 + wm_ * 64 + i * 32 + 8 * (2 * gp + hh_);
              const int h = col >> 6, d = col & 63;
              const float sc = rs[rl] * MLA_SCALE_L2;
              uint2 oa, ob;
              oa.x = pack2(acc[i][j][8 * gp] * sc, acc[i][j][8 * gp + 1] * sc);
              oa.y = pack2(acc[i][j][8 * gp + 2] * sc, acc[i][j][8 * gp + 3] * sc);
              ob.x = pack2(acc[i][j][8 * gp + 4] * sc, acc[i][j][8 * gp + 5] * sc);
              ob.y = pack2(acc[i][j][8 * gp + 6] * sc, acc[i][j][8 * gp + 7] * sc);
              *(uint4*)(QM + (size_t)(row0 + rl) * 768 + h * 96 + d) = pair_swap(oa, ob);
            }
      } else {
        const int wt = (ct - 4) * 2 + wm_;
#pragma unroll
        for (int j = 0; j < 2; j++) {
          const int rl = wn_ * 64 + j * 32 + r_;
          const float sc = rs[rl] * MLA_SCALE_L2;
          uint2 p1[4], p2[4];
#pragma unroll
          for (int g = 0; g < 4; g++) {
            const int idx = wt * 32 + 8 * g + 4 * hh_;
            const int e16 = idx & 15;
            float o1[4], o2[4];
#pragma unroll
            for (int q = 0; q < 4; q++) {
              float cs, sn;
              rope_cs(kk0 + rl, e16 + q, cs, sn);
              const float x1 = acc[0][j][4 * g + q] * sc, x2 = acc[1][j][4 * g + q] * sc;
              o1[q] = x1 * cs - x2 * sn;
              o2[q] = x2 * cs + x1 * sn;
            }
            p1[g].x = pack2(o1[0], o1[1]);
            p1[g].y = pack2(o1[2], o1[3]);
            p2[g].x = pack2(o2[0], o2[1]);
            p2[g].y = pack2(o2[2], o2[3]);
          }
#pragma unroll
          for (int gp = 0; gp < 2; gp++) {
            u16* qd = QM + (size_t)(row0 + rl) * 768 + (2 * wt + gp) * 96 + 64 + 8 * hh_;
            *(uint4*)qd = pair_swap(p1[2 * gp], p1[2 * gp + 1]);
            *(uint4*)(qd + 16) = pair_swap(p2[2 * gp], p2[2 * gp + 1]);
          }
        }
      }
      __syncthreads();
    } else if (t < nQ + nKV) {
      const int t2 = t - nQ;
      const int rt = t2 >> 3, ct = t2 & 7;
      const int row0 = rt * 128, b = row0 / KPB, kk0 = row0 - b * KPB;
      row_rms(LAT + (size_t)row0 * 512 + 256, 512, 128, rs);
      f32x16 acc[2][2];
      zero_acc(acc);
      if (ct < 4) {
        gemm_core(acc, wsp<u16>(p, O_WUKV) + (size_t)ct * 128 * 128, 128, LAT + (size_t)row0 * 512 + 256, 512, 128,
                  smem);
        u16* KN = wsp<u16>(p, O_KN);
#pragma unroll
        for (int i = 0; i < 2; i++)
#pragma unroll
          for (int j = 0; j < 2; j++)
#pragma unroll
            for (int gp = 0; gp < 2; gp++) {
              const int rl = wn_ * 64 + j * 32 + r_;
              const int col = ct * 128 + wm_ * 64 + i * 32 + 8 * (2 * gp + hh_);
              const float sc = rs[rl];
              uint2 oa, ob;
              oa.x = pack2(acc[i][j][8 * gp] * sc, acc[i][j][8 * gp + 1] * sc);
              oa.y = pack2(acc[i][j][8 * gp + 2] * sc, acc[i][j][8 * gp + 3] * sc);
              ob.x = pack2(acc[i][j][8 * gp + 4] * sc, acc[i][j][8 * gp + 5] * sc);
              ob.y = pack2(acc[i][j][8 * gp + 6] * sc, acc[i][j][8 * gp + 7] * sc);
              *(uint4*)(KN + (size_t)(row0 + rl) * 512 + col) = pair_swap(oa, ob);
            }
      } else {
        gemm_core(acc, LAT + (size_t)row0 * 512 + 256, 512, wsp<u16>(p, O_WUKV) + (size_t)ct * 128 * 128, 128, 128,
                  smem);
        u16* VMT = wsp<u16>(p, O_VMT);
#pragma unroll
        for (int i = 0; i < 2; i++)
#pragma unroll
          for (int j = 0; j < 2; j++)
#pragma unroll
            for (int gp = 0; gp < 2; gp++) {
              const int ra = wm_ * 64 + i * 32 + 16 * gp + 4 * hh_;
              const int rb2 = ra + 8;
              const int rst = wm_ * 64 + i * 32 + 8 * (2 * gp + hh_);
              const int col = (ct - 4) * 128 + wn_ * 64 + j * 32 + r_;
              uint2 oa, ob;
              oa.x = pack2(acc[i][j][8 * gp] * rs[ra], acc[i][j][8 * gp + 1] * rs[ra + 1]);
              oa.y = pack2(acc[i][j][8 * gp + 2] * rs[ra + 2], acc[i][j][8 * gp + 3] * rs[ra + 3]);
              ob.x = pack2(acc[i][j][8 * gp + 4] * rs[rb2], acc[i][j][8 * gp + 5] * rs[rb2 + 1]);
              ob.y = pack2(acc[i][j][8 * gp + 6] * rs[rb2 + 2], acc[i][j][8 * gp + 7] * rs[rb2 + 3]);
              *(uint4*)(VMT + ((size_t)(b * 512 + col)) * KPB + kk0 + rst) = make_uint4(oa.x, oa.y, ob.x, ob.y);
            }
      }
      __syncthreads();
    } else if (t < nQ + nKV + nFA) {
      const int t2 = t - nQ - nKV;
      const int rt = t2 >> 1, ct = t2 & 1;
      const int b = rt >> 9, jj = rt & 511;
      f32x16 acc[2][2];
      zero_acc(acc);
      gemm_core(acc, wsp<u16>(p, O_D1) + (size_t)rt * 128 * 256, 256, wsp<u16>(p, O_MA) + (size_t)ct * 128 * 256, 256,
                256, smem);
      const float* TW = wsp<float>(p, O_TW);
      u16* D2 = wsp<u16>(p, O_D2);
      const int klo = ct * 64 + wn_ * 32 + r_;
      const float2* twp = (const float2*)TW + klo;
#pragma unroll
      for (int i = 0; i < 2; i++)
      {
        uint2 pr[4], pi[4];
#pragma unroll
        for (int g = 0; g < 4; g++) {
          const int nlo = wm_ * 64 + i * 32 + 8 * g + 4 * hh_;
          float re[4], im[4];
#pragma unroll
          for (int q = 0; q < 4; q++) {
            const float2 tw = twp[(nlo + q) * 128];
            const float ar = acc[i][0][4 * g + q], ai = acc[i][1][4 * g + q];
            re[q] = ar * tw.x + ai * tw.y;
            im[q] = ai * tw.x - ar * tw.y;
          }
          pr[g].x = pack2(re[0], re[1]);
          pr[g].y = pack2(re[2], re[3]);
          pi[g].x = pack2(im[0], im[1]);
          pi[g].y = pack2(im[2], im[3]);
        }
#pragma unroll
        for (int gp = 0; gp < 2; gp++) {
          u16* d = D2 + ((((size_t)(b * 128 + klo)) * 512 + jj) * 2) * 128 + wm_ * 64 + i * 32 + 8 * (2 * gp + hh_);
          *(uint4*)d = pair_swap(pr[2 * gp], pr[2 * gp + 1]);
          *(uint4*)(d + 128) = pair_swap(pi[2 * gp], pi[2 * gp + 1]);
        }
      }
    } else {
      const int rt = t - nQ - nKV - nFA;
      u16* KRR = wsp<u16>(p, O_KRR);
      for (int idx = ltid(); idx < 128 * 16; idx += 256) {
        const int rl = idx >> 4, e16 = idx & 15;
        const int row = rt * 128 + rl, b = row / KPB, kk = row - b * KPB;
        const float x1 = bf2f(LAT[(size_t)row * 512 + 384 + e16]), x2 = bf2f(LAT[(size_t)row * 512 + 400 + e16]);
        float cs, sn;
        rope_cs(kk, e16, cs, sn);
        KRR[(size_t)row * 32 + e16] = f2bf(x1 * cs - x2 * sn);
        KRR[(size_t)row * 32 + 16 + e16] = f2bf(x2 * cs + x1 * sn);
      }
    }
  }
}

template <int MODE>
__device__ void attn_item(const Params& p, int l, int b, int h, int q0  ,
                          int ntiles  , int rs0, int ycol, u16* smem) {
  constexpr int DQK = MODE == 0 ? 96 : 64;
  constexpr int KSTR = DQK + 8;
  constexpr int NKS = DQK / 16;
  constexpr int CPR = DQK / 8;
  constexpr int NKC = 64 * CPR / 256;
  const int tid = ltid(), lane = tid & 63, wave = tid >> 6, r = lane & 31, hh = lane >> 5;
  u16* Ks = smem;
  u16* Vs = smem + 2 * 64 * KSTR;
  const unsigned char* wsb = p.ws;
  const int qk = q0 + wave * 32 + r;
  const size_t qrow = (size_t)b * KPB + qk;
  bf16x8 qf[NKS];
  {
    const u16* qp = MODE == 0 ? wsp<u16>(p, O_QM) + qrow * 768 + h * 96 : wsp<u16>(p, O_QNA) + qrow * 512 + h * 64;
#pragma unroll
    for (int ks = 0; ks < NKS; ks++) qf[ks] = *(const bf16x8*)(qp + ks * 16 + hh * 8);
  }
  const short one_or_zero = hh == 0 ? (short)0x3F80 : (short)0;
  const bf16x8 kone = {one_or_zero, 0, 0, 0, 0, 0, 0, 0};
  bf16x8 qm = {0, 0, 0, 0, 0, 0, 0, 0};
  int qr = 0, qc = 0, rsq = 0, cs = 0;
  const float* rpb = nullptr;
  if (MODE == 1 && rs0 >= 0) {
    const int tkn = qk - CTXL;
    qr = tkn >> 6;
    qc = tkn & 63;
    rsq = min(max(qr - 4, 0), 248);
    cs = min(max(qc - 8, 0), 48);
    rpb = p.rpb + ((size_t)(l * 8 + h)) * 15 * 31;
  }
  f32x16 o[2];
#pragma unroll
  for (int e = 0; e < 16; e++) { o[0][e] = 0.f; o[1][e] = 0.f; }
  float lsum = 0.f;
  float m = 0.f;
  const bf16x8 ones = {(short)0x3F80, (short)0x3F80, (short)0x3F80, (short)0x3F80,
                       (short)0x3F80, (short)0x3F80, (short)0x3F80, (short)0x3F80};

#define KGEO(i)                                                                                          \
  uint32_t kof##i, kmu##i;                                                                               \
  int kls##i;                                                                                            \
  {                                                                                                      \
    const int c = tid + 256 * (i);                                                                       \
    const int row = c / CPR, cc = c - row * CPR;                                                         \
    if (MODE == 0 && cc >= 8) {                                                                          \
      kof##i = (uint32_t)(O_KRR + ((size_t)(b * KPB + row) * 32 + (cc - 8) * 8) * 2);                    \
      kmu##i = 64u;                                                                                      \
    } else {                                                                                             \
      kof##i = (uint32_t)((MODE == 0 ? O_KN : O_KNA) + ((size_t)(b * KPB + row) * 512 + h * 64 + cc * 8) * 2); \
      kmu##i = 1024u;                                                                                    \
    }                                                                                                    \
    kls##i = row * KSTR + cc * 8;                                                                        \
  }
#define VGEO(i)                                                                                          \
  uint32_t vof##i;                                                                                       \
  int vls##i;                                                                                            \
  bool vsx##i;                                                                                           \
  {                                                                                                      \
    const int c = tid + 256 * (i);                                                                       \
    const int d = c >> 3, cc = c & 7;                                                                    \
    vof##i = (uint32_t)((MODE == 0 ? O_VMT : O_VNAT) + ((size_t)(b * 512 + h * 64 + d) * KPB + cc * 8) * 2); \
    vls##i = d * 72 + cc * 8;                                                                            \
    vsx##i = (d & 8) != 0;                                                                               \
  }
  KGEO(0) KGEO(1) KGEO(2) VGEO(0) VGEO(1)
  (void)kof2; (void)kmu2; (void)kls2;
  u32x4 kr0A, kr1A, kr2A, vr0A, vr1A, kr0B, kr1B, kr2B, vr0B, vr1B;
  kr2A = kr1A = kr0A = vr0A = vr1A = kr2B = kr1B = kr0B = vr0B = vr1B = (u32x4){0u, 0u, 0u, 0u};
#define TILE_KK0(t) ((MODE == 1 && (t) >= 4) ? (uint32_t)(CTXL + 64 * min(rs0 + (t)-4, 255)) : (uint32_t)(64 * (t)))
#define LOAD_KV(t, S)                                                                   \
  {                                                                                     \
    const uint32_t kk0_ = TILE_KK0(t);                                                  \
    kr0##S = *(const u32x4*)(wsb + (size_t)(kof0 + kk0_ * kmu0));                       \
    kr1##S = *(const u32x4*)(wsb + (size_t)(kof1 + kk0_ * kmu1));                       \
    if (NKC == 3) kr2##S = *(const u32x4*)(wsb + (size_t)(kof2 + kk0_ * kmu2));         \
    vr0##S = *(const u32x4*)(wsb + (size_t)(vof0 + kk0_ * 2u));                         \
    vr1##S = *(const u32x4*)(wsb + (size_t)(vof1 + kk0_ * 2u));                         \
  }
#define STORE_V1(buf, i, srcv)                                                          \
  {                                                                                     \
    *(u32x4*)(Vs + (buf)*64 * 72 + vls##i) = srcv;                                      \
  }
#define STORE_KV(buf, S)                                                                \
  {                                                                                     \
    *(u32x4*)(Ks + (buf)*64 * KSTR + kls0) = kr0##S;                                    \
    *(u32x4*)(Ks + (buf)*64 * KSTR + kls1) = kr1##S;                                    \
    if (NKC == 3) *(u32x4*)(Ks + (buf)*64 * KSTR + kls2) = kr2##S;                      \
    STORE_V1(buf, 0, vr0##S) STORE_V1(buf, 1, vr1##S)                                   \
  }
#define QK_TILE(kbuf, t)                                                                           \
  {                                                                                                \
    const u16* kb_ = Ks + (kbuf)*64 * KSTR + r * KSTR + hh * 8;                                    \
    {                                                                                              \
      f32x16 z_;                                                                                   \
      _Pragma("unroll") for (int e = 0; e < 16; e++) z_[e] = 0.f;                                  \
      sc[0] = __builtin_amdgcn_mfma_f32_32x32x16_bf16(kone, qm, z_, 0, 0, 0);                      \
      sc[1] = sc[0];                                                                               \
    }                                                                                              \
    _Pragma("unroll") for (int ks = 0; ks < NKS; ks++) {                                           \
      const bf16x8 kf0 = *(const bf16x8*)(kb_ + ks * 16);                                          \
      const bf16x8 kf1 = *(const bf16x8*)(kb_ + 32 * KSTR + ks * 16);                              \
      sc[0] = __builtin_amdgcn_mfma_f32_32x32x16_bf16(kf0, qf[ks], sc[0], 0, 0, 0);                \
      sc[1] = __builtin_amdgcn_mfma_f32_32x32x16_bf16(kf1, qf[ks], sc[1], 0, 0, 0);                \
    }                                                                                              \
    if (MODE == 1 && (t) >= 4) {                                                                   \
      const int kr_ = rs0 + (t)-4;                                                                 \
      const bool rowok = (kr_ >= rsq) && (kr_ < rsq + 8);                                          \
      const float* rp = rpb + (kr_ - qr + 7) * 31 + (15 - qc);                                     \
      _Pragma("unroll") for (int kb = 0; kb < 2; kb++) _Pragma("unroll") for (int e = 0; e < 16; e++) { \
        const int kc = kb * 32 + (e & 3) + 8 * (e >> 2) + 4 * hh;                                  \
        const bool valid = rowok && (kc >= cs) && (kc < cs + 16);                                  \
        float bias = 0.f;                                                                          \
        if (valid) bias = rp[kc];                                                                  \
        sc[kb][e] = valid ? sc[kb][e] + bias * LOG2E : -1e30f;                                     \
      }                                                                                            \
    }                                                                                              \
  }
#define TILE_MAX(tmax)                                                                             \
  {                                                                                                \
    tmax = sc[0][0];                                                                               \
    _Pragma("unroll") for (int e = 1; e < 16; e++) tmax = fmaxf(tmax, sc[0][e]);                   \
    _Pragma("unroll") for (int e = 0; e < 16; e++) tmax = fmaxf(tmax, sc[1][e]);                   \
    const uint32_t tu = __float_as_uint(tmax);                                                     \
    const auto sw = __builtin_amdgcn_permlane32_swap(tu, tu, false, false);                        \
    tmax = fmaxf(__uint_as_float(sw[0]), __uint_as_float(sw[1]));                                  \
  }
#define MOVE_REF(mnew_)                                                                            \
  {                                                                                                \
    const float mq_ = bf2f(f2bf(mnew_));                                                           \
    const float delta_ = mq_ - m;                                                                  \
    const float alpha = __builtin_amdgcn_exp2f(-delta_);                                           \
    m = mq_;                                                                                       \
    _Pragma("unroll") for (int e = 0; e < 16; e++) {                                               \
      o[0][e] *= alpha; o[1][e] *= alpha;                                                         \
      sc[0][e] -= delta_; sc[1][e] -= delta_;                                                      \
    }                                                                                              \
    lsum *= alpha;                                                                                 \
    qm[0] = (hh == 0) ? (short)f2bf(-m) : (short)0;                                                \
  }
#define SOFTMAX_PV(vbuf)                                                                           \
  {                                                                                                \
    const u16* vb_ = Vs + (vbuf)*64 * 72 + r * 72 + 8 * hh;                                        \
    _Pragma("unroll") for (int kb = 0; kb < 2; kb++) _Pragma("unroll") for (int st = 0; st < 2; st++) { \
      u32x4 pu;                                                                                    \
      _Pragma("unroll") for (int q = 0; q < 4; q++) {                                              \
        const float p0_ = __builtin_amdgcn_exp2f(sc[kb][8 * st + 2 * q]);                          \
        const float p1_ = __builtin_amdgcn_exp2f(sc[kb][8 * st + 2 * q + 1]);                      \
        lsum += p0_ + p1_;                                                                         \
        pu[q] = pack2(p0_, p1_);                                                                   \
      }                                                                                            \
      const bf16x8 pbv = __builtin_bit_cast(bf16x8, pu);                                           \
      _Pragma("unroll") for (int db = 0; db < 2; db++) {                                           \
        const u16* vp = vb_ + db * 32 * 72 + kb * 32 + 16 * st;                                    \
        const bf16x8 vfv = *(const bf16x8*)(vp);     \
        o[db] = __builtin_amdgcn_mfma_f32_32x32x16_bf16(vfv, pbv, o[db], 0, 0, 0);                 \
      }                                                                                            \
    }                                                                                              \
  }
#define DEFER_REF(tmax)                                                                            \
  if (__any(tmax > 8.f)) {                                                                         \
    const float mq_ = bf2f(f2bf(m + fmaxf(tmax, 0.f)));                                            \
    const float alpha = __builtin_amdgcn_exp2f(m - mq_);                                           \
    m = mq_;                                                                                       \
    _Pragma("unroll") for (int e = 0; e < 16; e++) { o[0][e] *= alpha; o[1][e] *= alpha; }       \
    lsum *= alpha;                                                                                 \
    qm[0] = (hh == 0) ? (short)f2bf(-m) : (short)0;                                                \
  }
#define ATT_STEP(t, LD, ST)                                        \
  {                                                                \
    const int cur = (t)&1;                                         \
    QK_TILE(cur, t)                                                \
    __builtin_amdgcn_sched_barrier(0);                             \
    LOAD_KV(min((t) + 2, tl), LD)                                  \
    __builtin_amdgcn_sched_barrier(0);                             \
    __builtin_amdgcn_s_setprio(1);                                 \
    SOFTMAX_PV(cur)                                                \
    __builtin_amdgcn_s_setprio(0);                                 \
    float tmax;                                                    \
    TILE_MAX(tmax)                                                 \
    DEFER_REF(tmax)                                                \
    STORE_KV(cur ^ 1, ST)                                          \
    __syncthreads();                                               \
  }

  const int tl = ntiles - 1;
  f32x16 sc[2];
  LOAD_KV(0, A)
  STORE_KV(0, A)
  LOAD_KV(min(1, tl), A)
  __syncthreads();
  {
    LOAD_KV(min(2, tl), B)
    __builtin_amdgcn_sched_barrier(0);
    QK_TILE(0, 0)
    float tmax;
    TILE_MAX(tmax)
    MOVE_REF(tmax)
    SOFTMAX_PV(0)
    STORE_KV(1, A)
    __syncthreads();
  }
  for (int t = 1; t + 1 < ntiles; t += 2) {
    ATT_STEP(t, A, B)
    ATT_STEP(t + 1, B, A)
  }
  ATT_STEP(tl, A, B)
  const float inv = 1.f / (lsum + __shfl_xor(lsum, 32));
  u16* yp = wsp<u16>(p, O_Y) + qrow * 1536 + ycol + h * 64;
#pragma unroll
  for (int db = 0; db < 2; db++)
#pragma unroll
    for (int gp = 0; gp < 2; gp++) {
      uint2 oa, ob;
      oa.x = pack2(o[db][8 * gp] * inv, o[db][8 * gp + 1] * inv);
      oa.y = pack2(o[db][8 * gp + 2] * inv, o[db][8 * gp + 3] * inv);
      ob.x = pack2(o[db][8 * gp + 4] * inv, o[db][8 * gp + 5] * inv);
      ob.y = pack2(o[db][8 * gp + 6] * inv, o[db][8 * gp + 7] * inv);
      *(uint4*)(yp + db * 32 + 8 * (2 * gp + hh)) = pair_swap(oa, ob);
    }
#undef KGEO
#undef VGEO
#undef TILE_KK0
#undef LOAD_KV
#undef STORE_V1
#undef STORE_KV
#undef QK_TILE
#undef TILE_MAX
#undef MOVE_REF
#undef SOFTMAX_PV
#undef ATT_STEP
#undef DEFER_REF
}

__device__ void phase_p3(const Params& p, int l, bool last, int bid, int nb, u16* smem) {
  EPI_DECL
  const int nMLA = 2048, nNA = 2048, nFB = 1024;
  const int nC = last ? 0 : (32 + 32 + 16);
  const int total = nMLA + nNA + nFB + nC;
  for (int t = bid; t < total; t += nb) {
    int kind, b = 0, h = 0, q0 = 0, ntl = 0, rs0 = -1;
    size_t aoff = 0, boff = 0;
    int Kf = 256, j0 = 0, tok0 = 0, tokmul = 1, colbase = 0;
    if (t < nMLA) {
      kind = 0;
      h = t & 7;
      const int rest = t >> 3;
      b = rest >> 7;
      q0 = CTXL + (rest & 127) * 128;
      ntl = 260;
    } else if (t < nMLA + nNA) {
      kind = 1;
      const int t2 = t - nMLA;
      h = t2 & 7;
      const int rest = t2 >> 3, rp = rest & 127;
      b = rest >> 7;
      rs0 = min(max(2 * rp - 4, 0), 248);
      const int rs1 = min(max(2 * rp + 1 - 4, 0), 248);
      q0 = CTXL + rp * 128;
      ntl = (4 + (rs1 + 8 - rs0) + 1) & ~1;
    } else if (t < nMLA + nNA + nFB) {
      kind = 2;
      const int rt = t - nMLA - nNA;
      const int bk = rt >> 2;
      j0 = (rt & 3) * 128;
      b = bk >> 7;
      tok0 = CTXL + (bk & 127);
      tokmul = 128;
      aoff = O_D2 + (size_t)rt * 128 * 256 * 2;
      boff = O_MB;
      Kf = 256;
    } else {
      const int t2 = t - nMLA - nNA - nFB;
      if (t2 < 64) {
        kind = t2 >> 5;
        const int t3 = t2 & 31;
        h = t3 & 7;
        b = (t3 >> 3) & 1;
        q0 = (t3 >> 4) * 128;
        ntl = 4;
      } else {
        kind = 2;
        const int t3 = t2 - 64;
        const int rt = t3 >> 1, ct = t3 & 1;
        b = rt >> 2;
        j0 = (rt & 3) * 128;
        colbase = ct * 128;
        aoff = O_D1C + (size_t)rt * 128 * 512 * 2;
        boff = O_MC + (size_t)ct * 128 * 512 * 2;
        Kf = 512;
      }
    }
    if (kind == 0) {
      attn_item<0>(p, l, b, h, q0, ntl, -1, 1024, smem);
    } else if (kind == 1) {
      attn_item<1>(p, l, b, h, q0, ntl, rs0, 512, smem);
    } else {
      f32x16 acc[2][2];
      zero_acc(acc);
      gemm_core(acc, wsp<u16>(p, aoff), Kf, wsp<u16>(p, boff), Kf, Kf, smem);
      u16* Y = wsp<u16>(p, O_Y);
#pragma unroll
      for (int i = 0; i < 2; i++)
#pragma unroll
        for (int j = 0; j < 2; j++)
#pragma unroll
          for (int gp = 0; gp < 2; gp++) {
            const int jj = j0 + wm_ * 64 + i * 32 + 8 * (2 * gp + hh_);
            const int tok = tok0 + (colbase + wn_ * 64 + j * 32 + r_) * tokmul;
            uint2 oa, ob;
            oa.x = pack2(acc[i][j][8 * gp], acc[i][j][8 * gp + 1]);
            oa.y = pack2(acc[i][j][8 * gp + 2], acc[i][j][8 * gp + 3]);
            ob.x = pack2(acc[i][j][8 * gp + 4], acc[i][j][8 * gp + 5]);
            ob.y = pack2(acc[i][j][8 * gp + 6], acc[i][j][8 * gp + 7]);
            *(uint4*)(Y + ((size_t)b * KPB + tok) * 1536 + jj) = pair_swap(oa, ob);
          }
    }
  }
}

__device__ __forceinline__ int n_row_tiles(bool last) { return last ? NRT - 4 : NRT; }
__device__ __forceinline__ int row_tile(bool last, int i) {
  if (!last) return i;
  return i < 128 ? i + 2 : i + 4;
}

__device__ void phase_p4(const Params& p, int l, bool last, int bid, int nb, u16* smem) {
  EPI_DECL
  const u16* A = wsp<u16>(p, O_A);
  const u16* Y = wsp<u16>(p, O_Y);
  u16* M = wsp<u16>(p, O_M);
  uint4* stash = wsp<uint4>(p, O_QM) + (size_t)bid * 24 * 256 + ltid();
  const int nrt_ = n_row_tiles(last);
  PATCH_LOOP_BEGIN(nrt_, 8, 8, 8)
    const int rt = row_tile(last, prt), ct = pct;
    f32x16 mg[2][2];
    zero_acc(mg);
#pragma unroll 1
    for (int g = 0; g < 3; g++) {
      uint32_t gp[2][2][8];
      {
        f32x16 acc[2][2];
        zero_acc(acc);
        gemm_core<true>(acc, wsp<u16>(p, O_WG) + (size_t)(g * 1024 + ct * 128) * D, D, A + (size_t)rt * 128 * D, D, D,
                        smem);
#pragma unroll
        for (int i = 0; i < 2; i++)
#pragma unroll
          for (int j = 0; j < 2; j++)
#pragma unroll
            for (int e = 0; e < 8; e++)
              gp[i][j][e] = pack2(fsigmoid(acc[i][j][2 * e]), fsigmoid(acc[i][j][2 * e + 1]));
      }
      {
        f32x16 acc[2][2];
        zero_acc(acc);
        gemm_core<false>(acc, wsp<u16>(p, O_WB) + (size_t)(g * 1024 + ct * 128) * 512, 512,
                         Y + (size_t)rt * 128 * 1536 + g * 512, 1536, 512, smem);
#pragma unroll
        for (int i = 0; i < 2; i++)
#pragma unroll
          for (int j = 0; j < 2; j++)
#pragma unroll
            for (int e = 0; e < 8; e++) {
              mg[i][j][2 * e] += __uint_as_float(gp[i][j][e] << 16) * acc[i][j][2 * e];
              mg[i][j][2 * e + 1] += __uint_as_float(gp[i][j][e] & 0xffff0000u) * acc[i][j][2 * e + 1];
            }
      }
    }
#pragma unroll
    for (int i = 0; i < 2; i++)
#pragma unroll
      for (int j = 0; j < 2; j++)
#pragma unroll
        for (int gp = 0; gp < 2; gp++) {
          const int row = rt * 128 + wn_ * 64 + j * 32 + r_;
          const int col = ct * 128 + wm_ * 64 + i * 32 + 8 * (2 * gp + hh_);
          uint2 oa, ob;
          oa.x = pack2(mg[i][j][8 * gp], mg[i][j][8 * gp + 1]);
          oa.y = pack2(mg[i][j][8 * gp + 2], mg[i][j][8 * gp + 3]);
          ob.x = pack2(mg[i][j][8 * gp + 4], mg[i][j][8 * gp + 5]);
          ob.y = pack2(mg[i][j][8 * gp + 6], mg[i][j][8 * gp + 7]);
          *(uint4*)(M + (size_t)row * D + col) = pair_swap(oa, ob);
        }
  PATCH_LOOP_END
}

__device__ void phase_resid(const Params& p, int l, bool last, const u16* Ain, size_t lda, const u16* W, int K,
                            int bid, int nb, u16* smem) {
  EPI_DECL
  const int nrt_ = n_row_tiles(last);
  PATCH_LOOP_BEGIN(nrt_, 8, 8, 8)
    const int rt = row_tile(last, prt), ct = pct;
    f32x16 acc[2][2];
    zero_acc(acc);
    gemm_core(acc, W + (size_t)ct * 128 * K, K, Ain + (size_t)rt * 128 * lda, lda, K, smem);
    u16* FB = wsp<u16>(p, O_FB);
#pragma unroll
    for (int i = 0; i < 2; i++)
#pragma unroll
      for (int j = 0; j < 2; j++)
#pragma unroll
        for (int gp = 0; gp < 2; gp++) {
          const int row = rt * 128 + wn_ * 64 + j * 32 + r_;
          const int col = ct * 128 + wm_ * 64 + i * 32 + 8 * (2 * gp + hh_);
          uint2 oa, ob;
          oa.x = pack2(acc[i][j][8 * gp], acc[i][j][8 * gp + 1]);
          oa.y = pack2(acc[i][j][8 * gp + 2], acc[i][j][8 * gp + 3]);
          ob.x = pack2(acc[i][j][8 * gp + 4], acc[i][j][8 * gp + 5]);
          ob.y = pack2(acc[i][j][8 * gp + 6], acc[i][j][8 * gp + 7]);
          *(uint4*)(FB + (size_t)row * D + col) = pair_swap(oa, ob);
        }
  PATCH_LOOP_END
}

__device__ void phase_p7(const Params& p, int l, bool last, int bid, int nb, u16* smem) {
  EPI_DECL
  const u16* A = wsp<u16>(p, O_A);
  u16* HH = wsp<u16>(p, O_HH);
  const int nrt_ = n_row_tiles(last);
  PATCH_LOOP_BEGIN(nrt_, 44, 16, 4)
    const int rt = row_tile(last, prt), ct = pct;
    f32x16 acc[2][2];
    zero_acc(acc);
    gemm_core(acc, wsp<u16>(p, O_WGU) + (size_t)ct * 128 * D, D, A + (size_t)rt * 128 * D, D, D, smem);
#pragma unroll
    for (int j = 0; j < 2; j++)
#pragma unroll
      for (int gp = 0; gp < 2; gp++) {
        const int row = rt * 128 + wn_ * 64 + j * 32 + r_;
        const int q = (ct * 2 + wm_) * 32 + 8 * (2 * gp + hh_);
        float hv[8];
#pragma unroll
        for (int t = 0; t < 8; t++) {
          const float gt = acc[0][j][8 * gp + t], up = acc[1][j][8 * gp + t];
          hv[t] = gt * fsigmoid(gt) * up;
        }
        uint2 oa, ob;
        oa.x = pack2(hv[0], hv[1]);
        oa.y = pack2(hv[2], hv[3]);
        ob.x = pack2(hv[4], hv[5]);
        ob.y = pack2(hv[6], hv[7]);
        *(uint4*)(HH + (size_t)row * FH + q) = pair_swap(oa, ob);
      }
  PATCH_LOOP_END
}

constexpr int NPHASE = 3 + 9 * 2;

__device__ void run_phase(const Params& p, int ph, int bid, int nb, u16* smem) {
  if (ph == 0) {
    prep_tables(p, bid, nb);
    prep_modp(p, bid, nb);
    prep_weights(p, 0, bid, nb, smem);
    return;
  }
  if (ph == 1) { prep_modr(p, bid, nb); return; }
  if (ph == 2) { ln_phase(p, 0, p.ln_in_g, p.ln_in_b, 0, 0, 1024, false, bid, nb); return; }
  const int l = (ph - 3) / 9, s = (ph - 3) % 9;
  const bool last = (l == 1);
  switch (s) {
    case 0: phase_p1(p, l, last, bid, nb, smem); break;
    case 1: phase_p2(p, l, bid, nb, smem); break;
    case 2: phase_p3(p, l, last, bid, nb, smem); break;
    case 3: phase_p4(p, l, last, bid, nb, smem); break;
    case 4: phase_resid(p, l, last, wsp<u16>(p, O_M), D, wsp<u16>(p, O_WO), D, bid, nb, smem); break;
    case 5: ln_phase(p, 1, p.ln1_g + l * D, p.ln1_b + l * D, l, 3072, 4096, last, bid, nb, l, 2048); break;
    case 6: phase_p7(p, l, last, bid, nb, smem); break;
    case 7: phase_resid(p, l, last, wsp<u16>(p, O_HH), FH, wsp<u16>(p, O_WD), FH, bid, nb, smem); break;
    default:
      ln_phase(p, 1, p.ln2_g + l * D, p.ln2_b + l * D, last ? -1 : l + 1, 0, 1024, last, bid, nb, l, 5120);
      if (!last) prep_weights(p, l + 1, bid, nb, smem);
      break;
  }
}


#define XB_TMO      128
#define XB_XCNT(j)  (256  + 64 * (j))
#define XB_XSUB(j)  (1280 + 64 * (j))
#define XB_XGEN(j)  (2304 + 64 * (j))
#define XB_TOP      3328
#define XB_TOPGEN   3392
#define XCD_BAR_WORDS 3456
#define XB_SPIN_CAP (1u << 20)
#define LAS __attribute__((address_space(3)))
__device__ __forceinline__ unsigned xb_ld(unsigned* p) { return __hip_atomic_load(p, __ATOMIC_RELAXED, __HIP_MEMORY_SCOPE_AGENT); }
__device__ __forceinline__ unsigned xb_add(unsigned* p, unsigned v) { return __hip_atomic_fetch_add(p, v, __ATOMIC_RELAXED, __HIP_MEMORY_SCOPE_AGENT); }
__device__ __forceinline__ unsigned xb_xcc_id() { return (unsigned)__builtin_amdgcn_s_getreg((3 << 11) | 20) & 0xFu; }
#define XB_SPIN(cond, bar) do { unsigned _sp = 0; while (cond) { __builtin_amdgcn_s_sleep(1); \
    if ((++_sp & 255u) == 0u) { if (xb_ld(&(bar)[XB_TMO])) break; if (_sp > XB_SPIN_CAP) { atomicAdd(&(bar)[XB_TMO], 1u); break; } } } } while (0)
struct XcdBarrier {
  unsigned* bar; unsigned x;
  volatile LAS unsigned* st;
};
__device__ __forceinline__ XcdBarrier xcd_barrier_post(unsigned* bar, volatile LAS unsigned* st) {
  XcdBarrier b; b.bar = bar; b.x = xb_xcc_id(); b.st = st;
  if (threadIdx.x == 0) (void)xb_add(&bar[XB_XCNT(b.x)], 1u);
  return b;
}
__device__ __forceinline__ void xcd_barrier_complete(unsigned* bar, unsigned x, unsigned& nloc, unsigned& nx) {
  const unsigned G = gridDim.x * gridDim.y * gridDim.z;
  unsigned sum, cnt, mine, sp = 0u;
  for (;;) {
    sum = 0u; cnt = 0u; mine = 0u;
#pragma unroll
    for (unsigned j = 0; j < 16; ++j) { const unsigned c = xb_ld(&bar[XB_XCNT(j)]); sum += c; cnt += (c > 0u) ? 1u : 0u; mine = (j == x) ? c : mine; }
    if (sum == G) break;
    __builtin_amdgcn_s_sleep(1);
    if ((++sp & 255u) == 0u) { if (xb_ld(&bar[XB_TMO])) break; if (sp > XB_SPIN_CAP) { atomicAdd(&bar[XB_TMO], 1u); break; } }
  }
  nloc = mine > 0u ? mine : 1u; nx = cnt > 0u ? cnt : 1u;
}
__device__ __forceinline__ void xcd_barrier(const XcdBarrier& b) {
  asm volatile("s_waitcnt vmcnt(0)" ::: "memory");
  __syncthreads();
  if (threadIdx.x == 0) {
    unsigned* bar = b.bar;
    __builtin_amdgcn_s_waitcnt(0);
    unsigned nloc = b.st[0], nx = b.st[1];
    if (nloc == 0u) { xcd_barrier_complete(bar, b.x, nloc, nx); b.st[0] = nloc; b.st[1] = nx; }
    const unsigned old = xb_add(&bar[XB_XSUB(b.x)], 1u);
    const unsigned gen = old / nloc;
    if (old + 1u == (gen + 1u) * nloc) {
      __builtin_amdgcn_fence(__ATOMIC_RELEASE, "agent");
      asm volatile("s_waitcnt vmcnt(0)" ::: "memory");
      const unsigned og = xb_add(&bar[XB_TOP], 1u);
      const unsigned tg = og / nx;
      if (og + 1u == (tg + 1u) * nx) xb_add(&bar[XB_TOPGEN], 1u);
      else XB_SPIN(xb_ld(&bar[XB_TOPGEN]) == tg, bar);
      __builtin_amdgcn_fence(__ATOMIC_ACQUIRE, "agent");
      xb_add(&bar[XB_XGEN(b.x)], 1u);
      asm volatile("s_waitcnt vmcnt(0)" ::: "memory");
    } else {
      XB_SPIN(xb_ld(&bar[XB_XGEN(b.x)]) == gen, bar);
      __builtin_amdgcn_fence(__ATOMIC_ACQUIRE, "agent");
      asm volatile("s_waitcnt vmcnt(0)" ::: "memory");
    }
  }
  __syncthreads();
}

constexpr int SMEM_ELEMS = 4 * SM_A + 256 + 8;

#if COOP
__global__ void __launch_bounds__(256, 2) mega_kernel(Params p) {
  __shared__ __attribute__((aligned(16))) u16 smem[SMEM_ELEMS];
  cg::grid_group grid = cg::this_grid();
  volatile LAS unsigned* st = (volatile LAS unsigned*)(smem + 4 * SM_A + 256);
  if (threadIdx.x == 0) { st[0] = 0u; st[1] = 0u; }
  __syncthreads();
  XcdBarrier xb = xcd_barrier_post((unsigned*)(p.ws + O_BAR), st);
  for (int ph = 0; ph < NPHASE; ph++) {
#ifdef PROBE_MASK
    const int s9 = ph >= 3 ? (ph - 3) % 9 : -1;
    const int nrep = (s9 >= 0 && ((PROBE_MASK >> s9) & 1)) ? 2 : 1;
    for (int rep = 0; rep < nrep; rep++) {
      run_phase(p, ph, blockIdx.x, gridDim.x, smem);
      if (ph == 0) grid.sync();
      else if (ph + 1 < NPHASE || rep + 1 < nrep) xcd_barrier(xb);
    }
#else
    run_phase(p, ph, blockIdx.x, gridDim.x, smem);
    if (ph == 0) grid.sync();
    else if (ph + 1 < NPHASE) xcd_barrier(xb);
#endif
  }
}
#else
__global__ void __launch_bounds__(256, 2) phase_kernel(Params p, int ph) {
  __shared__ __attribute__((aligned(16))) u16 smem[SMEM_ELEMS];
  run_phase(p, ph, blockIdx.x, gridDim.x, smem);
}
#endif

extern "C" void kernel_launch(void* const* d_in, const int* in_sizes, int n_in, void* d_out, int out_size, void* d_ws,
                              size_t ws_size, hipStream_t stream) {
  Params p{};
  const float** f = (const float**)&p;
  for (int i = 0; i < 25; i++) f[i] = (const float*)d_in[i];
  p.out = (float*)d_out;
  p.ws = (unsigned char*)d_ws;
  if (ws_size < O_WSEND) fprintf(stderr, "workspace too small: %zu < %zu\n", ws_size, (size_t)O_WSEND);
#if COOP
  static int grid_blocks = 0;
  if (!grid_blocks) {
    int dev = 0, cus = 0, per_cu = 0;
    hipGetDevice(&dev);
    hipDeviceGetAttribute(&cus, hipDeviceAttributeMultiprocessorCount, dev);
    hipOccupancyMaxActiveBlocksPerMultiprocessor(&per_cu, mega_kernel, 256, 0);
    if (per_cu > 2) per_cu = 2;
    grid_blocks = cus * per_cu;
  }
  (void)hipMemsetAsync(p.ws + O_BAR, 0, 3456 * 4, stream);
  void* args[] = {&p};
  hipError_t e = hipLaunchCooperativeKernel((void*)mega_kernel, dim3(grid_blocks), dim3(256), args, 0, stream);
  if (e != hipSuccess) fprintf(stderr, "cooperative launch failed: %s (grid %d)\n", hipGetErrorString(e), grid_blocks);
#else
  for (int ph = 0; ph < NPHASE; ph++) phase_kernel<<<512, 256, 0, stream>>>(p, ph);
#endif
}
```

```cpp
#include <hip/hip_runtime.h>
#include <hip/hip_cooperative_groups.h>
#include <stdint.h>
#include <cstdio>
namespace cg = cooperative_groups;

#ifndef COOP
#define COOP 1
#endif

typedef __attribute__((ext_vector_type(8))) short bf16x8;
typedef __attribute__((ext_vector_type(4))) short bf16x4;
typedef __attribute__((ext_vector_type(16))) float f32x16;
typedef unsigned short u16;
typedef __attribute__((ext_vector_type(4))) unsigned int u32x4;

constexpr int D = 1024;
constexpr int NBATCH = 2;
constexpr int SEQ = 16384;
constexpr int CTXL = 256;
constexpr int KPB = SEQ + CTXL;
constexpr int T = NBATCH * KPB;
constexpr int NRT = T / 128;
constexpr int FH = 2816;
constexpr int IN_DIM = 5536;
constexpr float LOG2E = 1.4426950408889634f;
constexpr float NA_SCALE_L2 = 0.125f * LOG2E;
constexpr float MLA_SCALE_L2 = 0.10206207261596575f * LOG2E;
constexpr float ALPHA = 1.4142135623730951f;
constexpr float EPS = 1e-5f;
constexpr float RS128 = 0.08838834764831845f;

constexpr size_t al256(size_t x) { return (x + 255) & ~(size_t)255; }
constexpr size_t O_WF = 0;
constexpr size_t O_WP = O_WF + (size_t)1024 * 1024 * 2;
constexpr size_t O_WG = O_WP + (size_t)2048 * 1024 * 2;
constexpr size_t O_WUQ = O_WG + (size_t)3072 * 1024 * 2;
constexpr size_t O_WUKV = O_WUQ + (size_t)768 * 256 * 2;
constexpr size_t O_WB = O_WUKV + (size_t)1024 * 128 * 2;
constexpr size_t O_WO = O_WB + (size_t)3 * 1024 * 512 * 2;
constexpr size_t O_WGU = O_WO + (size_t)1024 * 1024 * 2;
constexpr size_t O_WD = O_WGU + (size_t)5632 * 1024 * 2;
constexpr size_t O_MA = O_WD + (size_t)1024 * 2816 * 2;
constexpr size_t O_MB = O_MA + (size_t)256 * 256 * 2;
constexpr size_t O_MC = O_MB + (size_t)128 * 256 * 2;
constexpr size_t O_TW = O_MC + (size_t)256 * 512 * 2;
constexpr size_t O_MODP = O_TW + (size_t)128 * 128 * 2 * 4;
constexpr size_t O_MOD = O_MODP + (size_t)16 * 2 * 3 * 6144 * 4;
constexpr size_t O_XCTX = O_MOD + (size_t)2 * 3 * 6144 * 4;
constexpr size_t O_D1C = O_XCTX + (size_t)512 * 1024 * 4;
constexpr size_t O_A = O_D1C + (size_t)2 * 512 * 2 * 256 * 2;
constexpr size_t O_RQ = O_A + (size_t)T * 1024 * 2;
constexpr size_t O_QNA = O_RQ;
constexpr size_t O_KNA = O_QNA + (size_t)T * 512 * 2;
constexpr size_t O_VNAT = O_KNA + (size_t)T * 512 * 2;
constexpr size_t O_RY = O_VNAT + (size_t)T * 512 * 2;
constexpr size_t O_Y = O_RY;
constexpr size_t O_D1 = O_RY;
constexpr size_t O_LAT = O_RY + (size_t)67108864;
constexpr size_t O_D2 = O_RY + (size_t)T * 1536 * 2;
constexpr size_t O_QM = O_D2 + (size_t)67108864;
constexpr size_t O_KN = O_QM + (size_t)T * 768 * 2;
constexpr size_t O_KRR = O_KN + (size_t)T * 512 * 2;
constexpr size_t O_VMT = O_KRR + (size_t)T * 32 * 2;
constexpr size_t O_END = O_VMT + (size_t)T * 512 * 2;
constexpr size_t O_BAR = (O_END + 255) & ~(size_t)255;
constexpr size_t O_WSEND = O_BAR + 3456 * 4;
constexpr size_t O_FB = O_QM;
constexpr size_t O_M = O_RQ;
constexpr size_t O_HH = O_RQ;

struct Params {
  const float *x, *c, *ctx, *c_ctx, *ln_in_g, *ln_in_b, *w_mod, *b_mod, *w_in, *gq, *gkv, *w_uq, *w_qr, *w_uk,
      *w_uv, *rpb, *w_branch, *w_out, *ln1_g, *ln1_b, *ln2_g, *ln2_b, *w_gate, *w_up, *w_down;
  float* out;
  unsigned char* ws;
};

__device__ __forceinline__ u16 f2bf(float f) {
  uint32_t u = __float_as_uint(f);
  u += 0x7fffu + ((u >> 16) & 1u);
  return (u16)(u >> 16);
}
typedef __attribute__((ext_vector_type(2))) __bf16 bf16v2;
typedef __attribute__((ext_vector_type(2))) float f32v2;
__device__ __forceinline__ uint32_t pack2(float a, float b) {
  const f32v2 v = {a, b};
  return __builtin_bit_cast(uint32_t, __builtin_convertvector(v, bf16v2));
}
__device__ __forceinline__ uint4 pair_swap(uint2 a, uint2 b) {
  const auto rx = __builtin_amdgcn_permlane32_swap(a.x, b.x, false, false);
  const auto ry = __builtin_amdgcn_permlane32_swap(a.y, b.y, false, false);
  return make_uint4(rx[0], ry[0], rx[1], ry[1]);
}
__device__ __forceinline__ float bf2f(u16 v) { return __uint_as_float(((uint32_t)v) << 16); }
__device__ __forceinline__ float wsum(float v) {
#pragma unroll
  for (int o = 32; o > 0; o >>= 1) v += __shfl_xor(v, o);
  return v;
}
__device__ __forceinline__ float fsigmoid(float v) { return 1.f / (1.f + __expf(-v)); }

__device__ __forceinline__ int ltid() {
  int t = threadIdx.x;
  asm volatile("" : "+v"(t));
  return t;
}

template <typename Tp>
__device__ __forceinline__ Tp* wsp(const Params& p, size_t off) { return (Tp*)(p.ws + off); }

__device__ __forceinline__ float* xrow(const Params& p, int row) {
  int b = row / KPB, kk = row - b * KPB;
  if (kk < CTXL) return wsp<float>(p, O_XCTX) + (size_t)(b * CTXL + kk) * D;
  return p.out + (size_t)(b * SEQ + kk - CTXL) * D;
}

constexpr int LSTR = 72;
constexpr int SM_A = 128 * LSTR;

template <bool DEEP = true>
__device__ __forceinline__ void gemm_core(f32x16 (&acc)[2][2], const u16* __restrict__ A, size_t lda,
                                          const u16* __restrict__ B, size_t ldb, int K, u16* smem) {
  const int tid = ltid(), lane = tid & 63, wave = tid >> 6;
  const int wm = wave >> 1, wn = wave & 1, r = lane & 31, hh = lane >> 5;
  u16* sA = smem;
  u16* sB = smem + 2 * SM_A;
  const int lrow = tid >> 3, lkc = (tid & 7) * 8;
  const unsigned char* gab = (const unsigned char*)A;
  const unsigned char* gbb = (const unsigned char*)B;
  uint32_t oa[4], ob[4];
#pragma unroll
  for (int i = 0; i < 4; i++) {
    oa[i] = (uint32_t)(((size_t)(lrow + 32 * i) * lda + lkc) * 2);
    ob[i] = (uint32_t)(((size_t)(lrow + 32 * i) * ldb + lkc) * 2);
  }
  u16* wa = sA + lrow * LSTR + lkc;
  u16* wb = sB + lrow * LSTR + lkc;
  const u16* pa = sA + (wm * 64 + r) * LSTR + hh * 8;
  const u16* pb = sB + (wn * 64 + r) * LSTR + hh * 8;
  u32x4 a0r[4], b0r[4], a1r[4], b1r[4];
#define G_LOAD(ar, br, ko)                                               \
  _Pragma("unroll") for (int i = 0; i < 4; i++) {                        \
    ar[i] = *(const u32x4*)(gab + (size_t)(ko)*2 + oa[i]);               \
    br[i] = *(const u32x4*)(gbb + (size_t)(ko)*2 + ob[i]);               \
  }
#define G_STORE(ar, br, buf)                                             \
  _Pragma("unroll") for (int i = 0; i < 4; i++) {                        \
    *(u32x4*)(wa + (buf)*SM_A + 32 * i * LSTR) = ar[i];                  \
    *(u32x4*)(wb + (buf)*SM_A + 32 * i * LSTR) = br[i];                  \
  }
#define G_COMPUTE(buf)                                                                   \
  _Pragma("unroll") for (int ks = 0; ks < 4; ks++) {                                     \
    const bf16x8 fa0 = *(const bf16x8*)(pa + (buf)*SM_A + ks * 16);                      \
    const bf16x8 fa1 = *(const bf16x8*)(pa + (buf)*SM_A + 32 * LSTR + ks * 16);          \
    const bf16x8 fb0 = *(const bf16x8*)(pb + (buf)*SM_A + ks * 16);                      \
    const bf16x8 fb1 = *(const bf16x8*)(pb + (buf)*SM_A + 32 * LSTR + ks * 16);          \
    acc[0][0] = __builtin_amdgcn_mfma_f32_32x32x16_bf16(fa0, fb0, acc[0][0], 0, 0, 0);   \
    acc[0][1] = __builtin_amdgcn_mfma_f32_32x32x16_bf16(fa0, fb1, acc[0][1], 0, 0, 0);   \
    acc[1][0] = __builtin_amdgcn_mfma_f32_32x32x16_bf16(fa1, fb0, acc[1][0], 0, 0, 0);   \
    acc[1][1] = __builtin_amdgcn_mfma_f32_32x32x16_bf16(fa1, fb1, acc[1][1], 0, 0, 0);   \
  }
  const int nk = K >> 6;
  if (DEEP) {
    G_LOAD(a0r, b0r, 0)
    G_LOAD(a1r, b1r, 64)
    G_STORE(a0r, b0r, 0)
    __syncthreads();
    const int klast = (nk - 1) * 64;
    G_LOAD(a0r, b0r, min(128, klast))
    for (int kt = 0; kt < nk; kt += 2) {
      G_COMPUTE(0)
      G_STORE(a1r, b1r, 1)
      __syncthreads();
      G_LOAD(a1r, b1r, min((kt + 3) * 64, klast))
      __builtin_amdgcn_sched_barrier(0);
      G_COMPUTE(1)
      G_STORE(a0r, b0r, 0)
      __syncthreads();
      G_LOAD(a0r, b0r, min((kt + 4) * 64, klast))
      __builtin_amdgcn_sched_barrier(0);
    }
  } else {
    G_LOAD(a0r, b0r, 0)
    G_STORE(a0r, b0r, 0)
    __syncthreads();
    for (int kt = 0; kt < nk; kt += 2) {
      G_LOAD(a0r, b0r, (kt + 1) * 64)
      G_COMPUTE(0)
      G_STORE(a0r, b0r, 1)
      __syncthreads();
      if (kt + 2 < nk) G_LOAD(a0r, b0r, (kt + 2) * 64)
      G_COMPUTE(1)
      if (kt + 2 < nk) G_STORE(a0r, b0r, 0)
      __syncthreads();
    }
  }
#undef G_LOAD
#undef G_STORE
#undef G_COMPUTE
}

__device__ __forceinline__ void zero_acc(f32x16 (&acc)[2][2]) {
#pragma unroll
  for (int i = 0; i < 2; i++)
#pragma unroll
    for (int j = 0; j < 2; j++)
#pragma unroll
      for (int e = 0; e < 16; e++) acc[i][j][e] = 0.f;
}

#define EPI_DECL                                                     \
  const int lane_ = ltid() & 63, wave_ = ltid() >> 6;      \
  const int wm_ = wave_ >> 1, wn_ = wave_ & 1, r_ = lane_ & 31, hh_ = lane_ >> 5; \
  (void)wm_; (void)wn_; (void)r_; (void)hh_;

__device__ __forceinline__ const float* src_col(const Params& p, int l, int kind, int n, int& ld) {
  switch (kind) {
    case 0:
      ld = IN_DIM;
      return n < 1952 ? p.w_in + (size_t)l * D * IN_DIM + 512 + n : nullptr;
    case 1:
      ld = IN_DIM;
      return p.w_in + (size_t)l * D * IN_DIM + 2464 + n;
    case 2:
      if (n < 512) {
        ld = 512;
        return p.w_uq + (size_t)l * 256 * 512 + n;
      } else {
        int m = n - 512, wt = m >> 6, jb = (m >> 5) & 1, idx = wt * 32 + (m & 31);
        int h = idx >> 4, e = idx & 15;
        ld = 256;
        return p.w_qr + (size_t)l * 256 * 256 + h * 32 + jb * 16 + e;
      }
    case 3:
      ld = 512;
      return n < 512 ? p.w_uk + (size_t)l * 128 * 512 + n : p.w_uv + (size_t)l * 128 * 512 + (n - 512);
    case 4: {
      int g = n >> 10, nn = n & 1023;
      ld = 1024;
      return p.w_branch + ((size_t)(l * 3 + g) * 512) * 1024 + nn;
    }
    case 5:
      ld = 1024;
      return p.w_out + (size_t)l * D * D + n;
    case 6: {
      int jb = (n >> 5) & 1, q = (n >> 6) * 32 + (n & 31);
      ld = FH;
      return (jb ? p.w_up : p.w_gate) + (size_t)l * D * FH + q;
    }
    default:
      ld = 1024;
      return p.w_down + (size_t)l * FH * D + n;
  }
}

__device__ __forceinline__ int job_nd(int k) {
  switch (k) { case 0: return 2048; case 1: return 3072; case 2: return 768; case 3: return 1024; case 4: return 3072;
    case 5: return 1024; case 6: return 5632; default: return 1024; }
}
__device__ __forceinline__ int job_kd(int k) {
  switch (k) { case 0: return 1024; case 1: return 1024; case 2: return 256; case 3: return 128; case 4: return 512;
    case 5: return 1024; case 6: return 1024; default: return 2816; }
}
__device__ __forceinline__ size_t job_od(int k) {
  switch (k) { case 0: return O_WP; case 1: return O_WG; case 2: return O_WUQ; case 3: return O_WUKV; case 4: return O_WB;
    case 5: return O_WO; case 6: return O_WGU; default: return O_WD; }
}
__device__ void prep_weights(const Params& p, int l, int bid, int nb, u16* smem) {
  float* tile = (float*)smem;
  const int tid = ltid();
  int start = 0;
#pragma unroll 1
  for (int kind = 0; kind < 8; kind++) {
    const int Kk = job_kd(kind);
    const int nkt = Kk >> 6, ntile = (job_nd(kind) >> 6) * nkt;
    u16* dst = wsp<u16>(p, job_od(kind));
    const float* ksc = kind == 2 ? p.gq + l * 256 : (kind == 3 ? p.gkv + l * 128 : nullptr);
    for (int t = (bid + nb - (start % nb)) % nb; t < ntile; t += nb) {
      const int nt = t / nkt, kt = t - nt * nkt;
      const int n0 = nt * 64, k0 = kt * 64;
      {
        const int kq = tid >> 4, nn4 = (tid & 15) * 4;
        int ld;
        const float* sp = src_col(p, l, kind, n0 + nn4, ld);
#pragma unroll
        for (int i = 0; i < 4; i++) {
          const int kk = i * 16 + kq;
          float4 v = make_float4(0.f, 0.f, 0.f, 0.f);
          if (sp) v = *(const float4*)(sp + (size_t)(k0 + kk) * ld);
          if (ksc) {
            const float sc = ksc[k0 + kk];
            v.x *= sc; v.y *= sc; v.z *= sc; v.w *= sc;
          }
          float* tp = tile + kk * 65 + nn4;
          tp[0] = v.x; tp[1] = v.y; tp[2] = v.z; tp[3] = v.w;
        }
      }
      __syncthreads();
#pragma unroll
      for (int i = 0; i < 2; i++) {
        const int c = tid + 256 * i;
        const int nn = c >> 3, kc = (c & 7) * 8;
        const float* tp = tile + kc * 65 + nn;
        uint4 o;
        o.x = pack2(tp[0], tp[65]);
        o.y = pack2(tp[2 * 65], tp[3 * 65]);
        o.z = pack2(tp[4 * 65], tp[5 * 65]);
        o.w = pack2(tp[6 * 65], tp[7 * 65]);
        *(uint4*)(dst + (size_t)(n0 + nn) * Kk + k0 + kc) = o;
      }
      __syncthreads();
    }
    start += ntile;
  }
  {
    float* ctab = (float*)smem;
    __syncthreads();
    if (tid < 128) ctab[tid] = cospif((float)tid * (1.f / 64.f));
    __syncthreads();
    u16* dst = wsp<u16>(p, O_WF);
    for (int it = bid; it < 512; it += nb) {
      const int o = it * 256 + tid;
      const int np = o & 1023, k8 = (o >> 10) * 8;
      const int reim = np >> 9, g = (np >> 7) & 3, m = np & 127;
      const float* w = p.w_in + (size_t)l * D * IN_DIM + (size_t)k8 * IN_DIM + g * 128;
      const int sh = reim ? 96 : 0;
      float a8[8];
#pragma unroll
      for (int j = 0; j < 8; j++) a8[j] = 0.f;
#pragma unroll 4
      for (int c = 0; c < 128; c++) {
        const float tw = ctab[(m * c + sh) & 127];
#pragma unroll
        for (int j = 0; j < 8; j++) a8[j] += w[(size_t)j * IN_DIM + c] * tw;
      }
      uint4 ov;
      ov.x = pack2(a8[0] * RS128, a8[1] * RS128);
      ov.y = pack2(a8[2] * RS128, a8[3] * RS128);
      ov.z = pack2(a8[4] * RS128, a8[5] * RS128);
      ov.w = pack2(a8[6] * RS128, a8[7] * RS128);
      *(uint4*)(dst + (size_t)np * 1024 + k8) = ov;
    }
    __syncthreads();
  }
}

__device__ void prep_tables(const Params& p, int bid, int nb) {
  u16* MA = wsp<u16>(p, O_MA);
  u16* MB = wsp<u16>(p, O_MB);
  u16* MC = wsp<u16>(p, O_MC);
  float* TW = wsp<float>(p, O_TW);
  const int total = 65536 + 32768 + 131072 + 16384;
  for (int idx = bid * 256 + ltid(); idx < total; idx += nb * 256) {
    if (idx < 65536) {
      const int n = idx >> 8, k = idx & 255;
      const int nt = n >> 7, wn = (n >> 6) & 1, jb = (n >> 5) & 1, klo = nt * 64 + wn * 32 + (n & 31);
      const int ri = k >> 7, nhi = k & 127;
      const int xx = (klo * nhi) & 127;
      const float c = cospif((float)xx * (1.f / 64.f)), s = sinpif((float)xx * (1.f / 64.f));
      float v = jb == 0 ? (ri == 0 ? c : -s) : (ri == 0 ? -s : -c);
      MA[idx] = f2bf(v * RS128);
    } else if (idx < 65536 + 32768) {
      const int i2 = idx - 65536;
      const int khi = i2 >> 8, k = i2 & 255;
      const int ri = k >> 7, nlo = k & 127;
      const int xx = (khi * nlo) & 127;
      const float c = cospif((float)xx * (1.f / 64.f)), s = sinpif((float)xx * (1.f / 64.f));
      MB[i2] = f2bf((ri == 0 ? c : s) * RS128);
    } else if (idx < 65536 + 32768 + 131072) {
      const int i2 = idx - 65536 - 32768;
      const int kk = i2 >> 9, k = i2 & 511;
      const int ri = k >> 8, nn = k & 255;
      const int xx = (kk * nn) & 255;
      const float c = cospif((float)xx * (1.f / 128.f)), s = sinpif((float)xx * (1.f / 128.f));
      MC[i2] = f2bf((ri == 0 ? c : -s) * 0.0625f);
    } else {
      const int i2 = idx - 65536 - 32768 - 131072;
      const int klo = i2 >> 7, nlo = i2 & 127;
      const int xx = klo * nlo;
      TW[i2 * 2] = cospif((float)xx * (1.f / 8192.f));
      TW[i2 * 2 + 1] = sinpif((float)xx * (1.f / 8192.f));
    }
  }
}

__device__ void prep_modp(const Params& p, int bid, int nb) {
  float* modp = wsp<float>(p, O_MODP);
  for (int it = bid; it < 2 * 16 * 24; it += nb) {
    const int l = it / (16 * 24), rem = it - l * 16 * 24, kc = rem / 24, nblk = rem - kc * 24;
    const int n = nblk * 256 + ltid();
    const float* w = p.w_mod + (size_t)l * D * 6144 + n;
    float a0 = 0.f, a1 = 0.f, a2 = 0.f;
#pragma unroll 8
    for (int kk = 0; kk < 64; kk++) {
      const int k = kc * 64 + kk;
      const float wv = w[(size_t)k * 6144];
      float c0 = p.c[k], c1 = p.c[1024 + k], c2 = p.c_ctx[k];
      c0 = c0 / (1.f + __expf(-c0));
      c1 = c1 / (1.f + __expf(-c1));
      c2 = c2 / (1.f + __expf(-c2));
      a0 += c0 * wv;
      a1 += c1 * wv;
      a2 += c2 * wv;
    }
    float* o = modp + ((size_t)(kc * 2 + l) * 3) * 6144 + n;
    o[0] = a0;
    o[6144] = a1;
    o[2 * 6144] = a2;
  }
}
__device__ void prep_modr(const Params& p, int bid, int nb) {
  const float* modp = wsp<float>(p, O_MODP);
  float* mod = wsp<float>(p, O_MOD);
  for (int idx = bid * 256 + ltid(); idx < 2 * 3 * 6144; idx += nb * 256) {
    const int l = idx / (3 * 6144), n = idx % 6144;
    float v = p.b_mod[l * 6144 + n];
    for (int kc = 0; kc < 16; kc++) v += modp[(size_t)kc * 2 * 3 * 6144 + idx];
    mod[idx] = v;
  }
}

__device__ void ln_phase(const Params& p, int mode, const float* g, const float* bta, int lmod, int shoff, int scoff,
                         bool skip_ctx, int bid, int nb, int lres = 0, int goff = -1) {
  const int lane = ltid() & 63, wave = ltid() >> 6;
  u16* A = wsp<u16>(p, O_A);
  const float* mod = wsp<float>(p, O_MOD);
  float4 gg[4], bb[4], sh[4], sc[4], gt[4];
#pragma unroll
  for (int q = 0; q < 4; q++) gt[q] = make_float4(0.f, 0.f, 0.f, 0.f);
  int cur_mg = -1;
#pragma unroll
  for (int q = 0; q < 4; q++) {
    const int c0 = (q >> 1) * 512 + lane * 8 + (q & 1) * 4;
    gg[q] = *(const float4*)(g + c0);
    bb[q] = *(const float4*)(bta + c0);
    sh[q] = make_float4(0.f, 0.f, 0.f, 0.f);
    sc[q] = make_float4(0.f, 0.f, 0.f, 0.f);
  }
  int cur_m = -1;
  for (int row = bid * 4 + wave; row < T; row += nb * 4) {
    const int b = row / KPB, kk = row - b * KPB;
    if (skip_ctx && kk < CTXL) continue;
    float* xr = xrow(p, row);
    const float* src;
    if (mode == 0)
      src = kk < CTXL ? p.ctx + (size_t)(b * CTXL + kk) * D : p.x + (size_t)(b * SEQ + kk - CTXL) * D;
    else
      src = xr;
    float4 v[4];
    float s = 0.f;
    const int m = kk < CTXL ? 2 : b;
    if (goff >= 0 && m != cur_mg) {
      cur_mg = m;
#pragma unroll
      for (int q = 0; q < 4; q++)
        gt[q] = *(const float4*)(mod + ((size_t)lres * 3 + m) * 6144 + goff + (q >> 1) * 512 + lane * 8 + (q & 1) * 4);
    }
#pragma unroll
    for (int i = 0; i < 2; i++) {
      uint4 fv = make_uint4(0u, 0u, 0u, 0u);
      if (goff >= 0) fv = *(const uint4*)(wsp<u16>(p, O_FB) + (size_t)row * D + i * 512 + lane * 8);
      const uint32_t fw[4] = {fv.x, fv.y, fv.z, fv.w};
#pragma unroll
      for (int hq = 0; hq < 2; hq++) {
        const int q = i * 2 + hq;
        v[q] = *(const float4*)(src + i * 512 + lane * 8 + hq * 4);
        if (goff >= 0) {
          v[q].x = ALPHA * v[q].x + (1.f + gt[q].x) * __uint_as_float(fw[hq * 2] << 16);
          v[q].y = ALPHA * v[q].y + (1.f + gt[q].y) * __uint_as_float(fw[hq * 2] & 0xffff0000u);
          v[q].z = ALPHA * v[q].z + (1.f + gt[q].z) * __uint_as_float(fw[hq * 2 + 1] << 16);
          v[q].w = ALPHA * v[q].w + (1.f + gt[q].w) * __uint_as_float(fw[hq * 2 + 1] & 0xffff0000u);
        }
        s += v[q].x + v[q].y + v[q].z + v[q].w;
      }
    }
    if (lmod >= 0 && m != cur_m) {
      cur_m = m;
      const float* md = mod + ((size_t)lmod * 3 + m) * 6144;
#pragma unroll
      for (int q = 0; q < 4; q++) {
        const int c0 = (q >> 1) * 512 + lane * 8 + (q & 1) * 4;
        sh[q] = *(const float4*)(md + shoff + c0);
        sc[q] = *(const float4*)(md + scoff + c0);
      }
    }
    const float mu = wsum(s) * (1.f / 1024.f);
    float qs = 0.f;
#pragma unroll
    for (int q = 0; q < 4; q++) {
      v[q].x -= mu; v[q].y -= mu; v[q].z -= mu; v[q].w -= mu;
      qs += v[q].x * v[q].x + v[q].y * v[q].y + v[q].z * v[q].z + v[q].w * v[q].w;
    }
    const float rstd = rsqrtf(wsum(qs) * (1.f / 1024.f) + EPS);
#pragma unroll
    for (int i = 0; i < 2; i++) {
      uint4 o;
      uint32_t ow[4];
#pragma unroll
      for (int hq = 0; hq < 2; hq++) {
        const int q = i * 2 + hq;
        float4 y;
        y.x = v[q].x * rstd * gg[q].x + bb[q].x;
        y.y = v[q].y * rstd * gg[q].y + bb[q].y;
        y.z = v[q].z * rstd * gg[q].z + bb[q].z;
        y.w = v[q].w * rstd * gg[q].w + bb[q].w;
        *(float4*)(xr + i * 512 + lane * 8 + hq * 4) = y;
        ow[hq * 2] = pack2(y.x * (1.f + sc[q].x) + sh[q].x, y.y * (1.f + sc[q].y) + sh[q].y);
        ow[hq * 2 + 1] = pack2(y.z * (1.f + sc[q].z) + sh[q].z, y.w * (1.f + sc[q].w) + sh[q].w);
      }
      if (lmod >= 0) {
        o.x = ow[0]; o.y = ow[1]; o.z = ow[2]; o.w = ow[3];
        *(uint4*)(A + (size_t)row * D + i * 512 + lane * 8) = o;
      }
    }
  }
}

#define PATCH_LOOP_BEGIN(NR_, NC_, PR_, PC_)                                   \
  {                                                                            \
    const int x_ = bid & 7, w_ = bid >> 3, nbx_ = nb >> 3;                     \
    const int CG_ = ((NC_) + (PC_)-1) / (PC_);                                 \
    const int npatch_ = (((NR_) + (PR_)-1) / (PR_)) * CG_;                     \
    for (int u_ = w_;; u_ += nbx_) {                                           \
      const int g_ = (u_ >> 6) * 8 + x_;                                       \
      if (g_ >= npatch_) break;                                                \
      const int s_ = u_ & 63;                                                  \
      const int rg_ = g_ / CG_;                                                \
      const int prt = rg_ * (PR_) + s_ / (PC_);                                \
      const int pct = (g_ - rg_ * CG_) * (PC_) + s_ % (PC_);                   \
      if (prt >= (NR_) || pct >= (NC_)) continue;
#define PATCH_LOOP_END \
    }                  \
  }

__device__ void phase_p1(const Params& p, int l, bool last, int bid, int nb, u16* smem) {
  EPI_DECL
  const u16* A = wsp<u16>(p, O_A);
  PATCH_LOOP_BEGIN(NRT, 16, 8, 8)
    f32x16 acc[2][2];
    zero_acc(acc);
    {
      const int rt = prt, ct = pct;
      const int row0 = rt * 128, b = row0 / KPB, kk0 = row0 - b * KPB;
      if (ct < 8 || ct >= 12) {
        gemm_core(acc, wsp<u16>(p, O_WP) + (size_t)ct * 128 * D, D, A + (size_t)rt * 128 * D, D, D, smem);
        u16* dst;
        float sc = 1.f;
        int cb;
        if (ct < 4) { dst = wsp<u16>(p, O_QNA); sc = NA_SCALE_L2; cb = ct * 128; }
        else if (ct < 8) { dst = wsp<u16>(p, O_KNA); cb = (ct - 4) * 128; }
        else { dst = wsp<u16>(p, O_LAT); cb = (ct - 12) * 128; }
#pragma unroll
        for (int i = 0; i < 2; i++)
#pragma unroll
          for (int j = 0; j < 2; j++)
#pragma unroll
            for (int gp = 0; gp < 2; gp++) {
              const int row = row0 + wn_ * 64 + j * 32 + r_;
              const int col = cb + wm_ * 64 + i * 32 + 8 * (2 * gp + hh_);
              uint2 oa, ob;
              oa.x = pack2(acc[i][j][8 * gp] * sc, acc[i][j][8 * gp + 1] * sc);
              oa.y = pack2(acc[i][j][8 * gp + 2] * sc, acc[i][j][8 * gp + 3] * sc);
              ob.x = pack2(acc[i][j][8 * gp + 4] * sc, acc[i][j][8 * gp + 5] * sc);
              ob.y = pack2(acc[i][j][8 * gp + 6] * sc, acc[i][j][8 * gp + 7] * sc);
              *(uint4*)(dst + (size_t)row * 512 + col) = pair_swap(oa, ob);
            }
      } else {
        gemm_core(acc, A + (size_t)rt * 128 * D, D, wsp<u16>(p, O_WP) + (size_t)ct * 128 * D, D, D, smem);
        u16* dst = wsp<u16>(p, O_VNAT);
        const int cb = (ct - 8) * 128;
#pragma unroll
        for (int i = 0; i < 2; i++)
#pragma unroll
          for (int j = 0; j < 2; j++)
#pragma unroll
            for (int gp = 0; gp < 2; gp++) {
              const int kk = kk0 + wm_ * 64 + i * 32 + 8 * (2 * gp + hh_);
              const int col = cb + wn_ * 64 + j * 32 + r_;
              uint2 oa, ob;
              oa.x = pack2(acc[i][j][8 * gp], acc[i][j][8 * gp + 1]);
              oa.y = pack2(acc[i][j][8 * gp + 2], acc[i][j][8 * gp + 3]);
              ob.x = pack2(acc[i][j][8 * gp + 4], acc[i][j][8 * gp + 5]);
              ob.y = pack2(acc[i][j][8 * gp + 6], acc[i][j][8 * gp + 7]);
              *(uint4*)(dst + ((size_t)(b * 512 + col)) * KPB + kk) = make_uint4(oa.x, oa.y, ob.x, ob.y);
            }
      }
    }
  PATCH_LOOP_END
  PATCH_LOOP_BEGIN(256, 8, 8, 8)
    f32x16 acc[2][2];
    zero_acc(acc);
    {
      const int rt = prt, ct = pct;
      const int b = rt >> 7, nlo = rt & 127;
      gemm_core(acc, A + (size_t)(b * KPB + CTXL + nlo) * D, (size_t)128 * D,
                wsp<u16>(p, O_WF) + (size_t)ct * 128 * D, D, D, smem);
      u16* dst = wsp<u16>(p, O_D1);
#pragma unroll
      for (int i = 0; i < 2; i++)
#pragma unroll
        for (int j = 0; j < 2; j++)
#pragma unroll
          for (int gp = 0; gp < 2; gp++) {
            const int nhi = wm_ * 64 + i * 32 + 8 * (2 * gp + hh_);
            const int n = ct * 128 + wn_ * 64 + j * 32 + r_;
            const int reim = n >> 9, jj = n & 511;
            uint2 oa, ob;
            oa.x = pack2(acc[i][j][8 * gp], acc[i][j][8 * gp + 1]);
            oa.y = pack2(acc[i][j][8 * gp + 2], acc[i][j][8 * gp + 3]);
            ob.x = pack2(acc[i][j][8 * gp + 4], acc[i][j][8 * gp + 5]);
            ob.y = pack2(acc[i][j][8 * gp + 6], acc[i][j][8 * gp + 7]);
            *(uint4*)(dst + ((((size_t)(b * 512 + jj)) * 128 + nlo) * 2 + reim) * 128 + nhi) = pair_swap(oa, ob);
          }
    }
  PATCH_LOOP_END
  if (!last) {
    for (int t2 = bid; t2 < 32; t2 += nb) {
      f32x16 acc[2][2];
      zero_acc(acc);
      const int rt = t2 >> 3, ct = t2 & 7;
      const int b = rt >> 1, rb = rt & 1;
      gemm_core(acc, A + (size_t)(b * KPB + rb * 128) * D, D, wsp<u16>(p, O_WF) + (size_t)ct * 128 * D, D, D, smem);
      u16* dst = wsp<u16>(p, O_D1C);
#pragma unroll
      for (int i = 0; i < 2; i++)
#pragma unroll
        for (int j = 0; j < 2; j++)
#pragma unroll
          for (int gp = 0; gp < 2; gp++) {
            const int nc = rb * 128 + wm_ * 64 + i * 32 + 8 * (2 * gp + hh_);
            const int n = ct * 128 + wn_ * 64 + j * 32 + r_;
            const int reim = n >> 9, jj = n & 511;
            uint2 oa, ob;
            oa.x = pack2(acc[i][j][8 * gp], acc[i][j][8 * gp + 1]);
            oa.y = pack2(acc[i][j][8 * gp + 2], acc[i][j][8 * gp + 3]);
            ob.x = pack2(acc[i][j][8 * gp + 4], acc[i][j][8 * gp + 5]);
            ob.y = pack2(acc[i][j][8 * gp + 6], acc[i][j][8 * gp + 7]);
            *(uint4*)(dst + (((size_t)(b * 512 + jj)) * 2 + reim) * 256 + nc) = pair_swap(oa, ob);
          }
    }
  }
}

__device__ __forceinline__ float inv_freq(int i) {
  switch (i) {
    case 0: return 1.0f;
    case 1: return 0.31622776601683794f;
    case 2: return 0.1f;
    case 3: return 0.03162277660168379f;
    case 4: return 0.01f;
    case 5: return 0.0031622776601683794f;
    case 6: return 0.001f;
    default: return 0.00031622776601683794f;
  }
}
__device__ __forceinline__ void rope_cs(int kk, int e, float& cs, float& sn) {
  if (kk < CTXL) { cs = 1.f; sn = 0.f; return; }
  const int tkn = kk - CTXL;
  const float pos = (e < 8) ? (float)(tkn >> 6) : (float)(tkn & 63);
  const float ang = pos * inv_freq(e & 7);
  double xr = (double)ang * 0.31830988618379067;
  xr -= 2.0 * floor(xr * 0.5);
  const float yr = (float)xr;
  cs = cospif(yr);
  sn = sinpif(yr);
}

__device__ __forceinline__ void row_rms(const u16* A, size_t lda, int K, float* rs) {
  const int tid = ltid();
  const int row = tid >> 1, half = tid & 1;
  const u16* pr = A + (size_t)row * lda + half * (K >> 1);
  float s = 0.f;
  for (int c = 0; c < (K >> 1); c += 8) {
    uint4 v = *(const uint4*)(pr + c);
    const uint32_t w[4] = {v.x, v.y, v.z, v.w};
#pragma unroll
    for (int q = 0; q < 4; q++) {
      const float a = __uint_as_float(w[q] << 16), bq = __uint_as_float(w[q] & 0xffff0000u);
      s += a * a + bq * bq;
    }
  }
  s += __shfl_xor(s, 1);
  if (half == 0) rs[row] = rsqrtf(s / (float)K + EPS);
  __syncthreads();
}

__device__ void phase_p2(const Params& p, int l, int bid, int nb, u16* smem) {
  EPI_DECL
  const u16* LAT = wsp<u16>(p, O_LAT);
  float* rs = (float*)(smem + 4 * SM_A);
  const int nQ = NRT * 6, nKV = NRT * 8, nFA = 1024 * 2, nKR = NRT;
  const int total = nQ + nKV + nFA + nKR;
  for (int t = bid; t < total; t += nb) {
    if (t < nQ) {
      const int rt = t / 6, ct = t - rt * 6;
      const int row0 = rt * 128, b = row0 / KPB, kk0 = row0 - b * KPB;
      row_rms(LAT + (size_t)row0 * 512, 512, 256, rs);
      f32x16 acc[2][2];
      zero_acc(acc);
      gemm_core(acc, wsp<u16>(p, O_WUQ) + (size_t)ct * 128 * 256, 256, LAT + (size_t)row0 * 512, 512, 256, smem);
      u16* QM = wsp<u16>(p, O_QM);
      if (ct < 4) {
#pragma unroll
        for (int i = 0; i < 2; i++)
#pragma unroll
          for (int j = 0; j < 2; j++)
#pragma unroll
            for (int gp = 0; gp < 2; gp++) {
              const int rl = wn_ * 64 + j * 32 + r_;
              const int col = ct * 128 + wm_ * 64 + i * 32 + 8 * (2 * gp + hh_);
              const int h = col >> 6, d = col & 63;
              const float sc = rs[rl] * MLA_SCALE_L2;
              uint2 oa, ob;
              oa.x = pack2(acc[i][j][8 * gp] * sc, acc[i][j][8 * gp + 1] * sc);
              oa.y = pack2(acc[i][j][8 * gp + 2] * sc, acc[i][j][8 * gp + 3] * sc);
              ob.x = pack2(acc[i][j][8 * gp + 4] * sc, acc[i][j][8 * gp + 5] * sc);
              ob.y = pack2(acc[i][j][8 * gp + 6] * sc, acc[i][j][8 * gp + 7] * sc);
              *(uint4*)(QM + (size_t)(row0 + rl) * 768 + h * 96 + d) = pair_swap(oa, ob);
            }
      } else {
        const int wt = (ct - 4) * 2 + wm_;
#pragma unroll
        for (int j = 0; j < 2; j++) {
          const int rl = wn_ * 64 + j * 32 + r_;
          const float sc = rs[rl] * MLA_SCALE_L2;
          uint2 p1[4], p2[4];
#pragma unroll
          for (int g = 0; g < 4; g++) {
            const int idx = wt * 32 + 8 * g + 4 * hh_;
            const int e16 = idx & 15;
            float o1[4], o2[4];
#pragma unroll
            for (int q = 0; q < 4; q++) {
              float cs, sn;
              rope_cs(kk0 + rl, e16 + q, cs, sn);
              const float x1 = acc[0][j][4 * g + q] * sc, x2 = acc[1][j][4 * g + q] * sc;
              o1[q] = x1 * cs - x2 * sn;
              o2[q] = x2 * cs + x1 * sn;
            }
            p1[g].x = pack2(o1[0], o1[1]);
            p1[g].y = pack2(o1[2], o1[3]);
            p2[g].x = pack2(o2[0], o2[1]);
            p2[g].y = pack2(o2[2], o2[3]);
          }
#pragma unroll
          for (int gp = 0; gp < 2; gp++) {
            u16* qd = QM + (size_t)(row0 + rl) * 768 + (2 * wt + gp) * 96 + 64 + 8 * hh_;
            *(uint4*)qd = pair_swap(p1[2 * gp], p1[2 * gp + 1]);
            *(uint4*)(qd + 16) = pair_swap(p2[2 * gp], p2[2 * gp + 1]);
          }
        }
      }
      __syncthreads();
    } else if (t < nQ + nKV) {
      const int t2 = t - nQ;
      const int rt = t2 >> 3, ct = t2 & 7;
      const int row0 = rt * 128, b = row0 / KPB, kk0 = row0 - b * KPB;
      row_rms(LAT + (size_t)row0 * 512 + 256, 512, 128, rs);
      f32x16 acc[2][2];
      zero_acc(acc);
      if (ct < 4) {
        gemm_core(acc, wsp<u16>(p, O_WUKV) + (size_t)ct * 128 * 128, 128, LAT + (size_t)row0 * 512 + 256, 512, 128,
                  smem);
        u16* KN = wsp<u16>(p, O_KN);
#pragma unroll
        for (int i = 0; i < 2; i++)
#pragma unroll
          for (int j = 0; j < 2; j++)
#pragma unroll
            for (int gp = 0; gp < 2; gp++) {
              const int rl = wn_ * 64 + j * 32 + r_;
              const int col = ct * 128 + wm_ * 64 + i * 32 + 8 * (2 * gp + hh_);
              const float sc = rs[rl];
              uint2 oa, ob;
              oa.x = pack2(acc[i][j][8 * gp] * sc, acc[i][j][8 * gp + 1] * sc);
              oa.y = pack2(acc[i][j][8 * gp + 2] * sc, acc[i][j][8 * gp + 3] * sc);
              ob.x = pack2(acc[i][j][8 * gp + 4] * sc, acc[i][j][8 * gp + 5] * sc);
              ob.y = pack2(acc[i][j][8 * gp + 6] * sc, acc[i][j][8 * gp + 7] * sc);
              *(uint4*)(KN + (size_t)(row0 + rl) * 512 + col) = pair_swap(oa, ob);
            }
      } else {
        gemm_core(acc, LAT + (size_t)row0 * 512 + 256, 512, wsp<u16>(p, O_WUKV) + (size_t)ct * 128 * 128, 128, 128,
                  smem);
        u16* VMT = wsp<u16>(p, O_VMT);
#pragma unroll
        for (int i = 0; i < 2; i++)
#pragma unroll
          for (int j = 0; j < 2; j++)
#pragma unroll
            for (int gp = 0; gp < 2; gp++) {
              const int ra = wm_ * 64 + i * 32 + 16 * gp + 4 * hh_;
              const int rb2 = ra + 8;
              const int rst = wm_ * 64 + i * 32 + 8 * (2 * gp + hh_);
              const int col = (ct - 4) * 128 + wn_ * 64 + j * 32 + r_;
              uint2 oa, ob;
              oa.x = pack2(acc[i][j][8 * gp] * rs[ra], acc[i][j][8 * gp + 1] * rs[ra + 1]);
              oa.y = pack2(acc[i][j][8 * gp + 2] * rs[ra + 2], acc[i][j][8 * gp + 3] * rs[ra + 3]);
              ob.x = pack2(acc[i][j][8 * gp + 4] * rs[rb2], acc[i][j][8 * gp + 5] * rs[rb2 + 1]);
              ob.y = pack2(acc[i][j][8 * gp + 6] * rs[rb2 + 2], acc[i][j][8 * gp + 7] * rs[rb2 + 3]);
              *(uint4*)(VMT + ((size_t)(b * 512 + col)) * KPB + kk0 + rst) = make_uint4(oa.x, oa.y, ob.x, ob.y);
            }
      }
      __syncthreads();
    } else if (t < nQ + nKV + nFA) {
      const int t2 = t - nQ - nKV;
      const int rt = t2 >> 1, ct = t2 & 1;
      const int b = rt >> 9, jj = rt & 511;
      f32x16 acc[2][2];
      zero_acc(acc);
      gemm_core(acc, wsp<u16>(p, O_D1) + (size_t)rt * 128 * 256, 256, wsp<u16>(p, O_MA) + (size_t)ct * 128 * 256, 256,
                256, smem);
      const float* TW = wsp<float>(p, O_TW);
      u16* D2 = wsp<u16>(p, O_D2);
      const int klo = ct * 64 + wn_ * 32 + r_;
      const float2* twp = (const float2*)TW + klo;
#pragma unroll
      for (int i = 0; i < 2; i++)
      {
        uint2 pr[4], pi[4];
#pragma unroll
        for (int g = 0; g < 4; g++) {
          const int nlo = wm_ * 64 + i * 32 + 8 * g + 4 * hh_;
          float re[4], im[4];
#pragma unroll
          for (int q = 0; q < 4; q++) {
            const float2 tw = twp[(nlo + q) * 128];
            const float ar = acc[i][0][4 * g + q], ai = acc[i][1][4 * g + q];
            re[q] = ar * tw.x + ai * tw.y;
            im[q] = ai * tw.x - ar * tw.y;
          }
          pr[g].x = pack2(re[0], re[1]);
          pr[g].y = pack2(re[2], re[3]);
          pi[g].x = pack2(im[0], im[1]);
          pi[g].y = pack2(im[2], im[3]);
        }
#pragma unroll
        for (int gp = 0; gp < 2; gp++) {
          u16* d = D2 + ((((size_t)(b * 128 + klo)) * 512 + jj) * 2) * 128 + wm_ * 64 + i * 32 + 8 * (2 * gp + hh_);
          *(uint4*)d = pair_swap(pr[2 * gp], pr[2 * gp + 1]);
          *(uint4*)(d + 128) = pair_swap(pi[2 * gp], pi[2 * gp + 1]);
        }
      }
    } else {
      const int rt = t - nQ - nKV - nFA;
      u16* KRR = wsp<u16>(p, O_KRR);
      for (int idx = ltid(); idx < 128 * 16; idx += 256) {
        const int rl = idx >> 4, e16 = idx & 15;
        const int row = rt * 128 + rl, b = row / KPB, kk = row - b * KPB;
        const float x1 = bf2f(LAT[(size_t)row * 512 + 384 + e16]), x2 = bf2f(LAT[(size_t)row * 512 + 400 + e16]);
        float cs, sn;
        rope_cs(kk, e16, cs, sn);
        KRR[(size_t)row * 32 + e16] = f2bf(x1 * cs - x2 * sn);
        KRR[(size_t)row * 32 + 16 + e16] = f2bf(x2 * cs + x1 * sn);
      }
    }
  }
}

template <int MODE>
__device__ void attn_item(const Params& p, int l, int b, int h, int q0  ,
                          int ntiles  , int rs0, int ycol, u16* smem) {
  constexpr int DQK = MODE == 0 ? 96 : 64;
  constexpr int KSTR = DQK + 8;
  constexpr int NKS = DQK / 16;
  constexpr int CPR = DQK / 8;
  constexpr int NKC = 64 * CPR / 256;
  const int tid = ltid(), lane = tid & 63, wave = tid >> 6, r = lane & 31, hh = lane >> 5;
  u16* Ks = smem;
  u16* Vs = smem + 2 * 64 * KSTR;
  const unsigned char* wsb = p.ws;
  const int qk = q0 + wave * 32 + r;
  const size_t qrow = (size_t)b * KPB + qk;
  bf16x8 qf[NKS];
  {
    const u16* qp = MODE == 0 ? wsp<u16>(p, O_QM) + qrow * 768 + h * 96 : wsp<u16>(p, O_QNA) + qrow * 512 + h * 64;
#pragma unroll
    for (int ks = 0; ks < NKS; ks++) qf[ks] = *(const bf16x8*)(qp + ks * 16 + hh * 8);
  }
  const short one_or_zero = hh == 0 ? (short)0x3F80 : (short)0;
  const bf16x8 kone = {one_or_zero, 0, 0, 0, 0, 0, 0, 0};
  bf16x8 qm = {0, 0, 0, 0, 0, 0, 0, 0};
  int qr = 0, qc = 0, rsq = 0, cs = 0;
  const float* rpb = nullptr;
  if (MODE == 1 && rs0 >= 0) {
    const int tkn = qk - CTXL;
    qr = tkn >> 6;
    qc = tkn & 63;
    rsq = min(max(qr - 4, 0), 248);
    cs = min(max(qc - 8, 0), 48);
    rpb = p.rpb + ((size_t)(l * 8 + h)) * 15 * 31;
  }
  f32x16 o[2];
#pragma unroll
  for (int e = 0; e < 16; e++) { o[0][e] = 0.f; o[1][e] = 0.f; }
  float lsum = 0.f;
  float m = 0.f;
  const bf16x8 ones = {(short)0x3F80, (short)0x3F80, (short)0x3F80, (short)0x3F80,
                       (short)0x3F80, (short)0x3F80, (short)0x3F80, (short)0x3F80};

#define KGEO(i)                                                                                          \
  uint32_t kof##i, kmu##i;                                                                               \
  int kls##i;                                                                                            \
  {                                                                                                      \
    const int c = tid + 256 * (i);                                                                       \
    const int row = c / CPR, cc = c - row * CPR;                                                         \
    if (MODE == 0 && cc >= 8) {                                                                          \
      kof##i = (uint32_t)(O_KRR + ((size_t)(b * KPB + row) * 32 + (cc - 8) * 8) * 2);                    \
      kmu##i = 64u;                                                                                      \
    } else {                                                                                             \
      kof##i = (uint32_t)((MODE == 0 ? O_KN : O_KNA) + ((size_t)(b * KPB + row) * 512 + h * 64 + cc * 8) * 2); \
      kmu##i = 1024u;                                                                                    \
    }                                                                                                    \
    kls##i = row * KSTR + cc * 8;                                                                        \
  }
#define VGEO(i)                                                                                          \
  uint32_t vof##i;                                                                                       \
  int vls##i;                                                                                            \
  bool vsx##i;                                                                                           \
  {                                                                                                      \
    const int c = tid + 256 * (i);                                                                       \
    const int d = c >> 3, cc = c & 7;                                                                    \
    vof##i = (uint32_t)((MODE == 0 ? O_VMT : O_VNAT) + ((size_t)(b * 512 + h * 64 + d) * KPB + cc * 8) * 2); \
    vls##i = d * 72 + cc * 8;                                                                            \
    vsx##i = (d & 8) != 0;                                                                               \
  }
  KGEO(0) KGEO(1) KGEO(2) VGEO(0) VGEO(1)
  (void)kof2; (void)kmu2; (void)kls2;
  u32x4 kr0A, kr1A, kr2A, vr0A, vr1A, kr0B, kr1B, kr2B, vr0B, vr1B;
  kr2A = kr1A = kr0A = vr0A = vr1A = kr2B = kr1B = kr0B = vr0B = vr1B = (u32x4){0u, 0u, 0u, 0u};
#define TILE_KK0(t) ((MODE == 1 && (t) >= 4) ? (uint32_t)(CTXL + 64 * min(rs0 + (t)-4, 255)) : (uint32_t)(64 * (t)))
#define LOAD_KV(t, S)                                                                   \
  {                                                                                     \
    const uint32_t kk0_ = TILE_KK0(t);                                                  \
    kr0##S = *(const u32x4*)(wsb + (size_t)(kof0 + kk0_ * kmu0));                       \
    kr1##S = *(const u32x4*)(wsb + (size_t)(kof1 + kk0_ * kmu1));                       \
    if (NKC == 3) kr2##S = *(const u32x4*)(wsb + (size_t)(kof2 + kk0_ * kmu2));         \
    vr0##S = *(const u32x4*)(wsb + (size_t)(vof0 + kk0_ * 2u));                         \
    vr1##S = *(const u32x4*)(wsb + (size_t)(vof1 + kk0_ * 2u));                         \
  }
#define STORE_V1(buf, i, srcv)                                                          \
  {                                                                                     \
    *(u32x4*)(Vs + (buf)*64 * 72 + vls##i) = srcv;                                      \
  }
#define STORE_KV(buf, S)                                                                \
  {                                                                                     \
    *(u32x4*)(Ks + (buf)*64 * KSTR + kls0) = kr0##S;                                    \
    *(u32x4*)(Ks + (buf)*64 * KSTR + kls1) = kr1##S;                                    \
    if (NKC == 3) *(u32x4*)(Ks + (buf)*64 * KSTR + kls2) = kr2##S;                      \
    STORE_V1(buf, 0, vr0##S) STORE_V1(buf, 1, vr1##S)                                   \
  }
#define QK_TILE(kbuf, t)                                                                           \
  {                                                                                                \
    const u16* kb_ = Ks + (kbuf)*64 * KSTR + r * KSTR + hh * 8;                                    \
    {                                                                                              \
      f32x16 z_;                                                                                   \
      _Pragma("unroll") for (int e = 0; e < 16; e++) z_[e] = 0.f;                                  \
      sc[0] = __builtin_amdgcn_mfma_f32_32x32x16_bf16(kone, qm, z_, 0, 0, 0);                      \
      sc[1] = sc[0];                                                                               \
    }                                                                                              \
    _Pragma("unroll") for (int ks = 0; ks < NKS; ks++) {                                           \
      const bf16x8 kf0 = *(const bf16x8*)(kb_ + ks * 16);                                          \
      const bf16x8 kf1 = *(const bf16x8*)(kb_ + 32 * KSTR + ks * 16);                              \
      sc[0] = __builtin_amdgcn_mfma_f32_32x32x16_bf16(kf0, qf[ks], sc[0], 0, 0, 0);                \
      sc[1] = __builtin_amdgcn_mfma_f32_32x32x16_bf16(kf1, qf[ks], sc[1], 0, 0, 0);                \
    }                                                                                              \
    if (MODE == 1 && (t) >= 4) {                                                                   \
      const int kr_ = rs0 + (t)-4;                                                                 \
      const bool rowok = (kr_ >= rsq) && (kr_ < rsq + 8);                                          \
      const float* rp = rpb + (kr_ - qr + 7) * 31 + (15 - qc);                                     \
      _Pragma("unroll") for (int kb = 0; kb < 2; kb++) _Pragma("unroll") for (int e = 0; e < 16; e++) { \
        const int kc = kb * 32 + (e & 3) + 8 * (e >> 2) + 4 * hh;                                  \
        const bool valid = rowok && (kc >= cs) && (kc < cs + 16);                                  \
        float bias = 0.f;                                                                          \
        if (valid) bias = rp[kc];                                                                  \
        sc[kb][e] = valid ? sc[kb][e] + bias * LOG2E : -1e30f;                                     \
      }                                                                                            \
    }                                                                                              \
  }
#define TILE_MAX(tmax)                                                                             \
  {                                                                                                \
    tmax = sc[0][0];                                                                               \
    _Pragma("unroll") for (int e = 1; e < 16; e++) tmax = fmaxf(tmax, sc[0][e]);                   \
    _Pragma("unroll") for (int e = 0; e < 16; e++) tmax = fmaxf(tmax, sc[1][e]);                   \
    const uint32_t tu = __float_as_uint(tmax);                                                     \
    const auto sw = __builtin_amdgcn_permlane32_swap(tu, tu, false, false);                        \
    tmax = fmaxf(__uint_as_float(sw[0]), __uint_as_float(sw[1]));                                  \
  }
#define MOVE_REF(mnew_)                                                                            \
  {                                                                                                \
    const float mq_ = bf2f(f2bf(mnew_));                                                           \
    const float delta_ = mq_ - m;                                                                  \
    const float alpha = __builtin_amdgcn_exp2f(-delta_);                                           \
    m = mq_;                                                                                       \
    _Pragma("unroll") for (int e = 0; e < 16; e++) {                                               \
      o[0][e] *= alpha; o[1][e] *= alpha;                                                         \
      sc[0][e] -= delta_; sc[1][e] -= delta_;                                                      \
    }                                                                                              \
    lsum *= alpha;                                                                                 \
    qm[0] = (hh == 0) ? (short)f2bf(-m) : (short)0;                                                \
  }
#define SOFTMAX_PV(vbuf)                                                                           \
  {                                                                                                \
    const u16* vb_ = Vs + (vbuf)*64 * 72 + r * 72 + 8 * hh;                                        \
    _Pragma("unroll") for (int kb = 0; kb < 2; kb++) _Pragma("unroll") for (int st = 0; st < 2; st++) { \
      u32x4 pu;                                                                                    \
      _Pragma("unroll") for (int q = 0; q < 4; q++) {                                              \
        const float p0_ = __builtin_amdgcn_exp2f(sc[kb][8 * st + 2 * q]);                          \
        const float p1_ = __builtin_amdgcn_exp2f(sc[kb][8 * st + 2 * q + 1]);                      \
        lsum += p0_ + p1_;                                                                         \
        pu[q] = pack2(p0_, p1_);                                                                   \
      }                                                                                            \
      const bf16x8 pbv = __builtin_bit_cast(bf16x8, pu);                                           \
      _Pragma("unroll") for (int db = 0; db < 2; db++) {                                           \
        const u16* vp = vb_ + db * 32 * 72 + kb * 32 + 16 * st;                                    \
        const bf16x8 vfv = *(const bf16x8*)(vp);     \
        o[db] = __builtin_amdgcn_mfma_f32_32x32x16_bf16(vfv, pbv, o[db], 0, 0, 0);                 \
      }                                                                                            \
    }                                                                                              \
  }
#define DEFER_REF(tmax)                                                                            \
  if (__any(tmax > 8.f)) {                                                                         \
    const float mq_ = bf2f(f2bf(m + fmaxf(tmax, 0.f)));                                            \
    const float alpha = __builtin_amdgcn_exp2f(m - mq_);                                           \
    m = mq_;                                                                                       \
    _Pragma("unroll") for (int e = 0; e < 16; e++) { o[0][e] *= alpha; o[1][e] *= alpha; }       \
    lsum *= alpha;                                                                                 \
    qm[0] = (hh == 0) ? (short)f2bf(-m) : (short)0;                                                \
  }
#define ATT_STEP(t, LD, ST)                                        \
  {                                                                \
    const int cur = (t)&1;                                         \
    QK_TILE(cur, t)                                                \
    __builtin_amdgcn_sched_barrier(0);                             \
    LOAD_KV(min((t) + 2, tl), LD)                                  \
    __builtin_amdgcn_sched_barrier(0);                             \
    __builtin_amdgcn_s_setprio(1);                                 \
    SOFTMAX_PV(cur)                                                \
    __builtin_amdgcn_s_setprio(0);                                 \
      \
                               \
    if ((((t) & 3) == 1)) {                                        \
      float tmax;                                                  \
      TILE_MAX(tmax)                                               \
      DEFER_REF(tmax)                                              \
    }                                                              \
    STORE_KV(cur ^ 1, ST)                                          \
    __syncthreads();                                               \
  }

  const int tl = ntiles - 1;
  f32x16 sc[2];
  LOAD_KV(0, A)
  STORE_KV(0, A)
  LOAD_KV(min(1, tl), A)
  __syncthreads();
  {
    LOAD_KV(min(2, tl), B)
    __builtin_amdgcn_sched_barrier(0);
    QK_TILE(0, 0)
    float tmax;
    TILE_MAX(tmax)
    MOVE_REF(tmax)
    SOFTMAX_PV(0)
    STORE_KV(1, A)
    __syncthreads();
  }
  for (int t = 1; t + 1 < ntiles; t += 2) {
    ATT_STEP(t, A, B)
    ATT_STEP(t + 1, B, A)
  }
  ATT_STEP(tl, A, B)
  const float inv = 1.f / (lsum + __shfl_xor(lsum, 32));
  u16* yp = wsp<u16>(p, O_Y) + qrow * 1536 + ycol + h * 64;
#pragma unroll
  for (int db = 0; db < 2; db++)
#pragma unroll
    for (int gp = 0; gp < 2; gp++) {
      uint2 oa, ob;
      oa.x = pack2(o[db][8 * gp] * inv, o[db][8 * gp + 1] * inv);
      oa.y = pack2(o[db][8 * gp + 2] * inv, o[db][8 * gp + 3] * inv);
      ob.x = pack2(o[db][8 * gp + 4] * inv, o[db][8 * gp + 5] * inv);
      ob.y = pack2(o[db][8 * gp + 6] * inv, o[db][8 * gp + 7] * inv);
      *(uint4*)(yp + db * 32 + 8 * (2 * gp + hh)) = pair_swap(oa, ob);
    }
#undef KGEO
#undef VGEO
#undef TILE_KK0
#undef LOAD_KV
#undef STORE_V1
#undef STORE_KV
#undef QK_TILE
#undef TILE_MAX
#undef MOVE_REF
#undef SOFTMAX_PV
#undef ATT_STEP
#undef DEFER_REF
}

__device__ void phase_p3(const Params& p, int l, bool last, int bid, int nb, u16* smem) {
  EPI_DECL
  const int nMLA = 2048, nNA = 2048, nFB = 1024;
  const int nC = last ? 0 : (32 + 32 + 16);
  const int total = nMLA + nNA + nFB + nC;
  for (int t = bid; t < total; t += nb) {
    int kind, b = 0, h = 0, q0 = 0, ntl = 0, rs0 = -1;
    size_t aoff = 0, boff = 0;
    int Kf = 256, j0 = 0, tok0 = 0, tokmul = 1, colbase = 0;
    if (t < nMLA) {
      kind = 0;
      h = t & 7;
      const int rest = t >> 3;
      b = rest >> 7;
      q0 = CTXL + (rest & 127) * 128;
      ntl = 260;
    } else if (t < nMLA + nNA) {
      kind = 1;
      const int t2 = t - nMLA;
      h = t2 & 7;
      const int rest = t2 >> 3, rp = rest & 127;
      b = rest >> 7;
      rs0 = min(max(2 * rp - 4, 0), 248);
      const int rs1 = min(max(2 * rp + 1 - 4, 0), 248);
      q0 = CTXL + rp * 128;
      ntl = (4 + (rs1 + 8 - rs0) + 1) & ~1;
    } else if (t < nMLA + nNA + nFB) {
      kind = 2;
      const int rt = t - nMLA - nNA;
      const int bk = rt >> 2;
      j0 = (rt & 3) * 128;
      b = bk >> 7;
      tok0 = CTXL + (bk & 127);
      tokmul = 128;
      aoff = O_D2 + (size_t)rt * 128 * 256 * 2;
      boff = O_MB;
      Kf = 256;
    } else {
      const int t2 = t - nMLA - nNA - nFB;
      if (t2 < 64) {
        kind = t2 >> 5;
        const int t3 = t2 & 31;
        h = t3 & 7;
        b = (t3 >> 3) & 1;
        q0 = (t3 >> 4) * 128;
        ntl = 4;
      } else {
        kind = 2;
        const int t3 = t2 - 64;
        const int rt = t3 >> 1, ct = t3 & 1;
        b = rt >> 2;
        j0 = (rt & 3) * 128;
        colbase = ct * 128;
        aoff = O_D1C + (size_t)rt * 128 * 512 * 2;
        boff = O_MC + (size_t)ct * 128 * 512 * 2;
        Kf = 512;
      }
    }
    if (kind == 0) {
      attn_item<0>(p, l, b, h, q0, ntl, -1, 1024, smem);
    } else if (kind == 1) {
      attn_item<1>(p, l, b, h, q0, ntl, rs0, 512, smem);
    } else {
      f32x16 acc[2][2];
      zero_acc(acc);
      gemm_core(acc, wsp<u16>(p, aoff), Kf, wsp<u16>(p, boff), Kf, Kf, smem);
      u16* Y = wsp<u16>(p, O_Y);
#pragma unroll
      for (int i = 0; i < 2; i++)
#pragma unroll
        for (int j = 0; j < 2; j++)
#pragma unroll
          for (int gp = 0; gp < 2; gp++) {
            const int jj = j0 + wm_ * 64 + i * 32 + 8 * (2 * gp + hh_);
            const int tok = tok0 + (colbase + wn_ * 64 + j * 32 + r_) * tokmul;
            uint2 oa, ob;
            oa.x = pack2(acc[i][j][8 * gp], acc[i][j][8 * gp + 1]);
            oa.y = pack2(acc[i][j][8 * gp + 2], acc[i][j][8 * gp + 3]);
            ob.x = pack2(acc[i][j][8 * gp + 4], acc[i][j][8 * gp + 5]);
            ob.y = pack2(acc[i][j][8 * gp + 6], acc[i][j][8 * gp + 7]);
            *(uint4*)(Y + ((size_t)b * KPB + tok) * 1536 + jj) = pair_swap(oa, ob);
          }
    }
  }
}

__device__ __forceinline__ int n_row_tiles(bool last) { return last ? NRT - 4 : NRT; }
__device__ __forceinline__ int row_tile(bool last, int i) {
  if (!last) return i;
  return i < 128 ? i + 2 : i + 4;
}

__device__ void phase_p4(const Params& p, int l, bool last, int bid, int nb, u16* smem) {
  EPI_DECL
  const u16* A = wsp<u16>(p, O_A);
  const u16* Y = wsp<u16>(p, O_Y);
  u16* M = wsp<u16>(p, O_M);
  uint4* stash = wsp<uint4>(p, O_QM) + (size_t)bid * 24 * 256 + ltid();
  const int nrt_ = n_row_tiles(last);
  PATCH_LOOP_BEGIN(nrt_, 8, 8, 8)
    const int rt = row_tile(last, prt), ct = pct;
    f32x16 mg[2][2];
    zero_acc(mg);
#pragma unroll 1
    for (int g = 0; g < 3; g++) {
      uint32_t gp[2][2][8];
      {
        f32x16 acc[2][2];
        zero_acc(acc);
        gemm_core<true>(acc, wsp<u16>(p, O_WG) + (size_t)(g * 1024 + ct * 128) * D, D, A + (size_t)rt * 128 * D, D, D,
                        smem);
#pragma unroll
        for (int i = 0; i < 2; i++)
#pragma unroll
          for (int j = 0; j < 2; j++)
#pragma unroll
            for (int e = 0; e < 8; e++)
              gp[i][j][e] = pack2(fsigmoid(acc[i][j][2 * e]), fsigmoid(acc[i][j][2 * e + 1]));
      }
      {
        f32x16 acc[2][2];
        zero_acc(acc);
        gemm_core<false>(acc, wsp<u16>(p, O_WB) + (size_t)(g * 1024 + ct * 128) * 512, 512,
                         Y + (size_t)rt * 128 * 1536 + g * 512, 1536, 512, smem);
#pragma unroll
        for (int i = 0; i < 2; i++)
#pragma unroll
          for (int j = 0; j < 2; j++)
#pragma unroll
            for (int e = 0; e < 8; e++) {
              mg[i][j][2 * e] += __uint_as_float(gp[i][j][e] << 16) * acc[i][j][2 * e];
              mg[i][j][2 * e + 1] += __uint_as_float(gp[i][j][e] & 0xffff0000u) * acc[i][j][2 * e + 1];
            }
      }
    }
#pragma unroll
    for (int i = 0; i < 2; i++)
#pragma unroll
      for (int j = 0; j < 2; j++)
#pragma unroll
        for (int gp = 0; gp < 2; gp++) {
          const int row = rt * 128 + wn_ * 64 + j * 32 + r_;
          const int col = ct * 128 + wm_ * 64 + i * 32 + 8 * (2 * gp + hh_);
          uint2 oa, ob;
          oa.x = pack2(mg[i][j][8 * gp], mg[i][j][8 * gp + 1]);
          oa.y = pack2(mg[i][j][8 * gp + 2], mg[i][j][8 * gp + 3]);
          ob.x = pack2(mg[i][j][8 * gp + 4], mg[i][j][8 * gp + 5]);
          ob.y = pack2(mg[i][j][8 * gp + 6], mg[i][j][8 * gp + 7]);
          *(uint4*)(M + (size_t)row * D + col) = pair_swap(oa, ob);
        }
  PATCH_LOOP_END
}

__device__ void phase_resid(const Params& p, int l, bool last, const u16* Ain, size_t lda, const u16* W, int K,
                            int bid, int nb, u16* smem) {
  EPI_DECL
  const int nrt_ = n_row_tiles(last);
  PATCH_LOOP_BEGIN(nrt_, 8, 8, 8)
    const int rt = row_tile(last, prt), ct = pct;
    f32x16 acc[2][2];
    zero_acc(acc);
    gemm_core(acc, W + (size_t)ct * 128 * K, K, Ain + (size_t)rt * 128 * lda, lda, K, smem);
    u16* FB = wsp<u16>(p, O_FB);
#pragma unroll
    for (int i = 0; i < 2; i++)
#pragma unroll
      for (int j = 0; j < 2; j++)
#pragma unroll
        for (int gp = 0; gp < 2; gp++) {
          const int row = rt * 128 + wn_ * 64 + j * 32 + r_;
          const int col = ct * 128 + wm_ * 64 + i * 32 + 8 * (2 * gp + hh_);
          uint2 oa, ob;
          oa.x = pack2(acc[i][j][8 * gp], acc[i][j][8 * gp + 1]);
          oa.y = pack2(acc[i][j][8 * gp + 2], acc[i][j][8 * gp + 3]);
          ob.x = pack2(acc[i][j][8 * gp + 4], acc[i][j][8 * gp + 5]);
          ob.y = pack2(acc[i][j][8 * gp + 6], acc[i][j][8 * gp + 7]);
          *(uint4*)(FB + (size_t)row * D + col) = pair_swap(oa, ob);
        }
  PATCH_LOOP_END
}

__device__ void phase_p7(const Params& p, int l, bool last, int bid, int nb, u16* smem) {
  EPI_DECL
  const u16* A = wsp<u16>(p, O_A);
  u16* HH = wsp<u16>(p, O_HH);
  const int nrt_ = n_row_tiles(last);
  PATCH_LOOP_BEGIN(nrt_, 44, 16, 4)
    const int rt = row_tile(last, prt), ct = pct;
    f32x16 acc[2][2];
    zero_acc(acc);
    gemm_core(acc, wsp<u16>(p, O_WGU) + (size_t)ct * 128 * D, D, A + (size_t)rt * 128 * D, D, D, smem);
#pragma unroll
    for (int j = 0; j < 2; j++)
#pragma unroll
      for (int gp = 0; gp < 2; gp++) {
        const int row = rt * 128 + wn_ * 64 + j * 32 + r_;
        const int q = (ct * 2 + wm_) * 32 + 8 * (2 * gp + hh_);
        float hv[8];
#pragma unroll
        for (int t = 0; t < 8; t++) {
          const float gt = acc[0][j][8 * gp + t], up = acc[1][j][8 * gp + t];
          hv[t] = gt * fsigmoid(gt) * up;
        }
        uint2 oa, ob;
        oa.x = pack2(hv[0], hv[1]);
        oa.y = pack2(hv[2], hv[3]);
        ob.x = pack2(hv[4], hv[5]);
        ob.y = pack2(hv[6], hv[7]);
        *(uint4*)(HH + (size_t)row * FH + q) = pair_swap(oa, ob);
      }
  PATCH_LOOP_END
}

constexpr int NPHASE = 3 + 9 * 2;

__device__ void run_phase(const Params& p, int ph, int bid, int nb, u16* smem) {
  if (ph == 0) {
    prep_tables(p, bid, nb);
    prep_modp(p, bid, nb);
    prep_weights(p, 0, bid, nb, smem);
    return;
  }
  if (ph == 1) { prep_modr(p, bid, nb); return; }
  if (ph == 2) { ln_phase(p, 0, p.ln_in_g, p.ln_in_b, 0, 0, 1024, false, bid, nb); return; }
  const int l = (ph - 3) / 9, s = (ph - 3) % 9;
  const bool last = (l == 1);
  switch (s) {
    case 0: phase_p1(p, l, last, bid, nb, smem); break;
    case 1: phase_p2(p, l, bid, nb, smem); break;
    case 2: phase_p3(p, l, last, bid, nb, smem); break;
    case 3: phase_p4(p, l, last, bid, nb, smem); break;
    case 4: phase_resid(p, l, last, wsp<u16>(p, O_M), D, wsp<u16>(p, O_WO), D, bid, nb, smem); break;
    case 5: ln_phase(p, 1, p.ln1_g + l * D, p.ln1_b + l * D, l, 3072, 4096, last, bid, nb, l, 2048); break;
    case 6: phase_p7(p, l, last, bid, nb, smem); break;
    case 7: phase_resid(p, l, last, wsp<u16>(p, O_HH), FH, wsp<u16>(p, O_WD), FH, bid, nb, smem); break;
    default:
      ln_phase(p, 1, p.ln2_g + l * D, p.ln2_b + l * D, last ? -1 : l + 1, 0, 1024, last, bid, nb, l, 5120);
      if (!last) prep_weights(p, l + 1, bid, nb, smem);
      break;
  }
}


#define XB_TMO      128
#define XB_XCNT(j)  (256  + 64 * (j))
#define XB_XSUB(j)  (1280 + 64 * (j))
#define XB_XGEN(j)  (2304 + 64 * (j))
#define XB_TOP      3328
#define XB_TOPGEN   3392
#define XCD_BAR_WORDS 3456
#define XB_SPIN_CAP (1u << 20)
#define LAS __attribute__((address_space(3)))
__device__ __forceinline__ unsigned xb_ld(unsigned* p) { return __hip_atomic_load(p, __ATOMIC_RELAXED, __HIP_MEMORY_SCOPE_AGENT); }
__device__ __forceinline__ unsigned xb_add(unsigned* p, unsigned v) { return __hip_atomic_fetch_add(p, v, __ATOMIC_RELAXED, __HIP_MEMORY_SCOPE_AGENT); }
__device__ __forceinline__ unsigned xb_xcc_id() { return (unsigned)__builtin_amdgcn_s_getreg((3 << 11) | 20) & 0xFu; }
#define XB_SPIN(cond, bar) do { unsigned _sp = 0; while (cond) { __builtin_amdgcn_s_sleep(1); \
    if ((++_sp & 255u) == 0u) { if (xb_ld(&(bar)[XB_TMO])) break; if (_sp > XB_SPIN_CAP) { atomicAdd(&(bar)[XB_TMO], 1u); break; } } } } while (0)
struct XcdBarrier {
  unsigned* bar; unsigned x;
  volatile LAS unsigned* st;
};
__device__ __forceinline__ XcdBarrier xcd_barrier_post(unsigned* bar, volatile LAS unsigned* st) {
  XcdBarrier b; b.bar = bar; b.x = xb_xcc_id(); b.st = st;
  if (threadIdx.x == 0) (void)xb_add(&bar[XB_XCNT(b.x)], 1u);
  return b;
}
__device__ __forceinline__ void xcd_barrier_complete(unsigned* bar, unsigned x, unsigned& nloc, unsigned& nx) {
  const unsigned G = gridDim.x * gridDim.y * gridDim.z;
  unsigned sum, cnt, mine, sp = 0u;
  for (;;) {
    sum = 0u; cnt = 0u; mine = 0u;
#pragma unroll
    for (unsigned j = 0; j < 16; ++j) { const unsigned c = xb_ld(&bar[XB_XCNT(j)]); sum += c; cnt += (c > 0u) ? 1u : 0u; mine = (j == x) ? c : mine; }
    if (sum == G) break;
    __builtin_amdgcn_s_sleep(1);
    if ((++sp & 255u) == 0u) { if (xb_ld(&bar[XB_TMO])) break; if (sp > XB_SPIN_CAP) { atomicAdd(&bar[XB_TMO], 1u); break; } }
  }
  nloc = mine > 0u ? mine : 1u; nx = cnt > 0u ? cnt : 1u;
}
__device__ __forceinline__ void xcd_barrier(const XcdBarrier& b) {
  asm volatile("s_waitcnt vmcnt(0)" ::: "memory");
  __syncthreads();
  if (threadIdx.x == 0) {
    unsigned* bar = b.bar;
    __builtin_amdgcn_s_waitcnt(0);
    unsigned nloc = b.st[0], nx = b.st[1];
    if (nloc == 0u) { xcd_barrier_complete(bar, b.x, nloc, nx); b.st[0] = nloc; b.st[1] = nx; }
    const unsigned old = xb_add(&bar[XB_XSUB(b.x)], 1u);
    const unsigned gen = old / nloc;
    if (old + 1u == (gen + 1u) * nloc) {
      __builtin_amdgcn_fence(__ATOMIC_RELEASE, "agent");
      asm volatile("s_waitcnt vmcnt(0)" ::: "memory");
      const unsigned og = xb_add(&bar[XB_TOP], 1u);
      const unsigned tg = og / nx;
      if (og + 1u == (tg + 1u) * nx) xb_add(&bar[XB_TOPGEN], 1u);
      else XB_SPIN(xb_ld(&bar[XB_TOPGEN]) == tg, bar);
      __builtin_amdgcn_fence(__ATOMIC_ACQUIRE, "agent");
      xb_add(&bar[XB_XGEN(b.x)], 1u);
      asm volatile("s_waitcnt vmcnt(0)" ::: "memory");
    } else {
      XB_SPIN(xb_ld(&bar[XB_XGEN(b.x)]) == gen, bar);
      __builtin_amdgcn_fence(__ATOMIC_ACQUIRE, "agent");
      asm volatile("s_waitcnt vmcnt(0)" ::: "memory");
    }
  }
  __syncthreads();
}

constexpr int SMEM_ELEMS = 4 * SM_A + 256 + 8;

#if COOP
__global__ void __launch_bounds__(256, 2) mega_kernel(Params p) {
  __shared__ __attribute__((aligned(16))) u16 smem[SMEM_ELEMS];
  cg::grid_group grid = cg::this_grid();
  volatile LAS unsigned* st = (volatile LAS unsigned*)(smem + 4 * SM_A + 256);
  if (threadIdx.x == 0) { st[0] = 0u; st[1] = 0u; }
  __syncthreads();
  XcdBarrier xb = xcd_barrier_post((unsigned*)(p.ws + O_BAR), st);
  for (int ph = 0; ph < NPHASE; ph++) {
#ifdef PROBE_MASK
    const int s9 = ph >= 3 ? (ph - 3) % 9 : -1;
    const int nrep = (s9 >= 0 && ((PROBE_MASK >> s9) & 1)) ? 2 : 1;
    for (int rep = 0; rep < nrep; rep++) {
      run_phase(p, ph, blockIdx.x, gridDim.x, smem);
      if (ph == 0) grid.sync();
      else if (ph + 1 < NPHASE || rep + 1 < nrep) xcd_barrier(xb);
    }
#else
    run_phase(p, ph, blockIdx.x, gridDim.x, smem);
    if (ph == 0) grid.sync();
    else if (ph + 1 < NPHASE) xcd_barrier(xb);
#endif
  }
}
#else
__global__ void __launch_bounds__(256, 2) phase_kernel(Params p, int ph) {
  __shared__ __attribute__((aligned(16))) u16 smem[SMEM_ELEMS];
  run_phase(p, ph, blockIdx.x, gridDim.x, smem);
}
#endif

extern "C" void kernel_launch(void* const* d_in, const int* in_sizes, int n_in, void* d_out, int out_size, void* d_ws,
                              size_t ws_size, hipStream_t stream) {
  Params p{};
  const float** f = (const float**)&p;
  for (int i = 0; i < 25; i++) f[i] = (const float*)d_in[i];
  p.out = (float*)d_out;
  p.ws = (unsigned char*)d_ws;
  if (ws_size < O_WSEND) fprintf(stderr, "workspace too small: %zu < %zu\n", ws_size, (size_t)O_WSEND);
#if COOP
  static int grid_blocks = 0;
  if (!grid_blocks) {
    int dev = 0, cus = 0, per_cu = 0;
    hipGetDevice(&dev);
    hipDeviceGetAttribute(&cus, hipDeviceAttributeMultiprocessorCount, dev);
    hipOccupancyMaxActiveBlocksPerMultiprocessor(&per_cu, mega_kernel, 256, 0);
    if (per_cu > 2) per_cu = 2;
    grid_blocks = cus * per_cu;
  }
  (void)hipMemsetAsync(p.ws + O_BAR, 0, 3456 * 4, stream);
  void* args[] = {&p};
  hipError_t e = hipLaunchCooperativeKernel((void*)mega_kernel, dim3(grid_blocks), dim3(256), args, 0, stream);
  if (e != hipSuccess) fprintf(stderr, "cooperative launch failed: %s (grid %d)\n", hipGetErrorString(e), grid_blocks);
#else
  for (int ph = 0; ph < NPHASE; ph++) phase_kernel<<<512, 256, 0, stream>>>(p, ph);
#endif
}
```

```cpp
#include <hip/hip_runtime.h>
#include <hip/hip_cooperative_groups.h>
#include <stdint.h>
#include <cstdio>
namespace cg = cooperative_groups;

#ifndef COOP
#define COOP 1
#endif

typedef __attribute__((ext_vector_type(8))) short bf16x8;
typedef __attribute__((ext_vector_type(4))) short bf16x4;
typedef __attribute__((ext_vector_type(16))) float f32x16;
typedef unsigned short u16;
typedef __attribute__((ext_vector_type(4))) unsigned int u32x4;

constexpr int D = 1024;
constexpr int NBATCH = 2;
constexpr int SEQ = 16384;
constexpr int CTXL = 256;
constexpr int KPB = SEQ + CTXL;
constexpr int T = NBATCH * KPB;
constexpr int NRT = T / 128;
constexpr int FH = 2816;
constexpr int IN_DIM = 5536;
constexpr float LOG2E = 1.4426950408889634f;
constexpr float NA_SCALE_L2 = 0.125f * LOG2E;
constexpr float MLA_SCALE_L2 = 0.10206207261596575f * LOG2E;
constexpr float ALPHA = 1.4142135623730951f;
constexpr float EPS = 1e-5f;
constexpr float RS128 = 0.08838834764831845f;

constexpr size_t al256(size_t x) { return (x + 255) & ~(size_t)255; }
constexpr size_t O_WF = 0;
constexpr size_t O_WP = O_WF + (size_t)1024 * 1024 * 2;
constexpr size_t O_WG = O_WP + (size_t)2048 * 1024 * 2;
constexpr size_t O_WUQ = O_WG + (size_t)3072 * 1024 * 2;
constexpr size_t O_WUKV = O_WUQ + (size_t)768 * 256 * 2;
constexpr size_t O_WB = O_WUKV + (size_t)1024 * 128 * 2;
constexpr size_t O_WO = O_WB + (size_t)3 * 1024 * 512 * 2;
constexpr size_t O_WGU = O_WO + (size_t)1024 * 1024 * 2;
constexpr size_t O_WD = O_WGU + (size_t)5632 * 1024 * 2;
constexpr size_t O_MA = O_WD + (size_t)1024 * 2816 * 2;
constexpr size_t O_MB = O_MA + (size_t)256 * 256 * 2;
constexpr size_t O_MC = O_MB + (size_t)128 * 256 * 2;
constexpr size_t O_TW = O_MC + (size_t)256 * 512 * 2;
constexpr size_t O_MODP = O_TW + (size_t)128 * 128 * 2 * 4;
constexpr size_t O_MOD = O_MODP + (size_t)16 * 2 * 3 * 6144 * 4;
constexpr size_t O_XCTX = O_MOD + (size_t)2 * 3 * 6144 * 4;
constexpr size_t O_D1C = O_XCTX + (size_t)512 * 1024 * 4;
constexpr size_t O_A = O_D1C + (size_t)2 * 512 * 2 * 256 * 2;
constexpr size_t O_RQ = O_A + (size_t)T * 1024 * 2;
constexpr size_t O_QNA = O_RQ;
constexpr size_t O_KNA = O_QNA + (size_t)T * 512 * 2;
constexpr size_t O_VNAT = O_KNA + (size_t)T * 512 * 2;
constexpr size_t O_RY = O_VNAT + (size_t)T * 512 * 2;
constexpr size_t O_Y = O_RY;
constexpr size_t O_D1 = O_RY;
constexpr size_t O_LAT = O_RY + (size_t)67108864;
constexpr size_t O_D2 = O_RY + (size_t)T * 1536 * 2;
constexpr size_t O_QM = O_D2 + (size_t)67108864;
constexpr size_t O_KN = O_QM + (size_t)T * 768 * 2;
constexpr size_t O_KRR = O_KN + (size_t)T * 512 * 2;
constexpr size_t O_VMT = O_KRR + (size_t)T * 32 * 2;
constexpr size_t O_END = O_VMT + (size_t)T * 512 * 2;
constexpr size_t O_BAR = (O_END + 255) & ~(size_t)255;
constexpr size_t O_WSEND = O_BAR + 3456 * 4;
constexpr size_t O_FB = O_QM;
constexpr size_t O_M = O_RQ;
constexpr size_t O_HH = O_RQ;

struct Params {
  const float *x, *c, *ctx, *c_ctx, *ln_in_g, *ln_in_b, *w_mod, *b_mod, *w_in, *gq, *gkv, *w_uq, *w_qr, *w_uk,
      *w_uv, *rpb, *w_branch, *w_out, *ln1_g, *ln1_b, *ln2_g, *ln2_b, *w_gate, *w_up, *w_down;
  float* out;
  unsigned char* ws;
};

__device__ __forceinline__ u16 f2bf(float f) {
  uint32_t u = __float_as_uint(f);
  u += 0x7fffu + ((u >> 16) & 1u);
  return (u16)(u >> 16);
}
typedef __attribute__((ext_vector_type(2))) __bf16 bf16v2;
typedef __attribute__((ext_vector_type(2))) float f32v2;
__device__ __forceinline__ uint32_t pack2(float a, float b) {
  const f32v2 v = {a, b};
  return __builtin_bit_cast(uint32_t, __builtin_convertvector(v, bf16v2));
}
__device__ __forceinline__ uint4 pair_swap(uint2 a, uint2 b) {
  const auto rx = __builtin_amdgcn_permlane32_swap(a.x, b.x, false, false);
  const auto ry = __builtin_amdgcn_permlane32_swap(a.y, b.y, false, false);
  return make_uint4(rx[0], ry[0], rx[1], ry[1]);
}
__device__ __forceinline__ float bf2f(u16 v) { return __uint_as_float(((uint32_t)v) << 16); }
__device__ __forceinline__ float wsum(float v) {
#pragma unroll
  for (int o = 32; o > 0; o >>= 1) v += __shfl_xor(v, o);
  return v;
}
__device__ __forceinline__ float fsigmoid(float v) { return 1.f / (1.f + __expf(-v)); }

__device__ __forceinline__ int ltid() {
  int t = threadIdx.x;
  asm volatile("" : "+v"(t));
  return t;
}

template <typename Tp>
__device__ __forceinline__ Tp* wsp(const Params& p, size_t off) { return (Tp*)(p.ws + off); }

__device__ __forceinline__ float* xrow(const Params& p, int row) {
  int b = row / KPB, kk = row - b * KPB;
  if (kk < CTXL) return wsp<float>(p, O_XCTX) + (size_t)(b * CTXL + kk) * D;
  return p.out + (size_t)(b * SEQ + kk - CTXL) * D;
}

constexpr int LSTR = 72;
constexpr int SM_A = 128 * LSTR;

template <bool DEEP = true>
__device__ __forceinline__ void gemm_core(f32x16 (&acc)[2][2], const u16* __restrict__ A, size_t lda,
                                          const u16* __restrict__ B, size_t ldb, int K, u16* smem) {
  const int tid = ltid(), lane = tid & 63, wave = tid >> 6;
  const int wm = wave >> 1, wn = wave & 1, r = lane & 31, hh = lane >> 5;
  u16* sA = smem;
  u16* sB = smem + 2 * SM_A;
  const int lrow = tid >> 3, lkc = (tid & 7) * 8;
  const unsigned char* gab = (const unsigned char*)A;
  const unsigned char* gbb = (const unsigned char*)B;
  uint32_t oa[4], ob[4];
#pragma unroll
  for (int i = 0; i < 4; i++) {
    oa[i] = (uint32_t)(((size_t)(lrow + 32 * i) * lda + lkc) * 2);
    ob[i] = (uint32_t)(((size_t)(lrow + 32 * i) * ldb + lkc) * 2);
  }
  u16* wa = sA + lrow * LSTR + lkc;
  u16* wb = sB + lrow * LSTR + lkc;
  const u16* pa = sA + (wm * 64 + r) * LSTR + hh * 8;
  const u16* pb = sB + (wn * 64 + r) * LSTR + hh * 8;
  u32x4 a0r[4], b0r[4], a1r[4], b1r[4];
#define G_LOAD(ar, br, ko)                                               \
  _Pragma("unroll") for (int i = 0; i < 4; i++) {                        \
    ar[i] = *(const u32x4*)(gab + (size_t)(ko)*2 + oa[i]);               \
    br[i] = *(const u32x4*)(gbb + (size_t)(ko)*2 + ob[i]);               \
  }
#define G_STORE(ar, br, buf)                                             \
  _Pragma("unroll") for (int i = 0; i < 4; i++) {                        \
    *(u32x4*)(wa + (buf)*SM_A + 32 * i * LSTR) = ar[i];                  \
    *(u32x4*)(wb + (buf)*SM_A + 32 * i * LSTR) = br[i];                  \
  }
#define G_COMPUTE(buf)                                                                   \
  _Pragma("unroll") for (int ks = 0; ks < 4; ks++) {                                     \
    const bf16x8 fa0 = *(const bf16x8*)(pa + (buf)*SM_A + ks * 16);                      \
    const bf16x8 fa1 = *(const bf16x8*)(pa + (buf)*SM_A + 32 * LSTR + ks * 16);          \
    const bf16x8 fb0 = *(const bf16x8*)(pb + (buf)*SM_A + ks * 16);                      \
    const bf16x8 fb1 = *(const bf16x8*)(pb + (buf)*SM_A + 32 * LSTR + ks * 16);          \
    acc[0][0] = __builtin_amdgcn_mfma_f32_32x32x16_bf16(fa0, fb0, acc[0][0], 0, 0, 0);   \
    acc[0][1] = __builtin_amdgcn_mfma_f32_32x32x16_bf16(fa0, fb1, acc[0][1], 0, 0, 0);   \
    acc[1][0] = __builtin_amdgcn_mfma_f32_32x32x16_bf16(fa1, fb0, acc[1][0], 0, 0, 0);   \
    acc[1][1] = __builtin_amdgcn_mfma_f32_32x32x16_bf16(fa1, fb1, acc[1][1], 0, 0, 0);   \
  }
  const int nk = K >> 6;
  if (DEEP) {
    G_LOAD(a0r, b0r, 0)
    G_LOAD(a1r, b1r, 64)
    G_STORE(a0r, b0r, 0)
    __syncthreads();
    const int klast = (nk - 1) * 64;
    G_LOAD(a0r, b0r, min(128, klast))
    for (int kt = 0; kt < nk; kt += 2) {
      G_COMPUTE(0)
      G_STORE(a1r, b1r, 1)
      __syncthreads();
      G_LOAD(a1r, b1r, min((kt + 3) * 64, klast))
      __builtin_amdgcn_sched_barrier(0);
      G_COMPUTE(1)
      G_STORE(a0r, b0r, 0)
      __syncthreads();
      G_LOAD(a0r, b0r, min((kt + 4) * 64, klast))
      __builtin_amdgcn_sched_barrier(0);
    }
  } else {
    G_LOAD(a0r, b0r, 0)
    G_STORE(a0r, b0r, 0)
    __syncthreads();
    for (int kt = 0; kt < nk; kt += 2) {
      G_LOAD(a0r, b0r, (kt + 1) * 64)
      G_COMPUTE(0)
      G_STORE(a0r, b0r, 1)
      __syncthreads();
      if (kt + 2 < nk) G_LOAD(a0r, b0r, (kt + 2) * 64)
      G_COMPUTE(1)
      if (kt + 2 < nk) G_STORE(a0r, b0r, 0)
      __syncthreads();
    }
  }
#undef G_LOAD
#undef G_STORE
#undef G_COMPUTE
}

__device__ __forceinline__ void zero_acc(f32x16 (&acc)[2][2]) {
#pragma unroll
  for (int i = 0; i < 2; i++)
#pragma unroll
    for (int j = 0; j < 2; j++)
#pragma unroll
      for (int e = 0; e < 16; e++) acc[i][j][e] = 0.f;
}

#define EPI_DECL                                                     \
  const int lane_ = ltid() & 63, wave_ = ltid() >> 6;      \
  const int wm_ = wave_ >> 1, wn_ = wave_ & 1, r_ = lane_ & 31, hh_ = lane_ >> 5; \
  (void)wm_; (void)wn_; (void)r_; (void)hh_;

__device__ __forceinline__ const float* src_col(const Params& p, int l, int kind, int n, int& ld) {
  switch (kind) {
    case 0:
      ld = IN_DIM;
      return n < 1952 ? p.w_in + (size_t)l * D * IN_DIM + 512 + n : nullptr;
    case 1:
      ld = IN_DIM;
      return p.w_in + (size_t)l * D * IN_DIM + 2464 + n;
    case 2:
      if (n < 512) {
        ld = 512;
        return p.w_uq + (size_t)l * 256 * 512 + n;
      } else {
        int m = n - 512, wt = m >> 6, jb = (m >> 5) & 1, idx = wt * 32 + (m & 31);
        int h = idx >> 4, e = idx & 15;
        ld = 256;
        return p.w_qr + (size_t)l * 256 * 256 + h * 32 + jb * 16 + e;
      }
    case 3:
      ld = 512;
      return n < 512 ? p.w_uk + (size_t)l * 128 * 512 + n : p.w_uv + (size_t)l * 128 * 512 + (n - 512);
    case 4: {
      int g = n >> 10, nn = n & 1023;
      ld = 1024;
      return p.w_branch + ((size_t)(l * 3 + g) * 512) * 1024 + nn;
    }
    case 5:
      ld = 1024;
      return p.w_out + (size_t)l * D * D + n;
    case 6: {
      int jb = (n >> 5) & 1, q = (n >> 6) * 32 + (n & 31);
      ld = FH;
      return (jb ? p.w_up : p.w_gate) + (size_t)l * D * FH + q;
    }
    default:
      ld = 1024;
      return p.w_down + (size_t)l * FH * D + n;
  }
}

__device__ __forceinline__ int job_nd(int k) {
  switch (k) { case 0: return 2048; case 1: return 3072; case 2: return 768; case 3: return 1024; case 4: return 3072;
    case 5: return 1024; case 6: return 5632; default: return 1024; }
}
__device__ __forceinline__ int job_kd(int k) {
  switch (k) { case 0: return 1024; case 1: return 1024; case 2: return 256; case 3: return 128; case 4: return 512;
    case 5: return 1024; case 6: return 1024; default: return 2816; }
}
__device__ __forceinline__ size_t job_od(int k) {
  switch (k) { case 0: return O_WP; case 1: return O_WG; case 2: return O_WUQ; case 3: return O_WUKV; case 4: return O_WB;
    case 5: return O_WO; case 6: return O_WGU; default: return O_WD; }
}
__device__ void prep_weights(const Params& p, int l, int bid, int nb, u16* smem) {
  float* tile = (float*)smem;
  const int tid = ltid();
  int start = 0;
#pragma unroll 1
  for (int kind = 0; kind < 8; kind++) {
    const int Kk = job_kd(kind);
    const int nkt = Kk >> 6, ntile = (job_nd(kind) >> 6) * nkt;
    u16* dst = wsp<u16>(p, job_od(kind));
    const float* ksc = kind == 2 ? p.gq + l * 256 : (kind == 3 ? p.gkv + l * 128 : nullptr);
    for (int t = (bid + nb - (start % nb)) % nb; t < ntile; t += nb) {
      const int nt = t / nkt, kt = t - nt * nkt;
      const int n0 = nt * 64, k0 = kt * 64;
      {
        const int kq = tid >> 4, nn4 = (tid & 15) * 4;
        int ld;
        const float* sp = src_col(p, l, kind, n0 + nn4, ld);
#pragma unroll
        for (int i = 0; i < 4; i++) {
          const int kk = i * 16 + kq;
          float4 v = make_float4(0.f, 0.f, 0.f, 0.f);
          if (sp) v = *(const float4*)(sp + (size_t)(k0 + kk) * ld);
          if (ksc) {
            const float sc = ksc[k0 + kk];
            v.x *= sc; v.y *= sc; v.z *= sc; v.w *= sc;
          }
          float* tp = tile + kk * 65 + nn4;
          tp[0] = v.x; tp[1] = v.y; tp[2] = v.z; tp[3] = v.w;
        }
      }
      __syncthreads();
#pragma unroll
      for (int i = 0; i < 2; i++) {
        const int c = tid + 256 * i;
        const int nn = c >> 3, kc = (c & 7) * 8;
        const float* tp = tile + kc * 65 + nn;
        uint4 o;
        o.x = pack2(tp[0], tp[65]);
        o.y = pack2(tp[2 * 65], tp[3 * 65]);
        o.z = pack2(tp[4 * 65], tp[5 * 65]);
        o.w = pack2(tp[6 * 65], tp[7 * 65]);
        *(uint4*)(dst + (size_t)(n0 + nn) * Kk + k0 + kc) = o;
      }
      __syncthreads();
    }
    start += ntile;
  }
  {
    float* ctab = (float*)smem;
    __syncthreads();
    if (tid < 128) ctab[tid] = cospif((float)tid * (1.f / 64.f));
    __syncthreads();
    u16* dst = wsp<u16>(p, O_WF);
    for (int it = bid; it < 512; it += nb) {
      const int o = it * 256 + tid;
      const int np = o & 1023, k8 = (o >> 10) * 8;
      const int reim = np >> 9, g = (np >> 7) & 3, m = np & 127;
      const float* w = p.w_in + (size_t)l * D * IN_DIM + (size_t)k8 * IN_DIM + g * 128;
      const int sh = reim ? 96 : 0;
      float a8[8];
#pragma unroll
      for (int j = 0; j < 8; j++) a8[j] = 0.f;
#pragma unroll 4
      for (int c = 0; c < 128; c++) {
        const float tw = ctab[(m * c + sh) & 127];
#pragma unroll
        for (int j = 0; j < 8; j++) a8[j] += w[(size_t)j * IN_DIM + c] * tw;
      }
      uint4 ov;
      ov.x = pack2(a8[0] * RS128, a8[1] * RS128);
      ov.y = pack2(a8[2] * RS128, a8[3] * RS128);
      ov.z = pack2(a8[4] * RS128, a8[5] * RS128);
      ov.w = pack2(a8[6] * RS128, a8[7] * RS128);
      *(uint4*)(dst + (size_t)np * 1024 + k8) = ov;
    }
    __syncthreads();
  }
}

__device__ void prep_tables(const Params& p, int bid, int nb) {
  u16* MA = wsp<u16>(p, O_MA);
  u16* MB = wsp<u16>(p, O_MB);
  u16* MC = wsp<u16>(p, O_MC);
  float* TW = wsp<float>(p, O_TW);
  const int total = 65536 + 32768 + 131072 + 16384;
  for (int idx = bid * 256 + ltid(); idx < total; idx += nb * 256) {
    if (idx < 65536) {
      const int n = idx >> 8, k = idx & 255;
      const int nt = n >> 7, wn = (n >> 6) & 1, jb = (n >> 5) & 1, klo = nt * 64 + wn * 32 + (n & 31);
      const int ri = k >> 7, nhi = k & 127;
      const int xx = (klo * nhi) & 127;
      const float c = cospif((float)xx * (1.f / 64.f)), s = sinpif((float)xx * (1.f / 64.f));
      float v = jb == 0 ? (ri == 0 ? c : -s) : (ri == 0 ? -s : -c);
      MA[idx] = f2bf(v * RS128);
    } else if (idx < 65536 + 32768) {
      const int i2 = idx - 65536;
      const int khi = i2 >> 8, k = i2 & 255;
      const int ri = k >> 7, nlo = k & 127;
      const int xx = (khi * nlo) & 127;
      const float c = cospif((float)xx * (1.f / 64.f)), s = sinpif((float)xx * (1.f / 64.f));
      MB[i2] = f2bf((ri == 0 ? c : s) * RS128);
    } else if (idx < 65536 + 32768 + 131072) {
      const int i2 = idx - 65536 - 32768;
      const int kk = i2 >> 9, k = i2 & 511;
      const int ri = k >> 8, nn = k & 255;
      const int xx = (kk * nn) & 255;
      const float c = cospif((float)xx * (1.f / 128.f)), s = sinpif((float)xx * (1.f / 128.f));
      MC[i2] = f2bf((ri == 0 ? c : -s) * 0.0625f);
    } else {
      const int i2 = idx - 65536 - 32768 - 131072;
      const int klo = i2 >> 7, nlo = i2 & 127;
      const int xx = klo * nlo;
      TW[i2 * 2] = cospif((float)xx * (1.f / 8192.f));
      TW[i2 * 2 + 1] = sinpif((float)xx * (1.f / 8192.f));
    }
  }
}

__device__ void prep_modp(const Params& p, int bid, int nb) {
  float* modp = wsp<float>(p, O_MODP);
  for (int it = bid; it < 2 * 16 * 24; it += nb) {
    const int l = it / (16 * 24), rem = it - l * 16 * 24, kc = rem / 24, nblk = rem - kc * 24;
    const int n = nblk * 256 + ltid();
    const float* w = p.w_mod + (size_t)l * D * 6144 + n;
    float a0 = 0.f, a1 = 0.f, a2 = 0.f;
#pragma unroll 8
    for (int kk = 0; kk < 64; kk++) {
      const int k = kc * 64 + kk;
      const float wv = w[(size_t)k * 6144];
      float c0 = p.c[k], c1 = p.c[1024 + k], c2 = p.c_ctx[k];
      c0 = c0 / (1.f + __expf(-c0));
      c1 = c1 / (1.f + __expf(-c1));
      c2 = c2 / (1.f + __expf(-c2));
      a0 += c0 * wv;
      a1 += c1 * wv;
      a2 += c2 * wv;
    }
    float* o = modp + ((size_t)(kc * 2 + l) * 3) * 6144 + n;
    o[0] = a0;
    o[6144] = a1;
    o[2 * 6144] = a2;
  }
}
__device__ void prep_modr(const Params& p, int bid, int nb) {
  const float* modp = wsp<float>(p, O_MODP);
  float* mod = wsp<float>(p, O_MOD);
  for (int idx = bid * 256 + ltid(); idx < 2 * 3 * 6144; idx += nb * 256) {
    const int l = idx / (3 * 6144), n = idx % 6144;
    float v = p.b_mod[l * 6144 + n];
    for (int kc = 0; kc < 16; kc++) v += modp[(size_t)kc * 2 * 3 * 6144 + idx];
    mod[idx] = v;
  }
}

__device__ void ln_phase(const Params& p, int mode, const float* g, const float* bta, int lmod, int shoff, int scoff,
                         bool skip_ctx, int bid, int nb, int lres = 0, int goff = -1) {
  const int lane = ltid() & 63, wave = ltid() >> 6;
  u16* A = wsp<u16>(p, O_A);
  const float* mod = wsp<float>(p, O_MOD);
  float4 gg[4], bb[4], sh[4], sc[4], gt[4];
#pragma unroll
  for (int q = 0; q < 4; q++) gt[q] = make_float4(0.f, 0.f, 0.f, 0.f);
  int cur_mg = -1;
#pragma unroll
  for (int q = 0; q < 4; q++) {
    const int c0 = (q >> 1) * 512 + lane * 8 + (q & 1) * 4;
    gg[q] = *(const float4*)(g + c0);
    bb[q] = *(const float4*)(bta + c0);
    sh[q] = make_float4(0.f, 0.f, 0.f, 0.f);
    sc[q] = make_float4(0.f, 0.f, 0.f, 0.f);
  }
  int cur_m = -1;
  for (int row = bid * 4 + wave; row < T; row += nb * 4) {
    const int b = row / KPB, kk = row - b * KPB;
    if (skip_ctx && kk < CTXL) continue;
    float* xr = xrow(p, row);
    const float* src;
    if (mode == 0)
      src = kk < CTXL ? p.ctx + (size_t)(b * CTXL + kk) * D : p.x + (size_t)(b * SEQ + kk - CTXL) * D;
    else
      src = xr;
    float4 v[4];
    float s = 0.f;
    const int m = kk < CTXL ? 2 : b;
    if (goff >= 0 && m != cur_mg) {
      cur_mg = m;
#pragma unroll
      for (int q = 0; q < 4; q++)
        gt[q] = *(const float4*)(mod + ((size_t)lres * 3 + m) * 6144 + goff + (q >> 1) * 512 + lane * 8 + (q & 1) * 4);
    }
#pragma unroll
    for (int i = 0; i < 2; i++) {
      uint4 fv = make_uint4(0u, 0u, 0u, 0u);
      if (goff >= 0) fv = *(const uint4*)(wsp<u16>(p, O_FB) + (size_t)row * D + i * 512 + lane * 8);
      const uint32_t fw[4] = {fv.x, fv.y, fv.z, fv.w};
#pragma unroll
      for (int hq = 0; hq < 2; hq++) {
        const int q = i * 2 + hq;
        v[q] = *(const float4*)(src + i * 512 + lane * 8 + hq * 4);
        if (goff >= 0) {
          v[q].x = ALPHA * v[q].x + (1.f + gt[q].x) * __uint_as_float(fw[hq * 2] << 16);
          v[q].y = ALPHA * v[q].y + (1.f + gt[q].y) * __uint_as_float(fw[hq * 2] & 0xffff0000u);
          v[q].z = ALPHA * v[q].z + (1.f + gt[q].z) * __uint_as_float(fw[hq * 2 + 1] << 16);
          v[q].w = ALPHA * v[q].w + (1.f + gt[q].w) * __uint_as_float(fw[hq * 2 + 1] & 0xffff0000u);
        }
        s += v[q].x + v[q].y + v[q].z + v[q].w;
      }
    }
    if (lmod >= 0 && m != cur_m) {
      cur_m = m;
      const float* md = mod + ((size_t)lmod * 3 + m) * 6144;
#pragma unroll
      for (int q = 0; q < 4; q++) {
        const int c0 = (q >> 1) * 512 + lane * 8 + (q & 1) * 4;
        sh[q] = *(const float4*)(md + shoff + c0);
        sc[q] = *(const float4*)(md + scoff + c0);
      }
    }
    const float mu = wsum(s) * (1.f / 1024.f);
    float qs = 0.f;
#pragma unroll
    for (int q = 0; q < 4; q++) {
      v[q].x -= mu; v[q].y -= mu; v[q].z -= mu; v[q].w -= mu;
      qs += v[q].x * v[q].x + v[q].y * v[q].y + v[q].z * v[q].z + v[q].w * v[q].w;
    }
    const float rstd = rsqrtf(wsum(qs) * (1.f / 1024.f) + EPS);
#pragma unroll
    for (int i = 0; i < 2; i++) {
      uint4 o;
      uint32_t ow[4];
#pragma unroll
      for (int hq = 0; hq < 2; hq++) {
        const int q = i * 2 + hq;
        float4 y;
        y.x = v[q].x * rstd * gg[q].x + bb[q].x;
        y.y = v[q].y * rstd * gg[q].y + bb[q].y;
        y.z = v[q].z * rstd * gg[q].z + bb[q].z;
        y.w = v[q].w * rstd * gg[q].w + bb[q].w;
        *(float4*)(xr + i * 512 + lane * 8 + hq * 4) = y;
        ow[hq * 2] = pack2(y.x * (1.f + sc[q].x) + sh[q].x, y.y * (1.f + sc[q].y) + sh[q].y);
        ow[hq * 2 + 1] = pack2(y.z * (1.f + sc[q].z) + sh[q].z, y.w * (1.f + sc[q].w) + sh[q].w);
      }
      if (lmod >= 0) {
        o.x = ow[0]; o.y = ow[1]; o.z = ow[2]; o.w = ow[3];
        *(uint4*)(A + (size_t)row * D + i * 512 + lane * 8) = o;
      }
    }
  }
}

#define PATCH_LOOP_BEGIN(NR_, NC_, PR_, PC_)                                   \
  {                                                                            \
    const int x_ = bid & 7, w_ = bid >> 3, nbx_ = nb >> 3;                     \
    const int CG_ = ((NC_) + (PC_)-1) / (PC_);                                 \
    const int npatch_ = (((NR_) + (PR_)-1) / (PR_)) * CG_;                     \
    for (int u_ = w_;; u_ += nbx_) {                                           \
      const int g_ = (u_ >> 6) * 8 + x_;                                       \
      if (g_ >= npatch_) break;                                                \
      const int s_ = u_ & 63;                                                  \
      const int rg_ = g_ / CG_;                                                \
      const int prt = rg_ * (PR_) + s_ / (PC_);                                \
      const int pct = (g_ - rg_ * CG_) * (PC_) + s_ % (PC_);                   \
      if (prt >= (NR_) || pct >= (NC_)) continue;
#define PATCH_LOOP_END \
    }                  \
  }

__device__ void phase_p1(const Params& p, int l, bool last, int bid, int nb, u16* smem) {
  EPI_DECL
  const u16* A = wsp<u16>(p, O_A);
  PATCH_LOOP_BEGIN(NRT, 16, 8, 8)
    f32x16 acc[2][2];
    zero_acc(acc);
    {
      const int rt = prt, ct = pct;
      const int row0 = rt * 128, b = row0 / KPB, kk0 = row0 - b * KPB;
      if (ct < 8 || ct >= 12) {
        gemm_core(acc, wsp<u16>(p, O_WP) + (size_t)ct * 128 * D, D, A + (size_t)rt * 128 * D, D, D, smem);
        u16* dst;
        float sc = 1.f;
        int cb;
        if (ct < 4) { dst = wsp<u16>(p, O_QNA); sc = NA_SCALE_L2; cb = ct * 128; }
        else if (ct < 8) { dst = wsp<u16>(p, O_KNA); cb = (ct - 4) * 128; }
        else { dst = wsp<u16>(p, O_LAT); cb = (ct - 12) * 128; }
#pragma unroll
        for (int i = 0; i < 2; i++)
#pragma unroll
          for (int j = 0; j < 2; j++)
#pragma unroll
            for (int gp = 0; gp < 2; gp++) {
              const int row = row0 + wn_ * 64 + j * 32 + r_;
              const int col = cb + wm_ * 64 + i * 32 + 8 * (2 * gp + hh_);
              uint2 oa, ob;
              oa.x = pack2(acc[i][j][8 * gp] * sc, acc[i][j][8 * gp + 1] * sc);
              oa.y = pack2(acc[i][j][8 * gp + 2] * sc, acc[i][j][8 * gp + 3] * sc);
              ob.x = pack2(acc[i][j][8 * gp + 4] * sc, acc[i][j][8 * gp + 5] * sc);
              ob.y = pack2(acc[i][j][8 * gp + 6] * sc, acc[i][j][8 * gp + 7] * sc);
              *(uint4*)(dst + (size_t)row * 512 + col) = pair_swap(oa, ob);
            }
      } else {
        gemm_core(acc, A + (size_t)rt * 128 * D, D, wsp<u16>(p, O_WP) + (size_t)ct * 128 * D, D, D, smem);
        u16* dst = wsp<u16>(p, O_VNAT);
        const int cb = (ct - 8) * 128;
#pragma unroll
        for (int i = 0; i < 2; i++)
#pragma unroll
          for (int j = 0; j < 2; j++)
#pragma unroll
            for (int gp = 0; gp < 2; gp++) {
              const int kk = kk0 + wm_ * 64 + i * 32 + 8 * (2 * gp + hh_);
              const int col = cb + wn_ * 64 + j * 32 + r_;
              uint2 oa, ob;
              oa.x = pack2(acc[i][j][8 * gp], acc[i][j][8 * gp + 1]);
              oa.y = pack2(acc[i][j][8 * gp + 2], acc[i][j][8 * gp + 3]);
              ob.x = pack2(acc[i][j][8 * gp + 4], acc[i][j][8 * gp + 5]);
              ob.y = pack2(acc[i][j][8 * gp + 6], acc[i][j][8 * gp + 7]);
              *(uint4*)(dst + ((size_t)(b * 512 + col)) * KPB + kk) = make_uint4(oa.x, oa.y, ob.x, ob.y);
            }
      }
    }
  PATCH_LOOP_END
  PATCH_LOOP_BEGIN(256, 8, 8, 8)
    f32x16 acc[2][2];
    zero_acc(acc);
    {
      const int rt = prt, ct = pct;
      const int b = rt >> 7, nlo = rt & 127;
      gemm_core(acc, A + (size_t)(b * KPB + CTXL + nlo) * D, (size_t)128 * D,
                wsp<u16>(p, O_WF) + (size_t)ct * 128 * D, D, D, smem);
      u16* dst = wsp<u16>(p, O_D1);
#pragma unroll
      for (int i = 0; i < 2; i++)
#pragma unroll
        for (int j = 0; j < 2; j++)
#pragma unroll
          for (int gp = 0; gp < 2; gp++) {
            const int nhi = wm_ * 64 + i * 32 + 8 * (2 * gp + hh_);
            const int n = ct * 128 + wn_ * 64 + j * 32 + r_;
            const int reim = n >> 9, jj = n & 511;
            uint2 oa, ob;
            oa.x = pack2(acc[i][j][8 * gp], acc[i][j][8 * gp + 1]);
            oa.y = pack2(acc[i][j][8 * gp + 2], acc[i][j][8 * gp + 3]);
            ob.x = pack2(acc[i][j][8 * gp + 4], acc[i][j][8 * gp + 5]);
            ob.y = pack2(acc[i][j][8 * gp + 6], acc[i][j][8 * gp + 7]);
            *(uint4*)(dst + ((((size_t)(b * 512 + jj)) * 128 + nlo) * 2 + reim) * 128 + nhi) = pair_swap(oa, ob);
          }
    }
  PATCH_LOOP_END
  if (!last) {
    for (int t2 = bid; t2 < 32; t2 += nb) {
      f32x16 acc[2][2];
      zero_acc(acc);
      const int rt = t2 >> 3, ct = t2 & 7;
      const int b = rt >> 1, rb = rt & 1;
      gemm_core(acc, A + (size_t)(b * KPB + rb * 128) * D, D, wsp<u16>(p, O_WF) + (size_t)ct * 128 * D, D, D, smem);
      u16* dst = wsp<u16>(p, O_D1C);
#pragma unroll
      for (int i = 0; i < 2; i++)
#pragma unroll
        for (int j = 0; j < 2; j++)
#pragma unroll
          for (int gp = 0; gp < 2; gp++) {
            const int nc = rb * 128 + wm_ * 64 + i * 32 + 8 * (2 * gp + hh_);
            const int n = ct * 128 + wn_ * 64 + j * 32 + r_;
            const int reim = n >> 9, jj = n & 511;
            uint2 oa, ob;
            oa.x = pack2(acc[i][j][8 * gp], acc[i][j][8 * gp + 1]);
            oa.y = pack2(acc[i][j][8 * gp + 2], acc[i][j][8 * gp + 3]);
            ob.x = pack2(acc[i][j][8 * gp + 4], acc[i][j][8 * gp + 5]);
            ob.y = pack2(acc[i][j][8 * gp + 6], acc[i][j][8 * gp + 7]);
            *(uint4*)(dst + (((size_t)(b * 512 + jj)) * 2 + reim) * 256 + nc) = pair_swap(oa, ob);
          }
    }
  }
}

__device__ __forceinline__ float inv_freq(int i) {
  switch (i) {
    case 0: return 1.0f;
    case 1: return 0.31622776601683794f;
    case 2: return 0.1f;
    case 3: return 0.03162277660168379f;
    case 4: return 0.01f;
    case 5: return 0.0031622776601683794f;
    case 6: return 0.001f;
    default: return 0.00031622776601683794f;
  }
}
__device__ __forceinline__ void rope_cs(int kk, int e, float& cs, float& sn) {
  if (kk < CTXL) { cs = 1.f; sn = 0.f; return; }
  const int tkn = kk - CTXL;
  const float pos = (e < 8) ? (float)(tkn >> 6) : (float)(tkn & 63);
  const float ang = pos * inv_freq(e & 7);
  double xr = (double)ang * 0.31830988618379067;
  xr -= 2.0 * floor(xr * 0.5);
  const float yr = (float)xr;
  cs = cospif(yr);
  sn = sinpif(yr);
}

__device__ __forceinline__ void row_rms(const u16* A, size_t lda, int K, float* rs) {
  const int tid = ltid();
  const int row = tid >> 1, half = tid & 1;
  const u16* pr = A + (size_t)row * lda + half * (K >> 1);
  float s = 0.f;
  for (int c = 0; c < (K >> 1); c += 8) {
    uint4 v = *(const uint4*)(pr + c);
    const uint32_t w[4] = {v.x, v.y, v.z, v.w};
#pragma unroll
    for (int q = 0; q < 4; q++) {
      const float a = __uint_as_float(w[q] << 16), bq = __uint_as_float(w[q] & 0xffff0000u);
      s += a * a + bq * bq;
    }
  }
  s += __shfl_xor(s, 1);
  if (half == 0) rs[row] = rsqrtf(s / (float)K + EPS);
  __syncthreads();
}

__device__ void phase_p2(const Params& p, int l, int bid, int nb, u16* smem) {
  EPI_DECL
  const u16* LAT = wsp<u16>(p, O_LAT);
  float* rs = (float*)(smem + 4 * SM_A);
  const int nQ = NRT * 6, nKV = NRT * 8, nFA = 1024 * 2, nKR = NRT;
  const int total = nQ + nKV + nFA + nKR;
  for (int t = bid; t < total; t += nb) {
    if (t < nQ) {
      const int rt = t / 6, ct = t - rt * 6;
      const int row0 = rt * 128, b = row0 / KPB, kk0 = row0 - b * KPB;
      row_rms(LAT + (size_t)row0 * 512, 512, 256, rs);
      f32x16 acc[2][2];
      zero_acc(acc);
      gemm_core(acc, wsp<u16>(p, O_WUQ) + (size_t)ct * 128 * 256, 256, LAT + (size_t)row0 * 512, 512, 256, smem);
      u16* QM = wsp<u16>(p, O_QM);
      if (ct < 4) {
#pragma unroll
        for (int i = 0; i < 2; i++)
#pragma unroll
          for (int j = 0; j < 2; j++)
#pragma unroll
            for (int gp = 0; gp < 2; gp++) {
              const int rl = wn_ * 64 + j * 32 + r_;
              const int col = ct * 128 + wm_ * 64 + i * 32 + 8 * (2 * gp + hh_);
              const int h = col >> 6, d = col & 63;
              const float sc = rs[rl] * MLA_SCALE_L2;
              uint2 oa, ob;
              oa.x = pack2(acc[i][j][8 * gp] * sc, acc[i][j][8 * gp + 1] * sc);
              oa.y = pack2(acc[i][j][8 * gp + 2] * sc, acc[i][j][8 * gp + 3] * sc);
              ob.x = pack2(acc[i][j][8 * gp + 4] * sc, acc[i][j][8 * gp + 5] * sc);
              ob.y = pack2(acc[i][j][8 * gp + 6] * sc, acc[i][j][8 * gp + 7] * sc);
              *(uint4*)(QM + (size_t)(row0 + rl) * 768 + h * 96 + d) = pair_swap(oa, ob);
            }
      } else {
        const int wt = (ct - 4) * 2 + wm_;
#pragma unroll
        for (int j = 0; j < 2; j++) {
          const int rl = wn_ * 64 + j * 32 + r_;
          const float sc = rs[rl] * MLA_SCALE_L2;
          uint2 p1[4], p2[4];
#pragma unroll
          for (int g = 0; g < 4; g++) {
            const int idx = wt * 32 + 8 * g + 4 * hh_;
            const int e16 = idx & 15;
            float o1[4], o2[4];
#pragma unroll
            for (int q = 0; q < 4; q++) {
              float cs, sn;
              rope_cs(kk0 + rl, e16 + q, cs, sn);
              const float x1 = acc[0][j][4 * g + q] * sc, x2 = acc[1][j][4 * g + q] * sc;
              o1[q] = x1 * cs - x2 * sn;
              o2[q] = x2 * cs + x1 * sn;
            }
            p1[g].x = pack2(o1[0], o1[1]);
            p1[g].y = pack2(o1[2], o1[3]);
            p2[g].x = pack2(o2[0], o2[1]);
            p2[g].y = pack2(o2[2], o2[3]);
          }
#pragma unroll
          for (int gp = 0; gp < 2; gp++) {
            u16* qd = QM + (size_t)(row0 + rl) * 768 + (2 * wt + gp) * 96 + 64 + 8 * hh_;
            *(uint4*)qd = pair_swap(p1[2 * gp], p1[2 * gp + 1]);
            *(uint4*)(qd + 16) = pair_swap(p2[2 * gp], p2[2 * gp + 1]);
          }
        }
      }
      __syncthreads();
    } else if (t < nQ + nKV) {
      const int t2 = t - nQ;
      const int rt = t2 >> 3, ct = t2 & 7;
      const int row0 = rt * 128, b = row0 / KPB, kk0 = row0 - b * KPB;
      row_rms(LAT + (size_t)row0 * 512 + 256, 512, 128, rs);
      f32x16 acc[2][2];
      zero_acc(acc);
      if (ct < 4) {
        gemm_core(acc, wsp<u16>(p, O_WUKV) + (size_t)ct * 128 * 128, 128, LAT + (size_t)row0 * 512 + 256, 512, 128,
                  smem);
        u16* KN = wsp<u16>(p, O_KN);
#pragma unroll
        for (int i = 0; i < 2; i++)
#pragma unroll
          for (int j = 0; j < 2; j++)
#pragma unroll
            for (int gp = 0; gp < 2; gp++) {
              const int rl = wn_ * 64 + j * 32 + r_;
              const int col = ct * 128 + wm_ * 64 + i * 32 + 8 * (2 * gp + hh_);
              const float sc = rs[rl];
              uint2 oa, ob;
              oa.x = pack2(acc[i][j][8 * gp] * sc, acc[i][j][8 * gp + 1] * sc);
              oa.y = pack2(acc[i][j][8 * gp + 2] * sc, acc[i][j][8 * gp + 3] * sc);
              ob.x = pack2(acc[i][j][8 * gp + 4] * sc, acc[i][j][8 * gp + 5] * sc);
              ob.y = pack2(acc[i][j][8 * gp + 6] * sc, acc[i][j][8 * gp + 7] * sc);
              *(uint4*)(KN + (size_t)(row0 + rl) * 512 + col) = pair_swap(oa, ob);
            }
      } else {
        gemm_core(acc, LAT + (size_t)row0 * 512 + 256, 512, wsp<u16>(p, O_WUKV) + (size_t)ct * 128 * 128, 128, 128,
                  smem);
        u16* VMT = wsp<u16>(p, O_VMT);
#pragma unroll
        for (int i = 0; i < 2; i++)
#pragma unroll
          for (int j = 0; j < 2; j++)
#pragma unroll
            for (int gp = 0; gp < 2; gp++) {
              const int ra = wm_ * 64 + i * 32 + 16 * gp + 4 * hh_;
              const int rb2 = ra + 8;
              const int rst = wm_ * 64 + i * 32 + 8 * (2 * gp + hh_);
              const int col = (ct - 4) * 128 + wn_ * 64 + j * 32 + r_;
              uint2 oa, ob;
              oa.x = pack2(acc[i][j][8 * gp] * rs[ra], acc[i][j][8 * gp + 1] * rs[ra + 1]);
              oa.y = pack2(acc[i][j][8 * gp + 2] * rs[ra + 2], acc[i][j][8 * gp + 3] * rs[ra + 3]);
              ob.x = pack2(acc[i][j][8 * gp + 4] * rs[rb2], acc[i][j][8 * gp + 5] * rs[rb2 + 1]);
              ob.y = pack2(acc[i][j][8 * gp + 6] * rs[rb2 + 2], acc[i][j][8 * gp + 7] * rs[rb2 + 3]);
              *(uint4*)(VMT + ((size_t)(b * 512 + col)) * KPB + kk0 + rst) = make_uint4(oa.x, oa.y, ob.x, ob.y);
            }
      }
      __syncthreads();
    } else if (t < nQ + nKV + nFA) {
      const int t2 = t - nQ - nKV;
      const int rt = t2 >> 1, ct = t2 & 1;
      const int b = rt >> 9, jj = rt & 511;
      f32x16 acc[2][2];
      zero_acc(acc);
      gemm_core(acc, wsp<u16>(p, O_D1) + (size_t)rt * 128 * 256, 256, wsp<u16>(p, O_MA) + (size_t)ct * 128 * 256, 256,
                256, smem);
      const float* TW = wsp<float>(p, O_TW);
      u16* D2 = wsp<u16>(p, O_D2);
      const int klo = ct * 64 + wn_ * 32 + r_;
      const float2* twp = (const float2*)TW + klo;
#pragma unroll
      for (int i = 0; i < 2; i++)
      {
        uint2 pr[4], pi[4];
#pragma unroll
        for (int g = 0; g < 4; g++) {
          const int nlo = wm_ * 64 + i * 32 + 8 * g + 4 * hh_;
          float re[4], im[4];
#pragma unroll
          for (int q = 0; q < 4; q++) {
            const float2 tw = twp[(nlo + q) * 128];
            const float ar = acc[i][0][4 * g + q], ai = acc[i][1][4 * g + q];
            re[q] = ar * tw.x + ai * tw.y;
            im[q] = ai * tw.x - ar * tw.y;
          }
          pr[g].x = pack2(re[0], re[1]);
          pr[g].y = pack2(re[2], re[3]);
          pi[g].x = pack2(im[0], im[1]);
          pi[g].y = pack2(im[2], im[3]);
        }
#pragma unroll
        for (int gp = 0; gp < 2; gp++) {
          u16* d = D2 + ((((size_t)(b * 128 + klo)) * 512 + jj) * 2) * 128 + wm_ * 64 + i * 32 + 8 * (2 * gp + hh_);
          *(uint4*)d = pair_swap(pr[2 * gp], pr[2 * gp + 1]);
          *(uint4*)(d + 128) = pair_swap(pi[2 * gp], pi[2 * gp + 1]);
        }
      }
    } else {
      const int rt = t - nQ - nKV - nFA;
      u16* KRR = wsp<u16>(p, O_KRR);
      for (int idx = ltid(); idx < 128 * 16; idx += 256) {
        const int rl = idx >> 4, e16 = idx & 15;
        const int row = rt * 128 + rl, b = row / KPB, kk = row - b * KPB;
        const float x1 = bf2f(LAT[(size_t)row * 512 + 384 + e16]), x2 = bf2f(LAT[(size_t)row * 512 + 400 + e16]);
        float cs, sn;
        rope_cs(kk, e16, cs, sn);
        KRR[(size_t)row * 32 + e16] = f2bf(x1 * cs - x2 * sn);
        KRR[(size_t)row * 32 + 16 + e16] = f2bf(x2 * cs + x1 * sn);
      }
    }
  }
}

template <int MODE>
__device__ void attn_item(const Params& p, int l, int b, int h, int q0  ,
                          int ntiles  , int rs0, int ycol, u16* smem) {
  constexpr int DQK = MODE == 0 ? 96 : 64;
  constexpr int KSTR = DQK + 8;
  constexpr int NKS = DQK / 16;
  constexpr int CPR = DQK / 8;
  constexpr int NKC = 64 * CPR / 256;
  const int tid = ltid(), lane = tid & 63, wave = tid >> 6, r = lane & 31, hh = lane >> 5;
  u16* Ks = smem;
  u16* Vs = smem + 2 * 64 * KSTR;
  const unsigned char* wsb = p.ws;
  const int qk = q0 + wave * 32 + r;
  const size_t qrow = (size_t)b * KPB + qk;
  bf16x8 qf[NKS];
  {
    const u16* qp = MODE == 0 ? wsp<u16>(p, O_QM) + qrow * 768 + h * 96 : wsp<u16>(p, O_QNA) + qrow * 512 + h * 64;
#pragma unroll
    for (int ks = 0; ks < NKS; ks++) qf[ks] = *(const bf16x8*)(qp + ks * 16 + hh * 8);
  }
  const short one_or_zero = hh == 0 ? (short)0x3F80 : (short)0;
  const bf16x8 kone = {one_or_zero, 0, 0, 0, 0, 0, 0, 0};
  bf16x8 qm = {0, 0, 0, 0, 0, 0, 0, 0};
  int qr = 0, qc = 0, rsq = 0, cs = 0;
  const float* rpb = nullptr;
  if (MODE == 1 && rs0 >= 0) {
    const int tkn = qk - CTXL;
    qr = tkn >> 6;
    qc = tkn & 63;
    rsq = min(max(qr - 4, 0), 248);
    cs = min(max(qc - 8, 0), 48);
    rpb = p.rpb + ((size_t)(l * 8 + h)) * 15 * 31;
  }
  f32x16 o[2];
#pragma unroll
  for (int e = 0; e < 16; e++) { o[0][e] = 0.f; o[1][e] = 0.f; }
  float lsum = 0.f;
  float m = 0.f;
  const bf16x8 ones = {(short)0x3F80, (short)0x3F80, (short)0x3F80, (short)0x3F80,
                       (short)0x3F80, (short)0x3F80, (short)0x3F80, (short)0x3F80};

#define KGEO(i)                                                                                          \
  uint32_t kof##i, kmu##i;                                                                               \
  int kls##i;                                                                                            \
  {                                                                                                      \
    const int c = tid + 256 * (i);                                                                       \
    const int row = c / CPR, cc = c - row * CPR;                                                         \
    if (MODE == 0 && cc >= 8) {                                                                          \
      kof##i = (uint32_t)(O_KRR + ((size_t)(b * KPB + row) * 32 + (cc - 8) * 8) * 2);                    \
      kmu##i = 64u;                                                                                      \
    } else {                                                                                             \
      kof##i = (uint32_t)((MODE == 0 ? O_KN : O_KNA) + ((size_t)(b * KPB + row) * 512 + h * 64 + cc * 8) * 2); \
      kmu##i = 1024u;                                                                                    \
    }                                                                                                    \
    kls##i = row * KSTR + cc * 8;                                                                        \
  }
#define VGEO(i)                                                                                          \
  uint32_t vof##i;                                                                                       \
  int vls##i;                                                                                            \
  bool vsx##i;                                                                                           \
  {                                                                                                      \
    const int c = tid + 256 * (i);                                                                       \
    const int d = c >> 3, cc = c & 7;                                                                    \
    vof##i = (uint32_t)((MODE == 0 ? O_VMT : O_VNAT) + ((size_t)(b * 512 + h * 64 + d) * KPB + cc * 8) * 2); \
    vls##i = d * 72 + cc * 8;                                                                            \
    vsx##i = (d & 8) != 0;                                                                               \
  }
  KGEO(0) KGEO(1) KGEO(2) VGEO(0) VGEO(1)
  (void)kof2; (void)kmu2; (void)kls2;
  u32x4 kr0A, kr1A, kr2A, vr0A, vr1A, kr0B, kr1B, kr2B, vr0B, vr1B;
  kr2A = kr1A = kr0A = vr0A = vr1A = kr2B = kr1B = kr0B = vr0B = vr1B = (u32x4){0u, 0u, 0u, 0u};
#define TILE_KK0(t) ((MODE == 1 && (t) >= 4) ? (uint32_t)(CTXL + 64 * min(rs0 + (t)-4, 255)) : (uint32_t)(64 * (t)))
#define LOAD_KV(t, S)                                                                   \
  {                                                                                     \
    const uint32_t kk0_ = TILE_KK0(t);                                                  \
    kr0##S = *(const u32x4*)(wsb + (size_t)(kof0 + kk0_ * kmu0));                       \
    kr1##S = *(const u32x4*)(wsb + (size_t)(kof1 + kk0_ * kmu1));                       \
    if (NKC == 3) kr2##S = *(const u32x4*)(wsb + (size_t)(kof2 + kk0_ * kmu2));         \
    vr0##S = *(const u32x4*)(wsb + (size_t)(vof0 + kk0_ * 2u));                         \
    vr1##S = *(const u32x4*)(wsb + (size_t)(vof1 + kk0_ * 2u));                         \
  }
#define STORE_V1(buf, i, srcv)                                                          \
  {                                                                                     \
    *(u32x4*)(Vs + (buf)*64 * 72 + vls##i) = srcv;                                      \
  }
#define STORE_KV(buf, S)                                                                \
  {                                                                                     \
    *(u32x4*)(Ks + (buf)*64 * KSTR + kls0) = kr0##S;                                    \
    *(u32x4*)(Ks + (buf)*64 * KSTR + kls1) = kr1##S;                                    \
    if (NKC == 3) *(u32x4*)(Ks + (buf)*64 * KSTR + kls2) = kr2##S;                      \
    STORE_V1(buf, 0, vr0##S) STORE_V1(buf, 1, vr1##S)                                   \
  }
#define QK_TILE(kbuf, t)                                                                           \
  {                                                                                                \
    const u16* kb_ = Ks + (kbuf)*64 * KSTR + r * KSTR + hh * 8;                                    \
    {                                                                                              \
      f32x16 z_;                                                                                   \
      _Pragma("unroll") for (int e = 0; e < 16; e++) z_[e] = 0.f;                                  \
      f32x16 s0_ = __builtin_amdgcn_mfma_f32_32x32x16_bf16(kone, qm, z_, 0, 0, 0);                 \
      asm volatile("" : "+v"(s0_));              \
      sc[0] = s0_;                                                                                 \
      sc[1] = s0_;                                                                                 \
    }                                                                                              \
    _Pragma("unroll") for (int ks = 0; ks < NKS; ks++) {                                           \
      const bf16x8 kf0 = *(const bf16x8*)(kb_ + ks * 16);                                          \
      const bf16x8 kf1 = *(const bf16x8*)(kb_ + 32 * KSTR + ks * 16);                              \
      sc[0] = __builtin_amdgcn_mfma_f32_32x32x16_bf16(kf0, qf[ks], sc[0], 0, 0, 0);                \
      sc[1] = __builtin_amdgcn_mfma_f32_32x32x16_bf16(kf1, qf[ks], sc[1], 0, 0, 0);                \
    }                                                                                              \
    if (MODE == 1 && (t) >= 4) {                                                                   \
      const int kr_ = rs0 + (t)-4;                                                                 \
      const bool rowok = (kr_ >= rsq) && (kr_ < rsq + 8);                                          \
      const float* rp = rpb + (kr_ - qr + 7) * 31 + (15 - qc);                                     \
      _Pragma("unroll") for (int kb = 0; kb < 2; kb++) _Pragma("unroll") for (int e = 0; e < 16; e++) { \
        const int kc = kb * 32 + (e & 3) + 8 * (e >> 2) + 4 * hh;                                  \
        const bool valid = rowok && (kc >= cs) && (kc < cs + 16);                                  \
        float bias = 0.f;                                                                          \
        if (valid) bias = rp[kc];                                                                  \
        sc[kb][e] = valid ? sc[kb][e] + bias * LOG2E : -1e30f;                                     \
      }                                                                                            \
    }                                                                                              \
  }
#define TILE_MAX(tmax)                                                                             \
  {                                                                                                \
    tmax = sc[0][0];                                                                               \
    _Pragma("unroll") for (int e = 1; e < 16; e++) tmax = fmaxf(tmax, sc[0][e]);                   \
    _Pragma("unroll") for (int e = 0; e < 16; e++) tmax = fmaxf(tmax, sc[1][e]);                   \
    const uint32_t tu = __float_as_uint(tmax);                                                     \
    const auto sw = __builtin_amdgcn_permlane32_swap(tu, tu, false, false);                        \
    tmax = fmaxf(__uint_as_float(sw[0]), __uint_as_float(sw[1]));                                  \
  }
#define MOVE_REF(mnew_)                                                                            \
  {                                                                                                \
    const float mq_ = bf2f(f2bf(mnew_));                                                           \
    const float delta_ = mq_ - m;                                                                  \
    const float alpha = __builtin_amdgcn_exp2f(-delta_);                                           \
    m = mq_;                                                                                       \
    _Pragma("unroll") for (int e = 0; e < 16; e++) {                                               \
      o[0][e] *= alpha; o[1][e] *= alpha;                                                         \
      sc[0][e] -= delta_; sc[1][e] -= delta_;                                                      \
    }                                                                                              \
    lsum *= alpha;                                                                                 \
    qm[0] = (hh == 0) ? (short)f2bf(-m) : (short)0;                                                \
  }
#define SOFTMAX_PV(vbuf)                                                                           \
  {                                                                                                \
    const u16* vb_ = Vs + (vbuf)*64 * 72 + r * 72 + 8 * hh;                                        \
    _Pragma("unroll") for (int kb = 0; kb < 2; kb++) _Pragma("unroll") for (int st = 0; st < 2; st++) { \
      u32x4 pu;                                                                                    \
      _Pragma("unroll") for (int q = 0; q < 4; q++) {                                              \
        const float p0_ = __builtin_amdgcn_exp2f(sc[kb][8 * st + 2 * q]);                          \
        const float p1_ = __builtin_amdgcn_exp2f(sc[kb][8 * st + 2 * q + 1]);                      \
        lsum += p0_ + p1_;                                                                         \
        pu[q] = pack2(p0_, p1_);                                                                   \
      }                                                                                            \
      const bf16x8 pbv = __builtin_bit_cast(bf16x8, pu);                                           \
      _Pragma("unroll") for (int db = 0; db < 2; db++) {                                           \
        const u16* vp = vb_ + db * 32 * 72 + kb * 32 + 16 * st;                                    \
        const bf16x8 vfv = *(const bf16x8*)(vp);     \
        o[db] = __builtin_amdgcn_mfma_f32_32x32x16_bf16(vfv, pbv, o[db], 0, 0, 0);                 \
      }                                                                                            \
    }                                                                                              \
  }
#define DEFER_REF(tmax)                                                                            \
  if (__any(tmax > 8.f)) {                                                                         \
    const float mq_ = bf2f(f2bf(m + fmaxf(tmax, 0.f)));                                            \
    const float alpha = __builtin_amdgcn_exp2f(m - mq_);                                           \
    m = mq_;                                                                                       \
    _Pragma("unroll") for (int e = 0; e < 16; e++) { o[0][e] *= alpha; o[1][e] *= alpha; }       \
    lsum *= alpha;                                                                                 \
    qm[0] = (hh == 0) ? (short)f2bf(-m) : (short)0;                                                \
  }
#define ATT_STEP(t, LD, ST)                                        \
  {                                                                \
    const int cur = (t)&1;                                         \
    QK_TILE(cur, t)                                                \
    __builtin_amdgcn_sched_barrier(0);                             \
    LOAD_KV(min((t) + 2, tl), LD)                                  \
    __builtin_amdgcn_sched_barrier(0);                             \
    __builtin_amdgcn_s_setprio(1);                                 \
    SOFTMAX_PV(cur)                                                \
    __builtin_amdgcn_s_setprio(0);                                 \
      \
                               \
    if ((((t) & 3) == 1)) {                                        \
      float tmax;                                                  \
      TILE_MAX(tmax)                                               \
      DEFER_REF(tmax)                                              \
    }                                                              \
    STORE_KV(cur ^ 1, ST)                                          \
    __syncthreads();                                               \
  }

  const int tl = ntiles - 1;
  f32x16 sc[2];
  LOAD_KV(0, A)
  STORE_KV(0, A)
  LOAD_KV(min(1, tl), A)
  __syncthreads();
  {
    LOAD_KV(min(2, tl), B)
    __builtin_amdgcn_sched_barrier(0);
    QK_TILE(0, 0)
    float tmax;
    TILE_MAX(tmax)
    MOVE_REF(tmax)
    SOFTMAX_PV(0)
    STORE_KV(1, A)
    __syncthreads();
  }
  for (int t = 1; t + 1 < ntiles; t += 2) {
    ATT_STEP(t, A, B)
    ATT_STEP(t + 1, B, A)
  }
  ATT_STEP(tl, A, B)
  const float inv = 1.f / (lsum + __shfl_xor(lsum, 32));
  u16* yp = wsp<u16>(p, O_Y) + qrow * 1536 + ycol + h * 64;
#pragma unroll
  for (int db = 0; db < 2; db++)
#pragma unroll
    for (int gp = 0; gp < 2; gp++) {
      uint2 oa, ob;
      oa.x = pack2(o[db][8 * gp] * inv, o[db][8 * gp + 1] * inv);
      oa.y = pack2(o[db][8 * gp + 2] * inv, o[db][8 * gp + 3] * inv);
      ob.x = pack2(o[db][8 * gp + 4] * inv, o[db][8 * gp + 5] * inv);
      ob.y = pack2(o[db][8 * gp + 6] * inv, o[db][8 * gp + 7] * inv);
      *(uint4*)(yp + db * 32 + 8 * (2 * gp + hh)) = pair_swap(oa, ob);
    }
#undef KGEO
#undef VGEO
#undef TILE_KK0
#undef LOAD_KV
#undef STORE_V1
#undef STORE_KV
#undef QK_TILE
#undef TILE_MAX
#undef MOVE_REF
#undef SOFTMAX_PV
#undef ATT_STEP
#undef DEFER_REF
}

__device__ void phase_p3(const Params& p, int l, bool last, int bid, int nb, u16* smem) {
  EPI_DECL
  const int nMLA = 2048, nNA = 2048, nFB = 1024;
  const int nC = last ? 0 : (32 + 32 + 16);
  const int total = nMLA + nNA + nFB + nC;
  for (int t = bid; t < total; t += nb) {
    int kind, b = 0, h = 0, q0 = 0, ntl = 0, rs0 = -1;
    size_t aoff = 0, boff = 0;
    int Kf = 256, j0 = 0, tok0 = 0, tokmul = 1, colbase = 0;
    if (t < nMLA) {
      kind = 0;
      h = t & 7;
      const int rest = t >> 3;
      b = rest >> 7;
      q0 = CTXL + (rest & 127) * 128;
      ntl = 260;
    } else if (t < nMLA + nNA) {
      kind = 1;
      const int t2 = t - nMLA;
      h = t2 & 7;
      const int rest = t2 >> 3, rp = rest & 127;
      b = rest >> 7;
      rs0 = min(max(2 * rp - 4, 0), 248);
      const int rs1 = min(max(2 * rp + 1 - 4, 0), 248);
      q0 = CTXL + rp * 128;
      ntl = (4 + (rs1 + 8 - rs0) + 1) & ~1;
    } else if (t < nMLA + nNA + nFB) {
      kind = 2;
      const int rt = t - nMLA - nNA;
      const int bk = rt >> 2;
      j0 = (rt & 3) * 128;
      b = bk >> 7;
      tok0 = CTXL + (bk & 127);
      tokmul = 128;
      aoff = O_D2 + (size_t)rt * 128 * 256 * 2;
      boff = O_MB;
      Kf = 256;
    } else {
      const int t2 = t - nMLA - nNA - nFB;
      if (t2 < 64) {
        kind = t2 >> 5;
        const int t3 = t2 & 31;
        h = t3 & 7;
        b = (t3 >> 3) & 1;
        q0 = (t3 >> 4) * 128;
        ntl = 4;
      } else {
        kind = 2;
        const int t3 = t2 - 64;
        const int rt = t3 >> 1, ct = t3 & 1;
        b = rt >> 2;
        j0 = (rt & 3) * 128;
        colbase = ct * 128;
        aoff = O_D1C + (size_t)rt * 128 * 512 * 2;
        boff = O_MC + (size_t)ct * 128 * 512 * 2;
        Kf = 512;
      }
    }
    if (kind == 0) {
      attn_item<0>(p, l, b, h, q0, ntl, -1, 1024, smem);
    } else if (kind == 1) {
      attn_item<1>(p, l, b, h, q0, ntl, rs0, 512, smem);
    } else {
      f32x16 acc[2][2];
      zero_acc(acc);
      gemm_core(acc, wsp<u16>(p, aoff), Kf, wsp<u16>(p, boff), Kf, Kf, smem);
      u16* Y = wsp<u16>(p, O_Y);
#pragma unroll
      for (int i = 0; i < 2; i++)
#pragma unroll
        for (int j = 0; j < 2; j++)
#pragma unroll
          for (int gp = 0; gp < 2; gp++) {
            const int jj = j0 + wm_ * 64 + i * 32 + 8 * (2 * gp + hh_);
            const int tok = tok0 + (colbase + wn_ * 64 + j * 32 + r_) * tokmul;
            uint2 oa, ob;
            oa.x = pack2(acc[i][j][8 * gp], acc[i][j][8 * gp + 1]);
            oa.y = pack2(acc[i][j][8 * gp + 2], acc[i][j][8 * gp + 3]);
            ob.x = pack2(acc[i][j][8 * gp + 4], acc[i][j][8 * gp + 5]);
            ob.y = pack2(acc[i][j][8 * gp + 6], acc[i][j][8 * gp + 7]);
            *(uint4*)(Y + ((size_t)b * KPB + tok) * 1536 + jj) = pair_swap(oa, ob);
          }
    }
  }
}

__device__ __forceinline__ int n_row_tiles(bool last) { return last ? NRT - 4 : NRT; }
__device__ __forceinline__ int row_tile(bool last, int i) {
  if (!last) return i;
  return i < 128 ? i + 2 : i + 4;
}

__device__ void phase_p4(const Params& p, int l, bool last, int bid, int nb, u16* smem) {
  EPI_DECL
  const u16* A = wsp<u16>(p, O_A);
  const u16* Y = wsp<u16>(p, O_Y);
  u16* M = wsp<u16>(p, O_M);
  uint4* stash = wsp<uint4>(p, O_QM) + (size_t)bid * 24 * 256 + ltid();
  const int nrt_ = n_row_tiles(last);
  PATCH_LOOP_BEGIN(nrt_, 8, 8, 8)
    const int rt = row_tile(last, prt), ct = pct;
    f32x16 mg[2][2];
    zero_acc(mg);
#pragma unroll 1
    for (int g = 0; g < 3; g++) {
      uint32_t gp[2][2][8];
      {
        f32x16 acc[2][2];
        zero_acc(acc);
        gemm_core<true>(acc, wsp<u16>(p, O_WG) + (size_t)(g * 1024 + ct * 128) * D, D, A + (size_t)rt * 128 * D, D, D,
                        smem);
#pragma unroll
        for (int i = 0; i < 2; i++)
#pragma unroll
          for (int j = 0; j < 2; j++)
#pragma unroll
            for (int e = 0; e < 8; e++)
              gp[i][j][e] = pack2(fsigmoid(acc[i][j][2 * e]), fsigmoid(acc[i][j][2 * e + 1]));
      }
      {
        f32x16 acc[2][2];
        zero_acc(acc);
        gemm_core<false>(acc, wsp<u16>(p, O_WB) + (size_t)(g * 1024 + ct * 128) * 512, 512,
                         Y + (size_t)rt * 128 * 1536 + g * 512, 1536, 512, smem);
#pragma unroll
        for (int i = 0; i < 2; i++)
#pragma unroll
          for (int j = 0; j < 2; j++)
#pragma unroll
            for (int e = 0; e < 8; e++) {
              mg[i][j][2 * e] += __uint_as_float(gp[i][j][e] << 16) * acc[i][j][2 * e];
              mg[i][j][2 * e + 1] += __uint_as_float(gp[i][j][e] & 0xffff0000u) * acc[i][j][2 * e + 1];
            }
      }
    }
#pragma unroll
    for (int i = 0; i < 2; i++)
#pragma unroll
      for (int j = 0; j < 2; j++)
#pragma unroll
        for (int gp = 0; gp < 2; gp++) {
          const int row = rt * 128 + wn_ * 64 + j * 32 + r_;
          const int col = ct * 128 + wm_ * 64 + i * 32 + 8 * (2 * gp + hh_);
          uint2 oa, ob;
          oa.x = pack2(mg[i][j][8 * gp], mg[i][j][8 * gp + 1]);
          oa.y = pack2(mg[i][j][8 * gp + 2], mg[i][j][8 * gp + 3]);
          ob.x = pack2(mg[i][j][8 * gp + 4], mg[i][j][8 * gp + 5]);
          ob.y = pack2(mg[i][j][8 * gp + 6], mg[i][j][8 * gp + 7]);
          *(uint4*)(M + (size_t)row * D + col) = pair_swap(oa, ob);
        }
  PATCH_LOOP_END
}

__device__ void phase_resid(const Params& p, int l, bool last, const u16* Ain, size_t lda, const u16* W, int K,
                            int bid, int nb, u16* smem) {
  EPI_DECL
  const int nrt_ = n_row_tiles(last);
  PATCH_LOOP_BEGIN(nrt_, 8, 8, 8)
    const int rt = row_tile(last, prt), ct = pct;
    f32x16 acc[2][2];
    zero_acc(acc);
    gemm_core(acc, W + (size_t)ct * 128 * K, K, Ain + (size_t)rt * 128 * lda, lda, K, smem);
    u16* FB = wsp<u16>(p, O_FB);
#pragma unroll
    for (int i = 0; i < 2; i++)
#pragma unroll
      for (int j = 0; j < 2; j++)
#pragma unroll
        for (int gp = 0; gp < 2; gp++) {
          const int row = rt * 128 + wn_ * 64 + j * 32 + r_;
          const int col = ct * 128 + wm_ * 64 + i * 32 + 8 * (2 * gp + hh_);
          uint2 oa, ob;
          oa.x = pack2(acc[i][j][8 * gp], acc[i][j][8 * gp + 1]);
          oa.y = pack2(acc[i][j][8 * gp + 2], acc[i][j][8 * gp + 3]);
          ob.x = pack2(acc[i][j][8 * gp + 4], acc[i][j][8 * gp + 5]);
          ob.y = pack2(acc[i][j][8 * gp + 6], acc[i][j][8 * gp + 7]);
          *(uint4*)(FB + (size_t)row * D + col) = pair_swap(oa, ob);
        }
  PATCH_LOOP_END
}

__device__ void phase_p7(const Params& p, int l, bool last, int bid, int nb, u16* smem) {
  EPI_DECL
  const u16* A = wsp<u16>(p, O_A);
  u16* HH = wsp<u16>(p, O_HH);
  const int nrt_ = n_row_tiles(last);
  PATCH_LOOP_BEGIN(nrt_, 44, 16, 4)
    const int rt = row_tile(last, prt), ct = pct;
    f32x16 acc[2][2];
    zero_acc(acc);
    gemm_core(acc, wsp<u16>(p, O_WGU) + (size_t)ct * 128 * D, D, A + (size_t)rt * 128 * D, D, D, smem);
#pragma unroll
    for (int j = 0; j < 2; j++)
#pragma unroll
      for (int gp = 0; gp < 2; gp++) {
        const int row = rt * 128 + wn_ * 64 + j * 32 + r_;
        const int q = (ct * 2 + wm_) * 32 + 8 * (2 * gp + hh_);
        float hv[8];
#pragma unroll
        for (int t = 0; t < 8; t++) {
          const float gt = acc[0][j][8 * gp + t], up = acc[1][j][8 * gp + t];
          hv[t] = gt * fsigmoid(gt) * up;
        }
        uint2 oa, ob;
        oa.x = pack2(hv[0], hv[1]);
        oa.y = pack2(hv[2], hv[3]);
        ob.x = pack2(hv[4], hv[5]);
        ob.y = pack2(hv[6], hv[7]);
        *(uint4*)(HH + (size_t)row * FH + q) = pair_swap(oa, ob);
      }
  PATCH_LOOP_END
}

constexpr int NPHASE = 3 + 9 * 2;

__device__ void run_phase(const Params& p, int ph, int bid, int nb, u16* smem) {
  if (ph == 0) {
    prep_tables(p, bid, nb);
    prep_modp(p, bid, nb);
    prep_weights(p, 0, bid, nb, smem);
    return;
  }
  if (ph == 1) { prep_modr(p, bid, nb); return; }
  if (ph == 2) { ln_phase(p, 0, p.ln_in_g, p.ln_in_b, 0, 0, 1024, false, bid, nb); return; }
  const int l = (ph - 3) / 9, s = (ph - 3) % 9;
  const bool last = (l == 1);
  switch (s) {
    case 0: phase_p1(p, l, last, bid, nb, smem); break;
    case 1: phase_p2(p, l, bid, nb, smem); break;
    case 2: phase_p3(p, l, last, bid, nb, smem); break;
    case 3: phase_p4(p, l, last, bid, nb, smem); break;
    case 4: phase_resid(p, l, last, wsp<u16>(p, O_M), D, wsp<u16>(p, O_WO), D, bid, nb, smem); break;
    case 5: ln_phase(p, 1, p.ln1_g + l * D, p.ln1_b + l * D, l, 3072, 4096, last, bid, nb, l, 2048); break;
    case 6: phase_p7(p, l, last, bid, nb, smem); break;
    case 7: phase_resid(p, l, last, wsp<u16>(p, O_HH), FH, wsp<u16>(p, O_WD), FH, bid, nb, smem); break;
    default:
      ln_phase(p, 1, p.ln2_g + l * D, p.ln2_b + l * D, last ? -1 : l + 1, 0, 1024, last, bid, nb, l, 5120);
      if (!last) prep_weights(p, l + 1, bid, nb, smem);
      break;
  }
}


#define XB_TMO      128
#define XB_XCNT(j)  (256  + 64 * (j))
#define XB_XSUB(j)  (1280 + 64 * (j))
#define XB_XGEN(j)  (2304 + 64 * (j))
#define XB_TOP      3328
#define XB_TOPGEN   3392
#define XCD_BAR_WORDS 3456
#define XB_SPIN_CAP (1u << 20)
#define LAS __attribute__((address_space(3)))
__device__ __forceinline__ unsigned xb_ld(unsigned* p) { return __hip_atomic_load(p, __ATOMIC_RELAXED, __HIP_MEMORY_SCOPE_AGENT); }
__device__ __forceinline__ unsigned xb_add(unsigned* p, unsigned v) { return __hip_atomic_fetch_add(p, v, __ATOMIC_RELAXED, __HIP_MEMORY_SCOPE_AGENT); }
__device__ __forceinline__ unsigned xb_xcc_id() { return (unsigned)__builtin_amdgcn_s_getreg((3 << 11) | 20) & 0xFu; }
#define XB_SPIN(cond, bar) do { unsigned _sp = 0; while (cond) { __builtin_amdgcn_s_sleep(1); \
    if ((++_sp & 255u) == 0u) { if (xb_ld(&(bar)[XB_TMO])) break; if (_sp > XB_SPIN_CAP) { atomicAdd(&(bar)[XB_TMO], 1u); break; } } } } while (0)
struct XcdBarrier {
  unsigned* bar; unsigned x;
  volatile LAS unsigned* st;
};
__device__ __forceinline__ XcdBarrier xcd_barrier_post(unsigned* bar, volatile LAS unsigned* st) {
  XcdBarrier b; b.bar = bar; b.x = xb_xcc_id(); b.st = st;
  if (threadIdx.x == 0) (void)xb_add(&bar[XB_XCNT(b.x)], 1u);
  return b;
}
__device__ __forceinline__ void xcd_barrier_complete(unsigned* bar, unsigned x, unsigned& nloc, unsigned& nx) {
  const unsigned G = gridDim.x * gridDim.y * gridDim.z;
  unsigned sum, cnt, mine, sp = 0u;
  for (;;) {
    sum = 0u; cnt = 0u; mine = 0u;
#pragma unroll
    for (unsigned j = 0; j < 16; ++j) { const unsigned c = xb_ld(&bar[XB_XCNT(j)]); sum += c; cnt += (c > 0u) ? 1u : 0u; mine = (j == x) ? c : mine; }
    if (sum == G) break;
    __builtin_amdgcn_s_sleep(1);
    if ((++sp & 255u) == 0u) { if (xb_ld(&bar[XB_TMO])) break; if (sp > XB_SPIN_CAP) { atomicAdd(&bar[XB_TMO], 1u); break; } }
  }
  nloc = mine > 0u ? mine : 1u; nx = cnt > 0u ? cnt : 1u;
}
__device__ __forceinline__ void xcd_barrier(const XcdBarrier& b) {
  asm volatile("s_waitcnt vmcnt(0)" ::: "memory");
  __syncthreads();
  if (threadIdx.x == 0) {
    unsigned* bar = b.bar;
    __builtin_amdgcn_s_waitcnt(0);
    unsigned nloc = b.st[0], nx = b.st[1];
    if (nloc == 0u) { xcd_barrier_complete(bar, b.x, nloc, nx); b.st[0] = nloc; b.st[1] = nx; }
    const unsigned old = xb_add(&bar[XB_XSUB(b.x)], 1u);
    const unsigned gen = old / nloc;
    if (old + 1u == (gen + 1u) * nloc) {
      __builtin_amdgcn_fence(__ATOMIC_RELEASE, "agent");
      asm volatile("s_waitcnt vmcnt(0)" ::: "memory");
      const unsigned og = xb_add(&bar[XB_TOP], 1u);
      const unsigned tg = og / nx;
      if (og + 1u == (tg + 1u) * nx) xb_add(&bar[XB_TOPGEN], 1u);
      else XB_SPIN(xb_ld(&bar[XB_TOPGEN]) == tg, bar);
      __builtin_amdgcn_fence(__ATOMIC_ACQUIRE, "agent");
      xb_add(&bar[XB_XGEN(b.x)], 1u);
      asm volatile("s_waitcnt vmcnt(0)" ::: "memory");
    } else {
      XB_SPIN(xb_ld(&bar[XB_XGEN(b.x)]) == gen, bar);
      __builtin_amdgcn_fence(__ATOMIC_ACQUIRE, "agent");
      asm volatile("s_waitcnt vmcnt(0)" ::: "memory");
    }
  }
  __syncthreads();
}

constexpr int SMEM_ELEMS = 4 * SM_A + 256 + 8;

#if COOP
__global__ void __launch_bounds__(256, 2) mega_kernel(Params p) {
  __shared__ __attribute__((aligned(16))) u16 smem[SMEM_ELEMS];
  cg::grid_group grid = cg::this_grid();
  volatile LAS unsigned* st = (volatile LAS unsigned*)(smem + 4 * SM_A + 256);
  if (threadIdx.x == 0) { st[0] = 0u; st[1] = 0u; }
  __syncthreads();
  XcdBarrier xb = xcd_barrier_post((unsigned*)(p.ws + O_BAR), st);
  for (int ph = 0; ph < NPHASE; ph++) {
#ifdef PROBE_MASK
    const int s9 = ph >= 3 ? (ph - 3) % 9 : -1;
    const int nrep = (s9 >= 0 && ((PROBE_MASK >> s9) & 1)) ? 2 : 1;
    for (int rep = 0; rep < nrep; rep++) {
      run_phase(p, ph, blockIdx.x, gridDim.x, smem);
      if (ph == 0) grid.sync();
      else if (ph + 1 < NPHASE || rep + 1 < nrep) xcd_barrier(xb);
    }
#else
    run_phase(p, ph, blockIdx.x, gridDim.x, smem);
    if (ph == 0) grid.sync();
    else if (ph + 1 < NPHASE) xcd_barrier(xb);
#endif
  }
}
#else
__global__ void __launch_bounds__(256, 2) phase_kernel(Params p, int ph) {
  __shared__ __attribute__((aligned(16))) u16 smem[SMEM_ELEMS];
  run_phase(p, ph, blockIdx.x, gridDim.x, smem);
}
#endif

extern "C" void kernel_launch(void* const* d_in, const int* in_sizes, int n_in, void* d_out, int out_size, void* d_ws,
                              size_t ws_size, hipStream_t stream) {
  Params p{};
  const float** f = (const float**)&p;
  for (int i = 0; i < 25; i++) f[i] = (const float*)d_in[i];
  p.out = (float*)d_out;
  p.ws = (unsigned char*)d_ws;
  if (ws_size < O_WSEND) fprintf(stderr, "workspace too small: %zu < %zu\n", ws_size, (size_t)O_WSEND);
#if COOP
  static int grid_blocks = 0;
  if (!grid_blocks) {
    int dev = 0, cus = 0, per_cu = 0;
    hipGetDevice(&dev);
    hipDeviceGetAttribute(&cus, hipDeviceAttributeMultiprocessorCount, dev);
    hipOccupancyMaxActiveBlocksPerMultiprocessor(&per_cu, mega_kernel, 256, 0);
    if (per_cu > 2) per_cu = 2;
    grid_blocks = cus * per_cu;
  }
  (void)hipMemsetAsync(p.ws + O_BAR, 0, 3456 * 4, stream);
  void* args[] = {&p};
  hipError_t e = hipLaunchCooperativeKernel((void*)mega_kernel, dim3(grid_blocks), dim3(256), args, 0, stream);
  if (e != hipSuccess) fprintf(stderr, "cooperative launch failed: %s (grid %d)\n", hipGetErrorString(e), grid_blocks);
#else
  for (int ph = 0; ph < NPHASE; ph++) phase_kernel<<<512, 256, 0, stream>>>(p, ph);
#endif
}
```

```cpp
#include <hip/hip_runtime.h>
#include <hip/hip_cooperative_groups.h>
#include <stdint.h>
#include <cstdio>
namespace cg = cooperative_groups;

#ifndef COOP
#define COOP 1
#endif

typedef __attribute__((ext_vector_type(8))) short bf16x8;
typedef __attribute__((ext_vector_type(4))) short bf16x4;
typedef __attribute__((ext_vector_type(16))) float f32x16;
typedef unsigned short u16;
typedef __attribute__((ext_vector_type(4))) unsigned int u32x4;

constexpr int D = 1024;
constexpr int NBATCH = 2;
constexpr int SEQ = 16384;
constexpr int CTXL = 256;
constexpr int KPB = SEQ + CTXL;
constexpr int T = NBATCH * KPB;
constexpr int NRT = T / 128;
constexpr int FH = 2816;
constexpr int IN_DIM = 5536;
constexpr float LOG2E = 1.4426950408889634f;
constexpr float NA_SCALE_L2 = 0.125f * LOG2E;
constexpr float MLA_SCALE_L2 = 0.10206207261596575f * LOG2E;
constexpr float ALPHA = 1.4142135623730951f;
constexpr float EPS = 1e-5f;
constexpr float RS128 = 0.08838834764831845f;

constexpr size_t al256(size_t x) { return (x + 255) & ~(size_t)255; }
constexpr size_t O_WF = 0;
constexpr size_t O_WP = O_WF + (size_t)1024 * 1024 * 2;
constexpr size_t O_WG = O_WP + (size_t)2048 * 1024 * 2;
constexpr size_t O_WUQ = O_WG + (size_t)3072 * 1024 * 2;
constexpr size_t O_WUKV = O_WUQ + (size_t)768 * 256 * 2;
constexpr size_t O_WB = O_WUKV + (size_t)1024 * 128 * 2;
constexpr size_t O_WO = O_WB + (size_t)3 * 1024 * 512 * 2;
constexpr size_t O_WGU = O_WO + (size_t)1024 * 1024 * 2;
constexpr size_t O_WD = O_WGU + (size_t)5632 * 1024 * 2;
constexpr size_t O_MA = O_WD + (size_t)1024 * 2816 * 2;
constexpr size_t O_MB = O_MA + (size_t)256 * 256 * 2;
constexpr size_t O_MC = O_MB + (size_t)128 * 256 * 2;
constexpr size_t O_TW = O_MC + (size_t)256 * 512 * 2;
constexpr size_t O_MODP = O_TW + (size_t)128 * 128 * 2 * 4;
constexpr size_t O_MOD = O_MODP + (size_t)16 * 2 * 3 * 6144 * 4;
constexpr size_t O_XCTX = O_MOD + (size_t)2 * 3 * 6144 * 4;
constexpr size_t O_D1C = O_XCTX + (size_t)512 * 1024 * 4;
constexpr size_t O_A = O_D1C + (size_t)2 * 512 * 2 * 256 * 2;
constexpr size_t O_RQ = O_A + (size_t)T * 1024 * 2;
constexpr size_t O_QNA = O_RQ;
constexpr size_t O_KNA = O_QNA + (size_t)T * 512 * 2;
constexpr size_t O_VNAT = O_KNA + (size_t)T * 512 * 2;
constexpr size_t O_RY = O_VNAT + (size_t)T * 512 * 2;
constexpr size_t O_Y = O_RY;
constexpr size_t O_D1 = O_RY;
constexpr size_t O_LAT = O_RY + (size_t)67108864;
constexpr size_t O_D2 = O_RY + (size_t)T * 1536 * 2;
constexpr size_t O_QM = O_D2 + (size_t)67108864;
constexpr size_t O_KN = O_QM + (size_t)T * 768 * 2;
constexpr size_t O_KRR = O_KN + (size_t)T * 512 * 2;
constexpr size_t O_VMT = O_KRR + (size_t)T * 32 * 2;
constexpr size_t O_END = O_VMT + (size_t)T * 512 * 2;
constexpr size_t O_BAR = (O_END + 255) & ~(size_t)255;
constexpr size_t O_ROPE = (O_BAR + 3456 * 4 + 255) & ~(size_t)255;
constexpr size_t O_WSEND = O_ROPE + 256 * 8 * 2 * 4;
constexpr size_t O_FB = O_QM;
constexpr size_t O_M = O_RQ;
constexpr size_t O_HH = O_RQ;

struct Params {
  const float *x, *c, *ctx, *c_ctx, *ln_in_g, *ln_in_b, *w_mod, *b_mod, *w_in, *gq, *gkv, *w_uq, *w_qr, *w_uk,
      *w_uv, *rpb, *w_branch, *w_out, *ln1_g, *ln1_b, *ln2_g, *ln2_b, *w_gate, *w_up, *w_down;
  float* out;
  unsigned char* ws;
};

__device__ __forceinline__ u16 f2bf(float f) {
  uint32_t u = __float_as_uint(f);
  u += 0x7fffu + ((u >> 16) & 1u);
  return (u16)(u >> 16);
}
typedef __attribute__((ext_vector_type(2))) __bf16 bf16v2;
typedef __attribute__((ext_vector_type(2))) float f32v2;
__device__ __forceinline__ uint32_t pack2(float a, float b) {
  const f32v2 v = {a, b};
  return __builtin_bit_cast(uint32_t, __builtin_convertvector(v, bf16v2));
}
__device__ __forceinline__ uint4 pair_swap(uint2 a, uint2 b) {
  const auto rx = __builtin_amdgcn_permlane32_swap(a.x, b.x, false, false);
  const auto ry = __builtin_amdgcn_permlane32_swap(a.y, b.y, false, false);
  return make_uint4(rx[0], ry[0], rx[1], ry[1]);
}
__device__ __forceinline__ float bf2f(u16 v) { return __uint_as_float(((uint32_t)v) << 16); }
__device__ __forceinline__ float wsum(float v) {
#pragma unroll
  for (int o = 32; o > 0; o >>= 1) v += __shfl_xor(v, o);
  return v;
}
__device__ __forceinline__ float fsigmoid(float v) { return 1.f / (1.f + __expf(-v)); }

__device__ __forceinline__ int ltid() {
  int t = threadIdx.x;
  asm volatile("" : "+v"(t));
  return t;
}

template <typename Tp>
__device__ __forceinline__ Tp* wsp(const Params& p, size_t off) { return (Tp*)(p.ws + off); }

__device__ __forceinline__ float* xrow(const Params& p, int row) {
  int b = row / KPB, kk = row - b * KPB;
  if (kk < CTXL) return wsp<float>(p, O_XCTX) + (size_t)(b * CTXL + kk) * D;
  return p.out + (size_t)(b * SEQ + kk - CTXL) * D;
}

constexpr int LSTR = 72;
constexpr int SM_A = 128 * LSTR;

template <bool DEEP = true>
__device__ __forceinline__ void gemm_core(f32x16 (&acc)[2][2], const u16* __restrict__ A, size_t lda,
                                          const u16* __restrict__ B, size_t ldb, int K, u16* smem) {
  const int tid = ltid(), lane = tid & 63, wave = tid >> 6;
  const int wm = wave >> 1, wn = wave & 1, r = lane & 31, hh = lane >> 5;
  u16* sA = smem;
  u16* sB = smem + 2 * SM_A;
  const int lrow = tid >> 3, lkc = (tid & 7) * 8;
  const unsigned char* gab = (const unsigned char*)A;
  const unsigned char* gbb = (const unsigned char*)B;
  uint32_t oa[4], ob[4];
#pragma unroll
  for (int i = 0; i < 4; i++) {
    oa[i] = (uint32_t)(((size_t)(lrow + 32 * i) * lda + lkc) * 2);
    ob[i] = (uint32_t)(((size_t)(lrow + 32 * i) * ldb + lkc) * 2);
  }
  u16* wa = sA + lrow * LSTR + lkc;
  u16* wb = sB + lrow * LSTR + lkc;
  const u16* pa = sA + (wm * 64 + r) * LSTR + hh * 8;
  const u16* pb = sB + (wn * 64 + r) * LSTR + hh * 8;
  u32x4 a0r[4], b0r[4], a1r[4], b1r[4];
#define G_LOAD(ar, br, ko)                                               \
  _Pragma("unroll") for (int i = 0; i < 4; i++) {                        \
    ar[i] = *(const u32x4*)(gab + (size_t)(ko)*2 + oa[i]);               \
    br[i] = *(const u32x4*)(gbb + (size_t)(ko)*2 + ob[i]);               \
  }
#define G_STORE(ar, br, buf)                                             \
  _Pragma("unroll") for (int i = 0; i < 4; i++) {                        \
    *(u32x4*)(wa + (buf)*SM_A + 32 * i * LSTR) = ar[i];                  \
    *(u32x4*)(wb + (buf)*SM_A + 32 * i * LSTR) = br[i];                  \
  }
#define G_COMPUTE(buf)                                                                   \
  _Pragma("unroll") for (int ks = 0; ks < 4; ks++) {                                     \
    const bf16x8 fa0 = *(const bf16x8*)(pa + (buf)*SM_A + ks * 16);                      \
    const bf16x8 fa1 = *(const bf16x8*)(pa + (buf)*SM_A + 32 * LSTR + ks * 16);          \
    const bf16x8 fb0 = *(const bf16x8*)(pb + (buf)*SM_A + ks * 16);                      \
    const bf16x8 fb1 = *(const bf16x8*)(pb + (buf)*SM_A + 32 * LSTR + ks * 16);          \
    acc[0][0] = __builtin_amdgcn_mfma_f32_32x32x16_bf16(fa0, fb0, acc[0][0], 0, 0, 0);   \
    acc[0][1] = __builtin_amdgcn_mfma_f32_32x32x16_bf16(fa0, fb1, acc[0][1], 0, 0, 0);   \
    acc[1][0] = __builtin_amdgcn_mfma_f32_32x32x16_bf16(fa1, fb0, acc[1][0], 0, 0, 0);   \
    acc[1][1] = __builtin_amdgcn_mfma_f32_32x32x16_bf16(fa1, fb1, acc[1][1], 0, 0, 0);   \
  }
  const int nk = K >> 6;
  if (DEEP) {
    G_LOAD(a0r, b0r, 0)
    G_LOAD(a1r, b1r, 64)
    G_STORE(a0r, b0r, 0)
    __syncthreads();
    const int klast = (nk - 1) * 64;
    G_LOAD(a0r, b0r, min(128, klast))
    for (int kt = 0; kt < nk; kt += 2) {
      G_COMPUTE(0)
      G_STORE(a1r, b1r, 1)
      __syncthreads();
      G_LOAD(a1r, b1r, min((kt + 3) * 64, klast))
      __builtin_amdgcn_sched_barrier(0);
      G_COMPUTE(1)
      G_STORE(a0r, b0r, 0)
      __syncthreads();
      G_LOAD(a0r, b0r, min((kt + 4) * 64, klast))
      __builtin_amdgcn_sched_barrier(0);
    }
  } else {
    G_LOAD(a0r, b0r, 0)
    G_STORE(a0r, b0r, 0)
    __syncthreads();
    for (int kt = 0; kt < nk; kt += 2) {
      G_LOAD(a0r, b0r, (kt + 1) * 64)
      G_COMPUTE(0)
      G_STORE(a0r, b0r, 1)
      __syncthreads();
      if (kt + 2 < nk) G_LOAD(a0r, b0r, (kt + 2) * 64)
      G_COMPUTE(1)
      if (kt + 2 < nk) G_STORE(a0r, b0r, 0)
      __syncthreads();
    }
  }
#undef G_LOAD
#undef G_STORE
#undef G_COMPUTE
}

__device__ __forceinline__ void zero_acc(f32x16 (&acc)[2][2]) {
#pragma unroll
  for (int i = 0; i < 2; i++)
#pragma unroll
    for (int j = 0; j < 2; j++)
#pragma unroll
      for (int e = 0; e < 16; e++) acc[i][j][e] = 0.f;
}

#define EPI_DECL                                                     \
  const int lane_ = ltid() & 63, wave_ = ltid() >> 6;      \
  const int wm_ = wave_ >> 1, wn_ = wave_ & 1, r_ = lane_ & 31, hh_ = lane_ >> 5; \
  (void)wm_; (void)wn_; (void)r_; (void)hh_;

__device__ __forceinline__ const float* src_col(const Params& p, int l, int kind, int n, int& ld) {
  switch (kind) {
    case 0:
      ld = IN_DIM;
      return n < 1952 ? p.w_in + (size_t)l * D * IN_DIM + 512 + n : nullptr;
    case 1:
      ld = IN_DIM;
      return p.w_in + (size_t)l * D * IN_DIM + 2464 + n;
    case 2:
      if (n < 512) {
        ld = 512;
        return p.w_uq + (size_t)l * 256 * 512 + n;
      } else {
        int m = n - 512, wt = m >> 6, jb = (m >> 5) & 1, idx = wt * 32 + (m & 31);
        int h = idx >> 4, e = idx & 15;
        ld = 256;
        return p.w_qr + (size_t)l * 256 * 256 + h * 32 + jb * 16 + e;
      }
    case 3:
      ld = 512;
      return n < 512 ? p.w_uk + (size_t)l * 128 * 512 + n : p.w_uv + (size_t)l * 128 * 512 + (n - 512);
    case 4: {
      int g = n >> 10, nn = n & 1023;
      ld = 1024;
      return p.w_branch + ((size_t)(l * 3 + g) * 512) * 1024 + nn;
    }
    case 5:
      ld = 1024;
      return p.w_out + (size_t)l * D * D + n;
    case 6: {
      int jb = (n >> 5) & 1, q = (n >> 6) * 32 + (n & 31);
      ld = FH;
      return (jb ? p.w_up : p.w_gate) + (size_t)l * D * FH + q;
    }
    default:
      ld = 1024;
      return p.w_down + (size_t)l * FH * D + n;
  }
}

__device__ __forceinline__ int job_nd(int k) {
  switch (k) { case 0: return 2048; case 1: return 3072; case 2: return 768; case 3: return 1024; case 4: return 3072;
    case 5: return 1024; case 6: return 5632; default: return 1024; }
}
__device__ __forceinline__ int job_kd(int k) {
  switch (k) { case 0: return 1024; case 1: return 1024; case 2: return 256; case 3: return 128; case 4: return 512;
    case 5: return 1024; case 6: return 1024; default: return 2816; }
}
__device__ __forceinline__ size_t job_od(int k) {
  switch (k) { case 0: return O_WP; case 1: return O_WG; case 2: return O_WUQ; case 3: return O_WUKV; case 4: return O_WB;
    case 5: return O_WO; case 6: return O_WGU; default: return O_WD; }
}
__device__ void prep_weights(const Params& p, int l, int bid, int nb, u16* smem) {
  float* tile = (float*)smem;
  const int tid = ltid();
  int start = 0;
#pragma unroll 1
  for (int kind = 0; kind < 8; kind++) {
    const int Kk = job_kd(kind);
    const int nkt = Kk >> 6, ntile = (job_nd(kind) >> 6) * nkt;
    u16* dst = wsp<u16>(p, job_od(kind));
    const float* ksc = kind == 2 ? p.gq + l * 256 : (kind == 3 ? p.gkv + l * 128 : nullptr);
    for (int t = (bid + nb - (start % nb)) % nb; t < ntile; t += nb) {
      const int nt = t / nkt, kt = t - nt * nkt;
      const int n0 = nt * 64, k0 = kt * 64;
      {
        const int kq = tid >> 4, nn4 = (tid & 15) * 4;
        int ld;
        const float* sp = src_col(p, l, kind, n0 + nn4, ld);
#pragma unroll
        for (int i = 0; i < 4; i++) {
          const int kk = i * 16 + kq;
          float4 v = make_float4(0.f, 0.f, 0.f, 0.f);
          if (sp) v = *(const float4*)(sp + (size_t)(k0 + kk) * ld);
          if (ksc) {
            const float sc = ksc[k0 + kk];
            v.x *= sc; v.y *= sc; v.z *= sc; v.w *= sc;
          }
          float* tp = tile + kk * 65 + nn4;
          tp[0] = v.x; tp[1] = v.y; tp[2] = v.z; tp[3] = v.w;
        }
      }
      __syncthreads();
#pragma unroll
      for (int i = 0; i < 2; i++) {
        const int c = tid + 256 * i;
        const int nn = c >> 3, kc = (c & 7) * 8;
        const float* tp = tile + kc * 65 + nn;
        uint4 o;
        o.x = pack2(tp[0], tp[65]);
        o.y = pack2(tp[2 * 65], tp[3 * 65]);
        o.z = pack2(tp[4 * 65], tp[5 * 65]);
        o.w = pack2(tp[6 * 65], tp[7 * 65]);
        *(uint4*)(dst + (size_t)(n0 + nn) * Kk + k0 + kc) = o;
      }
      __syncthreads();
    }
    start += ntile;
  }
  {
    float* ctab = (float*)smem;
    __syncthreads();
    if (tid < 128) ctab[tid] = cospif((float)tid * (1.f / 64.f));
    __syncthreads();
    u16* dst = wsp<u16>(p, O_WF);
    for (int it = bid; it < 512; it += nb) {
      const int o = it * 256 + tid;
      const int np = o & 1023, k8 = (o >> 10) * 8;
      const int reim = np >> 9, g = (np >> 7) & 3, m = np & 127;
      const float* w = p.w_in + (size_t)l * D * IN_DIM + (size_t)k8 * IN_DIM + g * 128;
      const int sh = reim ? 96 : 0;
      float a8[8];
#pragma unroll
      for (int j = 0; j < 8; j++) a8[j] = 0.f;
#pragma unroll 4
      for (int c = 0; c < 128; c++) {
        const float tw = ctab[(m * c + sh) & 127];
#pragma unroll
        for (int j = 0; j < 8; j++) a8[j] += w[(size_t)j * IN_DIM + c] * tw;
      }
      uint4 ov;
      ov.x = pack2(a8[0] * RS128, a8[1] * RS128);
      ov.y = pack2(a8[2] * RS128, a8[3] * RS128);
      ov.z = pack2(a8[4] * RS128, a8[5] * RS128);
      ov.w = pack2(a8[6] * RS128, a8[7] * RS128);
      *(uint4*)(dst + (size_t)np * 1024 + k8) = ov;
    }
    __syncthreads();
  }
}

__device__ __forceinline__ void rope_entry(int posi, int f, float& cs, float& sn);
__device__ void prep_tables(const Params& p, int bid, int nb) {
  u16* MA = wsp<u16>(p, O_MA);
  u16* MB = wsp<u16>(p, O_MB);
  u16* MC = wsp<u16>(p, O_MC);
  float* TW = wsp<float>(p, O_TW);
  const int total = 65536 + 32768 + 131072 + 16384;
  for (int idx = bid * 256 + ltid(); idx < 2048; idx += nb * 256) {
    float cs, sn;
    rope_entry(idx >> 3, idx & 7, cs, sn);
    wsp<float2>(p, O_ROPE)[idx] = make_float2(cs, sn);
  }
  for (int idx = bid * 256 + ltid(); idx < total; idx += nb * 256) {
    if (idx < 65536) {
      const int n = idx >> 8, k = idx & 255;
      const int nt = n >> 7, wn = (n >> 6) & 1, jb = (n >> 5) & 1, klo = nt * 64 + wn * 32 + (n & 31);
      const int ri = k >> 7, nhi = k & 127;
      const int xx = (klo * nhi) & 127;
      const float c = cospif((float)xx * (1.f / 64.f)), s = sinpif((float)xx * (1.f / 64.f));
      float v = jb == 0 ? (ri == 0 ? c : -s) : (ri == 0 ? -s : -c);
      MA[idx] = f2bf(v * RS128);
    } else if (idx < 65536 + 32768) {
      const int i2 = idx - 65536;
      const int khi = i2 >> 8, k = i2 & 255;
      const int ri = k >> 7, nlo = k & 127;
      const int xx = (khi * nlo) & 127;
      const float c = cospif((float)xx * (1.f / 64.f)), s = sinpif((float)xx * (1.f / 64.f));
      MB[i2] = f2bf((ri == 0 ? c : s) * RS128);
    } else if (idx < 65536 + 32768 + 131072) {
      const int i2 = idx - 65536 - 32768;
      const int kk = i2 >> 9, k = i2 & 511;
      const int ri = k >> 8, nn = k & 255;
      const int xx = (kk * nn) & 255;
      const float c = cospif((float)xx * (1.f / 128.f)), s = sinpif((float)xx * (1.f / 128.f));
      MC[i2] = f2bf((ri == 0 ? c : -s) * 0.0625f);
    } else {
      const int i2 = idx - 65536 - 32768 - 131072;
      const int klo = i2 >> 7, nlo = i2 & 127;
      const int xx = klo * nlo;
      TW[i2 * 2] = cospif((float)xx * (1.f / 8192.f));
      TW[i2 * 2 + 1] = sinpif((float)xx * (1.f / 8192.f));
    }
  }
}

__device__ void prep_modp(const Params& p, int bid, int nb) {
  float* modp = wsp<float>(p, O_MODP);
  for (int it = bid; it < 2 * 16 * 24; it += nb) {
    const int l = it / (16 * 24), rem = it - l * 16 * 24, kc = rem / 24, nblk = rem - kc * 24;
    const int n = nblk * 256 + ltid();
    const float* w = p.w_mod + (size_t)l * D * 6144 + n;
    float a0 = 0.f, a1 = 0.f, a2 = 0.f;
#pragma unroll 8
    for (int kk = 0; kk < 64; kk++) {
      const int k = kc * 64 + kk;
      const float wv = w[(size_t)k * 6144];
      float c0 = p.c[k], c1 = p.c[1024 + k], c2 = p.c_ctx[k];
      c0 = c0 / (1.f + __expf(-c0));
      c1 = c1 / (1.f + __expf(-c1));
      c2 = c2 / (1.f + __expf(-c2));
      a0 += c0 * wv;
      a1 += c1 * wv;
      a2 += c2 * wv;
    }
    float* o = modp + ((size_t)(kc * 2 + l) * 3) * 6144 + n;
    o[0] = a0;
    o[6144] = a1;
    o[2 * 6144] = a2;
  }
}
__device__ void prep_modr(const Params& p, int bid, int nb) {
  const float* modp = wsp<float>(p, O_MODP);
  float* mod = wsp<float>(p, O_MOD);
  for (int idx = bid * 256 + ltid(); idx < 2 * 3 * 6144; idx += nb * 256) {
    const int l = idx / (3 * 6144), n = idx % 6144;
    float v = p.b_mod[l * 6144 + n];
    for (int kc = 0; kc < 16; kc++) v += modp[(size_t)kc * 2 * 3 * 6144 + idx];
    mod[idx] = v;
  }
}

__device__ void ln_phase(const Params& p, int mode, const float* g, const float* bta, int lmod, int shoff, int scoff,
                         bool skip_ctx, int bid, int nb, int lres = 0, int goff = -1) {
  const int lane = ltid() & 63, wave = ltid() >> 6;
  u16* A = wsp<u16>(p, O_A);
  const float* mod = wsp<float>(p, O_MOD);
  float4 gg[4], bb[4], sh[4], sc[4], gt[4];
#pragma unroll
  for (int q = 0; q < 4; q++) gt[q] = make_float4(0.f, 0.f, 0.f, 0.f);
  int cur_mg = -1;
#pragma unroll
  for (int q = 0; q < 4; q++) {
    const int c0 = (q >> 1) * 512 + lane * 8 + (q & 1) * 4;
    gg[q] = *(const float4*)(g + c0);
    bb[q] = *(const float4*)(bta + c0);
    sh[q] = make_float4(0.f, 0.f, 0.f, 0.f);
    sc[q] = make_float4(0.f, 0.f, 0.f, 0.f);
  }
  int cur_m = -1;
  for (int row = bid * 4 + wave; row < T; row += nb * 4) {
    const int b = row / KPB, kk = row - b * KPB;
    if (skip_ctx && kk < CTXL) continue;
    float* xr = xrow(p, row);
    const float* src;
    if (mode == 0)
      src = kk < CTXL ? p.ctx + (size_t)(b * CTXL + kk) * D : p.x + (size_t)(b * SEQ + kk - CTXL) * D;
    else
      src = xr;
    float4 v[4];
    float s = 0.f;
    const int m = kk < CTXL ? 2 : b;
    if (goff >= 0 && m != cur_mg) {
      cur_mg = m;
#pragma unroll
      for (int q = 0; q < 4; q++)
        gt[q] = *(const float4*)(mod + ((size_t)lres * 3 + m) * 6144 + goff + (q >> 1) * 512 + lane * 8 + (q & 1) * 4);
    }
#pragma unroll
    for (int i = 0; i < 2; i++) {
      uint4 fv = make_uint4(0u, 0u, 0u, 0u);
      if (goff >= 0) fv = *(const uint4*)(wsp<u16>(p, O_FB) + (size_t)row * D + i * 512 + lane * 8);
      const uint32_t fw[4] = {fv.x, fv.y, fv.z, fv.w};
#pragma unroll
      for (int hq = 0; hq < 2; hq++) {
        const int q = i * 2 + hq;
        v[q] = *(const float4*)(src + i * 512 + lane * 8 + hq * 4);
        if (goff >= 0) {
          v[q].x = ALPHA * v[q].x + (1.f + gt[q].x) * __uint_as_float(fw[hq * 2] << 16);
          v[q].y = ALPHA * v[q].y + (1.f + gt[q].y) * __uint_as_float(fw[hq * 2] & 0xffff0000u);
          v[q].z = ALPHA * v[q].z + (1.f + gt[q].z) * __uint_as_float(fw[hq * 2 + 1] << 16);
          v[q].w = ALPHA * v[q].w + (1.f + gt[q].w) * __uint_as_float(fw[hq * 2 + 1] & 0xffff0000u);
        }
        s += v[q].x + v[q].y + v[q].z + v[q].w;
      }
    }
    if (lmod >= 0 && m != cur_m) {
      cur_m = m;
      const float* md = mod + ((size_t)lmod * 3 + m) * 6144;
#pragma unroll
      for (int q = 0; q < 4; q++) {
        const int c0 = (q >> 1) * 512 + lane * 8 + (q & 1) * 4;
        sh[q] = *(const float4*)(md + shoff + c0);
        sc[q] = *(const float4*)(md + scoff + c0);
      }
    }
    const float mu = wsum(s) * (1.f / 1024.f);
    float qs = 0.f;
#pragma unroll
    for (int q = 0; q < 4; q++) {
      v[q].x -= mu; v[q].y -= mu; v[q].z -= mu; v[q].w -= mu;
      qs += v[q].x * v[q].x + v[q].y * v[q].y + v[q].z * v[q].z + v[q].w * v[q].w;
    }
    const float rstd = rsqrtf(wsum(qs) * (1.f / 1024.f) + EPS);
#pragma unroll
    for (int i = 0; i < 2; i++) {
      uint4 o;
      uint32_t ow[4];
#pragma unroll
      for (int hq = 0; hq < 2; hq++) {
        const int q = i * 2 + hq;
        float4 y;
        y.x = v[q].x * rstd * gg[q].x + bb[q].x;
        y.y = v[q].y * rstd * gg[q].y + bb[q].y;
        y.z = v[q].z * rstd * gg[q].z + bb[q].z;
        y.w = v[q].w * rstd * gg[q].w + bb[q].w;
        *(float4*)(xr + i * 512 + lane * 8 + hq * 4) = y;
        ow[hq * 2] = pack2(y.x * (1.f + sc[q].x) + sh[q].x, y.y * (1.f + sc[q].y) + sh[q].y);
        ow[hq * 2 + 1] = pack2(y.z * (1.f + sc[q].z) + sh[q].z, y.w * (1.f + sc[q].w) + sh[q].w);
      }
      if (lmod >= 0) {
        o.x = ow[0]; o.y = ow[1]; o.z = ow[2]; o.w = ow[3];
        *(uint4*)(A + (size_t)row * D + i * 512 + lane * 8) = o;
      }
    }
  }
}

#define PATCH_LOOP_BEGIN(NR_, NC_, PR_, PC_)                                   \
  {                                                                            \
    const int x_ = bid & 7, w_ = bid >> 3, nbx_ = nb >> 3;                     \
    const int CG_ = ((NC_) + (PC_)-1) / (PC_);                                 \
    const int npatch_ = (((NR_) + (PR_)-1) / (PR_)) * CG_;                     \
    for (int u_ = w_;; u_ += nbx_) {                                           \
      const int g_ = (u_ >> 6) * 8 + x_;                                       \
      if (g_ >= npatch_) break;                                                \
      const int s_ = u_ & 63;                                                  \
      const int rg_ = g_ / CG_;                                                \
      const int prt = rg_ * (PR_) + s_ / (PC_);                                \
      const int pct = (g_ - rg_ * CG_) * (PC_) + s_ % (PC_);                   \
      if (prt >= (NR_) || pct >= (NC_)) continue;
#define PATCH_LOOP_END \
    }                  \
  }

__device__ void phase_p1(const Params& p, int l, bool last, int bid, int nb, u16* smem) {
  EPI_DECL
  const u16* A = wsp<u16>(p, O_A);
  PATCH_LOOP_BEGIN(NRT, 16, 8, 8)
    f32x16 acc[2][2];
    zero_acc(acc);
    {
      const int rt = prt, ct = pct;
      const int row0 = rt * 128, b = row0 / KPB, kk0 = row0 - b * KPB;
      if (ct < 8 || ct >= 12) {
        gemm_core(acc, wsp<u16>(p, O_WP) + (size_t)ct * 128 * D, D, A + (size_t)rt * 128 * D, D, D, smem);
        u16* dst;
        float sc = 1.f;
        int cb;
        if (ct < 4) { dst = wsp<u16>(p, O_QNA); sc = NA_SCALE_L2; cb = ct * 128; }
        else if (ct < 8) { dst = wsp<u16>(p, O_KNA); cb = (ct - 4) * 128; }
        else { dst = wsp<u16>(p, O_LAT); cb = (ct - 12) * 128; }
#pragma unroll
        for (int i = 0; i < 2; i++)
#pragma unroll
          for (int j = 0; j < 2; j++)
#pragma unroll
            for (int gp = 0; gp < 2; gp++) {
              const int row = row0 + wn_ * 64 + j * 32 + r_;
              const int col = cb + wm_ * 64 + i * 32 + 8 * (2 * gp + hh_);
              uint2 oa, ob;
              oa.x = pack2(acc[i][j][8 * gp] * sc, acc[i][j][8 * gp + 1] * sc);
              oa.y = pack2(acc[i][j][8 * gp + 2] * sc, acc[i][j][8 * gp + 3] * sc);
              ob.x = pack2(acc[i][j][8 * gp + 4] * sc, acc[i][j][8 * gp + 5] * sc);
              ob.y = pack2(acc[i][j][8 * gp + 6] * sc, acc[i][j][8 * gp + 7] * sc);
              *(uint4*)(dst + (size_t)row * 512 + col) = pair_swap(oa, ob);
            }
      } else {
        gemm_core(acc, A + (size_t)rt * 128 * D, D, wsp<u16>(p, O_WP) + (size_t)ct * 128 * D, D, D, smem);
        u16* dst = wsp<u16>(p, O_VNAT);
        const int cb = (ct - 8) * 128;
#pragma unroll
        for (int i = 0; i < 2; i++)
#pragma unroll
          for (int j = 0; j < 2; j++)
#pragma unroll
            for (int gp = 0; gp < 2; gp++) {
              const int kk = kk0 + wm_ * 64 + i * 32 + 8 * (2 * gp + hh_);
              const int col = cb + wn_ * 64 + j * 32 + r_;
              uint2 oa, ob;
              oa.x = pack2(acc[i][j][8 * gp], acc[i][j][8 * gp + 1]);
              oa.y = pack2(acc[i][j][8 * gp + 2], acc[i][j][8 * gp + 3]);
              ob.x = pack2(acc[i][j][8 * gp + 4], acc[i][j][8 * gp + 5]);
              ob.y = pack2(acc[i][j][8 * gp + 6], acc[i][j][8 * gp + 7]);
              *(uint4*)(dst + ((size_t)(b * 512 + col)) * KPB + kk) = make_uint4(oa.x, oa.y, ob.x, ob.y);
            }
      }
    }
  PATCH_LOOP_END
  PATCH_LOOP_BEGIN(256, 8, 8, 8)
    f32x16 acc[2][2];
    zero_acc(acc);
    {
      const int rt = prt, ct = pct;
      const int b = rt >> 7, nlo = rt & 127;
      gemm_core(acc, A + (size_t)(b * KPB + CTXL + nlo) * D, (size_t)128 * D,
                wsp<u16>(p, O_WF) + (size_t)ct * 128 * D, D, D, smem);
      u16* dst = wsp<u16>(p, O_D1);
#pragma unroll
      for (int i = 0; i < 2; i++)
#pragma unroll
        for (int j = 0; j < 2; j++)
#pragma unroll
          for (int gp = 0; gp < 2; gp++) {
            const int nhi = wm_ * 64 + i * 32 + 8 * (2 * gp + hh_);
            const int n = ct * 128 + wn_ * 64 + j * 32 + r_;
            const int reim = n >> 9, jj = n & 511;
            uint2 oa, ob;
            oa.x = pack2(acc[i][j][8 * gp], acc[i][j][8 * gp + 1]);
            oa.y = pack2(acc[i][j][8 * gp + 2], acc[i][j][8 * gp + 3]);
            ob.x = pack2(acc[i][j][8 * gp + 4], acc[i][j][8 * gp + 5]);
            ob.y = pack2(acc[i][j][8 * gp + 6], acc[i][j][8 * gp + 7]);
            *(uint4*)(dst + ((((size_t)(b * 512 + jj)) * 128 + nlo) * 2 + reim) * 128 + nhi) = pair_swap(oa, ob);
          }
    }
  PATCH_LOOP_END
  if (!last) {
    for (int t2 = bid; t2 < 32; t2 += nb) {
      f32x16 acc[2][2];
      zero_acc(acc);
      const int rt = t2 >> 3, ct = t2 & 7;
      const int b = rt >> 1, rb = rt & 1;
      gemm_core(acc, A + (size_t)(b * KPB + rb * 128) * D, D, wsp<u16>(p, O_WF) + (size_t)ct * 128 * D, D, D, smem);
      u16* dst = wsp<u16>(p, O_D1C);
#pragma unroll
      for (int i = 0; i < 2; i++)
#pragma unroll
        for (int j = 0; j < 2; j++)
#pragma unroll
          for (int gp = 0; gp < 2; gp++) {
            const int nc = rb * 128 + wm_ * 64 + i * 32 + 8 * (2 * gp + hh_);
            const int n = ct * 128 + wn_ * 64 + j * 32 + r_;
            const int reim = n >> 9, jj = n & 511;
            uint2 oa, ob;
            oa.x = pack2(acc[i][j][8 * gp], acc[i][j][8 * gp + 1]);
            oa.y = pack2(acc[i][j][8 * gp + 2], acc[i][j][8 * gp + 3]);
            ob.x = pack2(acc[i][j][8 * gp + 4], acc[i][j][8 * gp + 5]);
            ob.y = pack2(acc[i][j][8 * gp + 6], acc[i][j][8 * gp + 7]);
            *(uint4*)(dst + (((size_t)(b * 512 + jj)) * 2 + reim) * 256 + nc) = pair_swap(oa, ob);
          }
    }
  }
}

__device__ __forceinline__ float inv_freq(int i) {
  switch (i) {
    case 0: return 1.0f;
    case 1: return 0.31622776601683794f;
    case 2: return 0.1f;
    case 3: return 0.03162277660168379f;
    case 4: return 0.01f;
    case 5: return 0.0031622776601683794f;
    case 6: return 0.001f;
    default: return 0.00031622776601683794f;
  }
}
__device__ __forceinline__ void rope_entry(int posi, int f, float& cs, float& sn) {
  const float ang = (float)posi * inv_freq(f);
  double xr = (double)ang * 0.31830988618379067;
  xr -= 2.0 * floor(xr * 0.5);
  const float yr = (float)xr;
  cs = cospif(yr);
  sn = sinpif(yr);
}
__device__ __forceinline__ void rope_cs(const float2* __restrict__ rtab, int kk, int e, float& cs, float& sn) {
  if (kk < CTXL) { cs = 1.f; sn = 0.f; return; }
  const int tkn = kk - CTXL;
  const int posi = (e < 8) ? (tkn >> 6) : (tkn & 63);
  const float2 v = rtab[posi * 8 + (e & 7)];
  cs = v.x;
  sn = v.y;
}

__device__ __forceinline__ void row_rms(const u16* A, size_t lda, int K, float* rs) {
  const int tid = ltid();
  const int row = tid >> 1, half = tid & 1;
  const u16* pr = A + (size_t)row * lda + half * (K >> 1);
  float s = 0.f;
  for (int c = 0; c < (K >> 1); c += 8) {
    uint4 v = *(const uint4*)(pr + c);
    const uint32_t w[4] = {v.x, v.y, v.z, v.w};
#pragma unroll
    for (int q = 0; q < 4; q++) {
      const float a = __uint_as_float(w[q] << 16), bq = __uint_as_float(w[q] & 0xffff0000u);
      s += a * a + bq * bq;
    }
  }
  s += __shfl_xor(s, 1);
  if (half == 0) rs[row] = rsqrtf(s / (float)K + EPS);
  __syncthreads();
}

__device__ void phase_p2(const Params& p, int l, int bid, int nb, u16* smem) {
  EPI_DECL
  const u16* LAT = wsp<u16>(p, O_LAT);
  float* rs = (float*)(smem + 4 * SM_A);
  const int nQ = NRT * 6, nKV = NRT * 8, nFA = 1024 * 2, nKR = NRT;
  const int total = nQ + nKV + nFA + nKR;
  for (int t = bid; t < total; t += nb) {
    if (t < nQ) {
      const int rt = t / 6, ct = t - rt * 6;
      const int row0 = rt * 128, b = row0 / KPB, kk0 = row0 - b * KPB;
      row_rms(LAT + (size_t)row0 * 512, 512, 256, rs);
      f32x16 acc[2][2];
      zero_acc(acc);
      gemm_core(acc, wsp<u16>(p, O_WUQ) + (size_t)ct * 128 * 256, 256, LAT + (size_t)row0 * 512, 512, 256, smem);
      u16* QM = wsp<u16>(p, O_QM);
      if (ct < 4) {
#pragma unroll
        for (int i = 0; i < 2; i++)
#pragma unroll
          for (int j = 0; j < 2; j++)
#pragma unroll
            for (int gp = 0; gp < 2; gp++) {
              const int rl = wn_ * 64 + j * 32 + r_;
              const int col = ct * 128 + wm_ * 64 + i * 32 + 8 * (2 * gp + hh_);
              const int h = col >> 6, d = col & 63;
              const float sc = rs[rl] * MLA_SCALE_L2;
              uint2 oa, ob;
              oa.x = pack2(acc[i][j][8 * gp] * sc, acc[i][j][8 * gp + 1] * sc);
              oa.y = pack2(acc[i][j][8 * gp + 2] * sc, acc[i][j][8 * gp + 3] * sc);
              ob.x = pack2(acc[i][j][8 * gp + 4] * sc, acc[i][j][8 * gp + 5] * sc);
              ob.y = pack2(acc[i][j][8 * gp + 6] * sc, acc[i][j][8 * gp + 7] * sc);
              *(uint4*)(QM + (size_t)(row0 + rl) * 768 + h * 96 + d) = pair_swap(oa, ob);
            }
      } else {
        const int wt = (ct - 4) * 2 + wm_;
#pragma unroll
        for (int j = 0; j < 2; j++) {
          const int rl = wn_ * 64 + j * 32 + r_;
          const float sc = rs[rl] * MLA_SCALE_L2;
          uint2 p1[4], p2[4];
#pragma unroll
          for (int g = 0; g < 4; g++) {
            const int idx = wt * 32 + 8 * g + 4 * hh_;
            const int e16 = idx & 15;
            float o1[4], o2[4];
#pragma unroll
            for (int q = 0; q < 4; q++) {
              float cs, sn;
              rope_cs(wsp<float2>(p, O_ROPE), kk0 + rl, e16 + q, cs, sn);
              const float x1 = acc[0][j][4 * g + q] * sc, x2 = acc[1][j][4 * g + q] * sc;
              o1[q] = x1 * cs - x2 * sn;
              o2[q] = x2 * cs + x1 * sn;
            }
            p1[g].x = pack2(o1[0], o1[1]);
            p1[g].y = pack2(o1[2], o1[3]);
            p2[g].x = pack2(o2[0], o2[1]);
            p2[g].y = pack2(o2[2], o2[3]);
          }
#pragma unroll
          for (int gp = 0; gp < 2; gp++) {
            u16* qd = QM + (size_t)(row0 + rl) * 768 + (2 * wt + gp) * 96 + 64 + 8 * hh_;
            *(uint4*)qd = pair_swap(p1[2 * gp], p1[2 * gp + 1]);
            *(uint4*)(qd + 16) = pair_swap(p2[2 * gp], p2[2 * gp + 1]);
          }
        }
      }
      __syncthreads();
    } else if (t < nQ + nKV) {
      const int t2 = t - nQ;
      const int rt = t2 >> 3, ct = t2 & 7;
      const int row0 = rt * 128, b = row0 / KPB, kk0 = row0 - b * KPB;
      row_rms(LAT + (size_t)row0 * 512 + 256, 512, 128, rs);
      f32x16 acc[2][2];
      zero_acc(acc);
      if (ct < 4) {
        gemm_core(acc, wsp<u16>(p, O_WUKV) + (size_t)ct * 128 * 128, 128, LAT + (size_t)row0 * 512 + 256, 512, 128,
                  smem);
        u16* KN = wsp<u16>(p, O_KN);
#pragma unroll
        for (int i = 0; i < 2; i++)
#pragma unroll
          for (int j = 0; j < 2; j++)
#pragma unroll
            for (int gp = 0; gp < 2; gp++) {
              const int rl = wn_ * 64 + j * 32 + r_;
              const int col = ct * 128 + wm_ * 64 + i * 32 + 8 * (2 * gp + hh_);
              const float sc = rs[rl];
              uint2 oa, ob;
              oa.x = pack2(acc[i][j][8 * gp] * sc, acc[i][j][8 * gp + 1] * sc);
              oa.y = pack2(acc[i][j][8 * gp + 2] * sc, acc[i][j][8 * gp + 3] * sc);
              ob.x = pack2(acc[i][j][8 * gp + 4] * sc, acc[i][j][8 * gp + 5] * sc);
              ob.y = pack2(acc[i][j][8 * gp + 6] * sc, acc[i][j][8 * gp + 7] * sc);
              *(uint4*)(KN + (size_t)(row0 + rl) * 512 + col) = pair_swap(oa, ob);
            }
      } else {
        gemm_core(acc, LAT + (size_t)row0 * 512 + 256, 512, wsp<u16>(p, O_WUKV) + (size_t)ct * 128 * 128, 128, 128,
                  smem);
        u16* VMT = wsp<u16>(p, O_VMT);
#pragma unroll
        for (int i = 0; i < 2; i++)
#pragma unroll
          for (int j = 0; j < 2; j++)
#pragma unroll
            for (int gp = 0; gp < 2; gp++) {
              const int ra = wm_ * 64 + i * 32 + 16 * gp + 4 * hh_;
              const int rb2 = ra + 8;
              const int rst = wm_ * 64 + i * 32 + 8 * (2 * gp + hh_);
              const int col = (ct - 4) * 128 + wn_ * 64 + j * 32 + r_;
              uint2 oa, ob;
              oa.x = pack2(acc[i][j][8 * gp] * rs[ra], acc[i][j][8 * gp + 1] * rs[ra + 1]);
              oa.y = pack2(acc[i][j][8 * gp + 2] * rs[ra + 2], acc[i][j][8 * gp + 3] * rs[ra + 3]);
              ob.x = pack2(acc[i][j][8 * gp + 4] * rs[rb2], acc[i][j][8 * gp + 5] * rs[rb2 + 1]);
              ob.y = pack2(acc[i][j][8 * gp + 6] * rs[rb2 + 2], acc[i][j][8 * gp + 7] * rs[rb2 + 3]);
              *(uint4*)(VMT + ((size_t)(b * 512 + col)) * KPB + kk0 + rst) = make_uint4(oa.x, oa.y, ob.x, ob.y);
            }
      }
      __syncthreads();
    } else if (t < nQ + nKV + nFA) {
      const int t2 = t - nQ - nKV;
      const int rt = t2 >> 1, ct = t2 & 1;
      const int b = rt >> 9, jj = rt & 511;
      f32x16 acc[2][2];
      zero_acc(acc);
      gemm_core(acc, wsp<u16>(p, O_D1) + (size_t)rt * 128 * 256, 256, wsp<u16>(p, O_MA) + (size_t)ct * 128 * 256, 256,
                256, smem);
      const float* TW = wsp<float>(p, O_TW);
      u16* D2 = wsp<u16>(p, O_D2);
      const int klo = ct * 64 + wn_ * 32 + r_;
      const float2* twp = (const float2*)TW + klo;
#pragma unroll
      for (int i = 0; i < 2; i++)
      {
        uint2 pr[4], pi[4];
#pragma unroll
        for (int g = 0; g < 4; g++) {
          const int nlo = wm_ * 64 + i * 32 + 8 * g + 4 * hh_;
          float re[4], im[4];
#pragma unroll
          for (int q = 0; q < 4; q++) {
            const float2 tw = twp[(nlo + q) * 128];
            const float ar = acc[i][0][4 * g + q], ai = acc[i][1][4 * g + q];
            re[q] = ar * tw.x + ai * tw.y;
            im[q] = ai * tw.x - ar * tw.y;
          }
          pr[g].x = pack2(re[0], re[1]);
          pr[g].y = pack2(re[2], re[3]);
          pi[g].x = pack2(im[0], im[1]);
          pi[g].y = pack2(im[2], im[3]);
        }
#pragma unroll
        for (int gp = 0; gp < 2; gp++) {
          u16* d = D2 + ((((size_t)(b * 128 + klo)) * 512 + jj) * 2) * 128 + wm_ * 64 + i * 32 + 8 * (2 * gp + hh_);
          *(uint4*)d = pair_swap(pr[2 * gp], pr[2 * gp + 1]);
          *(uint4*)(d + 128) = pair_swap(pi[2 * gp], pi[2 * gp + 1]);
        }
      }
    } else {
      const int rt = t - nQ - nKV - nFA;
      u16* KRR = wsp<u16>(p, O_KRR);
      for (int idx = ltid(); idx < 128 * 16; idx += 256) {
        const int rl = idx >> 4, e16 = idx & 15;
        const int row = rt * 128 + rl, b = row / KPB, kk = row - b * KPB;
        const float x1 = bf2f(LAT[(size_t)row * 512 + 384 + e16]), x2 = bf2f(LAT[(size_t)row * 512 + 400 + e16]);
        float cs, sn;
        rope_cs(wsp<float2>(p, O_ROPE), kk, e16, cs, sn);
        KRR[(size_t)row * 32 + e16] = f2bf(x1 * cs - x2 * sn);
        KRR[(size_t)row * 32 + 16 + e16] = f2bf(x2 * cs + x1 * sn);
      }
    }
  }
}

template <int MODE>
__device__ void attn_item(const Params& p, int l, int b, int h, int q0  ,
                          int ntiles  , int rs0, int ycol, u16* smem) {
  constexpr int DQK = MODE == 0 ? 96 : 64;
  constexpr int KSTR = DQK + 8;
  constexpr int NKS = DQK / 16;
  constexpr int CPR = DQK / 8;
  constexpr int NKC = 64 * CPR / 256;
  const int tid = ltid(), lane = tid & 63, wave = tid >> 6, r = lane & 31, hh = lane >> 5;
  u16* Ks = smem;
  u16* Vs = smem + 2 * 64 * KSTR;
  const unsigned char* wsb = p.ws;
  const int qk = q0 + wave * 32 + r;
  const size_t qrow = (size_t)b * KPB + qk;
  bf16x8 qf[NKS];
  {
    const u16* qp = MODE == 0 ? wsp<u16>(p, O_QM) + qrow * 768 + h * 96 : wsp<u16>(p, O_QNA) + qrow * 512 + h * 64;
#pragma unroll
    for (int ks = 0; ks < NKS; ks++) qf[ks] = *(const bf16x8*)(qp + ks * 16 + hh * 8);
  }
  const short one_or_zero = hh == 0 ? (short)0x3F80 : (short)0;
  const bf16x8 kone = {one_or_zero, 0, 0, 0, 0, 0, 0, 0};
  bf16x8 qm = {0, 0, 0, 0, 0, 0, 0, 0};
  int qr = 0, qc = 0, rsq = 0, cs = 0;
  const float* rpb = nullptr;
  if (MODE == 1 && rs0 >= 0) {
    const int tkn = qk - CTXL;
    qr = tkn >> 6;
    qc = tkn & 63;
    rsq = min(max(qr - 4, 0), 248);
    cs = min(max(qc - 8, 0), 48);
    rpb = p.rpb + ((size_t)(l * 8 + h)) * 15 * 31;
  }
  f32x16 o[2];
#pragma unroll
  for (int e = 0; e < 16; e++) { o[0][e] = 0.f; o[1][e] = 0.f; }
  float lsum = 0.f;
  float m = 0.f;
  const bf16x8 ones = {(short)0x3F80, (short)0x3F80, (short)0x3F80, (short)0x3F80,
                       (short)0x3F80, (short)0x3F80, (short)0x3F80, (short)0x3F80};

#define KGEO(i)                                                                                          \
  uint32_t kof##i, kmu##i;                                                                               \
  int kls##i;                                                                                            \
  {                                                                                                      \
    const int c = tid + 256 * (i);                                                                       \
    const int row = c / CPR, cc = c - row * CPR;                                                         \
    if (MODE == 0 && cc >= 8) {                                                                          \
      kof##i = (uint32_t)(O_KRR + ((size_t)(b * KPB + row) * 32 + (cc - 8) * 8) * 2);                    \
      kmu##i = 64u;                                                                                      \
    } else {                                                                                             \
      kof##i = (uint32_t)((MODE == 0 ? O_KN : O_KNA) + ((size_t)(b * KPB + row) * 512 + h * 64 + cc * 8) * 2); \
      kmu##i = 1024u;                                                                                    \
    }                                                                                                    \
    kls##i = row * KSTR + cc * 8;                                                                        \
  }
#define VGEO(i)                                                                                          \
  uint32_t vof##i;                                                                                       \
  int vls##i;                                                                                            \
  bool vsx##i;                                                                                           \
  {                                                                                                      \
    const int c = tid + 256 * (i);                                                                       \
    const int d = c >> 3, cc = c & 7;                                                                    \
    vof##i = (uint32_t)((MODE == 0 ? O_VMT : O_VNAT) + ((size_t)(b * 512 + h * 64 + d) * KPB + cc * 8) * 2); \
    vls##i = d * 72 + cc * 8;                                                                            \
    vsx##i = (d & 8) != 0;                                                                               \
  }
  KGEO(0) KGEO(1) KGEO(2) VGEO(0) VGEO(1)
  (void)kof2; (void)kmu2; (void)kls2;
  u32x4 kr0A, kr1A, kr2A, vr0A, vr1A, kr0B, kr1B, kr2B, vr0B, vr1B;
  kr2A = kr1A = kr0A = vr0A = vr1A = kr2B = kr1B = kr0B = vr0B = vr1B = (u32x4){0u, 0u, 0u, 0u};
#define TILE_KK0(t) ((MODE == 1 && (t) >= 4) ? (uint32_t)(CTXL + 64 * min(rs0 + (t)-4, 255)) : (uint32_t)(64 * (t)))
#define LOAD_KV(t, S)                                                                   \
  {                                                                                     \
    const uint32_t kk0_ = TILE_KK0(t);                                                  \
    kr0##S = *(const u32x4*)(wsb + (size_t)(kof0 + kk0_ * kmu0));                       \
    kr1##S = *(const u32x4*)(wsb + (size_t)(kof1 + kk0_ * kmu1));                       \
    if (NKC == 3) kr2##S = *(const u32x4*)(wsb + (size_t)(kof2 + kk0_ * kmu2));         \
    vr0##S = *(const u32x4*)(wsb + (size_t)(vof0 + kk0_ * 2u));                         \
    vr1##S = *(const u32x4*)(wsb + (size_t)(vof1 + kk0_ * 2u));                         \
  }
#define STORE_V1(buf, i, srcv)                                                          \
  {                                                                                     \
    *(u32x4*)(Vs + (buf)*64 * 72 + vls##i) = srcv;                                      \
  }
#define STORE_KV(buf, S)                                                                \
  {                                                                                     \
    *(u32x4*)(Ks + (buf)*64 * KSTR + kls0) = kr0##S;                                    \
    *(u32x4*)(Ks + (buf)*64 * KSTR + kls1) = kr1##S;                                    \
    if (NKC == 3) *(u32x4*)(Ks + (buf)*64 * KSTR + kls2) = kr2##S;                      \
    STORE_V1(buf, 0, vr0##S) STORE_V1(buf, 1, vr1##S)                                   \
  }
#define QK_TILE(kbuf, t)                                                                           \
  {                                                                                                \
    const u16* kb_ = Ks + (kbuf)*64 * KSTR + r * KSTR + hh * 8;                                    \
    {                                                                                              \
      f32x16 z_;                                                                                   \
      _Pragma("unroll") for (int e = 0; e < 16; e++) z_[e] = 0.f;                                  \
      f32x16 s0_ = __builtin_amdgcn_mfma_f32_32x32x16_bf16(kone, qm, z_, 0, 0, 0);                 \
      asm volatile("" : "+v"(s0_));              \
      sc[0] = s0_;                                                                                 \
      sc[1] = s0_;                                                                                 \
    }                                                                                              \
    _Pragma("unroll") for (int ks = 0; ks < NKS; ks++) {                                           \
      const bf16x8 kf0 = *(const bf16x8*)(kb_ + ks * 16);                                          \
      const bf16x8 kf1 = *(const bf16x8*)(kb_ + 32 * KSTR + ks * 16);                              \
      sc[0] = __builtin_amdgcn_mfma_f32_32x32x16_bf16(kf0, qf[ks], sc[0], 0, 0, 0);                \
      sc[1] = __builtin_amdgcn_mfma_f32_32x32x16_bf16(kf1, qf[ks], sc[1], 0, 0, 0);                \
    }                                                                                              \
    if (MODE == 1 && (t) >= 4) {                                                                   \
      const int kr_ = rs0 + (t)-4;                                                                 \
      const bool rowok = (kr_ >= rsq) && (kr_ < rsq + 8);                                          \
      const float* rp = rpb + (kr_ - qr + 7) * 31 + (15 - qc);                                     \
      _Pragma("unroll") for (int kb = 0; kb < 2; kb++) _Pragma("unroll") for (int e = 0; e < 16; e++) { \
        const int kc = kb * 32 + (e & 3) + 8 * (e >> 2) + 4 * hh;                                  \
        const bool valid = rowok && (kc >= cs) && (kc < cs + 16);                                  \
        float bias = 0.f;                                                                          \
        if (valid) bias = rp[kc];                                                                  \
        sc[kb][e] = valid ? sc[kb][e] + bias * LOG2E : -1e30f;                                     \
      }                                                                                            \
    }                                                                                              \
  }
#define TILE_MAX(tmax)                                                                             \
  {                                                                                                \
    tmax = sc[0][0];                                                                               \
    _Pragma("unroll") for (int e = 1; e < 16; e++) tmax = fmaxf(tmax, sc[0][e]);                   \
    _Pragma("unroll") for (int e = 0; e < 16; e++) tmax = fmaxf(tmax, sc[1][e]);                   \
    const uint32_t tu = __float_as_uint(tmax);                                                     \
    const auto sw = __builtin_amdgcn_permlane32_swap(tu, tu, false, false);                        \
    tmax = fmaxf(__uint_as_float(sw[0]), __uint_as_float(sw[1]));                                  \
  }
#define MOVE_REF(mnew_)                                                                            \
  {                                                                                                \
    const float mq_ = bf2f(f2bf(mnew_));                                                           \
    const float delta_ = mq_ - m;                                                                  \
    const float alpha = __builtin_amdgcn_exp2f(-delta_);                                           \
    m = mq_;                                                                                       \
    _Pragma("unroll") for (int e = 0; e < 16; e++) {                                               \
      o[0][e] *= alpha; o[1][e] *= alpha;                                                         \
      sc[0][e] -= delta_; sc[1][e] -= delta_;                                                      \
    }                                                                                              \
    lsum *= alpha;                                                                                 \
    qm[0] = (hh == 0) ? (short)f2bf(-m) : (short)0;                                                \
  }
#define SOFTMAX_PV(vbuf)                                                                           \
  {                                                                                                \
    const u16* vb_ = Vs + (vbuf)*64 * 72 + r * 72 + 8 * hh;                                        \
    _Pragma("unroll") for (int kb = 0; kb < 2; kb++) _Pragma("unroll") for (int st = 0; st < 2; st++) { \
      u32x4 pu;                                                                                    \
      _Pragma("unroll") for (int q = 0; q < 4; q++) {                                              \
        const float p0_ = __builtin_amdgcn_exp2f(sc[kb][8 * st + 2 * q]);                          \
        const float p1_ = __builtin_amdgcn_exp2f(sc[kb][8 * st + 2 * q + 1]);                      \
        lsum += p0_ + p1_;                                                                         \
        pu[q] = pack2(p0_, p1_);                                                                   \
      }                                                                                            \
      const bf16x8 pbv = __builtin_bit_cast(bf16x8, pu);                                           \
      _Pragma("unroll") for (int db = 0; db < 2; db++) {                                           \
        const u16* vp = vb_ + db * 32 * 72 + kb * 32 + 16 * st;                                    \
        const bf16x8 vfv = *(const bf16x8*)(vp);     \
        o[db] = __builtin_amdgcn_mfma_f32_32x32x16_bf16(vfv, pbv, o[db], 0, 0, 0);                 \
      }                                                                                            \
    }                                                                                              \
  }
#define DEFER_REF(tmax)                                                                            \
  if (__any(tmax > 8.f)) {                                                                         \
    const float mq_ = bf2f(f2bf(m + fmaxf(tmax, 0.f)));                                            \
    const float alpha = __builtin_amdgcn_exp2f(m - mq_);                                           \
    m = mq_;                                                                                       \
    _Pragma("unroll") for (int e = 0; e < 16; e++) { o[0][e] *= alpha; o[1][e] *= alpha; }       \
    lsum *= alpha;                                                                                 \
    qm[0] = (hh == 0) ? (short)f2bf(-m) : (short)0;                                                \
  }
#define ATT_STEP(t, LD, ST)                                        \
  {                                                                \
    const int cur = (t)&1;                                         \
    QK_TILE(cur, t)                                                \
    __builtin_amdgcn_sched_barrier(0);                             \
    LOAD_KV(min((t) + 2, tl), LD)                                  \
    __builtin_amdgcn_sched_barrier(0);                             \
    __builtin_amdgcn_s_setprio(1);                                 \
    SOFTMAX_PV(cur)                                                \
    __builtin_amdgcn_s_setprio(0);                                 \
      \
                               \
    if ((((t) & 3) == 1)) {                                        \
      float tmax;                                                  \
      TILE_MAX(tmax)                                               \
      DEFER_REF(tmax)                                              \
    }                                                              \
    STORE_KV(cur ^ 1, ST)                                          \
    __syncthreads();                                               \
  }

  const int tl = ntiles - 1;
  f32x16 sc[2];
  LOAD_KV(0, A)
  STORE_KV(0, A)
  LOAD_KV(min(1, tl), A)
  __syncthreads();
  {
    LOAD_KV(min(2, tl), B)
    __builtin_amdgcn_sched_barrier(0);
    QK_TILE(0, 0)
    float tmax;
    TILE_MAX(tmax)
    MOVE_REF(tmax)
    SOFTMAX_PV(0)
    STORE_KV(1, A)
    __syncthreads();
  }
  for (int t = 1; t + 1 < ntiles; t += 2) {
    ATT_STEP(t, A, B)
    ATT_STEP(t + 1, B, A)
  }
  ATT_STEP(tl, A, B)
  const float inv = 1.f / (lsum + __shfl_xor(lsum, 32));
  u16* yp = wsp<u16>(p, O_Y) + qrow * 1536 + ycol + h * 64;
#pragma unroll
  for (int db = 0; db < 2; db++)
#pragma unroll
    for (int gp = 0; gp < 2; gp++) {
      uint2 oa, ob;
      oa.x = pack2(o[db][8 * gp] * inv, o[db][8 * gp + 1] * inv);
      oa.y = pack2(o[db][8 * gp + 2] * inv, o[db][8 * gp + 3] * inv);
      ob.x = pack2(o[db][8 * gp + 4] * inv, o[db][8 * gp + 5] * inv);
      ob.y = pack2(o[db][8 * gp + 6] * inv, o[db][8 * gp + 7] * inv);
      *(uint4*)(yp + db * 32 + 8 * (2 * gp + hh)) = pair_swap(oa, ob);
    }
#undef KGEO
#undef VGEO
#undef TILE_KK0
#undef LOAD_KV
#undef STORE_V1
#undef STORE_KV
#undef QK_TILE
#undef TILE_MAX
#undef MOVE_REF
#undef SOFTMAX_PV
#undef ATT_STEP
#undef DEFER_REF
}

__device__ void phase_p3(const Params& p, int l, bool last, int bid, int nb, u16* smem) {
  EPI_DECL
  const int nMLA = 2048, nNA = 2048, nFB = 1024;
  const int nC = last ? 0 : (32 + 32 + 16);
  const int total = nMLA + nNA + nFB + nC;
  for (int t = bid; t < total; t += nb) {
    int kind, b = 0, h = 0, q0 = 0, ntl = 0, rs0 = -1;
    size_t aoff = 0, boff = 0;
    int Kf = 256, j0 = 0, tok0 = 0, tokmul = 1, colbase = 0;
    if (t < nMLA) {
      kind = 0;
      h = t & 7;
      const int rest = t >> 3;
      b = rest >> 7;
      q0 = CTXL + (rest & 127) * 128;
      ntl = 260;
    } else if (t < nMLA + nNA) {
      kind = 1;
      const int t2 = t - nMLA;
      h = t2 & 7;
      const int rest = t2 >> 3, rp = rest & 127;
      b = rest >> 7;
      rs0 = min(max(2 * rp - 4, 0), 248);
      const int rs1 = min(max(2 * rp + 1 - 4, 0), 248);
      q0 = CTXL + rp * 128;
      ntl = (4 + (rs1 + 8 - rs0) + 1) & ~1;
    } else if (t < nMLA + nNA + nFB) {
      kind = 2;
      const int rt = t - nMLA - nNA;
      const int bk = rt >> 2;
      j0 = (rt & 3) * 128;
      b = bk >> 7;
      tok0 = CTXL + (bk & 127);
      tokmul = 128;
      aoff = O_D2 + (size_t)rt * 128 * 256 * 2;
      boff = O_MB;
      Kf = 256;
    } else {
      const int t2 = t - nMLA - nNA - nFB;
      if (t2 < 64) {
        kind = t2 >> 5;
        const int t3 = t2 & 31;
        h = t3 & 7;
        b = (t3 >> 3) & 1;
        q0 = (t3 >> 4) * 128;
        ntl = 4;
      } else {
        kind = 2;
        const int t3 = t2 - 64;
        const int rt = t3 >> 1, ct = t3 & 1;
        b = rt >> 2;
        j0 = (rt & 3) * 128;
        colbase = ct * 128;
        aoff = O_D1C + (size_t)rt * 128 * 512 * 2;
        boff = O_MC + (size_t)ct * 128 * 512 * 2;
        Kf = 512;
      }
    }
    if (kind == 0) {
      attn_item<0>(p, l, b, h, q0, ntl, -1, 1024, smem);
    } else if (kind == 1) {
      attn_item<1>(p, l, b, h, q0, ntl, rs0, 512, smem);
    } else {
      f32x16 acc[2][2];
      zero_acc(acc);
      gemm_core(acc, wsp<u16>(p, aoff), Kf, wsp<u16>(p, boff), Kf, Kf, smem);
      u16* Y = wsp<u16>(p, O_Y);
#pragma unroll
      for (int i = 0; i < 2; i++)
#pragma unroll
        for (int j = 0; j < 2; j++)
#pragma unroll
          for (int gp = 0; gp < 2; gp++) {
            const int jj = j0 + wm_ * 64 + i * 32 + 8 * (2 * gp + hh_);
            const int tok = tok0 + (colbase + wn_ * 64 + j * 32 + r_) * tokmul;
            uint2 oa, ob;
            oa.x = pack2(acc[i][j][8 * gp], acc[i][j][8 * gp + 1]);
            oa.y = pack2(acc[i][j][8 * gp + 2], acc[i][j][8 * gp + 3]);
            ob.x = pack2(acc[i][j][8 * gp + 4], acc[i][j][8 * gp + 5]);
            ob.y = pack2(acc[i][j][8 * gp + 6], acc[i][j][8 * gp + 7]);
            *(uint4*)(Y + ((size_t)b * KPB + tok) * 1536 + jj) = pair_swap(oa, ob);
          }
    }
  }
}

__device__ __forceinline__ int n_row_tiles(bool last) { return last ? NRT - 4 : NRT; }
__device__ __forceinline__ int row_tile(bool last, int i) {
  if (!last) return i;
  return i < 128 ? i + 2 : i + 4;
}

__device__ void phase_p4(const Params& p, int l, bool last, int bid, int nb, u16* smem) {
  EPI_DECL
  const u16* A = wsp<u16>(p, O_A);
  const u16* Y = wsp<u16>(p, O_Y);
  u16* M = wsp<u16>(p, O_M);
  uint4* stash = wsp<uint4>(p, O_QM) + (size_t)bid * 24 * 256 + ltid();
  const int nrt_ = n_row_tiles(last);
  PATCH_LOOP_BEGIN(nrt_, 8, 8, 8)
    const int rt = row_tile(last, prt), ct = pct;
    f32x16 mg[2][2];
    zero_acc(mg);
#pragma unroll 1
    for (int g = 0; g < 3; g++) {
      uint32_t gp[2][2][8];
      {
        f32x16 acc[2][2];
        zero_acc(acc);
        gemm_core<true>(acc, wsp<u16>(p, O_WG) + (size_t)(g * 1024 + ct * 128) * D, D, A + (size_t)rt * 128 * D, D, D,
                        smem);
#pragma unroll
        for (int i = 0; i < 2; i++)
#pragma unroll
          for (int j = 0; j < 2; j++)
#pragma unroll
            for (int e = 0; e < 8; e++)
              gp[i][j][e] = pack2(fsigmoid(acc[i][j][2 * e]), fsigmoid(acc[i][j][2 * e + 1]));
      }
      {
        f32x16 acc[2][2];
        zero_acc(acc);
        gemm_core<false>(acc, wsp<u16>(p, O_WB) + (size_t)(g * 1024 + ct * 128) * 512, 512,
                         Y + (size_t)rt * 128 * 1536 + g * 512, 1536, 512, smem);
#pragma unroll
        for (int i = 0; i < 2; i++)
#pragma unroll
          for (int j = 0; j < 2; j++)
#pragma unroll
            for (int e = 0; e < 8; e++) {
              mg[i][j][2 * e] += __uint_as_float(gp[i][j][e] << 16) * acc[i][j][2 * e];
              mg[i][j][2 * e + 1] += __uint_as_float(gp[i][j][e] & 0xffff0000u) * acc[i][j][2 * e + 1];
            }
      }
    }
#pragma unroll
    for (int i = 0; i < 2; i++)
#pragma unroll
      for (int j = 0; j < 2; j++)
#pragma unroll
        for (int gp = 0; gp < 2; gp++) {
          const int row = rt * 128 + wn_ * 64 + j * 32 + r_;
          const int col = ct * 128 + wm_ * 64 + i * 32 + 8 * (2 * gp + hh_);
          uint2 oa, ob;
          oa.x = pack2(mg[i][j][8 * gp], mg[i][j][8 * gp + 1]);
          oa.y = pack2(mg[i][j][8 * gp + 2], mg[i][j][8 * gp + 3]);
          ob.x = pack2(mg[i][j][8 * gp + 4], mg[i][j][8 * gp + 5]);
          ob.y = pack2(mg[i][j][8 * gp + 6], mg[i][j][8 * gp + 7]);
          *(uint4*)(M + (size_t)row * D + col) = pair_swap(oa, ob);
        }
  PATCH_LOOP_END
}

__device__ void phase_resid(const Params& p, int l, bool last, const u16* Ain, size_t lda, const u16* W, int K,
                            int bid, int nb, u16* smem) {
  EPI_DECL
  const int nrt_ = n_row_tiles(last);
  PATCH_LOOP_BEGIN(nrt_, 8, 8, 8)
    const int rt = row_tile(last, prt), ct = pct;
    f32x16 acc[2][2];
    zero_acc(acc);
    gemm_core(acc, W + (size_t)ct * 128 * K, K, Ain + (size_t)rt * 128 * lda, lda, K, smem);
    u16* FB = wsp<u16>(p, O_FB);
#pragma unroll
    for (int i = 0; i < 2; i++)
#pragma unroll
      for (int j = 0; j < 2; j++)
#pragma unroll
        for (int gp = 0; gp < 2; gp++) {
          const int row = rt * 128 + wn_ * 64 + j * 32 + r_;
          const int col = ct * 128 + wm_ * 64 + i * 32 + 8 * (2 * gp + hh_);
          uint2 oa, ob;
          oa.x = pack2(acc[i][j][8 * gp], acc[i][j][8 * gp + 1]);
          oa.y = pack2(acc[i][j][8 * gp + 2], acc[i][j][8 * gp + 3]);
          ob.x = pack2(acc[i][j][8 * gp + 4], acc[i][j][8 * gp + 5]);
          ob.y = pack2(acc[i][j][8 * gp + 6], acc[i][j][8 * gp + 7]);
          *(uint4*)(FB + (size_t)row * D + col) = pair_swap(oa, ob);
        }
  PATCH_LOOP_END
}

__device__ void phase_p7(const Params& p, int l, bool last, int bid, int nb, u16* smem) {
  EPI_DECL
  const u16* A = wsp<u16>(p, O_A);
  u16* HH = wsp<u16>(p, O_HH);
  const int nrt_ = n_row_tiles(last);
  for (int t = bid; t < nrt_ * 44; t += nb) {
    const int prt = t / 44, ct = t - prt * 44;
    const int rt = row_tile(last, prt);
    f32x16 acc[2][2];
    zero_acc(acc);
    gemm_core(acc, wsp<u16>(p, O_WGU) + (size_t)ct * 128 * D, D, A + (size_t)rt * 128 * D, D, D, smem);
#pragma unroll
    for (int j = 0; j < 2; j++)
#pragma unroll
      for (int gp = 0; gp < 2; gp++) {
        const int row = rt * 128 + wn_ * 64 + j * 32 + r_;
        const int q = (ct * 2 + wm_) * 32 + 8 * (2 * gp + hh_);
        float hv[8];
#pragma unroll
        for (int t = 0; t < 8; t++) {
          const float gt = acc[0][j][8 * gp + t], up = acc[1][j][8 * gp + t];
          hv[t] = gt * fsigmoid(gt) * up;
        }
        uint2 oa, ob;
        oa.x = pack2(hv[0], hv[1]);
        oa.y = pack2(hv[2], hv[3]);
        ob.x = pack2(hv[4], hv[5]);
        ob.y = pack2(hv[6], hv[7]);
        *(uint4*)(HH + (size_t)row * FH + q) = pair_swap(oa, ob);
      }
  }
}

constexpr int NPHASE = 3 + 9 * 2;

__device__ void run_phase(const Params& p, int ph, int bid, int nb, u16* smem) {
  if (ph == 0) {
    prep_tables(p, bid, nb);
    prep_modp(p, bid, nb);
    prep_weights(p, 0, bid, nb, smem);
    return;
  }
  if (ph == 1) { prep_modr(p, bid, nb); return; }
  if (ph == 2) { ln_phase(p, 0, p.ln_in_g, p.ln_in_b, 0, 0, 1024, false, bid, nb); return; }
  const int l = (ph - 3) / 9, s = (ph - 3) % 9;
  const bool last = (l == 1);
  switch (s) {
    case 0: phase_p1(p, l, last, bid, nb, smem); break;
    case 1: phase_p2(p, l, bid, nb, smem); break;
    case 2: phase_p3(p, l, last, bid, nb, smem); break;
    case 3: phase_p4(p, l, last, bid, nb, smem); break;
    case 4: phase_resid(p, l, last, wsp<u16>(p, O_M), D, wsp<u16>(p, O_WO), D, bid, nb, smem); break;
    case 5: ln_phase(p, 1, p.ln1_g + l * D, p.ln1_b + l * D, l, 3072, 4096, last, bid, nb, l, 2048); break;
    case 6: phase_p7(p, l, last, bid, nb, smem); break;
    case 7: phase_resid(p, l, last, wsp<u16>(p, O_HH), FH, wsp<u16>(p, O_WD), FH, bid, nb, smem); break;
    default:
      ln_phase(p, 1, p.ln2_g + l * D, p.ln2_b + l * D, last ? -1 : l + 1, 0, 1024, last, bid, nb, l, 5120);
      if (!last) prep_weights(p, l + 1, bid, nb, smem);
      break;
  }
}


#define XB_TMO      128
#define XB_XCNT(j)  (256  + 64 * (j))
#define XB_XSUB(j)  (1280 + 64 * (j))
#define XB_XGEN(j)  (2304 + 64 * (j))
#define XB_TOP      3328
#define XB_TOPGEN   3392
#define XCD_BAR_WORDS 3456
#define XB_SPIN_CAP (1u << 20)
#define LAS __attribute__((address_space(3)))
__device__ __forceinline__ unsigned xb_ld(unsigned* p) { return __hip_atomic_load(p, __ATOMIC_RELAXED, __HIP_MEMORY_SCOPE_AGENT); }
__device__ __forceinline__ unsigned xb_add(unsigned* p, unsigned v) { return __hip_atomic_fetch_add(p, v, __ATOMIC_RELAXED, __HIP_MEMORY_SCOPE_AGENT); }
__device__ __forceinline__ unsigned xb_xcc_id() { return (unsigned)__builtin_amdgcn_s_getreg((3 << 11) | 20) & 0xFu; }
#define XB_SPIN(cond, bar) do { unsigned _sp = 0; while (cond) { __builtin_amdgcn_s_sleep(1); \
    if ((++_sp & 255u) == 0u) { if (xb_ld(&(bar)[XB_TMO])) break; if (_sp > XB_SPIN_CAP) { atomicAdd(&(bar)[XB_TMO], 1u); break; } } } } while (0)
struct XcdBarrier {
  unsigned* bar; unsigned x;
  volatile LAS unsigned* st;
};
__device__ __forceinline__ XcdBarrier xcd_barrier_post(unsigned* bar, volatile LAS unsigned* st) {
  XcdBarrier b; b.bar = bar; b.x = xb_xcc_id(); b.st = st;
  if (threadIdx.x == 0) (void)xb_add(&bar[XB_XCNT(b.x)], 1u);
  return b;
}
__device__ __forceinline__ void xcd_barrier_complete(unsigned* bar, unsigned x, unsigned& nloc, unsigned& nx) {
  const unsigned G = gridDim.x * gridDim.y * gridDim.z;
  unsigned sum, cnt, mine, sp = 0u;
  for (;;) {
    sum = 0u; cnt = 0u; mine = 0u;
#pragma unroll
    for (unsigned j = 0; j < 16; ++j) { const unsigned c = xb_ld(&bar[XB_XCNT(j)]); sum += c; cnt += (c > 0u) ? 1u : 0u; mine = (j == x) ? c : mine; }
    if (sum == G) break;
    __builtin_amdgcn_s_sleep(1);
    if ((++sp & 255u) == 0u) { if (xb_ld(&bar[XB_TMO])) break; if (sp > XB_SPIN_CAP) { atomicAdd(&bar[XB_TMO], 1u); break; } }
  }
  nloc = mine > 0u ? mine : 1u; nx = cnt > 0u ? cnt : 1u;
}
__device__ __forceinline__ void xcd_barrier(const XcdBarrier& b) {
  asm volatile("s_waitcnt vmcnt(0)" ::: "memory");
  __syncthreads();
  if (threadIdx.x == 0) {
    unsigned* bar = b.bar;
    __builtin_amdgcn_s_waitcnt(0);
    unsigned nloc = b.st[0], nx = b.st[1];
    if (nloc == 0u) { xcd_barrier_complete(bar, b.x, nloc, nx); b.st[0] = nloc; b.st[1] = nx; }
    const unsigned old = xb_add(&bar[XB_XSUB(b.x)], 1u);
    const unsigned gen = old / nloc;
    if (old + 1u == (gen + 1u) * nloc) {
      __builtin_amdgcn_fence(__ATOMIC_RELEASE, "agent");
      asm volatile("s_waitcnt vmcnt(0)" ::: "memory");
      const unsigned og = xb_add(&bar[XB_TOP], 1u);
      const unsigned tg = og / nx;
      if (og + 1u == (tg + 1u) * nx) xb_add(&bar[XB_TOPGEN], 1u);
      else XB_SPIN(xb_ld(&bar[XB_TOPGEN]) == tg, bar);
      __builtin_amdgcn_fence(__ATOMIC_ACQUIRE, "agent");
      xb_add(&bar[XB_XGEN(b.x)], 1u);
      asm volatile("s_waitcnt vmcnt(0)" ::: "memory");
    } else {
      XB_SPIN(xb_ld(&bar[XB_XGEN(b.x)]) == gen, bar);
      __builtin_amdgcn_fence(__ATOMIC_ACQUIRE, "agent");
      asm volatile("s_waitcnt vmcnt(0)" ::: "memory");
    }
  }
  __syncthreads();
}

constexpr int SMEM_ELEMS = 4 * SM_A + 256 + 8;

#if COOP
__global__ void __launch_bounds__(256, 2) mega_kernel(Params p) {
  __shared__ __attribute__((aligned(16))) u16 smem[SMEM_ELEMS];
  cg::grid_group grid = cg::this_grid();
  volatile LAS unsigned* st = (volatile LAS unsigned*)(smem + 4 * SM_A + 256);
  if (threadIdx.x == 0) { st[0] = 0u; st[1] = 0u; }
  __syncthreads();
  XcdBarrier xb = xcd_barrier_post((unsigned*)(p.ws + O_BAR), st);
  for (int ph = 0; ph < NPHASE; ph++) {
#ifdef PROBE_MASK
    const int s9 = ph >= 3 ? (ph - 3) % 9 : -1;
    const int nrep = (s9 >= 0 && ((PROBE_MASK >> s9) & 1)) ? 2 : 1;
    for (int rep = 0; rep < nrep; rep++) {
      run_phase(p, ph, blockIdx.x, gridDim.x, smem);
      if (ph == 0) grid.sync();
      else if (ph + 1 < NPHASE || rep + 1 < nrep) xcd_barrier(xb);
    }
#else
    run_phase(p, ph, blockIdx.x, gridDim.x, smem);
    if (ph == 0) grid.sync();
    else if (ph + 1 < NPHASE) xcd_barrier(xb);
#endif
  }
}
#else
__global__ void __launch_bounds__(256, 2) phase_kernel(Params p, int ph) {
  __shared__ __attribute__((aligned(16))) u16 smem[SMEM_ELEMS];
  run_phase(p, ph, blockIdx.x, gridDim.x, smem);
}
#endif

extern "C" void kernel_launch(void* const* d_in, const int* in_sizes, int n_in, void* d_out, int out_size, void* d_ws,
                              size_t ws_size, hipStream_t stream) {
  Params p{};
  const float** f = (const float**)&p;
  for (int i = 0; i < 25; i++) f[i] = (const float*)d_in[i];
  p.out = (float*)d_out;
  p.ws = (unsigned char*)d_ws;
  if (ws_size < O_WSEND) fprintf(stderr, "workspace too small: %zu < %zu\n", ws_size, (size_t)O_WSEND);
#if COOP
  static int grid_blocks = 0;
  if (!grid_blocks) {
    int dev = 0, cus = 0, per_cu = 0;
    hipGetDevice(&dev);
    hipDeviceGetAttribute(&cus, hipDeviceAttributeMultiprocessorCount, dev);
    hipOccupancyMaxActiveBlocksPerMultiprocessor(&per_cu, mega_kernel, 256, 0);
    if (per_cu > 2) per_cu = 2;
    grid_blocks = cus * per_cu;
  }
  (void)hipMemsetAsync(p.ws + O_BAR, 0, 3456 * 4, stream);
  void* args[] = {&p};
  hipError_t e = hipLaunchCooperativeKernel((void*)mega_kernel, dim3(grid_blocks), dim3(256), args, 0, stream);
  if (e != hipSuccess) fprintf(stderr, "cooperative launch failed: %s (grid %d)\n", hipGetErrorString(e), grid_blocks);
#else
  for (int ph = 0; ph < NPHASE; ph++) phase_kernel<<<512, 256, 0, stream>>>(p, ph);
#endif
}
```

```cpp
#include <hip/hip_runtime.h>
#include <hip/hip_cooperative_groups.h>
#include <stdint.h>
#include <cstdio>
namespace cg = cooperative_groups;

#ifndef COOP
#define COOP 1
#endif

typedef __attribute__((ext_vector_type(8))) short bf16x8;
typedef __attribute__((ext_vector_type(4))) short bf16x4;
typedef __attribute__((ext_vector_type(16))) float f32x16;
typedef unsigned short u16;
typedef __attribute__((ext_vector_type(4))) unsigned int u32x4;

constexpr int D = 1024;
constexpr int NBATCH = 2;
constexpr int SEQ = 16384;
constexpr int CTXL = 256;
constexpr int KPB = SEQ + CTXL;
constexpr int T = NBATCH * KPB;
constexpr int NRT = T / 128;
constexpr int FH = 2816;
constexpr int IN_DIM = 5536;
constexpr float LOG2E = 1.4426950408889634f;
constexpr float NA_SCALE_L2 = 0.125f * LOG2E;
constexpr float MLA_SCALE_L2 = 0.10206207261596575f * LOG2E;
constexpr float ALPHA = 1.4142135623730951f;
constexpr float EPS = 1e-5f;
constexpr float RS128 = 0.08838834764831845f;

constexpr size_t al256(size_t x) { return (x + 255) & ~(size_t)255; }
constexpr size_t O_WF = 0;
constexpr size_t O_WP = O_WF + (size_t)1024 * 1024 * 2;
constexpr size_t O_WG = O_WP + (size_t)2048 * 1024 * 2;
constexpr size_t O_WUQ = O_WG + (size_t)3072 * 1024 * 2;
constexpr size_t O_WUKV = O_WUQ + (size_t)768 * 256 * 2;
constexpr size_t O_WB = O_WUKV + (size_t)1024 * 128 * 2;
constexpr size_t O_WO = O_WB + (size_t)3 * 1024 * 512 * 2;
constexpr size_t O_WGU = O_WO + (size_t)1024 * 1024 * 2;
constexpr size_t O_WD = O_WGU + (size_t)5632 * 1024 * 2;
constexpr size_t O_MA = O_WD + (size_t)1024 * 2816 * 2;
constexpr size_t O_MB = O_MA + (size_t)256 * 256 * 2;
constexpr size_t O_MC = O_MB + (size_t)128 * 256 * 2;
constexpr size_t O_TW = O_MC + (size_t)256 * 512 * 2;
constexpr size_t O_MODP = O_TW + (size_t)128 * 128 * 2 * 4;
constexpr size_t O_MOD = O_MODP + (size_t)16 * 2 * 3 * 6144 * 4;
constexpr size_t O_XCTX = O_MOD + (size_t)2 * 3 * 6144 * 4;
constexpr size_t O_D1C = O_XCTX + (size_t)512 * 1024 * 4;
constexpr size_t O_A = O_D1C + (size_t)2 * 512 * 2 * 256 * 2;
constexpr size_t O_RQ = O_A + (size_t)T * 1024 * 2;
constexpr size_t O_QNA = O_RQ;
constexpr size_t O_KNA = O_QNA + (size_t)T * 512 * 2;
constexpr size_t O_VNAT = O_KNA + (size_t)T * 512 * 2;
constexpr size_t O_RY = O_VNAT + (size_t)T * 512 * 2;
constexpr size_t O_Y = O_RY;
constexpr size_t O_D1 = O_RY;
constexpr size_t O_LAT = O_RY + (size_t)67108864;
constexpr size_t O_D2 = O_RY + (size_t)T * 1536 * 2;
constexpr size_t O_QM = O_D2 + (size_t)67108864;
constexpr size_t O_KN = O_QM + (size_t)T * 768 * 2;
constexpr size_t O_KRR = O_KN + (size_t)T * 512 * 2;
constexpr size_t O_VMT = O_KRR + (size_t)T * 32 * 2;
constexpr size_t O_END = O_VMT + (size_t)T * 512 * 2;
constexpr size_t O_BAR = (O_END + 255) & ~(size_t)255;
constexpr size_t O_ROPE = (O_BAR + 3456 * 4 + 255) & ~(size_t)255;
constexpr size_t O_WSEND = O_ROPE + 256 * 8 * 2 * 4;
constexpr size_t O_FB = O_QM;
constexpr size_t O_M = O_RQ;
constexpr size_t O_HH = O_RQ;

struct Params {
  const float *x, *c, *ctx, *c_ctx, *ln_in_g, *ln_in_b, *w_mod, *b_mod, *w_in, *gq, *gkv, *w_uq, *w_qr, *w_uk,
      *w_uv, *rpb, *w_branch, *w_out, *ln1_g, *ln1_b, *ln2_g, *ln2_b, *w_gate, *w_up, *w_down;
  float* out;
  unsigned char* ws;
};

__device__ __forceinline__ u16 f2bf(float f) {
  uint32_t u = __float_as_uint(f);
  u += 0x7fffu + ((u >> 16) & 1u);
  return (u16)(u >> 16);
}
typedef __attribute__((ext_vector_type(2))) __bf16 bf16v2;
typedef __attribute__((ext_vector_type(2))) float f32v2;
__device__ __forceinline__ uint32_t pack2(float a, float b) {
  const f32v2 v = {a, b};
  return __builtin_bit_cast(uint32_t, __builtin_convertvector(v, bf16v2));
}
__device__ __forceinline__ uint4 pair_swap(uint2 a, uint2 b) {
  const auto rx = __builtin_amdgcn_permlane32_swap(a.x, b.x, false, false);
  const auto ry = __builtin_amdgcn_permlane32_swap(a.y, b.y, false, false);
  return make_uint4(rx[0], ry[0], rx[1], ry[1]);
}
__device__ __forceinline__ float bf2f(u16 v) { return __uint_as_float(((uint32_t)v) << 16); }
__device__ __forceinline__ float wsum(float v) {
#pragma unroll
  for (int o = 32; o > 0; o >>= 1) v += __shfl_xor(v, o);
  return v;
}
__device__ __forceinline__ float fsigmoid(float v) {
  return __builtin_amdgcn_rcpf(1.f + __builtin_amdgcn_exp2f(-LOG2E * v));
}

__device__ __forceinline__ int ltid() {
  int t = threadIdx.x;
  asm volatile("" : "+v"(t));
  return t;
}

template <typename Tp>
__device__ __forceinline__ Tp* wsp(const Params& p, size_t off) { return (Tp*)(p.ws + off); }

__device__ __forceinline__ float* xrow(const Params& p, int row) {
  int b = row / KPB, kk = row - b * KPB;
  if (kk < CTXL) return wsp<float>(p, O_XCTX) + (size_t)(b * CTXL + kk) * D;
  return p.out + (size_t)(b * SEQ + kk - CTXL) * D;
}

constexpr int LSTR = 72;
constexpr int SM_A = 128 * LSTR;

template <bool DEEP = true>
__device__ __forceinline__ void gemm_core(f32x16 (&acc)[2][2], const u16* __restrict__ A, size_t lda,
                                          const u16* __restrict__ B, size_t ldb, int K, u16* smem) {
  const int tid = ltid(), lane = tid & 63, wave = tid >> 6;
  const int wm = wave >> 1, wn = wave & 1, r = lane & 31, hh = lane >> 5;
  u16* sA = smem;
  u16* sB = smem + 2 * SM_A;
  const int lrow = tid >> 3, lkc = (tid & 7) * 8;
  const unsigned char* gab = (const unsigned char*)A;
  const unsigned char* gbb = (const unsigned char*)B;
  uint32_t oa[4], ob[4];
#pragma unroll
  for (int i = 0; i < 4; i++) {
    oa[i] = (uint32_t)(((size_t)(lrow + 32 * i) * lda + lkc) * 2);
    ob[i] = (uint32_t)(((size_t)(lrow + 32 * i) * ldb + lkc) * 2);
  }
  u16* wa = sA + lrow * LSTR + lkc;
  u16* wb = sB + lrow * LSTR + lkc;
  const u16* pa = sA + (wm * 64 + r) * LSTR + hh * 8;
  const u16* pb = sB + (wn * 64 + r) * LSTR + hh * 8;
  u32x4 a0r[4], b0r[4], a1r[4], b1r[4];
#define G_LOAD(ar, br, ko)                                               \
  _Pragma("unroll") for (int i = 0; i < 4; i++) {                        \
    ar[i] = *(const u32x4*)(gab + (size_t)(ko)*2 + oa[i]);               \
    br[i] = *(const u32x4*)(gbb + (size_t)(ko)*2 + ob[i]);               \
  }
#define G_STORE(ar, br, buf)                                             \
  _Pragma("unroll") for (int i = 0; i < 4; i++) {                        \
    *(u32x4*)(wa + (buf)*SM_A + 32 * i * LSTR) = ar[i];                  \
    *(u32x4*)(wb + (buf)*SM_A + 32 * i * LSTR) = br[i];                  \
  }
#define G_COMPUTE(buf)                                                                   \
  _Pragma("unroll") for (int ks = 0; ks < 4; ks++) {                                     \
    const bf16x8 fa0 = *(const bf16x8*)(pa + (buf)*SM_A + ks * 16);                      \
    const bf16x8 fa1 = *(const bf16x8*)(pa + (buf)*SM_A + 32 * LSTR + ks * 16);          \
    const bf16x8 fb0 = *(const bf16x8*)(pb + (buf)*SM_A + ks * 16);                      \
    const bf16x8 fb1 = *(const bf16x8*)(pb + (buf)*SM_A + 32 * LSTR + ks * 16);          \
    acc[0][0] = __builtin_amdgcn_mfma_f32_32x32x16_bf16(fa0, fb0, acc[0][0], 0, 0, 0);   \
    acc[0][1] = __builtin_amdgcn_mfma_f32_32x32x16_bf16(fa0, fb1, acc[0][1], 0, 0, 0);   \
    acc[1][0] = __builtin_amdgcn_mfma_f32_32x32x16_bf16(fa1, fb0, acc[1][0], 0, 0, 0);   \
    acc[1][1] = __builtin_amdgcn_mfma_f32_32x32x16_bf16(fa1, fb1, acc[1][1], 0, 0, 0);   \
  }
  const int nk = K >> 6;
  if (DEEP) {
    G_LOAD(a0r, b0r, 0)
    G_LOAD(a1r, b1r, 64)
    G_STORE(a0r, b0r, 0)
    __syncthreads();
    const int klast = (nk - 1) * 64;
    G_LOAD(a0r, b0r, min(128, klast))
    for (int kt = 0; kt < nk; kt += 2) {
      G_COMPUTE(0)
      G_STORE(a1r, b1r, 1)
      __syncthreads();
      G_LOAD(a1r, b1r, min((kt + 3) * 64, klast))
      __builtin_amdgcn_sched_barrier(0);
      G_COMPUTE(1)
      G_STORE(a0r, b0r, 0)
      __syncthreads();
      G_LOAD(a0r, b0r, min((kt + 4) * 64, klast))
      __builtin_amdgcn_sched_barrier(0);
    }
  } else {
    G_LOAD(a0r, b0r, 0)
    G_STORE(a0r, b0r, 0)
    __syncthreads();
    for (int kt = 0; kt < nk; kt += 2) {
      G_LOAD(a0r, b0r, (kt + 1) * 64)
      G_COMPUTE(0)
      G_STORE(a0r, b0r, 1)
      __syncthreads();
      if (kt + 2 < nk) G_LOAD(a0r, b0r, (kt + 2) * 64)
      G_COMPUTE(1)
      if (kt + 2 < nk) G_STORE(a0r, b0r, 0)
      __syncthreads();
    }
  }
#undef G_LOAD
#undef G_STORE
#undef G_COMPUTE
}

__device__ __forceinline__ void zero_acc(f32x16 (&acc)[2][2]) {
#pragma unroll
  for (int i = 0; i < 2; i++)
#pragma unroll
    for (int j = 0; j < 2; j++)
#pragma unroll
      for (int e = 0; e < 16; e++) acc[i][j][e] = 0.f;
}

#define EPI_DECL                                                     \
  const int lane_ = ltid() & 63, wave_ = ltid() >> 6;      \
  const int wm_ = wave_ >> 1, wn_ = wave_ & 1, r_ = lane_ & 31, hh_ = lane_ >> 5; \
  (void)wm_; (void)wn_; (void)r_; (void)hh_;

__device__ __forceinline__ const float* src_col(const Params& p, int l, int kind, int n, int& ld) {
  switch (kind) {
    case 0:
      ld = IN_DIM;
      return n < 1952 ? p.w_in + (size_t)l * D * IN_DIM + 512 + n : nullptr;
    case 1:
      ld = IN_DIM;
      return p.w_in + (size_t)l * D * IN_DIM + 2464 + n;
    case 2:
      if (n < 512) {
        ld = 512;
        return p.w_uq + (size_t)l * 256 * 512 + n;
      } else {
        int m = n - 512, wt = m >> 6, jb = (m >> 5) & 1, idx = wt * 32 + (m & 31);
        int h = idx >> 4, e = idx & 15;
        ld = 256;
        return p.w_qr + (size_t)l * 256 * 256 + h * 32 + jb * 16 + e;
      }
    case 3:
      ld = 512;
      return n < 512 ? p.w_uk + (size_t)l * 128 * 512 + n : p.w_uv + (size_t)l * 128 * 512 + (n - 512);
    case 4: {
      int g = n >> 10, nn = n & 1023;
      ld = 1024;
      return p.w_branch + ((size_t)(l * 3 + g) * 512) * 1024 + nn;
    }
    case 5:
      ld = 1024;
      return p.w_out + (size_t)l * D * D + n;
    case 6: {
      int jb = (n >> 5) & 1, q = (n >> 6) * 32 + (n & 31);
      ld = FH;
      return (jb ? p.w_up : p.w_gate) + (size_t)l * D * FH + q;
    }
    default:
      ld = 1024;
      return p.w_down + (size_t)l * FH * D + n;
  }
}

__device__ __forceinline__ int job_nd(int k) {
  switch (k) { case 0: return 2048; case 1: return 3072; case 2: return 768; case 3: return 1024; case 4: return 3072;
    case 5: return 1024; case 6: return 5632; default: return 1024; }
}
__device__ __forceinline__ int job_kd(int k) {
  switch (k) { case 0: return 1024; case 1: return 1024; case 2: return 256; case 3: return 128; case 4: return 512;
    case 5: return 1024; case 6: return 1024; default: return 2816; }
}
__device__ __forceinline__ size_t job_od(int k) {
  switch (k) { case 0: return O_WP; case 1: return O_WG; case 2: return O_WUQ; case 3: return O_WUKV; case 4: return O_WB;
    case 5: return O_WO; case 6: return O_WGU; default: return O_WD; }
}
__device__ void prep_weights(const Params& p, int l, int bid, int nb, u16* smem) {
  float* tile = (float*)smem;
  const int tid = ltid();
  int start = 0;
#pragma unroll 1
  for (int kind = 0; kind < 8; kind++) {
    const int Kk = job_kd(kind);
    const int nkt = Kk >> 6, ntile = (job_nd(kind) >> 6) * nkt;
    u16* dst = wsp<u16>(p, job_od(kind));
    const float* ksc = kind == 2 ? p.gq + l * 256 : (kind == 3 ? p.gkv + l * 128 : nullptr);
    for (int t = (bid + nb - (start % nb)) % nb; t < ntile; t += nb) {
      const int nt = t / nkt, kt = t - nt * nkt;
      const int n0 = nt * 64, k0 = kt * 64;
      {
        const int kq = tid >> 4, nn4 = (tid & 15) * 4;
        int ld;
        const float* sp = src_col(p, l, kind, n0 + nn4, ld);
#pragma unroll
        for (int i = 0; i < 4; i++) {
          const int kk = i * 16 + kq;
          float4 v = make_float4(0.f, 0.f, 0.f, 0.f);
          if (sp) v = *(const float4*)(sp + (size_t)(k0 + kk) * ld);
          if (ksc) {
            const float sc = ksc[k0 + kk];
            v.x *= sc; v.y *= sc; v.z *= sc; v.w *= sc;
          }
          float* tp = tile + kk * 65 + nn4;
          tp[0] = v.x; tp[1] = v.y; tp[2] = v.z; tp[3] = v.w;
        }
      }
      __syncthreads();
#pragma unroll
      for (int i = 0; i < 2; i++) {
        const int c = tid + 256 * i;
        const int nn = c >> 3, kc = (c & 7) * 8;
        const float* tp = tile + kc * 65 + nn;
        uint4 o;
        o.x = pack2(tp[0], tp[65]);
        o.y = pack2(tp[2 * 65], tp[3 * 65]);
        o.z = pack2(tp[4 * 65], tp[5 * 65]);
        o.w = pack2(tp[6 * 65], tp[7 * 65]);
        *(uint4*)(dst + (size_t)(n0 + nn) * Kk + k0 + kc) = o;
      }
      __syncthreads();
    }
    start += ntile;
  }
  {
    float* ctab = (float*)smem;
    __syncthreads();
    if (tid < 128) ctab[tid] = cospif((float)tid * (1.f / 64.f));
    __syncthreads();
    u16* dst = wsp<u16>(p, O_WF);
    for (int it = bid; it < 512; it += nb) {
      const int o = it * 256 + tid;
      const int np = o & 1023, k8 = (o >> 10) * 8;
      const int reim = np >> 9, g = (np >> 7) & 3, m = np & 127;
      const float* w = p.w_in + (size_t)l * D * IN_DIM + (size_t)k8 * IN_DIM + g * 128;
      const int sh = reim ? 96 : 0;
      float a8[8];
#pragma unroll
      for (int j = 0; j < 8; j++) a8[j] = 0.f;
#pragma unroll 4
      for (int c = 0; c < 128; c++) {
        const float tw = ctab[(m * c + sh) & 127];
#pragma unroll
        for (int j = 0; j < 8; j++) a8[j] += w[(size_t)j * IN_DIM + c] * tw;
      }
      uint4 ov;
      ov.x = pack2(a8[0] * RS128, a8[1] * RS128);
      ov.y = pack2(a8[2] * RS128, a8[3] * RS128);
      ov.z = pack2(a8[4] * RS128, a8[5] * RS128);
      ov.w = pack2(a8[6] * RS128, a8[7] * RS128);
      *(uint4*)(dst + (size_t)np * 1024 + k8) = ov;
    }
    __syncthreads();
  }
}

__device__ __forceinline__ void rope_entry(int posi, int f, float& cs, float& sn);
__device__ void prep_tables(const Params& p, int bid, int nb) {
  u16* MA = wsp<u16>(p, O_MA);
  u16* MB = wsp<u16>(p, O_MB);
  u16* MC = wsp<u16>(p, O_MC);
  float* TW = wsp<float>(p, O_TW);
  const int total = 65536 + 32768 + 131072 + 16384;
  for (int idx = bid * 256 + ltid(); idx < 2048; idx += nb * 256) {
    float cs, sn;
    rope_entry(idx >> 3, idx & 7, cs, sn);
    wsp<float2>(p, O_ROPE)[idx] = make_float2(cs, sn);
  }
  for (int idx = bid * 256 + ltid(); idx < total; idx += nb * 256) {
    if (idx < 65536) {
      const int n = idx >> 8, k = idx & 255;
      const int nt = n >> 7, wn = (n >> 6) & 1, jb = (n >> 5) & 1, klo = nt * 64 + wn * 32 + (n & 31);
      const int ri = k >> 7, nhi = k & 127;
      const int xx = (klo * nhi) & 127;
      const float c = cospif((float)xx * (1.f / 64.f)), s = sinpif((float)xx * (1.f / 64.f));
      float v = jb == 0 ? (ri == 0 ? c : -s) : (ri == 0 ? -s : -c);
      MA[idx] = f2bf(v * RS128);
    } else if (idx < 65536 + 32768) {
      const int i2 = idx - 65536;
      const int khi = i2 >> 8, k = i2 & 255;
      const int ri = k >> 7, nlo = k & 127;
      const int xx = (khi * nlo) & 127;
      const float c = cospif((float)xx * (1.f / 64.f)), s = sinpif((float)xx * (1.f / 64.f));
      MB[i2] = f2bf((ri == 0 ? c : s) * RS128);
    } else if (idx < 65536 + 32768 + 131072) {
      const int i2 = idx - 65536 - 32768;
      const int kk = i2 >> 9, k = i2 & 511;
      const int ri = k >> 8, nn = k & 255;
      const int xx = (kk * nn) & 255;
      const float c = cospif((float)xx * (1.f / 128.f)), s = sinpif((float)xx * (1.f / 128.f));
      MC[i2] = f2bf((ri == 0 ? c : -s) * 0.0625f);
    } else {
      const int i2 = idx - 65536 - 32768 - 131072;
      const int klo = i2 >> 7, nlo = i2 & 127;
      const int xx = klo * nlo;
      TW[i2 * 2] = cospif((float)xx * (1.f / 8192.f));
      TW[i2 * 2 + 1] = sinpif((float)xx * (1.f / 8192.f));
    }
  }
}

__device__ void prep_modp(const Params& p, int bid, int nb) {
  float* modp = wsp<float>(p, O_MODP);
  for (int it = bid; it < 2 * 16 * 24; it += nb) {
    const int l = it / (16 * 24), rem = it - l * 16 * 24, kc = rem / 24, nblk = rem - kc * 24;
    const int n = nblk * 256 + ltid();
    const float* w = p.w_mod + (size_t)l * D * 6144 + n;
    float a0 = 0.f, a1 = 0.f, a2 = 0.f;
#pragma unroll 8
    for (int kk = 0; kk < 64; kk++) {
      const int k = kc * 64 + kk;
      const float wv = w[(size_t)k * 6144];
      float c0 = p.c[k], c1 = p.c[1024 + k], c2 = p.c_ctx[k];
      c0 = c0 / (1.f + __expf(-c0));
      c1 = c1 / (1.f + __expf(-c1));
      c2 = c2 / (1.f + __expf(-c2));
      a0 += c0 * wv;
      a1 += c1 * wv;
      a2 += c2 * wv;
    }
    float* o = modp + ((size_t)(kc * 2 + l) * 3) * 6144 + n;
    o[0] = a0;
    o[6144] = a1;
    o[2 * 6144] = a2;
  }
}
__device__ void prep_modr(const Params& p, int bid, int nb) {
  const float* modp = wsp<float>(p, O_MODP);
  float* mod = wsp<float>(p, O_MOD);
  for (int idx = bid * 256 + ltid(); idx < 2 * 3 * 6144; idx += nb * 256) {
    const int l = idx / (3 * 6144), n = idx % 6144;
    float v = p.b_mod[l * 6144 + n];
    for (int kc = 0; kc < 16; kc++) v += modp[(size_t)kc * 2 * 3 * 6144 + idx];
    mod[idx] = v;
  }
}

__device__ void ln_phase(const Params& p, int mode, const float* g, const float* bta, int lmod, int shoff, int scoff,
                         bool skip_ctx, int bid, int nb, int lres = 0, int goff = -1) {
  const int lane = ltid() & 63, wave = ltid() >> 6;
  u16* A = wsp<u16>(p, O_A);
  const float* mod = wsp<float>(p, O_MOD);
  float4 gg[4], bb[4], sh[4], sc[4], gt[4];
#pragma unroll
  for (int q = 0; q < 4; q++) gt[q] = make_float4(0.f, 0.f, 0.f, 0.f);
  int cur_mg = -1;
#pragma unroll
  for (int q = 0; q < 4; q++) {
    const int c0 = (q >> 1) * 512 + lane * 8 + (q & 1) * 4;
    gg[q] = *(const float4*)(g + c0);
    bb[q] = *(const float4*)(bta + c0);
    sh[q] = make_float4(0.f, 0.f, 0.f, 0.f);
    sc[q] = make_float4(0.f, 0.f, 0.f, 0.f);
  }
  int cur_m = -1;
  for (int row = bid * 4 + wave; row < T; row += nb * 4) {
    const int b = row / KPB, kk = row - b * KPB;
    if (skip_ctx && kk < CTXL) continue;
    float* xr = xrow(p, row);
    const float* src;
    if (mode == 0)
      src = kk < CTXL ? p.ctx + (size_t)(b * CTXL + kk) * D : p.x + (size_t)(b * SEQ + kk - CTXL) * D;
    else
      src = xr;
    float4 v[4];
    float s = 0.f;
    const int m = kk < CTXL ? 2 : b;
    if (goff >= 0 && m != cur_mg) {
      cur_mg = m;
#pragma unroll
      for (int q = 0; q < 4; q++)
        gt[q] = *(const float4*)(mod + ((size_t)lres * 3 + m) * 6144 + goff + (q >> 1) * 512 + lane * 8 + (q & 1) * 4);
    }
#pragma unroll
    for (int i = 0; i < 2; i++) {
      uint4 fv = make_uint4(0u, 0u, 0u, 0u);
      if (goff >= 0) fv = *(const uint4*)(wsp<u16>(p, O_FB) + (size_t)row * D + i * 512 + lane * 8);
      const uint32_t fw[4] = {fv.x, fv.y, fv.z, fv.w};
#pragma unroll
      for (int hq = 0; hq < 2; hq++) {
        const int q = i * 2 + hq;
        v[q] = *(const float4*)(src + i * 512 + lane * 8 + hq * 4);
        if (goff >= 0) {
          v[q].x = ALPHA * v[q].x + (1.f + gt[q].x) * __uint_as_float(fw[hq * 2] << 16);
          v[q].y = ALPHA * v[q].y + (1.f + gt[q].y) * __uint_as_float(fw[hq * 2] & 0xffff0000u);
          v[q].z = ALPHA * v[q].z + (1.f + gt[q].z) * __uint_as_float(fw[hq * 2 + 1] << 16);
          v[q].w = ALPHA * v[q].w + (1.f + gt[q].w) * __uint_as_float(fw[hq * 2 + 1] & 0xffff0000u);
        }
        s += v[q].x + v[q].y + v[q].z + v[q].w;
      }
    }
    if (lmod >= 0 && m != cur_m) {
      cur_m = m;
      const float* md = mod + ((size_t)lmod * 3 + m) * 6144;
#pragma unroll
      for (int q = 0; q < 4; q++) {
        const int c0 = (q >> 1) * 512 + lane * 8 + (q & 1) * 4;
        sh[q] = *(const float4*)(md + shoff + c0);
        sc[q] = *(const float4*)(md + scoff + c0);
      }
    }
    const float mu = wsum(s) * (1.f / 1024.f);
    float qs = 0.f;
#pragma unroll
    for (int q = 0; q < 4; q++) {
      v[q].x -= mu; v[q].y -= mu; v[q].z -= mu; v[q].w -= mu;
      qs += v[q].x * v[q].x + v[q].y * v[q].y + v[q].z * v[q].z + v[q].w * v[q].w;
    }
    const float rstd = rsqrtf(wsum(qs) * (1.f / 1024.f) + EPS);
#pragma unroll
    for (int i = 0; i < 2; i++) {
      uint4 o;
      uint32_t ow[4];
#pragma unroll
      for (int hq = 0; hq < 2; hq++) {
        const int q = i * 2 + hq;
        float4 y;
        y.x = v[q].x * rstd * gg[q].x + bb[q].x;
        y.y = v[q].y * rstd * gg[q].y + bb[q].y;
        y.z = v[q].z * rstd * gg[q].z + bb[q].z;
        y.w = v[q].w * rstd * gg[q].w + bb[q].w;
        *(float4*)(xr + i * 512 + lane * 8 + hq * 4) = y;
        ow[hq * 2] = pack2(y.x * (1.f + sc[q].x) + sh[q].x, y.y * (1.f + sc[q].y) + sh[q].y);
        ow[hq * 2 + 1] = pack2(y.z * (1.f + sc[q].z) + sh[q].z, y.w * (1.f + sc[q].w) + sh[q].w);
      }
      if (lmod >= 0) {
        o.x = ow[0]; o.y = ow[1]; o.z = ow[2]; o.w = ow[3];
        *(uint4*)(A + (size_t)row * D + i * 512 + lane * 8) = o;
      }
    }
  }
}

#define PATCH_LOOP_BEGIN(NR_, NC_, PR_, PC_)                                   \
  {                                                                            \
    const int x_ = bid & 7, w_ = bid >> 3, nbx_ = nb >> 3;                     \
    const int CG_ = ((NC_) + (PC_)-1) / (PC_);                                 \
    const int npatch_ = (((NR_) + (PR_)-1) / (PR_)) * CG_;                     \
    for (int u_ = w_;; u_ += nbx_) {                                           \
      const int g_ = (u_ >> 6) * 8 + x_;                                       \
      if (g_ >= npatch_) break;                                                \
      const int s_ = u_ & 63;                                                  \
      const int rg_ = g_ / CG_;                                                \
      const int prt = rg_ * (PR_) + s_ / (PC_);                                \
      const int pct = (g_ - rg_ * CG_) * (PC_) + s_ % (PC_);                   \
      if (prt >= (NR_) || pct >= (NC_)) continue;
#define PATCH_LOOP_END \
    }                  \
  }

__device__ void phase_p1(const Params& p, int l, bool last, int bid, int nb, u16* smem) {
  EPI_DECL
  const u16* A = wsp<u16>(p, O_A);
  PATCH_LOOP_BEGIN(NRT, 16, 8, 8)
    f32x16 acc[2][2];
    zero_acc(acc);
    {
      const int rt = prt, ct = pct;
      const int row0 = rt * 128, b = row0 / KPB, kk0 = row0 - b * KPB;
      if (ct < 8 || ct >= 12) {
        gemm_core(acc, wsp<u16>(p, O_WP) + (size_t)ct * 128 * D, D, A + (size_t)rt * 128 * D, D, D, smem);
        u16* dst;
        float sc = 1.f;
        int cb;
        if (ct < 4) { dst = wsp<u16>(p, O_QNA); sc = NA_SCALE_L2; cb = ct * 128; }
        else if (ct < 8) { dst = wsp<u16>(p, O_KNA); cb = (ct - 4) * 128; }
        else { dst = wsp<u16>(p, O_LAT); cb = (ct - 12) * 128; }
#pragma unroll
        for (int i = 0; i < 2; i++)
#pragma unroll
          for (int j = 0; j < 2; j++)
#pragma unroll
            for (int gp = 0; gp < 2; gp++) {
              const int row = row0 + wn_ * 64 + j * 32 + r_;
              const int col = cb + wm_ * 64 + i * 32 + 8 * (2 * gp + hh_);
              uint2 oa, ob;
              oa.x = pack2(acc[i][j][8 * gp] * sc, acc[i][j][8 * gp + 1] * sc);
              oa.y = pack2(acc[i][j][8 * gp + 2] * sc, acc[i][j][8 * gp + 3] * sc);
              ob.x = pack2(acc[i][j][8 * gp + 4] * sc, acc[i][j][8 * gp + 5] * sc);
              ob.y = pack2(acc[i][j][8 * gp + 6] * sc, acc[i][j][8 * gp + 7] * sc);
              *(uint4*)(dst + (size_t)row * 512 + col) = pair_swap(oa, ob);
            }
      } else {
        gemm_core(acc, A + (size_t)rt * 128 * D, D, wsp<u16>(p, O_WP) + (size_t)ct * 128 * D, D, D, smem);
        u16* dst = wsp<u16>(p, O_VNAT);
        const int cb = (ct - 8) * 128;
#pragma unroll
        for (int i = 0; i < 2; i++)
#pragma unroll
          for (int j = 0; j < 2; j++)
#pragma unroll
            for (int gp = 0; gp < 2; gp++) {
              const int kk = kk0 + wm_ * 64 + i * 32 + 8 * (2 * gp + hh_);
              const int col = cb + wn_ * 64 + j * 32 + r_;
              uint2 oa, ob;
              oa.x = pack2(acc[i][j][8 * gp], acc[i][j][8 * gp + 1]);
              oa.y = pack2(acc[i][j][8 * gp + 2], acc[i][j][8 * gp + 3]);
              ob.x = pack2(acc[i][j][8 * gp + 4], acc[i][j][8 * gp + 5]);
              ob.y = pack2(acc[i][j][8 * gp + 6], acc[i][j][8 * gp + 7]);
              *(uint4*)(dst + ((size_t)(b * 512 + col)) * KPB + kk) = make_uint4(oa.x, oa.y, ob.x, ob.y);
            }
      }
    }
  PATCH_LOOP_END
  PATCH_LOOP_BEGIN(256, 8, 8, 8)
    f32x16 acc[2][2];
    zero_acc(acc);
    {
      const int rt = prt, ct = pct;
      const int b = rt >> 7, nlo = rt & 127;
      gemm_core(acc, A + (size_t)(b * KPB + CTXL + nlo) * D, (size_t)128 * D,
                wsp<u16>(p, O_WF) + (size_t)ct * 128 * D, D, D, smem);
      u16* dst = wsp<u16>(p, O_D1);
#pragma unroll
      for (int i = 0; i < 2; i++)
#pragma unroll
        for (int j = 0; j < 2; j++)
#pragma unroll
          for (int gp = 0; gp < 2; gp++) {
            const int nhi = wm_ * 64 + i * 32 + 8 * (2 * gp + hh_);
            const int n = ct * 128 + wn_ * 64 + j * 32 + r_;
            const int reim = n >> 9, jj = n & 511;
            uint2 oa, ob;
            oa.x = pack2(acc[i][j][8 * gp], acc[i][j][8 * gp + 1]);
            oa.y = pack2(acc[i][j][8 * gp + 2], acc[i][j][8 * gp + 3]);
            ob.x = pack2(acc[i][j][8 * gp + 4], acc[i][j][8 * gp + 5]);
            ob.y = pack2(acc[i][j][8 * gp + 6], acc[i][j][8 * gp + 7]);
            *(uint4*)(dst + ((((size_t)(b * 512 + jj)) * 128 + nlo) * 2 + reim) * 128 + nhi) = pair_swap(oa, ob);
          }
    }
  PATCH_LOOP_END
  if (!last) {
    for (int t2 = bid; t2 < 32; t2 += nb) {
      f32x16 acc[2][2];
      zero_acc(acc);
      const int rt = t2 >> 3, ct = t2 & 7;
      const int b = rt >> 1, rb = rt & 1;
      gemm_core(acc, A + (size_t)(b * KPB + rb * 128) * D, D, wsp<u16>(p, O_WF) + (size_t)ct * 128 * D, D, D, smem);
      u16* dst = wsp<u16>(p, O_D1C);
#pragma unroll
      for (int i = 0; i < 2; i++)
#pragma unroll
        for (int j = 0; j < 2; j++)
#pragma unroll
          for (int gp = 0; gp < 2; gp++) {
            const int nc = rb * 128 + wm_ * 64 + i * 32 + 8 * (2 * gp + hh_);
            const int n = ct * 128 + wn_ * 64 + j * 32 + r_;
            const int reim = n >> 9, jj = n & 511;
            uint2 oa, ob;
            oa.x = pack2(acc[i][j][8 * gp], acc[i][j][8 * gp + 1]);
            oa.y = pack2(acc[i][j][8 * gp + 2], acc[i][j][8 * gp + 3]);
            ob.x = pack2(acc[i][j][8 * gp + 4], acc[i][j][8 * gp + 5]);
            ob.y = pack2(acc[i][j][8 * gp + 6], acc[i][j][8 * gp + 7]);
            *(uint4*)(dst + (((size_t)(b * 512 + jj)) * 2 + reim) * 256 + nc) = pair_swap(oa, ob);
          }
    }
  }
}

__device__ __forceinline__ float inv_freq(int i) {
  switch (i) {
    case 0: return 1.0f;
    case 1: return 0.31622776601683794f;
    case 2: return 0.1f;
    case 3: return 0.03162277660168379f;
    case 4: return 0.01f;
    case 5: return 0.0031622776601683794f;
    case 6: return 0.001f;
    default: return 0.00031622776601683794f;
  }
}
__device__ __forceinline__ void rope_entry(int posi, int f, float& cs, float& sn) {
  const float ang = (float)posi * inv_freq(f);
  double xr = (double)ang * 0.31830988618379067;
  xr -= 2.0 * floor(xr * 0.5);
  const float yr = (float)xr;
  cs = cospif(yr);
  sn = sinpif(yr);
}
__device__ __forceinline__ void rope_cs(const float2* __restrict__ rtab, int kk, int e, float& cs, float& sn) {
  if (kk < CTXL) { cs = 1.f; sn = 0.f; return; }
  const int tkn = kk - CTXL;
  const int posi = (e < 8) ? (tkn >> 6) : (tkn & 63);
  const float2 v = rtab[posi * 8 + (e & 7)];
  cs = v.x;
  sn = v.y;
}

__device__ __forceinline__ void row_rms(const u16* A, size_t lda, int K, float* rs) {
  const int tid = ltid();
  const int row = tid >> 1, half = tid & 1;
  const u16* pr = A + (size_t)row * lda + half * (K >> 1);
  float s = 0.f;
  for (int c = 0; c < (K >> 1); c += 8) {
    uint4 v = *(const uint4*)(pr + c);
    const uint32_t w[4] = {v.x, v.y, v.z, v.w};
#pragma unroll
    for (int q = 0; q < 4; q++) {
      const float a = __uint_as_float(w[q] << 16), bq = __uint_as_float(w[q] & 0xffff0000u);
      s += a * a + bq * bq;
    }
  }
  s += __shfl_xor(s, 1);
  if (half == 0) rs[row] = rsqrtf(s / (float)K + EPS);
  __syncthreads();
}

__device__ void phase_p2(const Params& p, int l, int bid, int nb, u16* smem) {
  EPI_DECL
  const u16* LAT = wsp<u16>(p, O_LAT);
  float* rs = (float*)(smem + 4 * SM_A);
  const int nQ = NRT * 6, nKV = NRT * 8, nFA = 1024 * 2, nKR = NRT;
  const int total = nQ + nKV + nFA + nKR;
  for (int t = bid; t < total; t += nb) {
    if (t < nQ) {
      const int rt = t / 6, ct = t - rt * 6;
      const int row0 = rt * 128, b = row0 / KPB, kk0 = row0 - b * KPB;
      row_rms(LAT + (size_t)row0 * 512, 512, 256, rs);
      f32x16 acc[2][2];
      zero_acc(acc);
      gemm_core(acc, wsp<u16>(p, O_WUQ) + (size_t)ct * 128 * 256, 256, LAT + (size_t)row0 * 512, 512, 256, smem);
      u16* QM = wsp<u16>(p, O_QM);
      if (ct < 4) {
#pragma unroll
        for (int i = 0; i < 2; i++)
#pragma unroll
          for (int j = 0; j < 2; j++)
#pragma unroll
            for (int gp = 0; gp < 2; gp++) {
              const int rl = wn_ * 64 + j * 32 + r_;
              const int col = ct * 128 + wm_ * 64 + i * 32 + 8 * (2 * gp + hh_);
              const int h = col >> 6, d = col & 63;
              const float sc = rs[rl] * MLA_SCALE_L2;
              uint2 oa, ob;
              oa.x = pack2(acc[i][j][8 * gp] * sc, acc[i][j][8 * gp + 1] * sc);
              oa.y = pack2(acc[i][j][8 * gp + 2] * sc, acc[i][j][8 * gp + 3] * sc);
              ob.x = pack2(acc[i][j][8 * gp + 4] * sc, acc[i][j][8 * gp + 5] * sc);
              ob.y = pack2(acc[i][j][8 * gp + 6] * sc, acc[i][j][8 * gp + 7] * sc);
              *(uint4*)(QM + (size_t)(row0 + rl) * 768 + h * 96 + d) = pair_swap(oa, ob);
            }
      } else {
        const int wt = (ct - 4) * 2 + wm_;
#pragma unroll
        for (int j = 0; j < 2; j++) {
          const int rl = wn_ * 64 + j * 32 + r_;
          const float sc = rs[rl] * MLA_SCALE_L2;
          uint2 p1[4], p2[4];
#pragma unroll
          for (int g = 0; g < 4; g++) {
            const int idx = wt * 32 + 8 * g + 4 * hh_;
            const int e16 = idx & 15;
            float o1[4], o2[4];
#pragma unroll
            for (int q = 0; q < 4; q++) {
              float cs, sn;
              rope_cs(wsp<float2>(p, O_ROPE), kk0 + rl, e16 + q, cs, sn);
              const float x1 = acc[0][j][4 * g + q] * sc, x2 = acc[1][j][4 * g + q] * sc;
              o1[q] = x1 * cs - x2 * sn;
              o2[q] = x2 * cs + x1 * sn;
            }
            p1[g].x = pack2(o1[0], o1[1]);
            p1[g].y = pack2(o1[2], o1[3]);
            p2[g].x = pack2(o2[0], o2[1]);
            p2[g].y = pack2(o2[2], o2[3]);
          }
#pragma unroll
          for (int gp = 0; gp < 2; gp++) {
            u16* qd = QM + (size_t)(row0 + rl) * 768 + (2 * wt + gp) * 96 + 64 + 8 * hh_;
            *(uint4*)qd = pair_swap(p1[2 * gp], p1[2 * gp + 1]);
            *(uint4*)(qd + 16) = pair_swap(p2[2 * gp], p2[2 * gp + 1]);
          }
        }
      }
      __syncthreads();
    } else if (t < nQ + nKV) {
      const int t2 = t - nQ;
      const int rt = t2 >> 3, ct = t2 & 7;
      const int row0 = rt * 128, b = row0 / KPB, kk0 = row0 - b * KPB;
      row_rms(LAT + (size_t)row0 * 512 + 256, 512, 128, rs);
      f32x16 acc[2][2];
      zero_acc(acc);
      if (ct < 4) {
        gemm_core(acc, wsp<u16>(p, O_WUKV) + (size_t)ct * 128 * 128, 128, LAT + (size_t)row0 * 512 + 256, 512, 128,
                  smem);
        u16* KN = wsp<u16>(p, O_KN);
#pragma unroll
        for (int i = 0; i < 2; i++)
#pragma unroll
          for (int j = 0; j < 2; j++)
#pragma unroll
            for (int gp = 0; gp < 2; gp++) {
              const int rl = wn_ * 64 + j * 32 + r_;
              const int col = ct * 128 + wm_ * 64 + i * 32 + 8 * (2 * gp + hh_);
              const float sc = rs[rl];
              uint2 oa, ob;
              oa.x = pack2(acc[i][j][8 * gp] * sc, acc[i][j][8 * gp + 1] * sc);
              oa.y = pack2(acc[i][j][8 * gp + 2] * sc, acc[i][j][8 * gp + 3] * sc);
              ob.x = pack2(acc[i][j][8 * gp + 4] * sc, acc[i][j][8 * gp + 5] * sc);
              ob.y = pack2(acc[i][j][8 * gp + 6] * sc, acc[i][j][8 * gp + 7] * sc);
              *(uint4*)(KN + (size_t)(row0 + rl) * 512 + col) = pair_swap(oa, ob);
            }
      } else {
        gemm_core(acc, LAT + (size_t)row0 * 512 + 256, 512, wsp<u16>(p, O_WUKV) + (size_t)ct * 128 * 128, 128, 128,
                  smem);
        u16* VMT = wsp<u16>(p, O_VMT);
#pragma unroll
        for (int i = 0; i < 2; i++)
#pragma unroll
          for (int j = 0; j < 2; j++)
#pragma unroll
            for (int gp = 0; gp < 2; gp++) {
              const int ra = wm_ * 64 + i * 32 + 16 * gp + 4 * hh_;
              const int rb2 = ra + 8;
              const int rst = wm_ * 64 + i * 32 + 8 * (2 * gp + hh_);
              const int col = (ct - 4) * 128 + wn_ * 64 + j * 32 + r_;
              uint2 oa, ob;
              oa.x = pack2(acc[i][j][8 * gp] * rs[ra], acc[i][j][8 * gp + 1] * rs[ra + 1]);
              oa.y = pack2(acc[i][j][8 * gp + 2] * rs[ra + 2], acc[i][j][8 * gp + 3] * rs[ra + 3]);
              ob.x = pack2(acc[i][j][8 * gp + 4] * rs[rb2], acc[i][j][8 * gp + 5] * rs[rb2 + 1]);
              ob.y = pack2(acc[i][j][8 * gp + 6] * rs[rb2 + 2], acc[i][j][8 * gp + 7] * rs[rb2 + 3]);
              *(uint4*)(VMT + ((size_t)(b * 512 + col)) * KPB + kk0 + rst) = make_uint4(oa.x, oa.y, ob.x, ob.y);
            }
      }
      __syncthreads();
    } else if (t < nQ + nKV + nFA) {
      const int t2 = t - nQ - nKV;
      const int rt = t2 >> 1, ct = t2 & 1;
      const int b = rt >> 9, jj = rt & 511;
      f32x16 acc[2][2];
      zero_acc(acc);
      gemm_core(acc, wsp<u16>(p, O_D1) + (size_t)rt * 128 * 256, 256, wsp<u16>(p, O_MA) + (size_t)ct * 128 * 256, 256,
                256, smem);
      const float* TW = wsp<float>(p, O_TW);
      u16* D2 = wsp<u16>(p, O_D2);
      const int klo = ct * 64 + wn_ * 32 + r_;
      const float2* twp = (const float2*)TW + klo;
#pragma unroll
      for (int i = 0; i < 2; i++)
      {
        uint2 pr[4], pi[4];
#pragma unroll
        for (int g = 0; g < 4; g++) {
          const int nlo = wm_ * 64 + i * 32 + 8 * g + 4 * hh_;
          float re[4], im[4];
#pragma unroll
          for (int q = 0; q < 4; q++) {
            const float2 tw = twp[(nlo + q) * 128];
            const float ar = acc[i][0][4 * g + q], ai = acc[i][1][4 * g + q];
            re[q] = ar * tw.x + ai * tw.y;
            im[q] = ai * tw.x - ar * tw.y;
          }
          pr[g].x = pack2(re[0], re[1]);
          pr[g].y = pack2(re[2], re[3]);
          pi[g].x = pack2(im[0], im[1]);
          pi[g].y = pack2(im[2], im[3]);
        }
#pragma unroll
        for (int gp = 0; gp < 2; gp++) {
          u16* d = D2 + ((((size_t)(b * 128 + klo)) * 512 + jj) * 2) * 128 + wm_ * 64 + i * 32 + 8 * (2 * gp + hh_);
          *(uint4*)d = pair_swap(pr[2 * gp], pr[2 * gp + 1]);
          *(uint4*)(d + 128) = pair_swap(pi[2 * gp], pi[2 * gp + 1]);
        }
      }
    } else {
      const int rt = t - nQ - nKV - nFA;
      u16* KRR = wsp<u16>(p, O_KRR);
      for (int idx = ltid(); idx < 128 * 16; idx += 256) {
        const int rl = idx >> 4, e16 = idx & 15;
        const int row = rt * 128 + rl, b = row / KPB, kk = row - b * KPB;
        const float x1 = bf2f(LAT[(size_t)row * 512 + 384 + e16]), x2 = bf2f(LAT[(size_t)row * 512 + 400 + e16]);
        float cs, sn;
        rope_cs(wsp<float2>(p, O_ROPE), kk, e16, cs, sn);
        KRR[(size_t)row * 32 + e16] = f2bf(x1 * cs - x2 * sn);
        KRR[(size_t)row * 32 + 16 + e16] = f2bf(x2 * cs + x1 * sn);
      }
    }
  }
}

template <int MODE>
__device__ void attn_item(const Params& p, int l, int b, int h, int q0  ,
                          int ntiles  , int rs0, int ycol, u16* smem) {
  constexpr int DQK = MODE == 0 ? 96 : 64;
  constexpr int KSTR = DQK + 8;
  constexpr int NKS = DQK / 16;
  constexpr int CPR = DQK / 8;
  constexpr int NKC = 64 * CPR / 256;
  const int tid = ltid(), lane = tid & 63, wave = tid >> 6, r = lane & 31, hh = lane >> 5;
  u16* Ks = smem;
  u16* Vs = smem + 2 * 64 * KSTR;
  const unsigned char* wsb = p.ws;
  const int qk = q0 + wave * 32 + r;
  const size_t qrow = (size_t)b * KPB + qk;
  bf16x8 qf[NKS];
  {
    const u16* qp = MODE == 0 ? wsp<u16>(p, O_QM) + qrow * 768 + h * 96 : wsp<u16>(p, O_QNA) + qrow * 512 + h * 64;
#pragma unroll
    for (int ks = 0; ks < NKS; ks++) qf[ks] = *(const bf16x8*)(qp + ks * 16 + hh * 8);
  }
  const short one_or_zero = hh == 0 ? (short)0x3F80 : (short)0;
  const bf16x8 kone = {one_or_zero, 0, 0, 0, 0, 0, 0, 0};
  bf16x8 qm = {0, 0, 0, 0, 0, 0, 0, 0};
  int qr = 0, qc = 0, rsq = 0, cs = 0;
  const float* rpb = nullptr;
  if (MODE == 1 && rs0 >= 0) {
    const int tkn = qk - CTXL;
    qr = tkn >> 6;
    qc = tkn & 63;
    rsq = min(max(qr - 4, 0), 248);
    cs = min(max(qc - 8, 0), 48);
    rpb = p.rpb + ((size_t)(l * 8 + h)) * 15 * 31;
  }
  f32x16 o[2];
#pragma unroll
  for (int e = 0; e < 16; e++) { o[0][e] = 0.f; o[1][e] = 0.f; }
  float lsum = 0.f;
  float m = 0.f;
  const bf16x8 ones = {(short)0x3F80, (short)0x3F80, (short)0x3F80, (short)0x3F80,
                       (short)0x3F80, (short)0x3F80, (short)0x3F80, (short)0x3F80};

#define KGEO(i)                                                                                          \
  uint32_t kof##i, kmu##i;                                                                               \
  int kls##i;                                                                                            \
  {                                                                                                      \
    const int c = tid + 256 * (i);                                                                       \
    const int row = c / CPR, cc = c - row * CPR;                                                         \
    if (MODE == 0 && cc >= 8) {                                                                          \
      kof##i = (uint32_t)(O_KRR + ((size_t)(b * KPB + row) * 32 + (cc - 8) * 8) * 2);                    \
      kmu##i = 64u;                                                                                      \
    } else {                                                                                             \
      kof##i = (uint32_t)((MODE == 0 ? O_KN : O_KNA) + ((size_t)(b * KPB + row) * 512 + h * 64 + cc * 8) * 2); \
      kmu##i = 1024u;                                                                                    \
    }                                                                                                    \
    kls##i = row * KSTR + cc * 8;                                                                        \
  }
#define VGEO(i)                                                                                          \
  uint32_t vof##i;                                                                                       \
  int vls##i;                                                                                            \
  bool vsx##i;                                                                                           \
  {                                                                                                      \
    const int c = tid + 256 * (i);                                                                       \
    const int d = c >> 3, cc = c & 7;                                                                    \
    vof##i = (uint32_t)((MODE == 0 ? O_VMT : O_VNAT) + ((size_t)(b * 512 + h * 64 + d) * KPB + cc * 8) * 2); \
    vls##i = d * 72 + cc * 8;                                                                            \
    vsx##i = (d & 8) != 0;                                                                               \
  }
  KGEO(0) KGEO(1) KGEO(2) VGEO(0) VGEO(1)
  (void)kof2; (void)kmu2; (void)kls2;
  u32x4 kr0A, kr1A, kr2A, vr0A, vr1A, kr0B, kr1B, kr2B, vr0B, vr1B;
  kr2A = kr1A = kr0A = vr0A = vr1A = kr2B = kr1B = kr0B = vr0B = vr1B = (u32x4){0u, 0u, 0u, 0u};
#define TILE_KK0(t) ((MODE == 1 && (t) >= 4) ? (uint32_t)(CTXL + 64 * min(rs0 + (t)-4, 255)) : (uint32_t)(64 * (t)))
#define LOAD_KV(t, S)                                                                   \
  {                                                                                     \
    const uint32_t kk0_ = TILE_KK0(t);                                                  \
    kr0##S = *(const u32x4*)(wsb + (size_t)(kof0 + kk0_ * kmu0));                       \
    kr1##S = *(const u32x4*)(wsb + (size_t)(kof1 + kk0_ * kmu1));                       \
    if (NKC == 3) kr2##S = *(const u32x4*)(wsb + (size_t)(kof2 + kk0_ * kmu2));         \
    vr0##S = *(const u32x4*)(wsb + (size_t)(vof0 + kk0_ * 2u));                         \
    vr1##S = *(const u32x4*)(wsb + (size_t)(vof1 + kk0_ * 2u));                         \
  }
#define STORE_V1(buf, i, srcv)                                                          \
  {                                                                                     \
    *(u32x4*)(Vs + (buf)*64 * 72 + vls##i) = srcv;                                      \
  }
#define STORE_KV(buf, S)                                                                \
  {                                                                                     \
    *(u32x4*)(Ks + (buf)*64 * KSTR + kls0) = kr0##S;                                    \
    *(u32x4*)(Ks + (buf)*64 * KSTR + kls1) = kr1##S;                                    \
    if (NKC == 3) *(u32x4*)(Ks + (buf)*64 * KSTR + kls2) = kr2##S;                      \
    STORE_V1(buf, 0, vr0##S) STORE_V1(buf, 1, vr1##S)                                   \
  }
#define QK_TILE(kbuf, t)                                                                           \
  {                                                                                                \
    const u16* kb_ = Ks + (kbuf)*64 * KSTR + r * KSTR + hh * 8;                                    \
    {                                                                                              \
      f32x16 z_;                                                                                   \
      _Pragma("unroll") for (int e = 0; e < 16; e++) z_[e] = 0.f;                                  \
      f32x16 s0_ = __builtin_amdgcn_mfma_f32_32x32x16_bf16(kone, qm, z_, 0, 0, 0);                 \
      asm volatile("" : "+v"(s0_));              \
      sc[0] = s0_;                                                                                 \
      sc[1] = s0_;                                                                                 \
    }                                                                                              \
    _Pragma("unroll") for (int ks = 0; ks < NKS; ks++) {                                           \
      const bf16x8 kf0 = *(const bf16x8*)(kb_ + ks * 16);                                          \
      const bf16x8 kf1 = *(const bf16x8*)(kb_ + 32 * KSTR + ks * 16);                              \
      sc[0] = __builtin_amdgcn_mfma_f32_32x32x16_bf16(kf0, qf[ks], sc[0], 0, 0, 0);                \
      sc[1] = __builtin_amdgcn_mfma_f32_32x32x16_bf16(kf1, qf[ks], sc[1], 0, 0, 0);                \
    }                                                                                              \
    if (MODE == 1 && (t) >= 4) {                                                                   \
      const int kr_ = rs0 + (t)-4;                                                                 \
      const bool rowok = (kr_ >= rsq) && (kr_ < rsq + 8);                                          \
      const float* rp = rpb + (kr_ - qr + 7) * 31 + (15 - qc);                                     \
      _Pragma("unroll") for (int kb = 0; kb < 2; kb++) _Pragma("unroll") for (int e = 0; e < 16; e++) { \
        const int kc = kb * 32 + (e & 3) + 8 * (e >> 2) + 4 * hh;                                  \
        const bool valid = rowok && (kc >= cs) && (kc < cs + 16);                                  \
        float bias = 0.f;                                                                          \
        if (valid) bias = rp[kc];                                                                  \
        sc[kb][e] = valid ? sc[kb][e] + bias * LOG2E : -1e30f;                                     \
      }                                                                                            \
    }                                                                                              \
  }
#define TILE_MAX(tmax)                                                                             \
  {                                                                                                \
    tmax = sc[0][0];                                                                               \
    _Pragma("unroll") for (int e = 1; e < 16; e++) tmax = fmaxf(tmax, sc[0][e]);                   \
    _Pragma("unroll") for (int e = 0; e < 16; e++) tmax = fmaxf(tmax, sc[1][e]);                   \
    const uint32_t tu = __float_as_uint(tmax);                                                     \
    const auto sw = __builtin_amdgcn_permlane32_swap(tu, tu, false, false);                        \
    tmax = fmaxf(__uint_as_float(sw[0]), __uint_as_float(sw[1]));                                  \
  }
#define MOVE_REF(mnew_)                                                                            \
  {                                                                                                \
    const float mq_ = bf2f(f2bf(mnew_));                                                           \
    const float delta_ = mq_ - m;                                                                  \
    const float alpha = __builtin_amdgcn_exp2f(-delta_);                                           \
    m = mq_;                                                                                       \
    _Pragma("unroll") for (int e = 0; e < 16; e++) {                                               \
      o[0][e] *= alpha; o[1][e] *= alpha;                                                         \
      sc[0][e] -= delta_; sc[1][e] -= delta_;                                                      \
    }                                                                                              \
    lsum *= alpha;                                                                                 \
    qm[0] = (hh == 0) ? (short)f2bf(-m) : (short)0;                                                \
  }
#define SOFTMAX_PV(vbuf)                                                                           \
  {                                                                                                \
    const u16* vb_ = Vs + (vbuf)*64 * 72 + r * 72 + 8 * hh;                                        \
    _Pragma("unroll") for (int kb = 0; kb < 2; kb++) _Pragma("unroll") for (int st = 0; st < 2; st++) { \
      u32x4 pu;                                                                                    \
      _Pragma("unroll") for (int q = 0; q < 4; q++) {                                              \
        const float p0_ = __builtin_amdgcn_exp2f(sc[kb][8 * st + 2 * q]);                          \
        const float p1_ = __builtin_amdgcn_exp2f(sc[kb][8 * st + 2 * q + 1]);                      \
        lsum += p0_ + p1_;                                                                         \
        pu[q] = pack2(p0_, p1_);                                                                   \
      }                                                                                            \
      const bf16x8 pbv = __builtin_bit_cast(bf16x8, pu);                                           \
      _Pragma("unroll") for (int db = 0; db < 2; db++) {                                           \
        const u16* vp = vb_ + db * 32 * 72 + kb * 32 + 16 * st;                                    \
        const bf16x8 vfv = *(const bf16x8*)(vp);     \
        o[db] = __builtin_amdgcn_mfma_f32_32x32x16_bf16(vfv, pbv, o[db], 0, 0, 0);                 \
      }                                                                                            \
    }                                                                                              \
  }
#define DEFER_REF(tmax)                                                                            \
  if (__any(tmax > 8.f)) {                                                                         \
    const float mq_ = bf2f(f2bf(m + fmaxf(tmax, 0.f)));                                            \
    const float alpha = __builtin_amdgcn_exp2f(m - mq_);                                           \
    m = mq_;                                                                                       \
    _Pragma("unroll") for (int e = 0; e < 16; e++) { o[0][e] *= alpha; o[1][e] *= alpha; }       \
    lsum *= alpha;                                                                                 \
    qm[0] = (hh == 0) ? (short)f2bf(-m) : (short)0;                                                \
  }
#define ATT_STEP(t, LD, ST)                                        \
  {                                                                \
    const int cur = (t)&1;                                         \
    QK_TILE(cur, t)                                                \
    __builtin_amdgcn_sched_barrier(0);                             \
    LOAD_KV(min((t) + 2, tl), LD)                                  \
    __builtin_amdgcn_sched_barrier(0);                             \
    __builtin_amdgcn_s_setprio(1);                                 \
    SOFTMAX_PV(cur)                                                \
    __builtin_amdgcn_s_setprio(0);                                 \
      \
                               \
    if ((((t) & 3) == 1)) {                                        \
      float tmax;                                                  \
      TILE_MAX(tmax)                                               \
      DEFER_REF(tmax)                                              \
    }                                                              \
    STORE_KV(cur ^ 1, ST)                                          \
    __syncthreads();                                               \
  }

  const int tl = ntiles - 1;
  f32x16 sc[2];
  LOAD_KV(0, A)
  STORE_KV(0, A)
  LOAD_KV(min(1, tl), A)
  __syncthreads();
  {
    LOAD_KV(min(2, tl), B)
    __builtin_amdgcn_sched_barrier(0);
    QK_TILE(0, 0)
    float tmax;
    TILE_MAX(tmax)
    MOVE_REF(tmax)
    SOFTMAX_PV(0)
    STORE_KV(1, A)
    __syncthreads();
  }
  for (int t = 1; t + 1 < ntiles; t += 2) {
    ATT_STEP(t, A, B)
    ATT_STEP(t + 1, B, A)
  }
  ATT_STEP(tl, A, B)
  const float inv = 1.f / (lsum + __shfl_xor(lsum, 32));
  u16* yp = wsp<u16>(p, O_Y) + qrow * 1536 + ycol + h * 64;
#pragma unroll
  for (int db = 0; db < 2; db++)
#pragma unroll
    for (int gp = 0; gp < 2; gp++) {
      uint2 oa, ob;
      oa.x = pack2(o[db][8 * gp] * inv, o[db][8 * gp + 1] * inv);
      oa.y = pack2(o[db][8 * gp + 2] * inv, o[db][8 * gp + 3] * inv);
      ob.x = pack2(o[db][8 * gp + 4] * inv, o[db][8 * gp + 5] * inv);
      ob.y = pack2(o[db][8 * gp + 6] * inv, o[db][8 * gp + 7] * inv);
      *(uint4*)(yp + db * 32 + 8 * (2 * gp + hh)) = pair_swap(oa, ob);
    }
#undef KGEO
#undef VGEO
#undef TILE_KK0
#undef LOAD_KV
#undef STORE_V1
#undef STORE_KV
#undef QK_TILE
#undef TILE_MAX
#undef MOVE_REF
#undef SOFTMAX_PV
#undef ATT_STEP
#undef DEFER_REF
}

__device__ void phase_p3(const Params& p, int l, bool last, int bid, int nb, u16* smem) {
  EPI_DECL
  const int nMLA = 2048, nNA = 2048, nFB = 1024;
  const int nC = last ? 0 : (32 + 32 + 16);
  const int total = nMLA + nNA + nFB + nC;
  for (int t = bid; t < total; t += nb) {
    int kind, b = 0, h = 0, q0 = 0, ntl = 0, rs0 = -1;
    size_t aoff = 0, boff = 0;
    int Kf = 256, j0 = 0, tok0 = 0, tokmul = 1, colbase = 0;
    if (t < nMLA) {
      kind = 0;
      h = t & 7;
      const int rest = t >> 3;
      b = rest >> 7;
      q0 = CTXL + (rest & 127) * 128;
      ntl = 260;
    } else if (t < nMLA + nNA) {
      kind = 1;
      const int t2 = t - nMLA;
      h = t2 & 7;
      const int rest = t2 >> 3, rp = rest & 127;
      b = rest >> 7;
      rs0 = min(max(2 * rp - 4, 0), 248);
      const int rs1 = min(max(2 * rp + 1 - 4, 0), 248);
      q0 = CTXL + rp * 128;
      ntl = (4 + (rs1 + 8 - rs0) + 1) & ~1;
    } else if (t < nMLA + nNA + nFB) {
      kind = 2;
      const int rt = t - nMLA - nNA;
      const int bk = rt >> 2;
      j0 = (rt & 3) * 128;
      b = bk >> 7;
      tok0 = CTXL + (bk & 127);
      tokmul = 128;
      aoff = O_D2 + (size_t)rt * 128 * 256 * 2;
      boff = O_MB;
      Kf = 256;
    } else {
      const int t2 = t - nMLA - nNA - nFB;
      if (t2 < 64) {
        kind = t2 >> 5;
        const int t3 = t2 & 31;
        h = t3 & 7;
        b = (t3 >> 3) & 1;
        q0 = (t3 >> 4) * 128;
        ntl = 4;
      } else {
        kind = 2;
        const int t3 = t2 - 64;
        const int rt = t3 >> 1, ct = t3 & 1;
        b = rt >> 2;
        j0 = (rt & 3) * 128;
        colbase = ct * 128;
        aoff = O_D1C + (size_t)rt * 128 * 512 * 2;
        boff = O_MC + (size_t)ct * 128 * 512 * 2;
        Kf = 512;
      }
    }
    if (kind == 0) {
      attn_item<0>(p, l, b, h, q0, ntl, -1, 1024, smem);
    } else if (kind == 1) {
      attn_item<1>(p, l, b, h, q0, ntl, rs0, 512, smem);
    } else {
      f32x16 acc[2][2];
      zero_acc(acc);
      gemm_core(acc, wsp<u16>(p, aoff), Kf, wsp<u16>(p, boff), Kf, Kf, smem);
      u16* Y = wsp<u16>(p, O_Y);
#pragma unroll
      for (int i = 0; i < 2; i++)
#pragma unroll
        for (int j = 0; j < 2; j++)
#pragma unroll
          for (int gp = 0; gp < 2; gp++) {
            const int jj = j0 + wm_ * 64 + i * 32 + 8 * (2 * gp + hh_);
            const int tok = tok0 + (colbase + wn_ * 64 + j * 32 + r_) * tokmul;
            uint2 oa, ob;
            oa.x = pack2(acc[i][j][8 * gp], acc[i][j][8 * gp + 1]);
            oa.y = pack2(acc[i][j][8 * gp + 2], acc[i][j][8 * gp + 3]);
            ob.x = pack2(acc[i][j][8 * gp + 4], acc[i][j][8 * gp + 5]);
            ob.y = pack2(acc[i][j][8 * gp + 6], acc[i][j][8 * gp + 7]);
            *(uint4*)(Y + ((size_t)b * KPB + tok) * 1536 + jj) = pair_swap(oa, ob);
          }
    }
  }
}

__device__ __forceinline__ int n_row_tiles(bool last) { return last ? NRT - 4 : NRT; }
__device__ __forceinline__ int row_tile(bool last, int i) {
  if (!last) return i;
  return i < 128 ? i + 2 : i + 4;
}

__device__ void phase_p4(const Params& p, int l, bool last, int bid, int nb, u16* smem) {
  EPI_DECL
  const u16* A = wsp<u16>(p, O_A);
  const u16* Y = wsp<u16>(p, O_Y);
  u16* M = wsp<u16>(p, O_M);
  uint4* stash = wsp<uint4>(p, O_QM) + (size_t)bid * 24 * 256 + ltid();
  const int nrt_ = n_row_tiles(last);
  PATCH_LOOP_BEGIN(nrt_, 8, 8, 8)
    const int rt = row_tile(last, prt), ct = pct;
    f32x16 mg[2][2];
    zero_acc(mg);
#pragma unroll 1
    for (int g = 0; g < 3; g++) {
      uint32_t gp[2][2][8];
      {
        f32x16 acc[2][2];
        zero_acc(acc);
        gemm_core<true>(acc, wsp<u16>(p, O_WG) + (size_t)(g * 1024 + ct * 128) * D, D, A + (size_t)rt * 128 * D, D, D,
                        smem);
#pragma unroll
        for (int i = 0; i < 2; i++)
#pragma unroll
          for (int j = 0; j < 2; j++)
#pragma unroll
            for (int e = 0; e < 8; e++)
              gp[i][j][e] = pack2(fsigmoid(acc[i][j][2 * e]), fsigmoid(acc[i][j][2 * e + 1]));
      }
      {
        f32x16 acc[2][2];
        zero_acc(acc);
        gemm_core<false>(acc, wsp<u16>(p, O_WB) + (size_t)(g * 1024 + ct * 128) * 512, 512,
                         Y + (size_t)rt * 128 * 1536 + g * 512, 1536, 512, smem);
#pragma unroll
        for (int i = 0; i < 2; i++)
#pragma unroll
          for (int j = 0; j < 2; j++)
#pragma unroll
            for (int e = 0; e < 8; e++) {
              mg[i][j][2 * e] += __uint_as_float(gp[i][j][e] << 16) * acc[i][j][2 * e];
              mg[i][j][2 * e + 1] += __uint_as_float(gp[i][j][e] & 0xffff0000u) * acc[i][j][2 * e + 1];
            }
      }
    }
#pragma unroll
    for (int i = 0; i < 2; i++)
#pragma unroll
      for (int j = 0; j < 2; j++)
#pragma unroll
        for (int gp = 0; gp < 2; gp++) {
          const int row = rt * 128 + wn_ * 64 + j * 32 + r_;
          const int col = ct * 128 + wm_ * 64 + i * 32 + 8 * (2 * gp + hh_);
          uint2 oa, ob;
          oa.x = pack2(mg[i][j][8 * gp], mg[i][j][8 * gp + 1]);
          oa.y = pack2(mg[i][j][8 * gp + 2], mg[i][j][8 * gp + 3]);
          ob.x = pack2(mg[i][j][8 * gp + 4], mg[i][j][8 * gp + 5]);
          ob.y = pack2(mg[i][j][8 * gp + 6], mg[i][j][8 * gp + 7]);
          *(uint4*)(M + (size_t)row * D + col) = pair_swap(oa, ob);
        }
  PATCH_LOOP_END
}

__device__ void phase_resid(const Params& p, int l, bool last, const u16* Ain, size_t lda, const u16* W, int K,
                            int bid, int nb, u16* smem) {
  EPI_DECL
  const int nrt_ = n_row_tiles(last);
  PATCH_LOOP_BEGIN(nrt_, 8, 8, 8)
    const int rt = row_tile(last, prt), ct = pct;
    f32x16 acc[2][2];
    zero_acc(acc);
    gemm_core(acc, W + (size_t)ct * 128 * K, K, Ain + (size_t)rt * 128 * lda, lda, K, smem);
    u16* FB = wsp<u16>(p, O_FB);
#pragma unroll
    for (int i = 0; i < 2; i++)
#pragma unroll
      for (int j = 0; j < 2; j++)
#pragma unroll
        for (int gp = 0; gp < 2; gp++) {
          const int row = rt * 128 + wn_ * 64 + j * 32 + r_;
          const int col = ct * 128 + wm_ * 64 + i * 32 + 8 * (2 * gp + hh_);
          uint2 oa, ob;
          oa.x = pack2(acc[i][j][8 * gp], acc[i][j][8 * gp + 1]);
          oa.y = pack2(acc[i][j][8 * gp + 2], acc[i][j][8 * gp + 3]);
          ob.x = pack2(acc[i][j][8 * gp + 4], acc[i][j][8 * gp + 5]);
          ob.y = pack2(acc[i][j][8 * gp + 6], acc[i][j][8 * gp + 7]);
          *(uint4*)(FB + (size_t)row * D + col) = pair_swap(oa, ob);
        }
  PATCH_LOOP_END
}

__device__ void phase_p7(const Params& p, int l, bool last, int bid, int nb, u16* smem) {
  EPI_DECL
  const u16* A = wsp<u16>(p, O_A);
  u16* HH = wsp<u16>(p, O_HH);
  const int nrt_ = n_row_tiles(last);
  for (int t = bid; t < nrt_ * 44; t += nb) {
    const int prt = t / 44, ct = t - prt * 44;
    const int rt = row_tile(last, prt);
    f32x16 acc[2][2];
    zero_acc(acc);
    gemm_core(acc, wsp<u16>(p, O_WGU) + (size_t)ct * 128 * D, D, A + (size_t)rt * 128 * D, D, D, smem);
#pragma unroll
    for (int j = 0; j < 2; j++)
#pragma unroll
      for (int gp = 0; gp < 2; gp++) {
        const int row = rt * 128 + wn_ * 64 + j * 32 + r_;
        const int q = (ct * 2 + wm_) * 32 + 8 * (2 * gp + hh_);
        float hv[8];
#pragma unroll
        for (int t = 0; t < 8; t++) {
          const float gt = acc[0][j][8 * gp + t], up = acc[1][j][8 * gp + t];
          hv[t] = gt * fsigmoid(gt) * up;
        }
        uint2 oa, ob;
        oa.x = pack2(hv[0], hv[1]);
        oa.y = pack2(hv[2], hv[3]);
        ob.x = pack2(hv[4], hv[5]);
        ob.y = pack2(hv[6], hv[7]);
        *(uint4*)(HH + (size_t)row * FH + q) = pair_swap(oa, ob);
      }
  }
}

constexpr int NPHASE = 3 + 9 * 2;

__device__ void run_phase(const Params& p, int ph, int bid, int nb, u16* smem) {
  if (ph == 0) {
    prep_tables(p, bid, nb);
    prep_modp(p, bid, nb);
    prep_weights(p, 0, bid, nb, smem);
    return;
  }
  if (ph == 1) { prep_modr(p, bid, nb); return; }
  if (ph == 2) { ln_phase(p, 0, p.ln_in_g, p.ln_in_b, 0, 0, 1024, false, bid, nb); return; }
  const int l = (ph - 3) / 9, s = (ph - 3) % 9;
  const bool last = (l == 1);
  switch (s) {
    case 0: phase_p1(p, l, last, bid, nb, smem); break;
    case 1: phase_p2(p, l, bid, nb, smem); break;
    case 2: phase_p3(p, l, last, bid, nb, smem); break;
    case 3: phase_p4(p, l, last, bid, nb, smem); break;
    case 4: phase_resid(p, l, last, wsp<u16>(p, O_M), D, wsp<u16>(p, O_WO), D, bid, nb, smem); break;
    case 5: ln_phase(p, 1, p.ln1_g + l * D, p.ln1_b + l * D, l, 3072, 4096, last, bid, nb, l, 2048); break;
    case 6: phase_p7(p, l, last, bid, nb, smem); break;
    case 7: phase_resid(p, l, last, wsp<u16>(p, O_HH), FH, wsp<u16>(p, O_WD), FH, bid, nb, smem); break;
    default:
      ln_phase(p, 1, p.ln2_g + l * D, p.ln2_b + l * D, last ? -1 : l + 1, 0, 1024, last, bid, nb, l, 5120);
      if (!last) prep_weights(p, l + 1, bid, nb, smem);
      break;
  }
}


#define XB_TMO      128
#define XB_XCNT(j)  (256  + 64 * (j))
#define XB_XSUB(j)  (1280 + 64 * (j))
#define XB_XGEN(j)  (2304 + 64 * (j))
#define XB_TOP      3328
#define XB_TOPGEN   3392
#define XCD_BAR_WORDS 3456
#define XB_SPIN_CAP (1u << 20)
#define LAS __attribute__((address_space(3)))
__device__ __forceinline__ unsigned xb_ld(unsigned* p) { return __hip_atomic_load(p, __ATOMIC_RELAXED, __HIP_MEMORY_SCOPE_AGENT); }
__device__ __forceinline__ unsigned xb_add(unsigned* p, unsigned v) { return __hip_atomic_fetch_add(p, v, __ATOMIC_RELAXED, __HIP_MEMORY_SCOPE_AGENT); }
__device__ __forceinline__ unsigned xb_xcc_id() { return (unsigned)__builtin_amdgcn_s_getreg((3 << 11) | 20) & 0xFu; }
#define XB_SPIN(cond, bar) do { unsigned _sp = 0; while (cond) { __builtin_amdgcn_s_sleep(1); \
    if ((++_sp & 255u) == 0u) { if (xb_ld(&(bar)[XB_TMO])) break; if (_sp > XB_SPIN_CAP) { atomicAdd(&(bar)[XB_TMO], 1u); break; } } } } while (0)
struct XcdBarrier {
  unsigned* bar; unsigned x;
  volatile LAS unsigned* st;
};
__device__ __forceinline__ XcdBarrier xcd_barrier_post(unsigned* bar, volatile LAS unsigned* st) {
  XcdBarrier b; b.bar = bar; b.x = xb_xcc_id(); b.st = st;
  if (threadIdx.x == 0) (void)xb_add(&bar[XB_XCNT(b.x)], 1u);
  return b;
}
__device__ __forceinline__ void xcd_barrier_complete(unsigned* bar, unsigned x, unsigned& nloc, unsigned& nx) {
  const unsigned G = gridDim.x * gridDim.y * gridDim.z;
  unsigned sum, cnt, mine, sp = 0u;
  for (;;) {
    sum = 0u; cnt = 0u; mine = 0u;
#pragma unroll
    for (unsigned j = 0; j < 16; ++j) { const unsigned c = xb_ld(&bar[XB_XCNT(j)]); sum += c; cnt += (c > 0u) ? 1u : 0u; mine = (j == x) ? c : mine; }
    if (sum == G) break;
    __builtin_amdgcn_s_sleep(1);
    if ((++sp & 255u) == 0u) { if (xb_ld(&bar[XB_TMO])) break; if (sp > XB_SPIN_CAP) { atomicAdd(&bar[XB_TMO], 1u); break; } }
  }
  nloc = mine > 0u ? mine : 1u; nx = cnt > 0u ? cnt : 1u;
}
__device__ __forceinline__ void xcd_barrier(const XcdBarrier& b) {
  asm volatile("s_waitcnt vmcnt(0)" ::: "memory");
  __syncthreads();
  if (threadIdx.x == 0) {
    unsigned* bar = b.bar;
    __builtin_amdgcn_s_waitcnt(0);
    unsigned nloc = b.st[0], nx = b.st[1];
    if (nloc == 0u) { xcd_barrier_complete(bar, b.x, nloc, nx); b.st[0] = nloc; b.st[1] = nx; }
    const unsigned old = xb_add(&bar[XB_XSUB(b.x)], 1u);
    const unsigned gen = old / nloc;
    if (old + 1u == (gen + 1u) * nloc) {
      __builtin_amdgcn_fence(__ATOMIC_RELEASE, "agent");
      asm volatile("s_waitcnt vmcnt(0)" ::: "memory");
      const unsigned og = xb_add(&bar[XB_TOP], 1u);
      const unsigned tg = og / nx;
      if (og + 1u == (tg + 1u) * nx) xb_add(&bar[XB_TOPGEN], 1u);
      else XB_SPIN(xb_ld(&bar[XB_TOPGEN]) == tg, bar);
      __builtin_amdgcn_fence(__ATOMIC_ACQUIRE, "agent");
      xb_add(&bar[XB_XGEN(b.x)], 1u);
      asm volatile("s_waitcnt vmcnt(0)" ::: "memory");
    } else {
      XB_SPIN(xb_ld(&bar[XB_XGEN(b.x)]) == gen, bar);
      __builtin_amdgcn_fence(__ATOMIC_ACQUIRE, "agent");
      asm volatile("s_waitcnt vmcnt(0)" ::: "memory");
    }
  }
  __syncthreads();
}

constexpr int SMEM_ELEMS = 4 * SM_A + 256 + 8;

#if COOP
__global__ void __launch_bounds__(256, 2) mega_kernel(Params p) {
  __shared__ __attribute__((aligned(16))) u16 smem[SMEM_ELEMS];
  cg::grid_group grid = cg::this_grid();
  volatile LAS unsigned* st = (volatile LAS unsigned*)(smem + 4 * SM_A + 256);
  if (threadIdx.x == 0) { st[0] = 0u; st[1] = 0u; }
  __syncthreads();
  XcdBarrier xb = xcd_barrier_post((unsigned*)(p.ws + O_BAR), st);
  for (int ph = 0; ph < NPHASE; ph++) {
#ifdef PROBE_MASK
    const int s9 = ph >= 3 ? (ph - 3) % 9 : -1;
    const int nrep = (s9 >= 0 && ((PROBE_MASK >> s9) & 1)) ? 2 : 1;
    for (int rep = 0; rep < nrep; rep++) {
      run_phase(p, ph, blockIdx.x, gridDim.x, smem);
      if (ph == 0) grid.sync();
      else if (ph + 1 < NPHASE || rep + 1 < nrep) xcd_barrier(xb);
    }
#else
    run_phase(p, ph, blockIdx.x, gridDim.x, smem);
    if (ph == 0) grid.sync();
    else if (ph + 1 < NPHASE) xcd_barrier(xb);
#endif
  }
}
#else
__global__ void __launch_bounds__(256, 2) phase_kernel(Params p, int ph) {
  __shared__ __attribute__((aligned(16))) u16 smem[SMEM_ELEMS];
  run_phase(p, ph, blockIdx.x, gridDim.x, smem);
}
#endif

extern "C" void kernel_launch(void* const* d_in, const int* in_sizes, int n_in, void* d_out, int out_size, void* d_ws,
                              size_t ws_size, hipStream_t stream) {
  Params p{};
  const float** f = (const float**)&p;
  for (int i = 0; i < 25; i++) f[i] = (const float*)d_in[i];
  p.out = (float*)d_out;
  p.ws = (unsigned char*)d_ws;
  if (ws_size < O_WSEND) fprintf(stderr, "workspace too small: %zu < %zu\n", ws_size, (size_t)O_WSEND);
#if COOP
  static int grid_blocks = 0;
  if (!grid_blocks) {
    int dev = 0, cus = 0, per_cu = 0;
    hipGetDevice(&dev);
    hipDeviceGetAttribute(&cus, hipDeviceAttributeMultiprocessorCount, dev);
    hipOccupancyMaxActiveBlocksPerMultiprocessor(&per_cu, mega_kernel, 256, 0);
    if (per_cu > 2) per_cu = 2;
    grid_blocks = cus * per_cu;
  }
  (void)hipMemsetAsync(p.ws + O_BAR, 0, 3456 * 4, stream);
  void* args[] = {&p};
  hipError_t e = hipLaunchCooperativeKernel((void*)mega_kernel, dim3(grid_blocks), dim3(256), args, 0, stream);
  if (e != hipSuccess) fprintf(stderr, "cooperative launch failed: %s (grid %d)\n", hipGetErrorString(e), grid_blocks);
#else
  for (int ph = 0; ph < NPHASE; ph++) phase_kernel<<<512, 256, 0, stream>>>(p, ph);
#endif
}
```
